# Optimizing an MI355X kernel written in HIP

```python
import numpy as np
import jax
import jax.numpy as jnp
from jax import lax

D_MODEL = 1024
BATCH = 8
SEQ = 2048
DEPTH = 4

GRID_W = 64
CTX_LEN = 256
N_MIXERS = 3
NORM_EPS = 1e-6
ROPE_THETA = 10000.0
NEG_INF = -1e30

A_HEADS = 16
A_KV_HEADS = 4
A_GROUP = A_HEADS // A_KV_HEADS
A_HEAD_DIM = D_MODEL // A_HEADS
A_WINDOW = 128
A_BLOCK = 128

B_HEADS = 16
B_HEAD_DIM = D_MODEL // B_HEADS
NA_ROWS = 8
NA_COLS = 16
NA_QCOLS = 16
NA_KCOLS = NA_QCOLS + NA_COLS
NA_NCB = GRID_W // NA_QCOLS

C_HEADS = 16
C_NOPE_DIM = 64
C_ROPE_DIM = 32
C_V_DIM = 64
C_Q_LORA = 256
C_KV_LORA = 128
C_BLOCK = 128

N_EXPERTS = 32
TOP_K = 4
D_EXPERT = D_MODEL
SWIGLU_LIMIT = 7.0
SWIGLU_ALPHA = 1.702
MOE_BLOCK = 256

kernel_name = "hybrid_diffusion_swa_natten_mla_moe"

F32 = jnp.float32


def rmsnorm(x, g):
    xf = x.astype(F32)
    y = xf * lax.rsqrt(jnp.mean(xf * xf, axis=-1, keepdims=True) + NORM_EPS)
    return (y * g.astype(F32)).astype(x.dtype)


def modulate(x, shift, scale):
    return x * (1 + scale) + shift


def axial_rope_angles(n_tokens, rot_dim):
    t = jnp.arange(n_tokens)
    row = (t // GRID_W).astype(F32)
    col = (t % GRID_W).astype(F32)
    n_freq = rot_dim // 4
    inv = ROPE_THETA ** (-jnp.arange(n_freq, dtype=F32) / n_freq)
    ang = jnp.concatenate([row[:, None] * inv, col[:, None] * inv], axis=-1)
    return jnp.cos(ang), jnp.sin(ang)


def apply_rope(x, cos, sin):
    shape = (1, cos.shape[0]) + (1,) * (x.ndim - 3) + (cos.shape[1],)
    cs = cos.reshape(shape)
    sn = sin.reshape(shape)
    xf = x.astype(F32).reshape(x.shape[:-1] + (-1, 2))
    x1, x2 = xf[..., 0], xf[..., 1]
    out = jnp.stack([x1 * cs - x2 * sn, x1 * sn + x2 * cs], axis=-1).reshape(x.shape)
    return out.astype(x.dtype)


def joint_softmax(parts, sink=None):
    s = jnp.concatenate([p.astype(F32) for p in parts], axis=-1)
    m = jnp.max(s, axis=-1, keepdims=True)
    if sink is not None:
        m = jnp.maximum(m, sink)
    e = jnp.exp(s - m)
    den = jnp.sum(e, axis=-1, keepdims=True)
    if sink is not None:
        den = den + jnp.exp(sink - m)
    p = e / den
    cuts = [int(v) for v in np.cumsum([q.shape[-1] for q in parts])[:-1]]
    return jnp.split(p, cuts, axis=-1)


def window_gqa_mixer(h, hc, w_in, w_out, sink, cos, sin, need_ctx):
    B, S, _ = h.shape
    C = hc.shape[1]
    qd = A_HEADS * A_HEAD_DIM
    kd = A_KV_HEADS * A_HEAD_DIM
    y = h @ w_in
    q = y[..., :qd].reshape(B, S, A_KV_HEADS, A_GROUP, A_HEAD_DIM)
    k = y[..., qd:qd + kd].reshape(B, S, A_KV_HEADS, A_HEAD_DIM)
    v = y[..., qd + kd:].reshape(B, S, A_KV_HEADS, A_HEAD_DIM)
    q = apply_rope(q, cos, sin)
    k = apply_rope(k, cos, sin)
    yc = hc @ (w_in if need_ctx else w_in[:, qd:])
    kc = yc[..., -2 * kd:-kd].reshape(B, C, A_KV_HEADS, A_HEAD_DIM)
    vc = yc[..., -kd:].reshape(B, C, A_KV_HEADS, A_HEAD_DIM)
    scale = A_HEAD_DIM ** -0.5
    sink_f = sink.astype(F32).reshape(A_KV_HEADS, A_GROUP)[None, :, :, None, None]
    nb = S // A_BLOCK

    def windows(t):
        tp = jnp.pad(t, ((0, 0), (A_BLOCK, A_BLOCK), (0, 0), (0, 0)))
        tp = tp.reshape(B, nb + 2, A_BLOCK, A_KV_HEADS, A_HEAD_DIM)
        w = jnp.concatenate([tp[:, :-2], tp[:, 1:-1], tp[:, 2:]], axis=2)
        return jnp.moveaxis(w, 1, 0)

    qb = jnp.moveaxis(q.reshape(B, nb, A_BLOCK, A_KV_HEADS, A_GROUP, A_HEAD_DIM), 1, 0)
    rel = jnp.arange(3 * A_BLOCK)[None, :] - A_BLOCK - jnp.arange(A_BLOCK)[:, None]
    band = jnp.abs(rel) <= A_WINDOW

    def block(args):
        qi, ki, vi, b = args
        kpos = (b - 1) * A_BLOCK + jnp.arange(3 * A_BLOCK)
        valid = band & ((kpos >= 0) & (kpos < S))[None, :]
        s_loc = jnp.einsum('bqkgd,bjkd->bkgqj', qi, ki).astype(F32) * scale
        s_loc = jnp.where(valid, s_loc, NEG_INF)
        s_ctx = jnp.einsum('bqkgd,bckd->bkgqc', qi, kc).astype(F32) * scale
        p_loc, p_ctx = joint_softmax([s_loc, s_ctx], sink_f)
        return (jnp.einsum('bkgqj,bjkd->bqkgd', p_loc.astype(vi.dtype), vi)
                + jnp.einsum('bkgqc,bckd->bqkgd', p_ctx.astype(vc.dtype), vc))

    o = lax.map(block, (qb, windows(k), windows(v), jnp.arange(nb)))
    out = jnp.moveaxis(o, 0, 1).reshape(B, S, qd) @ w_out
    out_c = None
    if need_ctx:
        qc = yc[..., :qd].reshape(B, C, A_KV_HEADS, A_GROUP, A_HEAD_DIM)
        s = jnp.einsum('bqkgd,bckd->bkgqc', qc, kc).astype(F32) * scale
        (p,) = joint_softmax([s], sink_f)
        oc = jnp.einsum('bkgqc,bckd->bqkgd', p.astype(vc.dtype), vc)
        out_c = oc.reshape(B, C, qd) @ w_out
    return out, out_c


def neighbourhood_mixer(h, hc, w_in, w_out, rpb, need_ctx):
    B, S, _ = h.shape
    C = hc.shape[1]
    rows = S // GRID_W
    kh = min(NA_ROWS, rows)
    wd = B_HEADS * B_HEAD_DIM
    y = h @ w_in
    q = y[..., :wd].reshape(B, S, B_HEADS, B_HEAD_DIM)
    k = y[..., wd:2 * wd].reshape(B, S, B_HEADS, B_HEAD_DIM)
    v = y[..., 2 * wd:].reshape(B, S, B_HEADS, B_HEAD_DIM)
    yc = hc @ (w_in if need_ctx else w_in[:, wd:])
    kc = yc[..., -2 * wd:-wd].reshape(B, C, B_HEADS, B_HEAD_DIM)
    vc = yc[..., -wd:].reshape(B, C, B_HEADS, B_HEAD_DIM)
    scale = B_HEAD_DIM ** -0.5

    qcol = np.arange(NA_NCB)[:, None] * NA_QCOLS + np.arange(NA_QCOLS)[None, :]
    cstart = np.clip(np.arange(NA_NCB) * NA_QCOLS - NA_COLS // 2, 0, GRID_W - NA_KCOLS)
    kcol = cstart[:, None] + np.arange(NA_KCOLS)[None, :]
    wstart = np.clip(qcol - NA_COLS // 2, 0, GRID_W - NA_COLS)
    col_ok = ((kcol[:, None, :] >= wstart[..., None])
              & (kcol[:, None, :] < wstart[..., None] + NA_COLS))
    col_ok = jnp.asarray(col_ok[:, :, None, :])
    dc_idx = jnp.asarray(np.clip(kcol[:, None, :] - qcol[..., None] + NA_COLS - 1, 0, 2 * NA_COLS - 2))
    kcol_j = jnp.asarray(kcol)

    q_rows = jnp.moveaxis(q.reshape(B, rows, NA_NCB, NA_QCOLS, B_HEADS, B_HEAD_DIM), 1, 0)
    k_grid = k.reshape(B, rows, GRID_W, B_HEADS, B_HEAD_DIM)
    v_grid = v.reshape(B, rows, GRID_W, B_HEADS, B_HEAD_DIM)
    rpb_f = rpb.astype(F32)

    def row_block(args):
        qr, r = args
        r0 = jnp.clip(r - kh // 2, 0, rows - kh)
        kr = lax.dynamic_slice_in_dim(k_grid, r0, kh, axis=1)[:, :, kcol_j]
        vr = lax.dynamic_slice_in_dim(v_grid, r0, kh, axis=1)[:, :, kcol_j]
        s_loc = jnp.einsum('bjqhd,brjkhd->bhjqrk', qr, kr).astype(F32) * scale
        dr_idx = r0 + jnp.arange(kh) - r + NA_ROWS - 1
        bias = rpb_f[:, dr_idx[None, None, :, None], dc_idx[:, :, None, :]]
        s_loc = jnp.where(col_ok, s_loc + bias, NEG_INF)
        s_loc = s_loc.reshape(B, B_HEADS, NA_NCB, NA_QCOLS, kh * NA_KCOLS)
        s_ctx = jnp.einsum('bjqhd,bchd->bhjqc', qr, kc).astype(F32) * scale
        p_loc, p_ctx = joint_softmax([s_loc, s_ctx])
        p_loc = p_loc.reshape(B, B_HEADS, NA_NCB, NA_QCOLS, kh, NA_KCOLS)
        return (jnp.einsum('bhjqrk,brjkhd->bjqhd', p_loc.astype(vr.dtype), vr)
                + jnp.einsum('bhjqc,bchd->bjqhd', p_ctx.astype(vc.dtype), vc))

    o = lax.map(row_block, (q_rows, jnp.arange(rows)))
    out = jnp.moveaxis(o, 0, 1).reshape(B, S, wd) @ w_out
    out_c = None
    if need_ctx:
        qc = yc[..., :wd].reshape(B, C, B_HEADS, B_HEAD_DIM)
        s = jnp.einsum('bqhd,bchd->bhqc', qc, kc).astype(F32) * scale
        (p,) = joint_softmax([s])
        oc = jnp.einsum('bhqc,bchd->bqhd', p.astype(vc.dtype), vc)
        out_c = oc.reshape(B, C, wd) @ w_out
    return out, out_c


def mla_mixer(h, hc, w_in, q_norm, kv_norm, w_uq, w_ukv, w_out, cos, sin, need_ctx):
    B, S, _ = h.shape
    C = hc.shape[1]
    H = C_HEADS
    scale = (C_NOPE_DIM + C_ROPE_DIM) ** -0.5

    def kv_path(yk, n):
        ckv = rmsnorm(yk[..., :C_KV_LORA], kv_norm)
        k_rope = yk[..., C_KV_LORA:]
        kv = (ckv @ w_ukv).reshape(B, n, H, C_NOPE_DIM + C_V_DIM)
        return kv[..., :C_NOPE_DIM], k_rope, kv[..., C_NOPE_DIM:]

    def q_path(yq, n):
        cq = rmsnorm(yq, q_norm)
        qq = (cq @ w_uq).reshape(B, n, H, C_NOPE_DIM + C_ROPE_DIM)
        return qq[..., :C_NOPE_DIM], qq[..., C_NOPE_DIM:]

    def attend(qn, qr, kn, kr, vv):
        s = (jnp.einsum('bqhd,bkhd->bhqk', qn, kn)
             + jnp.einsum('bqhd,bkd->bhqk', qr, kr)).astype(F32) * scale
        (p,) = joint_softmax([s])
        return jnp.einsum('bhqk,bkhd->bqhd', p.astype(vv.dtype), vv)

    y = h @ w_in
    qn, qr = q_path(y[..., :C_Q_LORA], S)
    kn, kr, v = kv_path(y[..., C_Q_LORA:], S)
    qr = apply_rope(qr, cos, sin)
    kr = apply_rope(kr, cos, sin)
    yc = hc @ (w_in if need_ctx else w_in[:, C_Q_LORA:])
    kn_c, kr_c, v_c = kv_path(yc[..., -(C_KV_LORA + C_ROPE_DIM):], C)
    kn_all = jnp.concatenate([kn_c, kn], axis=1)
    kr_all = jnp.concatenate([kr_c, kr], axis=1)
    v_all = jnp.concatenate([v_c, v], axis=1)
    nb = S // C_BLOCK
    qn_b = jnp.moveaxis(qn.reshape(B, nb, C_BLOCK, H, C_NOPE_DIM), 1, 0)
    qr_b = jnp.moveaxis(qr.reshape(B, nb, C_BLOCK, H, C_ROPE_DIM), 1, 0)
    o = lax.map(lambda a: attend(a[0], a[1], kn_all, kr_all, v_all), (qn_b, qr_b))
    out = jnp.moveaxis(o, 0, 1).reshape(B, S, H * C_V_DIM) @ w_out
    out_c = None
    if need_ctx:
        qn_c, qr_c = q_path(yc[..., :C_Q_LORA], C)
        oc = attend(qn_c, qr_c, kn_c, kr_c, v_c)
        out_c = oc.reshape(B, C, H * C_V_DIM) @ w_out
    return out, out_c


def moe_ffn(t, router_w, router_b, w_gate, b_gate, w_up, b_up, w_down, b_down):
    n, d = t.shape
    logits = (t @ router_w).astype(F32) + router_b.astype(F32)
    top_val, top_idx = lax.top_k(logits, TOP_K)
    gates = jax.nn.softmax(top_val, axis=-1)
    nk = n * TOP_K
    flat_e = top_idx.reshape(-1).astype(jnp.int32)
    order = jnp.argsort(flat_e)
    sorted_e = flat_e[order]
    counts = jnp.bincount(flat_e, length=N_EXPERTS).astype(jnp.int32)
    padded = (counts + MOE_BLOCK - 1) // MOE_BLOCK * MOE_BLOCK
    pad_end = jnp.cumsum(padded)
    pad_start = pad_end - padded
    grp_start = jnp.cumsum(counts) - counts
    dest = pad_start[sorted_e] + jnp.arange(nk, dtype=jnp.int32) - grp_start[sorted_e]
    n_blocks = -(-nk // MOE_BLOCK) + N_EXPERTS
    slot_token = jnp.full((n_blocks * MOE_BLOCK,), n, jnp.int32).at[dest].set(
        (order // TOP_K).astype(jnp.int32))
    block_expert = jnp.minimum(
        jnp.searchsorted(pad_end, jnp.arange(n_blocks, dtype=jnp.int32) * MOE_BLOCK, side='right'),
        N_EXPERTS - 1)
    t_pad = jnp.concatenate([t, jnp.zeros((1, d), t.dtype)], axis=0)
    x_blocks = t_pad[slot_token].reshape(n_blocks, MOE_BLOCK, d)

    def expert_block(args):
        xb, e = args
        g = xb @ w_gate[e] + b_gate[e]
        u = xb @ w_up[e] + b_up[e]
        g = jnp.minimum(g, SWIGLU_LIMIT)
        u = jnp.clip(u, -SWIGLU_LIMIT, SWIGLU_LIMIT)
        a = g * jax.nn.sigmoid(SWIGLU_ALPHA * g) * (u + 1)
        return a @ w_down[e] + b_down[e]

    y_slots = lax.map(expert_block, (x_blocks, block_expert)).reshape(-1, d)
    slot_of = jnp.zeros((nk,), jnp.int32).at[order].set(dest)
    y = y_slots[slot_of].reshape(n, TOP_K, d)
    return jnp.einsum('nkd,nk->nd', y, gates.astype(y.dtype))


def setup_inputs(seed: int = 0) -> dict:
    key = jax.random.key(seed)
    keys = iter(jax.random.split(key, 32))

    def rnd(shape, scale):
        return jax.random.normal(next(keys), shape, jnp.float32) * scale

    D = D_MODEL
    n_a = len(range(0, DEPTH, N_MIXERS))
    n_b = len(range(1, DEPTH, N_MIXERS))
    n_c = len(range(2, DEPTH, N_MIXERS))
    a_qd = A_HEADS * A_HEAD_DIM
    a_in = a_qd + 2 * A_KV_HEADS * A_HEAD_DIM
    b_w = B_HEADS * B_HEAD_DIM
    c_in = C_Q_LORA + C_KV_LORA + C_ROPE_DIM
    return {
        "x": rnd((BATCH, SEQ, D), 1.0),
        "c": rnd((BATCH, D), 1.0),
        "ctx": rnd((BATCH, CTX_LEN, D), 1.0),
        "c_ctx": rnd((D,), 1.0),
        "ada_w": rnd((DEPTH, D, 6 * D), 0.5 * D ** -0.5),
        "ada_b": rnd((DEPTH, 6 * D), 0.02),
        "norm_mix": 1.0 + rnd((DEPTH, D), 0.05),
        "norm_ffn": 1.0 + rnd((DEPTH, D), 0.05),
        "norm_out": 1.0 + rnd((D,), 0.05),
        "a_w_in": rnd((n_a, D, a_in), D ** -0.5),
        "a_w_out": rnd((n_a, a_qd, D), a_qd ** -0.5),
        "a_sink": rnd((n_a, A_HEADS), 0.5),
        "b_w_in": rnd((n_b, D, 3 * b_w), D ** -0.5),
        "b_w_out": rnd((n_b, b_w, D), b_w ** -0.5),
        "b_rpb": rnd((n_b, B_HEADS, 2 * NA_ROWS - 1, 2 * NA_COLS - 1), 0.2),
        "c_w_in": rnd((n_c, D, c_in), D ** -0.5),
        "c_q_norm": 1.0 + rnd((n_c, C_Q_LORA), 0.05),
        "c_kv_norm": 1.0 + rnd((n_c, C_KV_LORA), 0.05),
        "c_w_uq": rnd((n_c, C_Q_LORA, C_HEADS * (C_NOPE_DIM + C_ROPE_DIM)), C_Q_LORA ** -0.5),
        "c_w_ukv": rnd((n_c, C_KV_LORA, C_HEADS * (C_NOPE_DIM + C_V_DIM)), C_KV_LORA ** -0.5),
        "c_w_out": rnd((n_c, C_HEADS * C_V_DIM, D), (C_HEADS * C_V_DIM) ** -0.5),
        "router_w": rnd((DEPTH, D, N_EXPERTS), D ** -0.5),
        "router_b": rnd((DEPTH, N_EXPERTS), 0.01),
        "moe_w_gate": rnd((DEPTH, N_EXPERTS, D, D_EXPERT), D ** -0.5),
        "moe_b_gate": rnd((DEPTH, N_EXPERTS, D_EXPERT), 0.02),
        "moe_w_up": rnd((DEPTH, N_EXPERTS, D, D_EXPERT), D ** -0.5),
        "moe_b_up": rnd((DEPTH, N_EXPERTS, D_EXPERT), 0.02),
        "moe_w_down": rnd((DEPTH, N_EXPERTS, D_EXPERT, D), D_EXPERT ** -0.5),
        "moe_b_down": rnd((DEPTH, N_EXPERTS, D), 0.02),
    }


def reference(x, c, ctx, c_ctx, ada_w, ada_b, norm_mix, norm_ffn, norm_out,
              a_w_in, a_w_out, a_sink, b_w_in, b_w_out, b_rpb,
              c_w_in, c_q_norm, c_kv_norm, c_w_uq, c_w_ukv, c_w_out,
              router_w, router_b, moe_w_gate, moe_b_gate, moe_w_up, moe_b_up,
              moe_w_down, moe_b_down):
    B, S, D = x.shape
    C = ctx.shape[1]
    cos_a, sin_a = axial_rope_angles(S, A_HEAD_DIM)
    cos_c, sin_c = axial_rope_angles(S, C_ROPE_DIM)
    silu_c = jax.nn.silu(c)
    silu_cc = jax.nn.silu(c_ctx)
    xl, xc = x, ctx
    for l in range(DEPTH):
        last = l == DEPTH - 1
        kind, slot = l % N_MIXERS, l // N_MIXERS
        mod = (silu_c @ ada_w[l] + ada_b[l])[:, None, :]
        sh1, sc1, g1, sh2, sc2, g2 = jnp.split(mod, 6, axis=-1)
        modc = silu_cc @ ada_w[l] + ada_b[l]
        ch1, cs1, cg1, ch2, cs2, cg2 = jnp.split(modc, 6, axis=-1)

        h = modulate(rmsnorm(xl, norm_mix[l]), sh1, sc1)
        hc = modulate(rmsnorm(xc, norm_mix[l]), ch1, cs1)
        if kind == 0:
            y, yc = window_gqa_mixer(h, hc, a_w_in[slot], a_w_out[slot], a_sink[slot],
                                     cos_a, sin_a, not last)
        elif kind == 1:
            y, yc = neighbourhood_mixer(h, hc, b_w_in[slot], b_w_out[slot], b_rpb[slot], not last)
        else:
            y, yc = mla_mixer(h, hc, c_w_in[slot], c_q_norm[slot], c_kv_norm[slot], c_w_uq[slot],
                              c_w_ukv[slot], c_w_out[slot], cos_c, sin_c, not last)
        xl = xl + g1 * y

        h = modulate(rmsnorm(xl, norm_ffn[l]), sh2, sc2)
        moe_args = (router_w[l], router_b[l], moe_w_gate[l], moe_b_gate[l], moe_w_up[l],
                    moe_b_up[l], moe_w_down[l], moe_b_down[l])
        if last:
            f = moe_ffn(h.reshape(B * S, D), *moe_args)
            xl = xl + g2 * f.reshape(B, S, D)
        else:
            xc = xc + cg1 * yc
            hc = modulate(rmsnorm(xc, norm_ffn[l]), ch2, cs2)
            tokens = jnp.concatenate([h.reshape(B * S, D), hc.reshape(B * C, D)], axis=0)
            f = moe_ffn(tokens, *moe_args)
            xl = xl + g2 * f[:B * S].reshape(B, S, D)
            xc = xc + cg2 * f[B * S:].reshape(B, C, D)
    return rmsnorm(xl, norm_out)
```

```cpp
#include <hip/hip_runtime.h>
#include <cstdio>
#include <cstdint>

#ifndef MK_PER_PHASE
#define MK_PER_PHASE 0
#endif
#ifndef MK_MASK
#define MK_MASK 0xFFFF
#endif
#ifndef MK_STOP_AFTER
#define MK_STOP_AFTER 9999
#endif

#define LAS __attribute__((address_space(3)))
#define GAS __attribute__((address_space(1)))
typedef unsigned short bf16_t;
typedef short bf16x8 __attribute__((ext_vector_type(8)));
typedef short s16x4 __attribute__((ext_vector_type(4)));
typedef float f32x2 __attribute__((ext_vector_type(2)));
typedef float f32x4 __attribute__((ext_vector_type(4)));
typedef float f32x16 __attribute__((ext_vector_type(16)));
typedef unsigned u32x2 __attribute__((ext_vector_type(2)));
typedef unsigned u32x4 __attribute__((ext_vector_type(4)));

constexpr int D = 1024, NB = 8, SEQ = 2048, CTXL = 256, DEPTH = 4;
constexpr int NL = NB * SEQ;
constexpr int NC = NB * CTXL;
constexpr int NT = NL + NC;
constexpr int NEXP = 32, TOPK = 4;
constexpr int MAXSLOT = 81920;
constexpr float NORM_EPS = 1e-6f;
constexpr float LOG2E = 1.4426950408889634f;
constexpr int A_IN = 1536, B_IN = 3072, C_IN = 416, C_INP = 512, C_UPK = 384, C_UPN = 3584;

constexpr size_t MiB = 1u << 20;
constexpr size_t WS_CTL = 0, CTL_BYTES = 1 * MiB;
constexpr size_t WS_MOD = 1 * MiB;
constexpr size_t WS_ROPE_A = 2 * MiB;
constexpr size_t WS_ROPE_C = 2 * MiB + 512 * 1024;
constexpr size_t WS_TOPE = 3 * MiB;
constexpr size_t WS_POS = 3 * MiB + 512 * 1024;
constexpr size_t WS_GATE = 4 * MiB;
constexpr size_t WS_ELIST = 5 * MiB;
constexpr size_t WS_KR = 8 * MiB;
constexpr size_t WS_CQKV = 10 * MiB;
constexpr size_t WS_Y416 = 24 * MiB;
constexpr size_t WS_XS = 60 * MiB;
constexpr size_t WS_H = 132 * MiB;
constexpr size_t WS_O = 168 * MiB;
constexpr size_t WS_QKV = 204 * MiB;
constexpr size_t WS_ACT = 330 * MiB;
constexpr size_t WS_YS = 490 * MiB;
constexpr size_t WS_WA_IN = 650 * MiB;
constexpr size_t WS_WA_OUT = 656 * MiB;
constexpr size_t WS_WB_IN = 660 * MiB;
constexpr size_t WS_WB_OUT = 666 * MiB;
constexpr size_t WS_WC_IN = 668 * MiB;
constexpr size_t WS_WC_UP = 669 * MiB;
constexpr size_t WS_WC_OUT = 672 * MiB;
constexpr size_t WS_WGU = 676 * MiB;
constexpr size_t WS_WD = 1188 * MiB;
constexpr size_t WS_END = 1444 * MiB;

constexpr int CW_CNT = 1024;
constexpr int CW_BAR = 65536;

constexpr int RING_BYTES = 131072;
constexpr int MISC_OFF = RING_BYTES;
constexpr int M_BARW = 0, M_LCNT = 64, M_LBASE = 192, M_CUMT = 320, M_ECNT = 512, M_GBASE = 640, M_RPB = 1024, M_REC = 3072;
constexpr int LDS_BYTES = 147456;

#define XB_TMO      128
#define XB_XCNT(j)  (256  + 64 * (j))
#define XB_XSUB(j)  (1280 + 64 * (j))
#define XB_XGEN(j)  (2304 + 64 * (j))
#define XB_TOP      3328
#define XB_TOPGEN   3392
#define XCD_BAR_WORDS 3456
#define XB_SPIN_CAP (1u << 18)

__device__ __forceinline__ unsigned xb_ld(unsigned* p)              { return __hip_atomic_load(p, __ATOMIC_RELAXED, __HIP_MEMORY_SCOPE_AGENT); }
__device__ __forceinline__ unsigned xb_add(unsigned* p, unsigned v) { return __hip_atomic_fetch_add(p, v, __ATOMIC_RELAXED, __HIP_MEMORY_SCOPE_AGENT); }
__device__ __forceinline__ unsigned xb_xcc_id() { return (unsigned)__builtin_amdgcn_s_getreg((3 << 11) | 20) & 0xFu; }
#define XB_SPIN(cond, bar) do { unsigned _sp = 0; while (cond) { __builtin_amdgcn_s_sleep(1); \
    if ((++_sp & 255u) == 0u) { if (xb_ld(&(bar)[XB_TMO])) break; if (_sp > XB_SPIN_CAP) { atomicAdd(&(bar)[XB_TMO], 1u); break; } } } } while (0)

__device__ __forceinline__ int lane_id() { int r; asm volatile("v_mbcnt_lo_u32_b32 %0, -1, 0\n\tv_mbcnt_hi_u32_b32 %0, -1, %0" : "=v"(r)); return r; }
struct XcdBarrier {
    unsigned* bar; unsigned x;
    volatile LAS unsigned* st;
    bool lead;
};
__device__ __forceinline__ XcdBarrier xcd_barrier_post(unsigned* bar, volatile LAS unsigned* st, bool lead) {
    XcdBarrier b; b.bar = bar; b.x = xb_xcc_id(); b.st = st; b.lead = lead;
    if (lead && lane_id() == 0) (void)xb_add(&bar[XB_XCNT(b.x)], 1u);
    return b;
}
__device__ __forceinline__ void xcd_barrier_complete(unsigned* bar, unsigned x, unsigned& nloc, unsigned& nx) {
    const unsigned G = gridDim.x * gridDim.y * gridDim.z;
    unsigned sum, cnt, mine, sp = 0u;
    for (;;) {
        sum = 0u; cnt = 0u; mine = 0u;
#pragma unroll
        for (unsigned j = 0; j < 16; ++j) { const unsigned c = xb_ld(&bar[XB_XCNT(j)]); sum += c; cnt += (c > 0u) ? 1u : 0u; mine = (j == x) ? c : mine; }
        if (sum == G) break;
        __builtin_amdgcn_s_sleep(1);
        if ((++sp & 255u) == 0u) { if (xb_ld(&bar[XB_TMO])) break; if (sp > XB_SPIN_CAP) { atomicAdd(&bar[XB_TMO], 1u); break; } }
    }
    nloc = mine > 0u ? mine : 1u; nx = cnt > 0u ? cnt : 1u;
}
__device__ __forceinline__ void xcd_barrier(const XcdBarrier& b) {
    asm volatile("s_waitcnt vmcnt(0)" ::: "memory");
    __syncthreads();
    if (b.lead && lane_id() == 0) {
        unsigned* bar = b.bar;
        __builtin_amdgcn_s_waitcnt(0);
        unsigned nloc = b.st[0], nx = b.st[1];
        if (nloc == 0u) { xcd_barrier_complete(bar, b.x, nloc, nx); b.st[0] = nloc; b.st[1] = nx; }
        const unsigned old = xb_add(&bar[XB_XSUB(b.x)], 1u);
        const unsigned gen = old / nloc;
        if (old + 1u == (gen + 1u) * nloc) {
            __builtin_amdgcn_fence(__ATOMIC_RELEASE, "agent");
            asm volatile("s_waitcnt vmcnt(0)" ::: "memory");
            const unsigned og = xb_add(&bar[XB_TOP], 1u);
            const unsigned tg = og / nx;
            if (og + 1u == (tg + 1u) * nx) xb_add(&bar[XB_TOPGEN], 1u);
            else XB_SPIN(xb_ld(&bar[XB_TOPGEN]) == tg, bar);
            __builtin_amdgcn_fence(__ATOMIC_ACQUIRE, "agent");
            xb_add(&bar[XB_XGEN(b.x)], 1u);
            asm volatile("s_waitcnt vmcnt(0)" ::: "memory");
        } else {
            XB_SPIN(xb_ld(&bar[XB_XGEN(b.x)]) == gen, bar);
            __builtin_amdgcn_fence(__ATOMIC_ACQUIRE, "agent");
            asm volatile("s_waitcnt vmcnt(0)" ::: "memory");
        }
    }
    __syncthreads();
}

__device__ __forceinline__ unsigned cvt_pk_bf16(float lo, float hi) { unsigned r; asm volatile("v_cvt_pk_bf16_f32 %0, %1, %2" : "=v"(r) : "v"(lo), "v"(hi)); return r; }
__device__ __forceinline__ float bf_lo(unsigned w) { return __uint_as_float(w << 16); }
__device__ __forceinline__ float bf_hi(unsigned w) { return __uint_as_float(w & 0xffff0000u); }
__device__ __forceinline__ float shx(float v, int mask, int lane) { return __int_as_float(__builtin_amdgcn_ds_bpermute((lane ^ mask) << 2, __float_as_int(v))); }
__device__ __forceinline__ float wave_sum(float v, int lane) {
#pragma unroll
    for (int o = 1; o < 64; o <<= 1) v += shx(v, o, lane);
    return v;
}
__device__ __forceinline__ float wave_max(float v, int lane) {
#pragma unroll
    for (int o = 1; o < 64; o <<= 1) v = fmaxf(v, shx(v, o, lane));
    return v;
}
__device__ __forceinline__ float swap32_max(float m) { auto rr = __builtin_amdgcn_permlane32_swap(__float_as_uint(m), __float_as_uint(m), false, false); return fmaxf(__uint_as_float(rr[0]), __uint_as_float(rr[1])); }
__device__ __forceinline__ float swap32_sum(float m) { auto rr = __builtin_amdgcn_permlane32_swap(__float_as_uint(m), __float_as_uint(m), false, false); return __uint_as_float(rr[0]) + __uint_as_float(rr[1]); }

namespace pg8 {
constexpr int BM = 256, BK = 64, HALF = 128, HTB = HALF * BK * 2, STAGE_BYTES = 8 * HTB;
__host__ __device__ __forceinline__ int lds_byte(int r, int c) { const int st = (r >> 4) * 2 + (c >> 5), rr = r & 15, cc = c & 31, ob = rr * 64 + cc * 2; return st * 1024 + (ob ^ (((ob >> 9) & 1) << 5)); }
__host__ __device__ __forceinline__ void stage_rc(int b, int& R, int& C) { const int st = b / 1024, sb = b % 1024, swz = sb ^ (((sb >> 9) & 1) << 5); R = (st >> 1) * 16 + swz / 64; C = (st & 1) * 32 + (swz % 64) / 2; }
__host__ __device__ __forceinline__ int perm32(int rho) { const int n = rho >> 4, i = rho & 15; return 8 * (i >> 2) + 4 * n + (i & 3); }

struct Unit { int pm, pn, e, mt, cnt; };
struct Gemm { const bf16_t* A; const bf16_t* Bt; int K; size_t bstride; const int* list; };

template <class Epi, class Sched, bool GATHER>
__device__ __forceinline__ void gemm_phase(LAS unsigned char* lds, const Gemm g, const Sched& S, const Epi& E, const int tid) {
    const int wid = __builtin_amdgcn_readfirstlane(tid >> 6), lane = tid & 63, wr = wid >> 2, wc = wid & 3, fr = lane & 15, fq = lane >> 4;
    const int K = g.K, nt = K / BK;
    unsigned voffA[2], voffB[2];
    int gR[2], gC[2];
#pragma unroll
    for (int i = 0; i < 2; ++i) { int R, C; stage_rc(tid * 16 + i * 8192, R, C); const int Rb = Epi::PERM ? ((R & ~31) + perm32(R & 31)) : R;
        voffA[i] = (unsigned)(R * K + C) * 2u; voffB[i] = (unsigned)(Rb * K + C) * 2u; gR[i] = R; gC[i] = C; }
    const size_t kstep = (size_t)(BK * 2);
    const size_t hstep = (size_t)HALF * K * 2;
    const size_t tstep = 2 * hstep;
    const unsigned ldsw = (unsigned)wid * 1024u;
    const int aoff = lds_byte(wr * 64 + fr, fq * 8), boff = lds_byte(wc * 32 + fr, fq * 8);
#define PG8_SA(b, h) (((b) * 2 + (h)) * HTB)
#define PG8_SB(b, h) ((4 + (b) * 2 + (h)) * HTB)
#define PG8_STAGE(bufoff, gbase, voff) do { _Pragma("unroll") for (int _i = 0; _i < 2; ++_i) \
        __builtin_amdgcn_global_load_lds((const unsigned*)((const char*)(gbase) + (voff)[_i]), (LAS unsigned*)(lds + (bufoff) + ldsw + _i * 8192), 16, 0, 0); } while (0)
#define PG8_STAGE_A(bufoff, SELN, H, KOFF) do { if constexpr (GATHER) { unsigned _vo[2]; _vo[0] = (SELN) ? voN[H][0] : voC[H][0]; _vo[1] = (SELN) ? voN[H][1] : voC[H][1]; \
            PG8_STAGE(bufoff, (const char*)g.A + (KOFF), _vo); } else { PG8_STAGE(bufoff, ((SELN) ? nA : cA) + (H) * hstep + (KOFF), voffA); } } while (0)
#define PG8_LDA(dst, b, h) do { _Pragma("unroll") for (int m = 0; m < 4; ++m) _Pragma("unroll") for (int k = 0; k < 2; ++k) dst[m][k] = *(const LAS bf16x8*)(lds + PG8_SA(b, h) + aoff + m * 2048 + k * 1024); } while (0)
#define PG8_LDB(dst, b, h) do { _Pragma("unroll") for (int n = 0; n < 2; ++n) _Pragma("unroll") for (int k = 0; k < 2; ++k) dst[n][k] = *(const LAS bf16x8*)(lds + PG8_SB(b, h) + boff + n * 2048 + k * 1024); } while (0)
#define PG8_MMA(ai, bj, At, Bt) do { __builtin_amdgcn_s_setprio(1); _Pragma("unroll") for (int m = 0; m < 4; ++m) _Pragma("unroll") for (int n = 0; n < 2; ++n) _Pragma("unroll") for (int k = 0; k < 2; ++k) \
        acc[ai][bj][m][n] = __builtin_amdgcn_mfma_f32_16x16x32_bf16(Bt[n][k], At[m][k], acc[ai][bj][m][n], 0, 0, 0); __builtin_amdgcn_s_setprio(0); } while (0)
#define PG8_WAIT_V(n) asm volatile("s_waitcnt vmcnt(" #n ")" ::: "memory")
#define PG8_WAIT_L(n) asm volatile("s_waitcnt lgkmcnt(" #n ")" ::: "memory")
#define PG8_BAR __builtin_amdgcn_s_barrier()
#define PG8_SCHED __builtin_amdgcn_sched_barrier(0)
#define PG8_GATH(U, VO) do { _Pragma("unroll") for (int _h = 0; _h < 2; ++_h) _Pragma("unroll") for (int _i = 0; _i < 2; ++_i) { \
        int _r = (U).mt * 256 + _h * 128 + gR[_i]; _r = _r < (U).cnt ? _r : 0; const int _tok = g.list[(size_t)(U).e * NT + _r]; VO[_h][_i] = (unsigned)(_tok * K + gC[_i]) * 2u; } } while (0)
    Unit cur, nxt; int ui = 0;
    if (!S.next(0, cur)) return;
    f32x4 acc[2][2][4][2];
#pragma unroll
    for (int a = 0; a < 2; ++a)
#pragma unroll
        for (int b = 0; b < 2; ++b)
#pragma unroll
            for (int m = 0; m < 4; ++m)
#pragma unroll
                for (int n = 0; n < 2; ++n) acc[a][b][m][n] = (f32x4){0.f, 0.f, 0.f, 0.f};
    bf16x8 At[4][2], B0[2][2], B1[2][2];
    unsigned voC[2][2] = {{0u, 0u}, {0u, 0u}}, voN[2][2] = {{0u, 0u}, {0u, 0u}};
    if constexpr (GATHER) { PG8_GATH(cur, voC); }
    const char* cA = GATHER ? (const char*)g.A : (const char*)g.A + (size_t)cur.pm * tstep;
    const char* cB = (const char*)g.Bt + ((size_t)cur.e * g.bstride) * 2 + (size_t)cur.pn * tstep;
    const char* nA = cA; const char* nB = cB;
    PG8_STAGE(PG8_SB(0, 0), cB, voffB); PG8_STAGE(PG8_SB(0, 1), cB + hstep, voffB); PG8_STAGE_A(PG8_SA(0, 0), false, 0, 0); PG8_STAGE_A(PG8_SA(0, 1), false, 1, 0);
    if (wr == 1) PG8_BAR;
    PG8_WAIT_V(2); PG8_BAR;
    PG8_STAGE(PG8_SB(1, 0), cB + kstep, voffB); PG8_STAGE_A(PG8_SA(1, 0), false, 0, kstep); PG8_STAGE(PG8_SB(1, 1), cB + hstep + kstep, voffB);
    PG8_WAIT_V(6); PG8_BAR;
    for (;;) {
        const bool has_next = S.next(ui + 1, nxt);
        nA = GATHER ? (const char*)g.A : (has_next ? (const char*)g.A + (size_t)nxt.pm * tstep : cA);
        nB = has_next ? (const char*)g.Bt + ((size_t)nxt.e * g.bstride) * 2 + (size_t)nxt.pn * tstep : cB;
        if constexpr (GATHER) { if (has_next) { PG8_GATH(nxt, voN); } else {
#pragma unroll
            for (int _h = 0; _h < 2; ++_h) { voN[_h][0] = voC[_h][0]; voN[_h][1] = voC[_h][1]; } }
            asm volatile("" : "+v"(voN[0][0]), "+v"(voN[0][1]), "+v"(voN[1][0]), "+v"(voN[1][1])); }
        for (int t = 0; t < nt; t += 2) {
            const bool last = (t == nt - 2);
            const size_t k1 = (size_t)(t + 1) * kstep;
            const size_t k2 = last ? 0 : (size_t)(t + 2) * kstep;
            const size_t k3 = k2 + kstep;
            const char* b2 = (last ? nB : cB) + k2; const char* b3 = b2 + kstep;
            PG8_LDB(B0, 0, 0); PG8_LDB(B1, 0, 1); PG8_SCHED; PG8_LDA(At, 0, 0); PG8_STAGE_A(PG8_SA(1, 1), false, 1, k1);
            PG8_WAIT_V(8); PG8_WAIT_L(0); PG8_BAR; PG8_MMA(0, 0, At, B0); PG8_MMA(0, 1, At, B1); PG8_BAR; PG8_SCHED;
            PG8_LDA(At, 0, 1); PG8_STAGE(PG8_SB(0, 0), b2, voffB); PG8_STAGE(PG8_SB(0, 1), b2 + hstep, voffB); PG8_STAGE_A(PG8_SA(0, 0), last, 0, k2);
            PG8_WAIT_V(8); PG8_WAIT_L(0); PG8_BAR; PG8_MMA(1, 0, At, B0); PG8_MMA(1, 1, At, B1); PG8_BAR; PG8_SCHED;
            PG8_LDB(B0, 1, 0); PG8_LDB(B1, 1, 1); PG8_SCHED; PG8_LDA(At, 1, 0); PG8_STAGE_A(PG8_SA(0, 1), last, 1, k2);
            PG8_WAIT_V(8); PG8_WAIT_L(0); PG8_BAR; PG8_MMA(0, 0, At, B0); PG8_MMA(0, 1, At, B1); PG8_BAR; PG8_SCHED;
            PG8_LDA(At, 1, 1); PG8_STAGE(PG8_SB(1, 0), b3, voffB); PG8_STAGE(PG8_SB(1, 1), b3 + hstep, voffB); PG8_STAGE_A(PG8_SA(1, 0), last, 0, k3);
            PG8_WAIT_V(8); PG8_WAIT_L(0); PG8_BAR; PG8_MMA(1, 0, At, B0); PG8_MMA(1, 1, At, B1); PG8_BAR; PG8_SCHED;
        }
        if (wr == 0) PG8_BAR;
        E(acc, cur, wr, wc, fr, fq);
        if (!has_next) break;
#pragma unroll
        for (int a = 0; a < 2; ++a)
#pragma unroll
            for (int b = 0; b < 2; ++b)
#pragma unroll
                for (int m = 0; m < 4; ++m)
#pragma unroll
                    for (int n = 0; n < 2; ++n) acc[a][b][m][n] = (f32x4){0.f, 0.f, 0.f, 0.f};
        cur = nxt; cA = nA; cB = nB; ++ui;
        if constexpr (GATHER) {
#pragma unroll
            for (int _h = 0; _h < 2; ++_h) { voC[_h][0] = voN[_h][0]; voC[_h][1] = voN[_h][1]; } }
        if (wr == 1) PG8_BAR;
    }
    PG8_WAIT_V(0);
    PG8_BAR;
#undef PG8_SA
#undef PG8_SB
#undef PG8_STAGE
#undef PG8_STAGE_A
#undef PG8_LDA
#undef PG8_LDB
#undef PG8_MMA
#undef PG8_WAIT_V
#undef PG8_WAIT_L
#undef PG8_BAR
#undef PG8_SCHED
#undef PG8_GATH
}
}

namespace pg8 {
struct EpiBf16Plain {
    static constexpr bool PERM = true;
    bf16_t* O; int ldc;
    __device__ __forceinline__ void operator()(const f32x4 (&acc)[2][2][4][2], const Unit& u, int wr, int wc, int fr, int fq) const {
        const int row0 = u.pm * BM + wr * 64 + fr, col0 = u.pn * BM + wc * 32 + 8 * fq;
#pragma unroll
        for (int ai = 0; ai < 2; ++ai)
#pragma unroll
            for (int m = 0; m < 4; ++m) { bf16_t* rowp = O + (size_t)(row0 + ai * HALF + m * 16) * ldc + col0;
#pragma unroll
                for (int bj = 0; bj < 2; ++bj) { const f32x4 v0 = acc[ai][bj][m][0], v1 = acc[ai][bj][m][1];
                    u32x4 w; w.x = cvt_pk_bf16(v0[0], v0[1]); w.y = cvt_pk_bf16(v0[2], v0[3]); w.z = cvt_pk_bf16(v1[0], v1[1]); w.w = cvt_pk_bf16(v1[2], v1[3]);
                    *(u32x4*)(rowp + bj * HALF) = w; } }
    }
};
struct EpiF32Plain {
    static constexpr bool PERM = false;
    float* C; int ldc;
    __device__ __forceinline__ void operator()(const f32x4 (&acc)[2][2][4][2], const Unit& u, int wr, int wc, int fr, int fq) const {
        const int row0 = u.pm * BM + wr * 64 + fr, col0 = u.pn * BM + wc * 32 + 4 * fq;
#pragma unroll
        for (int ai = 0; ai < 2; ++ai)
#pragma unroll
            for (int m = 0; m < 4; ++m) { float* rowp = C + (size_t)(row0 + ai * HALF + m * 16) * ldc + col0;
#pragma unroll
                for (int bj = 0; bj < 2; ++bj)
#pragma unroll
                    for (int n = 0; n < 2; ++n) *(f32x4*)(rowp + bj * HALF + n * 16) = acc[ai][bj][m][n]; }
    }
};
__device__ __forceinline__ void rope8(f32x4& v0, f32x4& v1, const float* cs) {
    const f32x4 a = *(const f32x4*)cs, b = *(const f32x4*)(cs + 4);
    const float x0 = v0[0], x1 = v0[1], x2 = v0[2], x3 = v0[3], y0 = v1[0], y1 = v1[1], y2 = v1[2], y3 = v1[3];
    v0[0] = x0 * a[0] - x1 * a[1]; v0[1] = x0 * a[1] + x1 * a[0];
    v0[2] = x2 * a[2] - x3 * a[3]; v0[3] = x2 * a[3] + x3 * a[2];
    v1[0] = y0 * b[0] - y1 * b[1]; v1[1] = y0 * b[1] + y1 * b[0];
    v1[2] = y2 * b[2] - y3 * b[3]; v1[3] = y2 * b[3] + y3 * b[2];
}
struct EpiQkvA {
    static constexpr bool PERM = true;
    bf16_t* O; const float* rope;
    __device__ __forceinline__ void operator()(const f32x4 (&acc)[2][2][4][2], const Unit& u, int wr, int wc, int fr, int fq) const {
        const int row0 = u.pm * BM + wr * 64 + fr, col0 = u.pn * BM + wc * 32 + 8 * fq;
        const bool do_rope = (u.pm < NL / 256) && (u.pn < 5);
#pragma unroll
        for (int ai = 0; ai < 2; ++ai)
#pragma unroll
            for (int m = 0; m < 4; ++m) { const int row = row0 + ai * HALF + m * 16; bf16_t* rowp = O + (size_t)row * A_IN + col0;
#pragma unroll
                for (int bj = 0; bj < 2; ++bj) { f32x4 v0 = acc[ai][bj][m][0], v1 = acc[ai][bj][m][1];
                    if (do_rope) { const int d = (col0 + bj * HALF) & 63; rope8(v0, v1, rope + ((size_t)(row & (SEQ - 1)) * 32 + (d >> 1)) * 2); }
                    u32x4 w; w.x = cvt_pk_bf16(v0[0], v0[1]); w.y = cvt_pk_bf16(v0[2], v0[3]); w.z = cvt_pk_bf16(v1[0], v1[1]); w.w = cvt_pk_bf16(v1[2], v1[3]);
                    *(u32x4*)(rowp + bj * HALF) = w; }
                asm volatile("" ::: "memory"); }
    }
};
struct EpiMlaUp {
    static constexpr bool PERM = true;
    bf16_t* O; const float* rope;
    __device__ __forceinline__ void operator()(const f32x4 (&acc)[2][2][4][2], const Unit& u, int wr, int wc, int fr, int fq) const {
        const int row0 = u.pm * BM + wr * 64 + fr, col0 = u.pn * BM + wc * 32 + 8 * fq;
        const bool qtile = (u.pm < NL / 256) && (u.pn < 6);
#pragma unroll
        for (int ai = 0; ai < 2; ++ai)
#pragma unroll
            for (int m = 0; m < 4; ++m) { const int row = row0 + ai * HALF + m * 16; bf16_t* rowp = O + (size_t)row * C_UPN + col0;
#pragma unroll
                for (int bj = 0; bj < 2; ++bj) { f32x4 v0 = acc[ai][bj][m][0], v1 = acc[ai][bj][m][1];
                    const int d96 = (col0 + bj * HALF) % 96;
                    if (qtile && d96 >= 64) rope8(v0, v1, rope + ((size_t)(row & (SEQ - 1)) * 16 + ((d96 - 64) >> 1)) * 2);
                    u32x4 w; w.x = cvt_pk_bf16(v0[0], v0[1]); w.y = cvt_pk_bf16(v0[2], v0[3]); w.z = cvt_pk_bf16(v1[0], v1[1]); w.w = cvt_pk_bf16(v1[2], v1[3]);
                    *(u32x4*)(rowp + bj * HALF) = w; }
                asm volatile("" ::: "memory"); }
    }
};
struct EpiResid {
    static constexpr bool PERM = false;
    float* XS; const float* gmod;
    __device__ __forceinline__ void operator()(const f32x4 (&acc)[2][2][4][2], const Unit& u, int wr, int wc, int fr, int fq) const {
        const int row0 = u.pm * BM + wr * 64 + fr, col0 = u.pn * BM + wc * 32 + 4 * fq;
        const int rb = u.pm < NL / 256 ? (u.pm >> 3) : 8;
        const float* gv = gmod + (size_t)rb * 6144 + col0;
        f32x4 gg[2][2];
#pragma unroll
        for (int bj = 0; bj < 2; ++bj)
#pragma unroll
            for (int n = 0; n < 2; ++n) gg[bj][n] = *(const f32x4*)(gv + bj * HALF + n * 16);
#pragma unroll
        for (int ai = 0; ai < 2; ++ai)
#pragma unroll
            for (int m = 0; m < 4; ++m) { float* rowp = XS + (size_t)(row0 + ai * HALF + m * 16) * D + col0;
#pragma unroll
                for (int bj = 0; bj < 2; ++bj)
#pragma unroll
                    for (int n = 0; n < 2; ++n) { f32x4* p = (f32x4*)(rowp + bj * HALF + n * 16); *p = *p + gg[bj][n] * acc[ai][bj][m][n]; } }
    }
};
struct EpiSwiglu {
    static constexpr bool PERM = true;
    bf16_t* ACT; const float* bg; const float* bu;
    __device__ __forceinline__ void operator()(const f32x4 (&acc)[2][2][4][2], const Unit& u, int wr, int wc, int fr, int fq) const {
        const int row0 = u.pm * BM + wr * 64 + fr, col0 = u.pn * HALF + wc * 32 + 8 * fq;
        const float* pg = bg + (size_t)u.e * D + col0; const float* pu = bu + (size_t)u.e * D + col0;
        const f32x4 g0 = *(const f32x4*)pg, g1 = *(const f32x4*)(pg + 4), u0 = *(const f32x4*)pu, u1 = *(const f32x4*)(pu + 4);
#pragma unroll
        for (int ai = 0; ai < 2; ++ai)
#pragma unroll
            for (int m = 0; m < 4; ++m) { bf16_t* rowp = ACT + (size_t)(row0 + ai * HALF + m * 16) * D + col0;
                float r[8];
#pragma unroll
                for (int n = 0; n < 2; ++n)
#pragma unroll
                    for (int j = 0; j < 4; ++j) {
                        float g = acc[ai][0][m][n][j] + (n ? g1[j] : g0[j]); float uu = acc[ai][1][m][n][j] + (n ? u1[j] : u0[j]);
                        g = fminf(g, 7.0f); uu = fminf(fmaxf(uu, -7.0f), 7.0f);
                        const float sg = __builtin_amdgcn_rcpf(1.0f + __builtin_amdgcn_exp2f(-1.702f * LOG2E * g));
                        r[n * 4 + j] = g * sg * (uu + 1.0f); }
                u32x4 w; w.x = cvt_pk_bf16(r[0], r[1]); w.y = cvt_pk_bf16(r[2], r[3]); w.z = cvt_pk_bf16(r[4], r[5]); w.w = cvt_pk_bf16(r[6], r[7]);
                *(u32x4*)rowp = w; }
    }
};
struct EpiDown {
    static constexpr bool PERM = true;
    bf16_t* YS; const float* bd;
    __device__ __forceinline__ void operator()(const f32x4 (&acc)[2][2][4][2], const Unit& u, int wr, int wc, int fr, int fq) const {
        const int row0 = u.pm * BM + wr * 64 + fr, col0 = u.pn * BM + wc * 32 + 8 * fq;
        const float* pb = bd + (size_t)u.e * D + col0;
        f32x4 bv[2][2];
#pragma unroll
        for (int bj = 0; bj < 2; ++bj)
#pragma unroll
            for (int n = 0; n < 2; ++n) bv[bj][n] = *(const f32x4*)(pb + bj * HALF + 4 * n);
#pragma unroll
        for (int ai = 0; ai < 2; ++ai)
#pragma unroll
            for (int m = 0; m < 4; ++m) { bf16_t* rowp = YS + (size_t)(row0 + ai * HALF + m * 16) * D + col0;
#pragma unroll
                for (int bj = 0; bj < 2; ++bj) { const f32x4 v0 = acc[ai][bj][m][0] + bv[bj][0], v1 = acc[ai][bj][m][1] + bv[bj][1];
                    u32x4 w; w.x = cvt_pk_bf16(v0[0], v0[1]); w.y = cvt_pk_bf16(v0[2], v0[3]); w.z = cvt_pk_bf16(v1[0], v1[1]); w.w = cvt_pk_bf16(v1[2], v1[3]);
                    *(u32x4*)(rowp + bj * HALF) = w; } }
    }
};

struct DenseOrder {
    int nM, nN, vcu, xM, xN0, xNn;
    __device__ __forceinline__ bool next(int i, Unit& u) const {
        int L = i * 256 + vcu; const int nmain = nM * nN;
        if (L < nmain) { const int nig = 8 * nN, gid = L / nig, fm = gid * 8, rem = nM - fm, gsz = rem < 8 ? rem : 8, w = L % nig; u.pm = fm + w % gsz; u.pn = w / gsz; }
        else { L -= nmain; if (L >= xM * xNn) return false; u.pm = nM + L % xM; u.pn = xN0 + L / xM; }
        u.e = 0; u.mt = 0; u.cnt = 0; return true;
    }
};
struct MoeOrder {
    const LAS int* ecnt; const LAS int* lbase; const LAS int* cumt; int nN, vcu;
    __device__ __forceinline__ bool next(int i, Unit& u) const {
        const int L = i * 256 + vcu;
        if (L >= cumt[32] * nN) return false;
        int e = 0;
        while (cumt[e + 1] * nN <= L) ++e;
        e = __builtin_amdgcn_readfirstlane(e);
        const int r = L - cumt[e] * nN, c = ecnt[e], mte = (c + 255) >> 8;
        u.e = e; u.pn = r / mte; u.mt = r % mte; u.pm = (lbase[e] >> 8) + u.mt; u.cnt = c; return true;
    }
};
}

namespace att {
constexpr int VSTR = 144;
template <int DQK> struct Cfg { static constexpr int KSTR = DQK * 2 + 16, KB = 64 * KSTR, VB = 64 * VSTR, STAGE = KB + VB, CPR = DQK / 8, NKS = DQK / 16; };
__device__ __forceinline__ int crow(int r, int hi) { return (r & 3) + 8 * (r >> 2) + 4 * hi; }

template <int DQK, bool MLA>
__device__ __forceinline__ void fetch(u32x4 (&r)[3], const bf16_t* Kb, const bf16_t* Vb, const bf16_t* KRb, int pitch, int row0, int tid) {
    typedef Cfg<DQK> C;
    { const int key = tid / C::CPR, ch = tid % C::CPR;
      const bf16_t* src = (MLA && ch >= 8) ? KRb + (size_t)(row0 + key) * 32 + (ch - 8) * 8 : Kb + (size_t)(row0 + key) * pitch + ch * 8;
      r[0] = *(const u32x4*)src; }
    if constexpr (DQK == 96) { if (tid < 256) { const int c = 512 + tid, key = c / C::CPR, ch = c % C::CPR;
      const bf16_t* src = (MLA && ch >= 8) ? KRb + (size_t)(row0 + key) * 32 + (ch - 8) * 8 : Kb + (size_t)(row0 + key) * pitch + ch * 8;
      r[1] = *(const u32x4*)src; } }
    { const int key = tid >> 3, ch = tid & 7; r[2] = *(const u32x4*)(Vb + (size_t)(row0 + key) * pitch + ch * 8); }
}
template <int DQK>
__device__ __forceinline__ void stash(LAS unsigned char* st, const u32x4 (&r)[3], int tid) {
    typedef Cfg<DQK> C;
    { const int key = tid / C::CPR, ch = tid % C::CPR; *(LAS u32x4*)(st + key * C::KSTR + ch * 16) = r[0]; }
    if constexpr (DQK == 96) { if (tid < 256) { const int c = 512 + tid, key = c / C::CPR, ch = c % C::CPR; *(LAS u32x4*)(st + key * C::KSTR + ch * 16) = r[1]; } }
    { const int key = tid >> 3, ch = tid & 7; *(LAS u32x4*)(st + C::KB + key * VSTR + ch * 16) = r[2]; }
}
template <int DQK>
__device__ __forceinline__ f32x16 qk(const LAS unsigned char* kst, int koff, const bf16x8 (&qr)[DQK / 16], int r32, int hi) {
    typedef Cfg<DQK> C;
    f32x16 p;
#pragma unroll
    for (int r = 0; r < 16; ++r) p[r] = 0.f;
    const LAS unsigned char* kb = kst + (koff + r32) * C::KSTR + hi * 16;
#pragma unroll
    for (int ks = 0; ks < C::NKS; ++ks) { const bf16x8 kf = *(const LAS bf16x8*)(kb + ks * 32); p = __builtin_amdgcn_mfma_f32_32x32x16_bf16(kf, qr[ks], p, 0, 0, 0); }
    return p;
}
__device__ __forceinline__ s16x4 vtr(const LAS unsigned char* p) { return __builtin_bit_cast(s16x4, __builtin_amdgcn_ds_read_tr16_b64_v4i16((LAS s16x4*)p)); }
template <int NS>
__device__ __forceinline__ void sm_pv(f32x16 (&t)[NS], const LAS unsigned char* vst, const int (&voff)[NS], f32x16 (&o)[2], float& m, float& l, int lane) {
    const int hi = lane >> 5;
    float mx = t[0][0];
#pragma unroll
    for (int s = 0; s < NS; ++s)
#pragma unroll
        for (int r = 0; r < 16; ++r) mx = fmaxf(mx, t[s][r]);
    mx = swap32_max(mx);
    if (__any(mx > m + 8.0f)) { const float mn = fmaxf(m, mx); const float a = __builtin_amdgcn_exp2f(m - mn); m = mn; l *= a;
#pragma unroll
        for (int r = 0; r < 16; ++r) { o[0][r] *= a; o[1][r] *= a; } }
    float rs = 0.f;
#pragma unroll
    for (int s = 0; s < NS; ++s)
#pragma unroll
        for (int r = 0; r < 16; ++r) { t[s][r] = __builtin_amdgcn_exp2f(t[s][r] - m); rs += t[s][r]; }
    l += rs;
    const int q4 = (lane & 15) >> 2, p4 = lane & 3, blk = (lane >> 4) & 1;
#pragma unroll
    for (int s = 0; s < NS; ++s) {
        const LAS unsigned char* vb = vst + (voff[s] + 4 * hi + q4) * VSTR + (16 * blk + 4 * p4) * 2;
#pragma unroll
        for (int kk = 0; kk < 2; ++kk) {
            u32x4 pw; pw.x = cvt_pk_bf16(t[s][8 * kk + 0], t[s][8 * kk + 1]); pw.y = cvt_pk_bf16(t[s][8 * kk + 2], t[s][8 * kk + 3]);
            pw.z = cvt_pk_bf16(t[s][8 * kk + 4], t[s][8 * kk + 5]); pw.w = cvt_pk_bf16(t[s][8 * kk + 6], t[s][8 * kk + 7]);
            const bf16x8 pb = __builtin_bit_cast(bf16x8, pw);
#pragma unroll
            for (int c = 0; c < 2; ++c) {
                const s16x4 lo = vtr(vb + (16 * kk) * VSTR + c * 64), h8 = vtr(vb + (16 * kk + 8) * VSTR + c * 64);
                const bf16x8 va = (bf16x8){lo[0], lo[1], lo[2], lo[3], h8[0], h8[1], h8[2], h8[3]};
                o[c] = __builtin_amdgcn_mfma_f32_32x32x16_bf16(va, pb, o[c], 0, 0, 0);
            }
        }
    }
}
__device__ __forceinline__ void finalize(const f32x16 (&o)[2], float l, bf16_t* orow, int hi) {
    l = swap32_sum(l); const float inv = 1.0f / l;
#pragma unroll
    for (int c = 0; c < 2; ++c)
#pragma unroll
        for (int g = 0; g < 4; ++g) { u32x2 w; w.x = cvt_pk_bf16(o[c][4 * g] * inv, o[c][4 * g + 1] * inv); w.y = cvt_pk_bf16(o[c][4 * g + 2] * inv, o[c][4 * g + 3] * inv);
            *(u32x2*)(orow + 32 * c + 8 * g + 4 * hi) = w; }
}
#define ATT_PIPE_BEGIN(DQK, MLA, ROW0_OF) \
    u32x4 pre[3]; pre[1] = (u32x4){0u, 0u, 0u, 0u}; \
    fetch<DQK, MLA>(pre, Kb, Vb, KRb, pitch, ROW0_OF(0), tid); stash<DQK>(lds, pre, tid); __syncthreads(); \
    for (int i = 0; i < ntiles; ++i) { \
        if (i + 1 < ntiles) fetch<DQK, MLA>(pre, Kb, Vb, KRb, pitch, ROW0_OF(i + 1), tid); \
        const LAS unsigned char* kst = lds + (i & 1) * Cfg<DQK>::STAGE; const LAS unsigned char* vst = kst + Cfg<DQK>::KB;
#define ATT_PIPE_END(DQK) \
        if (i + 1 < ntiles) stash<DQK>(lds + ((i + 1) & 1) * Cfg<DQK>::STAGE, pre, tid); \
        __syncthreads(); }

__device__ __forceinline__ void attn_A_unit(LAS unsigned char* lds, const bf16_t* QKV, bf16_t* O, const float* sink, int b, int kvh, int qb, bool ctxq, int tid) {
    const int lane = tid & 63, wid = __builtin_amdgcn_readfirstlane(tid >> 6), r32 = lane & 31, hi = lane >> 5;
    const int head = kvh * 4 + (wid >> 1), qoff = 32 * (wid & 1) + r32, t0 = qb * 64;
    const int qrow = ctxq ? NL + b * CTXL + t0 + qoff : b * SEQ + t0 + qoff;
    bf16x8 qr[4];
    { const bf16_t* qp = QKV + (size_t)qrow * A_IN + head * 64 + hi * 8;
#pragma unroll
      for (int ks = 0; ks < 4; ++ks) qr[ks] = *(const bf16x8*)(qp + ks * 16); }
    int jlo = 0, nloc = 0;
    if (!ctxq) { jlo = t0 >= 128 ? 0 : (t0 == 64 ? 1 : 2); int jhi = (2112 - t0) / 64; jhi = jhi > 4 ? 4 : jhi; nloc = jhi - jlo + 1; }
    const int ntiles = 4 + nloc, cbase = NL + b * CTXL, lbase = b * SEQ + t0 - 128 + 64 * jlo;
    const bf16_t* Kb = QKV + 1024 + kvh * 64; const bf16_t* Vb = QKV + 1280 + kvh * 64; const bf16_t* KRb = nullptr; const int pitch = A_IN;
    float m = sink[head] * LOG2E, l = hi ? 0.f : 1.f;
    f32x16 o[2];
#pragma unroll
    for (int r = 0; r < 16; ++r) { o[0][r] = 0.f; o[1][r] = 0.f; }
    const float sc = 0.125f * LOG2E;
#define A_ROW0(i) ((i) < 4 ? cbase + 64 * (i) : lbase + 64 * ((i) - 4))
    ATT_PIPE_BEGIN(64, false, A_ROW0)
        f32x16 t[2];
        t[0] = qk<64>(kst, 0, qr, r32, hi); t[1] = qk<64>(kst, 32, qr, r32, hi);
        const int j = i < 4 ? 2 : jlo + i - 4;
#pragma unroll
        for (int s = 0; s < 2; ++s)
#pragma unroll
            for (int r = 0; r < 16; ++r) { const int kk = 32 * s + crow(r, hi); float v = t[s][r] * sc;
                if (j == 0 && kk < qoff) v = -1e30f;
                if (j == 4 && kk > qoff) v = -1e30f;
                t[s][r] = v; }
        const int voff[2] = {0, 32};
        sm_pv<2>(t, vst, voff, o, m, l, lane);
    ATT_PIPE_END(64)
#undef A_ROW0
    finalize(o, l, O + (size_t)qrow * D + head * 64, hi);
}

__device__ __forceinline__ void attn_B_unit(LAS unsigned char* lds, LAS float* tab, const bf16_t* QKV, bf16_t* O, const float* rpb, int b, int h, int rq, bool ctxq, int tid) {
    const int lane = tid & 63, wid = __builtin_amdgcn_readfirstlane(tid >> 6), r32 = lane & 31, hi = lane >> 5;
    const int jb = wid & 3, rp = wid >> 2;
    const int rqa = 4 * rq + 2 * rp + (r32 >> 4), qcol = 16 * jb + (r32 & 15);
    const int qrow = ctxq ? NL + b * CTXL + 32 * wid + r32 : b * SEQ + rqa * 64 + qcol;
    for (int idx = tid; idx < 15 * 31; idx += 512) tab[(idx / 31) * 32 + idx % 31] = rpb[h * 465 + idx] * LOG2E;
    bf16x8 qr[4];
    { const bf16_t* qp = QKV + (size_t)qrow * B_IN + h * 64 + hi * 8;
#pragma unroll
      for (int ks = 0; ks < 4; ++ks) qr[ks] = *(const bf16x8*)(qp + ks * 16); }
    int klo = 0, nloc = 0;
    if (!ctxq) { klo = 4 * rq - 4; klo = klo < 0 ? 0 : (klo > 24 ? 24 : klo); int khi = 4 * rq - 1; khi = khi < 0 ? 0 : (khi > 24 ? 24 : khi); khi += 7; nloc = khi - klo + 1; }
    const int ntiles = 4 + nloc, cbase = NL + b * CTXL, lbase = b * SEQ;
    int r0q = rqa - 4; r0q = r0q < 0 ? 0 : (r0q > 24 ? 24 : r0q);
    int wst = qcol - 8; wst = wst < 0 ? 0 : (wst > 48 ? 48 : wst);
    int cst = 16 * jb - 8; cst = cst < 0 ? 0 : (cst > 32 ? 32 : cst);
    const int lo = wst - cst;
    int wr0 = 4 * rq + 2 * rp - 4; wr0 = wr0 < 0 ? 0 : (wr0 > 24 ? 24 : wr0);
    int wr1 = 4 * rq + 2 * rp + 1 - 4; wr1 = wr1 < 0 ? 0 : (wr1 > 24 ? 24 : wr1); wr1 += 7;
    const bf16_t* Kb = QKV + 1024 + h * 64; const bf16_t* Vb = QKV + 2048 + h * 64; const bf16_t* KRb = nullptr; const int pitch = B_IN;
    float m = -1e30f, l = 0.f;
    f32x16 o[2];
#pragma unroll
    for (int r = 0; r < 16; ++r) { o[0][r] = 0.f; o[1][r] = 0.f; }
    const float sc = 0.125f * LOG2E;
#define B_ROW0(i) ((i) < 4 ? cbase + 64 * (i) : lbase + 64 * (klo + (i) - 4))
    ATT_PIPE_BEGIN(64, false, B_ROW0)
        if (i < 4) {
            f32x16 t[2];
            t[0] = qk<64>(kst, 0, qr, r32, hi); t[1] = qk<64>(kst, 32, qr, r32, hi);
#pragma unroll
            for (int s = 0; s < 2; ++s)
#pragma unroll
                for (int r = 0; r < 16; ++r) t[s][r] *= sc;
            const int voff[2] = {0, 32};
            sm_pv<2>(t, vst, voff, o, m, l, lane);
        } else {
            const int kr = klo + i - 4;
            if (kr >= wr0 && kr <= wr1) {
                f32x16 t[1];
                t[0] = qk<64>(kst, cst, qr, r32, hi);
                const bool rowok = (kr >= r0q) && (kr < r0q + 8);
                const int bidx0 = (kr - rqa + 7) * 32 + cst - qcol + 15;
#pragma unroll
                for (int r = 0; r < 16; ++r) { const int kidx = crow(r, hi); const bool ok = rowok && ((unsigned)(kidx - lo) < 16u);
                    int bi = bidx0 + kidx; bi = bi < 0 ? 0 : (bi > 479 ? 479 : bi);
                    const float bias = tab[bi];
                    t[0][r] = ok ? t[0][r] * sc + bias : -1e30f; }
                const int voff[1] = {cst};
                sm_pv<1>(t, vst, voff, o, m, l, lane);
            }
        }
    ATT_PIPE_END(64)
#undef B_ROW0
    finalize(o, l, O + (size_t)qrow * D + h * 64, hi);
}

__device__ __forceinline__ void attn_C_unit(LAS unsigned char* lds, const bf16_t* Q2, const bf16_t* KR, bf16_t* O, int b, int h, int qb, bool ctxq, int tid) {
    const int lane = tid & 63, wid = __builtin_amdgcn_readfirstlane(tid >> 6), r32 = lane & 31, hi = lane >> 5;
    const int qrow = ctxq ? NL + b * CTXL + 32 * wid + r32 : b * SEQ + qb * 256 + 32 * wid + r32;
    bf16x8 qr[6];
    { const bf16_t* qp = Q2 + (size_t)qrow * C_UPN + h * 96 + hi * 8;
#pragma unroll
      for (int ks = 0; ks < 6; ++ks) qr[ks] = *(const bf16x8*)(qp + ks * 16); }
    const int ntiles = ctxq ? 4 : 36, cbase = NL + b * CTXL, lbase = b * SEQ;
    const bf16_t* Kb = Q2 + 1536 + h * 128; const bf16_t* Vb = Kb + 64; const bf16_t* KRb = KR; const int pitch = C_UPN;
    float m = -1e30f, l = 0.f;
    f32x16 o[2];
#pragma unroll
    for (int r = 0; r < 16; ++r) { o[0][r] = 0.f; o[1][r] = 0.f; }
    const float sc = 0.10206207261596575f * LOG2E;
#define C_ROW0(i) ((i) < 4 ? cbase + 64 * (i) : lbase + 64 * ((i) - 4))
    ATT_PIPE_BEGIN(96, true, C_ROW0)
        f32x16 t[2];
        t[0] = qk<96>(kst, 0, qr, r32, hi); t[1] = qk<96>(kst, 32, qr, r32, hi);
#pragma unroll
        for (int s = 0; s < 2; ++s)
#pragma unroll
            for (int r = 0; r < 16; ++r) t[s][r] *= sc;
        const int voff[2] = {0, 32};
        sm_pv<2>(t, vst, voff, o, m, l, lane);
    ATT_PIPE_END(96)
#undef C_ROW0
    finalize(o, l, O + (size_t)qrow * D + h * 64, hi);
}
}

struct Row4 { f32x4 v[4]; };
__device__ __forceinline__ void row_load(Row4& x, const float* p, int lane) {
#pragma unroll
    for (int j = 0; j < 4; ++j) x.v[j] = *(const f32x4*)(p + 4 * lane + 256 * j);
}
__device__ __forceinline__ void row_store(const Row4& x, float* p, int lane) {
#pragma unroll
    for (int j = 0; j < 4; ++j) *(f32x4*)(p + 4 * lane + 256 * j) = x.v[j];
}
__device__ __forceinline__ float row_rstd(const Row4& x, int lane) {
    float s = 0.f;
#pragma unroll
    for (int j = 0; j < 4; ++j) s += (x.v[j][0] * x.v[j][0] + x.v[j][1] * x.v[j][1]) + (x.v[j][2] * x.v[j][2] + x.v[j][3] * x.v[j][3]);
    s = wave_sum(s, lane);
    return 1.0f / sqrtf(s * (1.0f / D) + NORM_EPS);
}
__device__ __forceinline__ void norm_mod(const Row4& x, float rstd, const float* g, const float* sh, const float* sc, bf16_t* out, int lane, Row4& hv) {
#pragma unroll
    for (int j = 0; j < 4; ++j) { const int c = 4 * lane + 256 * j;
        const f32x4 gg = *(const f32x4*)(g + c), s1 = *(const f32x4*)(sc + c), s0 = *(const f32x4*)(sh + c);
        const f32x4 h = (x.v[j] * rstd * gg) * (s1 + 1.0f) + s0; hv.v[j] = h;
        u32x2 w; w.x = cvt_pk_bf16(h[0], h[1]); w.y = cvt_pk_bf16(h[2], h[3]); *(u32x2*)(out + c) = w; }
}

struct Ptrs {
    const float* in[29]; float* out; unsigned char* ws;
};
typedef const __attribute__((address_space(4))) Ptrs* PK;
#define WSP(T, off) ((T*)(P->ws + (off)))

__device__ __forceinline__ void phase_first_norm(PK P, int gw, int lane) {
    const float* MOD = WSP(const float, WS_MOD);
    for (int r = gw; r < NT; r += 2048) {
        const float* src = r < NL ? P->in[0] + (size_t)r * D : P->in[2] + (size_t)(r - NL) * D;
        Row4 x, hv; row_load(x, src, lane); row_store(x, WSP(float, WS_XS) + (size_t)r * D, lane);
        const float rstd = row_rstd(x, lane); const int rb = r < NL ? (r >> 11) : 8; const float* mod = MOD + (size_t)rb * 6144;
        norm_mod(x, rstd, P->in[6], mod, mod + 1024, WSP(bf16_t, WS_H) + (size_t)r * D, lane, hv);
    }
}
__device__ __forceinline__ void phase_mla_norm(PK P, int gw, int lane) {
    const float* Y = WSP(const float, WS_Y416); bf16_t* CQ = WSP(bf16_t, WS_CQKV); bf16_t* KR = WSP(bf16_t, WS_KR);
    const float* qn = P->in[16]; const float* kn = P->in[17]; const float* rope = WSP(const float, WS_ROPE_C);
    for (int r = gw; r < NT; r += 2048) {
        const float* y = Y + (size_t)r * C_INP;
        const f32x4 v = *(const f32x4*)(y + 4 * lane);
        const float ss = wave_sum((v[0] * v[0] + v[1] * v[1]) + (v[2] * v[2] + v[3] * v[3]), lane);
        const float rq = 1.0f / sqrtf(ss * (1.0f / 256.0f) + NORM_EPS);
        const f32x4 g = *(const f32x4*)(qn + 4 * lane);
        u32x2 w; w.x = cvt_pk_bf16(v[0] * rq * g[0], v[1] * rq * g[1]); w.y = cvt_pk_bf16(v[2] * rq * g[2], v[3] * rq * g[3]);
        *(u32x2*)(CQ + (size_t)r * C_UPK + 4 * lane) = w;
        const f32x2 k2 = *(const f32x2*)(y + 256 + 2 * lane);
        const float s2 = wave_sum(k2[0] * k2[0] + k2[1] * k2[1], lane);
        const float rk = 1.0f / sqrtf(s2 * (1.0f / 128.0f) + NORM_EPS);
        const f32x2 g2 = *(const f32x2*)(kn + 2 * lane);
        *(unsigned*)(CQ + (size_t)r * C_UPK + 256 + 2 * lane) = cvt_pk_bf16(k2[0] * rk * g2[0], k2[1] * rk * g2[1]);
        if (lane < 16) { f32x2 p = *(const f32x2*)(y + 384 + 2 * lane);
            if (r < NL) { const f32x2 cs = *(const f32x2*)(rope + ((size_t)(r & (SEQ - 1)) * 16 + lane) * 2); const float a = p[0], b = p[1]; p[0] = a * cs[0] - b * cs[1]; p[1] = a * cs[1] + b * cs[0]; }
            *(unsigned*)(KR + (size_t)r * 32 + 2 * lane) = cvt_pk_bf16(p[0], p[1]); }
    }
}
__device__ __forceinline__ void moe_tables(LAS unsigned char* misc, unsigned* gcnt, int tid) {
    LAS int* ecnt = (LAS int*)(misc + M_ECNT); LAS int* lbase = (LAS int*)(misc + M_LBASE); LAS int* cumt = (LAS int*)(misc + M_CUMT);
    if (tid < 32) ecnt[tid] = (int)__hip_atomic_load(gcnt + tid * 16, __ATOMIC_RELAXED, __HIP_MEMORY_SCOPE_AGENT);
    __syncthreads();
    if (tid == 0) { int s = 0, t = 0; for (int e = 0; e < 32; ++e) { lbase[e] = s; cumt[e] = t; const int mt = (ecnt[e] + 255) >> 8; s += mt * 256; t += mt; } cumt[32] = t; }
    __syncthreads();
}
__device__ __forceinline__ void phase_router(PK P, LAS unsigned char* lds, int l, int nrows, int vcu, int tid) {
    const int lane = tid & 63, wid = __builtin_amdgcn_readfirstlane(tid >> 6);
    LAS unsigned char* misc = lds + MISC_OFF;
    LAS int* lcnt = (LAS int*)(misc + M_LCNT); LAS int* gbase = (LAS int*)(misc + M_GBASE); LAS int* rec = (LAS int*)(misc + M_REC);
    const float* rw = P->in[21] + (size_t)l * D * NEXP; const float* rbias = P->in[22] + l * NEXP;
    for (int c = tid; c < D * 8; c += 512) { const int d = c >> 3, q = c & 7; const int rho = (d & ~5) | ((d & 1) << 2) | ((d >> 2) & 1);
        *(LAS f32x4*)(lds + rho * 128 + ((q ^ ((d >> 3) & 7)) * 16)) = *(const f32x4*)(rw + (size_t)d * 32 + q * 4); }
    if (tid < 32) lcnt[tid] = 0;
    __syncthreads();
    const int RPW = nrows >> 8;
    const float* MOD = WSP(const float, WS_MOD) + (size_t)l * 9 * 6144;
    float* XS = WSP(float, WS_XS); bf16_t* H = WSP(bf16_t, WS_H);
    int* TOPE = WSP(int, WS_TOPE); float* GATE = WSP(float, WS_GATE);
    for (int lr = wid; lr < RPW; lr += 8) {
        const int r = vcu * RPW + lr;
        Row4 x, hv; row_load(x, XS + (size_t)r * D, lane);
        const float rstd = row_rstd(x, lane); const int rb = r < NL ? (r >> 11) : 8; const float* mod = MOD + (size_t)rb * 6144;
        norm_mod(x, rstd, P->in[7] + (size_t)l * D, mod + 3072, mod + 4096, H + (size_t)r * D, lane, hv);
        float acc[32];
#pragma unroll
        for (int e = 0; e < 32; ++e) acc[e] = 0.f;
        const int sw = (lane >> 1) & 7;
#pragma unroll
        for (int j = 0; j < 4; ++j)
#pragma unroll
            for (int i = 0; i < 4; ++i) { const int d = 4 * lane + 256 * j + i; const int rho = (d & ~5) | ((i & 1) << 2) | (lane & 1); const float xv = hv.v[j][i];
                const LAS unsigned char* rowb = lds + rho * 128;
#pragma unroll
                for (int q = 0; q < 8; ++q) { const f32x4 wv = *(const LAS f32x4*)(rowb + ((q ^ sw) * 16));
                    acc[4 * q + 0] += xv * wv[0]; acc[4 * q + 1] += xv * wv[1]; acc[4 * q + 2] += xv * wv[2]; acc[4 * q + 3] += xv * wv[3]; } }
#define RT_STEP(NN, MASK) { const bool up = (lane & (MASK)) != 0; _Pragma("unroll") for (int i = 0; i < (NN); ++i) { const float a = acc[i], b2 = acc[i + (NN)]; const float send = up ? a : b2, keep = up ? b2 : a; acc[i] = keep + shx(send, (MASK), lane); } }
        RT_STEP(16, 32) RT_STEP(8, 16) RT_STEP(4, 8) RT_STEP(2, 4) RT_STEP(1, 2)
#undef RT_STEP
        float v = acc[0] + shx(acc[0], 1, lane);
        const int myE = lane >> 1;
        v += rbias[myE];
        float tv[4]; int te[4];
#pragma unroll
        for (int k = 0; k < 4; ++k) { const float mx = wave_max(v, lane); const unsigned long long bal = __ballot(v == mx); const int src = __ffsll((long long)bal) - 1; const int e = src >> 1;
            tv[k] = mx; te[k] = e; if (myE == e) v = -INFINITY; }
        const float e1 = __expf(tv[1] - tv[0]), e2 = __expf(tv[2] - tv[0]), e3 = __expf(tv[3] - tv[0]); const float inv = 1.0f / (1.0f + e1 + e2 + e3);
        if (lane == 0) {
            const float gt[4] = {inv, e1 * inv, e2 * inv, e3 * inv};
#pragma unroll
            for (int k = 0; k < 4; ++k) { TOPE[(size_t)r * 4 + k] = te[k]; GATE[(size_t)r * 4 + k] = gt[k];
                const int lp = __hip_atomic_fetch_add(lcnt + te[k], 1, __ATOMIC_RELAXED, __HIP_MEMORY_SCOPE_WORKGROUP);
                rec[2 * (lr * 4 + k)] = te[k]; rec[2 * (lr * 4 + k) + 1] = lp; }
        }
    }
    __syncthreads();
    unsigned* gcnt = WSP(unsigned, WS_CTL) + CW_CNT + l * 512;
    if (tid < 32) { const int c = lcnt[tid]; gbase[tid] = c ? (int)__hip_atomic_fetch_add(gcnt + tid * 16, (unsigned)c, __ATOMIC_RELAXED, __HIP_MEMORY_SCOPE_AGENT) : 0; }
    __syncthreads();
    int* ELIST = WSP(int, WS_ELIST); int* POS = WSP(int, WS_POS);
    for (int idx = tid; idx < RPW * 4; idx += 512) { const int e = rec[2 * idx], pos = gbase[e] + rec[2 * idx + 1]; const int r = vcu * RPW + (idx >> 2);
        ELIST[(size_t)e * NT + pos] = r; POS[(size_t)r * 4 + (idx & 3)] = pos; }
    __syncthreads();
}
__device__ __forceinline__ void phase_combine(PK P, LAS unsigned char* lds, int l, int nrows, int gw, int tid) {
    const int lane = tid & 63;
    LAS unsigned char* misc = lds + MISC_OFF;
    moe_tables(misc, WSP(unsigned, WS_CTL) + CW_CNT + l * 512, tid);
    const LAS int* lbase = (const LAS int*)(misc + M_LBASE);
    const float* MOD = WSP(const float, WS_MOD); const float* g2 = MOD + (size_t)l * 9 * 6144 + 5120;
    float* XS = WSP(float, WS_XS); const bf16_t* YS = WSP(const bf16_t, WS_YS);
    const int* TOPE = WSP(const int, WS_TOPE); const int* POS = WSP(const int, WS_POS); const float* GATE = WSP(const float, WS_GATE);
    const bool last = (l == DEPTH - 1);
    for (int r = gw; r < nrows; r += 2048) {
        int slot = 0; float gate = 0.f;
        if (lane < 4) { slot = lbase[TOPE[(size_t)r * 4 + lane]] + POS[(size_t)r * 4 + lane]; gate = GATE[(size_t)r * 4 + lane]; }
        Row4 x; row_load(x, XS + (size_t)r * D, lane);
        Row4 f;
#pragma unroll
        for (int j = 0; j < 4; ++j) f.v[j] = (f32x4){0.f, 0.f, 0.f, 0.f};
#pragma unroll
        for (int k = 0; k < 4; ++k) { const int sk = __builtin_amdgcn_readlane(slot, k); const float gk = __int_as_float(__builtin_amdgcn_readlane(__float_as_int(gate), k)); const bf16_t* yr = YS + (size_t)sk * D;
#pragma unroll
            for (int j = 0; j < 4; ++j) { const u32x2 w = *(const u32x2*)(yr + 4 * lane + 256 * j);
                f.v[j][0] += gk * bf_lo(w.x); f.v[j][1] += gk * bf_hi(w.x); f.v[j][2] += gk * bf_lo(w.y); f.v[j][3] += gk * bf_hi(w.y); } }
        const int rb = r < NL ? (r >> 11) : 8;
#pragma unroll
        for (int j = 0; j < 4; ++j) { const f32x4 gg = *(const f32x4*)(g2 + (size_t)rb * 6144 + 4 * lane + 256 * j); x.v[j] = x.v[j] + gg * f.v[j]; }
        const float rstd = row_rstd(x, lane);
        if (last) {
#pragma unroll
            for (int j = 0; j < 4; ++j) { const int c = 4 * lane + 256 * j; const f32x4 gn = *(const f32x4*)(P->in[8] + c); *(f32x4*)(P->out + (size_t)r * D + c) = x.v[j] * rstd * gn; }
        } else {
            row_store(x, XS + (size_t)r * D, lane);
            Row4 hv; const float* mod = MOD + (size_t)(l + 1) * 9 * 6144 + (size_t)rb * 6144;
            norm_mod(x, rstd, P->in[6] + (size_t)(l + 1) * D, mod, mod + 1024, WSP(bf16_t, WS_H) + (size_t)r * D, lane, hv);
        }
    }
}
__device__ __forceinline__ void phase_final_norm(PK P, int gw, int lane) {
    for (int r = gw; r < NL; r += 2048) { Row4 x; row_load(x, WSP(float, WS_XS) + (size_t)r * D, lane); const float rstd = row_rstd(x, lane);
#pragma unroll
        for (int j = 0; j < 4; ++j) { const int c = 4 * lane + 256 * j; const f32x4 gn = *(const f32x4*)(P->in[8] + c); *(f32x4*)(P->out + (size_t)r * D + c) = x.v[j] * rstd * gn; } }
}

__device__ __forceinline__ void conv_item(const float* src, int N, int nvalid, int k0, int n0, bf16_t* dst, int ldk, int drow0, int dk0, LAS unsigned* scr, int lane) {
    const int q = lane >> 4, nl = lane & 15, n = n0 + 4 * nl;
    f32x4 v[16];
#pragma unroll
    for (int r = 0; r < 16; ++r) { const int k = k0 + 8 * (r >> 1) + 2 * q + (r & 1);
        v[r] = (n < nvalid) ? __builtin_nontemporal_load((const f32x4*)(src + (size_t)k * N + n)) : (f32x4){0.f, 0.f, 0.f, 0.f}; }
#pragma unroll
    for (int rp = 0; rp < 8; ++rp)
#pragma unroll
        for (int i = 0; i < 4; ++i) { const int nn = 4 * nl + i, kw = 4 * rp + q; scr[nn * 32 + (kw ^ (4 * ((nn >> 2) & 7)))] = cvt_pk_bf16(v[2 * rp][i], v[2 * rp + 1][i]); }
    asm volatile("s_waitcnt lgkmcnt(0)" ::: "memory");
#pragma unroll
    for (int it = 0; it < 8; ++it) { const int nn = 8 * it + (lane >> 3), c = lane & 7;
        const u32x4 w = *(const LAS u32x4*)(scr + nn * 32 + 4 * (c ^ ((nn >> 2) & 7)));
        *(u32x4*)(dst + (size_t)(drow0 + nn) * ldk + dk0 + 8 * c) = w; }
    asm volatile("s_waitcnt lgkmcnt(0)" ::: "memory");
}
constexpr int CV_A_IN = 2 * 16 * 24, CV_A_OUT = 2 * 256, CV_B_IN = 16 * 48, CV_B_OUT = 256, CV_C_IN = 16 * 8, CV_C_UQ = 4 * 24, CV_C_UKV = 2 * 32, CV_C_OUT = 256;
constexpr int CV_SMALL = CV_A_IN + CV_A_OUT + CV_B_IN + CV_B_OUT + CV_C_IN + CV_C_UQ + CV_C_UKV + CV_C_OUT;
constexpr int CV_TOTAL = CV_SMALL + DEPTH * NEXP * 3 * 256;
__device__ __forceinline__ void conv_dispatch(PK P, int item, LAS unsigned* scr, int lane) {
    int r = item;
    if (r < CV_A_IN) { const int s = r / 384, it = r % 384, kb = it / 24, nb = it % 24;
        conv_item(P->in[9] + (size_t)s * D * A_IN, A_IN, A_IN, 64 * kb, 64 * nb, WSP(bf16_t, WS_WA_IN) + (size_t)s * A_IN * D, D, 64 * nb, 64 * kb, scr, lane); return; } r -= CV_A_IN;
    if (r < CV_A_OUT) { const int s = r / 256, it = r % 256, kb = it / 16, nb = it % 16;
        conv_item(P->in[10] + (size_t)s * D * D, D, D, 64 * kb, 64 * nb, WSP(bf16_t, WS_WA_OUT) + (size_t)s * D * D, D, 64 * nb, 64 * kb, scr, lane); return; } r -= CV_A_OUT;
    if (r < CV_B_IN) { const int kb = r / 48, nb = r % 48;
        conv_item(P->in[12], B_IN, B_IN, 64 * kb, 64 * nb, WSP(bf16_t, WS_WB_IN), D, 64 * nb, 64 * kb, scr, lane); return; } r -= CV_B_IN;
    if (r < CV_B_OUT) { const int kb = r / 16, nb = r % 16;
        conv_item(P->in[13], D, D, 64 * kb, 64 * nb, WSP(bf16_t, WS_WB_OUT), D, 64 * nb, 64 * kb, scr, lane); return; } r -= CV_B_OUT;
    if (r < CV_C_IN) { const int kb = r / 8, nb = r % 8;
        conv_item(P->in[15], C_IN, C_IN, 64 * kb, 64 * nb, WSP(bf16_t, WS_WC_IN), D, 64 * nb, 64 * kb, scr, lane); return; } r -= CV_C_IN;
    if (r < CV_C_UQ) { const int kb = r / 24, nb = r % 24;
        conv_item(P->in[18], 1536, 1536, 64 * kb, 64 * nb, WSP(bf16_t, WS_WC_UP), C_UPK, 64 * nb, 64 * kb, scr, lane); return; } r -= CV_C_UQ;
    if (r < CV_C_UKV) { const int kb = r / 32, nb = r % 32;
        conv_item(P->in[19], 2048, 2048, 64 * kb, 64 * nb, WSP(bf16_t, WS_WC_UP), C_UPK, 1536 + 64 * nb, 256 + 64 * kb, scr, lane); return; } r -= CV_C_UKV;
    if (r < CV_C_OUT) { const int kb = r / 16, nb = r % 16;
        conv_item(P->in[20], D, D, 64 * kb, 64 * nb, WSP(bf16_t, WS_WC_OUT), D, 64 * nb, 64 * kb, scr, lane); return; } r -= CV_C_OUT;
    const int mat = r >> 8, it = r & 255, kb = it >> 4, nb = it & 15, which = mat % 3, le = mat / 3;
    if (which == 2) { conv_item(P->in[27] + (size_t)le * D * D, D, D, 64 * kb, 64 * nb, WSP(bf16_t, WS_WD) + (size_t)le * D * D, D, 64 * nb, 64 * kb, scr, lane); return; }
    const int n0 = 64 * nb, drow0 = 256 * (n0 >> 7) + (n0 & 127) + (which ? 128 : 0);
    conv_item(P->in[which ? 25 : 23] + (size_t)le * D * D, D, D, 64 * kb, n0, WSP(bf16_t, WS_WGU) + (size_t)le * 2 * D * D, D, drow0, 64 * kb, scr, lane);
}
__device__ __forceinline__ void phase_prologue(PK P, LAS unsigned char* lds, int bid, int tid) {
    const int lane = tid & 63, wid = __builtin_amdgcn_readfirstlane(tid >> 6);
    {
        LAS float* S = (LAS float*)lds; LAS float* red = (LAS float*)(lds + 40960);
        for (int idx = tid; idx < 9 * D; idx += 512) { const int r = idx >> 10, d = idx & (D - 1); const float v = r < 8 ? P->in[1][r * D + d] : P->in[3][d];
            S[idx] = v / (1.0f + __builtin_amdgcn_exp2f(-v * LOG2E)); }
        __syncthreads();
        const int l = bid >> 6, c0 = (bid & 63) * 96;
        if (lane < 48) {
            float acc[9][2];
#pragma unroll
            for (int r = 0; r < 9; ++r) { acc[r][0] = 0.f; acc[r][1] = 0.f; }
            const float* wp = P->in[4] + ((size_t)l * D + 128 * wid) * 6144 + c0 + 2 * lane;
            const LAS float* sp = S + 128 * wid;
#pragma unroll 8
            for (int k = 0; k < 128; ++k) { const f32x2 w = *(const f32x2*)(wp + (size_t)k * 6144);
#pragma unroll
                for (int r = 0; r < 9; ++r) { const float s = sp[r * D + k]; acc[r][0] += s * w[0]; acc[r][1] += s * w[1]; } }
#pragma unroll
            for (int r = 0; r < 9; ++r) { red[(wid * 9 + r) * 96 + 2 * lane] = acc[r][0]; red[(wid * 9 + r) * 96 + 2 * lane + 1] = acc[r][1]; }
        }
        __syncthreads();
        float* MOD = WSP(float, WS_MOD);
        for (int idx = tid; idx < 9 * 96; idx += 512) { const int r = idx / 96, cc = idx % 96; float s = 0.f;
#pragma unroll
            for (int w = 0; w < 8; ++w) s += red[(w * 9 + r) * 96 + cc];
            MOD[((size_t)l * 9 + r) * 6144 + c0 + cc] = s + P->in[5][(size_t)l * 6144 + c0 + cc]; }
        __syncthreads();
    }
    {
        const int gt = bid * 512 + tid; float* RA = WSP(float, WS_ROPE_A); float* RC = WSP(float, WS_ROPE_C);
        const float L2T = 13.287712379549449f;
        for (int idx = gt; idx < SEQ * 32; idx += 131072) { const int t = idx >> 5, i = idx & 31; const float pos = (float)(i < 16 ? (t >> 6) : (t & 63));
            const float inv = __builtin_amdgcn_exp2f(-(float)(i & 15) * (1.0f / 16.0f) * L2T); const float ang = pos * inv; RA[2 * idx] = __cosf(ang); RA[2 * idx + 1] = __sinf(ang); }
        for (int idx = gt; idx < SEQ * 16; idx += 131072) { const int t = idx >> 4, i = idx & 15; const float pos = (float)(i < 8 ? (t >> 6) : (t & 63));
            const float inv = __builtin_amdgcn_exp2f(-(float)(i & 7) * (1.0f / 8.0f) * L2T); const float ang = pos * inv; RC[2 * idx] = __cosf(ang); RC[2 * idx + 1] = __sinf(ang); }
        bf16_t* WU = WSP(bf16_t, WS_WC_UP); const u32x4 z = (u32x4){0u, 0u, 0u, 0u};
        for (int idx = gt; idx < 1536 * 16; idx += 131072) *(u32x4*)(WU + (size_t)(idx >> 4) * C_UPK + 256 + 8 * (idx & 15)) = z;
        for (int idx = gt; idx < 2048 * 32; idx += 131072) *(u32x4*)(WU + (size_t)(1536 + (idx >> 5)) * C_UPK + 8 * (idx & 31)) = z;
    }
    {
        LAS unsigned* scr = (LAS unsigned*)(lds + wid * 8192);
        const int gw = bid * 8 + wid;
        for (int item = gw; item < CV_TOTAL; item += 2048) conv_dispatch(P, item, scr, lane);
    }
}

constexpr int PH_PRO = 0, PH_N0 = 1, PH_L0 = 2, PH_PER_LAYER = 9, PH_FINAL = PH_L0 + DEPTH * PH_PER_LAYER, NPH = PH_FINAL + 1;
enum { LP_IN = 0, LP_MLANORM = 1, LP_MLAUP = 2, LP_ATT = 3, LP_OUT = 4, LP_RT = 5, LP_GU = 6, LP_DN = 7, LP_CB = 8 };
struct Args { Ptrs P; int p_lo, p_hi, bar_idx, pad; };

__global__ void __launch_bounds__(512, 2) mk_fwd(Args a) {
    extern __shared__ __attribute__((aligned(16))) unsigned char lds_raw[];
    LAS unsigned char* const lds = (LAS unsigned char*)lds_raw;
    LAS unsigned char* const misc = lds + MISC_OFF;
    typedef const __attribute__((address_space(4))) Args* ArgsK;
    const ArgsK ak = (ArgsK)__builtin_amdgcn_kernarg_segment_ptr();
    (void)a;
    const int wid0 = __builtin_amdgcn_readfirstlane((int)threadIdx.x >> 6);
    if (wid0 == 0 && lane_id() < 4) ((LAS unsigned*)(misc + M_BARW))[lane_id()] = 0u;
    __syncthreads();
    XcdBarrier bar;
    { PK P = &ak->P; bar = xcd_barrier_post(WSP(unsigned, WS_CTL) + CW_BAR + ak->bar_idx * XCD_BAR_WORDS, (volatile LAS unsigned*)(misc + M_BARW), wid0 == 0); }
    bool ran = false;
    const int p_lo = ak->p_lo, p_hi = ak->p_hi;
#define PHASE_BEGIN(bit, p, cond) if ((((MK_MASK) >> (bit)) & 1) && p_lo <= (p) && (p) < p_hi && ((p) <= MK_STOP_AFTER || (p) == PH_FINAL) && (cond)) { if (ran) xcd_barrier(bar); ran = true; \
    int tid = wid0 * 64 + lane_id(); asm volatile("" : "+v"(tid)); int bid = blockIdx.x; asm volatile("" : "+s"(bid)); ArgsK ak_ = ak; asm volatile("" : "+s"(ak_)); PK P = &ak_->P; \
    const int lane = tid & 63, wid = __builtin_amdgcn_readfirstlane(tid >> 6), vcu = (bid & 7) * 32 + (bid >> 3), gw = vcu * 8 + wid; (void)lane; (void)gw; (void)P;
#define PHASE_END }

    PHASE_BEGIN(0, PH_PRO, true) phase_prologue(P, lds, bid, tid); PHASE_END
    PHASE_BEGIN(1, PH_N0, true) phase_first_norm(P, gw, lane); PHASE_END

    for (int l = 0; l < DEPTH; ++l) {
        const int kind = l % 3, slot = l / 3, pb = PH_L0 + l * PH_PER_LAYER;
        const bool last = (l == DEPTH - 1);
        const int nMrows = last ? NL / 256 : NT / 256;
        PHASE_BEGIN(2, pb + LP_IN, kind == 0) {
            pg8::Gemm g{WSP(const bf16_t, WS_H), WSP(const bf16_t, WS_WA_IN) + (size_t)slot * A_IN * D, D, 0, nullptr};
            pg8::DenseOrder S{nMrows, 6, vcu, last ? 8 : 0, 4, 2};
            pg8::EpiQkvA E{WSP(bf16_t, WS_QKV), WSP(const float, WS_ROPE_A)};
            pg8::gemm_phase<pg8::EpiQkvA, pg8::DenseOrder, false>(lds, g, S, E, tid);
        } PHASE_END
        PHASE_BEGIN(3, pb + LP_IN, kind == 1) {
            pg8::Gemm g{WSP(const bf16_t, WS_H), WSP(const bf16_t, WS_WB_IN), D, 0, nullptr};
            pg8::DenseOrder S{NT / 256, 12, vcu, 0, 0, 0};
            pg8::EpiBf16Plain E{WSP(bf16_t, WS_QKV), B_IN};
            pg8::gemm_phase<pg8::EpiBf16Plain, pg8::DenseOrder, false>(lds, g, S, E, tid);
        } PHASE_END
        PHASE_BEGIN(4, pb + LP_IN, kind == 2) {
            pg8::Gemm g{WSP(const bf16_t, WS_H), WSP(const bf16_t, WS_WC_IN), D, 0, nullptr};
            pg8::DenseOrder S{NT / 256, 2, vcu, 0, 0, 0};
            pg8::EpiF32Plain E{WSP(float, WS_Y416), C_INP};
            pg8::gemm_phase<pg8::EpiF32Plain, pg8::DenseOrder, false>(lds, g, S, E, tid);
        } PHASE_END
        PHASE_BEGIN(5, pb + LP_MLANORM, kind == 2) phase_mla_norm(P, gw, lane); PHASE_END
        PHASE_BEGIN(6, pb + LP_MLAUP, kind == 2) {
            pg8::Gemm g{WSP(const bf16_t, WS_CQKV), WSP(const bf16_t, WS_WC_UP), C_UPK, 0, nullptr};
            pg8::DenseOrder S{NT / 256, 14, vcu, 0, 0, 0};
            pg8::EpiMlaUp E{WSP(bf16_t, WS_QKV), WSP(const float, WS_ROPE_C)};
            pg8::gemm_phase<pg8::EpiMlaUp, pg8::DenseOrder, false>(lds, g, S, E, tid);
        } PHASE_END
        PHASE_BEGIN(7, pb + LP_ATT, kind == 0) {
            const bf16_t* QKV = WSP(const bf16_t, WS_QKV); bf16_t* O = WSP(bf16_t, WS_O); const float* sink = P->in[11] + slot * 16;
            for (int u = vcu; u < 1024; u += 256) { const int bk = u >> 5; att::attn_A_unit(lds, QKV, O, sink, bk >> 2, bk & 3, u & 31, false, tid); }
            if (!last) for (int u = vcu; u < 128; u += 256) { const int bk = u >> 2; att::attn_A_unit(lds, QKV, O, sink, bk >> 2, bk & 3, u & 3, true, tid); }
        } PHASE_END
        PHASE_BEGIN(8, pb + LP_ATT, kind == 1) {
            const bf16_t* QKV = WSP(const bf16_t, WS_QKV); bf16_t* O = WSP(bf16_t, WS_O); LAS float* tab = (LAS float*)(misc + M_RPB);
            for (int u = vcu; u < 1024; u += 256) { const int bh = u >> 3; att::attn_B_unit(lds, tab, QKV, O, P->in[14], bh >> 4, bh & 15, u & 7, false, tid); }
            for (int u = vcu; u < 128; u += 256) att::attn_B_unit(lds, tab, QKV, O, P->in[14], u >> 4, u & 15, 0, true, tid);
        } PHASE_END
        PHASE_BEGIN(9, pb + LP_ATT, kind == 2) {
            const bf16_t* QKV = WSP(const bf16_t, WS_QKV); bf16_t* O = WSP(bf16_t, WS_O); const bf16_t* KR = WSP(const bf16_t, WS_KR);
            for (int u = vcu; u < 1024; u += 256) { const int bh = u >> 3; att::attn_C_unit(lds, QKV, KR, O, bh >> 4, bh & 15, u & 7, false, tid); }
            for (int u = vcu; u < 128; u += 256) att::attn_C_unit(lds, QKV, KR, O, u >> 4, u & 15, 0, true, tid);
        } PHASE_END
        PHASE_BEGIN(10, pb + LP_OUT, true) {
            const bf16_t* W = kind == 0 ? WSP(const bf16_t, WS_WA_OUT) + (size_t)slot * D * D : (kind == 1 ? WSP(const bf16_t, WS_WB_OUT) : WSP(const bf16_t, WS_WC_OUT));
            pg8::Gemm g{WSP(const bf16_t, WS_O), W, D, 0, nullptr};
            pg8::DenseOrder S{nMrows, 4, vcu, 0, 0, 0};
            pg8::EpiResid E{WSP(float, WS_XS), WSP(const float, WS_MOD) + (size_t)l * 9 * 6144 + 2048};
            pg8::gemm_phase<pg8::EpiResid, pg8::DenseOrder, false>(lds, g, S, E, tid);
        } PHASE_END
        PHASE_BEGIN(11, pb + LP_RT, true) phase_router(P, lds, l, last ? NL : NT, vcu, tid); PHASE_END
        PHASE_BEGIN(12, pb + LP_GU, true) {
            moe_tables(misc, WSP(unsigned, WS_CTL) + CW_CNT + l * 512, tid);
            pg8::Gemm g{WSP(const bf16_t, WS_H), WSP(const bf16_t, WS_WGU) + (size_t)l * NEXP * 2 * D * D, D, (size_t)2 * D * D, WSP(const int, WS_ELIST)};
            pg8::MoeOrder S{(const LAS int*)(misc + M_ECNT), (const LAS int*)(misc + M_LBASE), (const LAS int*)(misc + M_CUMT), 8, vcu};
            pg8::EpiSwiglu E{WSP(bf16_t, WS_ACT), P->in[24] + (size_t)l * NEXP * D, P->in[26] + (size_t)l * NEXP * D};
            pg8::gemm_phase<pg8::EpiSwiglu, pg8::MoeOrder, true>(lds, g, S, E, tid);
        } PHASE_END
        PHASE_BEGIN(13, pb + LP_DN, true) {
            moe_tables(misc, WSP(unsigned, WS_CTL) + CW_CNT + l * 512, tid);
            pg8::Gemm g{WSP(const bf16_t, WS_ACT), WSP(const bf16_t, WS_WD) + (size_t)l * NEXP * D * D, D, (size_t)D * D, nullptr};
            pg8::MoeOrder S{(const LAS int*)(misc + M_ECNT), (const LAS int*)(misc + M_LBASE), (const LAS int*)(misc + M_CUMT), 4, vcu};
            pg8::EpiDown E{WSP(bf16_t, WS_YS), P->in[28] + (size_t)l * NEXP * D};
            pg8::gemm_phase<pg8::EpiDown, pg8::MoeOrder, false>(lds, g, S, E, tid);
        } PHASE_END
        PHASE_BEGIN(14, pb + LP_CB, true) phase_combine(P, lds, l, last ? NL : NT, gw, tid); PHASE_END
    }
    PHASE_BEGIN(15, PH_FINAL, MK_STOP_AFTER < PH_FINAL - 1) phase_final_norm(P, gw, lane); PHASE_END
#undef PHASE_BEGIN
#undef PHASE_END
}

extern "C" void kernel_launch(void* const* d_in, const int* in_sizes, int n_in, void* d_out, int out_size, void* d_ws, size_t ws_size, hipStream_t stream) {
    static int grid = 0;
    if (grid == 0) {
        if (n_in != 29 || out_size != NL * D || ws_size < WS_END) { fprintf(stderr, "kernel_launch: expected 29 inputs, out %d, ws >= %zu; got n_in %d out %d ws %zu\n", NL * D, (size_t)WS_END, n_in, out_size, ws_size); grid = -1; return; }
        int dev = 0, cus = 0, per_cu = 0;
        if (hipGetDevice(&dev) != hipSuccess || hipDeviceGetAttribute(&cus, hipDeviceAttributeMultiprocessorCount, dev) != hipSuccess) { grid = -1; return; }
        if (hipFuncSetAttribute((const void*)mk_fwd, hipFuncAttributeMaxDynamicSharedMemorySize, LDS_BYTES) != hipSuccess) { fprintf(stderr, "kernel_launch: hipFuncSetAttribute failed\n"); grid = -1; return; }
        if (hipOccupancyMaxActiveBlocksPerMultiprocessor(&per_cu, (const void*)mk_fwd, 512, LDS_BYTES) != hipSuccess || per_cu < 1) fprintf(stderr, "kernel_launch: occupancy query says %d\n", per_cu);
        (void)hipGetLastError();
        grid = 256;
        if (cus < 256) { fprintf(stderr, "kernel_launch: needs 256 CUs, device has %d\n", cus); grid = -1; return; }
    }
    if (grid < 0) return;
    if (hipMemsetAsync((char*)d_ws + WS_CTL, 0, CTL_BYTES, stream) != hipSuccess) return;
    Args a{};
    for (int i = 0; i < 29; ++i) a.P.in[i] = (const float*)d_in[i];
    a.P.out = (float*)d_out; a.P.ws = (unsigned char*)d_ws; a.pad = 0;
#if MK_PER_PHASE
    for (int p = 0; p < NPH; ++p) { a.p_lo = p; a.p_hi = p + 1; a.bar_idx = 0; hipLaunchKernelGGL(mk_fwd, dim3(grid), dim3(512), LDS_BYTES, stream, a); }
#else
    a.p_lo = 0; a.p_hi = NPH; a.bar_idx = 0;
    hipLaunchKernelGGL(mk_fwd, dim3(grid), dim3(512), LDS_BYTES, stream, a);
#endif
    const hipError_t le = hipPeekAtLastError();
    if (le != hipSuccess) fprintf(stderr, "kernel_launch: launch failed: %s\n", hipGetErrorName(le));
}
```

```cpp
#include <hip/hip_runtime.h>
#include <cstdio>
#include <cstdint>

#ifndef MK_PER_PHASE
#define MK_PER_PHASE 0
#endif
#ifndef MK_MASK
#define MK_MASK 0xFFFF
#endif
#ifndef MK_REP_MASK
#define MK_REP_MASK 0
#endif
#ifndef MK_Q_OUT
#define MK_Q_OUT 1
#endif
#ifndef MK_Q_GU
#define MK_Q_GU 1
#endif
#ifndef MK_Q_DN
#define MK_Q_DN 1
#endif
#ifndef MK_Q_IN
#define MK_Q_IN 1
#endif
#ifndef MK_STOP_AFTER
#define MK_STOP_AFTER 9999
#endif

#define LAS __attribute__((address_space(3)))
#define GAS __attribute__((address_space(1)))
typedef unsigned short bf16_t;
typedef short bf16x8 __attribute__((ext_vector_type(8)));
typedef short s16x4 __attribute__((ext_vector_type(4)));
typedef _Float16 f16x8 __attribute__((ext_vector_type(8)));
typedef _Float16 f16x2 __attribute__((ext_vector_type(2)));
typedef float f32x2 __attribute__((ext_vector_type(2)));
typedef float f32x4 __attribute__((ext_vector_type(4)));
typedef float f32x16 __attribute__((ext_vector_type(16)));
typedef unsigned u32x2 __attribute__((ext_vector_type(2)));
typedef unsigned u32x4 __attribute__((ext_vector_type(4)));

constexpr int D = 1024, NB = 8, SEQ = 2048, CTXL = 256, DEPTH = 4;
constexpr int NL = NB * SEQ;
constexpr int NC = NB * CTXL;
constexpr int NT = NL + NC;
constexpr int NEXP = 32, TOPK = 4;
constexpr int MAXSLOT = 81920;
constexpr float NORM_EPS = 1e-6f;
constexpr float LOG2E = 1.4426950408889634f;
constexpr int A_IN = 1536, B_IN = 3072, C_IN = 416, C_INP = 512, C_UPK = 384, C_UPN = 3584;

constexpr size_t MiB = 1u << 20;
constexpr size_t WS_CTL = 0, CTL_BYTES = 1 * MiB;
constexpr size_t WS_MOD = 1 * MiB;
constexpr size_t WS_ROPE_A = 2 * MiB;
constexpr size_t WS_ROPE_C = 2 * MiB + 512 * 1024;
constexpr size_t WS_TOPE = 3 * MiB;
constexpr size_t WS_POS = 3 * MiB + 512 * 1024;
constexpr size_t WS_GATE = 4 * MiB;
constexpr size_t WS_ELIST = 5 * MiB;
constexpr size_t WS_KR = 8 * MiB;
constexpr size_t WS_CQKV = 10 * MiB;
constexpr size_t WS_Y416 = 24 * MiB;
constexpr size_t WS_XS = 60 * MiB;
constexpr size_t WS_H = 132 * MiB;
constexpr size_t WS_O = 168 * MiB;
constexpr size_t WS_QKV = 204 * MiB;
constexpr size_t WS_ACT = 330 * MiB;
constexpr size_t WS_YS = 490 * MiB;
constexpr size_t WS_WA_IN = 650 * MiB;
constexpr size_t WS_WA_OUT = 656 * MiB;
constexpr size_t WS_WB_IN = 660 * MiB;
constexpr size_t WS_WB_OUT = 666 * MiB;
constexpr size_t WS_WC_IN = 668 * MiB;
constexpr size_t WS_WC_UP = 669 * MiB;
constexpr size_t WS_WC_OUT = 672 * MiB;
constexpr size_t WS_WGU = 676 * MiB;
constexpr size_t WS_WD = 1188 * MiB;
constexpr size_t WS_G16 = 1444 * MiB;
constexpr size_t WS_RC = 1447 * MiB;
constexpr size_t WS_END = 1448 * MiB;

constexpr int CW_CV = 512;
constexpr int CW_CNT = 1024;
constexpr int CW_BAR = 65536;

constexpr int RING_BYTES = 131072;
constexpr int MISC_OFF = RING_BYTES;
constexpr int M_BARW = 0, M_LCNT = 64, M_LBASE = 192, M_CUMT = 320, M_ECNT = 512, M_GBASE = 640, M_CVB = 768, M_RPB = 1024, M_REC = 3072;
constexpr int LDS_BYTES = 147456;

#define XB_TMO      128
#define XB_XCNT(j)  (256  + 64 * (j))
#define XB_XSUB(j)  (1280 + 64 * (j))
#define XB_XGEN(j)  (2304 + 64 * (j))
#define XB_TOP      3328
#define XB_TOPGEN   3392
#define XCD_BAR_WORDS 3456
#define XB_SPIN_CAP (1u << 18)

__device__ __forceinline__ unsigned xb_ld(unsigned* p)              { return __hip_atomic_load(p, __ATOMIC_RELAXED, __HIP_MEMORY_SCOPE_AGENT); }
__device__ __forceinline__ unsigned xb_add(unsigned* p, unsigned v) { return __hip_atomic_fetch_add(p, v, __ATOMIC_RELAXED, __HIP_MEMORY_SCOPE_AGENT); }
__device__ __forceinline__ unsigned xb_xcc_id() { return (unsigned)__builtin_amdgcn_s_getreg((3 << 11) | 20) & 0xFu; }
#define XB_SPIN(cond, bar) do { unsigned _sp = 0; while (cond) { __builtin_amdgcn_s_sleep(1); \
    if ((++_sp & 255u) == 0u) { if (xb_ld(&(bar)[XB_TMO])) break; if (_sp > XB_SPIN_CAP) { atomicAdd(&(bar)[XB_TMO], 1u); break; } } } } while (0)

__device__ __forceinline__ int lane_id() { int r; asm volatile("v_mbcnt_lo_u32_b32 %0, -1, 0\n\tv_mbcnt_hi_u32_b32 %0, -1, %0" : "=v"(r)); return r; }
struct XcdBarrier {
    unsigned* bar; unsigned x;
    volatile LAS unsigned* st;
    bool lead;
};
__device__ __forceinline__ XcdBarrier xcd_barrier_post(unsigned* bar, volatile LAS unsigned* st, bool lead) {
    XcdBarrier b; b.bar = bar; b.x = xb_xcc_id(); b.st = st; b.lead = lead;
    if (lead && lane_id() == 0) (void)xb_add(&bar[XB_XCNT(b.x)], 1u);
    return b;
}
__device__ __forceinline__ void xcd_barrier_complete(unsigned* bar, unsigned x, unsigned& nloc, unsigned& nx) {
    const unsigned G = gridDim.x * gridDim.y * gridDim.z;
    unsigned sum, cnt, mine, sp = 0u;
    for (;;) {
        sum = 0u; cnt = 0u; mine = 0u;
#pragma unroll
        for (unsigned j = 0; j < 16; ++j) { const unsigned c = xb_ld(&bar[XB_XCNT(j)]); sum += c; cnt += (c > 0u) ? 1u : 0u; mine = (j == x) ? c : mine; }
        if (sum == G) break;
        __builtin_amdgcn_s_sleep(1);
        if ((++sp & 255u) == 0u) { if (xb_ld(&bar[XB_TMO])) break; if (sp > XB_SPIN_CAP) { atomicAdd(&bar[XB_TMO], 1u); break; } }
    }
    nloc = mine > 0u ? mine : 1u; nx = cnt > 0u ? cnt : 1u;
}
__device__ __forceinline__ void xcd_barrier(const XcdBarrier& b) {
    asm volatile("s_waitcnt vmcnt(0)" ::: "memory");
    __syncthreads();
    if (b.lead && lane_id() == 0) {
        unsigned* bar = b.bar;
        __builtin_amdgcn_s_waitcnt(0);
        unsigned nloc = b.st[0], nx = b.st[1];
        if (nloc == 0u) { xcd_barrier_complete(bar, b.x, nloc, nx); b.st[0] = nloc; b.st[1] = nx; }
        const unsigned old = xb_add(&bar[XB_XSUB(b.x)], 1u);
        const unsigned gen = old / nloc;
        if (old + 1u == (gen + 1u) * nloc) {
            __builtin_amdgcn_fence(__ATOMIC_RELEASE, "agent");
            asm volatile("s_waitcnt vmcnt(0)" ::: "memory");
            const unsigned og = xb_add(&bar[XB_TOP], 1u);
            const unsigned tg = og / nx;
            if (og + 1u == (tg + 1u) * nx) xb_add(&bar[XB_TOPGEN], 1u);
            else XB_SPIN(xb_ld(&bar[XB_TOPGEN]) == tg, bar);
            __builtin_amdgcn_fence(__ATOMIC_ACQUIRE, "agent");
            xb_add(&bar[XB_XGEN(b.x)], 1u);
            asm volatile("s_waitcnt vmcnt(0)" ::: "memory");
        } else {
            XB_SPIN(xb_ld(&bar[XB_XGEN(b.x)]) == gen, bar);
            __builtin_amdgcn_fence(__ATOMIC_ACQUIRE, "agent");
            asm volatile("s_waitcnt vmcnt(0)" ::: "memory");
        }
    }
    __syncthreads();
}

__device__ __forceinline__ unsigned cvt_pk_bf16(float lo, float hi) { unsigned r; asm volatile("v_cvt_pk_bf16_f32 %0, %1, %2" : "=v"(r) : "v"(lo), "v"(hi)); return r; }
__device__ __forceinline__ float bf_lo(unsigned w) { return __uint_as_float(w << 16); }
__device__ __forceinline__ float bf_hi(unsigned w) { return __uint_as_float(w & 0xffff0000u); }
__device__ __forceinline__ float shx(float v, int mask, int lane) { return __int_as_float(__builtin_amdgcn_ds_bpermute((lane ^ mask) << 2, __float_as_int(v))); }
__device__ __forceinline__ float wave_sum(float v, int lane) {
#pragma unroll
    for (int o = 1; o < 64; o <<= 1) v += shx(v, o, lane);
    return v;
}
__device__ __forceinline__ float wave_max(float v, int lane) {
#pragma unroll
    for (int o = 1; o < 64; o <<= 1) v = fmaxf(v, shx(v, o, lane));
    return v;
}
__device__ __forceinline__ float swap32_max(float m) { auto rr = __builtin_amdgcn_permlane32_swap(__float_as_uint(m), __float_as_uint(m), false, false); return fmaxf(__uint_as_float(rr[0]), __uint_as_float(rr[1])); }
__device__ __forceinline__ float swap32_sum(float m) { auto rr = __builtin_amdgcn_permlane32_swap(__float_as_uint(m), __float_as_uint(m), false, false); return __uint_as_float(rr[0]) + __uint_as_float(rr[1]); }

namespace pg8 {
constexpr int BM = 256, BK = 64, HALF = 128, HTB = HALF * BK * 2, STAGE_BYTES = 8 * HTB;
__host__ __device__ __forceinline__ int lds_byte(int r, int c) { const int st = (r >> 4) * 2 + (c >> 5), rr = r & 15, cc = c & 31, ob = rr * 64 + cc * 2; return st * 1024 + (ob ^ (((ob >> 9) & 1) << 5)); }
__host__ __device__ __forceinline__ void stage_rc(int b, int& R, int& C) { const int st = b / 1024, sb = b % 1024, swz = sb ^ (((sb >> 9) & 1) << 5); R = (st >> 1) * 16 + swz / 64; C = (st & 1) * 32 + (swz % 64) / 2; }
__host__ __device__ __forceinline__ int perm32(int rho) { const int n = rho >> 4, i = rho & 15; return 8 * (i >> 2) + 4 * n + (i & 3); }

struct Unit { int pm, pn, e, mt, cnt; };
struct Gemm { const bf16_t* A; const bf16_t* Bt; int K; size_t bstride; const int* list; };

template <class Epi, class Sched, bool GATHER>
__device__ __forceinline__ void gemm_phase(LAS unsigned char* lds, const Gemm g, const Sched& S, const Epi& E, const int tid) {
    const int wid = __builtin_amdgcn_readfirstlane(tid >> 6), lane = tid & 63, wr = wid >> 2, wc = wid & 3, fr = lane & 15, fq = lane >> 4;
    const int K = g.K, nt = K / BK;
    unsigned voffA[2], voffB[2];
    int gR[2], gC[2];
#pragma unroll
    for (int i = 0; i < 2; ++i) { int R, C; stage_rc(tid * 16 + i * 8192, R, C); const int Rb = Epi::PERM ? ((R & ~31) + perm32(R & 31)) : R;
        voffA[i] = (unsigned)(R * K + C) * 2u; voffB[i] = (unsigned)(Rb * K + C) * 2u; gR[i] = R; gC[i] = C; }
    const size_t kstep = (size_t)(BK * 2);
    const size_t hstep = (size_t)HALF * K * 2;
    const size_t tstep = 2 * hstep;
    const unsigned ldsw = (unsigned)wid * 1024u;
    const int aoff = lds_byte(wr * 64 + fr, fq * 8), boff = lds_byte(wc * 32 + fr, fq * 8);
#define PG8_SA(b, h) (((b) * 2 + (h)) * HTB)
#define PG8_SB(b, h) ((4 + (b) * 2 + (h)) * HTB)
#define PG8_STAGE(bufoff, gbase, voff) do { _Pragma("unroll") for (int _i = 0; _i < 2; ++_i) \
        __builtin_amdgcn_global_load_lds((const unsigned*)((const char*)(gbase) + (voff)[_i]), (LAS unsigned*)(lds + (bufoff) + ldsw + _i * 8192), 16, 0, 0); } while (0)
#define PG8_STAGE_A(bufoff, SELN, H, KOFF) do { if constexpr (GATHER) { unsigned _vo[2]; _vo[0] = (SELN) ? voN[H][0] : voC[H][0]; _vo[1] = (SELN) ? voN[H][1] : voC[H][1]; \
            PG8_STAGE(bufoff, (const char*)g.A + (KOFF), _vo); } else { PG8_STAGE(bufoff, ((SELN) ? nA : cA) + (H) * hstep + (KOFF), voffA); } } while (0)
#define PG8_LDA(dst, b, h) do { _Pragma("unroll") for (int m = 0; m < 4; ++m) _Pragma("unroll") for (int k = 0; k < 2; ++k) dst[m][k] = *(const LAS bf16x8*)(lds + PG8_SA(b, h) + aoff + m * 2048 + k * 1024); } while (0)
#define PG8_LDB(dst, b, h) do { _Pragma("unroll") for (int n = 0; n < 2; ++n) _Pragma("unroll") for (int k = 0; k < 2; ++k) dst[n][k] = *(const LAS bf16x8*)(lds + PG8_SB(b, h) + boff + n * 2048 + k * 1024); } while (0)
#define PG8_MMA(ai, bj, At, Bt) do { __builtin_amdgcn_s_setprio(1); _Pragma("unroll") for (int m = 0; m < 4; ++m) _Pragma("unroll") for (int n = 0; n < 2; ++n) _Pragma("unroll") for (int k = 0; k < 2; ++k) \
        acc[ai][bj][m][n] = __builtin_amdgcn_mfma_f32_16x16x32_bf16(Bt[n][k], At[m][k], acc[ai][bj][m][n], 0, 0, 0); __builtin_amdgcn_s_setprio(0); } while (0)
#define PG8_WAIT_V(n) asm volatile("s_waitcnt vmcnt(" #n ")" ::: "memory")
#define PG8_WAIT_L(n) asm volatile("s_waitcnt lgkmcnt(" #n ")" ::: "memory")
#define PG8_BAR __builtin_amdgcn_s_barrier()
#define PG8_SCHED __builtin_amdgcn_sched_barrier(0)
#define PG8_GATH(U, VO) do { _Pragma("unroll") for (int _h = 0; _h < 2; ++_h) _Pragma("unroll") for (int _i = 0; _i < 2; ++_i) { \
        int _r = (U).mt * 256 + _h * 128 + gR[_i]; _r = _r < (U).cnt ? _r : 0; const int _tok = g.list[(size_t)(U).e * NT + _r]; VO[_h][_i] = (unsigned)(_tok * K + gC[_i]) * 2u; } } while (0)
    Unit cur, nxt; int ui = 0;
    if (!S.next(0, cur)) return;
    f32x4 acc[2][2][4][2];
#pragma unroll
    for (int a = 0; a < 2; ++a)
#pragma unroll
        for (int b = 0; b < 2; ++b)
#pragma unroll
            for (int m = 0; m < 4; ++m)
#pragma unroll
                for (int n = 0; n < 2; ++n) acc[a][b][m][n] = (f32x4){0.f, 0.f, 0.f, 0.f};
    bf16x8 At[4][2], B0[2][2], B1[2][2];
    unsigned voC[2][2] = {{0u, 0u}, {0u, 0u}}, voN[2][2] = {{0u, 0u}, {0u, 0u}};
    if constexpr (GATHER) { PG8_GATH(cur, voC); }
    const char* cA = GATHER ? (const char*)g.A : (const char*)g.A + (size_t)cur.pm * tstep;
    const char* cB = (const char*)g.Bt + ((size_t)cur.e * g.bstride) * 2 + (size_t)cur.pn * tstep;
    const char* nA = cA; const char* nB = cB;
    PG8_STAGE(PG8_SB(0, 0), cB, voffB); PG8_STAGE(PG8_SB(0, 1), cB + hstep, voffB); PG8_STAGE_A(PG8_SA(0, 0), false, 0, 0); PG8_STAGE_A(PG8_SA(0, 1), false, 1, 0);
    if (wr == 1) PG8_BAR;
    PG8_WAIT_V(2); PG8_BAR;
    PG8_STAGE(PG8_SB(1, 0), cB + kstep, voffB); PG8_STAGE_A(PG8_SA(1, 0), false, 0, kstep); PG8_STAGE(PG8_SB(1, 1), cB + hstep + kstep, voffB);
    PG8_WAIT_V(6); PG8_BAR;
    for (;;) {
        const bool has_next = S.next(ui + 1, nxt);
        nA = GATHER ? (const char*)g.A : (has_next ? (const char*)g.A + (size_t)nxt.pm * tstep : cA);
        nB = has_next ? (const char*)g.Bt + ((size_t)nxt.e * g.bstride) * 2 + (size_t)nxt.pn * tstep : cB;
        if constexpr (GATHER) { if (has_next) { PG8_GATH(nxt, voN); } else {
#pragma unroll
            for (int _h = 0; _h < 2; ++_h) { voN[_h][0] = voC[_h][0]; voN[_h][1] = voC[_h][1]; } }
            asm volatile("" : "+v"(voN[0][0]), "+v"(voN[0][1]), "+v"(voN[1][0]), "+v"(voN[1][1])); }
        for (int t = 0; t < nt; t += 2) {
            const bool last = (t == nt - 2);
            const size_t k1 = (size_t)(t + 1) * kstep;
            const size_t k2 = last ? 0 : (size_t)(t + 2) * kstep;
            const size_t k3 = k2 + kstep;
            const char* b2 = (last ? nB : cB) + k2; const char* b3 = b2 + kstep;
            PG8_LDB(B0, 0, 0); PG8_LDB(B1, 0, 1); PG8_SCHED; PG8_LDA(At, 0, 0); PG8_STAGE_A(PG8_SA(1, 1), false, 1, k1);
            PG8_WAIT_V(8); PG8_WAIT_L(0); PG8_BAR; PG8_MMA(0, 0, At, B0); PG8_MMA(0, 1, At, B1); PG8_BAR; PG8_SCHED;
            PG8_LDA(At, 0, 1); PG8_STAGE(PG8_SB(0, 0), b2, voffB); PG8_STAGE(PG8_SB(0, 1), b2 + hstep, voffB); PG8_STAGE_A(PG8_SA(0, 0), last, 0, k2);
            PG8_WAIT_V(8); PG8_WAIT_L(0); PG8_BAR; PG8_MMA(1, 0, At, B0); PG8_MMA(1, 1, At, B1); PG8_BAR; PG8_SCHED;
            PG8_LDB(B0, 1, 0); PG8_LDB(B1, 1, 1); PG8_SCHED; PG8_LDA(At, 1, 0); PG8_STAGE_A(PG8_SA(0, 1), last, 1, k2);
            PG8_WAIT_V(8); PG8_WAIT_L(0); PG8_BAR; PG8_MMA(0, 0, At, B0); PG8_MMA(0, 1, At, B1); PG8_BAR; PG8_SCHED;
            PG8_LDA(At, 1, 1); PG8_STAGE(PG8_SB(1, 0), b3, voffB); PG8_STAGE(PG8_SB(1, 1), b3 + hstep, voffB); PG8_STAGE_A(PG8_SA(1, 0), last, 0, k3);
            PG8_WAIT_V(8); PG8_WAIT_L(0); PG8_BAR; PG8_MMA(1, 0, At, B0); PG8_MMA(1, 1, At, B1); PG8_BAR; PG8_SCHED;
        }
        if (wr == 0) PG8_BAR;
        { const int ln_ = lane_id(); E(acc, cur, wr, wc, ln_ & 15, ln_ >> 4); }
        if (!has_next) break;
#pragma unroll
        for (int a = 0; a < 2; ++a)
#pragma unroll
            for (int b = 0; b < 2; ++b)
#pragma unroll
                for (int m = 0; m < 4; ++m)
#pragma unroll
                    for (int n = 0; n < 2; ++n) acc[a][b][m][n] = (f32x4){0.f, 0.f, 0.f, 0.f};
        cur = nxt; cA = nA; cB = nB; ++ui;
        if constexpr (GATHER) {
#pragma unroll
            for (int _h = 0; _h < 2; ++_h) { voC[_h][0] = voN[_h][0]; voC[_h][1] = voN[_h][1]; } }
        if (wr == 1) PG8_BAR;
    }
    PG8_WAIT_V(0);
    PG8_BAR;
#undef PG8_SA
#undef PG8_SB
#undef PG8_STAGE
#undef PG8_STAGE_A
#undef PG8_LDA
#undef PG8_LDB
#undef PG8_MMA
#undef PG8_WAIT_V
#undef PG8_WAIT_L
#undef PG8_BAR
#undef PG8_SCHED
#undef PG8_GATH
}
}

namespace pg8 {
struct EpiBf16Plain {
    static constexpr bool PERM = true;
    bf16_t* O; int ldc;
    __device__ __forceinline__ void operator()(const f32x4 (&acc)[2][2][4][2], const Unit& u, int wr, int wc, int fr, int fq) const {
        const int row0 = u.pm * BM + wr * 64 + fr, col0 = u.pn * BM + wc * 32 + 8 * fq;
#pragma unroll
        for (int ai = 0; ai < 2; ++ai)
#pragma unroll
            for (int m = 0; m < 4; ++m) { bf16_t* rowp = O + (size_t)(row0 + ai * HALF + m * 16) * ldc + col0;
#pragma unroll
                for (int bj = 0; bj < 2; ++bj) { const f32x4 v0 = acc[ai][bj][m][0], v1 = acc[ai][bj][m][1];
                    u32x4 w; w.x = cvt_pk_bf16(v0[0], v0[1]); w.y = cvt_pk_bf16(v0[2], v0[3]); w.z = cvt_pk_bf16(v1[0], v1[1]); w.w = cvt_pk_bf16(v1[2], v1[3]);
                    *(u32x4*)(rowp + bj * HALF) = w; } }
    }
};
struct EpiF32Plain {
    static constexpr bool PERM = false;
    float* C; int ldc;
    __device__ __forceinline__ void operator()(const f32x4 (&acc)[2][2][4][2], const Unit& u, int wr, int wc, int fr, int fq) const {
        const int row0 = u.pm * BM + wr * 64 + fr, col0 = u.pn * BM + wc * 32 + 4 * fq;
#pragma unroll
        for (int ai = 0; ai < 2; ++ai)
#pragma unroll
            for (int m = 0; m < 4; ++m) { float* rowp = C + (size_t)(row0 + ai * HALF + m * 16) * ldc + col0;
#pragma unroll
                for (int bj = 0; bj < 2; ++bj)
#pragma unroll
                    for (int n = 0; n < 2; ++n) *(f32x4*)(rowp + bj * HALF + n * 16) = acc[ai][bj][m][n]; }
    }
};
__device__ __forceinline__ void rope8(f32x4& v0, f32x4& v1, const float* cs) {
    const f32x4 a = *(const f32x4*)cs, b = *(const f32x4*)(cs + 4);
    const float x0 = v0[0], x1 = v0[1], x2 = v0[2], x3 = v0[3], y0 = v1[0], y1 = v1[1], y2 = v1[2], y3 = v1[3];
    v0[0] = x0 * a[0] - x1 * a[1]; v0[1] = x0 * a[1] + x1 * a[0];
    v0[2] = x2 * a[2] - x3 * a[3]; v0[3] = x2 * a[3] + x3 * a[2];
    v1[0] = y0 * b[0] - y1 * b[1]; v1[1] = y0 * b[1] + y1 * b[0];
    v1[2] = y2 * b[2] - y3 * b[3]; v1[3] = y2 * b[3] + y3 * b[2];
}
struct EpiQkvA {
    static constexpr bool PERM = true;
    bf16_t* O; const float* rope;
    __device__ __forceinline__ void operator()(const f32x4 (&acc)[2][2][4][2], const Unit& u, int wr, int wc, int fr, int fq) const {
        const int row0 = u.pm * BM + wr * 64 + fr, col0 = u.pn * BM + wc * 32 + 8 * fq;
        const bool do_rope = (u.pm < NL / 256) && (u.pn < 5);
#pragma unroll
        for (int ai = 0; ai < 2; ++ai)
#pragma unroll
            for (int m = 0; m < 4; ++m) { const int row = row0 + ai * HALF + m * 16; bf16_t* rowp = O + (size_t)row * A_IN + col0;
#pragma unroll
                for (int bj = 0; bj < 2; ++bj) { f32x4 v0 = acc[ai][bj][m][0], v1 = acc[ai][bj][m][1];
                    if (do_rope) { const int d = (col0 + bj * HALF) & 63; rope8(v0, v1, rope + ((size_t)(row & (SEQ - 1)) * 32 + (d >> 1)) * 2); }
                    u32x4 w; w.x = cvt_pk_bf16(v0[0], v0[1]); w.y = cvt_pk_bf16(v0[2], v0[3]); w.z = cvt_pk_bf16(v1[0], v1[1]); w.w = cvt_pk_bf16(v1[2], v1[3]);
                    *(u32x4*)(rowp + bj * HALF) = w; }
                asm volatile("" ::: "memory"); }
    }
};
struct EpiMlaUp {
    static constexpr bool PERM = true;
    bf16_t* O; const float* rope;
    __device__ __forceinline__ void operator()(const f32x4 (&acc)[2][2][4][2], const Unit& u, int wr, int wc, int fr, int fq) const {
        const int row0 = u.pm * BM + wr * 64 + fr, col0 = u.pn * BM + wc * 32 + 8 * fq;
        const bool qtile = (u.pm < NL / 256) && (u.pn < 6);
#pragma unroll
        for (int ai = 0; ai < 2; ++ai)
#pragma unroll
            for (int m = 0; m < 4; ++m) { const int row = row0 + ai * HALF + m * 16; bf16_t* rowp = O + (size_t)row * C_UPN + col0;
#pragma unroll
                for (int bj = 0; bj < 2; ++bj) { f32x4 v0 = acc[ai][bj][m][0], v1 = acc[ai][bj][m][1];
                    const int d96 = (col0 + bj * HALF) % 96;
                    if (qtile && d96 >= 64) rope8(v0, v1, rope + ((size_t)(row & (SEQ - 1)) * 16 + ((d96 - 64) >> 1)) * 2);
                    u32x4 w; w.x = cvt_pk_bf16(v0[0], v0[1]); w.y = cvt_pk_bf16(v0[2], v0[3]); w.z = cvt_pk_bf16(v1[0], v1[1]); w.w = cvt_pk_bf16(v1[2], v1[3]);
                    *(u32x4*)(rowp + bj * HALF) = w; }
                asm volatile("" ::: "memory"); }
    }
};
struct EpiResid {
    static constexpr bool PERM = false;
    float* XS; const float* gmod; float* XSo;
    __device__ __forceinline__ void operator()(const f32x4 (&acc)[2][2][4][2], const Unit& u, int wr, int wc, int fr, int fq) const {
        const int row0 = u.pm * BM + wr * 64 + fr, col0 = u.pn * BM + wc * 32 + 4 * fq;
        const int rb = u.pm < NL / 256 ? (u.pm >> 3) : 8;
        const float* gv = gmod + (size_t)rb * 6144 + col0;
        f32x4 gg[2][2];
#pragma unroll
        for (int bj = 0; bj < 2; ++bj)
#pragma unroll
            for (int n = 0; n < 2; ++n) gg[bj][n] = *(const f32x4*)(gv + bj * HALF + n * 16);
#pragma unroll
        for (int ai = 0; ai < 2; ++ai)
#pragma unroll
            for (int m = 0; m < 4; ++m) { float* rowp = XS + (size_t)(row0 + ai * HALF + m * 16) * D + col0;
#pragma unroll
                for (int bj = 0; bj < 2; ++bj)
#pragma unroll
                    for (int n = 0; n < 2; ++n) { const f32x4* p = (const f32x4*)(rowp + bj * HALF + n * 16); *(f32x4*)((float*)p + (XSo - XS)) = *p + gg[bj][n] * acc[ai][bj][m][n]; } }
    }
};
struct EpiSwiglu {
    static constexpr bool PERM = true;
    bf16_t* ACT; const float* bg; const float* bu;
    __device__ __forceinline__ void operator()(const f32x4 (&acc)[2][2][4][2], const Unit& u, int wr, int wc, int fr, int fq) const {
        const int row0 = u.pm * BM + wr * 64 + fr, col0 = u.pn * HALF + wc * 32 + 8 * fq;
        const float* pg = bg + (size_t)u.e * D + col0; const float* pu = bu + (size_t)u.e * D + col0;
        const f32x4 g0 = *(const f32x4*)pg, g1 = *(const f32x4*)(pg + 4), u0 = *(const f32x4*)pu, u1 = *(const f32x4*)(pu + 4);
#pragma unroll
        for (int ai = 0; ai < 2; ++ai)
#pragma unroll
            for (int m = 0; m < 4; ++m) { bf16_t* rowp = ACT + (size_t)(row0 + ai * HALF + m * 16) * D + col0;
                float r[8];
#pragma unroll
                for (int n = 0; n < 2; ++n)
#pragma unroll
                    for (int j = 0; j < 4; ++j) {
                        float g = acc[ai][0][m][n][j] + (n ? g1[j] : g0[j]); float uu = acc[ai][1][m][n][j] + (n ? u1[j] : u0[j]);
                        g = fminf(g, 7.0f); uu = fminf(fmaxf(uu, -7.0f), 7.0f);
                        const float sg = __builtin_amdgcn_rcpf(1.0f + __builtin_amdgcn_exp2f(-1.702f * LOG2E * g));
                        r[n * 4 + j] = g * sg * (uu + 1.0f); }
                u32x4 w; w.x = cvt_pk_bf16(r[0], r[1]); w.y = cvt_pk_bf16(r[2], r[3]); w.z = cvt_pk_bf16(r[4], r[5]); w.w = cvt_pk_bf16(r[6], r[7]);
                *(u32x4*)rowp = w; }
    }
};
struct EpiDown {
    static constexpr bool PERM = true;
    bf16_t* YS; const float* bd;
    __device__ __forceinline__ void operator()(const f32x4 (&acc)[2][2][4][2], const Unit& u, int wr, int wc, int fr, int fq) const {
        const int row0 = u.pm * BM + wr * 64 + fr, col0 = u.pn * BM + wc * 32 + 8 * fq;
        const float* pb = bd + (size_t)u.e * D + col0;
        f32x4 bv[2][2];
#pragma unroll
        for (int bj = 0; bj < 2; ++bj)
#pragma unroll
            for (int n = 0; n < 2; ++n) bv[bj][n] = *(const f32x4*)(pb + bj * HALF + 4 * n);
#pragma unroll
        for (int ai = 0; ai < 2; ++ai)
#pragma unroll
            for (int m = 0; m < 4; ++m) { bf16_t* rowp = YS + (size_t)(row0 + ai * HALF + m * 16) * D + col0;
#pragma unroll
                for (int bj = 0; bj < 2; ++bj) { const f32x4 v0 = acc[ai][bj][m][0] + bv[bj][0], v1 = acc[ai][bj][m][1] + bv[bj][1];
                    u32x4 w; w.x = cvt_pk_bf16(v0[0], v0[1]); w.y = cvt_pk_bf16(v0[2], v0[3]); w.z = cvt_pk_bf16(v1[0], v1[1]); w.w = cvt_pk_bf16(v1[2], v1[3]);
                    *(u32x4*)(rowp + bj * HALF) = w; } }
    }
};

struct DenseOrder {
    int nM, nN, vcu, xM, xN0, xNn;
    __device__ __forceinline__ bool short_one() const { const int U = nM * nN + xM * xNn, R = (U + 255) >> 8; return (U & 255) != 0 && vcu >= U - (R - 1) * 256; }
    __device__ __forceinline__ bool next(int i, Unit& u) const {
        int L = i * 256 + vcu; const int nmain = nM * nN;
        if (L < nmain) { const int nig = 8 * nN, gid = L / nig, fm = gid * 8, rem = nM - fm, gsz = rem < 8 ? rem : 8, w = L % nig; u.pm = fm + w % gsz; u.pn = w / gsz; }
        else { L -= nmain; if (L >= xM * xNn) return false; u.pm = nM + L % xM; u.pn = xN0 + L / xM; }
        u.e = 0; u.mt = 0; u.cnt = 0; return true;
    }
};
struct MoeOrder {
    const LAS int* ecnt; const LAS int* lbase; const LAS int* cumt; int nN, vcu;
    __device__ __forceinline__ bool short_one() const { const int U = cumt[32] * nN, R = (U + 255) >> 8; return (U & 255) != 0 && vcu >= U - (R - 1) * 256; }
    __device__ __forceinline__ bool next(int i, Unit& u) const {
        const int L = i * 256 + vcu;
        if (L >= cumt[32] * nN) return false;
        int e = 0;
        while (cumt[e + 1] * nN <= L) ++e;
        e = __builtin_amdgcn_readfirstlane(e);
        const int r = L - cumt[e] * nN, c = ecnt[e], mte = (c + 255) >> 8;
        u.e = e; u.pn = r / mte; u.mt = r % mte; u.pm = (lbase[e] >> 8) + u.mt; u.cnt = c; return true;
    }
};
}

namespace att {
constexpr int VSTR = 144;
template <int DQK> struct Cfg { static constexpr int KSTR = DQK * 2 + 16, KB = 64 * KSTR, VB = 64 * VSTR, STAGE = KB + VB, CPR = DQK / 8, NKS = DQK / 16; };
__device__ __forceinline__ int crow(int r, int hi) { return (r & 3) + 8 * (r >> 2) + 4 * hi; }

template <int DQK, bool MLA>
__device__ __forceinline__ void fetch(u32x4 (&r)[3], const bf16_t* Kb, const bf16_t* Vb, const bf16_t* KRb, int pitch, int row0, int tid) {
    typedef Cfg<DQK> C;
    { const int key = tid / C::CPR, ch = tid % C::CPR;
      const bf16_t* src = (MLA && ch >= 8) ? KRb + (size_t)(row0 + key) * 32 + (ch - 8) * 8 : Kb + (size_t)(row0 + key) * pitch + ch * 8;
      r[0] = *(const u32x4*)src; }
    if constexpr (DQK == 96) { if (tid < 256) { const int c = 512 + tid, key = c / C::CPR, ch = c % C::CPR;
      const bf16_t* src = (MLA && ch >= 8) ? KRb + (size_t)(row0 + key) * 32 + (ch - 8) * 8 : Kb + (size_t)(row0 + key) * pitch + ch * 8;
      r[1] = *(const u32x4*)src; } }
    { const int key = tid >> 3, ch = tid & 7; r[2] = *(const u32x4*)(Vb + (size_t)(row0 + key) * pitch + ch * 8); }
}
template <int DQK>
__device__ __forceinline__ void stash(LAS unsigned char* st, const u32x4 (&r)[3], int tid) {
    typedef Cfg<DQK> C;
    { const int key = tid / C::CPR, ch = tid % C::CPR; *(LAS u32x4*)(st + key * C::KSTR + ch * 16) = r[0]; }
    if constexpr (DQK == 96) { if (tid < 256) { const int c = 512 + tid, key = c / C::CPR, ch = c % C::CPR; *(LAS u32x4*)(st + key * C::KSTR + ch * 16) = r[1]; } }
    { const int key = tid >> 3, ch = tid & 7; *(LAS u32x4*)(st + C::KB + key * VSTR + ch * 16) = r[2]; }
}
template <int DQK>
__device__ __forceinline__ f32x16 qk(const LAS unsigned char* kst, int koff, const bf16x8 (&qr)[DQK / 16], int r32, int hi) {
    typedef Cfg<DQK> C;
    f32x16 p;
#pragma unroll
    for (int r = 0; r < 16; ++r) p[r] = 0.f;
    const LAS unsigned char* kb = kst + (koff + r32) * C::KSTR + hi * 16;
#pragma unroll
    for (int ks = 0; ks < C::NKS; ++ks) { const bf16x8 kf = *(const LAS bf16x8*)(kb + ks * 32); p = __builtin_amdgcn_mfma_f32_32x32x16_bf16(kf, qr[ks], p, 0, 0, 0); }
    return p;
}
__device__ __forceinline__ s16x4 vtr(const LAS unsigned char* p) { return __builtin_bit_cast(s16x4, __builtin_amdgcn_ds_read_tr16_b64_v4i16((LAS s16x4*)p)); }
template <int NS>
__device__ __forceinline__ void sm_pv(f32x16 (&t)[NS], const LAS unsigned char* vst, const int (&voff)[NS], f32x16 (&o)[2], float& m, float& l, int lane) {
    const int hi = lane >> 5;
    float mx = t[0][0];
#pragma unroll
    for (int s = 0; s < NS; ++s)
#pragma unroll
        for (int r = 0; r < 16; ++r) mx = fmaxf(mx, t[s][r]);
    mx = swap32_max(mx);
    if (__any(mx > m + 8.0f)) { const float mn = fmaxf(m, mx); const float a = __builtin_amdgcn_exp2f(m - mn); m = mn; l *= a;
#pragma unroll
        for (int r = 0; r < 16; ++r) { o[0][r] *= a; o[1][r] *= a; } }
    float rs = 0.f;
#pragma unroll
    for (int s = 0; s < NS; ++s)
#pragma unroll
        for (int r = 0; r < 16; ++r) { t[s][r] = __builtin_amdgcn_exp2f(t[s][r] - m); rs += t[s][r]; }
    l += rs;
    const int q4 = (lane & 15) >> 2, p4 = lane & 3, blk = (lane >> 4) & 1;
#pragma unroll
    for (int s = 0; s < NS; ++s) {
        const LAS unsigned char* vb = vst + (voff[s] + 4 * hi + q4) * VSTR + (16 * blk + 4 * p4) * 2;
#pragma unroll
        for (int kk = 0; kk < 2; ++kk) {
            u32x4 pw; pw.x = cvt_pk_bf16(t[s][8 * kk + 0], t[s][8 * kk + 1]); pw.y = cvt_pk_bf16(t[s][8 * kk + 2], t[s][8 * kk + 3]);
            pw.z = cvt_pk_bf16(t[s][8 * kk + 4], t[s][8 * kk + 5]); pw.w = cvt_pk_bf16(t[s][8 * kk + 6], t[s][8 * kk + 7]);
            const bf16x8 pb = __builtin_bit_cast(bf16x8, pw);
#pragma unroll
            for (int c = 0; c < 2; ++c) {
                const s16x4 lo = vtr(vb + (16 * kk) * VSTR + c * 64), h8 = vtr(vb + (16 * kk + 8) * VSTR + c * 64);
                const bf16x8 va = (bf16x8){lo[0], lo[1], lo[2], lo[3], h8[0], h8[1], h8[2], h8[3]};
                o[c] = __builtin_amdgcn_mfma_f32_32x32x16_bf16(va, pb, o[c], 0, 0, 0);
            }
        }
    }
}
__device__ __forceinline__ void finalize(const f32x16 (&o)[2], float l, bf16_t* orow, int hi) {
    l = swap32_sum(l); const float inv = 1.0f / l;
#pragma unroll
    for (int c = 0; c < 2; ++c)
#pragma unroll
        for (int g = 0; g < 4; ++g) { u32x2 w; w.x = cvt_pk_bf16(o[c][4 * g] * inv, o[c][4 * g + 1] * inv); w.y = cvt_pk_bf16(o[c][4 * g + 2] * inv, o[c][4 * g + 3] * inv);
            *(u32x2*)(orow + 32 * c + 8 * g + 4 * hi) = w; }
}
#define ATT_PIPE_BEGIN(DQK, MLA, ROW0_OF) \
    u32x4 pre[3]; pre[1] = (u32x4){0u, 0u, 0u, 0u}; \
    fetch<DQK, MLA>(pre, Kb, Vb, KRb, pitch, ROW0_OF(0), tid); stash<DQK>(lds, pre, tid); __syncthreads(); \
    for (int i = 0; i < ntiles; ++i) { \
        if (i + 1 < ntiles) fetch<DQK, MLA>(pre, Kb, Vb, KRb, pitch, ROW0_OF(i + 1), tid); \
        const LAS unsigned char* kst = lds + (i & 1) * Cfg<DQK>::STAGE; const LAS unsigned char* vst = kst + Cfg<DQK>::KB;
#define ATT_PIPE_END(DQK) \
        if (i + 1 < ntiles) stash<DQK>(lds + ((i + 1) & 1) * Cfg<DQK>::STAGE, pre, tid); \
        __syncthreads(); }

__device__ __forceinline__ void attn_A_unit(LAS unsigned char* lds, const bf16_t* QKV, bf16_t* O, const float* sink, int b, int kvh, int qb, bool ctxq, int tid) {
    const int lane = tid & 63, wid = __builtin_amdgcn_readfirstlane(tid >> 6), r32 = lane & 31, hi = lane >> 5;
    const int head = kvh * 4 + (wid >> 1), qoff = 32 * (wid & 1) + r32, t0 = qb * 64;
    const int qrow = ctxq ? NL + b * CTXL + t0 + qoff : b * SEQ + t0 + qoff;
    bf16x8 qr[4];
    { const bf16_t* qp = QKV + (size_t)qrow * A_IN + head * 64 + hi * 8;
#pragma unroll
      for (int ks = 0; ks < 4; ++ks) qr[ks] = *(const bf16x8*)(qp + ks * 16); }
    int jlo = 0, nloc = 0;
    if (!ctxq) { jlo = t0 >= 128 ? 0 : (t0 == 64 ? 1 : 2); int jhi = (2112 - t0) / 64; jhi = jhi > 4 ? 4 : jhi; nloc = jhi - jlo + 1; }
    const int ntiles = 4 + nloc, cbase = NL + b * CTXL, lbase = b * SEQ + t0 - 128 + 64 * jlo;
    const bf16_t* Kb = QKV + 1024 + kvh * 64; const bf16_t* Vb = QKV + 1280 + kvh * 64; const bf16_t* KRb = nullptr; const int pitch = A_IN;
    float m = sink[head] * LOG2E, l = hi ? 0.f : 1.f;
    f32x16 o[2];
#pragma unroll
    for (int r = 0; r < 16; ++r) { o[0][r] = 0.f; o[1][r] = 0.f; }
    const float sc = 0.125f * LOG2E;
#define A_ROW0(i) ((i) < 4 ? cbase + 64 * (i) : lbase + 64 * ((i) - 4))
    ATT_PIPE_BEGIN(64, false, A_ROW0)
        f32x16 t[2];
        t[0] = qk<64>(kst, 0, qr, r32, hi); t[1] = qk<64>(kst, 32, qr, r32, hi);
        const int j = i < 4 ? 2 : jlo + i - 4;
#pragma unroll
        for (int s = 0; s < 2; ++s)
#pragma unroll
            for (int r = 0; r < 16; ++r) { const int kk = 32 * s + crow(r, hi); float v = t[s][r] * sc;
                if (j == 0 && kk < qoff) v = -1e30f;
                if (j == 4 && kk > qoff) v = -1e30f;
                t[s][r] = v; }
        const int voff[2] = {0, 32};
        sm_pv<2>(t, vst, voff, o, m, l, lane);
    ATT_PIPE_END(64)
#undef A_ROW0
    finalize(o, l, O + (size_t)qrow * D + head * 64, hi);
}

__device__ __forceinline__ void attn_B_unit(LAS unsigned char* lds, LAS float* tab, const bf16_t* QKV, bf16_t* O, const float* rpb, int b, int h, int rq, bool ctxq, int tid) {
    const int lane = tid & 63, wid = __builtin_amdgcn_readfirstlane(tid >> 6), r32 = lane & 31, hi = lane >> 5;
    const int jb = wid & 3, rp = wid >> 2;
    const int rqa = 4 * rq + 2 * rp + (r32 >> 4), qcol = 16 * jb + (r32 & 15);
    const int qrow = ctxq ? NL + b * CTXL + 32 * wid + r32 : b * SEQ + rqa * 64 + qcol;
    for (int idx = tid; idx < 15 * 31; idx += 512) tab[(idx / 31) * 32 + idx % 31] = rpb[h * 465 + idx] * LOG2E;
    bf16x8 qr[4];
    { const bf16_t* qp = QKV + (size_t)qrow * B_IN + h * 64 + hi * 8;
#pragma unroll
      for (int ks = 0; ks < 4; ++ks) qr[ks] = *(const bf16x8*)(qp + ks * 16); }
    int klo = 0, nloc = 0;
    if (!ctxq) { klo = 4 * rq - 4; klo = klo < 0 ? 0 : (klo > 24 ? 24 : klo); int khi = 4 * rq - 1; khi = khi < 0 ? 0 : (khi > 24 ? 24 : khi); khi += 7; nloc = khi - klo + 1; }
    const int ntiles = 4 + nloc, cbase = NL + b * CTXL, lbase = b * SEQ;
    int r0q = rqa - 4; r0q = r0q < 0 ? 0 : (r0q > 24 ? 24 : r0q);
    int wst = qcol - 8; wst = wst < 0 ? 0 : (wst > 48 ? 48 : wst);
    int cst = 16 * jb - 8; cst = cst < 0 ? 0 : (cst > 32 ? 32 : cst);
    const int lo = wst - cst;
    int wr0 = 4 * rq + 2 * rp - 4; wr0 = wr0 < 0 ? 0 : (wr0 > 24 ? 24 : wr0);
    int wr1 = 4 * rq + 2 * rp + 1 - 4; wr1 = wr1 < 0 ? 0 : (wr1 > 24 ? 24 : wr1); wr1 += 7;
    const bf16_t* Kb = QKV + 1024 + h * 64; const bf16_t* Vb = QKV + 2048 + h * 64; const bf16_t* KRb = nullptr; const int pitch = B_IN;
    float m = -1e30f, l = 0.f;
    f32x16 o[2];
#pragma unroll
    for (int r = 0; r < 16; ++r) { o[0][r] = 0.f; o[1][r] = 0.f; }
    const float sc = 0.125f * LOG2E;
#define B_ROW0(i) ((i) < 4 ? cbase + 64 * (i) : lbase + 64 * (klo + (i) - 4))
    ATT_PIPE_BEGIN(64, false, B_ROW0)
        if (i < 4) {
            f32x16 t[2];
            t[0] = qk<64>(kst, 0, qr, r32, hi); t[1] = qk<64>(kst, 32, qr, r32, hi);
#pragma unroll
            for (int s = 0; s < 2; ++s)
#pragma unroll
                for (int r = 0; r < 16; ++r) t[s][r] *= sc;
            const int voff[2] = {0, 32};
            sm_pv<2>(t, vst, voff, o, m, l, lane);
        } else {
            const int kr = klo + i - 4;
            if (kr >= wr0 && kr <= wr1) {
                f32x16 t[1];
                t[0] = qk<64>(kst, cst, qr, r32, hi);
                const bool rowok = (kr >= r0q) && (kr < r0q + 8);
                const int bidx0 = (kr - rqa + 7) * 32 + cst - qcol + 15;
#pragma unroll
                for (int r = 0; r < 16; ++r) { const int kidx = crow(r, hi); const bool ok = rowok && ((unsigned)(kidx - lo) < 16u);
                    int bi = bidx0 + kidx; bi = bi < 0 ? 0 : (bi > 479 ? 479 : bi);
                    const float bias = tab[bi];
                    t[0][r] = ok ? t[0][r] * sc + bias : -1e30f; }
                const int voff[1] = {cst};
                sm_pv<1>(t, vst, voff, o, m, l, lane);
            }
        }
    ATT_PIPE_END(64)
#undef B_ROW0
    finalize(o, l, O + (size_t)qrow * D + h * 64, hi);
}

__device__ __forceinline__ void attn_C_unit(LAS unsigned char* lds, const bf16_t* Q2, const bf16_t* KR, bf16_t* O, int b, int h, int qb, bool ctxq, int tid) {
    const int lane = tid & 63, wid = __builtin_amdgcn_readfirstlane(tid >> 6), r32 = lane & 31, hi = lane >> 5;
    const int qrow = ctxq ? NL + b * CTXL + 32 * wid + r32 : b * SEQ + qb * 256 + 32 * wid + r32;
    bf16x8 qr[6];
    { const bf16_t* qp = Q2 + (size_t)qrow * C_UPN + h * 96 + hi * 8;
#pragma unroll
      for (int ks = 0; ks < 6; ++ks) qr[ks] = *(const bf16x8*)(qp + ks * 16); }
    const int ntiles = ctxq ? 4 : 36, cbase = NL + b * CTXL, lbase = b * SEQ;
    const bf16_t* Kb = Q2 + 1536 + h * 128; const bf16_t* Vb = Kb + 64; const bf16_t* KRb = KR; const int pitch = C_UPN;
    float m = -1e30f, l = 0.f;
    f32x16 o[2];
#pragma unroll
    for (int r = 0; r < 16; ++r) { o[0][r] = 0.f; o[1][r] = 0.f; }
    const float sc = 0.10206207261596575f * LOG2E;
#define C_ROW0(i) ((i) < 4 ? cbase + 64 * (i) : lbase + 64 * ((i) - 4))
    ATT_PIPE_BEGIN(96, true, C_ROW0)
        f32x16 t[2];
        t[0] = qk<96>(kst, 0, qr, r32, hi); t[1] = qk<96>(kst, 32, qr, r32, hi);
#pragma unroll
        for (int s = 0; s < 2; ++s)
#pragma unroll
            for (int r = 0; r < 16; ++r) t[s][r] *= sc;
        const int voff[2] = {0, 32};
        sm_pv<2>(t, vst, voff, o, m, l, lane);
    ATT_PIPE_END(96)
#undef C_ROW0
    finalize(o, l, O + (size_t)qrow * D + h * 64, hi);
}
}

struct Row4 { f32x4 v[4]; };
__device__ __forceinline__ void row_load(Row4& x, const float* p, int lane) {
#pragma unroll
    for (int j = 0; j < 4; ++j) x.v[j] = *(const f32x4*)(p + 4 * lane + 256 * j);
}
__device__ __forceinline__ void row_store(const Row4& x, float* p, int lane) {
#pragma unroll
    for (int j = 0; j < 4; ++j) *(f32x4*)(p + 4 * lane + 256 * j) = x.v[j];
}
__device__ __forceinline__ float row_rstd(const Row4& x, int lane) {
    float s = 0.f;
#pragma unroll
    for (int j = 0; j < 4; ++j) s += (x.v[j][0] * x.v[j][0] + x.v[j][1] * x.v[j][1]) + (x.v[j][2] * x.v[j][2] + x.v[j][3] * x.v[j][3]);
    s = wave_sum(s, lane);
    return 1.0f / sqrtf(s * (1.0f / D) + NORM_EPS);
}
__device__ __forceinline__ void norm_mod(const Row4& x, float rstd, const float* g, const float* sh, const float* sc, bf16_t* out, int lane, Row4& hv) {
#pragma unroll
    for (int j = 0; j < 4; ++j) { const int c = 4 * lane + 256 * j;
        const f32x4 gg = *(const f32x4*)(g + c), s1 = *(const f32x4*)(sc + c), s0 = *(const f32x4*)(sh + c);
        const f32x4 h = (x.v[j] * rstd * gg) * (s1 + 1.0f) + s0; hv.v[j] = h;
        u32x2 w; w.x = cvt_pk_bf16(h[0], h[1]); w.y = cvt_pk_bf16(h[2], h[3]); *(u32x2*)(out + c) = w; }
}

struct Ptrs {
    const float* in[29]; float* out; unsigned char* ws;
};
typedef const __attribute__((address_space(4))) Ptrs* PK;
#define WSP(T, off) ((T*)(P->ws + (off)))

__device__ __forceinline__ unsigned pk_f16(float a, float b) { const f32x2 v = {a, b}; const f16x2 h = __builtin_convertvector(v, f16x2); return __builtin_bit_cast(unsigned, h); }
__device__ __forceinline__ void phase_first_norm(PK P, int gw, int lane) {
    const float* MOD = WSP(const float, WS_MOD);
    {
        const int gt = gw * 64 + lane;
        for (int q = gt; q < DEPTH * 9 * 4096; q += 131072) { const int lb = q >> 12, cc = q & 4095, c = cc >> 5, e = cc & 31, l = lb / 9, b = lb - 9 * l;
            const float* g = P->in[7] + (size_t)l * D + 8 * c; const float* sc = MOD + ((size_t)l * 9 + b) * 6144 + 4096 + 8 * c; const float* w = P->in[21] + ((size_t)l * D + 8 * c) * NEXP + e;
            float v[8];
#pragma unroll
            for (int j = 0; j < 8; ++j) v[j] = g[j] * (1.0f + sc[j]) * w[j * NEXP];
            u32x4 o; o.x = pk_f16(v[0], v[1]); o.y = pk_f16(v[2], v[3]); o.z = pk_f16(v[4], v[5]); o.w = pk_f16(v[6], v[7]);
            *(u32x4*)(WSP(unsigned char, WS_G16) + (size_t)lb * 65536 + e * 2048 + ((c ^ (e & 15)) * 16)) = o; }
        for (int q = gw; q < DEPTH * 9 * 32; q += 2048) { const int lb = q >> 5, e = q & 31, l = lb / 9, b = lb - 9 * l;
            const float* sh = MOD + ((size_t)l * 9 + b) * 6144 + 3072; const float* w = P->in[21] + (size_t)l * D * NEXP + e; float t = 0.f;
#pragma unroll
            for (int j = 0; j < 16; ++j) { const int k = lane + 64 * j; t += sh[k] * w[(size_t)k * NEXP]; }
            t = wave_sum(t, lane);
            if (lane == 0) WSP(float, WS_RC)[q] = t + P->in[22][l * NEXP + e]; }
    }
    for (int r = gw; r < NT; r += 2048) {
        const float* src = r < NL ? P->in[0] + (size_t)r * D : P->in[2] + (size_t)(r - NL) * D;
        Row4 x, hv; row_load(x, src, lane); row_store(x, WSP(float, WS_XS) + (size_t)r * D, lane);
        const float rstd = row_rstd(x, lane); const int rb = r < NL ? (r >> 11) : 8; const float* mod = MOD + (size_t)rb * 6144;
        norm_mod(x, rstd, P->in[6], mod, mod + 1024, WSP(bf16_t, WS_H) + (size_t)r * D, lane, hv);
    }
}
__device__ __forceinline__ void phase_mla_norm(PK P, int gw, int lane) {
    const float* Y = WSP(const float, WS_Y416); bf16_t* CQ = WSP(bf16_t, WS_CQKV); bf16_t* KR = WSP(bf16_t, WS_KR);
    const float* qn = P->in[16]; const float* kn = P->in[17]; const float* rope = WSP(const float, WS_ROPE_C);
    for (int r = gw; r < NT; r += 2048) {
        const float* y = Y + (size_t)r * C_INP;
        const f32x4 v = *(const f32x4*)(y + 4 * lane);
        const float ss = wave_sum((v[0] * v[0] + v[1] * v[1]) + (v[2] * v[2] + v[3] * v[3]), lane);
        const float rq = 1.0f / sqrtf(ss * (1.0f / 256.0f) + NORM_EPS);
        const f32x4 g = *(const f32x4*)(qn + 4 * lane);
        u32x2 w; w.x = cvt_pk_bf16(v[0] * rq * g[0], v[1] * rq * g[1]); w.y = cvt_pk_bf16(v[2] * rq * g[2], v[3] * rq * g[3]);
        *(u32x2*)(CQ + (size_t)r * C_UPK + 4 * lane) = w;
        const f32x2 k2 = *(const f32x2*)(y + 256 + 2 * lane);
        const float s2 = wave_sum(k2[0] * k2[0] + k2[1] * k2[1], lane);
        const float rk = 1.0f / sqrtf(s2 * (1.0f / 128.0f) + NORM_EPS);
        const f32x2 g2 = *(const f32x2*)(kn + 2 * lane);
        *(unsigned*)(CQ + (size_t)r * C_UPK + 256 + 2 * lane) = cvt_pk_bf16(k2[0] * rk * g2[0], k2[1] * rk * g2[1]);
        if (lane < 16) { f32x2 p = *(const f32x2*)(y + 384 + 2 * lane);
            if (r < NL) { const f32x2 cs = *(const f32x2*)(rope + ((size_t)(r & (SEQ - 1)) * 16 + lane) * 2); const float a = p[0], b = p[1]; p[0] = a * cs[0] - b * cs[1]; p[1] = a * cs[1] + b * cs[0]; }
            *(unsigned*)(KR + (size_t)r * 32 + 2 * lane) = cvt_pk_bf16(p[0], p[1]); }
    }
}
__device__ __forceinline__ void moe_tables(LAS unsigned char* misc, unsigned* gcnt, int tid) {
    LAS int* ecnt = (LAS int*)(misc + M_ECNT); LAS int* lbase = (LAS int*)(misc + M_LBASE); LAS int* cumt = (LAS int*)(misc + M_CUMT);
    if (tid < 32) ecnt[tid] = (int)__hip_atomic_load(gcnt + tid * 16, __ATOMIC_RELAXED, __HIP_MEMORY_SCOPE_AGENT);
    __syncthreads();
    if (tid == 0) { int s = 0, t = 0; for (int e = 0; e < 32; ++e) { lbase[e] = s; cumt[e] = t; const int mt = (ecnt[e] + 255) >> 8; s += mt * 256; t += mt; } cumt[32] = t; }
    __syncthreads();
}
constexpr int RT_PLOG = 65536, RT_LOGIT = 98304, RT_SSQ = 102912, RT_RSTD = 103936, RT_CVEC = 104064;
__device__ __forceinline__ void phase_router(PK P, LAS unsigned char* lds, int l, int nrows, int vcu, int tid, int cset) {
    const int lane = tid & 63, wid = __builtin_amdgcn_readfirstlane(tid >> 6), i32 = lane & 31, hi = lane >> 5;
    LAS unsigned char* misc = lds + MISC_OFF;
    LAS int* lcnt = (LAS int*)(misc + M_LCNT); LAS int* gbase = (LAS int*)(misc + M_GBASE); LAS int* rec = (LAS int*)(misc + M_REC);
    LAS float* plog = (LAS float*)(lds + RT_PLOG); LAS float* logit = (LAS float*)(lds + RT_LOGIT); LAS float* ssq = (LAS float*)(lds + RT_SSQ);
    LAS float* rstd_s = (LAS float*)(lds + RT_RSTD); LAS float* cvec = (LAS float*)(lds + RT_CVEC);
    const bool last = (nrows == NL);
    const int nb = (!last && vcu < 64) ? 3 : 2;
    const float* MOD = WSP(const float, WS_MOD) + (size_t)l * 9 * 6144;
    float* XS = WSP(float, WS_XS); bf16_t* H = WSP(bf16_t, WS_H);
    int* TOPE = WSP(int, WS_TOPE); float* GATE = WSP(float, WS_GATE);
    const float* gn = P->in[7] + (size_t)l * D;
    if (tid < 32) lcnt[tid] = 0;
    for (int bi = 0; bi < nb; ++bi) {
        const int rb = bi < 2 ? (vcu >> 5) : 8;
        const int row0 = bi < 2 ? 64 * vcu + 32 * bi : NL + 32 * vcu;
        if (bi != 1) {
            __syncthreads();
            const u32x4* gsrc = (const u32x4*)(WSP(const unsigned char, WS_G16) + (size_t)(l * 9 + rb) * 65536);
#pragma unroll
            for (int c = 0; c < 8; ++c) *(LAS u32x4*)(lds + (size_t)(tid + 512 * c) * 16) = gsrc[tid + 512 * c];
            if (tid < 32) cvec[tid] = WSP(const float, WS_RC)[(l * 9 + rb) * 32 + tid];
            __syncthreads();
        }
        const int r = row0 + i32; const float* xp = XS + (size_t)r * D + 128 * wid + 8 * hi;
        f32x4 xa[8], xb[8];
#pragma unroll
        for (int s = 0; s < 8; ++s) { xa[s] = *(const f32x4*)(xp + 16 * s); xb[s] = *(const f32x4*)(xp + 16 * s + 4); }
        float ss = 0.f;
        f32x16 acc;
#pragma unroll
        for (int q = 0; q < 16; ++q) acc[q] = 0.f;
#pragma unroll
        for (int s = 0; s < 8; ++s) {
            ss += (xa[s][0] * xa[s][0] + xa[s][1] * xa[s][1]) + (xa[s][2] * xa[s][2] + xa[s][3] * xa[s][3]) + (xb[s][0] * xb[s][0] + xb[s][1] * xb[s][1]) + (xb[s][2] * xb[s][2] + xb[s][3] * xb[s][3]);
            u32x4 aw; aw.x = pk_f16(xa[s][0], xa[s][1]); aw.y = pk_f16(xa[s][2], xa[s][3]); aw.z = pk_f16(xb[s][0], xb[s][1]); aw.w = pk_f16(xb[s][2], xb[s][3]);
            const int c = 16 * wid + 2 * s + hi;
            const f16x8 bf = *(const LAS f16x8*)(lds + i32 * 2048 + ((c ^ (i32 & 15)) * 16));
            acc = __builtin_amdgcn_mfma_f32_32x32x16_f16(__builtin_bit_cast(f16x8, aw), bf, acc, 0, 0, 0);
        }
        ss = swap32_sum(ss);
        if (hi == 0) ssq[wid * 32 + i32] = ss;
#pragma unroll
        for (int q = 0; q < 16; ++q) plog[(wid * 32 + att::crow(q, hi)) * 32 + i32] = acc[q];
        __syncthreads();
        if (tid < 32) { float t = 0.f;
#pragma unroll
            for (int w = 0; w < 8; ++w) t += ssq[w * 32 + tid];
            rstd_s[tid] = 1.0f / sqrtf(t * (1.0f / D) + NORM_EPS); }
        __syncthreads();
#pragma unroll
        for (int u = 0; u < 2; ++u) { const int idx = tid + 512 * u, rr = idx >> 5, e = idx & 31; float t = 0.f;
#pragma unroll
            for (int w = 0; w < 8; ++w) t += plog[(w * 32 + rr) * 32 + e];
            logit[rr * 33 + e] = rstd_s[rr] * t + cvec[e]; }
        { const float rs = rstd_s[i32]; const float* mod = MOD + (size_t)rb * 6144; const int k0 = 128 * wid + 8 * hi; bf16_t* hp = H + (size_t)r * D + k0;
#pragma unroll
          for (int s = 0; s < 8; ++s) { const int k = k0 + 16 * s;
              const f32x4 g0 = *(const f32x4*)(gn + k), g1 = *(const f32x4*)(gn + k + 4), c0 = *(const f32x4*)(mod + 4096 + k), c1 = *(const f32x4*)(mod + 4096 + k + 4);
              const f32x4 s0 = *(const f32x4*)(mod + 3072 + k), s1 = *(const f32x4*)(mod + 3072 + k + 4);
              const f32x4 h0 = (xa[s] * rs * g0) * (c0 + 1.0f) + s0, h1 = (xb[s] * rs * g1) * (c1 + 1.0f) + s1;
              u32x4 w; w.x = cvt_pk_bf16(h0[0], h0[1]); w.y = cvt_pk_bf16(h0[2], h0[3]); w.z = cvt_pk_bf16(h1[0], h1[1]); w.w = cvt_pk_bf16(h1[2], h1[3]);
              *(u32x4*)(hp + 16 * s) = w; } }
        __syncthreads();
        if (tid < 32) {
            float t0 = -INFINITY, t1 = -INFINITY, t2 = -INFINITY, t3 = -INFINITY; int e0 = 0, e1 = 0, e2 = 0, e3 = 0;
#pragma unroll 4
            for (int e = 0; e < 32; ++e) { const float v = logit[tid * 33 + e];
                if (v > t3) { if (v > t2) { t3 = t2; e3 = e2; if (v > t1) { t2 = t1; e2 = e1; if (v > t0) { t1 = t0; e1 = e0; t0 = v; e0 = e; } else { t1 = v; e1 = e; } } else { t2 = v; e2 = e; } } else { t3 = v; e3 = e; } } }
            const float x1 = __expf(t1 - t0), x2 = __expf(t2 - t0), x3 = __expf(t3 - t0); const float inv = 1.0f / (1.0f + x1 + x2 + x3);
            const int rr = row0 + tid, lr = 32 * bi + tid;
            *(int4*)(TOPE + (size_t)rr * 4) = make_int4(e0, e1, e2, e3);
            *(f32x4*)(GATE + (size_t)rr * 4) = (f32x4){inv, x1 * inv, x2 * inv, x3 * inv};
            const int ee[4] = {e0, e1, e2, e3};
#pragma unroll
            for (int k = 0; k < 4; ++k) { const int lp = __hip_atomic_fetch_add(lcnt + ee[k], 1, __ATOMIC_RELAXED, __HIP_MEMORY_SCOPE_WORKGROUP); rec[2 * (lr * 4 + k)] = ee[k]; rec[2 * (lr * 4 + k) + 1] = lp; }
        }
    }
    __syncthreads();
    unsigned* gcnt = WSP(unsigned, WS_CTL) + CW_CNT + (l * 2 + cset) * 512;
    if (tid < 32) { const int c = lcnt[tid]; gbase[tid] = c ? (int)__hip_atomic_fetch_add(gcnt + tid * 16, (unsigned)c, __ATOMIC_RELAXED, __HIP_MEMORY_SCOPE_AGENT) : 0; }
    __syncthreads();
    int* ELIST = WSP(int, WS_ELIST); int* POS = WSP(int, WS_POS);
    for (int idx = tid; idx < nb * 128; idx += 512) { const int e = rec[2 * idx], pos = gbase[e] + rec[2 * idx + 1]; const int lr = idx >> 2; const int r = lr < 64 ? 64 * vcu + lr : NL + 32 * vcu + (lr - 64);
        ELIST[(size_t)e * NT + pos] = r; POS[(size_t)r * 4 + (idx & 3)] = pos; }
    __syncthreads();
}
__device__ __forceinline__ void phase_combine(PK P, LAS unsigned char* lds, int l, int nrows, int gw, int tid, bool dry) {
    const int lane = tid & 63;
    LAS unsigned char* misc = lds + MISC_OFF;
    moe_tables(misc, WSP(unsigned, WS_CTL) + CW_CNT + (l * 2 + ((MK_REP_MASK >> 11) & 1)) * 512, tid);
    const size_t dryoff = dry ? (WS_ACT - WS_XS) / 4 : 0;
    const LAS int* lbase = (const LAS int*)(misc + M_LBASE);
    const float* MOD = WSP(const float, WS_MOD); const float* g2 = MOD + (size_t)l * 9 * 6144 + 5120;
    float* XS = WSP(float, WS_XS); const bf16_t* YS = WSP(const bf16_t, WS_YS);
    const int* TOPE = WSP(const int, WS_TOPE); const int* POS = WSP(const int, WS_POS); const float* GATE = WSP(const float, WS_GATE);
    const bool last = (l == DEPTH - 1);
    for (int r = gw; r < nrows; r += 2048) {
        int slot = 0; float gate = 0.f;
        if (lane < 4) { slot = lbase[TOPE[(size_t)r * 4 + lane]] + POS[(size_t)r * 4 + lane]; gate = GATE[(size_t)r * 4 + lane]; }
        Row4 x; row_load(x, XS + (size_t)r * D, lane);
        Row4 f;
#pragma unroll
        for (int j = 0; j < 4; ++j) f.v[j] = (f32x4){0.f, 0.f, 0.f, 0.f};
#pragma unroll
        for (int k = 0; k < 4; ++k) { const int sk = __builtin_amdgcn_readlane(slot, k); const float gk = __int_as_float(__builtin_amdgcn_readlane(__float_as_int(gate), k)); const bf16_t* yr = YS + (size_t)sk * D;
#pragma unroll
            for (int j = 0; j < 4; ++j) { const u32x2 w = *(const u32x2*)(yr + 4 * lane + 256 * j);
                f.v[j][0] += gk * bf_lo(w.x); f.v[j][1] += gk * bf_hi(w.x); f.v[j][2] += gk * bf_lo(w.y); f.v[j][3] += gk * bf_hi(w.y); } }
        const int rb = r < NL ? (r >> 11) : 8;
#pragma unroll
        for (int j = 0; j < 4; ++j) { const f32x4 gg = *(const f32x4*)(g2 + (size_t)rb * 6144 + 4 * lane + 256 * j); x.v[j] = x.v[j] + gg * f.v[j]; }
        const float rstd = row_rstd(x, lane);
        if (last) {
#pragma unroll
            for (int j = 0; j < 4; ++j) { const int c = 4 * lane + 256 * j; const f32x4 gn = *(const f32x4*)(P->in[8] + c); *(f32x4*)((dry ? XS + dryoff : P->out) + (size_t)r * D + c) = x.v[j] * rstd * gn; }
        } else {
            row_store(x, XS + dryoff + (size_t)r * D, lane);
            Row4 hv; const float* mod = MOD + (size_t)(l + 1) * 9 * 6144 + (size_t)rb * 6144;
            norm_mod(x, rstd, P->in[6] + (size_t)(l + 1) * D, mod, mod + 1024, (dry ? WSP(bf16_t, WS_ACT + 80 * MiB) : WSP(bf16_t, WS_H)) + (size_t)r * D, lane, hv);
        }
    }
}
__device__ __forceinline__ void phase_final_norm(PK P, int gw, int lane) {
    for (int r = gw; r < NL; r += 2048) { Row4 x; row_load(x, WSP(float, WS_XS) + (size_t)r * D, lane); const float rstd = row_rstd(x, lane);
#pragma unroll
        for (int j = 0; j < 4; ++j) { const int c = 4 * lane + 256 * j; const f32x4 gn = *(const f32x4*)(P->in[8] + c); *(f32x4*)(P->out + (size_t)r * D + c) = x.v[j] * rstd * gn; } }
}

__device__ __forceinline__ void conv_item(const float* src, int N, int nvalid, int k0, int n0, bf16_t* dst, int ldk, int drow0, int dk0, LAS unsigned* scr, int lane) {
    const int q = lane >> 4, nl = lane & 15, n = n0 + 4 * nl;
    f32x4 v[16];
#pragma unroll
    for (int r = 0; r < 16; ++r) { const int k = k0 + 8 * (r >> 1) + 2 * q + (r & 1);
        v[r] = (n < nvalid) ? __builtin_nontemporal_load((const f32x4*)(src + (size_t)k * N + n)) : (f32x4){0.f, 0.f, 0.f, 0.f}; }
#pragma unroll
    for (int rp = 0; rp < 8; ++rp)
#pragma unroll
        for (int i = 0; i < 4; ++i) { const int nn = 4 * nl + i, kw = 4 * rp + q; scr[nn * 32 + (kw ^ (4 * ((nn >> 2) & 7)))] = cvt_pk_bf16(v[2 * rp][i], v[2 * rp + 1][i]); }
    asm volatile("s_waitcnt lgkmcnt(0)" ::: "memory");
#pragma unroll
    for (int it = 0; it < 8; ++it) { const int nn = 8 * it + (lane >> 3), c = lane & 7;
        const u32x4 w = *(const LAS u32x4*)(scr + nn * 32 + 4 * (c ^ ((nn >> 2) & 7)));
        *(u32x4*)(dst + (size_t)(drow0 + nn) * ldk + dk0 + 8 * c) = w; }
    asm volatile("s_waitcnt lgkmcnt(0)" ::: "memory");
}
constexpr int CV_A_IN = 2 * 16 * 24, CV_A_OUT = 2 * 256, CV_B_IN = 16 * 48, CV_B_OUT = 256, CV_C_IN = 16 * 8, CV_C_UQ = 4 * 24, CV_C_UKV = 2 * 32, CV_C_OUT = 256;
constexpr int CV_SMALL = CV_A_IN + CV_A_OUT + CV_B_IN + CV_B_OUT + CV_C_IN + CV_C_UQ + CV_C_UKV + CV_C_OUT;
constexpr int CV_LAYER = NEXP * 3 * 256;
constexpr int CV_TOTAL = CV_SMALL + DEPTH * CV_LAYER;
constexpr int CV_CHUNK = 32;
__device__ __forceinline__ void conv_dispatch(PK P, int item, LAS unsigned* scr, int lane) {
    int r = item;
    if (r < CV_A_IN) { const int s = r / 384, it = r % 384, kb = it / 24, nb = it % 24;
        conv_item(P->in[9] + (size_t)s * D * A_IN, A_IN, A_IN, 64 * kb, 64 * nb, WSP(bf16_t, WS_WA_IN) + (size_t)s * A_IN * D, D, 64 * nb, 64 * kb, scr, lane); return; } r -= CV_A_IN;
    if (r < CV_A_OUT) { const int s = r / 256, it = r % 256, kb = it / 16, nb = it % 16;
        conv_item(P->in[10] + (size_t)s * D * D, D, D, 64 * kb, 64 * nb, WSP(bf16_t, WS_WA_OUT) + (size_t)s * D * D, D, 64 * nb, 64 * kb, scr, lane); return; } r -= CV_A_OUT;
    if (r < CV_B_IN) { const int kb = r / 48, nb = r % 48;
        conv_item(P->in[12], B_IN, B_IN, 64 * kb, 64 * nb, WSP(bf16_t, WS_WB_IN), D, 64 * nb, 64 * kb, scr, lane); return; } r -= CV_B_IN;
    if (r < CV_B_OUT) { const int kb = r / 16, nb = r % 16;
        conv_item(P->in[13], D, D, 64 * kb, 64 * nb, WSP(bf16_t, WS_WB_OUT), D, 64 * nb, 64 * kb, scr, lane); return; } r -= CV_B_OUT;
    if (r < CV_C_IN) { const int kb = r / 8, nb = r % 8;
        conv_item(P->in[15], C_IN, C_IN, 64 * kb, 64 * nb, WSP(bf16_t, WS_WC_IN), D, 64 * nb, 64 * kb, scr, lane); return; } r -= CV_C_IN;
    if (r < CV_C_UQ) { const int kb = r / 24, nb = r % 24;
        conv_item(P->in[18], 1536, 1536, 64 * kb, 64 * nb, WSP(bf16_t, WS_WC_UP), C_UPK, 64 * nb, 64 * kb, scr, lane); return; } r -= CV_C_UQ;
    if (r < CV_C_UKV) { const int kb = r / 32, nb = r % 32;
        conv_item(P->in[19], 2048, 2048, 64 * kb, 64 * nb, WSP(bf16_t, WS_WC_UP), C_UPK, 1536 + 64 * nb, 256 + 64 * kb, scr, lane); return; } r -= CV_C_UKV;
    if (r < CV_C_OUT) { const int kb = r / 16, nb = r % 16;
        conv_item(P->in[20], D, D, 64 * kb, 64 * nb, WSP(bf16_t, WS_WC_OUT), D, 64 * nb, 64 * kb, scr, lane); return; } r -= CV_C_OUT;
    const int mat = r >> 8, it = r & 255, kb = it >> 4, nb = it & 15, which = mat % 3, le = mat / 3;
    if (which == 2) { conv_item(P->in[27] + (size_t)le * D * D, D, D, 64 * kb, 64 * nb, WSP(bf16_t, WS_WD) + (size_t)le * D * D, D, 64 * nb, 64 * kb, scr, lane); return; }
    const int n0 = 64 * nb, drow0 = 256 * (n0 >> 7) + (n0 & 127) + (which ? 128 : 0);
    conv_item(P->in[which ? 25 : 23] + (size_t)le * D * D, D, D, 64 * kb, n0, WSP(bf16_t, WS_WGU) + (size_t)le * 2 * D * D, D, drow0, 64 * kb, scr, lane);
}
__device__ __forceinline__ void conv_claim(PK P, LAS unsigned char* lds, int L, int quota, int tid) {
    const int lane = tid & 63, wid = __builtin_amdgcn_readfirstlane(tid >> 6);
    LAS int* slot = (LAS int*)(lds + MISC_OFF + M_CVB);
    unsigned* ctr = WSP(unsigned, WS_CTL) + CW_CV + L * 16;
    LAS unsigned* scr = (LAS unsigned*)(lds + wid * 8192);
    for (int q = 0; q < quota; ++q) {
        __syncthreads();
        if (tid == 0) *slot = (int)__hip_atomic_fetch_add(ctr, (unsigned)CV_CHUNK, __ATOMIC_RELAXED, __HIP_MEMORY_SCOPE_AGENT);
        __syncthreads();
        const int base = __builtin_amdgcn_readfirstlane(*slot);
        if (base >= CV_LAYER) break;
#pragma unroll 1
        for (int j = 0; j < CV_CHUNK / 8; ++j) conv_dispatch(P, CV_SMALL + L * CV_LAYER + base + wid + 8 * j, scr, lane);
    }
    __syncthreads();
}
__device__ __forceinline__ void phase_prologue(PK P, LAS unsigned char* lds, int bid, int tid) {
    const int lane = tid & 63, wid = __builtin_amdgcn_readfirstlane(tid >> 6);
    {
        LAS float* S = (LAS float*)lds; LAS float* red = (LAS float*)(lds + 40960);
        for (int idx = tid; idx < 9 * D; idx += 512) { const int r = idx >> 10, d = idx & (D - 1); const float v = r < 8 ? P->in[1][r * D + d] : P->in[3][d];
            S[idx] = v / (1.0f + __builtin_amdgcn_exp2f(-v * LOG2E)); }
        __syncthreads();
        const int l = bid >> 6, c0 = (bid & 63) * 96;
        if (lane < 48) {
            float acc[9][2];
#pragma unroll
            for (int r = 0; r < 9; ++r) { acc[r][0] = 0.f; acc[r][1] = 0.f; }
            const float* wp = P->in[4] + ((size_t)l * D + 128 * wid) * 6144 + c0 + 2 * lane;
            const LAS float* sp = S + 128 * wid;
#pragma unroll 8
            for (int k = 0; k < 128; ++k) { const f32x2 w = *(const f32x2*)(wp + (size_t)k * 6144);
#pragma unroll
                for (int r = 0; r < 9; ++r) { const float s = sp[r * D + k]; acc[r][0] += s * w[0]; acc[r][1] += s * w[1]; } }
#pragma unroll
            for (int r = 0; r < 9; ++r) { red[(wid * 9 + r) * 96 + 2 * lane] = acc[r][0]; red[(wid * 9 + r) * 96 + 2 * lane + 1] = acc[r][1]; }
        }
        __syncthreads();
        float* MOD = WSP(float, WS_MOD);
        for (int idx = tid; idx < 9 * 96; idx += 512) { const int r = idx / 96, cc = idx % 96; float s = 0.f;
#pragma unroll
            for (int w = 0; w < 8; ++w) s += red[(w * 9 + r) * 96 + cc];
            MOD[((size_t)l * 9 + r) * 6144 + c0 + cc] = s + P->in[5][(size_t)l * 6144 + c0 + cc]; }
        __syncthreads();
    }
    {
        const int gt = bid * 512 + tid; float* RA = WSP(float, WS_ROPE_A); float* RC = WSP(float, WS_ROPE_C);
        const float L2T = 13.287712379549449f;
        for (int idx = gt; idx < SEQ * 32; idx += 131072) { const int t = idx >> 5, i = idx & 31; const float pos = (float)(i < 16 ? (t >> 6) : (t & 63));
            const float inv = __builtin_amdgcn_exp2f(-(float)(i & 15) * (1.0f / 16.0f) * L2T); const float ang = pos * inv; RA[2 * idx] = __cosf(ang); RA[2 * idx + 1] = __sinf(ang); }
        for (int idx = gt; idx < SEQ * 16; idx += 131072) { const int t = idx >> 4, i = idx & 15; const float pos = (float)(i < 8 ? (t >> 6) : (t & 63));
            const float inv = __builtin_amdgcn_exp2f(-(float)(i & 7) * (1.0f / 8.0f) * L2T); const float ang = pos * inv; RC[2 * idx] = __cosf(ang); RC[2 * idx + 1] = __sinf(ang); }
        bf16_t* WU = WSP(bf16_t, WS_WC_UP); const u32x4 z = (u32x4){0u, 0u, 0u, 0u};
        for (int idx = gt; idx < 1536 * 16; idx += 131072) *(u32x4*)(WU + (size_t)(idx >> 4) * C_UPK + 256 + 8 * (idx & 15)) = z;
        for (int idx = gt; idx < 2048 * 32; idx += 131072) *(u32x4*)(WU + (size_t)(1536 + (idx >> 5)) * C_UPK + 8 * (idx & 31)) = z;
    }
    {
        LAS unsigned* scr = (LAS unsigned*)(lds + wid * 8192);
        const int gw = bid * 8 + wid;
        for (int item = gw; item < CV_SMALL + CV_LAYER; item += 2048) conv_dispatch(P, item, scr, lane);
    }
}

constexpr int PH_PRO = 0, PH_N0 = 1, PH_L0 = 2, PH_PER_LAYER = 9, PH_FINAL = PH_L0 + DEPTH * PH_PER_LAYER, NPH = PH_FINAL + 1;
enum { LP_IN = 0, LP_MLANORM = 1, LP_MLAUP = 2, LP_ATT = 3, LP_OUT = 4, LP_RT = 5, LP_GU = 6, LP_DN = 7, LP_CB = 8 };
struct Args { Ptrs P; int p_lo, p_hi, bar_idx, pad; };

__global__ void __launch_bounds__(512, 2) mk_fwd(Args a) {
    extern __shared__ __attribute__((aligned(16))) unsigned char lds_raw[];
    LAS unsigned char* const lds = (LAS unsigned char*)lds_raw;
    LAS unsigned char* const misc = lds + MISC_OFF;
    typedef const __attribute__((address_space(4))) Args* ArgsK;
    const ArgsK ak = (ArgsK)__builtin_amdgcn_kernarg_segment_ptr();
    (void)a;
    const int wid0 = __builtin_amdgcn_readfirstlane((int)threadIdx.x >> 6);
    if (wid0 == 0 && lane_id() < 4) ((LAS unsigned*)(misc + M_BARW))[lane_id()] = 0u;
    __syncthreads();
    XcdBarrier bar;
    { PK P = &ak->P; bar = xcd_barrier_post(WSP(unsigned, WS_CTL) + CW_BAR + ak->bar_idx * XCD_BAR_WORDS, (volatile LAS unsigned*)(misc + M_BARW), wid0 == 0); }
    bool ran = false;
    const int p_lo = ak->p_lo, p_hi = ak->p_hi;
#define PHASE_BEGIN(bit, p, cond) if ((((MK_MASK) >> (bit)) & 1) && p_lo <= (p) && (p) < p_hi && ((p) <= MK_STOP_AFTER || (p) == PH_FINAL) && (cond)) for (int rep_ = 0; rep_ < 1 + (((MK_REP_MASK) >> (bit)) & 1); ++rep_) { if (ran) xcd_barrier(bar); ran = true; \
    int tid = wid0 * 64 + lane_id(); asm volatile("" : "+v"(tid)); int bid = blockIdx.x; asm volatile("" : "+s"(bid)); ArgsK ak_ = ak; asm volatile("" : "+s"(ak_)); PK P = &ak_->P; \
    const int lane = tid & 63, wid = __builtin_amdgcn_readfirstlane(tid >> 6), vcu = (bid & 7) * 32 + (bid >> 3), gw = vcu * 8 + wid; (void)lane; (void)gw; (void)P;
#define PHASE_END }

    PHASE_BEGIN(0, PH_PRO, true) phase_prologue(P, lds, bid, tid); PHASE_END
    PHASE_BEGIN(1, PH_N0, true) phase_first_norm(P, gw, lane); PHASE_END

    for (int l = 0; l < DEPTH; ++l) {
        const int kind = l % 3, slot = l / 3, pb = PH_L0 + l * PH_PER_LAYER;
        const bool last = (l == DEPTH - 1);
        const int nMrows = last ? NL / 256 : NT / 256;
        PHASE_BEGIN(2, pb + LP_IN, kind == 0) {
            pg8::Gemm g{WSP(const bf16_t, WS_H), WSP(const bf16_t, WS_WA_IN) + (size_t)slot * A_IN * D, D, 0, nullptr};
            pg8::DenseOrder S{nMrows, 6, vcu, last ? 8 : 0, 4, 2};
            pg8::EpiQkvA E{WSP(bf16_t, WS_QKV), WSP(const float, WS_ROPE_A)};
            pg8::gemm_phase<pg8::EpiQkvA, pg8::DenseOrder, false>(lds, g, S, E, tid);
            if (l >= 1 && S.short_one()) conv_claim(P, lds, l, MK_Q_IN, tid);
        } PHASE_END
        PHASE_BEGIN(3, pb + LP_IN, kind == 1) {
            pg8::Gemm g{WSP(const bf16_t, WS_H), WSP(const bf16_t, WS_WB_IN), D, 0, nullptr};
            pg8::DenseOrder S{NT / 256, 12, vcu, 0, 0, 0};
            pg8::EpiBf16Plain E{WSP(bf16_t, WS_QKV), B_IN};
            pg8::gemm_phase<pg8::EpiBf16Plain, pg8::DenseOrder, false>(lds, g, S, E, tid);
            if (S.short_one()) conv_claim(P, lds, l, MK_Q_IN, tid);
        } PHASE_END
        PHASE_BEGIN(4, pb + LP_IN, kind == 2) {
            pg8::Gemm g{WSP(const bf16_t, WS_H), WSP(const bf16_t, WS_WC_IN), D, 0, nullptr};
            pg8::DenseOrder S{NT / 256, 2, vcu, 0, 0, 0};
            pg8::EpiF32Plain E{WSP(float, WS_Y416), C_INP};
            pg8::gemm_phase<pg8::EpiF32Plain, pg8::DenseOrder, false>(lds, g, S, E, tid);
            if (S.short_one()) conv_claim(P, lds, l, MK_Q_IN, tid);
        } PHASE_END
        PHASE_BEGIN(5, pb + LP_MLANORM, kind == 2) phase_mla_norm(P, gw, lane); PHASE_END
        PHASE_BEGIN(6, pb + LP_MLAUP, kind == 2) {
            pg8::Gemm g{WSP(const bf16_t, WS_CQKV), WSP(const bf16_t, WS_WC_UP), C_UPK, 0, nullptr};
            pg8::DenseOrder S{NT / 256, 14, vcu, 0, 0, 0};
            pg8::EpiMlaUp E{WSP(bf16_t, WS_QKV), WSP(const float, WS_ROPE_C)};
            pg8::gemm_phase<pg8::EpiMlaUp, pg8::DenseOrder, false>(lds, g, S, E, tid);
        } PHASE_END
        PHASE_BEGIN(7, pb + LP_ATT, kind == 0) {
            const bf16_t* QKV = WSP(const bf16_t, WS_QKV); bf16_t* O = WSP(bf16_t, WS_O); const float* sink = P->in[11] + slot * 16;
            for (int u = vcu; u < 1024; u += 256) { const int bk = u >> 5; att::attn_A_unit(lds, QKV, O, sink, bk >> 2, bk & 3, u & 31, false, tid); }
            if (!last) for (int u = vcu; u < 128; u += 256) { const int bk = u >> 2; att::attn_A_unit(lds, QKV, O, sink, bk >> 2, bk & 3, u & 3, true, tid); }
        } PHASE_END
        PHASE_BEGIN(8, pb + LP_ATT, kind == 1) {
            const bf16_t* QKV = WSP(const bf16_t, WS_QKV); bf16_t* O = WSP(bf16_t, WS_O); LAS float* tab = (LAS float*)(misc + M_RPB);
            for (int u = vcu; u < 1024; u += 256) { const int bh = u >> 3; att::attn_B_unit(lds, tab, QKV, O, P->in[14], bh >> 4, bh & 15, u & 7, false, tid); }
            for (int u = vcu; u < 128; u += 256) att::attn_B_unit(lds, tab, QKV, O, P->in[14], u >> 4, u & 15, 0, true, tid);
        } PHASE_END
        PHASE_BEGIN(9, pb + LP_ATT, kind == 2) {
            const bf16_t* QKV = WSP(const bf16_t, WS_QKV); bf16_t* O = WSP(bf16_t, WS_O); const bf16_t* KR = WSP(const bf16_t, WS_KR);
            for (int u = vcu; u < 1024; u += 256) { const int bh = u >> 3; att::attn_C_unit(lds, QKV, KR, O, bh >> 4, bh & 15, u & 7, false, tid); }
            for (int u = vcu; u < 128; u += 256) att::attn_C_unit(lds, QKV, KR, O, u >> 4, u & 15, 0, true, tid);
        } PHASE_END
        PHASE_BEGIN(10, pb + LP_OUT, true) {
            const bf16_t* W = kind == 0 ? WSP(const bf16_t, WS_WA_OUT) + (size_t)slot * D * D : (kind == 1 ? WSP(const bf16_t, WS_WB_OUT) : WSP(const bf16_t, WS_WC_OUT));
            pg8::Gemm g{WSP(const bf16_t, WS_O), W, D, 0, nullptr};
            pg8::DenseOrder S{nMrows, 4, vcu, 0, 0, 0};
            pg8::EpiResid E{WSP(float, WS_XS), WSP(const float, WS_MOD) + (size_t)l * 9 * 6144 + 2048, (rep_ + 1 < 1 + ((MK_REP_MASK >> 10) & 1)) ? WSP(float, WS_ACT) : WSP(float, WS_XS)};
            pg8::gemm_phase<pg8::EpiResid, pg8::DenseOrder, false>(lds, g, S, E, tid);
            if (!last && S.short_one()) conv_claim(P, lds, l + 1, MK_Q_OUT, tid);
        } PHASE_END
        PHASE_BEGIN(11, pb + LP_RT, true) { if (l >= 1) conv_claim(P, lds, l, 1 << 30, tid); phase_router(P, lds, l, last ? NL : NT, vcu, tid, rep_); } PHASE_END
        PHASE_BEGIN(12, pb + LP_GU, true) {
            moe_tables(misc, WSP(unsigned, WS_CTL) + CW_CNT + (l * 2 + ((MK_REP_MASK >> 11) & 1)) * 512, tid);
            pg8::Gemm g{WSP(const bf16_t, WS_H), WSP(const bf16_t, WS_WGU) + (size_t)l * NEXP * 2 * D * D, D, (size_t)2 * D * D, WSP(const int, WS_ELIST)};
            pg8::MoeOrder S{(const LAS int*)(misc + M_ECNT), (const LAS int*)(misc + M_LBASE), (const LAS int*)(misc + M_CUMT), 8, vcu};
            pg8::EpiSwiglu E{WSP(bf16_t, WS_ACT), P->in[24] + (size_t)l * NEXP * D, P->in[26] + (size_t)l * NEXP * D};
            pg8::gemm_phase<pg8::EpiSwiglu, pg8::MoeOrder, true>(lds, g, S, E, tid);
            if (!last && S.short_one()) conv_claim(P, lds, l + 1, MK_Q_GU, tid);
        } PHASE_END
        PHASE_BEGIN(13, pb + LP_DN, true) {
            moe_tables(misc, WSP(unsigned, WS_CTL) + CW_CNT + (l * 2 + ((MK_REP_MASK >> 11) & 1)) * 512, tid);
            pg8::Gemm g{WSP(const bf16_t, WS_ACT), WSP(const bf16_t, WS_WD) + (size_t)l * NEXP * D * D, D, (size_t)D * D, nullptr};
            pg8::MoeOrder S{(const LAS int*)(misc + M_ECNT), (const LAS int*)(misc + M_LBASE), (const LAS int*)(misc + M_CUMT), 4, vcu};
            pg8::EpiDown E{WSP(bf16_t, WS_YS), P->in[28] + (size_t)l * NEXP * D};
            pg8::gemm_phase<pg8::EpiDown, pg8::MoeOrder, false>(lds, g, S, E, tid);
            if (!last && S.short_one()) conv_claim(P, lds, l + 1, MK_Q_DN, tid);
        } PHASE_END
        PHASE_BEGIN(14, pb + LP_CB, true) phase_combine(P, lds, l, last ? NL : NT, gw, tid, (rep_ + 1 < 1 + ((MK_REP_MASK >> 14) & 1))); PHASE_END
    }
    PHASE_BEGIN(15, PH_FINAL, MK_STOP_AFTER < PH_FINAL - 1) phase_final_norm(P, gw, lane); PHASE_END
#undef PHASE_BEGIN
#undef PHASE_END
}

extern "C" void kernel_launch(void* const* d_in, const int* in_sizes, int n_in, void* d_out, int out_size, void* d_ws, size_t ws_size, hipStream_t stream) {
    static int grid = 0;
    if (grid == 0) {
        if (n_in != 29 || out_size != NL * D || ws_size < WS_END) { fprintf(stderr, "kernel_launch: expected 29 inputs, out %d, ws >= %zu; got n_in %d out %d ws %zu\n", NL * D, (size_t)WS_END, n_in, out_size, ws_size); grid = -1; return; }
        int dev = 0, cus = 0, per_cu = 0;
        if (hipGetDevice(&dev) != hipSuccess || hipDeviceGetAttribute(&cus, hipDeviceAttributeMultiprocessorCount, dev) != hipSuccess) { grid = -1; return; }
        if (hipFuncSetAttribute((const void*)mk_fwd, hipFuncAttributeMaxDynamicSharedMemorySize, LDS_BYTES) != hipSuccess) { fprintf(stderr, "kernel_launch: hipFuncSetAttribute failed\n"); grid = -1; return; }
        if (hipOccupancyMaxActiveBlocksPerMultiprocessor(&per_cu, (const void*)mk_fwd, 512, LDS_BYTES) != hipSuccess || per_cu < 1) fprintf(stderr, "kernel_launch: occupancy query says %d\n", per_cu);
        (void)hipGetLastError();
        grid = 256;
        if (cus < 256) { fprintf(stderr, "kernel_launch: needs 256 CUs, device has %d\n", cus); grid = -1; return; }
    }
    if (grid < 0) return;
    if (hipMemsetAsync((char*)d_ws + WS_CTL, 0, CTL_BYTES, stream) != hipSuccess) return;
    Args a{};
    for (int i = 0; i < 29; ++i) a.P.in[i] = (const float*)d_in[i];
    a.P.out = (float*)d_out; a.P.ws = (unsigned char*)d_ws; a.pad = 0;
#if MK_PER_PHASE
    for (int p = 0; p < NPH; ++p) { a.p_lo = p; a.p_hi = p + 1; a.bar_idx = 0; hipLaunchKernelGGL(mk_fwd, dim3(grid), dim3(512), LDS_BYTES, stream, a); }
#else
    a.p_lo = 0; a.p_hi = NPH; a.bar_idx = 0;
    hipLaunchKernelGGL(mk_fwd, dim3(grid), dim3(512), LDS_BYTES, stream, a);
#endif
    const hipError_t le = hipPeekAtLastError();
    if (le != hipSuccess) fprintf(stderr, "kernel_launch: launch failed: %s\n", hipGetErrorName(le));
}
```

```cpp
#include <hip/hip_runtime.h>
#include <cstdio>
#include <cstdint>

#ifndef MK_PER_PHASE
#define MK_PER_PHASE 0
#endif
#ifndef MK_MASK
#define MK_MASK 0xFFFF
#endif
#ifndef MK_REP_MASK
#define MK_REP_MASK 0
#endif
#ifndef MK_Q_OUT
#define MK_Q_OUT 1
#endif
#ifndef MK_Q_GU
#define MK_Q_GU 1
#endif
#ifndef MK_Q_DN
#define MK_Q_DN 1
#endif
#ifndef MK_Q_IN
#define MK_Q_IN 1
#endif
#ifndef MK_MT_MAJOR
#define MK_MT_MAJOR 1
#endif
#ifndef MK_STOP_AFTER
#define MK_STOP_AFTER 9999
#endif

#define LAS __attribute__((address_space(3)))
#define GAS __attribute__((address_space(1)))
typedef unsigned short bf16_t;
typedef short bf16x8 __attribute__((ext_vector_type(8)));
typedef short s16x4 __attribute__((ext_vector_type(4)));
typedef _Float16 f16x8 __attribute__((ext_vector_type(8)));
typedef _Float16 f16x2 __attribute__((ext_vector_type(2)));
typedef float f32x2 __attribute__((ext_vector_type(2)));
typedef float f32x4 __attribute__((ext_vector_type(4)));
typedef float f32x16 __attribute__((ext_vector_type(16)));
typedef unsigned u32x2 __attribute__((ext_vector_type(2)));
typedef unsigned u32x4 __attribute__((ext_vector_type(4)));

constexpr int D = 1024, NB = 8, SEQ = 2048, CTXL = 256, DEPTH = 4;
constexpr int NL = NB * SEQ;
constexpr int NC = NB * CTXL;
constexpr int NT = NL + NC;
constexpr int NEXP = 32, TOPK = 4;
constexpr int MAXSLOT = 81920;
constexpr float NORM_EPS = 1e-6f;
constexpr float LOG2E = 1.4426950408889634f;
constexpr int A_IN = 1536, B_IN = 3072, C_IN = 416, C_INP = 512, C_UPK = 384, C_UPN = 3584;

constexpr size_t MiB = 1u << 20;
constexpr size_t WS_CTL = 0, CTL_BYTES = 1 * MiB;
constexpr size_t WS_MOD = 1 * MiB;
constexpr size_t WS_ROPE_A = 2 * MiB;
constexpr size_t WS_ROPE_C = 2 * MiB + 512 * 1024;
constexpr size_t WS_TOPE = 3 * MiB;
constexpr size_t WS_POS = 3 * MiB + 512 * 1024;
constexpr size_t WS_GATE = 4 * MiB;
constexpr size_t WS_ELIST = 5 * MiB;
constexpr size_t WS_KR = 8 * MiB;
constexpr size_t WS_CQKV = 10 * MiB;
constexpr size_t WS_Y416 = 24 * MiB;
constexpr size_t WS_XS = 60 * MiB;
constexpr size_t WS_H = 132 * MiB;
constexpr size_t WS_O = 168 * MiB;
constexpr size_t WS_QKV = 204 * MiB;
constexpr size_t WS_ACT = 330 * MiB;
constexpr size_t WS_YS = 490 * MiB;
constexpr size_t WS_WA_IN = 650 * MiB;
constexpr size_t WS_WA_OUT = 656 * MiB;
constexpr size_t WS_WB_IN = 660 * MiB;
constexpr size_t WS_WB_OUT = 666 * MiB;
constexpr size_t WS_WC_IN = 668 * MiB;
constexpr size_t WS_WC_UP = 669 * MiB;
constexpr size_t WS_WC_OUT = 672 * MiB;
constexpr size_t WS_WGU = 676 * MiB;
constexpr size_t WS_WD = 1188 * MiB;
constexpr size_t WS_G16 = 1444 * MiB;
constexpr size_t WS_RC = 1447 * MiB;
constexpr size_t WS_END = 1448 * MiB;

constexpr int CW_CV = 512;
constexpr int CW_CNT = 1024;
constexpr int CW_BAR = 65536;

constexpr int RING_BYTES = 131072;
constexpr int MISC_OFF = RING_BYTES;
constexpr int M_BARW = 0, M_LCNT = 64, M_LBASE = 192, M_CUMT = 320, M_ECNT = 512, M_GBASE = 640, M_CVB = 768, M_UL = 6656, M_RPB = 1024, M_REC = 3072;
constexpr int LDS_BYTES = 147456;

#define XB_TMO      128
#define XB_XCNT(j)  (256  + 64 * (j))
#define XB_XSUB(j)  (1280 + 64 * (j))
#define XB_XGEN(j)  (2304 + 64 * (j))
#define XB_TOP      3328
#define XB_TOPGEN   3392
#define XCD_BAR_WORDS 3456
#define XB_SPIN_CAP (1u << 18)

__device__ __forceinline__ unsigned xb_ld(unsigned* p)              { return __hip_atomic_load(p, __ATOMIC_RELAXED, __HIP_MEMORY_SCOPE_AGENT); }
__device__ __forceinline__ unsigned xb_add(unsigned* p, unsigned v) { return __hip_atomic_fetch_add(p, v, __ATOMIC_RELAXED, __HIP_MEMORY_SCOPE_AGENT); }
__device__ __forceinline__ unsigned xb_xcc_id() { return (unsigned)__builtin_amdgcn_s_getreg((3 << 11) | 20) & 0xFu; }
#define XB_SPIN(cond, bar) do { unsigned _sp = 0; while (cond) { __builtin_amdgcn_s_sleep(1); \
    if ((++_sp & 255u) == 0u) { if (xb_ld(&(bar)[XB_TMO])) break; if (_sp > XB_SPIN_CAP) { atomicAdd(&(bar)[XB_TMO], 1u); break; } } } } while (0)

__device__ __forceinline__ int lane_id() { int r; asm volatile("v_mbcnt_lo_u32_b32 %0, -1, 0\n\tv_mbcnt_hi_u32_b32 %0, -1, %0" : "=v"(r)); return r; }
struct XcdBarrier {
    unsigned* bar; unsigned x;
    volatile LAS unsigned* st;
    bool lead;
};
__device__ __forceinline__ XcdBarrier xcd_barrier_post(unsigned* bar, volatile LAS unsigned* st, bool lead) {
    XcdBarrier b; b.bar = bar; b.x = xb_xcc_id(); b.st = st; b.lead = lead;
    if (lead && lane_id() == 0) (void)xb_add(&bar[XB_XCNT(b.x)], 1u);
    return b;
}
__device__ __forceinline__ void xcd_barrier_complete(unsigned* bar, unsigned x, unsigned& nloc, unsigned& nx) {
    const unsigned G = gridDim.x * gridDim.y * gridDim.z;
    unsigned sum, cnt, mine, sp = 0u;
    for (;;) {
        sum = 0u; cnt = 0u; mine = 0u;
#pragma unroll
        for (unsigned j = 0; j < 16; ++j) { const unsigned c = xb_ld(&bar[XB_XCNT(j)]); sum += c; cnt += (c > 0u) ? 1u : 0u; mine = (j == x) ? c : mine; }
        if (sum == G) break;
        __builtin_amdgcn_s_sleep(1);
        if ((++sp & 255u) == 0u) { if (xb_ld(&bar[XB_TMO])) break; if (sp > XB_SPIN_CAP) { atomicAdd(&bar[XB_TMO], 1u); break; } }
    }
    nloc = mine > 0u ? mine : 1u; nx = cnt > 0u ? cnt : 1u;
}
__device__ __forceinline__ void xcd_barrier(const XcdBarrier& b) {
    asm volatile("s_waitcnt vmcnt(0)" ::: "memory");
    __syncthreads();
    if (b.lead && lane_id() == 0) {
        unsigned* bar = b.bar;
        __builtin_amdgcn_s_waitcnt(0);
        unsigned nloc = b.st[0], nx = b.st[1];
        if (nloc == 0u) { xcd_barrier_complete(bar, b.x, nloc, nx); b.st[0] = nloc; b.st[1] = nx; }
        const unsigned old = xb_add(&bar[XB_XSUB(b.x)], 1u);
        const unsigned gen = old / nloc;
        if (old + 1u == (gen + 1u) * nloc) {
            __builtin_amdgcn_fence(__ATOMIC_RELEASE, "agent");
            asm volatile("s_waitcnt vmcnt(0)" ::: "memory");
            const unsigned og = xb_add(&bar[XB_TOP], 1u);
            const unsigned tg = og / nx;
            if (og + 1u == (tg + 1u) * nx) xb_add(&bar[XB_TOPGEN], 1u);
            else XB_SPIN(xb_ld(&bar[XB_TOPGEN]) == tg, bar);
            __builtin_amdgcn_fence(__ATOMIC_ACQUIRE, "agent");
            xb_add(&bar[XB_XGEN(b.x)], 1u);
            asm volatile("s_waitcnt vmcnt(0)" ::: "memory");
        } else {
            XB_SPIN(xb_ld(&bar[XB_XGEN(b.x)]) == gen, bar);
            __builtin_amdgcn_fence(__ATOMIC_ACQUIRE, "agent");
            asm volatile("s_waitcnt vmcnt(0)" ::: "memory");
        }
    }
    __syncthreads();
}

__device__ __forceinline__ unsigned cvt_pk_bf16(float lo, float hi) { unsigned r; asm volatile("v_cvt_pk_bf16_f32 %0, %1, %2" : "=v"(r) : "v"(lo), "v"(hi)); return r; }
__device__ __forceinline__ float bf_lo(unsigned w) { return __uint_as_float(w << 16); }
__device__ __forceinline__ float bf_hi(unsigned w) { return __uint_as_float(w & 0xffff0000u); }
__device__ __forceinline__ float shx(float v, int mask, int lane) { return __int_as_float(__builtin_amdgcn_ds_bpermute((lane ^ mask) << 2, __float_as_int(v))); }
__device__ __forceinline__ float wave_sum(float v, int lane) {
#pragma unroll
    for (int o = 1; o < 64; o <<= 1) v += shx(v, o, lane);
    return v;
}
__device__ __forceinline__ float wave_max(float v, int lane) {
#pragma unroll
    for (int o = 1; o < 64; o <<= 1) v = fmaxf(v, shx(v, o, lane));
    return v;
}
__device__ __forceinline__ float swap32_max(float m) { auto rr = __builtin_amdgcn_permlane32_swap(__float_as_uint(m), __float_as_uint(m), false, false); return fmaxf(__uint_as_float(rr[0]), __uint_as_float(rr[1])); }
__device__ __forceinline__ float swap32_sum(float m) { auto rr = __builtin_amdgcn_permlane32_swap(__float_as_uint(m), __float_as_uint(m), false, false); return __uint_as_float(rr[0]) + __uint_as_float(rr[1]); }

namespace pg8 {
constexpr int BM = 256, BK = 64, HALF = 128, HTB = HALF * BK * 2, STAGE_BYTES = 8 * HTB;
__host__ __device__ __forceinline__ int lds_byte(int r, int c) { const int st = (r >> 4) * 2 + (c >> 5), rr = r & 15, cc = c & 31, ob = rr * 64 + cc * 2; return st * 1024 + (ob ^ (((ob >> 9) & 1) << 5)); }
__host__ __device__ __forceinline__ void stage_rc(int b, int& R, int& C) { const int st = b / 1024, sb = b % 1024, swz = sb ^ (((sb >> 9) & 1) << 5); R = (st >> 1) * 16 + swz / 64; C = (st & 1) * 32 + (swz % 64) / 2; }
__host__ __device__ __forceinline__ int perm32(int rho) { const int n = rho >> 4, i = rho & 15; return 8 * (i >> 2) + 4 * n + (i & 3); }

struct Unit { int pm, pn, e, mt, cnt; };
struct Gemm { const bf16_t* A; const bf16_t* Bt; int K; size_t bstride; const int* list; };

template <class Epi, class Sched, bool GATHER>
__device__ __forceinline__ void gemm_phase(LAS unsigned char* lds, const Gemm g, const Sched& S, const Epi& E, const int tid) {
    const int wid = __builtin_amdgcn_readfirstlane(tid >> 6), lane = tid & 63, wr = wid >> 2, wc = wid & 3, fr = lane & 15, fq = lane >> 4;
    const int K = g.K, nt = K / BK;
    unsigned voffA[2], voffB[2];
    int gR[2], gC[2];
#pragma unroll
    for (int i = 0; i < 2; ++i) { int R, C; stage_rc(tid * 16 + i * 8192, R, C); const int Rb = Epi::PERM ? ((R & ~31) + perm32(R & 31)) : R;
        voffA[i] = (unsigned)(R * K + C) * 2u; voffB[i] = (unsigned)(Rb * K + C) * 2u; gR[i] = R; gC[i] = C; }
    const size_t kstep = (size_t)(BK * 2);
    const size_t hstep = (size_t)HALF * K * 2;
    const size_t tstep = 2 * hstep;
    const unsigned ldsw = (unsigned)wid * 1024u;
    const int aoff = lds_byte(wr * 64 + fr, fq * 8), boff = lds_byte(wc * 32 + fr, fq * 8);
#define PG8_SA(b, h) (((b) * 2 + (h)) * HTB)
#define PG8_SB(b, h) ((4 + (b) * 2 + (h)) * HTB)
#define PG8_STAGE(bufoff, gbase, voff) do { _Pragma("unroll") for (int _i = 0; _i < 2; ++_i) \
        __builtin_amdgcn_global_load_lds((const unsigned*)((const char*)(gbase) + (voff)[_i]), (LAS unsigned*)(lds + (bufoff) + ldsw + _i * 8192), 16, 0, 0); } while (0)
#define PG8_STAGE_A(bufoff, SELN, H, KOFF) do { if constexpr (GATHER) { unsigned _vo[2]; _vo[0] = (SELN) ? voN[H][0] : voC[H][0]; _vo[1] = (SELN) ? voN[H][1] : voC[H][1]; \
            PG8_STAGE(bufoff, (const char*)g.A + (KOFF), _vo); } else { PG8_STAGE(bufoff, ((SELN) ? nA : cA) + (H) * hstep + (KOFF), voffA); } } while (0)
#define PG8_LDA(dst, b, h) do { _Pragma("unroll") for (int m = 0; m < 4; ++m) _Pragma("unroll") for (int k = 0; k < 2; ++k) dst[m][k] = *(const LAS bf16x8*)(lds + PG8_SA(b, h) + aoff + m * 2048 + k * 1024); } while (0)
#define PG8_LDB(dst, b, h) do { _Pragma("unroll") for (int n = 0; n < 2; ++n) _Pragma("unroll") for (int k = 0; k < 2; ++k) dst[n][k] = *(const LAS bf16x8*)(lds + PG8_SB(b, h) + boff + n * 2048 + k * 1024); } while (0)
#define PG8_MMA(ai, bj, At, Bt) do { __builtin_amdgcn_s_setprio(1); _Pragma("unroll") for (int m = 0; m < 4; ++m) _Pragma("unroll") for (int n = 0; n < 2; ++n) _Pragma("unroll") for (int k = 0; k < 2; ++k) \
        acc[ai][bj][m][n] = __builtin_amdgcn_mfma_f32_16x16x32_bf16(Bt[n][k], At[m][k], acc[ai][bj][m][n], 0, 0, 0); __builtin_amdgcn_s_setprio(0); } while (0)
#define PG8_WAIT_V(n) asm volatile("s_waitcnt vmcnt(" #n ")" ::: "memory")
#define PG8_WAIT_L(n) asm volatile("s_waitcnt lgkmcnt(" #n ")" ::: "memory")
#define PG8_BAR __builtin_amdgcn_s_barrier()
#define PG8_SCHED __builtin_amdgcn_sched_barrier(0)
#define PG8_GATH(U, VO) do { _Pragma("unroll") for (int _h = 0; _h < 2; ++_h) _Pragma("unroll") for (int _i = 0; _i < 2; ++_i) { \
        int _r = (U).mt * 256 + _h * 128 + gR[_i]; _r = _r < (U).cnt ? _r : 0; const int _tok = g.list[(size_t)(U).e * NT + _r]; VO[_h][_i] = (unsigned)(_tok * K + gC[_i]) * 2u; } } while (0)
    Unit cur, nxt; int ui = 0;
    if (!S.next(0, cur)) return;
    f32x4 acc[2][2][4][2];
#pragma unroll
    for (int a = 0; a < 2; ++a)
#pragma unroll
        for (int b = 0; b < 2; ++b)
#pragma unroll
            for (int m = 0; m < 4; ++m)
#pragma unroll
                for (int n = 0; n < 2; ++n) acc[a][b][m][n] = (f32x4){0.f, 0.f, 0.f, 0.f};
    bf16x8 At[4][2], B0[2][2], B1[2][2];
    unsigned voC[2][2] = {{0u, 0u}, {0u, 0u}}, voN[2][2] = {{0u, 0u}, {0u, 0u}};
    if constexpr (GATHER) { PG8_GATH(cur, voC); }
    const char* cA = GATHER ? (const char*)g.A : (const char*)g.A + (size_t)cur.pm * tstep;
    const char* cB = (const char*)g.Bt + ((size_t)cur.e * g.bstride) * 2 + (size_t)cur.pn * tstep;
    const char* nA = cA; const char* nB = cB;
    PG8_STAGE(PG8_SB(0, 0), cB, voffB); PG8_STAGE(PG8_SB(0, 1), cB + hstep, voffB); PG8_STAGE_A(PG8_SA(0, 0), false, 0, 0); PG8_STAGE_A(PG8_SA(0, 1), false, 1, 0);
    if (wr == 1) PG8_BAR;
    PG8_WAIT_V(2); PG8_BAR;
    PG8_STAGE(PG8_SB(1, 0), cB + kstep, voffB); PG8_STAGE_A(PG8_SA(1, 0), false, 0, kstep); PG8_STAGE(PG8_SB(1, 1), cB + hstep + kstep, voffB);
    PG8_WAIT_V(6); PG8_BAR;
    for (;;) {
        const bool has_next = S.next(ui + 1, nxt);
        nA = GATHER ? (const char*)g.A : (has_next ? (const char*)g.A + (size_t)nxt.pm * tstep : cA);
        nB = has_next ? (const char*)g.Bt + ((size_t)nxt.e * g.bstride) * 2 + (size_t)nxt.pn * tstep : cB;
        int tokN[2][2] = {{0, 0}, {0, 0}};
        if constexpr (GATHER) { if (has_next) {
#pragma unroll
            for (int _h = 0; _h < 2; ++_h)
#pragma unroll
                for (int _i = 0; _i < 2; ++_i) { int _r = nxt.mt * 256 + _h * 128 + gR[_i]; _r = _r < nxt.cnt ? _r : 0; const int* _p = g.list + (size_t)nxt.e * NT + _r;
                    asm volatile("global_load_dword %0, %1, off" : "=v"(tokN[_h][_i]) : "v"(_p) : "memory"); } } }
        for (int t = 0; t < nt; t += 2) {
            const bool last = (t == nt - 2);
            const size_t k1 = (size_t)(t + 1) * kstep;
            const size_t k2 = last ? 0 : (size_t)(t + 2) * kstep;
            const size_t k3 = k2 + kstep;
            const char* b2 = (last ? nB : cB) + k2; const char* b3 = b2 + kstep;
            PG8_LDB(B0, 0, 0); PG8_LDB(B1, 0, 1); PG8_SCHED; PG8_LDA(At, 0, 0); PG8_STAGE_A(PG8_SA(1, 1), false, 1, k1);
            PG8_WAIT_V(8); PG8_WAIT_L(0); PG8_BAR; PG8_MMA(0, 0, At, B0); PG8_MMA(0, 1, At, B1); PG8_BAR; PG8_SCHED;
            if constexpr (GATHER) { if (last) { if (has_next) {
                asm volatile("" : "+v"(tokN[0][0]), "+v"(tokN[0][1]), "+v"(tokN[1][0]), "+v"(tokN[1][1]));
#pragma unroll
                for (int _h = 0; _h < 2; ++_h) { voN[_h][0] = (unsigned)(tokN[_h][0] * K + gC[0]) * 2u; voN[_h][1] = (unsigned)(tokN[_h][1] * K + gC[1]) * 2u; } } else {
#pragma unroll
                for (int _h = 0; _h < 2; ++_h) { voN[_h][0] = voC[_h][0]; voN[_h][1] = voC[_h][1]; } } } }
            PG8_LDA(At, 0, 1); PG8_STAGE(PG8_SB(0, 0), b2, voffB); PG8_STAGE(PG8_SB(0, 1), b2 + hstep, voffB); PG8_STAGE_A(PG8_SA(0, 0), last, 0, k2);
            PG8_WAIT_V(8); PG8_WAIT_L(0); PG8_BAR; PG8_MMA(1, 0, At, B0); PG8_MMA(1, 1, At, B1); PG8_BAR; PG8_SCHED;
            PG8_LDB(B0, 1, 0); PG8_LDB(B1, 1, 1); PG8_SCHED; PG8_LDA(At, 1, 0); PG8_STAGE_A(PG8_SA(0, 1), last, 1, k2);
            PG8_WAIT_V(8); PG8_WAIT_L(0); PG8_BAR; PG8_MMA(0, 0, At, B0); PG8_MMA(0, 1, At, B1); PG8_BAR; PG8_SCHED;
            PG8_LDA(At, 1, 1); PG8_STAGE(PG8_SB(1, 0), b3, voffB); PG8_STAGE(PG8_SB(1, 1), b3 + hstep, voffB); PG8_STAGE_A(PG8_SA(1, 0), last, 0, k3);
            PG8_WAIT_V(8); PG8_WAIT_L(0); PG8_BAR; PG8_MMA(1, 0, At, B0); PG8_MMA(1, 1, At, B1); PG8_BAR; PG8_SCHED;
        }
        if (wr == 0) PG8_BAR;
        { const int ln_ = lane_id(); E(acc, cur, wr, wc, ln_ & 15, ln_ >> 4); }
        if (!has_next) break;
#pragma unroll
        for (int a = 0; a < 2; ++a)
#pragma unroll
            for (int b = 0; b < 2; ++b)
#pragma unroll
                for (int m = 0; m < 4; ++m)
#pragma unroll
                    for (int n = 0; n < 2; ++n) acc[a][b][m][n] = (f32x4){0.f, 0.f, 0.f, 0.f};
        cur = nxt; cA = nA; cB = nB; ++ui;
        if constexpr (GATHER) {
#pragma unroll
            for (int _h = 0; _h < 2; ++_h) { voC[_h][0] = voN[_h][0]; voC[_h][1] = voN[_h][1]; } }
        if (wr == 1) PG8_BAR;
    }
    PG8_WAIT_V(0);
    PG8_BAR;
#undef PG8_SA
#undef PG8_SB
#undef PG8_STAGE
#undef PG8_STAGE_A
#undef PG8_LDA
#undef PG8_LDB
#undef PG8_MMA
#undef PG8_WAIT_V
#undef PG8_WAIT_L
#undef PG8_BAR
#undef PG8_SCHED
#undef PG8_GATH
}
}

namespace pg8 {
struct EpiBf16Plain {
    static constexpr bool PERM = true;
    bf16_t* O; int ldc; int qtiles; float qscale;
    __device__ __forceinline__ void operator()(const f32x4 (&acc)[2][2][4][2], const Unit& u, int wr, int wc, int fr, int fq) const {
        const int row0 = u.pm * BM + wr * 64 + fr, col0 = u.pn * BM + wc * 32 + 8 * fq;
        const float qs = u.pn < qtiles ? qscale : 1.0f;
#pragma unroll
        for (int ai = 0; ai < 2; ++ai)
#pragma unroll
            for (int m = 0; m < 4; ++m) { bf16_t* rowp = O + (size_t)(row0 + ai * HALF + m * 16) * ldc + col0;
#pragma unroll
                for (int bj = 0; bj < 2; ++bj) { const f32x4 v0 = acc[ai][bj][m][0] * qs, v1 = acc[ai][bj][m][1] * qs;
                    u32x4 w; w.x = cvt_pk_bf16(v0[0], v0[1]); w.y = cvt_pk_bf16(v0[2], v0[3]); w.z = cvt_pk_bf16(v1[0], v1[1]); w.w = cvt_pk_bf16(v1[2], v1[3]);
                    *(u32x4*)(rowp + bj * HALF) = w; } }
    }
};
struct EpiF32Plain {
    static constexpr bool PERM = false;
    float* C; int ldc;
    __device__ __forceinline__ void operator()(const f32x4 (&acc)[2][2][4][2], const Unit& u, int wr, int wc, int fr, int fq) const {
        const int row0 = u.pm * BM + wr * 64 + fr, col0 = u.pn * BM + wc * 32 + 4 * fq;
#pragma unroll
        for (int ai = 0; ai < 2; ++ai)
#pragma unroll
            for (int m = 0; m < 4; ++m) { float* rowp = C + (size_t)(row0 + ai * HALF + m * 16) * ldc + col0;
#pragma unroll
                for (int bj = 0; bj < 2; ++bj)
#pragma unroll
                    for (int n = 0; n < 2; ++n) *(f32x4*)(rowp + bj * HALF + n * 16) = acc[ai][bj][m][n]; }
    }
};
__device__ __forceinline__ void rope8(f32x4& v0, f32x4& v1, const float* cs) {
    const f32x4 a = *(const f32x4*)cs, b = *(const f32x4*)(cs + 4);
    const float x0 = v0[0], x1 = v0[1], x2 = v0[2], x3 = v0[3], y0 = v1[0], y1 = v1[1], y2 = v1[2], y3 = v1[3];
    v0[0] = x0 * a[0] - x1 * a[1]; v0[1] = x0 * a[1] + x1 * a[0];
    v0[2] = x2 * a[2] - x3 * a[3]; v0[3] = x2 * a[3] + x3 * a[2];
    v1[0] = y0 * b[0] - y1 * b[1]; v1[1] = y0 * b[1] + y1 * b[0];
    v1[2] = y2 * b[2] - y3 * b[3]; v1[3] = y2 * b[3] + y3 * b[2];
}
struct EpiQkvA {
    static constexpr bool PERM = true;
    bf16_t* O; const float* rope;
    __device__ __forceinline__ void operator()(const f32x4 (&acc)[2][2][4][2], const Unit& u, int wr, int wc, int fr, int fq) const {
        const int row0 = u.pm * BM + wr * 64 + fr, col0 = u.pn * BM + wc * 32 + 8 * fq;
        const bool do_rope = (u.pm < NL / 256) && (u.pn < 5);
        const float qs = u.pn < 4 ? 0.125f * LOG2E : 1.0f;
#pragma unroll
        for (int ai = 0; ai < 2; ++ai)
#pragma unroll
            for (int m = 0; m < 4; ++m) { const int row = row0 + ai * HALF + m * 16; bf16_t* rowp = O + (size_t)row * A_IN + col0;
#pragma unroll
                for (int bj = 0; bj < 2; ++bj) { f32x4 v0 = acc[ai][bj][m][0], v1 = acc[ai][bj][m][1];
                    if (do_rope) { const int d = (col0 + bj * HALF) & 63; rope8(v0, v1, rope + ((size_t)(row & (SEQ - 1)) * 32 + (d >> 1)) * 2); }
                    v0 = v0 * qs; v1 = v1 * qs;
                    u32x4 w; w.x = cvt_pk_bf16(v0[0], v0[1]); w.y = cvt_pk_bf16(v0[2], v0[3]); w.z = cvt_pk_bf16(v1[0], v1[1]); w.w = cvt_pk_bf16(v1[2], v1[3]);
                    *(u32x4*)(rowp + bj * HALF) = w; }
                asm volatile("" ::: "memory"); }
    }
};
struct EpiMlaUp {
    static constexpr bool PERM = true;
    bf16_t* O; const float* rope;
    __device__ __forceinline__ void operator()(const f32x4 (&acc)[2][2][4][2], const Unit& u, int wr, int wc, int fr, int fq) const {
        const int row0 = u.pm * BM + wr * 64 + fr, col0 = u.pn * BM + wc * 32 + 8 * fq;
        const bool qtile = (u.pm < NL / 256) && (u.pn < 6);
        const float qs = u.pn < 6 ? 0.10206207261596575f * LOG2E : 1.0f;
#pragma unroll
        for (int ai = 0; ai < 2; ++ai)
#pragma unroll
            for (int m = 0; m < 4; ++m) { const int row = row0 + ai * HALF + m * 16; bf16_t* rowp = O + (size_t)row * C_UPN + col0;
#pragma unroll
                for (int bj = 0; bj < 2; ++bj) { f32x4 v0 = acc[ai][bj][m][0], v1 = acc[ai][bj][m][1];
                    const int d96 = (col0 + bj * HALF) % 96;
                    if (qtile && d96 >= 64) rope8(v0, v1, rope + ((size_t)(row & (SEQ - 1)) * 16 + ((d96 - 64) >> 1)) * 2);
                    v0 = v0 * qs; v1 = v1 * qs;
                    u32x4 w; w.x = cvt_pk_bf16(v0[0], v0[1]); w.y = cvt_pk_bf16(v0[2], v0[3]); w.z = cvt_pk_bf16(v1[0], v1[1]); w.w = cvt_pk_bf16(v1[2], v1[3]);
                    *(u32x4*)(rowp + bj * HALF) = w; }
                asm volatile("" ::: "memory"); }
    }
};
struct EpiResid {
    static constexpr bool PERM = false;
    float* XS; const float* gmod; float* XSo;
    __device__ __forceinline__ void operator()(const f32x4 (&acc)[2][2][4][2], const Unit& u, int wr, int wc, int fr, int fq) const {
        const int row0 = u.pm * BM + wr * 64 + fr, col0 = u.pn * BM + wc * 32 + 4 * fq;
        const int rb = u.pm < NL / 256 ? (u.pm >> 3) : 8;
        const float* gv = gmod + (size_t)rb * 6144 + col0;
        f32x4 gg[2][2];
#pragma unroll
        for (int bj = 0; bj < 2; ++bj)
#pragma unroll
            for (int n = 0; n < 2; ++n) gg[bj][n] = *(const f32x4*)(gv + bj * HALF + n * 16);
#pragma unroll
        for (int ai = 0; ai < 2; ++ai)
#pragma unroll
            for (int m = 0; m < 4; ++m) { float* rowp = XS + (size_t)(row0 + ai * HALF + m * 16) * D + col0;
#pragma unroll
                for (int bj = 0; bj < 2; ++bj)
#pragma unroll
                    for (int n = 0; n < 2; ++n) { const f32x4* p = (const f32x4*)(rowp + bj * HALF + n * 16); *(f32x4*)((float*)p + (XSo - XS)) = *p + gg[bj][n] * acc[ai][bj][m][n]; } }
    }
};
struct EpiSwiglu {
    static constexpr bool PERM = true;
    bf16_t* ACT; const float* bg; const float* bu;
    __device__ __forceinline__ void operator()(const f32x4 (&acc)[2][2][4][2], const Unit& u, int wr, int wc, int fr, int fq) const {
        const int row0 = u.pm * BM + wr * 64 + fr, col0 = u.pn * HALF + wc * 32 + 8 * fq;
        const float* pg = bg + (size_t)u.e * D + col0; const float* pu = bu + (size_t)u.e * D + col0;
        const f32x4 g0 = *(const f32x4*)pg, g1 = *(const f32x4*)(pg + 4), u0 = *(const f32x4*)pu, u1 = *(const f32x4*)(pu + 4);
#pragma unroll
        for (int ai = 0; ai < 2; ++ai)
#pragma unroll
            for (int m = 0; m < 4; ++m) { bf16_t* rowp = ACT + (size_t)(row0 + ai * HALF + m * 16) * D + col0;
                float r[8];
#pragma unroll
                for (int n = 0; n < 2; ++n)
#pragma unroll
                    for (int j = 0; j < 4; ++j) {
                        float g = acc[ai][0][m][n][j] + (n ? g1[j] : g0[j]); float uu = acc[ai][1][m][n][j] + (n ? u1[j] : u0[j]);
                        g = fminf(g, 7.0f); uu = fminf(fmaxf(uu, -7.0f), 7.0f);
                        const float sg = __builtin_amdgcn_rcpf(1.0f + __builtin_amdgcn_exp2f(-1.702f * LOG2E * g));
                        r[n * 4 + j] = g * sg * (uu + 1.0f); }
                u32x4 w; w.x = cvt_pk_bf16(r[0], r[1]); w.y = cvt_pk_bf16(r[2], r[3]); w.z = cvt_pk_bf16(r[4], r[5]); w.w = cvt_pk_bf16(r[6], r[7]);
                *(u32x4*)rowp = w; }
    }
};
struct EpiDown {
    static constexpr bool PERM = true;
    bf16_t* YS; const float* bd;
    __device__ __forceinline__ void operator()(const f32x4 (&acc)[2][2][4][2], const Unit& u, int wr, int wc, int fr, int fq) const {
        const int row0 = u.pm * BM + wr * 64 + fr, col0 = u.pn * BM + wc * 32 + 8 * fq;
        const float* pb = bd + (size_t)u.e * D + col0;
        f32x4 bv[2][2];
#pragma unroll
        for (int bj = 0; bj < 2; ++bj)
#pragma unroll
            for (int n = 0; n < 2; ++n) bv[bj][n] = *(const f32x4*)(pb + bj * HALF + 4 * n);
#pragma unroll
        for (int ai = 0; ai < 2; ++ai)
#pragma unroll
            for (int m = 0; m < 4; ++m) { bf16_t* rowp = YS + (size_t)(row0 + ai * HALF + m * 16) * D + col0;
#pragma unroll
                for (int bj = 0; bj < 2; ++bj) { const f32x4 v0 = acc[ai][bj][m][0] + bv[bj][0], v1 = acc[ai][bj][m][1] + bv[bj][1];
                    u32x4 w; w.x = cvt_pk_bf16(v0[0], v0[1]); w.y = cvt_pk_bf16(v0[2], v0[3]); w.z = cvt_pk_bf16(v1[0], v1[1]); w.w = cvt_pk_bf16(v1[2], v1[3]);
                    *(u32x4*)(rowp + bj * HALF) = w; } }
    }
};

struct DenseOrder {
    int nM, nN, vcu, xM, xN0, xNn;
    __device__ __forceinline__ bool short_one() const { const int U = nM * nN + xM * xNn, R = (U + 255) >> 8; return (U & 255) != 0 && vcu >= U - (R - 1) * 256; }
    __device__ __forceinline__ bool next(int i, Unit& u) const {
        int L = i * 256 + vcu; const int nmain = nM * nN;
        if (L < nmain) { const int nig = 8 * nN, gid = L / nig, fm = gid * 8, rem = nM - fm, gsz = rem < 8 ? rem : 8, w = L % nig; u.pm = fm + w % gsz; u.pn = w / gsz; }
        else { L -= nmain; if (L >= xM * xNn) return false; u.pm = nM + L % xM; u.pn = xN0 + L / xM; }
        u.e = 0; u.mt = 0; u.cnt = 0; return true;
    }
};
struct MoeOrder {
    const LAS int* ecnt; const LAS int* lbase; const LAS int* cumt; int nN, vcu; LAS int* ul;
    __device__ __forceinline__ bool short_one() const { const int U = cumt[32] * nN, R = (U + 255) >> 8; return (U & 255) != 0 && vcu >= U - (R - 1) * 256; }
    __device__ __forceinline__ void build(int tid) const {
        if (tid < 16) { const int L = tid * 256 + vcu; int e = -1, pn = 0, mt = 0, pm = 0, c = 0;
            if (L < cumt[32] * nN) { e = 0; while (cumt[e + 1] * nN <= L) ++e; const int r = L - cumt[e] * nN; c = ecnt[e]; const int mte = (c + 255) >> 8; if (MK_MT_MAJOR & (nN == 4 ? 1 : 2)) { pn = r % nN; mt = r / nN; } else { pn = r / mte; mt = r % mte; } pm = (lbase[e] >> 8) + mt; }
            ul[tid * 8 + 0] = e; ul[tid * 8 + 1] = pn; ul[tid * 8 + 2] = mt; ul[tid * 8 + 3] = pm; ul[tid * 8 + 4] = c; }
        __syncthreads();
    }
    __device__ __forceinline__ bool next(int i, Unit& u) const {
        if (i >= 16) return false;
        const int e = __builtin_amdgcn_readfirstlane(ul[i * 8 + 0]);
        if (e < 0) return false;
        u.e = e; u.pn = __builtin_amdgcn_readfirstlane(ul[i * 8 + 1]); u.mt = __builtin_amdgcn_readfirstlane(ul[i * 8 + 2]); u.pm = __builtin_amdgcn_readfirstlane(ul[i * 8 + 3]); u.cnt = __builtin_amdgcn_readfirstlane(ul[i * 8 + 4]); return true;
    }
};
}

namespace att {
constexpr int VSTR = 144;
template <int DQK> struct Cfg { static constexpr int KSTR = DQK * 2 + 16, KB = 64 * KSTR, VB = 64 * VSTR, STAGE = KB + VB, CPR = DQK / 8, NKS = DQK / 16; };
__device__ __forceinline__ int crow(int r, int hi) { return (r & 3) + 8 * (r >> 2) + 4 * hi; }

template <int DQK, bool MLA>
__device__ __forceinline__ void fetchK(u32x4 (&r)[2], const bf16_t* Kb, const bf16_t* KRb, int pitch, int row0, int tid) {
    typedef Cfg<DQK> C;
    { const int key = tid / C::CPR, ch = tid % C::CPR;
      const bf16_t* src = (MLA && ch >= 8) ? KRb + (size_t)(row0 + key) * 32 + (ch - 8) * 8 : Kb + (size_t)(row0 + key) * pitch + ch * 8;
      r[0] = *(const u32x4*)src; }
    if constexpr (DQK == 96) { if (tid < 256) { const int c = 512 + tid, key = c / C::CPR, ch = c % C::CPR;
      const bf16_t* src = (MLA && ch >= 8) ? KRb + (size_t)(row0 + key) * 32 + (ch - 8) * 8 : Kb + (size_t)(row0 + key) * pitch + ch * 8;
      r[1] = *(const u32x4*)src; } }
}
__device__ __forceinline__ void fetchV(u32x4& r, const bf16_t* Vb, int pitch, int row0, int tid) { const int key = tid >> 3, ch = tid & 7; r = *(const u32x4*)(Vb + (size_t)(row0 + key) * pitch + ch * 8); }
template <int DQK>
__device__ __forceinline__ void stashK(LAS unsigned char* kst, const u32x4 (&r)[2], int tid) {
    typedef Cfg<DQK> C;
    { const int key = tid / C::CPR, ch = tid % C::CPR; *(LAS u32x4*)(kst + key * C::KSTR + ch * 16) = r[0]; }
    if constexpr (DQK == 96) { if (tid < 256) { const int c = 512 + tid, key = c / C::CPR, ch = c % C::CPR; *(LAS u32x4*)(kst + key * C::KSTR + ch * 16) = r[1]; } }
}
__device__ __forceinline__ void stashV(LAS unsigned char* vst, const u32x4& r, int tid) { const int key = tid >> 3, ch = tid & 7; *(LAS u32x4*)(vst + key * VSTR + ch * 16) = r; }
template <int DQK, bool MLA>
__device__ __forceinline__ void fetch(u32x4 (&r)[3], const bf16_t* Kb, const bf16_t* Vb, const bf16_t* KRb, int pitch, int row0, int tid) {
    u32x4 k2[2]; k2[1] = (u32x4){0u, 0u, 0u, 0u}; fetchK<DQK, MLA>(k2, Kb, KRb, pitch, row0, tid); r[0] = k2[0]; r[1] = k2[1]; fetchV(r[2], Vb, pitch, row0, tid);
}
template <int DQK>
__device__ __forceinline__ void stash(LAS unsigned char* st, const u32x4 (&r)[3], int tid) {
    const u32x4 k2[2] = {r[0], r[1]}; stashK<DQK>(st, k2, tid); stashV(st + Cfg<DQK>::KB, r[2], tid);
}
template <int DQK>
__device__ __forceinline__ f32x16 qk(const LAS unsigned char* kst, int koff, const bf16x8 (&qr)[DQK / 16], int r32, int hi) {
    typedef Cfg<DQK> C;
    f32x16 p;
#pragma unroll
    for (int r = 0; r < 16; ++r) p[r] = 0.f;
    const LAS unsigned char* kb = kst + (koff + r32) * C::KSTR + hi * 16;
#pragma unroll
    for (int ks = 0; ks < C::NKS; ++ks) { const bf16x8 kf = *(const LAS bf16x8*)(kb + ks * 32); p = __builtin_amdgcn_mfma_f32_32x32x16_bf16(kf, qr[ks], p, 0, 0, 0); }
    return p;
}
__device__ __forceinline__ s16x4 vtr(const LAS unsigned char* p) { return __builtin_bit_cast(s16x4, __builtin_amdgcn_ds_read_tr16_b64_v4i16((LAS s16x4*)p)); }
typedef __bf16 bf16x2_t __attribute__((ext_vector_type(2)));
__device__ __forceinline__ unsigned cvtpk_s(float lo, float hi) { const f32x2 v = {lo, hi}; const bf16x2_t b = __builtin_convertvector(v, bf16x2_t); return __builtin_bit_cast(unsigned, b); }
template <int NS>
__device__ __forceinline__ void sm_max(const f32x16 (&t)[NS], const float sc, f32x16 (&o)[2], float& m, float& l) {
    float mx = t[0][0];
#pragma unroll
    for (int s = 0; s < NS; ++s)
#pragma unroll
        for (int r = 0; r < 16; ++r) mx = fmaxf(mx, t[s][r]);
    mx = swap32_max(mx) * sc;
    if (__any(mx > m + 8.0f)) { const float mn = fmaxf(m, mx); const float a = __builtin_amdgcn_exp2f(m - mn); m = mn; l *= a;
#pragma unroll
        for (int r = 0; r < 16; ++r) { o[0][r] *= a; o[1][r] *= a; } }
}
template <int NS>
__device__ __forceinline__ void sm_exp_pv(f32x16 (&t)[NS], const float sc, const LAS unsigned char* vst, const int (&voff)[NS], f32x16 (&o)[2], const float m, float& l, int lane) {
    const int hi = lane >> 5;
    float rs = 0.f;
#pragma unroll
    for (int s = 0; s < NS; ++s)
#pragma unroll
        for (int r = 0; r < 16; ++r) { t[s][r] = __builtin_amdgcn_exp2f(__builtin_fmaf(t[s][r], sc, -m)); rs += t[s][r]; }
    l += rs;
    const int q4 = (lane & 15) >> 2, p4 = lane & 3, blk = (lane >> 4) & 1;
#pragma unroll
    for (int s = 0; s < NS; ++s) {
        const LAS unsigned char* vb = vst + (voff[s] + 4 * hi + q4) * VSTR + (16 * blk + 4 * p4) * 2;
#pragma unroll
        for (int kk = 0; kk < 2; ++kk) {
            u32x4 pw; pw.x = cvtpk_s(t[s][8 * kk + 0], t[s][8 * kk + 1]); pw.y = cvtpk_s(t[s][8 * kk + 2], t[s][8 * kk + 3]);
            pw.z = cvtpk_s(t[s][8 * kk + 4], t[s][8 * kk + 5]); pw.w = cvtpk_s(t[s][8 * kk + 6], t[s][8 * kk + 7]);
            const bf16x8 pb = __builtin_bit_cast(bf16x8, pw);
#pragma unroll
            for (int c = 0; c < 2; ++c) {
                const s16x4 lo = vtr(vb + (16 * kk) * VSTR + c * 64), h8 = vtr(vb + (16 * kk + 8) * VSTR + c * 64);
                const bf16x8 va = (bf16x8){lo[0], lo[1], lo[2], lo[3], h8[0], h8[1], h8[2], h8[3]};
                o[c] = __builtin_amdgcn_mfma_f32_32x32x16_bf16(va, pb, o[c], 0, 0, 0);
            }
        }
    }
}
template <int NS>
__device__ __forceinline__ void sm_pv(f32x16 (&t)[NS], const float sc, const LAS unsigned char* vst, const int (&voff)[NS], f32x16 (&o)[2], float& m, float& l, int lane) {
    sm_max<NS>(t, sc, o, m, l); sm_exp_pv<NS>(t, sc, vst, voff, o, m, l, lane);
}
template <int DQK>
__device__ __forceinline__ f32x16 qkn(const LAS unsigned char* kst, int koff, const bf16x8 (&qr)[DQK / 16], const f32x16& negm, int r32, int hi) {
    typedef Cfg<DQK> C;
    f32x16 p = negm;
    const LAS unsigned char* kb = kst + (koff + r32) * C::KSTR + hi * 16;
#pragma unroll
    for (int ks = 0; ks < C::NKS; ++ks) { const bf16x8 kf = *(const LAS bf16x8*)(kb + ks * 32); p = __builtin_amdgcn_mfma_f32_32x32x16_bf16(kf, qr[ks], p, 0, 0, 0); }
    return p;
}
__device__ __forceinline__ void sm_max_n(f32x16 (&t)[2], f32x16 (&o)[2], f32x16& osum, float& m, f32x16& negm, bool first) {
    float a0 = fmaxf(fmaxf(t[0][0], t[0][1]), t[0][2]), a1 = fmaxf(fmaxf(t[1][0], t[1][1]), t[1][2]);
#pragma unroll
    for (int r = 3; r < 15; r += 2) { a0 = fmaxf(fmaxf(a0, t[0][r]), t[0][r + 1]); a1 = fmaxf(fmaxf(a1, t[1][r]), t[1][r + 1]); }
    float mx = fmaxf(fmaxf(a0, a1), fmaxf(t[0][15], t[1][15]));
    mx = swap32_max(mx);
    if (first || __any(mx > 8.0f)) { const float d = first ? mx : fmaxf(mx, 0.f); const float a = first ? 1.0f : __builtin_amdgcn_exp2f(-d); m += d;
#pragma unroll
        for (int r = 0; r < 16; ++r) { t[0][r] -= d; t[1][r] -= d; o[0][r] *= a; o[1][r] *= a; osum[r] *= a; negm[r] = -m; } }
}
__device__ __forceinline__ void sm_exp_pv_n(f32x16 (&t)[2], const LAS unsigned char* vst, f32x16 (&o)[2], f32x16& osum, int lane) {
    const int hi = lane >> 5, q4 = (lane & 15) >> 2, p4 = lane & 3, blk = (lane >> 4) & 1;
    const LAS unsigned char* vb = vst + (4 * hi + q4) * VSTR + (16 * blk + 4 * p4) * 2;
    bf16x8 va[2][2][2];
#pragma unroll
    for (int s = 0; s < 2; ++s)
#pragma unroll
        for (int kk = 0; kk < 2; ++kk)
#pragma unroll
            for (int c = 0; c < 2; ++c) { const s16x4 lo = vtr(vb + (32 * s + 16 * kk) * VSTR + c * 64), h8 = vtr(vb + (32 * s + 16 * kk + 8) * VSTR + c * 64);
                va[s][kk][c] = (bf16x8){lo[0], lo[1], lo[2], lo[3], h8[0], h8[1], h8[2], h8[3]}; }
    const bf16x8 ones = (bf16x8){0x3F80, 0x3F80, 0x3F80, 0x3F80, 0x3F80, 0x3F80, 0x3F80, 0x3F80};
#pragma unroll
    for (int s = 0; s < 2; ++s)
#pragma unroll
        for (int kk = 0; kk < 2; ++kk) {
            float e[8];
#pragma unroll
            for (int j = 0; j < 8; ++j) e[j] = __builtin_amdgcn_exp2f(t[s][8 * kk + j]);
            u32x4 pw; pw.x = cvtpk_s(e[0], e[1]); pw.y = cvtpk_s(e[2], e[3]); pw.z = cvtpk_s(e[4], e[5]); pw.w = cvtpk_s(e[6], e[7]);
            const bf16x8 pb = __builtin_bit_cast(bf16x8, pw);
            o[0] = __builtin_amdgcn_mfma_f32_32x32x16_bf16(va[s][kk][0], pb, o[0], 0, 0, 0);
            o[1] = __builtin_amdgcn_mfma_f32_32x32x16_bf16(va[s][kk][1], pb, o[1], 0, 0, 0);
            osum = __builtin_amdgcn_mfma_f32_32x32x16_bf16(ones, pb, osum, 0, 0, 0);
        }
}
__device__ __forceinline__ void finalize_n(const f32x16 (&o)[2], const f32x16& osum, bf16_t* orow, int hi) {
    const float inv = 1.0f / osum[0];
#pragma unroll
    for (int c = 0; c < 2; ++c)
#pragma unroll
        for (int g = 0; g < 4; ++g) { u32x2 w; w.x = cvt_pk_bf16(o[c][4 * g] * inv, o[c][4 * g + 1] * inv); w.y = cvt_pk_bf16(o[c][4 * g + 2] * inv, o[c][4 * g + 3] * inv);
            *(u32x2*)(orow + 32 * c + 8 * g + 4 * hi) = w; }
}
__device__ __forceinline__ void finalize(const f32x16 (&o)[2], float l, bf16_t* orow, int hi) {
    l = swap32_sum(l); const float inv = 1.0f / l;
#pragma unroll
    for (int c = 0; c < 2; ++c)
#pragma unroll
        for (int g = 0; g < 4; ++g) { u32x2 w; w.x = cvt_pk_bf16(o[c][4 * g] * inv, o[c][4 * g + 1] * inv); w.y = cvt_pk_bf16(o[c][4 * g + 2] * inv, o[c][4 * g + 3] * inv);
            *(u32x2*)(orow + 32 * c + 8 * g + 4 * hi) = w; }
}
#define ATT_PIPE_BEGIN(DQK, MLA, ROW0_OF) \
    u32x4 pre[3]; pre[1] = (u32x4){0u, 0u, 0u, 0u}; \
    fetch<DQK, MLA>(pre, Kb, Vb, KRb, pitch, ROW0_OF(0), tid); stash<DQK>(lds, pre, tid); __syncthreads(); \
    for (int i = 0; i < ntiles; ++i) { \
        if (i + 1 < ntiles) fetch<DQK, MLA>(pre, Kb, Vb, KRb, pitch, ROW0_OF(i + 1), tid); \
        const LAS unsigned char* kst = lds + (i & 1) * Cfg<DQK>::STAGE; const LAS unsigned char* vst = kst + Cfg<DQK>::KB;
#define ATT_PIPE_END(DQK) \
        if (i + 1 < ntiles) stash<DQK>(lds + ((i + 1) & 1) * Cfg<DQK>::STAGE, pre, tid); \
        __syncthreads(); }

#define ATT2_RUN(DQK, MLA, ROW0_OF, QK2, FIRST) \
    { typedef Cfg<DQK> C_; LAS unsigned char* const kb_ = lds; LAS unsigned char* const vb_ = lds + 2 * C_::KB; \
    u32x4 pk_[2], pv_; pk_[1] = (u32x4){0u, 0u, 0u, 0u}; \
    fetchK<DQK, MLA>(pk_, Kb, KRb, pitch, ROW0_OF(0), tid); fetchV(pv_, Vb, pitch, ROW0_OF(0), tid); stashK<DQK>(kb_, pk_, tid); stashV(vb_, pv_, tid); \
    if (ntiles > 1) { fetchK<DQK, MLA>(pk_, Kb, KRb, pitch, ROW0_OF(1), tid); stashK<DQK>(kb_ + C_::KB, pk_, tid); } \
    __syncthreads(); \
    f32x16 t[2]; QK2(t, kb_, 0); \
    __syncthreads();     \
    for (int i = 0; i + 1 < ntiles; ++i) { \
        if (i + 2 < ntiles) fetchK<DQK, MLA>(pk_, Kb, KRb, pitch, ROW0_OF(i + 2), tid); \
        fetchV(pv_, Vb, pitch, ROW0_OF(i + 1), tid); \
        sm_max_n(t, o, osum, m, negm, (FIRST) && i == 0); \
        f32x16 tn[2]; QK2(tn, kb_ + ((i + 1) & 1) * C_::KB, i + 1);     \
        sm_exp_pv_n(t, vb_ + (i & 1) * C_::VB, o, osum, lane); \
        t[0] = tn[0]; t[1] = tn[1]; \
        if (i + 2 < ntiles) stashK<DQK>(kb_ + (i & 1) * C_::KB, pk_, tid); \
        stashV(vb_ + ((i + 1) & 1) * C_::VB, pv_, tid); \
        __syncthreads(); } \
    sm_max_n(t, o, osum, m, negm, (FIRST) && ntiles == 1); \
    sm_exp_pv_n(t, vb_ + ((ntiles - 1) & 1) * C_::VB, o, osum, lane); \
    __syncthreads(); }

__device__ __forceinline__ void attn_A_unit(LAS unsigned char* lds, const bf16_t* QKV, bf16_t* O, const float* sink, int b, int kvh, int qb, bool ctxq, int tid) {
    const int lane = tid & 63, wid = __builtin_amdgcn_readfirstlane(tid >> 6), r32 = lane & 31, hi = lane >> 5;
    const int head = kvh * 4 + (wid >> 1), qoff = 32 * (wid & 1) + r32, t0 = qb * 64;
    const int qrow = ctxq ? NL + b * CTXL + t0 + qoff : b * SEQ + t0 + qoff;
    bf16x8 qr[4];
    { const bf16_t* qp = QKV + (size_t)qrow * A_IN + head * 64 + hi * 8;
#pragma unroll
      for (int ks = 0; ks < 4; ++ks) qr[ks] = *(const bf16x8*)(qp + ks * 16); }
    int jlo = 0, nloc = 0;
    if (!ctxq) { jlo = t0 >= 128 ? 0 : (t0 == 64 ? 1 : 2); int jhi = (2112 - t0) / 64; jhi = jhi > 4 ? 4 : jhi; nloc = jhi - jlo + 1; }
    const int ntiles = 4 + nloc, cbase = NL + b * CTXL, lbase = b * SEQ + t0 - 128 + 64 * jlo;
    const bf16_t* Kb = QKV + 1024 + kvh * 64; const bf16_t* Vb = QKV + 1280 + kvh * 64; const bf16_t* KRb = nullptr; const int pitch = A_IN;
    float m = sink[head] * LOG2E;
    f32x16 o[2], osum, negm;
#pragma unroll
    for (int r = 0; r < 16; ++r) { o[0][r] = 0.f; o[1][r] = 0.f; osum[r] = 1.0f; negm[r] = -m; }
#define A_ROW0(i) ((i) < 4 ? cbase + 64 * (i) : lbase + 64 * ((i) - 4))
#define A_QK2(dst, kst, ti) { dst[0] = qkn<64>(kst, 0, qr, negm, r32, hi); dst[1] = qkn<64>(kst, 32, qr, negm, r32, hi); const int j_ = (ti) < 4 ? 2 : jlo + (ti) - 4; \
        if (j_ == 0 || j_ == 4) { _Pragma("unroll") for (int s = 0; s < 2; ++s) _Pragma("unroll") for (int r = 0; r < 16; ++r) { const int kk = 32 * s + crow(r, hi); \
            if (j_ == 0 ? (kk < qoff) : (kk > qoff)) dst[s][r] = -1e30f; } } }
    ATT2_RUN(64, false, A_ROW0, A_QK2, false)
#undef A_QK2
#undef A_ROW0
    finalize_n(o, osum, O + (size_t)qrow * D + head * 64, hi);
}

__device__ __forceinline__ void attn_B_unit(LAS unsigned char* lds, LAS float* tab, const bf16_t* QKV, bf16_t* O, const float* rpb, int b, int h, int rq, bool ctxq, int tid) {
    const int lane = tid & 63, wid = __builtin_amdgcn_readfirstlane(tid >> 6), r32 = lane & 31, hi = lane >> 5;
    const int jb = wid & 3, rp = wid >> 2;
    const int rqa = 4 * rq + 2 * rp + (r32 >> 4), qcol = 16 * jb + (r32 & 15);
    const int qrow = ctxq ? NL + b * CTXL + 32 * wid + r32 : b * SEQ + rqa * 64 + qcol;
    for (int idx = tid; idx < 15 * 31; idx += 512) tab[(idx / 31) * 32 + idx % 31] = rpb[h * 465 + idx] * LOG2E;
    bf16x8 qr[4];
    { const bf16_t* qp = QKV + (size_t)qrow * B_IN + h * 64 + hi * 8;
#pragma unroll
      for (int ks = 0; ks < 4; ++ks) qr[ks] = *(const bf16x8*)(qp + ks * 16); }
    int klo = 0, nloc = 0;
    if (!ctxq) { klo = 4 * rq - 4; klo = klo < 0 ? 0 : (klo > 24 ? 24 : klo); int khi = 4 * rq - 1; khi = khi < 0 ? 0 : (khi > 24 ? 24 : khi); khi += 7; nloc = khi - klo + 1; }
    const int ntiles = 4 + nloc, cbase = NL + b * CTXL, lbase = b * SEQ;
    int r0q = rqa - 4; r0q = r0q < 0 ? 0 : (r0q > 24 ? 24 : r0q);
    int wst = qcol - 8; wst = wst < 0 ? 0 : (wst > 48 ? 48 : wst);
    int cst = 16 * jb - 8; cst = cst < 0 ? 0 : (cst > 32 ? 32 : cst);
    const int lo = wst - cst;
    int wr0 = 4 * rq + 2 * rp - 4; wr0 = wr0 < 0 ? 0 : (wr0 > 24 ? 24 : wr0);
    int wr1 = 4 * rq + 2 * rp + 1 - 4; wr1 = wr1 < 0 ? 0 : (wr1 > 24 ? 24 : wr1); wr1 += 7;
    const bf16_t* Kb = QKV + 1024 + h * 64; const bf16_t* Vb = QKV + 2048 + h * 64; const bf16_t* KRb = nullptr; const int pitch = B_IN;
    float m = -1e30f, l = 0.f;
    f32x16 o[2];
#pragma unroll
    for (int r = 0; r < 16; ++r) { o[0][r] = 0.f; o[1][r] = 0.f; }
    const float sc = 0.125f * LOG2E;
#define B_ROW0(i) ((i) < 4 ? cbase + 64 * (i) : lbase + 64 * (klo + (i) - 4))
    ATT_PIPE_BEGIN(64, false, B_ROW0)
        if (i < 4) {
            f32x16 t[2];
            t[0] = qk<64>(kst, 0, qr, r32, hi); t[1] = qk<64>(kst, 32, qr, r32, hi);
#pragma unroll
            for (int s = 0; s < 2; ++s)
#pragma unroll
                for (int r = 0; r < 16; ++r) t[s][r] *= 1.0f;
            const int voff[2] = {0, 32};
            sm_pv<2>(t, 1.0f, vst, voff, o, m, l, lane);
        } else {
            const int kr = klo + i - 4;
            if (kr >= wr0 && kr <= wr1) {
                f32x16 t[1];
                t[0] = qk<64>(kst, cst, qr, r32, hi);
                const bool rowok = (kr >= r0q) && (kr < r0q + 8);
                const int bidx0 = (kr - rqa + 7) * 32 + cst - qcol + 15;
#pragma unroll
                for (int r = 0; r < 16; ++r) { const int kidx = crow(r, hi); const bool ok = rowok && ((unsigned)(kidx - lo) < 16u);
                    int bi = bidx0 + kidx; bi = bi < 0 ? 0 : (bi > 479 ? 479 : bi);
                    const float bias = tab[bi];
                    t[0][r] = ok ? t[0][r] + bias : -1e30f; }
                const int voff[1] = {cst};
                sm_pv<1>(t, 1.0f, vst, voff, o, m, l, lane);
            }
        }
    ATT_PIPE_END(64)
#undef B_ROW0
    finalize(o, l, O + (size_t)qrow * D + h * 64, hi);
}

__device__ __forceinline__ void attn_C_unit(LAS unsigned char* lds, const bf16_t* Q2, const bf16_t* KR, bf16_t* O, int b, int h, int qb, bool ctxq, int tid) {
    const int lane = tid & 63, wid = __builtin_amdgcn_readfirstlane(tid >> 6), r32 = lane & 31, hi = lane >> 5;
    const int qrow = ctxq ? NL + b * CTXL + 32 * wid + r32 : b * SEQ + qb * 256 + 32 * wid + r32;
    bf16x8 qr[6];
    { const bf16_t* qp = Q2 + (size_t)qrow * C_UPN + h * 96 + hi * 8;
#pragma unroll
      for (int ks = 0; ks < 6; ++ks) qr[ks] = *(const bf16x8*)(qp + ks * 16); }
    const int ntiles = ctxq ? 4 : 36, cbase = NL + b * CTXL, lbase = b * SEQ;
    const bf16_t* Kb = Q2 + 1536 + h * 128; const bf16_t* Vb = Kb + 64; const bf16_t* KRb = KR; const int pitch = C_UPN;
    float m = 0.f;
    f32x16 o[2], osum, negm;
#pragma unroll
    for (int r = 0; r < 16; ++r) { o[0][r] = 0.f; o[1][r] = 0.f; osum[r] = 0.f; negm[r] = 0.f; }
#define C_ROW0(i) ((i) < 4 ? cbase + 64 * (i) : lbase + 64 * ((i) - 4))
#define C_QK2(dst, kst, ti) { dst[0] = qkn<96>(kst, 0, qr, negm, r32, hi); dst[1] = qkn<96>(kst, 32, qr, negm, r32, hi); }
    ATT2_RUN(96, true, C_ROW0, C_QK2, true)
#undef C_QK2
#undef C_ROW0
    finalize_n(o, osum, O + (size_t)qrow * D + h * 64, hi);
}
}

struct Row4 { f32x4 v[4]; };
__device__ __forceinline__ void row_load(Row4& x, const float* p, int lane) {
#pragma unroll
    for (int j = 0; j < 4; ++j) x.v[j] = *(const f32x4*)(p + 4 * lane + 256 * j);
}
__device__ __forceinline__ void row_store(const Row4& x, float* p, int lane) {
#pragma unroll
    for (int j = 0; j < 4; ++j) *(f32x4*)(p + 4 * lane + 256 * j) = x.v[j];
}
__device__ __forceinline__ float row_rstd(const Row4& x, int lane) {
    float s = 0.f;
#pragma unroll
    for (int j = 0; j < 4; ++j) s += (x.v[j][0] * x.v[j][0] + x.v[j][1] * x.v[j][1]) + (x.v[j][2] * x.v[j][2] + x.v[j][3] * x.v[j][3]);
    s = wave_sum(s, lane);
    return 1.0f / sqrtf(s * (1.0f / D) + NORM_EPS);
}
__device__ __forceinline__ void norm_mod(const Row4& x, float rstd, const float* g, const float* sh, const float* sc, bf16_t* out, int lane, Row4& hv) {
#pragma unroll
    for (int j = 0; j < 4; ++j) { const int c = 4 * lane + 256 * j;
        const f32x4 gg = *(const f32x4*)(g + c), s1 = *(const f32x4*)(sc + c), s0 = *(const f32x4*)(sh + c);
        const f32x4 h = (x.v[j] * rstd * gg) * (s1 + 1.0f) + s0; hv.v[j] = h;
        u32x2 w; w.x = cvt_pk_bf16(h[0], h[1]); w.y = cvt_pk_bf16(h[2], h[3]); *(u32x2*)(out + c) = w; }
}

struct Ptrs {
    const float* in[29]; float* out; unsigned char* ws;
};
typedef const __attribute__((address_space(4))) Ptrs* PK;
#define WSP(T, off) ((T*)(P->ws + (off)))

__device__ __forceinline__ unsigned pk_f16(float a, float b) { const f32x2 v = {a, b}; const f16x2 h = __builtin_convertvector(v, f16x2); return __builtin_bit_cast(unsigned, h); }
__device__ __forceinline__ void phase_first_norm(PK P, int gw, int lane) {
    const float* MOD = WSP(const float, WS_MOD);
    {
        const int gt = gw * 64 + lane;
        for (int q = gt; q < DEPTH * 9 * 4096; q += 131072) { const int lb = q >> 12, cc = q & 4095, c = cc >> 5, e = cc & 31, l = lb / 9, b = lb - 9 * l;
            const float* g = P->in[7] + (size_t)l * D + 8 * c; const float* sc = MOD + ((size_t)l * 9 + b) * 6144 + 4096 + 8 * c; const float* w = P->in[21] + ((size_t)l * D + 8 * c) * NEXP + e;
            float v[8];
#pragma unroll
            for (int j = 0; j < 8; ++j) v[j] = g[j] * (1.0f + sc[j]) * w[j * NEXP];
            u32x4 o; o.x = pk_f16(v[0], v[1]); o.y = pk_f16(v[2], v[3]); o.z = pk_f16(v[4], v[5]); o.w = pk_f16(v[6], v[7]);
            *(u32x4*)(WSP(unsigned char, WS_G16) + (size_t)lb * 65536 + e * 2048 + ((c ^ (e & 15)) * 16)) = o; }
        for (int q = gw; q < DEPTH * 9 * 32; q += 2048) { const int lb = q >> 5, e = q & 31, l = lb / 9, b = lb - 9 * l;
            const float* sh = MOD + ((size_t)l * 9 + b) * 6144 + 3072; const float* w = P->in[21] + (size_t)l * D * NEXP + e; float t = 0.f;
#pragma unroll
            for (int j = 0; j < 16; ++j) { const int k = lane + 64 * j; t += sh[k] * w[(size_t)k * NEXP]; }
            t = wave_sum(t, lane);
            if (lane == 0) WSP(float, WS_RC)[q] = t + P->in[22][l * NEXP + e]; }
    }
    for (int r = gw; r < NT; r += 2048) {
        const float* src = r < NL ? P->in[0] + (size_t)r * D : P->in[2] + (size_t)(r - NL) * D;
        Row4 x, hv; row_load(x, src, lane); row_store(x, WSP(float, WS_XS) + (size_t)r * D, lane);
        const float rstd = row_rstd(x, lane); const int rb = r < NL ? (r >> 11) : 8; const float* mod = MOD + (size_t)rb * 6144;
        norm_mod(x, rstd, P->in[6], mod, mod + 1024, WSP(bf16_t, WS_H) + (size_t)r * D, lane, hv);
    }
}
__device__ __forceinline__ void phase_mla_norm(PK P, int gw, int lane) {
    const float* Y = WSP(const float, WS_Y416); bf16_t* CQ = WSP(bf16_t, WS_CQKV); bf16_t* KR = WSP(bf16_t, WS_KR);
    const float* qn = P->in[16]; const float* kn = P->in[17]; const float* rope = WSP(const float, WS_ROPE_C);
    for (int r = gw; r < NT; r += 2048) {
        const float* y = Y + (size_t)r * C_INP;
        const f32x4 v = *(const f32x4*)(y + 4 * lane);
        const float ss = wave_sum((v[0] * v[0] + v[1] * v[1]) + (v[2] * v[2] + v[3] * v[3]), lane);
        const float rq = 1.0f / sqrtf(ss * (1.0f / 256.0f) + NORM_EPS);
        const f32x4 g = *(const f32x4*)(qn + 4 * lane);
        u32x2 w; w.x = cvt_pk_bf16(v[0] * rq * g[0], v[1] * rq * g[1]); w.y = cvt_pk_bf16(v[2] * rq * g[2], v[3] * rq * g[3]);
        *(u32x2*)(CQ + (size_t)r * C_UPK + 4 * lane) = w;
        const f32x2 k2 = *(const f32x2*)(y + 256 + 2 * lane);
        const float s2 = wave_sum(k2[0] * k2[0] + k2[1] * k2[1], lane);
        const float rk = 1.0f / sqrtf(s2 * (1.0f / 128.0f) + NORM_EPS);
        const f32x2 g2 = *(const f32x2*)(kn + 2 * lane);
        *(unsigned*)(CQ + (size_t)r * C_UPK + 256 + 2 * lane) = cvt_pk_bf16(k2[0] * rk * g2[0], k2[1] * rk * g2[1]);
        if (lane < 16) { f32x2 p = *(const f32x2*)(y + 384 + 2 * lane);
            if (r < NL) { const f32x2 cs = *(const f32x2*)(rope + ((size_t)(r & (SEQ - 1)) * 16 + lane) * 2); const float a = p[0], b = p[1]; p[0] = a * cs[0] - b * cs[1]; p[1] = a * cs[1] + b * cs[0]; }
            *(unsigned*)(KR + (size_t)r * 32 + 2 * lane) = cvt_pk_bf16(p[0], p[1]); }
    }
}
__device__ __forceinline__ void moe_tables(LAS unsigned char* misc, unsigned* gcnt, int tid) {
    LAS int* ecnt = (LAS int*)(misc + M_ECNT); LAS int* lbase = (LAS int*)(misc + M_LBASE); LAS int* cumt = (LAS int*)(misc + M_CUMT);
    if (tid < 32) ecnt[tid] = (int)__hip_atomic_load(gcnt + tid * 16, __ATOMIC_RELAXED, __HIP_MEMORY_SCOPE_AGENT);
    __syncthreads();
    if (tid == 0) { int s = 0, t = 0; for (int e = 0; e < 32; ++e) { lbase[e] = s; cumt[e] = t; const int mt = (ecnt[e] + 255) >> 8; s += mt * 256; t += mt; } cumt[32] = t; }
    __syncthreads();
}
constexpr int RT_PLOG = 65536, RT_LOGIT = 98304, RT_SSQ = 102912, RT_RSTD = 103936, RT_CVEC = 104064;
__device__ __forceinline__ void phase_router(PK P, LAS unsigned char* lds, int l, int nrows, int vcu, int tid, int cset) {
    const int lane = tid & 63, wid = __builtin_amdgcn_readfirstlane(tid >> 6), i32 = lane & 31, hi = lane >> 5;
    LAS unsigned char* misc = lds + MISC_OFF;
    LAS int* lcnt = (LAS int*)(misc + M_LCNT); LAS int* gbase = (LAS int*)(misc + M_GBASE); LAS int* rec = (LAS int*)(misc + M_REC);
    LAS float* plog = (LAS float*)(lds + RT_PLOG); LAS float* logit = (LAS float*)(lds + RT_LOGIT); LAS float* ssq = (LAS float*)(lds + RT_SSQ);
    LAS float* rstd_s = (LAS float*)(lds + RT_RSTD); LAS float* cvec = (LAS float*)(lds + RT_CVEC);
    const bool last = (nrows == NL);
    const int nb = (!last && vcu < 64) ? 3 : 2;
    const float* MOD = WSP(const float, WS_MOD) + (size_t)l * 9 * 6144;
    float* XS = WSP(float, WS_XS); bf16_t* H = WSP(bf16_t, WS_H);
    int* TOPE = WSP(int, WS_TOPE); float* GATE = WSP(float, WS_GATE);
    const float* gn = P->in[7] + (size_t)l * D;
    if (tid < 32) lcnt[tid] = 0;
    for (int bi = 0; bi < nb; ++bi) {
        const int rb = bi < 2 ? (vcu >> 5) : 8;
        const int row0 = bi < 2 ? 64 * vcu + 32 * bi : NL + 32 * vcu;
        if (bi != 1) {
            __syncthreads();
            const u32x4* gsrc = (const u32x4*)(WSP(const unsigned char, WS_G16) + (size_t)(l * 9 + rb) * 65536);
#pragma unroll
            for (int c = 0; c < 8; ++c) *(LAS u32x4*)(lds + (size_t)(tid + 512 * c) * 16) = gsrc[tid + 512 * c];
            if (tid < 32) cvec[tid] = WSP(const float, WS_RC)[(l * 9 + rb) * 32 + tid];
            __syncthreads();
        }
        const int r = row0 + i32; const float* xp = XS + (size_t)r * D + 128 * wid + 8 * hi;
        f32x4 xa[8], xb[8];
#pragma unroll
        for (int s = 0; s < 8; ++s) { xa[s] = *(const f32x4*)(xp + 16 * s); xb[s] = *(const f32x4*)(xp + 16 * s + 4); }
        float ss = 0.f;
        f32x16 acc;
#pragma unroll
        for (int q = 0; q < 16; ++q) acc[q] = 0.f;
#pragma unroll
        for (int s = 0; s < 8; ++s) {
            ss += (xa[s][0] * xa[s][0] + xa[s][1] * xa[s][1]) + (xa[s][2] * xa[s][2] + xa[s][3] * xa[s][3]) + (xb[s][0] * xb[s][0] + xb[s][1] * xb[s][1]) + (xb[s][2] * xb[s][2] + xb[s][3] * xb[s][3]);
            u32x4 aw; aw.x = pk_f16(xa[s][0], xa[s][1]); aw.y = pk_f16(xa[s][2], xa[s][3]); aw.z = pk_f16(xb[s][0], xb[s][1]); aw.w = pk_f16(xb[s][2], xb[s][3]);
            const int c = 16 * wid + 2 * s + hi;
            const f16x8 bf = *(const LAS f16x8*)(lds + i32 * 2048 + ((c ^ (i32 & 15)) * 16));
            acc = __builtin_amdgcn_mfma_f32_32x32x16_f16(__builtin_bit_cast(f16x8, aw), bf, acc, 0, 0, 0);
        }
        ss = swap32_sum(ss);
        if (hi == 0) ssq[wid * 32 + i32] = ss;
#pragma unroll
        for (int q = 0; q < 16; ++q) plog[(wid * 32 + att::crow(q, hi)) * 32 + i32] = acc[q];
        __syncthreads();
        if (tid < 32) { float t = 0.f;
#pragma unroll
            for (int w = 0; w < 8; ++w) t += ssq[w * 32 + tid];
            rstd_s[tid] = 1.0f / sqrtf(t * (1.0f / D) + NORM_EPS); }
        __syncthreads();
#pragma unroll
        for (int u = 0; u < 2; ++u) { const int idx = tid + 512 * u, rr = idx >> 5, e = idx & 31; float t = 0.f;
#pragma unroll
            for (int w = 0; w < 8; ++w) t += plog[(w * 32 + rr) * 32 + e];
            logit[rr * 33 + e] = rstd_s[rr] * t + cvec[e]; }
        { const float rs = rstd_s[i32]; const float* mod = MOD + (size_t)rb * 6144; const int k0 = 128 * wid + 8 * hi; bf16_t* hp = H + (size_t)r * D + k0;
#pragma unroll
          for (int s = 0; s < 8; ++s) { const int k = k0 + 16 * s;
              const f32x4 g0 = *(const f32x4*)(gn + k), g1 = *(const f32x4*)(gn + k + 4), c0 = *(const f32x4*)(mod + 4096 + k), c1 = *(const f32x4*)(mod + 4096 + k + 4);
              const f32x4 s0 = *(const f32x4*)(mod + 3072 + k), s1 = *(const f32x4*)(mod + 3072 + k + 4);
              const f32x4 h0 = (xa[s] * rs * g0) * (c0 + 1.0f) + s0, h1 = (xb[s] * rs * g1) * (c1 + 1.0f) + s1;
              u32x4 w; w.x = cvt_pk_bf16(h0[0], h0[1]); w.y = cvt_pk_bf16(h0[2], h0[3]); w.z = cvt_pk_bf16(h1[0], h1[1]); w.w = cvt_pk_bf16(h1[2], h1[3]);
              *(u32x4*)(hp + 16 * s) = w; } }
        __syncthreads();
        if (tid < 32) {
            float t0 = -INFINITY, t1 = -INFINITY, t2 = -INFINITY, t3 = -INFINITY; int e0 = 0, e1 = 0, e2 = 0, e3 = 0;
#pragma unroll 4
            for (int e = 0; e < 32; ++e) { const float v = logit[tid * 33 + e];
                if (v > t3) { if (v > t2) { t3 = t2; e3 = e2; if (v > t1) { t2 = t1; e2 = e1; if (v > t0) { t1 = t0; e1 = e0; t0 = v; e0 = e; } else { t1 = v; e1 = e; } } else { t2 = v; e2 = e; } } else { t3 = v; e3 = e; } } }
            const float x1 = __expf(t1 - t0), x2 = __expf(t2 - t0), x3 = __expf(t3 - t0); const float inv = 1.0f / (1.0f + x1 + x2 + x3);
            const int rr = row0 + tid, lr = 32 * bi + tid;
            *(int4*)(TOPE + (size_t)rr * 4) = make_int4(e0, e1, e2, e3);
            *(f32x4*)(GATE + (size_t)rr * 4) = (f32x4){inv, x1 * inv, x2 * inv, x3 * inv};
            const int ee[4] = {e0, e1, e2, e3};
#pragma unroll
            for (int k = 0; k < 4; ++k) { const int lp = __hip_atomic_fetch_add(lcnt + ee[k], 1, __ATOMIC_RELAXED, __HIP_MEMORY_SCOPE_WORKGROUP); rec[2 * (lr * 4 + k)] = ee[k]; rec[2 * (lr * 4 + k) + 1] = lp; }
        }
    }
    __syncthreads();
    unsigned* gcnt = WSP(unsigned, WS_CTL) + CW_CNT + (l * 2 + cset) * 512;
    if (tid < 32) { const int c = lcnt[tid]; gbase[tid] = c ? (int)__hip_atomic_fetch_add(gcnt + tid * 16, (unsigned)c, __ATOMIC_RELAXED, __HIP_MEMORY_SCOPE_AGENT) : 0; }
    __syncthreads();
    int* ELIST = WSP(int, WS_ELIST); int* POS = WSP(int, WS_POS);
    for (int idx = tid; idx < nb * 128; idx += 512) { const int e = rec[2 * idx], pos = gbase[e] + rec[2 * idx + 1]; const int lr = idx >> 2; const int r = lr < 64 ? 64 * vcu + lr : NL + 32 * vcu + (lr - 64);
        ELIST[(size_t)e * NT + pos] = r; POS[(size_t)r * 4 + (idx & 3)] = pos; }
    __syncthreads();
}
__device__ __forceinline__ void phase_combine(PK P, LAS unsigned char* lds, int l, int nrows, int gw, int tid, bool dry) {
    const int lane = tid & 63;
    LAS unsigned char* misc = lds + MISC_OFF;
    moe_tables(misc, WSP(unsigned, WS_CTL) + CW_CNT + (l * 2 + ((MK_REP_MASK >> 11) & 1)) * 512, tid);
    const size_t dryoff = dry ? (WS_ACT - WS_XS) / 4 : 0;
    const LAS int* lbase = (const LAS int*)(misc + M_LBASE);
    const float* MOD = WSP(const float, WS_MOD); const float* g2 = MOD + (size_t)l * 9 * 6144 + 5120;
    float* XS = WSP(float, WS_XS); const bf16_t* YS = WSP(const bf16_t, WS_YS);
    const int* TOPE = WSP(const int, WS_TOPE); const int* POS = WSP(const int, WS_POS); const float* GATE = WSP(const float, WS_GATE);
    const bool last = (l == DEPTH - 1);
    for (int r = gw; r < nrows; r += 2048) {
        int slot = 0; float gate = 0.f;
        if (lane < 4) { slot = lbase[TOPE[(size_t)r * 4 + lane]] + POS[(size_t)r * 4 + lane]; gate = GATE[(size_t)r * 4 + lane]; }
        Row4 x; row_load(x, XS + (size_t)r * D, lane);
        Row4 f;
#pragma unroll
        for (int j = 0; j < 4; ++j) f.v[j] = (f32x4){0.f, 0.f, 0.f, 0.f};
#pragma unroll
        for (int k = 0; k < 4; ++k) { const int sk = __builtin_amdgcn_readlane(slot, k); const float gk = __int_as_float(__builtin_amdgcn_readlane(__float_as_int(gate), k)); const bf16_t* yr = YS + (size_t)sk * D;
#pragma unroll
            for (int j = 0; j < 4; ++j) { const u32x2 w = *(const u32x2*)(yr + 4 * lane + 256 * j);
                f.v[j][0] += gk * bf_lo(w.x); f.v[j][1] += gk * bf_hi(w.x); f.v[j][2] += gk * bf_lo(w.y); f.v[j][3] += gk * bf_hi(w.y); } }
        const int rb = r < NL ? (r >> 11) : 8;
#pragma unroll
        for (int j = 0; j < 4; ++j) { const f32x4 gg = *(const f32x4*)(g2 + (size_t)rb * 6144 + 4 * lane + 256 * j); x.v[j] = x.v[j] + gg * f.v[j]; }
        const float rstd = row_rstd(x, lane);
        if (last) {
#pragma unroll
            for (int j = 0; j < 4; ++j) { const int c = 4 * lane + 256 * j; const f32x4 gn = *(const f32x4*)(P->in[8] + c); *(f32x4*)((dry ? XS + dryoff : P->out) + (size_t)r * D + c) = x.v[j] * rstd * gn; }
        } else {
            row_store(x, XS + dryoff + (size_t)r * D, lane);
            Row4 hv; const float* mod = MOD + (size_t)(l + 1) * 9 * 6144 + (size_t)rb * 6144;
            norm_mod(x, rstd, P->in[6] + (size_t)(l + 1) * D, mod, mod + 1024, (dry ? WSP(bf16_t, WS_ACT + 80 * MiB) : WSP(bf16_t, WS_H)) + (size_t)r * D, lane, hv);
        }
    }
}
__device__ __forceinline__ void phase_final_norm(PK P, int gw, int lane) {
    for (int r = gw; r < NL; r += 2048) { Row4 x; row_load(x, WSP(float, WS_XS) + (size_t)r * D, lane); const float rstd = row_rstd(x, lane);
#pragma unroll
        for (int j = 0; j < 4; ++j) { const int c = 4 * lane + 256 * j; const f32x4 gn = *(const f32x4*)(P->in[8] + c); *(f32x4*)(P->out + (size_t)r * D + c) = x.v[j] * rstd * gn; } }
}

__device__ __forceinline__ void conv_item(const float* src, int N, int nvalid, int k0, int n0, bf16_t* dst, int ldk, int drow0, int dk0, LAS unsigned* scr, int lane) {
    const int q = lane >> 4, nl = lane & 15, n = n0 + 4 * nl;
    f32x4 v[16];
#pragma unroll
    for (int r = 0; r < 16; ++r) { const int k = k0 + 8 * (r >> 1) + 2 * q + (r & 1);
        v[r] = (n < nvalid) ? __builtin_nontemporal_load((const f32x4*)(src + (size_t)k * N + n)) : (f32x4){0.f, 0.f, 0.f, 0.f}; }
#pragma unroll
    for (int rp = 0; rp < 8; ++rp)
#pragma unroll
        for (int i = 0; i < 4; ++i) { const int nn = 4 * nl + i, kw = 4 * rp + q; scr[nn * 32 + (kw ^ (4 * ((nn >> 2) & 7)))] = cvt_pk_bf16(v[2 * rp][i], v[2 * rp + 1][i]); }
    asm volatile("s_waitcnt lgkmcnt(0)" ::: "memory");
#pragma unroll
    for (int it = 0; it < 8; ++it) { const int nn = 8 * it + (lane >> 3), c = lane & 7;
        const u32x4 w = *(const LAS u32x4*)(scr + nn * 32 + 4 * (c ^ ((nn >> 2) & 7)));
        *(u32x4*)(dst + (size_t)(drow0 + nn) * ldk + dk0 + 8 * c) = w; }
    asm volatile("s_waitcnt lgkmcnt(0)" ::: "memory");
}
constexpr int CV_A_IN = 2 * 16 * 24, CV_A_OUT = 2 * 256, CV_B_IN = 16 * 48, CV_B_OUT = 256, CV_C_IN = 16 * 8, CV_C_UQ = 4 * 24, CV_C_UKV = 2 * 32, CV_C_OUT = 256;
constexpr int CV_SMALL = CV_A_IN + CV_A_OUT + CV_B_IN + CV_B_OUT + CV_C_IN + CV_C_UQ + CV_C_UKV + CV_C_OUT;
constexpr int CV_LAYER = NEXP * 3 * 256;
constexpr int CV_TOTAL = CV_SMALL + DEPTH * CV_LAYER;
constexpr int CV_CHUNK = 32;
__device__ __forceinline__ void conv_dispatch(PK P, int item, LAS unsigned* scr, int lane) {
    int r = item;
    if (r < CV_A_IN) { const int s = r / 384, it = r % 384, kb = it / 24, nb = it % 24;
        conv_item(P->in[9] + (size_t)s * D * A_IN, A_IN, A_IN, 64 * kb, 64 * nb, WSP(bf16_t, WS_WA_IN) + (size_t)s * A_IN * D, D, 64 * nb, 64 * kb, scr, lane); return; } r -= CV_A_IN;
    if (r < CV_A_OUT) { const int s = r / 256, it = r % 256, kb = it / 16, nb = it % 16;
        conv_item(P->in[10] + (size_t)s * D * D, D, D, 64 * kb, 64 * nb, WSP(bf16_t, WS_WA_OUT) + (size_t)s * D * D, D, 64 * nb, 64 * kb, scr, lane); return; } r -= CV_A_OUT;
    if (r < CV_B_IN) { const int kb = r / 48, nb = r % 48;
        conv_item(P->in[12], B_IN, B_IN, 64 * kb, 64 * nb, WSP(bf16_t, WS_WB_IN), D, 64 * nb, 64 * kb, scr, lane); return; } r -= CV_B_IN;
    if (r < CV_B_OUT) { const int kb = r / 16, nb = r % 16;
        conv_item(P->in[13], D, D, 64 * kb, 64 * nb, WSP(bf16_t, WS_WB_OUT), D, 64 * nb, 64 * kb, scr, lane); return; } r -= CV_B_OUT;
    if (r < CV_C_IN) { const int kb = r / 8, nb = r % 8;
        conv_item(P->in[15], C_IN, C_IN, 64 * kb, 64 * nb, WSP(bf16_t, WS_WC_IN), D, 64 * nb, 64 * kb, scr, lane); return; } r -= CV_C_IN;
    if (r < CV_C_UQ) { const int kb = r / 24, nb = r % 24;
        conv_item(P->in[18], 1536, 1536, 64 * kb, 64 * nb, WSP(bf16_t, WS_WC_UP), C_UPK, 64 * nb, 64 * kb, scr, lane); return; } r -= CV_C_UQ;
    if (r < CV_C_UKV) { const int kb = r / 32, nb = r % 32;
        conv_item(P->in[19], 2048, 2048, 64 * kb, 64 * nb, WSP(bf16_t, WS_WC_UP), C_UPK, 1536 + 64 * nb, 256 + 64 * kb, scr, lane); return; } r -= CV_C_UKV;
    if (r < CV_C_OUT) { const int kb = r / 16, nb = r % 16;
        conv_item(P->in[20], D, D, 64 * kb, 64 * nb, WSP(bf16_t, WS_WC_OUT), D, 64 * nb, 64 * kb, scr, lane); return; } r -= CV_C_OUT;
    const int mat = r >> 8, it = r & 255, kb = it >> 4, nb = it & 15, which = mat % 3, le = mat / 3;
    if (which == 2) { conv_item(P->in[27] + (size_t)le * D * D, D, D, 64 * kb, 64 * nb, WSP(bf16_t, WS_WD) + (size_t)le * D * D, D, 64 * nb, 64 * kb, scr, lane); return; }
    const int n0 = 64 * nb, drow0 = 256 * (n0 >> 7) + (n0 & 127) + (which ? 128 : 0);
    conv_item(P->in[which ? 25 : 23] + (size_t)le * D * D, D, D, 64 * kb, n0, WSP(bf16_t, WS_WGU) + (size_t)le * 2 * D * D, D, drow0, 64 * kb, scr, lane);
}
__device__ __forceinline__ void conv_claim(PK P, LAS unsigned char* lds, int L, int quota, int tid) {
    const int lane = tid & 63, wid = __builtin_amdgcn_readfirstlane(tid >> 6);
    LAS int* slot = (LAS int*)(lds + MISC_OFF + M_CVB);
    unsigned* ctr = WSP(unsigned, WS_CTL) + CW_CV + L * 16;
    LAS unsigned* scr = (LAS unsigned*)(lds + wid * 8192);
    for (int q = 0; q < quota; ++q) {
        __syncthreads();
        if (tid == 0) *slot = (int)__hip_atomic_fetch_add(ctr, (unsigned)CV_CHUNK, __ATOMIC_RELAXED, __HIP_MEMORY_SCOPE_AGENT);
        __syncthreads();
        const int base = __builtin_amdgcn_readfirstlane(*slot);
        if (base >= CV_LAYER) break;
#pragma unroll 1
        for (int j = 0; j < CV_CHUNK / 8; ++j) conv_dispatch(P, CV_SMALL + L * CV_LAYER + base + wid + 8 * j, scr, lane);
    }
    __syncthreads();
}
__device__ __forceinline__ void phase_prologue(PK P, LAS unsigned char* lds, int bid, int tid) {
    const int lane = tid & 63, wid = __builtin_amdgcn_readfirstlane(tid >> 6);
    {
        LAS float* S = (LAS float*)lds; LAS float* red = (LAS float*)(lds + 40960);
        for (int idx = tid; idx < 9 * D; idx += 512) { const int r = idx >> 10, d = idx & (D - 1); const float v = r < 8 ? P->in[1][r * D + d] : P->in[3][d];
            S[idx] = v / (1.0f + __builtin_amdgcn_exp2f(-v * LOG2E)); }
        __syncthreads();
        const int l = bid >> 6, c0 = (bid & 63) * 96;
        if (lane < 48) {
            float acc[9][2];
#pragma unroll
            for (int r = 0; r < 9; ++r) { acc[r][0] = 0.f; acc[r][1] = 0.f; }
            const float* wp = P->in[4] + ((size_t)l * D + 128 * wid) * 6144 + c0 + 2 * lane;
            const LAS float* sp = S + 128 * wid;
#pragma unroll 8
            for (int k = 0; k < 128; ++k) { const f32x2 w = *(const f32x2*)(wp + (size_t)k * 6144);
#pragma unroll
                for (int r = 0; r < 9; ++r) { const float s = sp[r * D + k]; acc[r][0] += s * w[0]; acc[r][1] += s * w[1]; } }
#pragma unroll
            for (int r = 0; r < 9; ++r) { red[(wid * 9 + r) * 96 + 2 * lane] = acc[r][0]; red[(wid * 9 + r) * 96 + 2 * lane + 1] = acc[r][1]; }
        }
        __syncthreads();
        float* MOD = WSP(float, WS_MOD);
        for (int idx = tid; idx < 9 * 96; idx += 512) { const int r = idx / 96, cc = idx % 96; float s = 0.f;
#pragma unroll
            for (int w = 0; w < 8; ++w) s += red[(w * 9 + r) * 96 + cc];
            MOD[((size_t)l * 9 + r) * 6144 + c0 + cc] = s + P->in[5][(size_t)l * 6144 + c0 + cc]; }
        __syncthreads();
    }
    {
        const int gt = bid * 512 + tid; float* RA = WSP(float, WS_ROPE_A); float* RC = WSP(float, WS_ROPE_C);
        const float L2T = 13.287712379549449f;
        for (int idx = gt; idx < SEQ * 32; idx += 131072) { const int t = idx >> 5, i = idx & 31; const float pos = (float)(i < 16 ? (t >> 6) : (t & 63));
            const float inv = __builtin_amdgcn_exp2f(-(float)(i & 15) * (1.0f / 16.0f) * L2T); const float ang = pos * inv; RA[2 * idx] = __cosf(ang); RA[2 * idx + 1] = __sinf(ang); }
        for (int idx = gt; idx < SEQ * 16; idx += 131072) { const int t = idx >> 4, i = idx & 15; const float pos = (float)(i < 8 ? (t >> 6) : (t & 63));
            const float inv = __builtin_amdgcn_exp2f(-(float)(i & 7) * (1.0f / 8.0f) * L2T); const float ang = pos * inv; RC[2 * idx] = __cosf(ang); RC[2 * idx + 1] = __sinf(ang); }
        bf16_t* WU = WSP(bf16_t, WS_WC_UP); const u32x4 z = (u32x4){0u, 0u, 0u, 0u};
        for (int idx = gt; idx < 1536 * 16; idx += 131072) *(u32x4*)(WU + (size_t)(idx >> 4) * C_UPK + 256 + 8 * (idx & 15)) = z;
        for (int idx = gt; idx < 2048 * 32; idx += 131072) *(u32x4*)(WU + (size_t)(1536 + (idx >> 5)) * C_UPK + 8 * (idx & 31)) = z;
    }
    {
        LAS unsigned* scr = (LAS unsigned*)(lds + wid * 8192);
        const int gw = bid * 8 + wid;
        for (int item = gw; item < CV_SMALL + CV_LAYER; item += 2048) conv_dispatch(P, item, scr, lane);
    }
}

constexpr int PH_PRO = 0, PH_N0 = 1, PH_L0 = 2, PH_PER_LAYER = 9, PH_FINAL = PH_L0 + DEPTH * PH_PER_LAYER, NPH = PH_FINAL + 1;
enum { LP_IN = 0, LP_MLANORM = 1, LP_MLAUP = 2, LP_ATT = 3, LP_OUT = 4, LP_RT = 5, LP_GU = 6, LP_DN = 7, LP_CB = 8 };
struct Args { Ptrs P; int p_lo, p_hi, bar_idx, pad; };

__global__ void __launch_bounds__(512, 2) mk_fwd(Args a) {
    extern __shared__ __attribute__((aligned(16))) unsigned char lds_raw[];
    LAS unsigned char* const lds = (LAS unsigned char*)lds_raw;
    LAS unsigned char* const misc = lds + MISC_OFF;
    typedef const __attribute__((address_space(4))) Args* ArgsK;
    const ArgsK ak = (ArgsK)__builtin_amdgcn_kernarg_segment_ptr();
    (void)a;
    const int wid0 = __builtin_amdgcn_readfirstlane((int)threadIdx.x >> 6);
    if (wid0 == 0 && lane_id() < 4) ((LAS unsigned*)(misc + M_BARW))[lane_id()] = 0u;
    __syncthreads();
    XcdBarrier bar;
    { PK P = &ak->P; bar = xcd_barrier_post(WSP(unsigned, WS_CTL) + CW_BAR + ak->bar_idx * XCD_BAR_WORDS, (volatile LAS unsigned*)(misc + M_BARW), wid0 == 0); }
    bool ran = false;
    const int p_lo = ak->p_lo, p_hi = ak->p_hi;
#define PHASE_BEGIN(bit, p, cond) if ((((MK_MASK) >> (bit)) & 1) && p_lo <= (p) && (p) < p_hi && ((p) <= MK_STOP_AFTER || (p) == PH_FINAL) && (cond)) for (int rep_ = 0; rep_ < 1 + (((MK_REP_MASK) >> (bit)) & 1); ++rep_) { if (ran) xcd_barrier(bar); ran = true; \
    int tid = wid0 * 64 + lane_id(); asm volatile("" : "+v"(tid)); int bid = blockIdx.x; asm volatile("" : "+s"(bid)); ArgsK ak_ = ak; asm volatile("" : "+s"(ak_)); PK P = &ak_->P; \
    const int lane = tid & 63, wid = __builtin_amdgcn_readfirstlane(tid >> 6), vcu = (bid & 7) * 32 + (bid >> 3), gw = vcu * 8 + wid; (void)lane; (void)gw; (void)P;
#define PHASE_END }

    PHASE_BEGIN(0, PH_PRO, true) phase_prologue(P, lds, bid, tid); PHASE_END
    PHASE_BEGIN(1, PH_N0, true) phase_first_norm(P, gw, lane); PHASE_END

    for (int l = 0; l < DEPTH; ++l) {
        const int kind = l % 3, slot = l / 3, pb = PH_L0 + l * PH_PER_LAYER;
        const bool last = (l == DEPTH - 1);
        const int nMrows = last ? NL / 256 : NT / 256;
        PHASE_BEGIN(2, pb + LP_IN, kind == 0) {
            pg8::Gemm g{WSP(const bf16_t, WS_H), WSP(const bf16_t, WS_WA_IN) + (size_t)slot * A_IN * D, D, 0, nullptr};
            pg8::DenseOrder S{nMrows, 6, vcu, last ? 8 : 0, 4, 2};
            pg8::EpiQkvA E{WSP(bf16_t, WS_QKV), WSP(const float, WS_ROPE_A)};
            pg8::gemm_phase<pg8::EpiQkvA, pg8::DenseOrder, false>(lds, g, S, E, tid);
            if (l >= 1 && S.short_one()) conv_claim(P, lds, l, MK_Q_IN, tid);
        } PHASE_END
        PHASE_BEGIN(3, pb + LP_IN, kind == 1) {
            pg8::Gemm g{WSP(const bf16_t, WS_H), WSP(const bf16_t, WS_WB_IN), D, 0, nullptr};
            pg8::DenseOrder S{NT / 256, 12, vcu, 0, 0, 0};
            pg8::EpiBf16Plain E{WSP(bf16_t, WS_QKV), B_IN, 4, 0.125f * LOG2E};
            pg8::gemm_phase<pg8::EpiBf16Plain, pg8::DenseOrder, false>(lds, g, S, E, tid);
            if (S.short_one()) conv_claim(P, lds, l, MK_Q_IN, tid);
        } PHASE_END
        PHASE_BEGIN(4, pb + LP_IN, kind == 2) {
            pg8::Gemm g{WSP(const bf16_t, WS_H), WSP(const bf16_t, WS_WC_IN), D, 0, nullptr};
            pg8::DenseOrder S{NT / 256, 2, vcu, 0, 0, 0};
            pg8::EpiF32Plain E{WSP(float, WS_Y416), C_INP};
            pg8::gemm_phase<pg8::EpiF32Plain, pg8::DenseOrder, false>(lds, g, S, E, tid);
            if (S.short_one()) conv_claim(P, lds, l, MK_Q_IN, tid);
        } PHASE_END
        PHASE_BEGIN(5, pb + LP_MLANORM, kind == 2) phase_mla_norm(P, gw, lane); PHASE_END
        PHASE_BEGIN(6, pb + LP_MLAUP, kind == 2) {
            pg8::Gemm g{WSP(const bf16_t, WS_CQKV), WSP(const bf16_t, WS_WC_UP), C_UPK, 0, nullptr};
            pg8::DenseOrder S{NT / 256, 14, vcu, 0, 0, 0};
            pg8::EpiMlaUp E{WSP(bf16_t, WS_QKV), WSP(const float, WS_ROPE_C)};
            pg8::gemm_phase<pg8::EpiMlaUp, pg8::DenseOrder, false>(lds, g, S, E, tid);
        } PHASE_END
        PHASE_BEGIN(7, pb + LP_ATT, kind == 0) {
            const bf16_t* QKV = WSP(const bf16_t, WS_QKV); bf16_t* O = WSP(bf16_t, WS_O); const float* sink = P->in[11] + slot * 16;
            for (int u = vcu; u < 1024; u += 256) { const int bk = u >> 5; att::attn_A_unit(lds, QKV, O, sink, bk >> 2, bk & 3, u & 31, false, tid); }
            if (!last) for (int u = vcu; u < 128; u += 256) { const int bk = u >> 2; att::attn_A_unit(lds, QKV, O, sink, bk >> 2, bk & 3, u & 3, true, tid); }
        } PHASE_END
        PHASE_BEGIN(8, pb + LP_ATT, kind == 1) {
            const bf16_t* QKV = WSP(const bf16_t, WS_QKV); bf16_t* O = WSP(bf16_t, WS_O); LAS float* tab = (LAS float*)(misc + M_RPB);
            for (int u = vcu; u < 1024; u += 256) { const int bh = u >> 3; att::attn_B_unit(lds, tab, QKV, O, P->in[14], bh >> 4, bh & 15, u & 7, false, tid); }
            for (int u = vcu; u < 128; u += 256) att::attn_B_unit(lds, tab, QKV, O, P->in[14], u >> 4, u & 15, 0, true, tid);
        } PHASE_END
        PHASE_BEGIN(9, pb + LP_ATT, kind == 2) {
            const bf16_t* QKV = WSP(const bf16_t, WS_QKV); bf16_t* O = WSP(bf16_t, WS_O); const bf16_t* KR = WSP(const bf16_t, WS_KR);
            for (int u = vcu; u < 1024; u += 256) { const int bh = u >> 3; att::attn_C_unit(lds, QKV, KR, O, bh >> 4, bh & 15, u & 7, false, tid); }
            for (int u = vcu; u < 128; u += 256) att::attn_C_unit(lds, QKV, KR, O, u >> 4, u & 15, 0, true, tid);
        } PHASE_END
        PHASE_BEGIN(10, pb + LP_OUT, true) {
            const bf16_t* W = kind == 0 ? WSP(const bf16_t, WS_WA_OUT) + (size_t)slot * D * D : (kind == 1 ? WSP(const bf16_t, WS_WB_OUT) : WSP(const bf16_t, WS_WC_OUT));
            pg8::Gemm g{WSP(const bf16_t, WS_O), W, D, 0, nullptr};
            pg8::DenseOrder S{nMrows, 4, vcu, 0, 0, 0};
            pg8::EpiResid E{WSP(float, WS_XS), WSP(const float, WS_MOD) + (size_t)l * 9 * 6144 + 2048, (rep_ + 1 < 1 + ((MK_REP_MASK >> 10) & 1)) ? WSP(float, WS_ACT) : WSP(float, WS_XS)};
            pg8::gemm_phase<pg8::EpiResid, pg8::DenseOrder, false>(lds, g, S, E, tid);
            if (!last && S.short_one()) conv_claim(P, lds, l + 1, MK_Q_OUT, tid);
        } PHASE_END
        PHASE_BEGIN(11, pb + LP_RT, true) { if (l >= 1) conv_claim(P, lds, l, 1 << 30, tid); phase_router(P, lds, l, last ? NL : NT, vcu, tid, rep_); } PHASE_END
        PHASE_BEGIN(12, pb + LP_GU, true) {
            moe_tables(misc, WSP(unsigned, WS_CTL) + CW_CNT + (l * 2 + ((MK_REP_MASK >> 11) & 1)) * 512, tid);
            pg8::Gemm g{WSP(const bf16_t, WS_H), WSP(const bf16_t, WS_WGU) + (size_t)l * NEXP * 2 * D * D, D, (size_t)2 * D * D, WSP(const int, WS_ELIST)};
            pg8::MoeOrder S{(const LAS int*)(misc + M_ECNT), (const LAS int*)(misc + M_LBASE), (const LAS int*)(misc + M_CUMT), 8, vcu, (LAS int*)(misc + M_UL)}; S.build(tid);
            pg8::EpiSwiglu E{WSP(bf16_t, WS_ACT), P->in[24] + (size_t)l * NEXP * D, P->in[26] + (size_t)l * NEXP * D};
            pg8::gemm_phase<pg8::EpiSwiglu, pg8::MoeOrder, true>(lds, g, S, E, tid);
            if (!last && S.short_one()) conv_claim(P, lds, l + 1, MK_Q_GU, tid);
        } PHASE_END
        PHASE_BEGIN(13, pb + LP_DN, true) {
            moe_tables(misc, WSP(unsigned, WS_CTL) + CW_CNT + (l * 2 + ((MK_REP_MASK >> 11) & 1)) * 512, tid);
            pg8::Gemm g{WSP(const bf16_t, WS_ACT), WSP(const bf16_t, WS_WD) + (size_t)l * NEXP * D * D, D, (size_t)D * D, nullptr};
            pg8::MoeOrder S{(const LAS int*)(misc + M_ECNT), (const LAS int*)(misc + M_LBASE), (const LAS int*)(misc + M_CUMT), 4, vcu, (LAS int*)(misc + M_UL)}; S.build(tid);
            pg8::EpiDown E{WSP(bf16_t, WS_YS), P->in[28] + (size_t)l * NEXP * D};
            pg8::gemm_phase<pg8::EpiDown, pg8::MoeOrder, false>(lds, g, S, E, tid);
            if (!last && S.short_one()) conv_claim(P, lds, l + 1, MK_Q_DN, tid);
        } PHASE_END
        PHASE_BEGIN(14, pb + LP_CB, true) phase_combine(P, lds, l, last ? NL : NT, gw, tid, (rep_ + 1 < 1 + ((MK_REP_MASK >> 14) & 1))); PHASE_END
    }
    PHASE_BEGIN(15, PH_FINAL, MK_STOP_AFTER < PH_FINAL - 1) phase_final_norm(P, gw, lane); PHASE_END
#undef PHASE_BEGIN
#undef PHASE_END
}

extern "C" void kernel_launch(void* const* d_in, const int* in_sizes, int n_in, void* d_out, int out_size, void* d_ws, size_t ws_size, hipStream_t stream) {
    static int grid = 0;
    if (grid == 0) {
        if (n_in != 29 || out_size != NL * D || ws_size < WS_END) { fprintf(stderr, "kernel_launch: expected 29 inputs, out %d, ws >= %zu; got n_in %d out %d ws %zu\n", NL * D, (size_t)WS_END, n_in, out_size, ws_size); grid = -1; return; }
        int dev = 0, cus = 0, per_cu = 0;
        if (hipGetDevice(&dev) != hipSuccess || hipDeviceGetAttribute(&cus, hipDeviceAttributeMultiprocessorCount, dev) != hipSuccess) { grid = -1; return; }
        if (hipFuncSetAttribute((const void*)mk_fwd, hipFuncAttributeMaxDynamicSharedMemorySize, LDS_BYTES) != hipSuccess) { fprintf(stderr, "kernel_launch: hipFuncSetAttribute failed\n"); grid = -1; return; }
        if (hipOccupancyMaxActiveBlocksPerMultiprocessor(&per_cu, (const void*)mk_fwd, 512, LDS_BYTES) != hipSuccess || per_cu < 1) fprintf(stderr, "kernel_launch: occupancy query says %d\n", per_cu);
        (void)hipGetLastError();
        grid = 256;
        if (cus < 256) { fprintf(stderr, "kernel_launch: needs 256 CUs, device has %d\n", cus); grid = -1; return; }
    }
    if (grid < 0) return;
    if (hipMemsetAsync((char*)d_ws + WS_CTL, 0, CTL_BYTES, stream) != hipSuccess) return;
    Args a{};
    for (int i = 0; i < 29; ++i) a.P.in[i] = (const float*)d_in[i];
    a.P.out = (float*)d_out; a.P.ws = (unsigned char*)d_ws; a.pad = 0;
#if MK_PER_PHASE
    for (int p = 0; p < NPH; ++p) { a.p_lo = p; a.p_hi = p + 1; a.bar_idx = 0; hipLaunchKernelGGL(mk_fwd, dim3(grid), dim3(512), LDS_BYTES, stream, a); }
#else
    a.p_lo = 0; a.p_hi = NPH; a.bar_idx = 0;
    hipLaunchKernelGGL(mk_fwd, dim3(grid), dim3(512), LDS_BYTES, stream, a);
#endif
    const hipError_t le = hipPeekAtLastError();
    if (le != hipSuccess) fprintf(stderr, "kernel_launch: launch failed: %s\n", hipGetErrorName(le));
}
```

```cpp
#include <hip/hip_runtime.h>
#include <cstdio>
#include <cstdint>

#ifndef MK_PER_PHASE
#define MK_PER_PHASE 0
#endif
#ifndef MK_MASK
#define MK_MASK 0xFFFF
#endif
#ifndef MK_REP_MASK
#define MK_REP_MASK 0
#endif
#ifndef MK_Q_OUT
#define MK_Q_OUT 1
#endif
#ifndef MK_Q_GU
#define MK_Q_GU 1
#endif
#ifndef MK_Q_DN
#define MK_Q_DN 1
#endif
#ifndef MK_Q_IN
#define MK_Q_IN 1
#endif
#ifndef MK_MT_MAJOR
#define MK_MT_MAJOR 1
#endif
#ifndef MK_STOP_AFTER
#define MK_STOP_AFTER 9999
#endif

#define LAS __attribute__((address_space(3)))
#define GAS __attribute__((address_space(1)))
typedef unsigned short bf16_t;
typedef short bf16x8 __attribute__((ext_vector_type(8)));
typedef short s16x4 __attribute__((ext_vector_type(4)));
typedef _Float16 f16x8 __attribute__((ext_vector_type(8)));
typedef _Float16 f16x2 __attribute__((ext_vector_type(2)));
typedef float f32x2 __attribute__((ext_vector_type(2)));
typedef float f32x4 __attribute__((ext_vector_type(4)));
typedef float f32x16 __attribute__((ext_vector_type(16)));
typedef unsigned u32x2 __attribute__((ext_vector_type(2)));
typedef unsigned u32x4 __attribute__((ext_vector_type(4)));
typedef int i32x4 __attribute__((ext_vector_type(4)));

constexpr int D = 1024, NB = 8, SEQ = 2048, CTXL = 256, DEPTH = 4;
constexpr int NL = NB * SEQ;
constexpr int NC = NB * CTXL;
constexpr int NT = NL + NC;
constexpr int NEXP = 32, TOPK = 4;
constexpr int MAXSLOT = 81920;
constexpr float NORM_EPS = 1e-6f;
constexpr float LOG2E = 1.4426950408889634f;
constexpr int A_IN = 1536, B_IN = 3072, C_IN = 416, C_INP = 512, C_UPK = 384, C_UPN = 3584;

constexpr size_t MiB = 1u << 20;
constexpr size_t WS_CTL = 0, CTL_BYTES = 1 * MiB;
constexpr size_t WS_MOD = 1 * MiB;
constexpr size_t WS_ROPE_A = 2 * MiB;
constexpr size_t WS_ROPE_C = 2 * MiB + 512 * 1024;
constexpr size_t WS_TOPE = 3 * MiB;
constexpr size_t WS_POS = 3 * MiB + 512 * 1024;
constexpr size_t WS_GATE = 4 * MiB;
constexpr size_t WS_ELIST = 5 * MiB;
constexpr size_t WS_KR = 8 * MiB;
constexpr size_t WS_CQKV = 10 * MiB;
constexpr size_t WS_Y416 = 24 * MiB;
constexpr size_t WS_XS = 60 * MiB;
constexpr size_t WS_H = 132 * MiB;
constexpr size_t WS_O = 168 * MiB;
constexpr size_t WS_QKV = 204 * MiB;
constexpr size_t WS_ACT = 330 * MiB;
constexpr size_t WS_YS = 490 * MiB;
constexpr size_t WS_WA_IN = 650 * MiB;
constexpr size_t WS_WA_OUT = 656 * MiB;
constexpr size_t WS_WB_IN = 660 * MiB;
constexpr size_t WS_WB_OUT = 666 * MiB;
constexpr size_t WS_WC_IN = 668 * MiB;
constexpr size_t WS_WC_UP = 669 * MiB;
constexpr size_t WS_WC_OUT = 672 * MiB;
constexpr size_t WS_WGU = 676 * MiB;
constexpr size_t WS_WD = 1188 * MiB;
constexpr size_t WS_G16 = 1444 * MiB;
constexpr size_t WS_RC = 1447 * MiB;
constexpr size_t WS_SBW = 1448 * MiB;
constexpr size_t WS_SAL = 1449 * MiB;
constexpr size_t WS_END = 1452 * MiB;

constexpr int CW_CV = 512;
constexpr int CW_CNT = 1024;
constexpr int CW_BAR = 65536;

constexpr int RING_BYTES = 131072;
constexpr int MISC_OFF = RING_BYTES;
constexpr int M_BARW = 0, M_LCNT = 64, M_LBASE = 192, M_CUMT = 320, M_ECNT = 512, M_GBASE = 640, M_CVB = 768, M_UL = 6656, M_RSA = 7424, M_RPB = 1024, M_REC = 3072;
constexpr int LDS_BYTES = 147456;

#define XB_TMO      128
#define XB_XCNT(j)  (256  + 64 * (j))
#define XB_XSUB(j)  (1280 + 64 * (j))
#define XB_XGEN(j)  (2304 + 64 * (j))
#define XB_TOP      3328
#define XB_TOPGEN   3392
#define XCD_BAR_WORDS 3456
#define XB_SPIN_CAP (1u << 18)

__device__ __forceinline__ unsigned xb_ld(unsigned* p)              { return __hip_atomic_load(p, __ATOMIC_RELAXED, __HIP_MEMORY_SCOPE_AGENT); }
__device__ __forceinline__ unsigned xb_add(unsigned* p, unsigned v) { return __hip_atomic_fetch_add(p, v, __ATOMIC_RELAXED, __HIP_MEMORY_SCOPE_AGENT); }
__device__ __forceinline__ unsigned xb_xcc_id() { return (unsigned)__builtin_amdgcn_s_getreg((3 << 11) | 20) & 0xFu; }
#define XB_SPIN(cond, bar) do { unsigned _sp = 0; while (cond) { __builtin_amdgcn_s_sleep(1); \
    if ((++_sp & 255u) == 0u) { if (xb_ld(&(bar)[XB_TMO])) break; if (_sp > XB_SPIN_CAP) { atomicAdd(&(bar)[XB_TMO], 1u); break; } } } } while (0)

__device__ __forceinline__ int lane_id() { int r; asm volatile("v_mbcnt_lo_u32_b32 %0, -1, 0\n\tv_mbcnt_hi_u32_b32 %0, -1, %0" : "=v"(r)); return r; }
struct XcdBarrier {
    unsigned* bar; unsigned x;
    volatile LAS unsigned* st;
    bool lead;
};
__device__ __forceinline__ XcdBarrier xcd_barrier_post(unsigned* bar, volatile LAS unsigned* st, bool lead) {
    XcdBarrier b; b.bar = bar; b.x = xb_xcc_id(); b.st = st; b.lead = lead;
    if (lead && lane_id() == 0) (void)xb_add(&bar[XB_XCNT(b.x)], 1u);
    return b;
}
__device__ __forceinline__ void xcd_barrier_complete(unsigned* bar, unsigned x, unsigned& nloc, unsigned& nx) {
    const unsigned G = gridDim.x * gridDim.y * gridDim.z;
    unsigned sum, cnt, mine, sp = 0u;
    for (;;) {
        sum = 0u; cnt = 0u; mine = 0u;
#pragma unroll
        for (unsigned j = 0; j < 16; ++j) { const unsigned c = xb_ld(&bar[XB_XCNT(j)]); sum += c; cnt += (c > 0u) ? 1u : 0u; mine = (j == x) ? c : mine; }
        if (sum == G) break;
        __builtin_amdgcn_s_sleep(1);
        if ((++sp & 255u) == 0u) { if (xb_ld(&bar[XB_TMO])) break; if (sp > XB_SPIN_CAP) { atomicAdd(&bar[XB_TMO], 1u); break; } }
    }
    nloc = mine > 0u ? mine : 1u; nx = cnt > 0u ? cnt : 1u;
}
__device__ __forceinline__ void xcd_barrier(const XcdBarrier& b) {
    asm volatile("s_waitcnt vmcnt(0)" ::: "memory");
    __syncthreads();
    if (b.lead && lane_id() == 0) {
        unsigned* bar = b.bar;
        __builtin_amdgcn_s_waitcnt(0);
        unsigned nloc = b.st[0], nx = b.st[1];
        if (nloc == 0u) { xcd_barrier_complete(bar, b.x, nloc, nx); b.st[0] = nloc; b.st[1] = nx; }
        const unsigned old = xb_add(&bar[XB_XSUB(b.x)], 1u);
        const unsigned gen = old / nloc;
        if (old + 1u == (gen + 1u) * nloc) {
            __builtin_amdgcn_fence(__ATOMIC_RELEASE, "agent");
            asm volatile("s_waitcnt vmcnt(0)" ::: "memory");
            const unsigned og = xb_add(&bar[XB_TOP], 1u);
            const unsigned tg = og / nx;
            if (og + 1u == (tg + 1u) * nx) xb_add(&bar[XB_TOPGEN], 1u);
            else XB_SPIN(xb_ld(&bar[XB_TOPGEN]) == tg, bar);
            __builtin_amdgcn_fence(__ATOMIC_ACQUIRE, "agent");
            xb_add(&bar[XB_XGEN(b.x)], 1u);
            asm volatile("s_waitcnt vmcnt(0)" ::: "memory");
        } else {
            XB_SPIN(xb_ld(&bar[XB_XGEN(b.x)]) == gen, bar);
            __builtin_amdgcn_fence(__ATOMIC_ACQUIRE, "agent");
            asm volatile("s_waitcnt vmcnt(0)" ::: "memory");
        }
    }
    __syncthreads();
}

__device__ __forceinline__ unsigned cvt_pk_bf16(float lo, float hi) { unsigned r; asm volatile("v_cvt_pk_bf16_f32 %0, %1, %2" : "=v"(r) : "v"(lo), "v"(hi)); return r; }
__device__ __forceinline__ float bf_lo(unsigned w) { return __uint_as_float(w << 16); }
__device__ __forceinline__ float bf_hi(unsigned w) { return __uint_as_float(w & 0xffff0000u); }
__device__ __forceinline__ float shx(float v, int mask, int lane) { return __int_as_float(__builtin_amdgcn_ds_bpermute((lane ^ mask) << 2, __float_as_int(v))); }
__device__ __forceinline__ float wave_sum(float v, int lane) {
#pragma unroll
    for (int o = 1; o < 64; o <<= 1) v += shx(v, o, lane);
    return v;
}
__device__ __forceinline__ float wave_max(float v, int lane) {
#pragma unroll
    for (int o = 1; o < 64; o <<= 1) v = fmaxf(v, shx(v, o, lane));
    return v;
}
__device__ __forceinline__ float swap32_max(float m) { auto rr = __builtin_amdgcn_permlane32_swap(__float_as_uint(m), __float_as_uint(m), false, false); return fmaxf(__uint_as_float(rr[0]), __uint_as_float(rr[1])); }
__device__ __forceinline__ float swap32_sum(float m) { auto rr = __builtin_amdgcn_permlane32_swap(__float_as_uint(m), __float_as_uint(m), false, false); return __uint_as_float(rr[0]) + __uint_as_float(rr[1]); }

namespace pg8 {
constexpr int BM = 256, BK = 64, HALF = 128, HTB = HALF * BK * 2, STAGE_BYTES = 8 * HTB;
__host__ __device__ __forceinline__ int lds_byte(int r, int c) { const int st = (r >> 4) * 2 + (c >> 5), rr = r & 15, cc = c & 31, ob = rr * 64 + cc * 2; return st * 1024 + (ob ^ (((ob >> 9) & 1) << 5)); }
__host__ __device__ __forceinline__ void stage_rc(int b, int& R, int& C) { const int st = b / 1024, sb = b % 1024, swz = sb ^ (((sb >> 9) & 1) << 5); R = (st >> 1) * 16 + swz / 64; C = (st & 1) * 32 + (swz % 64) / 2; }
__host__ __device__ __forceinline__ int perm32(int rho) { const int n = rho >> 4, i = rho & 15; return 8 * (i >> 2) + 4 * n + (i & 3); }

struct Unit { int pm, pn, e, mt, cnt; };
struct Gemm { const void* A; const void* Bt; int K; size_t bstride; const int* list; };

template <bool I8> struct AccSel { typedef f32x4 type; };
template <> struct AccSel<true> { typedef i32x4 type; };
template <class Epi, class Sched, bool GATHER, bool I8 = false>
__device__ __forceinline__ void gemm_phase(LAS unsigned char* lds, const Gemm g, const Sched& S, const Epi& E, const int tid) {
    const int wid = __builtin_amdgcn_readfirstlane(tid >> 6), lane = tid & 63, wr = wid >> 2, wc = wid & 3, fr = lane & 15, fq = lane >> 4;
    typedef typename AccSel<I8>::type acc_t;
    const int K = g.K, RB = I8 ? K : 2 * K, nt = RB / (BK * 2);
    unsigned voffA[2], voffB[2];
    int gR[2], gC[2];
#pragma unroll
    for (int i = 0; i < 2; ++i) { int R, C; stage_rc(tid * 16 + i * 8192, R, C); const int Rb = Epi::PERM ? ((R & ~31) + perm32(R & 31)) : R;
        voffA[i] = (unsigned)(R * RB + C * 2); voffB[i] = (unsigned)(Rb * RB + C * 2); gR[i] = R; gC[i] = C; }
    const size_t kstep = (size_t)(BK * 2);
    const size_t hstep = (size_t)HALF * RB;
    const size_t tstep = 2 * hstep;
    const unsigned ldsw = (unsigned)wid * 1024u;
    const int aoff = lds_byte(wr * 64 + fr, fq * 8), boff = lds_byte(wc * 32 + fr, fq * 8);
#define PG8_SA(b, h) (((b) * 2 + (h)) * HTB)
#define PG8_SB(b, h) ((4 + (b) * 2 + (h)) * HTB)
#define PG8_STAGE(bufoff, gbase, voff) do { _Pragma("unroll") for (int _i = 0; _i < 2; ++_i) \
        __builtin_amdgcn_global_load_lds((const unsigned*)((const char*)(gbase) + (voff)[_i]), (LAS unsigned*)(lds + (bufoff) + ldsw + _i * 8192), 16, 0, 0); } while (0)
#define PG8_STAGE_A(bufoff, SELN, H, KOFF) do { if constexpr (GATHER) { unsigned _vo[2]; _vo[0] = (SELN) ? voN[H][0] : voC[H][0]; _vo[1] = (SELN) ? voN[H][1] : voC[H][1]; \
            PG8_STAGE(bufoff, (const char*)g.A + (KOFF), _vo); } else { PG8_STAGE(bufoff, ((SELN) ? nA : cA) + (H) * hstep + (KOFF), voffA); } } while (0)
#define PG8_LDA(dst, b, h) do { _Pragma("unroll") for (int m = 0; m < 4; ++m) _Pragma("unroll") for (int k = 0; k < 2; ++k) dst[m][k] = *(const LAS bf16x8*)(lds + PG8_SA(b, h) + aoff + m * 2048 + k * 1024); } while (0)
#define PG8_LDB(dst, b, h) do { _Pragma("unroll") for (int n = 0; n < 2; ++n) _Pragma("unroll") for (int k = 0; k < 2; ++k) dst[n][k] = *(const LAS bf16x8*)(lds + PG8_SB(b, h) + boff + n * 2048 + k * 1024); } while (0)
#define PG8_MMA(ai, bj, At, Bt) do { __builtin_amdgcn_s_setprio(1); _Pragma("unroll") for (int m = 0; m < 4; ++m) _Pragma("unroll") for (int n = 0; n < 2; ++n) _Pragma("unroll") for (int k = 0; k < 2; ++k) \
        { if constexpr (I8) acc[ai][bj][m][n] = __builtin_amdgcn_mfma_i32_16x16x64_i8(__builtin_bit_cast(i32x4, Bt[n][k]), __builtin_bit_cast(i32x4, At[m][k]), acc[ai][bj][m][n], 0, 0, 0); \
          else acc[ai][bj][m][n] = __builtin_amdgcn_mfma_f32_16x16x32_bf16(Bt[n][k], At[m][k], acc[ai][bj][m][n], 0, 0, 0); } __builtin_amdgcn_s_setprio(0); } while (0)
#define PG8_WAIT_V(n) asm volatile("s_waitcnt vmcnt(" #n ")" ::: "memory")
#define PG8_WAIT_L(n) asm volatile("s_waitcnt lgkmcnt(" #n ")" ::: "memory")
#define PG8_BAR __builtin_amdgcn_s_barrier()
#define PG8_SCHED __builtin_amdgcn_sched_barrier(0)
#define PG8_GATH(U, VO) do { _Pragma("unroll") for (int _h = 0; _h < 2; ++_h) _Pragma("unroll") for (int _i = 0; _i < 2; ++_i) { \
        int _r = (U).mt * 256 + _h * 128 + gR[_i]; _r = _r < (U).cnt ? _r : 0; const int _tok = g.list[(size_t)(U).e * NT + _r]; VO[_h][_i] = (unsigned)(_tok * RB + gC[_i] * 2); } } while (0)
    Unit cur, nxt; int ui = 0;
    if (!S.next(0, cur)) return;
    acc_t acc[2][2][4][2];
#pragma unroll
    for (int a = 0; a < 2; ++a)
#pragma unroll
        for (int b = 0; b < 2; ++b)
#pragma unroll
            for (int m = 0; m < 4; ++m)
#pragma unroll
                for (int n = 0; n < 2; ++n) acc[a][b][m][n] = (acc_t){0, 0, 0, 0};
    bf16x8 At[4][2], B0[2][2], B1[2][2];
    unsigned voC[2][2] = {{0u, 0u}, {0u, 0u}}, voN[2][2] = {{0u, 0u}, {0u, 0u}};
    if constexpr (GATHER) { PG8_GATH(cur, voC); }
    const char* cA = GATHER ? (const char*)g.A : (const char*)g.A + (size_t)cur.pm * tstep;
    const size_t bsb = I8 ? g.bstride : 2 * g.bstride;
    const char* cB = (const char*)g.Bt + (size_t)cur.e * bsb + (size_t)cur.pn * tstep;
    const char* nA = cA; const char* nB = cB;
    PG8_STAGE(PG8_SB(0, 0), cB, voffB); PG8_STAGE(PG8_SB(0, 1), cB + hstep, voffB); PG8_STAGE_A(PG8_SA(0, 0), false, 0, 0); PG8_STAGE_A(PG8_SA(0, 1), false, 1, 0);
    if (wr == 1) PG8_BAR;
    PG8_WAIT_V(2); PG8_BAR;
    PG8_STAGE(PG8_SB(1, 0), cB + kstep, voffB); PG8_STAGE_A(PG8_SA(1, 0), false, 0, kstep); PG8_STAGE(PG8_SB(1, 1), cB + hstep + kstep, voffB);
    PG8_WAIT_V(6); PG8_BAR;
    for (;;) {
        const bool has_next = S.next(ui + 1, nxt);
        nA = GATHER ? (const char*)g.A : (has_next ? (const char*)g.A + (size_t)nxt.pm * tstep : cA);
        nB = has_next ? (const char*)g.Bt + (size_t)nxt.e * bsb + (size_t)nxt.pn * tstep : cB;
        int tokN[2][2] = {{0, 0}, {0, 0}};
        if constexpr (GATHER) { if (has_next) {
#pragma unroll
            for (int _h = 0; _h < 2; ++_h)
#pragma unroll
                for (int _i = 0; _i < 2; ++_i) { int _r = nxt.mt * 256 + _h * 128 + gR[_i]; _r = _r < nxt.cnt ? _r : 0; const int* _p = g.list + (size_t)nxt.e * NT + _r;
                    asm volatile("global_load_dword %0, %1, off" : "=v"(tokN[_h][_i]) : "v"(_p) : "memory"); } } }
        for (int t = 0; t < nt; t += 2) {
            const bool last = (t == nt - 2);
            const size_t k1 = (size_t)(t + 1) * kstep;
            const size_t k2 = last ? 0 : (size_t)(t + 2) * kstep;
            const size_t k3 = k2 + kstep;
            const char* b2 = (last ? nB : cB) + k2; const char* b3 = b2 + kstep;
            PG8_LDB(B0, 0, 0); PG8_LDB(B1, 0, 1); PG8_SCHED; PG8_LDA(At, 0, 0); PG8_STAGE_A(PG8_SA(1, 1), false, 1, k1);
            PG8_WAIT_V(8); PG8_WAIT_L(0); PG8_BAR; PG8_MMA(0, 0, At, B0); PG8_MMA(0, 1, At, B1); PG8_BAR; PG8_SCHED;
            if constexpr (GATHER) { if (last) { if (has_next) {
                asm volatile("" : "+v"(tokN[0][0]), "+v"(tokN[0][1]), "+v"(tokN[1][0]), "+v"(tokN[1][1]));
#pragma unroll
                for (int _h = 0; _h < 2; ++_h) { voN[_h][0] = (unsigned)(tokN[_h][0] * RB + gC[0] * 2); voN[_h][1] = (unsigned)(tokN[_h][1] * RB + gC[1] * 2); } } else {
#pragma unroll
                for (int _h = 0; _h < 2; ++_h) { voN[_h][0] = voC[_h][0]; voN[_h][1] = voC[_h][1]; } } } }
            PG8_LDA(At, 0, 1); PG8_STAGE(PG8_SB(0, 0), b2, voffB); PG8_STAGE(PG8_SB(0, 1), b2 + hstep, voffB); PG8_STAGE_A(PG8_SA(0, 0), last, 0, k2);
            PG8_WAIT_V(8); PG8_WAIT_L(0); PG8_BAR; PG8_MMA(1, 0, At, B0); PG8_MMA(1, 1, At, B1); PG8_BAR; PG8_SCHED;
            PG8_LDB(B0, 1, 0); PG8_LDB(B1, 1, 1); PG8_SCHED; PG8_LDA(At, 1, 0); PG8_STAGE_A(PG8_SA(0, 1), last, 1, k2);
            PG8_WAIT_V(8); PG8_WAIT_L(0); PG8_BAR; PG8_MMA(0, 0, At, B0); PG8_MMA(0, 1, At, B1); PG8_BAR; PG8_SCHED;
            PG8_LDA(At, 1, 1); PG8_STAGE(PG8_SB(1, 0), b3, voffB); PG8_STAGE(PG8_SB(1, 1), b3 + hstep, voffB); PG8_STAGE_A(PG8_SA(1, 0), last, 0, k3);
            PG8_WAIT_V(8); PG8_WAIT_L(0); PG8_BAR; PG8_MMA(1, 0, At, B0); PG8_MMA(1, 1, At, B1); PG8_BAR; PG8_SCHED;
        }
        if (wr == 0) PG8_BAR;
        { const int ln_ = lane_id(); E(acc, cur, wr, wc, ln_ & 15, ln_ >> 4); }
        if (!has_next) break;
#pragma unroll
        for (int a = 0; a < 2; ++a)
#pragma unroll
            for (int b = 0; b < 2; ++b)
#pragma unroll
                for (int m = 0; m < 4; ++m)
#pragma unroll
                    for (int n = 0; n < 2; ++n) acc[a][b][m][n] = (acc_t){0, 0, 0, 0};
        cur = nxt; cA = nA; cB = nB; ++ui;
        if constexpr (GATHER) {
#pragma unroll
            for (int _h = 0; _h < 2; ++_h) { voC[_h][0] = voN[_h][0]; voC[_h][1] = voN[_h][1]; } }
        if (wr == 1) PG8_BAR;
    }
    PG8_WAIT_V(0);
    PG8_BAR;
#undef PG8_SA
#undef PG8_SB
#undef PG8_STAGE
#undef PG8_STAGE_A
#undef PG8_LDA
#undef PG8_LDB
#undef PG8_MMA
#undef PG8_WAIT_V
#undef PG8_WAIT_L
#undef PG8_BAR
#undef PG8_SCHED
#undef PG8_GATH
}
}

namespace pg8 {
struct EpiBf16Plain {
    static constexpr bool PERM = true;
    bf16_t* O; int ldc; int qtiles; float qscale;
    __device__ __forceinline__ void operator()(const f32x4 (&acc)[2][2][4][2], const Unit& u, int wr, int wc, int fr, int fq) const {
        const int row0 = u.pm * BM + wr * 64 + fr, col0 = u.pn * BM + wc * 32 + 8 * fq;
        const float qs = u.pn < qtiles ? qscale : 1.0f;
#pragma unroll
        for (int ai = 0; ai < 2; ++ai)
#pragma unroll
            for (int m = 0; m < 4; ++m) { bf16_t* rowp = O + (size_t)(row0 + ai * HALF + m * 16) * ldc + col0;
#pragma unroll
                for (int bj = 0; bj < 2; ++bj) { const f32x4 v0 = acc[ai][bj][m][0] * qs, v1 = acc[ai][bj][m][1] * qs;
                    u32x4 w; w.x = cvt_pk_bf16(v0[0], v0[1]); w.y = cvt_pk_bf16(v0[2], v0[3]); w.z = cvt_pk_bf16(v1[0], v1[1]); w.w = cvt_pk_bf16(v1[2], v1[3]);
                    *(u32x4*)(rowp + bj * HALF) = w; } }
    }
};
struct EpiF32Plain {
    static constexpr bool PERM = false;
    float* C; int ldc;
    __device__ __forceinline__ void operator()(const f32x4 (&acc)[2][2][4][2], const Unit& u, int wr, int wc, int fr, int fq) const {
        const int row0 = u.pm * BM + wr * 64 + fr, col0 = u.pn * BM + wc * 32 + 4 * fq;
#pragma unroll
        for (int ai = 0; ai < 2; ++ai)
#pragma unroll
            for (int m = 0; m < 4; ++m) { float* rowp = C + (size_t)(row0 + ai * HALF + m * 16) * ldc + col0;
#pragma unroll
                for (int bj = 0; bj < 2; ++bj)
#pragma unroll
                    for (int n = 0; n < 2; ++n) *(f32x4*)(rowp + bj * HALF + n * 16) = acc[ai][bj][m][n]; }
    }
};
__device__ __forceinline__ void rope8(f32x4& v0, f32x4& v1, const float* cs) {
    const f32x4 a = *(const f32x4*)cs, b = *(const f32x4*)(cs + 4);
    const float x0 = v0[0], x1 = v0[1], x2 = v0[2], x3 = v0[3], y0 = v1[0], y1 = v1[1], y2 = v1[2], y3 = v1[3];
    v0[0] = x0 * a[0] - x1 * a[1]; v0[1] = x0 * a[1] + x1 * a[0];
    v0[2] = x2 * a[2] - x3 * a[3]; v0[3] = x2 * a[3] + x3 * a[2];
    v1[0] = y0 * b[0] - y1 * b[1]; v1[1] = y0 * b[1] + y1 * b[0];
    v1[2] = y2 * b[2] - y3 * b[3]; v1[3] = y2 * b[3] + y3 * b[2];
}
struct EpiQkvA {
    static constexpr bool PERM = true;
    bf16_t* O; const float* rope;
    __device__ __forceinline__ void operator()(const f32x4 (&acc)[2][2][4][2], const Unit& u, int wr, int wc, int fr, int fq) const {
        const int row0 = u.pm * BM + wr * 64 + fr, col0 = u.pn * BM + wc * 32 + 8 * fq;
        const bool do_rope = (u.pm < NL / 256) && (u.pn < 5);
        const float qs = u.pn < 4 ? 0.125f * LOG2E : 1.0f;
#pragma unroll
        for (int ai = 0; ai < 2; ++ai)
#pragma unroll
            for (int m = 0; m < 4; ++m) { const int row = row0 + ai * HALF + m * 16; bf16_t* rowp = O + (size_t)row * A_IN + col0;
#pragma unroll
                for (int bj = 0; bj < 2; ++bj) { f32x4 v0 = acc[ai][bj][m][0], v1 = acc[ai][bj][m][1];
                    if (do_rope) { const int d = (col0 + bj * HALF) & 63; rope8(v0, v1, rope + ((size_t)(row & (SEQ - 1)) * 32 + (d >> 1)) * 2); }
                    v0 = v0 * qs; v1 = v1 * qs;
                    u32x4 w; w.x = cvt_pk_bf16(v0[0], v0[1]); w.y = cvt_pk_bf16(v0[2], v0[3]); w.z = cvt_pk_bf16(v1[0], v1[1]); w.w = cvt_pk_bf16(v1[2], v1[3]);
                    *(u32x4*)(rowp + bj * HALF) = w; }
                asm volatile("" ::: "memory"); }
    }
};
struct EpiMlaUp {
    static constexpr bool PERM = true;
    bf16_t* O; const float* rope;
    __device__ __forceinline__ void operator()(const f32x4 (&acc)[2][2][4][2], const Unit& u, int wr, int wc, int fr, int fq) const {
        const int row0 = u.pm * BM + wr * 64 + fr, col0 = u.pn * BM + wc * 32 + 8 * fq;
        const bool qtile = (u.pm < NL / 256) && (u.pn < 6);
        const float qs = u.pn < 6 ? 0.10206207261596575f * LOG2E : 1.0f;
#pragma unroll
        for (int ai = 0; ai < 2; ++ai)
#pragma unroll
            for (int m = 0; m < 4; ++m) { const int row = row0 + ai * HALF + m * 16; bf16_t* rowp = O + (size_t)row * C_UPN + col0;
#pragma unroll
                for (int bj = 0; bj < 2; ++bj) { f32x4 v0 = acc[ai][bj][m][0], v1 = acc[ai][bj][m][1];
                    const int d96 = (col0 + bj * HALF) % 96;
                    if (qtile && d96 >= 64) rope8(v0, v1, rope + ((size_t)(row & (SEQ - 1)) * 16 + ((d96 - 64) >> 1)) * 2);
                    v0 = v0 * qs; v1 = v1 * qs;
                    u32x4 w; w.x = cvt_pk_bf16(v0[0], v0[1]); w.y = cvt_pk_bf16(v0[2], v0[3]); w.z = cvt_pk_bf16(v1[0], v1[1]); w.w = cvt_pk_bf16(v1[2], v1[3]);
                    *(u32x4*)(rowp + bj * HALF) = w; }
                asm volatile("" ::: "memory"); }
    }
};
struct EpiResid {
    static constexpr bool PERM = false;
    float* XS; const float* gmod; float* XSo;
    __device__ __forceinline__ void operator()(const f32x4 (&acc)[2][2][4][2], const Unit& u, int wr, int wc, int fr, int fq) const {
        const int row0 = u.pm * BM + wr * 64 + fr, col0 = u.pn * BM + wc * 32 + 4 * fq;
        const int rb = u.pm < NL / 256 ? (u.pm >> 3) : 8;
        const float* gv = gmod + (size_t)rb * 6144 + col0;
        f32x4 gg[2][2];
#pragma unroll
        for (int bj = 0; bj < 2; ++bj)
#pragma unroll
            for (int n = 0; n < 2; ++n) gg[bj][n] = *(const f32x4*)(gv + bj * HALF + n * 16);
#pragma unroll
        for (int ai = 0; ai < 2; ++ai)
#pragma unroll
            for (int m = 0; m < 4; ++m) { float* rowp = XS + (size_t)(row0 + ai * HALF + m * 16) * D + col0;
#pragma unroll
                for (int bj = 0; bj < 2; ++bj)
#pragma unroll
                    for (int n = 0; n < 2; ++n) { const f32x4* p = (const f32x4*)(rowp + bj * HALF + n * 16); *(f32x4*)((float*)p + (XSo - XS)) = *p + gg[bj][n] * acc[ai][bj][m][n]; } }
    }
};
struct EpiSwiglu {
    static constexpr bool PERM = true;
    bf16_t* ACT; const float* bg; const float* bu;
    __device__ __forceinline__ void operator()(const f32x4 (&acc)[2][2][4][2], const Unit& u, int wr, int wc, int fr, int fq) const {
        const int row0 = u.pm * BM + wr * 64 + fr, col0 = u.pn * HALF + wc * 32 + 8 * fq;
        const float* pg = bg + (size_t)u.e * D + col0; const float* pu = bu + (size_t)u.e * D + col0;
        const f32x4 g0 = *(const f32x4*)pg, g1 = *(const f32x4*)(pg + 4), u0 = *(const f32x4*)pu, u1 = *(const f32x4*)(pu + 4);
#pragma unroll
        for (int ai = 0; ai < 2; ++ai)
#pragma unroll
            for (int m = 0; m < 4; ++m) { bf16_t* rowp = ACT + (size_t)(row0 + ai * HALF + m * 16) * D + col0;
                float r[8];
#pragma unroll
                for (int n = 0; n < 2; ++n)
#pragma unroll
                    for (int j = 0; j < 4; ++j) {
                        float g = acc[ai][0][m][n][j] + (n ? g1[j] : g0[j]); float uu = acc[ai][1][m][n][j] + (n ? u1[j] : u0[j]);
                        g = fminf(g, 7.0f); uu = fminf(fmaxf(uu, -7.0f), 7.0f);
                        const float sg = __builtin_amdgcn_rcpf(1.0f + __builtin_amdgcn_exp2f(-1.702f * LOG2E * g));
                        r[n * 4 + j] = g * sg * (uu + 1.0f); }
                u32x4 w; w.x = cvt_pk_bf16(r[0], r[1]); w.y = cvt_pk_bf16(r[2], r[3]); w.z = cvt_pk_bf16(r[4], r[5]); w.w = cvt_pk_bf16(r[6], r[7]);
                *(u32x4*)rowp = w; }
    }
};
struct EpiSwiglu8 {
    static constexpr bool PERM = true;
    bf16_t* ACT; const float* bg; const float* bu; const float* sal; const float* sbw;
    __device__ __forceinline__ void operator()(const i32x4 (&acc)[2][2][4][2], const Unit& u, int wr, int wc, int fr, int fq) const {
        const int lr0 = wr * 64 + fr, row0 = u.pm * BM + lr0, col0 = u.pn * HALF + wc * 32 + 8 * fq;
        const float* psa = sal + (size_t)u.e * NT + u.mt * 256;
#pragma unroll
        for (int n = 0; n < 2; ++n) {
            const f32x4 gb = *(const f32x4*)(bg + (size_t)u.e * D + col0 + 4 * n), ub = *(const f32x4*)(bu + (size_t)u.e * D + col0 + 4 * n);
            const float* ps = sbw + (size_t)u.e * 2048 + u.pn * BM + wc * 32 + 8 * fq + 4 * n;
            const f32x4 sg = *(const f32x4*)ps, su = *(const f32x4*)(ps + HALF);
#pragma unroll
            for (int ai = 0; ai < 2; ++ai)
#pragma unroll
                for (int m = 0; m < 4; ++m) { int lr = lr0 + ai * HALF + m * 16; const float sa_ = psa[(u.mt * 256 + lr) < u.cnt ? lr : 0];
                    float r[4];
#pragma unroll
                    for (int j = 0; j < 4; ++j) {
                        float g = (float)acc[ai][0][m][n][j] * (sa_ * sg[j]) + gb[j];
                        float uu = (float)acc[ai][1][m][n][j] * (sa_ * su[j]) + ub[j];
                        g = fminf(g, 7.0f); uu = fminf(fmaxf(uu, -7.0f), 7.0f);
                        const float sgm = __builtin_amdgcn_rcpf(1.0f + __builtin_amdgcn_exp2f(-1.702f * LOG2E * g));
                        r[j] = g * sgm * (uu + 1.0f); }
                    u32x2 w; w.x = cvt_pk_bf16(r[0], r[1]); w.y = cvt_pk_bf16(r[2], r[3]);
                    *(u32x2*)(ACT + (size_t)(row0 + ai * HALF + m * 16) * D + col0 + 4 * n) = w; }
            asm volatile("" ::: "memory");
        }
    }
};
struct EpiDown {
    static constexpr bool PERM = true;
    bf16_t* YS; const float* bd;
    __device__ __forceinline__ void operator()(const f32x4 (&acc)[2][2][4][2], const Unit& u, int wr, int wc, int fr, int fq) const {
        const int row0 = u.pm * BM + wr * 64 + fr, col0 = u.pn * BM + wc * 32 + 8 * fq;
        const float* pb = bd + (size_t)u.e * D + col0;
        f32x4 bv[2][2];
#pragma unroll
        for (int bj = 0; bj < 2; ++bj)
#pragma unroll
            for (int n = 0; n < 2; ++n) bv[bj][n] = *(const f32x4*)(pb + bj * HALF + 4 * n);
#pragma unroll
        for (int ai = 0; ai < 2; ++ai)
#pragma unroll
            for (int m = 0; m < 4; ++m) { bf16_t* rowp = YS + (size_t)(row0 + ai * HALF + m * 16) * D + col0;
#pragma unroll
                for (int bj = 0; bj < 2; ++bj) { const f32x4 v0 = acc[ai][bj][m][0] + bv[bj][0], v1 = acc[ai][bj][m][1] + bv[bj][1];
                    u32x4 w; w.x = cvt_pk_bf16(v0[0], v0[1]); w.y = cvt_pk_bf16(v0[2], v0[3]); w.z = cvt_pk_bf16(v1[0], v1[1]); w.w = cvt_pk_bf16(v1[2], v1[3]);
                    *(u32x4*)(rowp + bj * HALF) = w; } }
    }
};

struct DenseOrder {
    int nM, nN, vcu, xM, xN0, xNn;
    __device__ __forceinline__ bool short_one() const { const int U = nM * nN + xM * xNn, R = (U + 255) >> 8; return (U & 255) != 0 && vcu >= U - (R - 1) * 256; }
    __device__ __forceinline__ bool next(int i, Unit& u) const {
        int L = i * 256 + vcu; const int nmain = nM * nN;
        if (L < nmain) { const int nig = 8 * nN, gid = L / nig, fm = gid * 8, rem = nM - fm, gsz = rem < 8 ? rem : 8, w = L % nig; u.pm = fm + w % gsz; u.pn = w / gsz; }
        else { L -= nmain; if (L >= xM * xNn) return false; u.pm = nM + L % xM; u.pn = xN0 + L / xM; }
        u.e = 0; u.mt = 0; u.cnt = 0; return true;
    }
};
struct MoeOrder {
    const LAS int* ecnt; const LAS int* lbase; const LAS int* cumt; int nN, vcu; LAS int* ul;
    __device__ __forceinline__ bool short_one() const { const int U = cumt[32] * nN, R = (U + 255) >> 8; return (U & 255) != 0 && vcu >= U - (R - 1) * 256; }
    __device__ __forceinline__ void build(int tid) const {
        if (tid < 16) { const int L = tid * 256 + vcu; int e = -1, pn = 0, mt = 0, pm = 0, c = 0;
            if (L < cumt[32] * nN) { e = 0; while (cumt[e + 1] * nN <= L) ++e; const int r = L - cumt[e] * nN; c = ecnt[e]; const int mte = (c + 255) >> 8; if (MK_MT_MAJOR & (nN == 4 ? 1 : 2)) { pn = r % nN; mt = r / nN; } else { pn = r / mte; mt = r % mte; } pm = (lbase[e] >> 8) + mt; }
            ul[tid * 8 + 0] = e; ul[tid * 8 + 1] = pn; ul[tid * 8 + 2] = mt; ul[tid * 8 + 3] = pm; ul[tid * 8 + 4] = c; }
        __syncthreads();
    }
    __device__ __forceinline__ bool next(int i, Unit& u) const {
        if (i >= 16) return false;
        const int e = __builtin_amdgcn_readfirstlane(ul[i * 8 + 0]);
        if (e < 0) return false;
        u.e = e; u.pn = __builtin_amdgcn_readfirstlane(ul[i * 8 + 1]); u.mt = __builtin_amdgcn_readfirstlane(ul[i * 8 + 2]); u.pm = __builtin_amdgcn_readfirstlane(ul[i * 8 + 3]); u.cnt = __builtin_amdgcn_readfirstlane(ul[i * 8 + 4]); return true;
    }
};
}

namespace att {
constexpr int VSTR = 144;
template <int DQK> struct Cfg { static constexpr int KSTR = DQK * 2 + 16, KB = 64 * KSTR, VB = 64 * VSTR, STAGE = KB + VB, CPR = DQK / 8, NKS = DQK / 16; };
__device__ __forceinline__ int crow(int r, int hi) { return (r & 3) + 8 * (r >> 2) + 4 * hi; }

template <int DQK, bool MLA>
__device__ __forceinline__ void fetchK(u32x4 (&r)[2], const bf16_t* Kb, const bf16_t* KRb, int pitch, int row0, int tid) {
    typedef Cfg<DQK> C;
    { const int key = tid / C::CPR, ch = tid % C::CPR;
      const bf16_t* src = (MLA && ch >= 8) ? KRb + (size_t)(row0 + key) * 32 + (ch - 8) * 8 : Kb + (size_t)(row0 + key) * pitch + ch * 8;
      r[0] = *(const u32x4*)src; }
    if constexpr (DQK == 96) { if (tid < 256) { const int c = 512 + tid, key = c / C::CPR, ch = c % C::CPR;
      const bf16_t* src = (MLA && ch >= 8) ? KRb + (size_t)(row0 + key) * 32 + (ch - 8) * 8 : Kb + (size_t)(row0 + key) * pitch + ch * 8;
      r[1] = *(const u32x4*)src; } }
}
__device__ __forceinline__ void fetchV(u32x4& r, const bf16_t* Vb, int pitch, int row0, int tid) { const int key = tid >> 3, ch = tid & 7; r = *(const u32x4*)(Vb + (size_t)(row0 + key) * pitch + ch * 8); }
template <int DQK>
__device__ __forceinline__ void stashK(LAS unsigned char* kst, const u32x4 (&r)[2], int tid) {
    typedef Cfg<DQK> C;
    { const int key = tid / C::CPR, ch = tid % C::CPR; *(LAS u32x4*)(kst + key * C::KSTR + ch * 16) = r[0]; }
    if constexpr (DQK == 96) { if (tid < 256) { const int c = 512 + tid, key = c / C::CPR, ch = c % C::CPR; *(LAS u32x4*)(kst + key * C::KSTR + ch * 16) = r[1]; } }
}
__device__ __forceinline__ void stashV(LAS unsigned char* vst, const u32x4& r, int tid) { const int key = tid >> 3, ch = tid & 7; *(LAS u32x4*)(vst + key * VSTR + ch * 16) = r; }
template <int DQK, bool MLA>
__device__ __forceinline__ void fetch(u32x4 (&r)[3], const bf16_t* Kb, const bf16_t* Vb, const bf16_t* KRb, int pitch, int row0, int tid) {
    u32x4 k2[2]; k2[1] = (u32x4){0u, 0u, 0u, 0u}; fetchK<DQK, MLA>(k2, Kb, KRb, pitch, row0, tid); r[0] = k2[0]; r[1] = k2[1]; fetchV(r[2], Vb, pitch, row0, tid);
}
template <int DQK>
__device__ __forceinline__ void stash(LAS unsigned char* st, const u32x4 (&r)[3], int tid) {
    const u32x4 k2[2] = {r[0], r[1]}; stashK<DQK>(st, k2, tid); stashV(st + Cfg<DQK>::KB, r[2], tid);
}
template <int DQK>
__device__ __forceinline__ f32x16 qk(const LAS unsigned char* kst, int koff, const bf16x8 (&qr)[DQK / 16], int r32, int hi) {
    typedef Cfg<DQK> C;
    f32x16 p;
#pragma unroll
    for (int r = 0; r < 16; ++r) p[r] = 0.f;
    const LAS unsigned char* kb = kst + (koff + r32) * C::KSTR + hi * 16;
#pragma unroll
    for (int ks = 0; ks < C::NKS; ++ks) { const bf16x8 kf = *(const LAS bf16x8*)(kb + ks * 32); p = __builtin_amdgcn_mfma_f32_32x32x16_bf16(kf, qr[ks], p, 0, 0, 0); }
    return p;
}
__device__ __forceinline__ s16x4 vtr(const LAS unsigned char* p) { return __builtin_bit_cast(s16x4, __builtin_amdgcn_ds_read_tr16_b64_v4i16((LAS s16x4*)p)); }
typedef __bf16 bf16x2_t __attribute__((ext_vector_type(2)));
__device__ __forceinline__ unsigned cvtpk_s(float lo, float hi) { const f32x2 v = {lo, hi}; const bf16x2_t b = __builtin_convertvector(v, bf16x2_t); return __builtin_bit_cast(unsigned, b); }
template <int NS>
__device__ __forceinline__ void sm_max(const f32x16 (&t)[NS], const float sc, f32x16 (&o)[2], float& m, float& l) {
    float mx = t[0][0];
#pragma unroll
    for (int s = 0; s < NS; ++s)
#pragma unroll
        for (int r = 0; r < 16; ++r) mx = fmaxf(mx, t[s][r]);
    mx = swap32_max(mx) * sc;
    if (__any(mx > m + 8.0f)) { const float mn = fmaxf(m, mx); const float a = __builtin_amdgcn_exp2f(m - mn); m = mn; l *= a;
#pragma unroll
        for (int r = 0; r < 16; ++r) { o[0][r] *= a; o[1][r] *= a; } }
}
template <int NS>
__device__ __forceinline__ void sm_exp_pv(f32x16 (&t)[NS], const float sc, const LAS unsigned char* vst, const int (&voff)[NS], f32x16 (&o)[2], const float m, float& l, int lane) {
    const int hi = lane >> 5;
    float rs = 0.f;
#pragma unroll
    for (int s = 0; s < NS; ++s)
#pragma unroll
        for (int r = 0; r < 16; ++r) { t[s][r] = __builtin_amdgcn_exp2f(__builtin_fmaf(t[s][r], sc, -m)); rs += t[s][r]; }
    l += rs;
    const int q4 = (lane & 15) >> 2, p4 = lane & 3, blk = (lane >> 4) & 1;
#pragma unroll
    for (int s = 0; s < NS; ++s) {
        const LAS unsigned char* vb = vst + (voff[s] + 4 * hi + q4) * VSTR + (16 * blk + 4 * p4) * 2;
#pragma unroll
        for (int kk = 0; kk < 2; ++kk) {
            u32x4 pw; pw.x = cvtpk_s(t[s][8 * kk + 0], t[s][8 * kk + 1]); pw.y = cvtpk_s(t[s][8 * kk + 2], t[s][8 * kk + 3]);
            pw.z = cvtpk_s(t[s][8 * kk + 4], t[s][8 * kk + 5]); pw.w = cvtpk_s(t[s][8 * kk + 6], t[s][8 * kk + 7]);
            const bf16x8 pb = __builtin_bit_cast(bf16x8, pw);
#pragma unroll
            for (int c = 0; c < 2; ++c) {
                const s16x4 lo = vtr(vb + (16 * kk) * VSTR + c * 64), h8 = vtr(vb + (16 * kk + 8) * VSTR + c * 64);
                const bf16x8 va = (bf16x8){lo[0], lo[1], lo[2], lo[3], h8[0], h8[1], h8[2], h8[3]};
                o[c] = __builtin_amdgcn_mfma_f32_32x32x16_bf16(va, pb, o[c], 0, 0, 0);
            }
        }
    }
}
template <int NS>
__device__ __forceinline__ void sm_pv(f32x16 (&t)[NS], const float sc, const LAS unsigned char* vst, const int (&voff)[NS], f32x16 (&o)[2], float& m, float& l, int lane) {
    sm_max<NS>(t, sc, o, m, l); sm_exp_pv<NS>(t, sc, vst, voff, o, m, l, lane);
}
template <int DQK>
__device__ __forceinline__ f32x16 qkn(const LAS unsigned char* kst, int koff, const bf16x8 (&qr)[DQK / 16], const f32x16& negm, int r32, int hi) {
    typedef Cfg<DQK> C;
    f32x16 p = negm;
    const LAS unsigned char* kb = kst + (koff + r32) * C::KSTR + hi * 16;
#pragma unroll
    for (int ks = 0; ks < C::NKS; ++ks) { const bf16x8 kf = *(const LAS bf16x8*)(kb + ks * 32); p = __builtin_amdgcn_mfma_f32_32x32x16_bf16(kf, qr[ks], p, 0, 0, 0); }
    return p;
}
__device__ __forceinline__ void sm_max_n(f32x16 (&t)[2], f32x16 (&o)[2], f32x16& osum, float& m, f32x16& negm, bool first) {
    float a0 = fmaxf(fmaxf(t[0][0], t[0][1]), t[0][2]), a1 = fmaxf(fmaxf(t[1][0], t[1][1]), t[1][2]);
#pragma unroll
    for (int r = 3; r < 15; r += 2) { a0 = fmaxf(fmaxf(a0, t[0][r]), t[0][r + 1]); a1 = fmaxf(fmaxf(a1, t[1][r]), t[1][r + 1]); }
    float mx = fmaxf(fmaxf(a0, a1), fmaxf(t[0][15], t[1][15]));
    mx = swap32_max(mx);
    if (first || __any(mx > 8.0f)) { const float d = first ? mx : fmaxf(mx, 0.f); const float a = first ? 1.0f : __builtin_amdgcn_exp2f(-d); m += d;
#pragma unroll
        for (int r = 0; r < 16; ++r) { t[0][r] -= d; t[1][r] -= d; o[0][r] *= a; o[1][r] *= a; osum[r] *= a; negm[r] = -m; } }
}
__device__ __forceinline__ void sm_exp_pv_n(f32x16 (&t)[2], const LAS unsigned char* vst, f32x16 (&o)[2], f32x16& osum, int lane) {
    const int hi = lane >> 5, q4 = (lane & 15) >> 2, p4 = lane & 3, blk = (lane >> 4) & 1;
    const LAS unsigned char* vb = vst + (4 * hi + q4) * VSTR + (16 * blk + 4 * p4) * 2;
    bf16x8 va[2][2][2];
#pragma unroll
    for (int s = 0; s < 2; ++s)
#pragma unroll
        for (int kk = 0; kk < 2; ++kk)
#pragma unroll
            for (int c = 0; c < 2; ++c) { const s16x4 lo = vtr(vb + (32 * s + 16 * kk) * VSTR + c * 64), h8 = vtr(vb + (32 * s + 16 * kk + 8) * VSTR + c * 64);
                va[s][kk][c] = (bf16x8){lo[0], lo[1], lo[2], lo[3], h8[0], h8[1], h8[2], h8[3]}; }
    const bf16x8 ones = (bf16x8){0x3F80, 0x3F80, 0x3F80, 0x3F80, 0x3F80, 0x3F80, 0x3F80, 0x3F80};
#pragma unroll
    for (int s = 0; s < 2; ++s)
#pragma unroll
        for (int kk = 0; kk < 2; ++kk) {
            float e[8];
#pragma unroll
            for (int j = 0; j < 8; ++j) e[j] = __builtin_amdgcn_exp2f(t[s][8 * kk + j]);
            u32x4 pw; pw.x = cvtpk_s(e[0], e[1]); pw.y = cvtpk_s(e[2], e[3]); pw.z = cvtpk_s(e[4], e[5]); pw.w = cvtpk_s(e[6], e[7]);
            const bf16x8 pb = __builtin_bit_cast(bf16x8, pw);
            o[0] = __builtin_amdgcn_mfma_f32_32x32x16_bf16(va[s][kk][0], pb, o[0], 0, 0, 0);
            o[1] = __builtin_amdgcn_mfma_f32_32x32x16_bf16(va[s][kk][1], pb, o[1], 0, 0, 0);
            osum = __builtin_amdgcn_mfma_f32_32x32x16_bf16(ones, pb, osum, 0, 0, 0);
        }
}
__device__ __forceinline__ void finalize_n(const f32x16 (&o)[2], const f32x16& osum, bf16_t* orow, int hi) {
    const float inv = 1.0f / osum[0];
#pragma unroll
    for (int c = 0; c < 2; ++c)
#pragma unroll
        for (int g = 0; g < 4; ++g) { u32x2 w; w.x = cvt_pk_bf16(o[c][4 * g] * inv, o[c][4 * g + 1] * inv); w.y = cvt_pk_bf16(o[c][4 * g + 2] * inv, o[c][4 * g + 3] * inv);
            *(u32x2*)(orow + 32 * c + 8 * g + 4 * hi) = w; }
}
__device__ __forceinline__ void finalize(const f32x16 (&o)[2], float l, bf16_t* orow, int hi) {
    l = swap32_sum(l); const float inv = 1.0f / l;
#pragma unroll
    for (int c = 0; c < 2; ++c)
#pragma unroll
        for (int g = 0; g < 4; ++g) { u32x2 w; w.x = cvt_pk_bf16(o[c][4 * g] * inv, o[c][4 * g + 1] * inv); w.y = cvt_pk_bf16(o[c][4 * g + 2] * inv, o[c][4 * g + 3] * inv);
            *(u32x2*)(orow + 32 * c + 8 * g + 4 * hi) = w; }
}
#define ATT_PIPE_BEGIN(DQK, MLA, ROW0_OF) \
    u32x4 pre[3]; pre[1] = (u32x4){0u, 0u, 0u, 0u}; \
    fetch<DQK, MLA>(pre, Kb, Vb, KRb, pitch, ROW0_OF(0), tid); stash<DQK>(lds, pre, tid); __syncthreads(); \
    for (int i = 0; i < ntiles; ++i) { \
        if (i + 1 < ntiles) fetch<DQK, MLA>(pre, Kb, Vb, KRb, pitch, ROW0_OF(i + 1), tid); \
        const LAS unsigned char* kst = lds + (i & 1) * Cfg<DQK>::STAGE; const LAS unsigned char* vst = kst + Cfg<DQK>::KB;
#define ATT_PIPE_END(DQK) \
        if (i + 1 < ntiles) stash<DQK>(lds + ((i + 1) & 1) * Cfg<DQK>::STAGE, pre, tid); \
        __syncthreads(); }

#define ATT2_RUN(DQK, MLA, ROW0_OF, QK2, FIRST) \
    { typedef Cfg<DQK> C_; LAS unsigned char* const kb_ = lds; LAS unsigned char* const vb_ = lds + 2 * C_::KB; \
    u32x4 pk_[2], pv_; pk_[1] = (u32x4){0u, 0u, 0u, 0u}; \
    fetchK<DQK, MLA>(pk_, Kb, KRb, pitch, ROW0_OF(0), tid); fetchV(pv_, Vb, pitch, ROW0_OF(0), tid); stashK<DQK>(kb_, pk_, tid); stashV(vb_, pv_, tid); \
    if (ntiles > 1) { fetchK<DQK, MLA>(pk_, Kb, KRb, pitch, ROW0_OF(1), tid); stashK<DQK>(kb_ + C_::KB, pk_, tid); } \
    __syncthreads(); \
    f32x16 t[2]; QK2(t, kb_, 0); \
    __syncthreads();     \
    for (int i = 0; i + 1 < ntiles; ++i) { \
        if (i + 2 < ntiles) fetchK<DQK, MLA>(pk_, Kb, KRb, pitch, ROW0_OF(i + 2), tid); \
        fetchV(pv_, Vb, pitch, ROW0_OF(i + 1), tid); \
        sm_max_n(t, o, osum, m, negm, (FIRST) && i == 0); \
        f32x16 tn[2]; QK2(tn, kb_ + ((i + 1) & 1) * C_::KB, i + 1);     \
        sm_exp_pv_n(t, vb_ + (i & 1) * C_::VB, o, osum, lane); \
        t[0] = tn[0]; t[1] = tn[1]; \
        if (i + 2 < ntiles) stashK<DQK>(kb_ + (i & 1) * C_::KB, pk_, tid); \
        stashV(vb_ + ((i + 1) & 1) * C_::VB, pv_, tid); \
        __syncthreads(); } \
    sm_max_n(t, o, osum, m, negm, (FIRST) && ntiles == 1); \
    sm_exp_pv_n(t, vb_ + ((ntiles - 1) & 1) * C_::VB, o, osum, lane); \
    __syncthreads(); }

__device__ __forceinline__ void attn_A_unit(LAS unsigned char* lds, const bf16_t* QKV, bf16_t* O, const float* sink, int b, int kvh, int qb, bool ctxq, int tid) {
    const int lane = tid & 63, wid = __builtin_amdgcn_readfirstlane(tid >> 6), r32 = lane & 31, hi = lane >> 5;
    const int head = kvh * 4 + (wid >> 1), qoff = 32 * (wid & 1) + r32, t0 = qb * 64;
    const int qrow = ctxq ? NL + b * CTXL + t0 + qoff : b * SEQ + t0 + qoff;
    bf16x8 qr[4];
    { const bf16_t* qp = QKV + (size_t)qrow * A_IN + head * 64 + hi * 8;
#pragma unroll
      for (int ks = 0; ks < 4; ++ks) qr[ks] = *(const bf16x8*)(qp + ks * 16); }
    int jlo = 0, nloc = 0;
    if (!ctxq) { jlo = t0 >= 128 ? 0 : (t0 == 64 ? 1 : 2); int jhi = (2112 - t0) / 64; jhi = jhi > 4 ? 4 : jhi; nloc = jhi - jlo + 1; }
    const int ntiles = 4 + nloc, cbase = NL + b * CTXL, lbase = b * SEQ + t0 - 128 + 64 * jlo;
    const bf16_t* Kb = QKV + 1024 + kvh * 64; const bf16_t* Vb = QKV + 1280 + kvh * 64; const bf16_t* KRb = nullptr; const int pitch = A_IN;
    float m = sink[head] * LOG2E;
    f32x16 o[2], osum, negm;
#pragma unroll
    for (int r = 0; r < 16; ++r) { o[0][r] = 0.f; o[1][r] = 0.f; osum[r] = 1.0f; negm[r] = -m; }
#define A_ROW0(i) ((i) < 4 ? cbase + 64 * (i) : lbase + 64 * ((i) - 4))
#define A_QK2(dst, kst, ti) { dst[0] = qkn<64>(kst, 0, qr, negm, r32, hi); dst[1] = qkn<64>(kst, 32, qr, negm, r32, hi); const int j_ = (ti) < 4 ? 2 : jlo + (ti) - 4; \
        if (j_ == 0 || j_ == 4) { _Pragma("unroll") for (int s = 0; s < 2; ++s) _Pragma("unroll") for (int r = 0; r < 16; ++r) { const int kk = 32 * s + crow(r, hi); \
            if (j_ == 0 ? (kk < qoff) : (kk > qoff)) dst[s][r] = -1e30f; } } }
    ATT2_RUN(64, false, A_ROW0, A_QK2, false)
#undef A_QK2
#undef A_ROW0
    finalize_n(o, osum, O + (size_t)qrow * D + head * 64, hi);
}

__device__ __forceinline__ void attn_B_unit(LAS unsigned char* lds, LAS float* tab, const bf16_t* QKV, bf16_t* O, const float* rpb, int b, int h, int rq, bool ctxq, int tid) {
    const int lane = tid & 63, wid = __builtin_amdgcn_readfirstlane(tid >> 6), r32 = lane & 31, hi = lane >> 5;
    const int jb = wid & 3, rp = wid >> 2;
    const int rqa = 4 * rq + 2 * rp + (r32 >> 4), qcol = 16 * jb + (r32 & 15);
    const int qrow = ctxq ? NL + b * CTXL + 32 * wid + r32 : b * SEQ + rqa * 64 + qcol;
    for (int idx = tid; idx < 15 * 31; idx += 512) tab[(idx / 31) * 32 + idx % 31] = rpb[h * 465 + idx] * LOG2E;
    bf16x8 qr[4];
    { const bf16_t* qp = QKV + (size_t)qrow * B_IN + h * 64 + hi * 8;
#pragma unroll
      for (int ks = 0; ks < 4; ++ks) qr[ks] = *(const bf16x8*)(qp + ks * 16); }
    int klo = 0, nloc = 0;
    if (!ctxq) { klo = 4 * rq - 4; klo = klo < 0 ? 0 : (klo > 24 ? 24 : klo); int khi = 4 * rq - 1; khi = khi < 0 ? 0 : (khi > 24 ? 24 : khi); khi += 7; nloc = khi - klo + 1; }
    const int ntiles = 4 + nloc, cbase = NL + b * CTXL, lbase = b * SEQ;
    int r0q = rqa - 4; r0q = r0q < 0 ? 0 : (r0q > 24 ? 24 : r0q);
    int wst = qcol - 8; wst = wst < 0 ? 0 : (wst > 48 ? 48 : wst);
    int cst = 16 * jb - 8; cst = cst < 0 ? 0 : (cst > 32 ? 32 : cst);
    const int lo = wst - cst;
    int wr0 = 4 * rq + 2 * rp - 4; wr0 = wr0 < 0 ? 0 : (wr0 > 24 ? 24 : wr0);
    int wr1 = 4 * rq + 2 * rp + 1 - 4; wr1 = wr1 < 0 ? 0 : (wr1 > 24 ? 24 : wr1); wr1 += 7;
    const bf16_t* Kb = QKV + 1024 + h * 64; const bf16_t* Vb = QKV + 2048 + h * 64; const bf16_t* KRb = nullptr; const int pitch = B_IN;
    float m = -1e30f, l = 0.f;
    f32x16 o[2];
#pragma unroll
    for (int r = 0; r < 16; ++r) { o[0][r] = 0.f; o[1][r] = 0.f; }
    const float sc = 0.125f * LOG2E;
#define B_ROW0(i) ((i) < 4 ? cbase + 64 * (i) : lbase + 64 * (klo + (i) - 4))
    ATT_PIPE_BEGIN(64, false, B_ROW0)
        if (i < 4) {
            f32x16 t[2];
            t[0] = qk<64>(kst, 0, qr, r32, hi); t[1] = qk<64>(kst, 32, qr, r32, hi);
#pragma unroll
            for (int s = 0; s < 2; ++s)
#pragma unroll
                for (int r = 0; r < 16; ++r) t[s][r] *= 1.0f;
            const int voff[2] = {0, 32};
            sm_pv<2>(t, 1.0f, vst, voff, o, m, l, lane);
        } else {
            const int kr = klo + i - 4;
            if (kr >= wr0 && kr <= wr1) {
                f32x16 t[1];
                t[0] = qk<64>(kst, cst, qr, r32, hi);
                const bool rowok = (kr >= r0q) && (kr < r0q + 8);
                const int bidx0 = (kr - rqa + 7) * 32 + cst - qcol + 15;
#pragma unroll
                for (int r = 0; r < 16; ++r) { const int kidx = crow(r, hi); const bool ok = rowok && ((unsigned)(kidx - lo) < 16u);
                    int bi = bidx0 + kidx; bi = bi < 0 ? 0 : (bi > 479 ? 479 : bi);
                    const float bias = tab[bi];
                    t[0][r] = ok ? t[0][r] + bias : -1e30f; }
                const int voff[1] = {cst};
                sm_pv<1>(t, 1.0f, vst, voff, o, m, l, lane);
            }
        }
    ATT_PIPE_END(64)
#undef B_ROW0
    finalize(o, l, O + (size_t)qrow * D + h * 64, hi);
}

__device__ __forceinline__ void attn_C_unit(LAS unsigned char* lds, const bf16_t* Q2, const bf16_t* KR, bf16_t* O, int b, int h, int qb, bool ctxq, int tid) {
    const int lane = tid & 63, wid = __builtin_amdgcn_readfirstlane(tid >> 6), r32 = lane & 31, hi = lane >> 5;
    const int qrow = ctxq ? NL + b * CTXL + 32 * wid + r32 : b * SEQ + qb * 256 + 32 * wid + r32;
    bf16x8 qr[6];
    { const bf16_t* qp = Q2 + (size_t)qrow * C_UPN + h * 96 + hi * 8;
#pragma unroll
      for (int ks = 0; ks < 6; ++ks) qr[ks] = *(const bf16x8*)(qp + ks * 16); }
    const int ntiles = ctxq ? 4 : 36, cbase = NL + b * CTXL, lbase = b * SEQ;
    const bf16_t* Kb = Q2 + 1536 + h * 128; const bf16_t* Vb = Kb + 64; const bf16_t* KRb = KR; const int pitch = C_UPN;
    float m = 0.f;
    f32x16 o[2], osum, negm;
#pragma unroll
    for (int r = 0; r < 16; ++r) { o[0][r] = 0.f; o[1][r] = 0.f; osum[r] = 0.f; negm[r] = 0.f; }
#define C_ROW0(i) ((i) < 4 ? cbase + 64 * (i) : lbase + 64 * ((i) - 4))
#define C_QK2(dst, kst, ti) { dst[0] = qkn<96>(kst, 0, qr, negm, r32, hi); dst[1] = qkn<96>(kst, 32, qr, negm, r32, hi); }
    ATT2_RUN(96, true, C_ROW0, C_QK2, true)
#undef C_QK2
#undef C_ROW0
    finalize_n(o, osum, O + (size_t)qrow * D + h * 64, hi);
}
}

struct Row4 { f32x4 v[4]; };
__device__ __forceinline__ void row_load(Row4& x, const float* p, int lane) {
#pragma unroll
    for (int j = 0; j < 4; ++j) x.v[j] = *(const f32x4*)(p + 4 * lane + 256 * j);
}
__device__ __forceinline__ void row_store(const Row4& x, float* p, int lane) {
#pragma unroll
    for (int j = 0; j < 4; ++j) *(f32x4*)(p + 4 * lane + 256 * j) = x.v[j];
}
__device__ __forceinline__ float row_rstd(const Row4& x, int lane) {
    float s = 0.f;
#pragma unroll
    for (int j = 0; j < 4; ++j) s += (x.v[j][0] * x.v[j][0] + x.v[j][1] * x.v[j][1]) + (x.v[j][2] * x.v[j][2] + x.v[j][3] * x.v[j][3]);
    s = wave_sum(s, lane);
    return 1.0f / sqrtf(s * (1.0f / D) + NORM_EPS);
}
__device__ __forceinline__ void norm_mod(const Row4& x, float rstd, const float* g, const float* sh, const float* sc, bf16_t* out, int lane, Row4& hv) {
#pragma unroll
    for (int j = 0; j < 4; ++j) { const int c = 4 * lane + 256 * j;
        const f32x4 gg = *(const f32x4*)(g + c), s1 = *(const f32x4*)(sc + c), s0 = *(const f32x4*)(sh + c);
        const f32x4 h = (x.v[j] * rstd * gg) * (s1 + 1.0f) + s0; hv.v[j] = h;
        u32x2 w; w.x = cvt_pk_bf16(h[0], h[1]); w.y = cvt_pk_bf16(h[2], h[3]); *(u32x2*)(out + c) = w; }
}

struct Ptrs {
    const float* in[29]; float* out; unsigned char* ws;
};
typedef const __attribute__((address_space(4))) Ptrs* PK;
#define WSP(T, off) ((T*)(P->ws + (off)))

__device__ __forceinline__ unsigned pk_f16(float a, float b) { const f32x2 v = {a, b}; const f16x2 h = __builtin_convertvector(v, f16x2); return __builtin_bit_cast(unsigned, h); }
__device__ __forceinline__ void phase_first_norm(PK P, int gw, int lane) {
    const float* MOD = WSP(const float, WS_MOD);
    {
        const int gt = gw * 64 + lane;
        for (int q = gt; q < DEPTH * 9 * 4096; q += 131072) { const int lb = q >> 12, cc = q & 4095, c = cc >> 5, e = cc & 31, l = lb / 9, b = lb - 9 * l;
            const float* g = P->in[7] + (size_t)l * D + 8 * c; const float* sc = MOD + ((size_t)l * 9 + b) * 6144 + 4096 + 8 * c; const float* w = P->in[21] + ((size_t)l * D + 8 * c) * NEXP + e;
            float v[8];
#pragma unroll
            for (int j = 0; j < 8; ++j) v[j] = g[j] * (1.0f + sc[j]) * w[j * NEXP];
            u32x4 o; o.x = pk_f16(v[0], v[1]); o.y = pk_f16(v[2], v[3]); o.z = pk_f16(v[4], v[5]); o.w = pk_f16(v[6], v[7]);
            *(u32x4*)(WSP(unsigned char, WS_G16) + (size_t)lb * 65536 + e * 2048 + ((c ^ (e & 15)) * 16)) = o; }
        for (int q = gw; q < DEPTH * 9 * 32; q += 2048) { const int lb = q >> 5, e = q & 31, l = lb / 9, b = lb - 9 * l;
            const float* sh = MOD + ((size_t)l * 9 + b) * 6144 + 3072; const float* w = P->in[21] + (size_t)l * D * NEXP + e; float t = 0.f;
#pragma unroll
            for (int j = 0; j < 16; ++j) { const int k = lane + 64 * j; t += sh[k] * w[(size_t)k * NEXP]; }
            t = wave_sum(t, lane);
            if (lane == 0) WSP(float, WS_RC)[q] = t + P->in[22][l * NEXP + e]; }
    }
    for (int r = gw; r < NT; r += 2048) {
        const float* src = r < NL ? P->in[0] + (size_t)r * D : P->in[2] + (size_t)(r - NL) * D;
        Row4 x, hv; row_load(x, src, lane); row_store(x, WSP(float, WS_XS) + (size_t)r * D, lane);
        const float rstd = row_rstd(x, lane); const int rb = r < NL ? (r >> 11) : 8; const float* mod = MOD + (size_t)rb * 6144;
        norm_mod(x, rstd, P->in[6], mod, mod + 1024, WSP(bf16_t, WS_H) + (size_t)r * D, lane, hv);
    }
}
__device__ __forceinline__ void phase_mla_norm(PK P, int gw, int lane) {
    const float* Y = WSP(const float, WS_Y416); bf16_t* CQ = WSP(bf16_t, WS_CQKV); bf16_t* KR = WSP(bf16_t, WS_KR);
    const float* qn = P->in[16]; const float* kn = P->in[17]; const float* rope = WSP(const float, WS_ROPE_C);
    for (int r = gw; r < NT; r += 2048) {
        const float* y = Y + (size_t)r * C_INP;
        const f32x4 v = *(const f32x4*)(y + 4 * lane);
        const float ss = wave_sum((v[0] * v[0] + v[1] * v[1]) + (v[2] * v[2] + v[3] * v[3]), lane);
        const float rq = 1.0f / sqrtf(ss * (1.0f / 256.0f) + NORM_EPS);
        const f32x4 g = *(const f32x4*)(qn + 4 * lane);
        u32x2 w; w.x = cvt_pk_bf16(v[0] * rq * g[0], v[1] * rq * g[1]); w.y = cvt_pk_bf16(v[2] * rq * g[2], v[3] * rq * g[3]);
        *(u32x2*)(CQ + (size_t)r * C_UPK + 4 * lane) = w;
        const f32x2 k2 = *(const f32x2*)(y + 256 + 2 * lane);
        const float s2 = wave_sum(k2[0] * k2[0] + k2[1] * k2[1], lane);
        const float rk = 1.0f / sqrtf(s2 * (1.0f / 128.0f) + NORM_EPS);
        const f32x2 g2 = *(const f32x2*)(kn + 2 * lane);
        *(unsigned*)(CQ + (size_t)r * C_UPK + 256 + 2 * lane) = cvt_pk_bf16(k2[0] * rk * g2[0], k2[1] * rk * g2[1]);
        if (lane < 16) { f32x2 p = *(const f32x2*)(y + 384 + 2 * lane);
            if (r < NL) { const f32x2 cs = *(const f32x2*)(rope + ((size_t)(r & (SEQ - 1)) * 16 + lane) * 2); const float a = p[0], b = p[1]; p[0] = a * cs[0] - b * cs[1]; p[1] = a * cs[1] + b * cs[0]; }
            *(unsigned*)(KR + (size_t)r * 32 + 2 * lane) = cvt_pk_bf16(p[0], p[1]); }
    }
}
__device__ __forceinline__ void moe_tables(LAS unsigned char* misc, unsigned* gcnt, int tid) {
    LAS int* ecnt = (LAS int*)(misc + M_ECNT); LAS int* lbase = (LAS int*)(misc + M_LBASE); LAS int* cumt = (LAS int*)(misc + M_CUMT);
    if (tid < 32) ecnt[tid] = (int)__hip_atomic_load(gcnt + tid * 16, __ATOMIC_RELAXED, __HIP_MEMORY_SCOPE_AGENT);
    __syncthreads();
    if (tid == 0) { int s = 0, t = 0; for (int e = 0; e < 32; ++e) { lbase[e] = s; cumt[e] = t; const int mt = (ecnt[e] + 255) >> 8; s += mt * 256; t += mt; } cumt[32] = t; }
    __syncthreads();
}
constexpr int RT_PLOG = 65536, RT_LOGIT = 98304, RT_SSQ = 102912, RT_RSTD = 103936, RT_CVEC = 104064, RT_AMX = 104192;
__device__ __forceinline__ unsigned pk_i8x4(float a, float b, float c, float d, float inv) {
    const int q0 = (int)rintf(a * inv), q1 = (int)rintf(b * inv), q2 = (int)rintf(c * inv), q3 = (int)rintf(d * inv);
    return (unsigned)(q0 & 255) | ((unsigned)(q1 & 255) << 8) | ((unsigned)(q2 & 255) << 16) | ((unsigned)q3 << 24);
}
__device__ __forceinline__ void phase_router(PK P, LAS unsigned char* lds, int l, int nrows, int vcu, int tid, int cset) {
    const int lane = tid & 63, wid = __builtin_amdgcn_readfirstlane(tid >> 6), i32 = lane & 31, hi = lane >> 5;
    LAS unsigned char* misc = lds + MISC_OFF;
    LAS int* lcnt = (LAS int*)(misc + M_LCNT); LAS int* gbase = (LAS int*)(misc + M_GBASE); LAS int* rec = (LAS int*)(misc + M_REC);
    LAS float* plog = (LAS float*)(lds + RT_PLOG); LAS float* logit = (LAS float*)(lds + RT_LOGIT); LAS float* ssq = (LAS float*)(lds + RT_SSQ);
    LAS float* rstd_s = (LAS float*)(lds + RT_RSTD); LAS float* cvec = (LAS float*)(lds + RT_CVEC); LAS float* amx = (LAS float*)(lds + RT_AMX); LAS float* rowsa = (LAS float*)(misc + M_RSA);
    const bool last = (nrows == NL);
    const int nb = (!last && vcu < 64) ? 3 : 2;
    const float* MOD = WSP(const float, WS_MOD) + (size_t)l * 9 * 6144;
    float* XS = WSP(float, WS_XS); unsigned char* H8 = WSP(unsigned char, WS_H);
    int* TOPE = WSP(int, WS_TOPE); float* GATE = WSP(float, WS_GATE);
    const float* gn = P->in[7] + (size_t)l * D;
    if (tid < 32) lcnt[tid] = 0;
    for (int bi = 0; bi < nb; ++bi) {
        const int rb = bi < 2 ? (vcu >> 5) : 8;
        const int row0 = bi < 2 ? 64 * vcu + 32 * bi : NL + 32 * vcu;
        if (bi != 1) {
            __syncthreads();
            const u32x4* gsrc = (const u32x4*)(WSP(const unsigned char, WS_G16) + (size_t)(l * 9 + rb) * 65536);
#pragma unroll
            for (int c = 0; c < 8; ++c) *(LAS u32x4*)(lds + (size_t)(tid + 512 * c) * 16) = gsrc[tid + 512 * c];
            if (tid < 32) cvec[tid] = WSP(const float, WS_RC)[(l * 9 + rb) * 32 + tid];
            __syncthreads();
        }
        const int r = row0 + i32; const float* xp = XS + (size_t)r * D + 128 * wid + 8 * hi;
        f32x4 xa[8], xb[8];
#pragma unroll
        for (int s = 0; s < 8; ++s) { xa[s] = *(const f32x4*)(xp + 16 * s); xb[s] = *(const f32x4*)(xp + 16 * s + 4); }
        float ss = 0.f;
        f32x16 acc;
#pragma unroll
        for (int q = 0; q < 16; ++q) acc[q] = 0.f;
#pragma unroll
        for (int s = 0; s < 8; ++s) {
            ss += (xa[s][0] * xa[s][0] + xa[s][1] * xa[s][1]) + (xa[s][2] * xa[s][2] + xa[s][3] * xa[s][3]) + (xb[s][0] * xb[s][0] + xb[s][1] * xb[s][1]) + (xb[s][2] * xb[s][2] + xb[s][3] * xb[s][3]);
            u32x4 aw; aw.x = pk_f16(xa[s][0], xa[s][1]); aw.y = pk_f16(xa[s][2], xa[s][3]); aw.z = pk_f16(xb[s][0], xb[s][1]); aw.w = pk_f16(xb[s][2], xb[s][3]);
            const int c = 16 * wid + 2 * s + hi;
            const f16x8 bf = *(const LAS f16x8*)(lds + i32 * 2048 + ((c ^ (i32 & 15)) * 16));
            acc = __builtin_amdgcn_mfma_f32_32x32x16_f16(__builtin_bit_cast(f16x8, aw), bf, acc, 0, 0, 0);
        }
        ss = swap32_sum(ss);
        if (hi == 0) ssq[wid * 32 + i32] = ss;
#pragma unroll
        for (int q = 0; q < 16; ++q) plog[(wid * 32 + att::crow(q, hi)) * 32 + i32] = acc[q];
        __syncthreads();
        if (tid < 32) { float t = 0.f;
#pragma unroll
            for (int w = 0; w < 8; ++w) t += ssq[w * 32 + tid];
            rstd_s[tid] = 1.0f / sqrtf(t * (1.0f / D) + NORM_EPS); }
        __syncthreads();
#pragma unroll
        for (int u = 0; u < 2; ++u) { const int idx = tid + 512 * u, rr = idx >> 5, e = idx & 31; float t = 0.f;
#pragma unroll
            for (int w = 0; w < 8; ++w) t += plog[(w * 32 + rr) * 32 + e];
            logit[rr * 33 + e] = rstd_s[rr] * t + cvec[e]; }
        { const float rs = rstd_s[i32]; const float* mod = MOD + (size_t)rb * 6144; const int k0 = 128 * wid + 8 * hi; float am = 0.f;
#pragma unroll
          for (int s = 0; s < 8; ++s) { const int k = k0 + 16 * s;
              const f32x4 g0 = *(const f32x4*)(gn + k), g1 = *(const f32x4*)(gn + k + 4), c0 = *(const f32x4*)(mod + 4096 + k), c1 = *(const f32x4*)(mod + 4096 + k + 4);
              const f32x4 s0 = *(const f32x4*)(mod + 3072 + k), s1 = *(const f32x4*)(mod + 3072 + k + 4);
              const f32x4 h0 = (xa[s] * rs * g0) * (c0 + 1.0f) + s0, h1 = (xb[s] * rs * g1) * (c1 + 1.0f) + s1; xa[s] = h0; xb[s] = h1;
              am = fmaxf(fmaxf(fmaxf(am, fabsf(h0[0])), fmaxf(fabsf(h0[1]), fabsf(h0[2]))), fmaxf(fmaxf(fabsf(h0[3]), fabsf(h1[0])), fmaxf(fabsf(h1[1]), fmaxf(fabsf(h1[2]), fabsf(h1[3]))))); }
          am = swap32_max(am);
          if (hi == 0) amx[wid * 32 + i32] = am; }
        __syncthreads();
        { float a = amx[i32];
#pragma unroll
          for (int w = 1; w < 8; ++w) a = fmaxf(a, amx[w * 32 + i32]);
          a = fmaxf(a, 1e-20f); const float inv = 127.0f / a;
          if (wid == 0 && hi == 0) rowsa[32 * bi + i32] = a * (1.0f / 127.0f);
          unsigned char* hp = H8 + (size_t)r * D + 128 * wid + 8 * hi;
#pragma unroll
          for (int s = 0; s < 8; ++s) { u32x2 w; w.x = pk_i8x4(xa[s][0], xa[s][1], xa[s][2], xa[s][3], inv); w.y = pk_i8x4(xb[s][0], xb[s][1], xb[s][2], xb[s][3], inv); *(u32x2*)(hp + 16 * s) = w; } }
        if (tid < 32) {
            float t0 = -INFINITY, t1 = -INFINITY, t2 = -INFINITY, t3 = -INFINITY; int e0 = 0, e1 = 0, e2 = 0, e3 = 0;
#pragma unroll 4
            for (int e = 0; e < 32; ++e) { const float v = logit[tid * 33 + e];
                if (v > t3) { if (v > t2) { t3 = t2; e3 = e2; if (v > t1) { t2 = t1; e2 = e1; if (v > t0) { t1 = t0; e1 = e0; t0 = v; e0 = e; } else { t1 = v; e1 = e; } } else { t2 = v; e2 = e; } } else { t3 = v; e3 = e; } } }
            const float x1 = __expf(t1 - t0), x2 = __expf(t2 - t0), x3 = __expf(t3 - t0); const float inv = 1.0f / (1.0f + x1 + x2 + x3);
            const int rr = row0 + tid, lr = 32 * bi + tid;
            *(int4*)(TOPE + (size_t)rr * 4) = make_int4(e0, e1, e2, e3);
            *(f32x4*)(GATE + (size_t)rr * 4) = (f32x4){inv, x1 * inv, x2 * inv, x3 * inv};
            const int ee[4] = {e0, e1, e2, e3};
#pragma unroll
            for (int k = 0; k < 4; ++k) { const int lp = __hip_atomic_fetch_add(lcnt + ee[k], 1, __ATOMIC_RELAXED, __HIP_MEMORY_SCOPE_WORKGROUP); rec[2 * (lr * 4 + k)] = ee[k]; rec[2 * (lr * 4 + k) + 1] = lp; }
        }
    }
    __syncthreads();
    unsigned* gcnt = WSP(unsigned, WS_CTL) + CW_CNT + (l * 2 + cset) * 512;
    if (tid < 32) { const int c = lcnt[tid]; gbase[tid] = c ? (int)__hip_atomic_fetch_add(gcnt + tid * 16, (unsigned)c, __ATOMIC_RELAXED, __HIP_MEMORY_SCOPE_AGENT) : 0; }
    __syncthreads();
    int* ELIST = WSP(int, WS_ELIST); int* POS = WSP(int, WS_POS);
    for (int idx = tid; idx < nb * 128; idx += 512) { const int e = rec[2 * idx], pos = gbase[e] + rec[2 * idx + 1]; const int lr = idx >> 2; const int r = lr < 64 ? 64 * vcu + lr : NL + 32 * vcu + (lr - 64);
        ELIST[(size_t)e * NT + pos] = r; POS[(size_t)r * 4 + (idx & 3)] = pos; WSP(float, WS_SAL)[(size_t)e * NT + pos] = rowsa[lr]; }
    __syncthreads();
}
__device__ __forceinline__ void phase_combine(PK P, LAS unsigned char* lds, int l, int nrows, int gw, int tid, bool dry) {
    const int lane = tid & 63;
    LAS unsigned char* misc = lds + MISC_OFF;
    moe_tables(misc, WSP(unsigned, WS_CTL) + CW_CNT + (l * 2 + ((MK_REP_MASK >> 11) & 1)) * 512, tid);
    const size_t dryoff = dry ? (WS_ACT - WS_XS) / 4 : 0;
    const LAS int* lbase = (const LAS int*)(misc + M_LBASE);
    const float* MOD = WSP(const float, WS_MOD); const float* g2 = MOD + (size_t)l * 9 * 6144 + 5120;
    float* XS = WSP(float, WS_XS); const bf16_t* YS = WSP(const bf16_t, WS_YS);
    const int* TOPE = WSP(const int, WS_TOPE); const int* POS = WSP(const int, WS_POS); const float* GATE = WSP(const float, WS_GATE);
    const bool last = (l == DEPTH - 1);
    for (int r = gw; r < nrows; r += 2048) {
        int slot = 0; float gate = 0.f;
        if (lane < 4) { slot = lbase[TOPE[(size_t)r * 4 + lane]] + POS[(size_t)r * 4 + lane]; gate = GATE[(size_t)r * 4 + lane]; }
        Row4 x; row_load(x, XS + (size_t)r * D, lane);
        Row4 f;
#pragma unroll
        for (int j = 0; j < 4; ++j) f.v[j] = (f32x4){0.f, 0.f, 0.f, 0.f};
#pragma unroll
        for (int k = 0; k < 4; ++k) { const int sk = __builtin_amdgcn_readlane(slot, k); const float gk = __int_as_float(__builtin_amdgcn_readlane(__float_as_int(gate), k)); const bf16_t* yr = YS + (size_t)sk * D;
#pragma unroll
            for (int j = 0; j < 4; ++j) { const u32x2 w = *(const u32x2*)(yr + 4 * lane + 256 * j);
                f.v[j][0] += gk * bf_lo(w.x); f.v[j][1] += gk * bf_hi(w.x); f.v[j][2] += gk * bf_lo(w.y); f.v[j][3] += gk * bf_hi(w.y); } }
        const int rb = r < NL ? (r >> 11) : 8;
#pragma unroll
        for (int j = 0; j < 4; ++j) { const f32x4 gg = *(const f32x4*)(g2 + (size_t)rb * 6144 + 4 * lane + 256 * j); x.v[j] = x.v[j] + gg * f.v[j]; }
        const float rstd = row_rstd(x, lane);
        if (last) {
#pragma unroll
            for (int j = 0; j < 4; ++j) { const int c = 4 * lane + 256 * j; const f32x4 gn = *(const f32x4*)(P->in[8] + c); *(f32x4*)((dry ? XS + dryoff : P->out) + (size_t)r * D + c) = x.v[j] * rstd * gn; }
        } else {
            row_store(x, XS + dryoff + (size_t)r * D, lane);
            Row4 hv; const float* mod = MOD + (size_t)(l + 1) * 9 * 6144 + (size_t)rb * 6144;
            norm_mod(x, rstd, P->in[6] + (size_t)(l + 1) * D, mod, mod + 1024, (dry ? WSP(bf16_t, WS_ACT + 80 * MiB) : WSP(bf16_t, WS_H)) + (size_t)r * D, lane, hv);
        }
    }
}
__device__ __forceinline__ void phase_final_norm(PK P, int gw, int lane) {
    for (int r = gw; r < NL; r += 2048) { Row4 x; row_load(x, WSP(float, WS_XS) + (size_t)r * D, lane); const float rstd = row_rstd(x, lane);
#pragma unroll
        for (int j = 0; j < 4; ++j) { const int c = 4 * lane + 256 * j; const f32x4 gn = *(const f32x4*)(P->in[8] + c); *(f32x4*)(P->out + (size_t)r * D + c) = x.v[j] * rstd * gn; } }
}

__device__ __forceinline__ void conv_item(const float* src, int N, int nvalid, int k0, int n0, bf16_t* dst, int ldk, int drow0, int dk0, LAS unsigned* scr, int lane) {
    const int q = lane >> 4, nl = lane & 15, n = n0 + 4 * nl;
    f32x4 v[16];
#pragma unroll
    for (int r = 0; r < 16; ++r) { const int k = k0 + 8 * (r >> 1) + 2 * q + (r & 1);
        v[r] = (n < nvalid) ? __builtin_nontemporal_load((const f32x4*)(src + (size_t)k * N + n)) : (f32x4){0.f, 0.f, 0.f, 0.f}; }
#pragma unroll
    for (int rp = 0; rp < 8; ++rp)
#pragma unroll
        for (int i = 0; i < 4; ++i) { const int nn = 4 * nl + i, kw = 4 * rp + q; scr[nn * 32 + (kw ^ (4 * ((nn >> 2) & 7)))] = cvt_pk_bf16(v[2 * rp][i], v[2 * rp + 1][i]); }
    asm volatile("s_waitcnt lgkmcnt(0)" ::: "memory");
#pragma unroll
    for (int it = 0; it < 8; ++it) { const int nn = 8 * it + (lane >> 3), c = lane & 7;
        const u32x4 w = *(const LAS u32x4*)(scr + nn * 32 + 4 * (c ^ ((nn >> 2) & 7)));
        *(u32x4*)(dst + (size_t)(drow0 + nn) * ldk + dk0 + 8 * c) = w; }
    asm volatile("s_waitcnt lgkmcnt(0)" ::: "memory");
}
constexpr int CV_A_IN = 2 * 16 * 24, CV_A_OUT = 2 * 256, CV_B_IN = 16 * 48, CV_B_OUT = 256, CV_C_IN = 16 * 8, CV_C_UQ = 4 * 24, CV_C_UKV = 2 * 32, CV_C_OUT = 256;
constexpr int CV_SMALL = CV_A_IN + CV_A_OUT + CV_B_IN + CV_B_OUT + CV_C_IN + CV_C_UQ + CV_C_UKV + CV_C_OUT;
constexpr int CV_LAYER = NEXP * 3 * 256;
constexpr int CV_TOTAL = CV_SMALL + DEPTH * CV_LAYER;
constexpr int CV_CHUNK = 32;
__device__ __forceinline__ void conv_dispatch(PK P, int item, LAS unsigned* scr, int lane) {
    int r = item; const float* src; bf16_t* dst; int N, kb, nb, ldk = D, drow_off = 0, dk_off = 0;
    if (r < CV_A_IN) { const int s = r / 384, it = r % 384; kb = it / 24; nb = it % 24; src = P->in[9] + (size_t)s * D * A_IN; N = A_IN; dst = WSP(bf16_t, WS_WA_IN) + (size_t)s * A_IN * D; }
    else if ((r -= CV_A_IN) < CV_A_OUT) { const int s = r / 256, it = r % 256; kb = it / 16; nb = it % 16; src = P->in[10] + (size_t)s * D * D; N = D; dst = WSP(bf16_t, WS_WA_OUT) + (size_t)s * D * D; }
    else if ((r -= CV_A_OUT) < CV_B_IN) { kb = r / 48; nb = r % 48; src = P->in[12]; N = B_IN; dst = WSP(bf16_t, WS_WB_IN); }
    else if ((r -= CV_B_IN) < CV_B_OUT) { kb = r / 16; nb = r % 16; src = P->in[13]; N = D; dst = WSP(bf16_t, WS_WB_OUT); }
    else if ((r -= CV_B_OUT) < CV_C_IN) { kb = r / 8; nb = r % 8; src = P->in[15]; N = C_IN; dst = WSP(bf16_t, WS_WC_IN); }
    else if ((r -= CV_C_IN) < CV_C_UQ) { kb = r / 24; nb = r % 24; src = P->in[18]; N = 1536; dst = WSP(bf16_t, WS_WC_UP); ldk = C_UPK; }
    else if ((r -= CV_C_UQ) < CV_C_UKV) { kb = r / 32; nb = r % 32; src = P->in[19]; N = 2048; dst = WSP(bf16_t, WS_WC_UP); ldk = C_UPK; drow_off = 1536; dk_off = 256; }
    else { r -= CV_C_UKV; kb = r / 16; nb = r % 16; src = P->in[20]; N = D; dst = WSP(bf16_t, WS_WC_OUT); }
    conv_item(src, N, N, 64 * kb, 64 * nb, dst, ldk, drow_off + 64 * nb, dk_off + 64 * kb, scr, lane);
}
__device__ __forceinline__ void conv_down_item(PK P, int L, int di, LAS unsigned* scr, int lane) {
    const int le = L * NEXP + (di >> 8), it = di & 255, kb = it >> 4, nb = it & 15;
    conv_item(P->in[27] + (size_t)le * D * D, D, D, 64 * kb, 64 * nb, WSP(bf16_t, WS_WD) + (size_t)le * D * D, D, 64 * nb, 64 * kb, scr, lane);
}
__device__ __forceinline__ void conv_gu_block(PK P, LAS unsigned char* lds, int le, int which, int nb, int tid) {
    const int lane = tid & 63, wid = __builtin_amdgcn_readfirstlane(tid >> 6), q = lane >> 4, nl = lane & 15, n0 = 64 * nb;
    const float* src = P->in[which ? 25 : 23] + (size_t)le * D * D + n0 + 4 * nl;
    f32x4 v[32];
#pragma unroll
    for (int r = 0; r < 32; ++r) { const int k = 128 * wid + 16 * (r >> 2) + 4 * q + (r & 3); v[r] = __builtin_nontemporal_load((const f32x4*)(src + (size_t)k * D)); }
    float cm[4] = {0.f, 0.f, 0.f, 0.f};
#pragma unroll
    for (int r = 0; r < 32; ++r)
#pragma unroll
        for (int i = 0; i < 4; ++i) cm[i] = fmaxf(cm[i], fabsf(v[r][i]));
    LAS float* cmx = (LAS float*)(lds + 65536);
#pragma unroll
    for (int i = 0; i < 4; ++i) { cm[i] = fmaxf(cm[i], shx(cm[i], 16, lane)); cm[i] = swap32_max(cm[i]); }
    if (q == 0) { *(LAS f32x4*)(cmx + wid * 64 + 4 * nl) = (f32x4){cm[0], cm[1], cm[2], cm[3]}; }
    __syncthreads();
    f32x4 a = *(const LAS f32x4*)(cmx + 4 * nl);
#pragma unroll
    for (int w = 1; w < 8; ++w) { const f32x4 b = *(const LAS f32x4*)(cmx + w * 64 + 4 * nl); a[0] = fmaxf(a[0], b[0]); a[1] = fmaxf(a[1], b[1]); a[2] = fmaxf(a[2], b[2]); a[3] = fmaxf(a[3], b[3]); }
    float inv[4];
#pragma unroll
    for (int i = 0; i < 4; ++i) { a[i] = fmaxf(a[i], 1e-30f); inv[i] = 127.0f / a[i]; }
    const int drow0 = 256 * (n0 >> 7) + (n0 & 127) + (which ? 128 : 0);
    if (wid == 0 && q == 0) *(f32x4*)(WSP(float, WS_SBW) + (size_t)le * 2048 + drow0 + 4 * nl) = a * (1.0f / 127.0f);
    LAS unsigned* scr = (LAS unsigned*)(lds + wid * 8192);
#pragma unroll
    for (int rp = 0; rp < 8; ++rp)
#pragma unroll
        for (int i = 0; i < 4; ++i) { const int nn = 4 * nl + i, kw = 4 * rp + q;
            scr[nn * 32 + (kw ^ (4 * ((nn >> 2) & 7)))] = pk_i8x4(v[4 * rp][i], v[4 * rp + 1][i], v[4 * rp + 2][i], v[4 * rp + 3][i], inv[i]); }
    asm volatile("s_waitcnt lgkmcnt(0)" ::: "memory");
    unsigned char* dst = WSP(unsigned char, WS_WGU) + (size_t)le * 2048 * D + 128 * wid;
#pragma unroll
    for (int it = 0; it < 8; ++it) { const int nn = 8 * it + (lane >> 3), c = lane & 7;
        const u32x4 w = *(const LAS u32x4*)(scr + nn * 32 + 4 * (c ^ ((nn >> 2) & 7)));
        *(u32x4*)(dst + (size_t)(drow0 + nn) * D + 16 * c) = w; }
    __syncthreads();
}
constexpr int CV_SLOTS = 1152;
__device__ __forceinline__ void conv_slot(PK P, LAS unsigned char* lds, int L, int s, int tid) {
    if (s < 1024) { conv_gu_block(P, lds, L * NEXP + (s >> 5), (s >> 4) & 1, s & 15, tid); return; }
    const int lane = tid & 63, wid = __builtin_amdgcn_readfirstlane(tid >> 6);
    LAS unsigned* scr = (LAS unsigned*)(lds + wid * 8192);
#pragma unroll 1
    for (int j = 0; j < 8; ++j) conv_down_item(P, L, (s - 1024) * 64 + wid * 8 + j, scr, lane);
}
__device__ __forceinline__ void conv_claim(PK P, LAS unsigned char* lds, int L, int quota, int tid) {
    LAS int* slot = (LAS int*)(lds + MISC_OFF + M_CVB);
    unsigned* ctr = WSP(unsigned, WS_CTL) + CW_CV + L * 16;
    for (int q = 0; q < quota; ++q) {
        __syncthreads();
        if (tid == 0) *slot = (int)__hip_atomic_fetch_add(ctr, 1u, __ATOMIC_RELAXED, __HIP_MEMORY_SCOPE_AGENT);
        __syncthreads();
        const int sl = __builtin_amdgcn_readfirstlane(*slot);
        if (sl >= CV_SLOTS) break;
        conv_slot(P, lds, L, sl, tid);
    }
    __syncthreads();
}
__device__ __forceinline__ void phase_prologue(PK P, LAS unsigned char* lds, int bid, int tid) {
    const int lane = tid & 63, wid = __builtin_amdgcn_readfirstlane(tid >> 6);
    {
        LAS float* S = (LAS float*)lds; LAS float* red = (LAS float*)(lds + 40960);
        for (int idx = tid; idx < 9 * D; idx += 512) { const int r = idx >> 10, d = idx & (D - 1); const float v = r < 8 ? P->in[1][r * D + d] : P->in[3][d];
            S[idx] = v / (1.0f + __builtin_amdgcn_exp2f(-v * LOG2E)); }
        __syncthreads();
        const int l = bid >> 6, c0 = (bid & 63) * 96;
        if (lane < 48) {
            float acc[9][2];
#pragma unroll
            for (int r = 0; r < 9; ++r) { acc[r][0] = 0.f; acc[r][1] = 0.f; }
            const float* wp = P->in[4] + ((size_t)l * D + 128 * wid) * 6144 + c0 + 2 * lane;
            const LAS float* sp = S + 128 * wid;
#pragma unroll 8
            for (int k = 0; k < 128; ++k) { const f32x2 w = *(const f32x2*)(wp + (size_t)k * 6144);
#pragma unroll
                for (int r = 0; r < 9; ++r) { const float s = sp[r * D + k]; acc[r][0] += s * w[0]; acc[r][1] += s * w[1]; } }
#pragma unroll
            for (int r = 0; r < 9; ++r) { red[(wid * 9 + r) * 96 + 2 * lane] = acc[r][0]; red[(wid * 9 + r) * 96 + 2 * lane + 1] = acc[r][1]; }
        }
        __syncthreads();
        float* MOD = WSP(float, WS_MOD);
        for (int idx = tid; idx < 9 * 96; idx += 512) { const int r = idx / 96, cc = idx % 96; float s = 0.f;
#pragma unroll
            for (int w = 0; w < 8; ++w) s += red[(w * 9 + r) * 96 + cc];
            MOD[((size_t)l * 9 + r) * 6144 + c0 + cc] = s + P->in[5][(size_t)l * 6144 + c0 + cc]; }
        __syncthreads();
    }
    {
        const int gt = bid * 512 + tid; float* RA = WSP(float, WS_ROPE_A); float* RC = WSP(float, WS_ROPE_C);
        const float L2T = 13.287712379549449f;
        for (int idx = gt; idx < SEQ * 32; idx += 131072) { const int t = idx >> 5, i = idx & 31; const float pos = (float)(i < 16 ? (t >> 6) : (t & 63));
            const float inv = __builtin_amdgcn_exp2f(-(float)(i & 15) * (1.0f / 16.0f) * L2T); const float ang = pos * inv; RA[2 * idx] = __cosf(ang); RA[2 * idx + 1] = __sinf(ang); }
        for (int idx = gt; idx < SEQ * 16; idx += 131072) { const int t = idx >> 4, i = idx & 15; const float pos = (float)(i < 8 ? (t >> 6) : (t & 63));
            const float inv = __builtin_amdgcn_exp2f(-(float)(i & 7) * (1.0f / 8.0f) * L2T); const float ang = pos * inv; RC[2 * idx] = __cosf(ang); RC[2 * idx + 1] = __sinf(ang); }
        bf16_t* WU = WSP(bf16_t, WS_WC_UP); const u32x4 z = (u32x4){0u, 0u, 0u, 0u};
        for (int idx = gt; idx < 1536 * 16; idx += 131072) *(u32x4*)(WU + (size_t)(idx >> 4) * C_UPK + 256 + 8 * (idx & 15)) = z;
        for (int idx = gt; idx < 2048 * 32; idx += 131072) *(u32x4*)(WU + (size_t)(1536 + (idx >> 5)) * C_UPK + 8 * (idx & 31)) = z;
    }
    {
        LAS unsigned* scr = (LAS unsigned*)(lds + wid * 8192);
        const int gw = bid * 8 + wid;
        for (int item = gw; item < CV_SMALL; item += 2048) conv_dispatch(P, item, scr, lane);
        __syncthreads();
        for (int sl = bid; sl < CV_SLOTS; sl += 256) conv_slot(P, lds, 0, sl, tid);
    }
}

constexpr int PH_PRO = 0, PH_N0 = 1, PH_L0 = 2, PH_PER_LAYER = 9, PH_FINAL = PH_L0 + DEPTH * PH_PER_LAYER, NPH = PH_FINAL + 1;
enum { LP_IN = 0, LP_MLANORM = 1, LP_MLAUP = 2, LP_ATT = 3, LP_OUT = 4, LP_RT = 5, LP_GU = 6, LP_DN = 7, LP_CB = 8 };
struct Args { Ptrs P; int p_lo, p_hi, bar_idx, pad; };

__global__ void __launch_bounds__(512, 2) mk_fwd(Args a) {
    extern __shared__ __attribute__((aligned(16))) unsigned char lds_raw[];
    LAS unsigned char* const lds = (LAS unsigned char*)lds_raw;
    LAS unsigned char* const misc = lds + MISC_OFF;
    typedef const __attribute__((address_space(4))) Args* ArgsK;
    const ArgsK ak = (ArgsK)__builtin_amdgcn_kernarg_segment_ptr();
    (void)a;
    const int wid0 = __builtin_amdgcn_readfirstlane((int)threadIdx.x >> 6);
    if (wid0 == 0 && lane_id() < 4) ((LAS unsigned*)(misc + M_BARW))[lane_id()] = 0u;
    __syncthreads();
    XcdBarrier bar;
    { PK P = &ak->P; bar = xcd_barrier_post(WSP(unsigned, WS_CTL) + CW_BAR + ak->bar_idx * XCD_BAR_WORDS, (volatile LAS unsigned*)(misc + M_BARW), wid0 == 0); }
    bool ran = false;
    const int p_lo = ak->p_lo, p_hi = ak->p_hi;
#define PHASE_BEGIN(bit, p, cond) if ((((MK_MASK) >> (bit)) & 1) && p_lo <= (p) && (p) < p_hi && ((p) <= MK_STOP_AFTER || (p) == PH_FINAL) && (cond)) for (int rep_ = 0; rep_ < 1 + (((MK_REP_MASK) >> (bit)) & 1); ++rep_) { if (ran) xcd_barrier(bar); ran = true; \
    int tid = wid0 * 64 + lane_id(); asm volatile("" : "+v"(tid)); int bid = blockIdx.x; asm volatile("" : "+s"(bid)); ArgsK ak_ = ak; asm volatile("" : "+s"(ak_)); PK P = &ak_->P; \
    const int lane = tid & 63, wid = __builtin_amdgcn_readfirstlane(tid >> 6), vcu = (bid & 7) * 32 + (bid >> 3), gw = vcu * 8 + wid; (void)lane; (void)gw; (void)P;
#define PHASE_END }

    PHASE_BEGIN(0, PH_PRO, true) phase_prologue(P, lds, bid, tid); PHASE_END
    PHASE_BEGIN(1, PH_N0, true) phase_first_norm(P, gw, lane); PHASE_END

    for (int l = 0; l < DEPTH; ++l) {
        const int kind = l % 3, slot = l / 3, pb = PH_L0 + l * PH_PER_LAYER;
        const bool last = (l == DEPTH - 1);
        const int nMrows = last ? NL / 256 : NT / 256;
        PHASE_BEGIN(2, pb + LP_IN, kind == 0) {
            pg8::Gemm g{WSP(const bf16_t, WS_H), WSP(const bf16_t, WS_WA_IN) + (size_t)slot * A_IN * D, D, 0, nullptr};
            pg8::DenseOrder S{nMrows, 6, vcu, last ? 8 : 0, 4, 2};
            pg8::EpiQkvA E{WSP(bf16_t, WS_QKV), WSP(const float, WS_ROPE_A)};
            pg8::gemm_phase<pg8::EpiQkvA, pg8::DenseOrder, false>(lds, g, S, E, tid);
        } PHASE_END
        PHASE_BEGIN(3, pb + LP_IN, kind == 1) {
            pg8::Gemm g{WSP(const bf16_t, WS_H), WSP(const bf16_t, WS_WB_IN), D, 0, nullptr};
            pg8::DenseOrder S{NT / 256, 12, vcu, 0, 0, 0};
            pg8::EpiBf16Plain E{WSP(bf16_t, WS_QKV), B_IN, 4, 0.125f * LOG2E};
            pg8::gemm_phase<pg8::EpiBf16Plain, pg8::DenseOrder, false>(lds, g, S, E, tid);
        } PHASE_END
        PHASE_BEGIN(4, pb + LP_IN, kind == 2) {
            pg8::Gemm g{WSP(const bf16_t, WS_H), WSP(const bf16_t, WS_WC_IN), D, 0, nullptr};
            pg8::DenseOrder S{NT / 256, 2, vcu, 0, 0, 0};
            pg8::EpiF32Plain E{WSP(float, WS_Y416), C_INP};
            pg8::gemm_phase<pg8::EpiF32Plain, pg8::DenseOrder, false>(lds, g, S, E, tid);
        } PHASE_END
        PHASE_BEGIN(5, pb + LP_MLANORM, kind == 2) phase_mla_norm(P, gw, lane); PHASE_END
        PHASE_BEGIN(6, pb + LP_MLAUP, kind == 2) {
            pg8::Gemm g{WSP(const bf16_t, WS_CQKV), WSP(const bf16_t, WS_WC_UP), C_UPK, 0, nullptr};
            pg8::DenseOrder S{NT / 256, 14, vcu, 0, 0, 0};
            pg8::EpiMlaUp E{WSP(bf16_t, WS_QKV), WSP(const float, WS_ROPE_C)};
            pg8::gemm_phase<pg8::EpiMlaUp, pg8::DenseOrder, false>(lds, g, S, E, tid);
        } PHASE_END
        PHASE_BEGIN(7, pb + LP_ATT, kind == 0) {
            const bf16_t* QKV = WSP(const bf16_t, WS_QKV); bf16_t* O = WSP(bf16_t, WS_O); const float* sink = P->in[11] + slot * 16;
            for (int u = vcu; u < 1024; u += 256) { const int bk = u >> 5; att::attn_A_unit(lds, QKV, O, sink, bk >> 2, bk & 3, u & 31, false, tid); }
            if (!last) for (int u = vcu; u < 128; u += 256) { const int bk = u >> 2; att::attn_A_unit(lds, QKV, O, sink, bk >> 2, bk & 3, u & 3, true, tid); }
        } PHASE_END
        PHASE_BEGIN(8, pb + LP_ATT, kind == 1) {
            const bf16_t* QKV = WSP(const bf16_t, WS_QKV); bf16_t* O = WSP(bf16_t, WS_O); LAS float* tab = (LAS float*)(misc + M_RPB);
            for (int u = vcu; u < 1024; u += 256) { const int bh = u >> 3; att::attn_B_unit(lds, tab, QKV, O, P->in[14], bh >> 4, bh & 15, u & 7, false, tid); }
            for (int u = vcu; u < 128; u += 256) att::attn_B_unit(lds, tab, QKV, O, P->in[14], u >> 4, u & 15, 0, true, tid);
        } PHASE_END
        PHASE_BEGIN(9, pb + LP_ATT, kind == 2) {
            const bf16_t* QKV = WSP(const bf16_t, WS_QKV); bf16_t* O = WSP(bf16_t, WS_O); const bf16_t* KR = WSP(const bf16_t, WS_KR);
            for (int u = vcu; u < 1024; u += 256) { const int bh = u >> 3; att::attn_C_unit(lds, QKV, KR, O, bh >> 4, bh & 15, u & 7, false, tid); }
            for (int u = vcu; u < 128; u += 256) att::attn_C_unit(lds, QKV, KR, O, u >> 4, u & 15, 0, true, tid);
        } PHASE_END
        PHASE_BEGIN(10, pb + LP_OUT, true) {
            const bf16_t* W = kind == 0 ? WSP(const bf16_t, WS_WA_OUT) + (size_t)slot * D * D : (kind == 1 ? WSP(const bf16_t, WS_WB_OUT) : WSP(const bf16_t, WS_WC_OUT));
            pg8::Gemm g{WSP(const bf16_t, WS_O), W, D, 0, nullptr};
            pg8::DenseOrder S{nMrows, 4, vcu, 0, 0, 0};
            pg8::EpiResid E{WSP(float, WS_XS), WSP(const float, WS_MOD) + (size_t)l * 9 * 6144 + 2048, (rep_ + 1 < 1 + ((MK_REP_MASK >> 10) & 1)) ? WSP(float, WS_ACT) : WSP(float, WS_XS)};
            pg8::gemm_phase<pg8::EpiResid, pg8::DenseOrder, false>(lds, g, S, E, tid);
            if (!last && S.short_one()) conv_claim(P, lds, l + 1, MK_Q_OUT, tid);
        } PHASE_END
        PHASE_BEGIN(11, pb + LP_RT, true) { if (l >= 1) conv_claim(P, lds, l, 1 << 30, tid); phase_router(P, lds, l, last ? NL : NT, vcu, tid, rep_); } PHASE_END
        PHASE_BEGIN(12, pb + LP_GU, true) {
            moe_tables(misc, WSP(unsigned, WS_CTL) + CW_CNT + (l * 2 + ((MK_REP_MASK >> 11) & 1)) * 512, tid);
            pg8::Gemm g{WSP(const void, WS_H), WSP(const unsigned char, WS_WGU) + (size_t)l * NEXP * 2 * D * D, D, (size_t)2 * D * D, WSP(const int, WS_ELIST)};
            pg8::MoeOrder S{(const LAS int*)(misc + M_ECNT), (const LAS int*)(misc + M_LBASE), (const LAS int*)(misc + M_CUMT), 8, vcu, (LAS int*)(misc + M_UL)}; S.build(tid);
            pg8::EpiSwiglu8 E{WSP(bf16_t, WS_ACT), P->in[24] + (size_t)l * NEXP * D, P->in[26] + (size_t)l * NEXP * D, WSP(const float, WS_SAL), WSP(const float, WS_SBW) + (size_t)l * NEXP * 2048};
            pg8::gemm_phase<pg8::EpiSwiglu8, pg8::MoeOrder, true, true>(lds, g, S, E, tid);
            if (!last && S.short_one()) conv_claim(P, lds, l + 1, MK_Q_GU, tid);
        } PHASE_END
        PHASE_BEGIN(13, pb + LP_DN, true) {
            moe_tables(misc, WSP(unsigned, WS_CTL) + CW_CNT + (l * 2 + ((MK_REP_MASK >> 11) & 1)) * 512, tid);
            pg8::Gemm g{WSP(const bf16_t, WS_ACT), WSP(const bf16_t, WS_WD) + (size_t)l * NEXP * D * D, D, (size_t)D * D, nullptr};
            pg8::MoeOrder S{(const LAS int*)(misc + M_ECNT), (const LAS int*)(misc + M_LBASE), (const LAS int*)(misc + M_CUMT), 4, vcu, (LAS int*)(misc + M_UL)}; S.build(tid);
            pg8::EpiDown E{WSP(bf16_t, WS_YS), P->in[28] + (size_t)l * NEXP * D};
            pg8::gemm_phase<pg8::EpiDown, pg8::MoeOrder, false>(lds, g, S, E, tid);
            if (!last && S.short_one()) conv_claim(P, lds, l + 1, MK_Q_DN, tid);
        } PHASE_END
        PHASE_BEGIN(14, pb + LP_CB, true) phase_combine(P, lds, l, last ? NL : NT, gw, tid, (rep_ + 1 < 1 + ((MK_REP_MASK >> 14) & 1))); PHASE_END
    }
    PHASE_BEGIN(15, PH_FINAL, MK_STOP_AFTER < PH_FINAL - 1) phase_final_norm(P, gw, lane); PHASE_END
#undef PHASE_BEGIN
#undef PHASE_END
}

extern "C" void kernel_launch(void* const* d_in, const int* in_sizes, int n_in, void* d_out, int out_size, void* d_ws, size_t ws_size, hipStream_t stream) {
    static int grid = 0;
    if (grid == 0) {
        if (n_in != 29 || out_size != NL * D || ws_size < WS_END) { fprintf(stderr, "kernel_launch: expected 29 inputs, out %d, ws >= %zu; got n_in %d out %d ws %zu\n", NL * D, (size_t)WS_END, n_in, out_size, ws_size); grid = -1; return; }
        int dev = 0, cus = 0, per_cu = 0;
        if (hipGetDevice(&dev) != hipSuccess || hipDeviceGetAttribute(&cus, hipDeviceAttributeMultiprocessorCount, dev) != hipSuccess) { grid = -1; return; }
        if (hipFuncSetAttribute((const void*)mk_fwd, hipFuncAttributeMaxDynamicSharedMemorySize, LDS_BYTES) != hipSuccess) { fprintf(stderr, "kernel_launch: hipFuncSetAttribute failed\n"); grid = -1; return; }
        if (hipOccupancyMaxActiveBlocksPerMultiprocessor(&per_cu, (const void*)mk_fwd, 512, LDS_BYTES) != hipSuccess || per_cu < 1) fprintf(stderr, "kernel_launch: occupancy query says %d\n", per_cu);
        (void)hipGetLastError();
        grid = 256;
        if (cus < 256) { fprintf(stderr, "kernel_launch: needs 256 CUs, device has %d\n", cus); grid = -1; return; }
    }
    if (grid < 0) return;
    if (hipMemsetAsync((char*)d_ws + WS_CTL, 0, CTL_BYTES, stream) != hipSuccess) return;
    Args a{};
    for (int i = 0; i < 29; ++i) a.P.in[i] = (const float*)d_in[i];
    a.P.out = (float*)d_out; a.P.ws = (unsigned char*)d_ws; a.pad = 0;
#if MK_PER_PHASE
    for (int p = 0; p < NPH; ++p) { a.p_lo = p; a.p_hi = p + 1; a.bar_idx = 0; hipLaunchKernelGGL(mk_fwd, dim3(grid), dim3(512), LDS_BYTES, stream, a); }
#else
    a.p_lo = 0; a.p_hi = NPH; a.bar_idx = 0;
    hipLaunchKernelGGL(mk_fwd, dim3(grid), dim3(512), LDS_BYTES, stream, a);
#endif
    const hipError_t le = hipPeekAtLastError();
    if (le != hipSuccess) fprintf(stderr, "kernel_launch: launch failed: %s\n", hipGetErrorName(le));
}
```

```cpp
#include <hip/hip_runtime.h>
#include <cstdio>
#include <cstdint>

#ifndef MK_PER_PHASE
#define MK_PER_PHASE 0
#endif
#ifndef MK_MASK
#define MK_MASK 0xFFFF
#endif
#ifndef MK_REP_MASK
#define MK_REP_MASK 0
#endif
#ifndef MK_Q_OUT
#define MK_Q_OUT 1
#endif
#ifndef MK_Q_GU
#define MK_Q_GU 1
#endif
#ifndef MK_Q_DN
#define MK_Q_DN 1
#endif
#ifndef MK_Q_IN
#define MK_Q_IN 1
#endif
#ifndef MK_MT_MAJOR
#define MK_MT_MAJOR 1
#endif
#ifndef MK_CVW_GU
#define MK_CVW_GU 0
#endif
#ifndef MK_CVW_DN
#define MK_CVW_DN 0
#endif
#ifndef MK_STOP_AFTER
#define MK_STOP_AFTER 9999
#endif

#define LAS __attribute__((address_space(3)))
#define GAS __attribute__((address_space(1)))
typedef unsigned short bf16_t;
typedef short bf16x8 __attribute__((ext_vector_type(8)));
typedef short s16x4 __attribute__((ext_vector_type(4)));
typedef _Float16 f16x8 __attribute__((ext_vector_type(8)));
typedef _Float16 f16x2 __attribute__((ext_vector_type(2)));
typedef float f32x2 __attribute__((ext_vector_type(2)));
typedef float f32x4 __attribute__((ext_vector_type(4)));
typedef float f32x16 __attribute__((ext_vector_type(16)));
typedef unsigned u32x2 __attribute__((ext_vector_type(2)));
typedef unsigned u32x4 __attribute__((ext_vector_type(4)));
typedef int i32x4 __attribute__((ext_vector_type(4)));

constexpr int D = 1024, NB = 8, SEQ = 2048, CTXL = 256, DEPTH = 4;
constexpr int NL = NB * SEQ;
constexpr int NC = NB * CTXL;
constexpr int NT = NL + NC;
constexpr int NEXP = 32, TOPK = 4;
constexpr int MAXSLOT = 81920;
constexpr float NORM_EPS = 1e-6f;
constexpr float LOG2E = 1.4426950408889634f;
constexpr int A_IN = 1536, B_IN = 3072, C_IN = 416, C_INP = 512, C_UPK = 384, C_UPN = 3584;

constexpr size_t MiB = 1u << 20;
constexpr size_t WS_CTL = 0, CTL_BYTES = 1 * MiB;
constexpr size_t WS_MOD = 1 * MiB;
constexpr size_t WS_ROPE_A = 2 * MiB;
constexpr size_t WS_ROPE_C = 2 * MiB + 512 * 1024;
constexpr size_t WS_TOPE = 3 * MiB;
constexpr size_t WS_POS = 3 * MiB + 512 * 1024;
constexpr size_t WS_GATE = 4 * MiB;
constexpr size_t WS_ELIST = 5 * MiB;
constexpr size_t WS_KR = 8 * MiB;
constexpr size_t WS_CQKV = 10 * MiB;
constexpr size_t WS_Y416 = 24 * MiB;
constexpr size_t WS_XS = 60 * MiB;
constexpr size_t WS_H = 132 * MiB;
constexpr size_t WS_O = 168 * MiB;
constexpr size_t WS_QKV = 204 * MiB;
constexpr size_t WS_ACT = 330 * MiB;
constexpr size_t WS_YS = 490 * MiB;
constexpr size_t WS_WA_IN = 650 * MiB;
constexpr size_t WS_WA_OUT = 656 * MiB;
constexpr size_t WS_WB_IN = 660 * MiB;
constexpr size_t WS_WB_OUT = 666 * MiB;
constexpr size_t WS_WC_IN = 668 * MiB;
constexpr size_t WS_WC_UP = 669 * MiB;
constexpr size_t WS_WC_OUT = 672 * MiB;
constexpr size_t WS_WGU = 676 * MiB;
constexpr size_t WS_WD = 1188 * MiB;
constexpr size_t WS_G16 = 1444 * MiB;
constexpr size_t WS_RC = 1447 * MiB;
constexpr size_t WS_SBW = 1448 * MiB;
constexpr size_t WS_SAL = 1449 * MiB;
constexpr size_t WS_SAH = 1452 * MiB;
constexpr size_t WS_SBI = 1452 * MiB + 128 * 1024;
constexpr size_t WS_ACT8 = 1453 * MiB;
constexpr size_t WS_SAQ = 1533 * MiB;
constexpr size_t WS_SBD = 1533 * MiB + 512 * 1024;
constexpr size_t WS_END = 1535 * MiB;

constexpr int CW_CV = 512;
constexpr int CW_CNT = 1024;
constexpr int CW_BAR = 65536;

constexpr int RING_BYTES = 131072;
constexpr int MISC_OFF = RING_BYTES;
constexpr int M_BARW = 0, M_LCNT = 64, M_LBASE = 192, M_CUMT = 320, M_ECNT = 512, M_GBASE = 640, M_CVB = 768, M_UL = 6656, M_RSA = 7424, M_RPB = 1024, M_REC = 3072;
constexpr int LDS_BYTES = 147456;

#define XB_TMO      128
#define XB_XCNT(j)  (256  + 64 * (j))
#define XB_XSUB(j)  (1280 + 64 * (j))
#define XB_XGEN(j)  (2304 + 64 * (j))
#define XB_TOP      3328
#define XB_TOPGEN   3392
#define XCD_BAR_WORDS 3456
#define XB_SPIN_CAP (1u << 18)

__device__ __forceinline__ unsigned xb_ld(unsigned* p)              { return __hip_atomic_load(p, __ATOMIC_RELAXED, __HIP_MEMORY_SCOPE_AGENT); }
__device__ __forceinline__ unsigned xb_add(unsigned* p, unsigned v) { return __hip_atomic_fetch_add(p, v, __ATOMIC_RELAXED, __HIP_MEMORY_SCOPE_AGENT); }
__device__ __forceinline__ unsigned xb_xcc_id() { return (unsigned)__builtin_amdgcn_s_getreg((3 << 11) | 20) & 0xFu; }
#define XB_SPIN(cond, bar) do { unsigned _sp = 0; while (cond) { __builtin_amdgcn_s_sleep(1); \
    if ((++_sp & 255u) == 0u) { if (xb_ld(&(bar)[XB_TMO])) break; if (_sp > XB_SPIN_CAP) { atomicAdd(&(bar)[XB_TMO], 1u); break; } } } } while (0)

__device__ __forceinline__ int lane_id() { int r; asm volatile("v_mbcnt_lo_u32_b32 %0, -1, 0\n\tv_mbcnt_hi_u32_b32 %0, -1, %0" : "=v"(r)); return r; }
struct XcdBarrier {
    unsigned* bar; unsigned x;
    volatile LAS unsigned* st;
    bool lead;
};
__device__ __forceinline__ XcdBarrier xcd_barrier_post(unsigned* bar, volatile LAS unsigned* st, bool lead) {
    XcdBarrier b; b.bar = bar; b.x = xb_xcc_id(); b.st = st; b.lead = lead;
    if (lead && lane_id() == 0) (void)xb_add(&bar[XB_XCNT(b.x)], 1u);
    return b;
}
__device__ __forceinline__ void xcd_barrier_complete(unsigned* bar, unsigned x, unsigned& nloc, unsigned& nx) {
    const unsigned G = gridDim.x * gridDim.y * gridDim.z;
    unsigned sum, cnt, mine, sp = 0u;
    for (;;) {
        sum = 0u; cnt = 0u; mine = 0u;
#pragma unroll
        for (unsigned j = 0; j < 16; ++j) { const unsigned c = xb_ld(&bar[XB_XCNT(j)]); sum += c; cnt += (c > 0u) ? 1u : 0u; mine = (j == x) ? c : mine; }
        if (sum == G) break;
        __builtin_amdgcn_s_sleep(1);
        if ((++sp & 255u) == 0u) { if (xb_ld(&bar[XB_TMO])) break; if (sp > XB_SPIN_CAP) { atomicAdd(&bar[XB_TMO], 1u); break; } }
    }
    nloc = mine > 0u ? mine : 1u; nx = cnt > 0u ? cnt : 1u;
}
__device__ __forceinline__ void xcd_barrier(const XcdBarrier& b) {
    asm volatile("s_waitcnt vmcnt(0)" ::: "memory");
    __syncthreads();
    if (b.lead && lane_id() == 0) {
        unsigned* bar = b.bar;
        __builtin_amdgcn_s_waitcnt(0);
        unsigned nloc = b.st[0], nx = b.st[1];
        if (nloc == 0u) { xcd_barrier_complete(bar, b.x, nloc, nx); b.st[0] = nloc; b.st[1] = nx; }
        const unsigned old = xb_add(&bar[XB_XSUB(b.x)], 1u);
        const unsigned gen = old / nloc;
        if (old + 1u == (gen + 1u) * nloc) {
            __builtin_amdgcn_fence(__ATOMIC_RELEASE, "agent");
            asm volatile("s_waitcnt vmcnt(0)" ::: "memory");
            const unsigned og = xb_add(&bar[XB_TOP], 1u);
            const unsigned tg = og / nx;
            if (og + 1u == (tg + 1u) * nx) xb_add(&bar[XB_TOPGEN], 1u);
            else XB_SPIN(xb_ld(&bar[XB_TOPGEN]) == tg, bar);
            __builtin_amdgcn_fence(__ATOMIC_ACQUIRE, "agent");
            xb_add(&bar[XB_XGEN(b.x)], 1u);
            asm volatile("s_waitcnt vmcnt(0)" ::: "memory");
        } else {
            XB_SPIN(xb_ld(&bar[XB_XGEN(b.x)]) == gen, bar);
            __builtin_amdgcn_fence(__ATOMIC_ACQUIRE, "agent");
            asm volatile("s_waitcnt vmcnt(0)" ::: "memory");
        }
    }
    __syncthreads();
}

__device__ __forceinline__ unsigned cvt_pk_bf16(float lo, float hi) { unsigned r; asm volatile("v_cvt_pk_bf16_f32 %0, %1, %2" : "=v"(r) : "v"(lo), "v"(hi)); return r; }
__device__ __forceinline__ float bf_lo(unsigned w) { return __uint_as_float(w << 16); }
__device__ __forceinline__ float bf_hi(unsigned w) { return __uint_as_float(w & 0xffff0000u); }
__device__ __forceinline__ float shx(float v, int mask, int lane) { return __int_as_float(__builtin_amdgcn_ds_bpermute((lane ^ mask) << 2, __float_as_int(v))); }
__device__ __forceinline__ float wave_sum(float v, int lane) {
#pragma unroll
    for (int o = 1; o < 64; o <<= 1) v += shx(v, o, lane);
    return v;
}
__device__ __forceinline__ float wave_max(float v, int lane) {
#pragma unroll
    for (int o = 1; o < 64; o <<= 1) v = fmaxf(v, shx(v, o, lane));
    return v;
}
__device__ __forceinline__ float swap32_max(float m) { auto rr = __builtin_amdgcn_permlane32_swap(__float_as_uint(m), __float_as_uint(m), false, false); return fmaxf(__uint_as_float(rr[0]), __uint_as_float(rr[1])); }
__device__ __forceinline__ float swap32_sum(float m) { auto rr = __builtin_amdgcn_permlane32_swap(__float_as_uint(m), __float_as_uint(m), false, false); return __uint_as_float(rr[0]) + __uint_as_float(rr[1]); }

namespace pg8 {
constexpr int BM = 256, BK = 64, HALF = 128, HTB = HALF * BK * 2, STAGE_BYTES = 8 * HTB;
__host__ __device__ __forceinline__ int lds_byte(int r, int c) { const int st = (r >> 4) * 2 + (c >> 5), rr = r & 15, cc = c & 31, ob = rr * 64 + cc * 2; return st * 1024 + (ob ^ (((ob >> 9) & 1) << 5)); }
__host__ __device__ __forceinline__ void stage_rc(int b, int& R, int& C) { const int st = b / 1024, sb = b % 1024, swz = sb ^ (((sb >> 9) & 1) << 5); R = (st >> 1) * 16 + swz / 64; C = (st & 1) * 32 + (swz % 64) / 2; }
__host__ __device__ __forceinline__ int perm32(int rho) { const int n = rho >> 4, i = rho & 15; return 8 * (i >> 2) + 4 * n + (i & 3); }

struct Unit { int pm, pn, e, mt, cnt; };
struct Gemm { const void* A; const void* Bt; int K; size_t bstride; const int* list; };

template <bool I8> struct AccSel { typedef f32x4 type; };
template <> struct AccSel<true> { typedef i32x4 type; };
template <class Epi, class Sched, bool GATHER, bool I8 = false>
__device__ __forceinline__ void gemm_phase(LAS unsigned char* lds, const Gemm g, const Sched& S, const Epi& E, const int tid) {
    const int wid = __builtin_amdgcn_readfirstlane(tid >> 6), lane = tid & 63, wr = wid >> 2, wc = wid & 3, fr = lane & 15, fq = lane >> 4;
    typedef typename AccSel<I8>::type acc_t;
    const int K = g.K, RB = I8 ? K : 2 * K, nt = RB / (BK * 2);
    unsigned voffA[2], voffB[2];
    int gR[2], gC[2];
#pragma unroll
    for (int i = 0; i < 2; ++i) { int R, C; stage_rc(tid * 16 + i * 8192, R, C); const int Rb = Epi::PERM ? ((R & ~31) + perm32(R & 31)) : R;
        voffA[i] = (unsigned)(R * RB + C * 2); voffB[i] = (unsigned)(Rb * RB + C * 2); gR[i] = R; gC[i] = C; }
    const size_t kstep = (size_t)(BK * 2);
    const size_t hstep = (size_t)HALF * RB;
    const size_t tstep = 2 * hstep;
    const unsigned ldsw = (unsigned)wid * 1024u;
    const int aoff = lds_byte(wr * 64 + fr, fq * 8), boff = lds_byte(wc * 32 + fr, fq * 8);
#define PG8_SA(b, h) (((b) * 2 + (h)) * HTB)
#define PG8_SB(b, h) ((4 + (b) * 2 + (h)) * HTB)
#define PG8_STAGE(bufoff, gbase, voff) do { _Pragma("unroll") for (int _i = 0; _i < 2; ++_i) \
        __builtin_amdgcn_global_load_lds((const unsigned*)((const char*)(gbase) + (voff)[_i]), (LAS unsigned*)(lds + (bufoff) + ldsw + _i * 8192), 16, 0, 0); } while (0)
#define PG8_STAGE_A(bufoff, SELN, H, KOFF) do { if constexpr (GATHER) { unsigned _vo[2]; _vo[0] = (SELN) ? voN[H][0] : voC[H][0]; _vo[1] = (SELN) ? voN[H][1] : voC[H][1]; \
            PG8_STAGE(bufoff, (const char*)g.A + (KOFF), _vo); } else { PG8_STAGE(bufoff, ((SELN) ? nA : cA) + (H) * hstep + (KOFF), voffA); } } while (0)
#define PG8_LDA(dst, b, h) do { _Pragma("unroll") for (int m = 0; m < 4; ++m) _Pragma("unroll") for (int k = 0; k < 2; ++k) dst[m][k] = *(const LAS bf16x8*)(lds + PG8_SA(b, h) + aoff + m * 2048 + k * 1024); } while (0)
#define PG8_LDB(dst, b, h) do { _Pragma("unroll") for (int n = 0; n < 2; ++n) _Pragma("unroll") for (int k = 0; k < 2; ++k) dst[n][k] = *(const LAS bf16x8*)(lds + PG8_SB(b, h) + boff + n * 2048 + k * 1024); } while (0)
#define PG8_MMA(ai, bj, At, Bt) do { __builtin_amdgcn_s_setprio(1); _Pragma("unroll") for (int m = 0; m < 4; ++m) _Pragma("unroll") for (int n = 0; n < 2; ++n) _Pragma("unroll") for (int k = 0; k < 2; ++k) \
        { if constexpr (I8) acc[ai][bj][m][n] = __builtin_amdgcn_mfma_i32_16x16x64_i8(__builtin_bit_cast(i32x4, Bt[n][k]), __builtin_bit_cast(i32x4, At[m][k]), acc[ai][bj][m][n], 0, 0, 0); \
          else acc[ai][bj][m][n] = __builtin_amdgcn_mfma_f32_16x16x32_bf16(Bt[n][k], At[m][k], acc[ai][bj][m][n], 0, 0, 0); } __builtin_amdgcn_s_setprio(0); } while (0)
#define PG8_WAIT_V(n) asm volatile("s_waitcnt vmcnt(" #n ")" ::: "memory")
#define PG8_WAIT_L(n) asm volatile("s_waitcnt lgkmcnt(" #n ")" ::: "memory")
#define PG8_BAR __builtin_amdgcn_s_barrier()
#define PG8_SCHED __builtin_amdgcn_sched_barrier(0)
#define PG8_GATH(U, VO) do { _Pragma("unroll") for (int _h = 0; _h < 2; ++_h) _Pragma("unroll") for (int _i = 0; _i < 2; ++_i) { \
        int _r = (U).mt * 256 + _h * 128 + gR[_i]; _r = _r < (U).cnt ? _r : 0; const int _tok = g.list[(size_t)(U).e * NT + _r]; VO[_h][_i] = (unsigned)(_tok * RB + gC[_i] * 2); } } while (0)
    Unit cur, nxt; int ui = 0;
    if (!S.next(0, cur)) return;
    acc_t acc[2][2][4][2];
#pragma unroll
    for (int a = 0; a < 2; ++a)
#pragma unroll
        for (int b = 0; b < 2; ++b)
#pragma unroll
            for (int m = 0; m < 4; ++m)
#pragma unroll
                for (int n = 0; n < 2; ++n) acc[a][b][m][n] = (acc_t){0, 0, 0, 0};
    bf16x8 At[4][2], B0[2][2], B1[2][2];
    unsigned voC[2][2] = {{0u, 0u}, {0u, 0u}}, voN[2][2] = {{0u, 0u}, {0u, 0u}};
    if constexpr (GATHER) { PG8_GATH(cur, voC); }
    const char* cA = GATHER ? (const char*)g.A : (const char*)g.A + (size_t)cur.pm * tstep;
    const size_t bsb = I8 ? g.bstride : 2 * g.bstride;
    const char* cB = (const char*)g.Bt + (size_t)cur.e * bsb + (size_t)cur.pn * tstep;
    const char* nA = cA; const char* nB = cB;
    PG8_STAGE(PG8_SB(0, 0), cB, voffB); PG8_STAGE(PG8_SB(0, 1), cB + hstep, voffB); PG8_STAGE_A(PG8_SA(0, 0), false, 0, 0); PG8_STAGE_A(PG8_SA(0, 1), false, 1, 0);
    if (wr == 1) PG8_BAR;
    PG8_WAIT_V(2); PG8_BAR;
    PG8_STAGE(PG8_SB(1, 0), cB + kstep, voffB); PG8_STAGE_A(PG8_SA(1, 0), false, 0, kstep); PG8_STAGE(PG8_SB(1, 1), cB + hstep + kstep, voffB);
    PG8_WAIT_V(6); PG8_BAR;
    for (;;) {
        const bool has_next = S.next(ui + 1, nxt);
        nA = GATHER ? (const char*)g.A : (has_next ? (const char*)g.A + (size_t)nxt.pm * tstep : cA);
        nB = has_next ? (const char*)g.Bt + (size_t)nxt.e * bsb + (size_t)nxt.pn * tstep : cB;
        int tokN[2][2] = {{0, 0}, {0, 0}};
        if constexpr (GATHER) { if (has_next) {
#pragma unroll
            for (int _h = 0; _h < 2; ++_h)
#pragma unroll
                for (int _i = 0; _i < 2; ++_i) { int _r = nxt.mt * 256 + _h * 128 + gR[_i]; _r = _r < nxt.cnt ? _r : 0; const int* _p = g.list + (size_t)nxt.e * NT + _r;
                    asm volatile("global_load_dword %0, %1, off" : "=v"(tokN[_h][_i]) : "v"(_p) : "memory"); } } }
        for (int t = 0; t < nt; t += 2) {
            const bool last = (t == nt - 2);
            const size_t k1 = (size_t)(t + 1) * kstep;
            const size_t k2 = last ? 0 : (size_t)(t + 2) * kstep;
            const size_t k3 = k2 + kstep;
            const char* b2 = (last ? nB : cB) + k2; const char* b3 = b2 + kstep;
            PG8_LDB(B0, 0, 0); PG8_LDB(B1, 0, 1); PG8_SCHED; PG8_LDA(At, 0, 0); PG8_STAGE_A(PG8_SA(1, 1), false, 1, k1);
            PG8_WAIT_V(8); PG8_WAIT_L(0); PG8_BAR; PG8_MMA(0, 0, At, B0); PG8_MMA(0, 1, At, B1); PG8_BAR; PG8_SCHED;
            if constexpr (GATHER) { if (last) { if (has_next) {
                asm volatile("" : "+v"(tokN[0][0]), "+v"(tokN[0][1]), "+v"(tokN[1][0]), "+v"(tokN[1][1]));
#pragma unroll
                for (int _h = 0; _h < 2; ++_h) { voN[_h][0] = (unsigned)(tokN[_h][0] * RB + gC[0] * 2); voN[_h][1] = (unsigned)(tokN[_h][1] * RB + gC[1] * 2); } } else {
#pragma unroll
                for (int _h = 0; _h < 2; ++_h) { voN[_h][0] = voC[_h][0]; voN[_h][1] = voC[_h][1]; } } } }
            PG8_LDA(At, 0, 1); PG8_STAGE(PG8_SB(0, 0), b2, voffB); PG8_STAGE(PG8_SB(0, 1), b2 + hstep, voffB); PG8_STAGE_A(PG8_SA(0, 0), last, 0, k2);
            PG8_WAIT_V(8); PG8_WAIT_L(0); PG8_BAR; PG8_MMA(1, 0, At, B0); PG8_MMA(1, 1, At, B1); PG8_BAR; PG8_SCHED;
            PG8_LDB(B0, 1, 0); PG8_LDB(B1, 1, 1); PG8_SCHED; PG8_LDA(At, 1, 0); PG8_STAGE_A(PG8_SA(0, 1), last, 1, k2);
            PG8_WAIT_V(8); PG8_WAIT_L(0); PG8_BAR; PG8_MMA(0, 0, At, B0); PG8_MMA(0, 1, At, B1); PG8_BAR; PG8_SCHED;
            PG8_LDA(At, 1, 1); PG8_STAGE(PG8_SB(1, 0), b3, voffB); PG8_STAGE(PG8_SB(1, 1), b3 + hstep, voffB); PG8_STAGE_A(PG8_SA(1, 0), last, 0, k3);
            PG8_WAIT_V(8); PG8_WAIT_L(0); PG8_BAR; PG8_MMA(1, 0, At, B0); PG8_MMA(1, 1, At, B1); PG8_BAR; PG8_SCHED;
        }
        if (wr == 0) PG8_BAR;
        { const int ln_ = lane_id(); E(acc, cur, wr, wc, ln_ & 15, ln_ >> 4); }
        if (!has_next) break;
#pragma unroll
        for (int a = 0; a < 2; ++a)
#pragma unroll
            for (int b = 0; b < 2; ++b)
#pragma unroll
                for (int m = 0; m < 4; ++m)
#pragma unroll
                    for (int n = 0; n < 2; ++n) acc[a][b][m][n] = (acc_t){0, 0, 0, 0};
        cur = nxt; cA = nA; cB = nB; ++ui;
        if constexpr (GATHER) {
#pragma unroll
            for (int _h = 0; _h < 2; ++_h) { voC[_h][0] = voN[_h][0]; voC[_h][1] = voN[_h][1]; } }
        if (wr == 1) PG8_BAR;
    }
    PG8_WAIT_V(0);
    PG8_BAR;
#undef PG8_SA
#undef PG8_SB
#undef PG8_STAGE
#undef PG8_STAGE_A
#undef PG8_LDA
#undef PG8_LDB
#undef PG8_MMA
#undef PG8_WAIT_V
#undef PG8_WAIT_L
#undef PG8_BAR
#undef PG8_SCHED
#undef PG8_GATH
}
}

namespace pg8 {
struct EpiBf16Plain {
    static constexpr bool PERM = true;
    bf16_t* O; int ldc; int qtiles; float qscale;
    __device__ __forceinline__ void operator()(const f32x4 (&acc)[2][2][4][2], const Unit& u, int wr, int wc, int fr, int fq) const {
        const int row0 = u.pm * BM + wr * 64 + fr, col0 = u.pn * BM + wc * 32 + 8 * fq;
        const float qs = u.pn < qtiles ? qscale : 1.0f;
#pragma unroll
        for (int ai = 0; ai < 2; ++ai)
#pragma unroll
            for (int m = 0; m < 4; ++m) { bf16_t* rowp = O + (size_t)(row0 + ai * HALF + m * 16) * ldc + col0;
#pragma unroll
                for (int bj = 0; bj < 2; ++bj) { const f32x4 v0 = acc[ai][bj][m][0] * qs, v1 = acc[ai][bj][m][1] * qs;
                    u32x4 w; w.x = cvt_pk_bf16(v0[0], v0[1]); w.y = cvt_pk_bf16(v0[2], v0[3]); w.z = cvt_pk_bf16(v1[0], v1[1]); w.w = cvt_pk_bf16(v1[2], v1[3]);
                    *(u32x4*)(rowp + bj * HALF) = w; } }
    }
};
struct EpiBf16Plain8 {
    static constexpr bool PERM = true;
    bf16_t* O; int ldc; int qtiles; float qscale; const float* sa; const float* sb;
    __device__ __forceinline__ void operator()(const i32x4 (&acc)[2][2][4][2], const Unit& u, int wr, int wc, int fr, int fq) const {
        const int row0 = u.pm * BM + wr * 64 + fr, col0 = u.pn * BM + wc * 32 + 8 * fq;
        const float qs = u.pn < qtiles ? qscale : 1.0f;
        f32x4 cs[2][2];
#pragma unroll
        for (int bj = 0; bj < 2; ++bj)
#pragma unroll
            for (int n = 0; n < 2; ++n) cs[bj][n] = *(const f32x4*)(sb + col0 + bj * HALF + 4 * n) * qs;
#pragma unroll
        for (int ai = 0; ai < 2; ++ai)
#pragma unroll
            for (int m = 0; m < 4; ++m) { const int row = row0 + ai * HALF + m * 16; bf16_t* rowp = O + (size_t)row * ldc + col0; const float sr = sa[row];
#pragma unroll
                for (int bj = 0; bj < 2; ++bj) { f32x4 v0, v1;
#pragma unroll
                    for (int j = 0; j < 4; ++j) { v0[j] = (float)acc[ai][bj][m][0][j] * (sr * cs[bj][0][j]); v1[j] = (float)acc[ai][bj][m][1][j] * (sr * cs[bj][1][j]); }
                    u32x4 w; w.x = cvt_pk_bf16(v0[0], v0[1]); w.y = cvt_pk_bf16(v0[2], v0[3]); w.z = cvt_pk_bf16(v1[0], v1[1]); w.w = cvt_pk_bf16(v1[2], v1[3]);
                    *(u32x4*)(rowp + bj * HALF) = w; }
                asm volatile("" ::: "memory"); }
    }
};
struct EpiF32Plain {
    static constexpr bool PERM = false;
    float* C; int ldc;
    __device__ __forceinline__ void operator()(const f32x4 (&acc)[2][2][4][2], const Unit& u, int wr, int wc, int fr, int fq) const {
        const int row0 = u.pm * BM + wr * 64 + fr, col0 = u.pn * BM + wc * 32 + 4 * fq;
#pragma unroll
        for (int ai = 0; ai < 2; ++ai)
#pragma unroll
            for (int m = 0; m < 4; ++m) { float* rowp = C + (size_t)(row0 + ai * HALF + m * 16) * ldc + col0;
#pragma unroll
                for (int bj = 0; bj < 2; ++bj)
#pragma unroll
                    for (int n = 0; n < 2; ++n) *(f32x4*)(rowp + bj * HALF + n * 16) = acc[ai][bj][m][n]; }
    }
};
__device__ __forceinline__ void rope8(f32x4& v0, f32x4& v1, const float* cs) {
    const f32x4 a = *(const f32x4*)cs, b = *(const f32x4*)(cs + 4);
    const float x0 = v0[0], x1 = v0[1], x2 = v0[2], x3 = v0[3], y0 = v1[0], y1 = v1[1], y2 = v1[2], y3 = v1[3];
    v0[0] = x0 * a[0] - x1 * a[1]; v0[1] = x0 * a[1] + x1 * a[0];
    v0[2] = x2 * a[2] - x3 * a[3]; v0[3] = x2 * a[3] + x3 * a[2];
    v1[0] = y0 * b[0] - y1 * b[1]; v1[1] = y0 * b[1] + y1 * b[0];
    v1[2] = y2 * b[2] - y3 * b[3]; v1[3] = y2 * b[3] + y3 * b[2];
}
struct EpiQkvA {
    static constexpr bool PERM = true;
    bf16_t* O; const float* rope;
    __device__ __forceinline__ void operator()(const f32x4 (&acc)[2][2][4][2], const Unit& u, int wr, int wc, int fr, int fq) const {
        const int row0 = u.pm * BM + wr * 64 + fr, col0 = u.pn * BM + wc * 32 + 8 * fq;
        const bool do_rope = (u.pm < NL / 256) && (u.pn < 5);
        const float qs = u.pn < 4 ? 0.125f * LOG2E : 1.0f;
#pragma unroll
        for (int ai = 0; ai < 2; ++ai)
#pragma unroll
            for (int m = 0; m < 4; ++m) { const int row = row0 + ai * HALF + m * 16; bf16_t* rowp = O + (size_t)row * A_IN + col0;
#pragma unroll
                for (int bj = 0; bj < 2; ++bj) { f32x4 v0 = acc[ai][bj][m][0], v1 = acc[ai][bj][m][1];
                    if (do_rope) { const int d = (col0 + bj * HALF) & 63; rope8(v0, v1, rope + ((size_t)(row & (SEQ - 1)) * 32 + (d >> 1)) * 2); }
                    v0 = v0 * qs; v1 = v1 * qs;
                    u32x4 w; w.x = cvt_pk_bf16(v0[0], v0[1]); w.y = cvt_pk_bf16(v0[2], v0[3]); w.z = cvt_pk_bf16(v1[0], v1[1]); w.w = cvt_pk_bf16(v1[2], v1[3]);
                    *(u32x4*)(rowp + bj * HALF) = w; }
                asm volatile("" ::: "memory"); }
    }
};
struct EpiQkvA8 {
    static constexpr bool PERM = true;
    bf16_t* O; const float* rope; const float* sa; const float* sb;
    __device__ __forceinline__ void operator()(const i32x4 (&acc)[2][2][4][2], const Unit& u, int wr, int wc, int fr, int fq) const {
        const int row0 = u.pm * BM + wr * 64 + fr, col0 = u.pn * BM + wc * 32 + 8 * fq;
        const bool do_rope = (u.pm < NL / 256) && (u.pn < 5);
        const float qs = u.pn < 4 ? 0.125f * LOG2E : 1.0f;
        f32x4 cs[2][2];
#pragma unroll
        for (int bj = 0; bj < 2; ++bj)
#pragma unroll
            for (int n = 0; n < 2; ++n) cs[bj][n] = *(const f32x4*)(sb + col0 + bj * HALF + 4 * n) * qs;
#pragma unroll
        for (int ai = 0; ai < 2; ++ai)
#pragma unroll
            for (int m = 0; m < 4; ++m) { const int row = row0 + ai * HALF + m * 16; bf16_t* rowp = O + (size_t)row * A_IN + col0; const float sr = sa[row];
#pragma unroll
                for (int bj = 0; bj < 2; ++bj) { f32x4 v0, v1;
#pragma unroll
                    for (int j = 0; j < 4; ++j) { v0[j] = (float)acc[ai][bj][m][0][j] * (sr * cs[bj][0][j]); v1[j] = (float)acc[ai][bj][m][1][j] * (sr * cs[bj][1][j]); }
                    if (do_rope) { const int d = (col0 + bj * HALF) & 63; rope8(v0, v1, rope + ((size_t)(row & (SEQ - 1)) * 32 + (d >> 1)) * 2); }
                    u32x4 w; w.x = cvt_pk_bf16(v0[0], v0[1]); w.y = cvt_pk_bf16(v0[2], v0[3]); w.z = cvt_pk_bf16(v1[0], v1[1]); w.w = cvt_pk_bf16(v1[2], v1[3]);
                    *(u32x4*)(rowp + bj * HALF) = w; }
                asm volatile("" ::: "memory"); }
    }
};
struct EpiMlaUp {
    static constexpr bool PERM = true;
    bf16_t* O; const float* rope;
    __device__ __forceinline__ void operator()(const f32x4 (&acc)[2][2][4][2], const Unit& u, int wr, int wc, int fr, int fq) const {
        const int row0 = u.pm * BM + wr * 64 + fr, col0 = u.pn * BM + wc * 32 + 8 * fq;
        const bool qtile = (u.pm < NL / 256) && (u.pn < 6);
        const float qs = u.pn < 6 ? 0.10206207261596575f * LOG2E : 1.0f;
#pragma unroll
        for (int ai = 0; ai < 2; ++ai)
#pragma unroll
            for (int m = 0; m < 4; ++m) { const int row = row0 + ai * HALF + m * 16; bf16_t* rowp = O + (size_t)row * C_UPN + col0;
#pragma unroll
                for (int bj = 0; bj < 2; ++bj) { f32x4 v0 = acc[ai][bj][m][0], v1 = acc[ai][bj][m][1];
                    const int d96 = (col0 + bj * HALF) % 96;
                    if (qtile && d96 >= 64) rope8(v0, v1, rope + ((size_t)(row & (SEQ - 1)) * 16 + ((d96 - 64) >> 1)) * 2);
                    v0 = v0 * qs; v1 = v1 * qs;
                    u32x4 w; w.x = cvt_pk_bf16(v0[0], v0[1]); w.y = cvt_pk_bf16(v0[2], v0[3]); w.z = cvt_pk_bf16(v1[0], v1[1]); w.w = cvt_pk_bf16(v1[2], v1[3]);
                    *(u32x4*)(rowp + bj * HALF) = w; }
                asm volatile("" ::: "memory"); }
    }
};
struct EpiResid {
    static constexpr bool PERM = false;
    bf16_t* XS; const float* gmod; bf16_t* XSo;
    __device__ __forceinline__ void operator()(const f32x4 (&acc)[2][2][4][2], const Unit& u, int wr, int wc, int fr, int fq) const {
        const int row0 = u.pm * BM + wr * 64 + fr, col0 = u.pn * BM + wc * 32 + 4 * fq;
        const int rb = u.pm < NL / 256 ? (u.pm >> 3) : 8;
        const float* gv = gmod + (size_t)rb * 6144 + col0;
        f32x4 gg[2][2];
#pragma unroll
        for (int bj = 0; bj < 2; ++bj)
#pragma unroll
            for (int n = 0; n < 2; ++n) gg[bj][n] = *(const f32x4*)(gv + bj * HALF + n * 16);
#pragma unroll
        for (int ai = 0; ai < 2; ++ai)
#pragma unroll
            for (int m = 0; m < 4; ++m) { const size_t off = (size_t)(row0 + ai * HALF + m * 16) * D + col0;
#pragma unroll
                for (int bj = 0; bj < 2; ++bj)
#pragma unroll
                    for (int n = 0; n < 2; ++n) { const u32x2 w = *(const u32x2*)(XS + off + bj * HALF + n * 16);
                        const f32x4 v = (f32x4){bf_lo(w.x), bf_hi(w.x), bf_lo(w.y), bf_hi(w.y)} + gg[bj][n] * acc[ai][bj][m][n];
                        u32x2 o; o.x = cvt_pk_bf16(v[0], v[1]); o.y = cvt_pk_bf16(v[2], v[3]); *(u32x2*)(XSo + off + bj * HALF + n * 16) = o; } }
    }
};
struct EpiSwiglu {
    static constexpr bool PERM = true;
    bf16_t* ACT; const float* bg; const float* bu;
    __device__ __forceinline__ void operator()(const f32x4 (&acc)[2][2][4][2], const Unit& u, int wr, int wc, int fr, int fq) const {
        const int row0 = u.pm * BM + wr * 64 + fr, col0 = u.pn * HALF + wc * 32 + 8 * fq;
        const float* pg = bg + (size_t)u.e * D + col0; const float* pu = bu + (size_t)u.e * D + col0;
        const f32x4 g0 = *(const f32x4*)pg, g1 = *(const f32x4*)(pg + 4), u0 = *(const f32x4*)pu, u1 = *(const f32x4*)(pu + 4);
#pragma unroll
        for (int ai = 0; ai < 2; ++ai)
#pragma unroll
            for (int m = 0; m < 4; ++m) { bf16_t* rowp = ACT + (size_t)(row0 + ai * HALF + m * 16) * D + col0;
                float r[8];
#pragma unroll
                for (int n = 0; n < 2; ++n)
#pragma unroll
                    for (int j = 0; j < 4; ++j) {
                        float g = acc[ai][0][m][n][j] + (n ? g1[j] : g0[j]); float uu = acc[ai][1][m][n][j] + (n ? u1[j] : u0[j]);
                        g = fminf(g, 7.0f); uu = fminf(fmaxf(uu, -7.0f), 7.0f);
                        const float sg = __builtin_amdgcn_rcpf(1.0f + __builtin_amdgcn_exp2f(-1.702f * LOG2E * g));
                        r[n * 4 + j] = g * sg * (uu + 1.0f); }
                u32x4 w; w.x = cvt_pk_bf16(r[0], r[1]); w.y = cvt_pk_bf16(r[2], r[3]); w.z = cvt_pk_bf16(r[4], r[5]); w.w = cvt_pk_bf16(r[6], r[7]);
                *(u32x4*)rowp = w; }
    }
};
struct EpiSwiglu8 {
    static constexpr bool PERM = true;
    bf16_t* ACT; const float* bg; const float* bu; const float* sal; const float* sbw;
    __device__ __forceinline__ void operator()(const i32x4 (&acc)[2][2][4][2], const Unit& u, int wr, int wc, int fr, int fq) const {
        const int lr0 = wr * 64 + fr, row0 = u.pm * BM + lr0, col0 = u.pn * HALF + wc * 32 + 8 * fq;
        const float* psa = sal + (size_t)u.e * NT + u.mt * 256;
#pragma unroll
        for (int n = 0; n < 2; ++n) {
            const f32x4 gb = *(const f32x4*)(bg + (size_t)u.e * D + col0 + 4 * n), ub = *(const f32x4*)(bu + (size_t)u.e * D + col0 + 4 * n);
            const float* ps = sbw + (size_t)u.e * 2048 + u.pn * BM + wc * 32 + 8 * fq + 4 * n;
            const f32x4 sg = *(const f32x4*)ps, su = *(const f32x4*)(ps + HALF);
#pragma unroll
            for (int ai = 0; ai < 2; ++ai)
#pragma unroll
                for (int m = 0; m < 4; ++m) { int lr = lr0 + ai * HALF + m * 16; const float sa_ = psa[(u.mt * 256 + lr) < u.cnt ? lr : 0];
                    float r[4];
#pragma unroll
                    for (int j = 0; j < 4; ++j) {
                        float g = (float)acc[ai][0][m][n][j] * (sa_ * sg[j]) + gb[j];
                        float uu = (float)acc[ai][1][m][n][j] * (sa_ * su[j]) + ub[j];
                        g = fminf(g, 7.0f); uu = fminf(fmaxf(uu, -7.0f), 7.0f);
                        const float sgm = __builtin_amdgcn_rcpf(1.0f + __builtin_amdgcn_exp2f(-1.702f * LOG2E * g));
                        r[j] = g * sgm * (uu + 1.0f); }
                    u32x2 w; w.x = cvt_pk_bf16(r[0], r[1]); w.y = cvt_pk_bf16(r[2], r[3]);
                    *(u32x2*)(ACT + (size_t)(row0 + ai * HALF + m * 16) * D + col0 + 4 * n) = w; }
            asm volatile("" ::: "memory");
        }
    }
};
struct EpiDown {
    static constexpr bool PERM = true;
    bf16_t* YS; const float* bd;
    __device__ __forceinline__ void operator()(const f32x4 (&acc)[2][2][4][2], const Unit& u, int wr, int wc, int fr, int fq) const {
        const int row0 = u.pm * BM + wr * 64 + fr, col0 = u.pn * BM + wc * 32 + 8 * fq;
        const float* pb = bd + (size_t)u.e * D + col0;
        f32x4 bv[2][2];
#pragma unroll
        for (int bj = 0; bj < 2; ++bj)
#pragma unroll
            for (int n = 0; n < 2; ++n) bv[bj][n] = *(const f32x4*)(pb + bj * HALF + 4 * n);
#pragma unroll
        for (int ai = 0; ai < 2; ++ai)
#pragma unroll
            for (int m = 0; m < 4; ++m) { bf16_t* rowp = YS + (size_t)(row0 + ai * HALF + m * 16) * D + col0;
#pragma unroll
                for (int bj = 0; bj < 2; ++bj) { const f32x4 v0 = acc[ai][bj][m][0] + bv[bj][0], v1 = acc[ai][bj][m][1] + bv[bj][1];
                    u32x4 w; w.x = cvt_pk_bf16(v0[0], v0[1]); w.y = cvt_pk_bf16(v0[2], v0[3]); w.z = cvt_pk_bf16(v1[0], v1[1]); w.w = cvt_pk_bf16(v1[2], v1[3]);
                    *(u32x4*)(rowp + bj * HALF) = w; } }
    }
};

struct EpiDown8 {
    static constexpr bool PERM = true;
    bf16_t* YS; const float* bd; const float* saq; const float* sbd;
    __device__ __forceinline__ void operator()(const i32x4 (&acc)[2][2][4][2], const Unit& u, int wr, int wc, int fr, int fq) const {
        const int row0 = u.pm * BM + wr * 64 + fr, col0 = u.pn * BM + wc * 32 + 8 * fq;
#pragma unroll
        for (int bj = 0; bj < 2; ++bj) {
            const float* pb = bd + (size_t)u.e * D + col0 + bj * HALF; const float* ps = sbd + (size_t)u.e * D + col0 + bj * HALF;
            const f32x4 b0 = *(const f32x4*)pb, b1 = *(const f32x4*)(pb + 4), s0 = *(const f32x4*)ps, s1 = *(const f32x4*)(ps + 4);
#pragma unroll
            for (int ai = 0; ai < 2; ++ai)
#pragma unroll
                for (int m = 0; m < 4; ++m) { const int row = row0 + ai * HALF + m * 16; const float sr = saq[row]; f32x4 v0, v1;
#pragma unroll
                    for (int j = 0; j < 4; ++j) { v0[j] = (float)acc[ai][bj][m][0][j] * (sr * s0[j]) + b0[j]; v1[j] = (float)acc[ai][bj][m][1][j] * (sr * s1[j]) + b1[j]; }
                    u32x4 w; w.x = cvt_pk_bf16(v0[0], v0[1]); w.y = cvt_pk_bf16(v0[2], v0[3]); w.z = cvt_pk_bf16(v1[0], v1[1]); w.w = cvt_pk_bf16(v1[2], v1[3]);
                    *(u32x4*)(YS + (size_t)row * D + col0 + bj * HALF) = w; }
            asm volatile("" ::: "memory");
        }
    }
};
struct DenseOrder {
    int nM, nN, vcu, xM, xN0, xNn;
    __device__ __forceinline__ bool short_one() const { const int U = nM * nN + xM * xNn, R = (U + 255) >> 8; return (U & 255) != 0 && vcu >= U - (R - 1) * 256; }
    __device__ __forceinline__ bool next(int i, Unit& u) const {
        int L = i * 256 + vcu; const int nmain = nM * nN;
        if (L < nmain) { const int nig = 8 * nN, gid = L / nig, fm = gid * 8, rem = nM - fm, gsz = rem < 8 ? rem : 8, w = L % nig; u.pm = fm + w % gsz; u.pn = w / gsz; }
        else { L -= nmain; if (L >= xM * xNn) return false; u.pm = nM + L % xM; u.pn = xN0 + L / xM; }
        u.e = 0; u.mt = 0; u.cnt = 0; return true;
    }
};
struct MoeOrder {
    const LAS int* ecnt; const LAS int* lbase; const LAS int* cumt; int nN, idx, G; LAS int* ul;
    __device__ __forceinline__ bool short_one() const { const int U = cumt[32] * nN, R = (U + G - 1) / G; return (U % G) != 0 && idx >= U - (R - 1) * G; }
    __device__ __forceinline__ void build(int tid) const {
        if (tid < 16) { const int L = tid * G + idx; int e = -1, pn = 0, mt = 0, pm = 0, c = 0;
            if (idx >= 0 && L < cumt[32] * nN) { e = 0; while (cumt[e + 1] * nN <= L) ++e; const int r = L - cumt[e] * nN; c = ecnt[e]; const int mte = (c + 255) >> 8;
                if (MK_MT_MAJOR & (nN == 4 ? 1 : 2)) { pn = r % nN; mt = r / nN; } else { pn = r / mte; mt = r % mte; } pm = (lbase[e] >> 8) + mt; }
            ul[tid * 8 + 0] = e; ul[tid * 8 + 1] = pn; ul[tid * 8 + 2] = mt; ul[tid * 8 + 3] = pm; ul[tid * 8 + 4] = c; }
        __syncthreads();
    }
    __device__ __forceinline__ bool next(int i, Unit& u) const {
        if (i >= 16) return false;
        const int e = __builtin_amdgcn_readfirstlane(ul[i * 8 + 0]);
        if (e < 0) return false;
        u.e = e; u.pn = __builtin_amdgcn_readfirstlane(ul[i * 8 + 1]); u.mt = __builtin_amdgcn_readfirstlane(ul[i * 8 + 2]); u.pm = __builtin_amdgcn_readfirstlane(ul[i * 8 + 3]); u.cnt = __builtin_amdgcn_readfirstlane(ul[i * 8 + 4]); return true;
    }
};
}

namespace att {
constexpr int VSTR = 144;
template <int DQK> struct Cfg { static constexpr int KSTR = DQK * 2 + 16, KB = 64 * KSTR, VB = 64 * VSTR, STAGE = KB + VB, CPR = DQK / 8, NKS = DQK / 16; };
__device__ __forceinline__ int crow(int r, int hi) { return (r & 3) + 8 * (r >> 2) + 4 * hi; }

template <int DQK, bool MLA>
__device__ __forceinline__ void fetchK(u32x4 (&r)[2], const bf16_t* Kb, const bf16_t* KRb, int pitch, int row0, int tid) {
    typedef Cfg<DQK> C;
    { const int key = tid / C::CPR, ch = tid % C::CPR;
      const bf16_t* src = (MLA && ch >= 8) ? KRb + (size_t)(row0 + key) * 32 + (ch - 8) * 8 : Kb + (size_t)(row0 + key) * pitch + ch * 8;
      r[0] = *(const u32x4*)src; }
    if constexpr (DQK == 96) { if (tid < 256) { const int c = 512 + tid, key = c / C::CPR, ch = c % C::CPR;
      const bf16_t* src = (MLA && ch >= 8) ? KRb + (size_t)(row0 + key) * 32 + (ch - 8) * 8 : Kb + (size_t)(row0 + key) * pitch + ch * 8;
      r[1] = *(const u32x4*)src; } }
}
__device__ __forceinline__ void fetchV(u32x4& r, const bf16_t* Vb, int pitch, int row0, int tid) { const int key = tid >> 3, ch = tid & 7; r = *(const u32x4*)(Vb + (size_t)(row0 + key) * pitch + ch * 8); }
template <int DQK>
__device__ __forceinline__ void stashK(LAS unsigned char* kst, const u32x4 (&r)[2], int tid) {
    typedef Cfg<DQK> C;
    { const int key = tid / C::CPR, ch = tid % C::CPR; *(LAS u32x4*)(kst + key * C::KSTR + ch * 16) = r[0]; }
    if constexpr (DQK == 96) { if (tid < 256) { const int c = 512 + tid, key = c / C::CPR, ch = c % C::CPR; *(LAS u32x4*)(kst + key * C::KSTR + ch * 16) = r[1]; } }
}
__device__ __forceinline__ void stashV(LAS unsigned char* vst, const u32x4& r, int tid) { const int key = tid >> 3, ch = tid & 7; *(LAS u32x4*)(vst + key * VSTR + ch * 16) = r; }
template <int DQK, bool MLA>
__device__ __forceinline__ void fetch(u32x4 (&r)[3], const bf16_t* Kb, const bf16_t* Vb, const bf16_t* KRb, int pitch, int row0, int tid) {
    u32x4 k2[2]; k2[1] = (u32x4){0u, 0u, 0u, 0u}; fetchK<DQK, MLA>(k2, Kb, KRb, pitch, row0, tid); r[0] = k2[0]; r[1] = k2[1]; fetchV(r[2], Vb, pitch, row0, tid);
}
template <int DQK>
__device__ __forceinline__ void stash(LAS unsigned char* st, const u32x4 (&r)[3], int tid) {
    const u32x4 k2[2] = {r[0], r[1]}; stashK<DQK>(st, k2, tid); stashV(st + Cfg<DQK>::KB, r[2], tid);
}
template <int DQK>
__device__ __forceinline__ f32x16 qk(const LAS unsigned char* kst, int koff, const bf16x8 (&qr)[DQK / 16], int r32, int hi) {
    typedef Cfg<DQK> C;
    f32x16 p;
#pragma unroll
    for (int r = 0; r < 16; ++r) p[r] = 0.f;
    const LAS unsigned char* kb = kst + (koff + r32) * C::KSTR + hi * 16;
#pragma unroll
    for (int ks = 0; ks < C::NKS; ++ks) { const bf16x8 kf = *(const LAS bf16x8*)(kb + ks * 32); p = __builtin_amdgcn_mfma_f32_32x32x16_bf16(kf, qr[ks], p, 0, 0, 0); }
    return p;
}
__device__ __forceinline__ s16x4 vtr(const LAS unsigned char* p) { return __builtin_bit_cast(s16x4, __builtin_amdgcn_ds_read_tr16_b64_v4i16((LAS s16x4*)p)); }
typedef __bf16 bf16x2_t __attribute__((ext_vector_type(2)));
__device__ __forceinline__ unsigned cvtpk_s(float lo, float hi) { const f32x2 v = {lo, hi}; const bf16x2_t b = __builtin_convertvector(v, bf16x2_t); return __builtin_bit_cast(unsigned, b); }
template <int NS>
__device__ __forceinline__ void sm_max(const f32x16 (&t)[NS], const float sc, f32x16 (&o)[2], float& m, float& l) {
    float mx = t[0][0];
#pragma unroll
    for (int s = 0; s < NS; ++s)
#pragma unroll
        for (int r = 0; r < 16; ++r) mx = fmaxf(mx, t[s][r]);
    mx = swap32_max(mx) * sc;
    if (__any(mx > m + 8.0f)) { const float mn = fmaxf(m, mx); const float a = __builtin_amdgcn_exp2f(m - mn); m = mn; l *= a;
#pragma unroll
        for (int r = 0; r < 16; ++r) { o[0][r] *= a; o[1][r] *= a; } }
}
template <int NS>
__device__ __forceinline__ void sm_exp_pv(f32x16 (&t)[NS], const float sc, const LAS unsigned char* vst, const int (&voff)[NS], f32x16 (&o)[2], const float m, float& l, int lane) {
    const int hi = lane >> 5;
    float rs = 0.f;
#pragma unroll
    for (int s = 0; s < NS; ++s)
#pragma unroll
        for (int r = 0; r < 16; ++r) { t[s][r] = __builtin_amdgcn_exp2f(__builtin_fmaf(t[s][r], sc, -m)); rs += t[s][r]; }
    l += rs;
    const int q4 = (lane & 15) >> 2, p4 = lane & 3, blk = (lane >> 4) & 1;
#pragma unroll
    for (int s = 0; s < NS; ++s) {
        const LAS unsigned char* vb = vst + (voff[s] + 4 * hi + q4) * VSTR + (16 * blk + 4 * p4) * 2;
#pragma unroll
        for (int kk = 0; kk < 2; ++kk) {
            u32x4 pw; pw.x = cvtpk_s(t[s][8 * kk + 0], t[s][8 * kk + 1]); pw.y = cvtpk_s(t[s][8 * kk + 2], t[s][8 * kk + 3]);
            pw.z = cvtpk_s(t[s][8 * kk + 4], t[s][8 * kk + 5]); pw.w = cvtpk_s(t[s][8 * kk + 6], t[s][8 * kk + 7]);
            const bf16x8 pb = __builtin_bit_cast(bf16x8, pw);
#pragma unroll
            for (int c = 0; c < 2; ++c) {
                const s16x4 lo = vtr(vb + (16 * kk) * VSTR + c * 64), h8 = vtr(vb + (16 * kk + 8) * VSTR + c * 64);
                const bf16x8 va = (bf16x8){lo[0], lo[1], lo[2], lo[3], h8[0], h8[1], h8[2], h8[3]};
                o[c] = __builtin_amdgcn_mfma_f32_32x32x16_bf16(va, pb, o[c], 0, 0, 0);
            }
        }
    }
}
template <int NS>
__device__ __forceinline__ void sm_pv(f32x16 (&t)[NS], const float sc, const LAS unsigned char* vst, const int (&voff)[NS], f32x16 (&o)[2], float& m, float& l, int lane) {
    sm_max<NS>(t, sc, o, m, l); sm_exp_pv<NS>(t, sc, vst, voff, o, m, l, lane);
}
template <int DQK>
__device__ __forceinline__ f32x16 qkn(const LAS unsigned char* kst, int koff, const bf16x8 (&qr)[DQK / 16], const f32x16& negm, int r32, int hi) {
    typedef Cfg<DQK> C;
    f32x16 p = negm;
    const LAS unsigned char* kb = kst + (koff + r32) * C::KSTR + hi * 16;
#pragma unroll
    for (int ks = 0; ks < C::NKS; ++ks) { const bf16x8 kf = *(const LAS bf16x8*)(kb + ks * 32); p = __builtin_amdgcn_mfma_f32_32x32x16_bf16(kf, qr[ks], p, 0, 0, 0); }
    return p;
}
__device__ __forceinline__ void sm_max_n(f32x16 (&t)[2], f32x16 (&o)[2], f32x16& osum, float& m, f32x16& negm, bool first) {
    float a0 = fmaxf(fmaxf(t[0][0], t[0][1]), t[0][2]), a1 = fmaxf(fmaxf(t[1][0], t[1][1]), t[1][2]);
#pragma unroll
    for (int r = 3; r < 15; r += 2) { a0 = fmaxf(fmaxf(a0, t[0][r]), t[0][r + 1]); a1 = fmaxf(fmaxf(a1, t[1][r]), t[1][r + 1]); }
    float mx = fmaxf(fmaxf(a0, a1), fmaxf(t[0][15], t[1][15]));
    mx = swap32_max(mx);
    if (first || __any(mx > 8.0f)) { const float d = first ? mx : fmaxf(mx, 0.f); const float a = first ? 1.0f : __builtin_amdgcn_exp2f(-d); m += d;
#pragma unroll
        for (int r = 0; r < 16; ++r) { t[0][r] -= d; t[1][r] -= d; o[0][r] *= a; o[1][r] *= a; osum[r] *= a; negm[r] = -m; } }
}
__device__ __forceinline__ void sm_exp_pv_n(f32x16 (&t)[2], const LAS unsigned char* vst, f32x16 (&o)[2], f32x16& osum, int lane) {
    const int hi = lane >> 5, q4 = (lane & 15) >> 2, p4 = lane & 3, blk = (lane >> 4) & 1;
    const LAS unsigned char* vb = vst + (4 * hi + q4) * VSTR + (16 * blk + 4 * p4) * 2;
    bf16x8 va[2][2][2];
#pragma unroll
    for (int s = 0; s < 2; ++s)
#pragma unroll
        for (int kk = 0; kk < 2; ++kk)
#pragma unroll
            for (int c = 0; c < 2; ++c) { const s16x4 lo = vtr(vb + (32 * s + 16 * kk) * VSTR + c * 64), h8 = vtr(vb + (32 * s + 16 * kk + 8) * VSTR + c * 64);
                va[s][kk][c] = (bf16x8){lo[0], lo[1], lo[2], lo[3], h8[0], h8[1], h8[2], h8[3]}; }
    const bf16x8 ones = (bf16x8){0x3F80, 0x3F80, 0x3F80, 0x3F80, 0x3F80, 0x3F80, 0x3F80, 0x3F80};
#pragma unroll
    for (int s = 0; s < 2; ++s)
#pragma unroll
        for (int kk = 0; kk < 2; ++kk) {
            float e[8];
#pragma unroll
            for (int j = 0; j < 8; ++j) e[j] = __builtin_amdgcn_exp2f(t[s][8 * kk + j]);
            u32x4 pw; pw.x = cvtpk_s(e[0], e[1]); pw.y = cvtpk_s(e[2], e[3]); pw.z = cvtpk_s(e[4], e[5]); pw.w = cvtpk_s(e[6], e[7]);
            const bf16x8 pb = __builtin_bit_cast(bf16x8, pw);
            o[0] = __builtin_amdgcn_mfma_f32_32x32x16_bf16(va[s][kk][0], pb, o[0], 0, 0, 0);
            o[1] = __builtin_amdgcn_mfma_f32_32x32x16_bf16(va[s][kk][1], pb, o[1], 0, 0, 0);
            osum = __builtin_amdgcn_mfma_f32_32x32x16_bf16(ones, pb, osum, 0, 0, 0);
        }
}
__device__ __forceinline__ void finalize_n(const f32x16 (&o)[2], const f32x16& osum, bf16_t* orow, int hi) {
    const float inv = 1.0f / osum[0];
#pragma unroll
    for (int c = 0; c < 2; ++c)
#pragma unroll
        for (int g = 0; g < 4; ++g) { u32x2 w; w.x = cvt_pk_bf16(o[c][4 * g] * inv, o[c][4 * g + 1] * inv); w.y = cvt_pk_bf16(o[c][4 * g + 2] * inv, o[c][4 * g + 3] * inv);
            *(u32x2*)(orow + 32 * c + 8 * g + 4 * hi) = w; }
}
__device__ __forceinline__ void finalize(const f32x16 (&o)[2], float l, bf16_t* orow, int hi) {
    l = swap32_sum(l); const float inv = 1.0f / l;
#pragma unroll
    for (int c = 0; c < 2; ++c)
#pragma unroll
        for (int g = 0; g < 4; ++g) { u32x2 w; w.x = cvt_pk_bf16(o[c][4 * g] * inv, o[c][4 * g + 1] * inv); w.y = cvt_pk_bf16(o[c][4 * g + 2] * inv, o[c][4 * g + 3] * inv);
            *(u32x2*)(orow + 32 * c + 8 * g + 4 * hi) = w; }
}
#define ATT_PIPE_BEGIN(DQK, MLA, ROW0_OF) \
    u32x4 pre[3]; pre[1] = (u32x4){0u, 0u, 0u, 0u}; \
    fetch<DQK, MLA>(pre, Kb, Vb, KRb, pitch, ROW0_OF(0), tid); stash<DQK>(lds, pre, tid); __syncthreads(); \
    for (int i = 0; i < ntiles; ++i) { \
        if (i + 1 < ntiles) fetch<DQK, MLA>(pre, Kb, Vb, KRb, pitch, ROW0_OF(i + 1), tid); \
        const LAS unsigned char* kst = lds + (i & 1) * Cfg<DQK>::STAGE; const LAS unsigned char* vst = kst + Cfg<DQK>::KB;
#define ATT_PIPE_END(DQK) \
        if (i + 1 < ntiles) stash<DQK>(lds + ((i + 1) & 1) * Cfg<DQK>::STAGE, pre, tid); \
        __syncthreads(); }

#define ATT2_RUN(DQK, MLA, ROW0_OF, QK2, FIRST) \
    { typedef Cfg<DQK> C_; LAS unsigned char* const kb_ = lds; LAS unsigned char* const vb_ = lds + 2 * C_::KB; \
    u32x4 pk_[2], pv_; pk_[1] = (u32x4){0u, 0u, 0u, 0u}; \
    fetchK<DQK, MLA>(pk_, Kb, KRb, pitch, ROW0_OF(0), tid); fetchV(pv_, Vb, pitch, ROW0_OF(0), tid); stashK<DQK>(kb_, pk_, tid); stashV(vb_, pv_, tid); \
    if (ntiles > 1) { fetchK<DQK, MLA>(pk_, Kb, KRb, pitch, ROW0_OF(1), tid); stashK<DQK>(kb_ + C_::KB, pk_, tid); } \
    __syncthreads(); \
    f32x16 t[2]; QK2(t, kb_, 0); \
    __syncthreads();     \
    for (int i = 0; i + 1 < ntiles; ++i) { \
        if (i + 2 < ntiles) fetchK<DQK, MLA>(pk_, Kb, KRb, pitch, ROW0_OF(i + 2), tid); \
        fetchV(pv_, Vb, pitch, ROW0_OF(i + 1), tid); \
        sm_max_n(t, o, osum, m, negm, (FIRST) && i == 0); \
        f32x16 tn[2]; QK2(tn, kb_ + ((i + 1) & 1) * C_::KB, i + 1);     \
        sm_exp_pv_n(t, vb_ + (i & 1) * C_::VB, o, osum, lane); \
        t[0] = tn[0]; t[1] = tn[1]; \
        if (i + 2 < ntiles) stashK<DQK>(kb_ + (i & 1) * C_::KB, pk_, tid); \
        stashV(vb_ + ((i + 1) & 1) * C_::VB, pv_, tid); \
        __syncthreads(); } \
    sm_max_n(t, o, osum, m, negm, (FIRST) && ntiles == 1); \
    sm_exp_pv_n(t, vb_ + ((ntiles - 1) & 1) * C_::VB, o, osum, lane); \
    __syncthreads(); }

__device__ __forceinline__ void attn_A_unit(LAS unsigned char* lds, const bf16_t* QKV, bf16_t* O, const float* sink, int b, int kvh, int qb, bool ctxq, int tid) {
    const int lane = tid & 63, wid = __builtin_amdgcn_readfirstlane(tid >> 6), r32 = lane & 31, hi = lane >> 5;
    const int head = kvh * 4 + (wid >> 1), qoff = 32 * (wid & 1) + r32, t0 = qb * 64;
    const int qrow = ctxq ? NL + b * CTXL + t0 + qoff : b * SEQ + t0 + qoff;
    bf16x8 qr[4];
    { const bf16_t* qp = QKV + (size_t)qrow * A_IN + head * 64 + hi * 8;
#pragma unroll
      for (int ks = 0; ks < 4; ++ks) qr[ks] = *(const bf16x8*)(qp + ks * 16); }
    int jlo = 0, nloc = 0;
    if (!ctxq) { jlo = t0 >= 128 ? 0 : (t0 == 64 ? 1 : 2); int jhi = (2112 - t0) / 64; jhi = jhi > 4 ? 4 : jhi; nloc = jhi - jlo + 1; }
    const int ntiles = 4 + nloc, cbase = NL + b * CTXL, lbase = b * SEQ + t0 - 128 + 64 * jlo;
    const bf16_t* Kb = QKV + 1024 + kvh * 64; const bf16_t* Vb = QKV + 1280 + kvh * 64; const bf16_t* KRb = nullptr; const int pitch = A_IN;
    float m = sink[head] * LOG2E;
    f32x16 o[2], osum, negm;
#pragma unroll
    for (int r = 0; r < 16; ++r) { o[0][r] = 0.f; o[1][r] = 0.f; osum[r] = 1.0f; negm[r] = -m; }
#define A_ROW0(i) ((i) < 4 ? cbase + 64 * (i) : lbase + 64 * ((i) - 4))
#define A_QK2(dst, kst, ti) { dst[0] = qkn<64>(kst, 0, qr, negm, r32, hi); dst[1] = qkn<64>(kst, 32, qr, negm, r32, hi); const int j_ = (ti) < 4 ? 2 : jlo + (ti) - 4; \
        if (j_ == 0 || j_ == 4) { _Pragma("unroll") for (int s = 0; s < 2; ++s) _Pragma("unroll") for (int r = 0; r < 16; ++r) { const int kk = 32 * s + crow(r, hi); \
            if (j_ == 0 ? (kk < qoff) : (kk > qoff)) dst[s][r] = -1e30f; } } }
    ATT2_RUN(64, false, A_ROW0, A_QK2, false)
#undef A_QK2
#undef A_ROW0
    finalize_n(o, osum, O + (size_t)qrow * D + head * 64, hi);
}

__device__ __forceinline__ void attn_B_unit(LAS unsigned char* lds, LAS float* tab, const bf16_t* QKV, bf16_t* O, const float* rpb, int b, int h, int rq, bool ctxq, int tid) {
    const int lane = tid & 63, wid = __builtin_amdgcn_readfirstlane(tid >> 6), r32 = lane & 31, hi = lane >> 5;
    const int jb = wid & 3, rp = wid >> 2;
    const int rqa = 4 * rq + 2 * rp + (r32 >> 4), qcol = 16 * jb + (r32 & 15);
    const int qrow = ctxq ? NL + b * CTXL + 32 * wid + r32 : b * SEQ + rqa * 64 + qcol;
    for (int idx = tid; idx < 15 * 31; idx += 512) tab[(idx / 31) * 32 + idx % 31] = rpb[h * 465 + idx] * LOG2E;
    bf16x8 qr[4];
    { const bf16_t* qp = QKV + (size_t)qrow * B_IN + h * 64 + hi * 8;
#pragma unroll
      for (int ks = 0; ks < 4; ++ks) qr[ks] = *(const bf16x8*)(qp + ks * 16); }
    int klo = 0, nloc = 0;
    if (!ctxq) { klo = 4 * rq - 4; klo = klo < 0 ? 0 : (klo > 24 ? 24 : klo); int khi = 4 * rq - 1; khi = khi < 0 ? 0 : (khi > 24 ? 24 : khi); khi += 7; nloc = khi - klo + 1; }
    const int ntiles = 4 + nloc, cbase = NL + b * CTXL, lbase = b * SEQ;
    int r0q = rqa - 4; r0q = r0q < 0 ? 0 : (r0q > 24 ? 24 : r0q);
    int wst = qcol - 8; wst = wst < 0 ? 0 : (wst > 48 ? 48 : wst);
    int cst = 16 * jb - 8; cst = cst < 0 ? 0 : (cst > 32 ? 32 : cst);
    const int lo = wst - cst;
    int wr0 = 4 * rq + 2 * rp - 4; wr0 = wr0 < 0 ? 0 : (wr0 > 24 ? 24 : wr0);
    int wr1 = 4 * rq + 2 * rp + 1 - 4; wr1 = wr1 < 0 ? 0 : (wr1 > 24 ? 24 : wr1); wr1 += 7;
    const bf16_t* Kb = QKV + 1024 + h * 64; const bf16_t* Vb = QKV + 2048 + h * 64; const bf16_t* KRb = nullptr; const int pitch = B_IN;
    float m = -1e30f, l = 0.f;
    f32x16 o[2];
#pragma unroll
    for (int r = 0; r < 16; ++r) { o[0][r] = 0.f; o[1][r] = 0.f; }
    const float sc = 0.125f * LOG2E;
#define B_ROW0(i) ((i) < 4 ? cbase + 64 * (i) : lbase + 64 * (klo + (i) - 4))
    ATT_PIPE_BEGIN(64, false, B_ROW0)
        if (i < 4) {
            f32x16 t[2];
            t[0] = qk<64>(kst, 0, qr, r32, hi); t[1] = qk<64>(kst, 32, qr, r32, hi);
#pragma unroll
            for (int s = 0; s < 2; ++s)
#pragma unroll
                for (int r = 0; r < 16; ++r) t[s][r] *= 1.0f;
            const int voff[2] = {0, 32};
            sm_pv<2>(t, 1.0f, vst, voff, o, m, l, lane);
        } else {
            const int kr = klo + i - 4;
            if (kr >= wr0 && kr <= wr1) {
                f32x16 t[1];
                t[0] = qk<64>(kst, cst, qr, r32, hi);
                const bool rowok = (kr >= r0q) && (kr < r0q + 8);
                const int bidx0 = (kr - rqa + 7) * 32 + cst - qcol + 15;
#pragma unroll
                for (int r = 0; r < 16; ++r) { const int kidx = crow(r, hi); const bool ok = rowok && ((unsigned)(kidx - lo) < 16u);
                    int bi = bidx0 + kidx; bi = bi < 0 ? 0 : (bi > 479 ? 479 : bi);
                    const float bias = tab[bi];
                    t[0][r] = ok ? t[0][r] + bias : -1e30f; }
                const int voff[1] = {cst};
                sm_pv<1>(t, 1.0f, vst, voff, o, m, l, lane);
            }
        }
    ATT_PIPE_END(64)
#undef B_ROW0
    finalize(o, l, O + (size_t)qrow * D + h * 64, hi);
}

__device__ __forceinline__ void attn_C_unit(LAS unsigned char* lds, const bf16_t* Q2, const bf16_t* KR, bf16_t* O, int b, int h, int qb, bool ctxq, int tid) {
    const int lane = tid & 63, wid = __builtin_amdgcn_readfirstlane(tid >> 6), r32 = lane & 31, hi = lane >> 5;
    const int qrow = ctxq ? NL + b * CTXL + 32 * wid + r32 : b * SEQ + qb * 256 + 32 * wid + r32;
    bf16x8 qr[6];
    { const bf16_t* qp = Q2 + (size_t)qrow * C_UPN + h * 96 + hi * 8;
#pragma unroll
      for (int ks = 0; ks < 6; ++ks) qr[ks] = *(const bf16x8*)(qp + ks * 16); }
    const int ntiles = ctxq ? 4 : 36, cbase = NL + b * CTXL, lbase = b * SEQ;
    const bf16_t* Kb = Q2 + 1536 + h * 128; const bf16_t* Vb = Kb + 64; const bf16_t* KRb = KR; const int pitch = C_UPN;
    float m = 0.f;
    f32x16 o[2], osum, negm;
#pragma unroll
    for (int r = 0; r < 16; ++r) { o[0][r] = 0.f; o[1][r] = 0.f; osum[r] = 0.f; negm[r] = 0.f; }
#define C_ROW0(i) ((i) < 4 ? cbase + 64 * (i) : lbase + 64 * ((i) - 4))
#define C_QK2(dst, kst, ti) { dst[0] = qkn<96>(kst, 0, qr, negm, r32, hi); dst[1] = qkn<96>(kst, 32, qr, negm, r32, hi); }
    ATT2_RUN(96, true, C_ROW0, C_QK2, true)
#undef C_QK2
#undef C_ROW0
    finalize_n(o, osum, O + (size_t)qrow * D + h * 64, hi);
}
}

struct Row4 { f32x4 v[4]; };
__device__ __forceinline__ void row_load(Row4& x, const float* p, int lane) {
#pragma unroll
    for (int j = 0; j < 4; ++j) x.v[j] = *(const f32x4*)(p + 4 * lane + 256 * j);
}
__device__ __forceinline__ void row_store(const Row4& x, float* p, int lane) {
#pragma unroll
    for (int j = 0; j < 4; ++j) *(f32x4*)(p + 4 * lane + 256 * j) = x.v[j];
}
__device__ __forceinline__ void row_load_bf(Row4& x, const bf16_t* p, int lane) {
#pragma unroll
    for (int j = 0; j < 4; ++j) { const u32x2 w = *(const u32x2*)(p + 4 * lane + 256 * j); x.v[j] = (f32x4){bf_lo(w.x), bf_hi(w.x), bf_lo(w.y), bf_hi(w.y)}; }
}
__device__ __forceinline__ void row_store_bf(const Row4& x, bf16_t* p, int lane) {
#pragma unroll
    for (int j = 0; j < 4; ++j) { u32x2 w; w.x = cvt_pk_bf16(x.v[j][0], x.v[j][1]); w.y = cvt_pk_bf16(x.v[j][2], x.v[j][3]); *(u32x2*)(p + 4 * lane + 256 * j) = w; }
}
__device__ __forceinline__ float row_rstd(const Row4& x, int lane) {
    float s = 0.f;
#pragma unroll
    for (int j = 0; j < 4; ++j) s += (x.v[j][0] * x.v[j][0] + x.v[j][1] * x.v[j][1]) + (x.v[j][2] * x.v[j][2] + x.v[j][3] * x.v[j][3]);
    s = wave_sum(s, lane);
    return 1.0f / sqrtf(s * (1.0f / D) + NORM_EPS);
}
__device__ __forceinline__ void norm_mod(const Row4& x, float rstd, const float* g, const float* sh, const float* sc, bf16_t* out, int lane, Row4& hv) {
#pragma unroll
    for (int j = 0; j < 4; ++j) { const int c = 4 * lane + 256 * j;
        const f32x4 gg = *(const f32x4*)(g + c), s1 = *(const f32x4*)(sc + c), s0 = *(const f32x4*)(sh + c);
        const f32x4 h = (x.v[j] * rstd * gg) * (s1 + 1.0f) + s0; hv.v[j] = h;
        u32x2 w; w.x = cvt_pk_bf16(h[0], h[1]); w.y = cvt_pk_bf16(h[2], h[3]); *(u32x2*)(out + c) = w; }
}

__device__ __forceinline__ unsigned pk_i8x4(float a, float b, float c, float d, float inv) {
    const int q0 = (int)rintf(a * inv), q1 = (int)rintf(b * inv), q2 = (int)rintf(c * inv), q3 = (int)rintf(d * inv);
    return (unsigned)(q0 & 255) | ((unsigned)(q1 & 255) << 8) | ((unsigned)(q2 & 255) << 16) | ((unsigned)q3 << 24);
}
__device__ __forceinline__ void norm_mod8(const Row4& x, float rstd, const float* g, const float* sh, const float* sc, unsigned char* out, float* sarow, int lane) {
    Row4 hv; float am = 0.f;
#pragma unroll
    for (int j = 0; j < 4; ++j) { const int c = 4 * lane + 256 * j;
        const f32x4 gg = *(const f32x4*)(g + c), s1 = *(const f32x4*)(sc + c), s0 = *(const f32x4*)(sh + c);
        const f32x4 h = (x.v[j] * rstd * gg) * (s1 + 1.0f) + s0; hv.v[j] = h;
        am = fmaxf(fmaxf(am, fmaxf(fabsf(h[0]), fabsf(h[1]))), fmaxf(fabsf(h[2]), fabsf(h[3]))); }
    am = fmaxf(wave_max(am, lane), 1e-20f); const float inv = 127.0f / am;
#pragma unroll
    for (int j = 0; j < 4; ++j) *(unsigned*)(out + 4 * lane + 256 * j) = pk_i8x4(hv.v[j][0], hv.v[j][1], hv.v[j][2], hv.v[j][3], inv);
    if (lane == 0) *sarow = am * (1.0f / 127.0f);
}

struct Ptrs {
    const float* in[29]; float* out; unsigned char* ws;
};
typedef const __attribute__((address_space(4))) Ptrs* PK;
#define WSP(T, off) ((T*)(P->ws + (off)))

__device__ __forceinline__ unsigned pk_f16(float a, float b) { const f32x2 v = {a, b}; const f16x2 h = __builtin_convertvector(v, f16x2); return __builtin_bit_cast(unsigned, h); }
__device__ __forceinline__ void phase_first_norm(PK P, int gw, int lane) {
    const float* MOD = WSP(const float, WS_MOD);
    {
        const int gt = gw * 64 + lane;
        for (int q = gt; q < DEPTH * 9 * 4096; q += 131072) { const int lb = q >> 12, cc = q & 4095, c = cc >> 5, e = cc & 31, l = lb / 9, b = lb - 9 * l;
            const float* g = P->in[7] + (size_t)l * D + 8 * c; const float* sc = MOD + ((size_t)l * 9 + b) * 6144 + 4096 + 8 * c; const float* w = P->in[21] + ((size_t)l * D + 8 * c) * NEXP + e;
            float v[8];
#pragma unroll
            for (int j = 0; j < 8; ++j) v[j] = g[j] * (1.0f + sc[j]) * w[j * NEXP];
            u32x4 o; o.x = pk_f16(v[0], v[1]); o.y = pk_f16(v[2], v[3]); o.z = pk_f16(v[4], v[5]); o.w = pk_f16(v[6], v[7]);
            *(u32x4*)(WSP(unsigned char, WS_G16) + (size_t)lb * 65536 + e * 2048 + ((c ^ (e & 15)) * 16)) = o; }
        for (int q = gw; q < DEPTH * 9 * 32; q += 2048) { const int lb = q >> 5, e = q & 31, l = lb / 9, b = lb - 9 * l;
            const float* sh = MOD + ((size_t)l * 9 + b) * 6144 + 3072; const float* w = P->in[21] + (size_t)l * D * NEXP + e; float t = 0.f;
#pragma unroll
            for (int j = 0; j < 16; ++j) { const int k = lane + 64 * j; t += sh[k] * w[(size_t)k * NEXP]; }
            t = wave_sum(t, lane);
            if (lane == 0) WSP(float, WS_RC)[q] = t + P->in[22][l * NEXP + e]; }
    }
    for (int r = gw; r < NT; r += 2048) {
        const float* src = r < NL ? P->in[0] + (size_t)r * D : P->in[2] + (size_t)(r - NL) * D;
        Row4 x; row_load(x, src, lane); row_store_bf(x, WSP(bf16_t, WS_XS) + (size_t)r * D, lane);
        const float rstd = row_rstd(x, lane); const int rb = r < NL ? (r >> 11) : 8; const float* mod = MOD + (size_t)rb * 6144;
        norm_mod8(x, rstd, P->in[6], mod, mod + 1024, WSP(unsigned char, WS_H) + (size_t)r * D, WSP(float, WS_SAH) + r, lane);
    }
}
__device__ __forceinline__ void phase_mla_norm(PK P, int gw, int lane) {
    const float* Y = WSP(const float, WS_Y416); bf16_t* CQ = WSP(bf16_t, WS_CQKV); bf16_t* KR = WSP(bf16_t, WS_KR);
    const float* qn = P->in[16]; const float* kn = P->in[17]; const float* rope = WSP(const float, WS_ROPE_C);
    for (int r = gw; r < NT; r += 2048) {
        const float* y = Y + (size_t)r * C_INP;
        const f32x4 v = *(const f32x4*)(y + 4 * lane);
        const float ss = wave_sum((v[0] * v[0] + v[1] * v[1]) + (v[2] * v[2] + v[3] * v[3]), lane);
        const float rq = 1.0f / sqrtf(ss * (1.0f / 256.0f) + NORM_EPS);
        const f32x4 g = *(const f32x4*)(qn + 4 * lane);
        u32x2 w; w.x = cvt_pk_bf16(v[0] * rq * g[0], v[1] * rq * g[1]); w.y = cvt_pk_bf16(v[2] * rq * g[2], v[3] * rq * g[3]);
        *(u32x2*)(CQ + (size_t)r * C_UPK + 4 * lane) = w;
        const f32x2 k2 = *(const f32x2*)(y + 256 + 2 * lane);
        const float s2 = wave_sum(k2[0] * k2[0] + k2[1] * k2[1], lane);
        const float rk = 1.0f / sqrtf(s2 * (1.0f / 128.0f) + NORM_EPS);
        const f32x2 g2 = *(const f32x2*)(kn + 2 * lane);
        *(unsigned*)(CQ + (size_t)r * C_UPK + 256 + 2 * lane) = cvt_pk_bf16(k2[0] * rk * g2[0], k2[1] * rk * g2[1]);
        if (lane < 16) { f32x2 p = *(const f32x2*)(y + 384 + 2 * lane);
            if (r < NL) { const f32x2 cs = *(const f32x2*)(rope + ((size_t)(r & (SEQ - 1)) * 16 + lane) * 2); const float a = p[0], b = p[1]; p[0] = a * cs[0] - b * cs[1]; p[1] = a * cs[1] + b * cs[0]; }
            *(unsigned*)(KR + (size_t)r * 32 + 2 * lane) = cvt_pk_bf16(p[0], p[1]); }
    }
}
__device__ __forceinline__ void moe_tables(LAS unsigned char* misc, unsigned* gcnt, int tid) {
    LAS int* ecnt = (LAS int*)(misc + M_ECNT); LAS int* lbase = (LAS int*)(misc + M_LBASE); LAS int* cumt = (LAS int*)(misc + M_CUMT);
    if (tid < 32) ecnt[tid] = (int)__hip_atomic_load(gcnt + tid * 16, __ATOMIC_RELAXED, __HIP_MEMORY_SCOPE_AGENT);
    __syncthreads();
    if (tid == 0) { int s = 0, t = 0; for (int e = 0; e < 32; ++e) { lbase[e] = s; cumt[e] = t; const int mt = (ecnt[e] + 255) >> 8; s += mt * 256; t += mt; } cumt[32] = t; }
    __syncthreads();
}
constexpr int RT_PLOG = 65536, RT_LOGIT = 98304, RT_SSQ = 102912, RT_RSTD = 103936, RT_CVEC = 104064, RT_AMX = 104192;
__device__ __forceinline__ void phase_router(PK P, LAS unsigned char* lds, int l, int nrows, int vcu, int tid, int cset) {
    const int lane = tid & 63, wid = __builtin_amdgcn_readfirstlane(tid >> 6), i32 = lane & 31, hi = lane >> 5;
    LAS unsigned char* misc = lds + MISC_OFF;
    LAS int* lcnt = (LAS int*)(misc + M_LCNT); LAS int* gbase = (LAS int*)(misc + M_GBASE); LAS int* rec = (LAS int*)(misc + M_REC);
    LAS float* plog = (LAS float*)(lds + RT_PLOG); LAS float* logit = (LAS float*)(lds + RT_LOGIT); LAS float* ssq = (LAS float*)(lds + RT_SSQ);
    LAS float* rstd_s = (LAS float*)(lds + RT_RSTD); LAS float* cvec = (LAS float*)(lds + RT_CVEC); LAS float* amx = (LAS float*)(lds + RT_AMX); LAS float* rowsa = (LAS float*)(misc + M_RSA);
    const bool last = (nrows == NL);
    const int nb = (!last && vcu < 64) ? 3 : 2;
    const float* MOD = WSP(const float, WS_MOD) + (size_t)l * 9 * 6144;
    const bf16_t* XS = WSP(const bf16_t, WS_XS); unsigned char* H8 = WSP(unsigned char, WS_H);
    int* TOPE = WSP(int, WS_TOPE); float* GATE = WSP(float, WS_GATE);
    const float* gn = P->in[7] + (size_t)l * D;
    if (tid < 32) lcnt[tid] = 0;
    for (int bi = 0; bi < nb; ++bi) {
        const int rb = bi < 2 ? (vcu >> 5) : 8;
        const int row0 = bi < 2 ? 64 * vcu + 32 * bi : NL + 32 * vcu;
        if (bi != 1) {
            __syncthreads();
            const u32x4* gsrc = (const u32x4*)(WSP(const unsigned char, WS_G16) + (size_t)(l * 9 + rb) * 65536);
#pragma unroll
            for (int c = 0; c < 8; ++c) *(LAS u32x4*)(lds + (size_t)(tid + 512 * c) * 16) = gsrc[tid + 512 * c];
            if (tid < 32) cvec[tid] = WSP(const float, WS_RC)[(l * 9 + rb) * 32 + tid];
            __syncthreads();
        }
        const int r = row0 + i32; const bf16_t* xp = XS + (size_t)r * D + 128 * wid + 8 * hi;
        f32x4 xa[8], xb[8];
#pragma unroll
        for (int s = 0; s < 8; ++s) { const u32x4 w = *(const u32x4*)(xp + 16 * s);
            xa[s] = (f32x4){bf_lo(w.x), bf_hi(w.x), bf_lo(w.y), bf_hi(w.y)}; xb[s] = (f32x4){bf_lo(w.z), bf_hi(w.z), bf_lo(w.w), bf_hi(w.w)}; }
        float ss = 0.f;
        f32x16 acc;
#pragma unroll
        for (int q = 0; q < 16; ++q) acc[q] = 0.f;
#pragma unroll
        for (int s = 0; s < 8; ++s) {
            ss += (xa[s][0] * xa[s][0] + xa[s][1] * xa[s][1]) + (xa[s][2] * xa[s][2] + xa[s][3] * xa[s][3]) + (xb[s][0] * xb[s][0] + xb[s][1] * xb[s][1]) + (xb[s][2] * xb[s][2] + xb[s][3] * xb[s][3]);
            u32x4 aw; aw.x = pk_f16(xa[s][0], xa[s][1]); aw.y = pk_f16(xa[s][2], xa[s][3]); aw.z = pk_f16(xb[s][0], xb[s][1]); aw.w = pk_f16(xb[s][2], xb[s][3]);
            const int c = 16 * wid + 2 * s + hi;
            const f16x8 bf = *(const LAS f16x8*)(lds + i32 * 2048 + ((c ^ (i32 & 15)) * 16));
            acc = __builtin_amdgcn_mfma_f32_32x32x16_f16(__builtin_bit_cast(f16x8, aw), bf, acc, 0, 0, 0);
        }
        ss = swap32_sum(ss);
        if (hi == 0) ssq[wid * 32 + i32] = ss;
#pragma unroll
        for (int q = 0; q < 16; ++q) plog[(wid * 32 + att::crow(q, hi)) * 32 + i32] = acc[q];
        __syncthreads();
        if (tid < 32) { float t = 0.f;
#pragma unroll
            for (int w = 0; w < 8; ++w) t += ssq[w * 32 + tid];
            rstd_s[tid] = 1.0f / sqrtf(t * (1.0f / D) + NORM_EPS); }
        __syncthreads();
#pragma unroll
        for (int u = 0; u < 2; ++u) { const int idx = tid + 512 * u, rr = idx >> 5, e = idx & 31; float t = 0.f;
#pragma unroll
            for (int w = 0; w < 8; ++w) t += plog[(w * 32 + rr) * 32 + e];
            logit[rr * 33 + e] = rstd_s[rr] * t + cvec[e]; }
        { const float rs = rstd_s[i32]; const float* mod = MOD + (size_t)rb * 6144; const int k0 = 128 * wid + 8 * hi; float am = 0.f;
#pragma unroll
          for (int s = 0; s < 8; ++s) { const int k = k0 + 16 * s;
              const f32x4 g0 = *(const f32x4*)(gn + k), g1 = *(const f32x4*)(gn + k + 4), c0 = *(const f32x4*)(mod + 4096 + k), c1 = *(const f32x4*)(mod + 4096 + k + 4);
              const f32x4 s0 = *(const f32x4*)(mod + 3072 + k), s1 = *(const f32x4*)(mod + 3072 + k + 4);
              const f32x4 h0 = (xa[s] * rs * g0) * (c0 + 1.0f) + s0, h1 = (xb[s] * rs * g1) * (c1 + 1.0f) + s1; xa[s] = h0; xb[s] = h1;
              am = fmaxf(fmaxf(fmaxf(am, fabsf(h0[0])), fmaxf(fabsf(h0[1]), fabsf(h0[2]))), fmaxf(fmaxf(fabsf(h0[3]), fabsf(h1[0])), fmaxf(fabsf(h1[1]), fmaxf(fabsf(h1[2]), fabsf(h1[3]))))); }
          am = swap32_max(am);
          if (hi == 0) amx[wid * 32 + i32] = am; }
        __syncthreads();
        { float a = amx[i32];
#pragma unroll
          for (int w = 1; w < 8; ++w) a = fmaxf(a, amx[w * 32 + i32]);
          a = fmaxf(a, 1e-20f); const float inv = 127.0f / a;
          if (wid == 0 && hi == 0) rowsa[32 * bi + i32] = a * (1.0f / 127.0f);
          unsigned char* hp = H8 + (size_t)r * D + 128 * wid + 8 * hi;
#pragma unroll
          for (int s = 0; s < 8; ++s) { u32x2 w; w.x = pk_i8x4(xa[s][0], xa[s][1], xa[s][2], xa[s][3], inv); w.y = pk_i8x4(xb[s][0], xb[s][1], xb[s][2], xb[s][3], inv); *(u32x2*)(hp + 16 * s) = w; } }
        if (tid < 32) {
            float t0 = -INFINITY, t1 = -INFINITY, t2 = -INFINITY, t3 = -INFINITY; int e0 = 0, e1 = 0, e2 = 0, e3 = 0;
#pragma unroll 4
            for (int e = 0; e < 32; ++e) { const float v = logit[tid * 33 + e];
                if (v > t3) { if (v > t2) { t3 = t2; e3 = e2; if (v > t1) { t2 = t1; e2 = e1; if (v > t0) { t1 = t0; e1 = e0; t0 = v; e0 = e; } else { t1 = v; e1 = e; } } else { t2 = v; e2 = e; } } else { t3 = v; e3 = e; } } }
            const float x1 = __expf(t1 - t0), x2 = __expf(t2 - t0), x3 = __expf(t3 - t0); const float inv = 1.0f / (1.0f + x1 + x2 + x3);
            const int rr = row0 + tid, lr = 32 * bi + tid;
            *(int4*)(TOPE + (size_t)rr * 4) = make_int4(e0, e1, e2, e3);
            *(f32x4*)(GATE + (size_t)rr * 4) = (f32x4){inv, x1 * inv, x2 * inv, x3 * inv};
            const int ee[4] = {e0, e1, e2, e3};
#pragma unroll
            for (int k = 0; k < 4; ++k) { const int lp = __hip_atomic_fetch_add(lcnt + ee[k], 1, __ATOMIC_RELAXED, __HIP_MEMORY_SCOPE_WORKGROUP); rec[2 * (lr * 4 + k)] = ee[k]; rec[2 * (lr * 4 + k) + 1] = lp; }
        }
    }
    __syncthreads();
    unsigned* gcnt = WSP(unsigned, WS_CTL) + CW_CNT + (l * 2 + cset) * 512;
    if (tid < 32) { const int c = lcnt[tid]; gbase[tid] = c ? (int)__hip_atomic_fetch_add(gcnt + tid * 16, (unsigned)c, __ATOMIC_RELAXED, __HIP_MEMORY_SCOPE_AGENT) : 0; }
    __syncthreads();
    int* ELIST = WSP(int, WS_ELIST); int* POS = WSP(int, WS_POS);
    for (int idx = tid; idx < nb * 128; idx += 512) { const int e = rec[2 * idx], pos = gbase[e] + rec[2 * idx + 1]; const int lr = idx >> 2; const int r = lr < 64 ? 64 * vcu + lr : NL + 32 * vcu + (lr - 64);
        ELIST[(size_t)e * NT + pos] = r; POS[(size_t)r * 4 + (idx & 3)] = pos; WSP(float, WS_SAL)[(size_t)e * NT + pos] = rowsa[lr]; }
    __syncthreads();
}
__device__ __forceinline__ void phase_requant(PK P, const LAS int* cumt, int gw, int lane) {
    const int nrows = cumt[32] * 256;
    const bf16_t* ACT = WSP(const bf16_t, WS_ACT); unsigned char* A8 = WSP(unsigned char, WS_ACT8); float* SAQ = WSP(float, WS_SAQ);
    for (int r = gw; r < nrows; r += 2048) {
        const u32x4 a = *(const u32x4*)(ACT + (size_t)r * D + 8 * lane), b = *(const u32x4*)(ACT + (size_t)r * D + 512 + 8 * lane);
        float v[16];
        v[0] = bf_lo(a.x); v[1] = bf_hi(a.x); v[2] = bf_lo(a.y); v[3] = bf_hi(a.y); v[4] = bf_lo(a.z); v[5] = bf_hi(a.z); v[6] = bf_lo(a.w); v[7] = bf_hi(a.w);
        v[8] = bf_lo(b.x); v[9] = bf_hi(b.x); v[10] = bf_lo(b.y); v[11] = bf_hi(b.y); v[12] = bf_lo(b.z); v[13] = bf_hi(b.z); v[14] = bf_lo(b.w); v[15] = bf_hi(b.w);
        float am = 0.f;
#pragma unroll
        for (int j = 0; j < 16; ++j) am = fmaxf(am, fabsf(v[j]));
        am = fmaxf(wave_max(am, lane), 1e-20f); const float inv = 127.0f / am;
        u32x2 w0, w1; w0.x = pk_i8x4(v[0], v[1], v[2], v[3], inv); w0.y = pk_i8x4(v[4], v[5], v[6], v[7], inv); w1.x = pk_i8x4(v[8], v[9], v[10], v[11], inv); w1.y = pk_i8x4(v[12], v[13], v[14], v[15], inv);
        *(u32x2*)(A8 + (size_t)r * D + 8 * lane) = w0; *(u32x2*)(A8 + (size_t)r * D + 512 + 8 * lane) = w1;
        if (lane == 0) SAQ[r] = am * (1.0f / 127.0f);
    }
}
__device__ __forceinline__ void phase_combine(PK P, LAS unsigned char* lds, int l, int nrows, int gw, int tid, bool dry) {
    const int lane = tid & 63;
    LAS unsigned char* misc = lds + MISC_OFF;
    moe_tables(misc, WSP(unsigned, WS_CTL) + CW_CNT + (l * 2 + ((MK_REP_MASK >> 11) & 1)) * 512, tid);
    const size_t dryoff = dry ? (WS_ACT - WS_XS) / 2 : 0;
    const LAS int* lbase = (const LAS int*)(misc + M_LBASE);
    const float* MOD = WSP(const float, WS_MOD); const float* g2 = MOD + (size_t)l * 9 * 6144 + 5120;
    bf16_t* XS = WSP(bf16_t, WS_XS); const bf16_t* YS = WSP(const bf16_t, WS_YS);
    const int* TOPE = WSP(const int, WS_TOPE); const int* POS = WSP(const int, WS_POS); const float* GATE = WSP(const float, WS_GATE);
    const bool last = (l == DEPTH - 1);
    for (int r = gw; r < nrows; r += 2048) {
        int slot = 0; float gate = 0.f;
        if (lane < 4) { slot = lbase[TOPE[(size_t)r * 4 + lane]] + POS[(size_t)r * 4 + lane]; gate = GATE[(size_t)r * 4 + lane]; }
        Row4 x; row_load_bf(x, XS + (size_t)r * D, lane);
        Row4 f;
#pragma unroll
        for (int j = 0; j < 4; ++j) f.v[j] = (f32x4){0.f, 0.f, 0.f, 0.f};
#pragma unroll
        for (int k = 0; k < 4; ++k) { const int sk = __builtin_amdgcn_readlane(slot, k); const float gk = __int_as_float(__builtin_amdgcn_readlane(__float_as_int(gate), k)); const bf16_t* yr = YS + (size_t)sk * D;
#pragma unroll
            for (int j = 0; j < 4; ++j) { const u32x2 w = *(const u32x2*)(yr + 4 * lane + 256 * j);
                f.v[j][0] += gk * bf_lo(w.x); f.v[j][1] += gk * bf_hi(w.x); f.v[j][2] += gk * bf_lo(w.y); f.v[j][3] += gk * bf_hi(w.y); } }
        const int rb = r < NL ? (r >> 11) : 8;
#pragma unroll
        for (int j = 0; j < 4; ++j) { const f32x4 gg = *(const f32x4*)(g2 + (size_t)rb * 6144 + 4 * lane + 256 * j); x.v[j] = x.v[j] + gg * f.v[j]; }
        const float rstd = row_rstd(x, lane);
        if (last) {
#pragma unroll
            for (int j = 0; j < 4; ++j) { const int c = 4 * lane + 256 * j; const f32x4 gn = *(const f32x4*)(P->in[8] + c); *(f32x4*)((dry ? WSP(float, WS_ACT) : P->out) + (size_t)r * D + c) = x.v[j] * rstd * gn; }
        } else {
            row_store_bf(x, XS + dryoff + (size_t)r * D, lane);
            Row4 hv; const float* mod = MOD + (size_t)(l + 1) * 9 * 6144 + (size_t)rb * 6144;
            if ((l + 1) % 3 == 2) norm_mod(x, rstd, P->in[6] + (size_t)(l + 1) * D, mod, mod + 1024, (dry ? WSP(bf16_t, WS_ACT + 80 * MiB) : WSP(bf16_t, WS_H)) + (size_t)r * D, lane, hv);
            else norm_mod8(x, rstd, P->in[6] + (size_t)(l + 1) * D, mod, mod + 1024, (dry ? WSP(unsigned char, WS_ACT + 80 * MiB) : WSP(unsigned char, WS_H)) + (size_t)r * D, (dry ? WSP(float, WS_ACT + 120 * MiB) : WSP(float, WS_SAH)) + r, lane);
        }
    }
}
__device__ __forceinline__ void phase_final_norm(PK P, int gw, int lane) {
    for (int r = gw; r < NL; r += 2048) { Row4 x; row_load_bf(x, WSP(const bf16_t, WS_XS) + (size_t)r * D, lane); const float rstd = row_rstd(x, lane);
#pragma unroll
        for (int j = 0; j < 4; ++j) { const int c = 4 * lane + 256 * j; const f32x4 gn = *(const f32x4*)(P->in[8] + c); *(f32x4*)(P->out + (size_t)r * D + c) = x.v[j] * rstd * gn; } }
}

__device__ __forceinline__ void conv_item(const float* src, int N, int nvalid, int k0, int n0, bf16_t* dst, int ldk, int drow0, int dk0, LAS unsigned* scr, int lane) {
    const int q = lane >> 4, nl = lane & 15, n = n0 + 4 * nl;
    f32x4 v[16];
#pragma unroll
    for (int r = 0; r < 16; ++r) { const int k = k0 + 8 * (r >> 1) + 2 * q + (r & 1);
        v[r] = (n < nvalid) ? __builtin_nontemporal_load((const f32x4*)(src + (size_t)k * N + n)) : (f32x4){0.f, 0.f, 0.f, 0.f}; }
#pragma unroll
    for (int rp = 0; rp < 8; ++rp)
#pragma unroll
        for (int i = 0; i < 4; ++i) { const int nn = 4 * nl + i, kw = 4 * rp + q; scr[nn * 32 + (kw ^ (4 * ((nn >> 2) & 7)))] = cvt_pk_bf16(v[2 * rp][i], v[2 * rp + 1][i]); }
    asm volatile("s_waitcnt lgkmcnt(0)" ::: "memory");
#pragma unroll
    for (int it = 0; it < 8; ++it) { const int nn = 8 * it + (lane >> 3), c = lane & 7;
        const u32x4 w = *(const LAS u32x4*)(scr + nn * 32 + 4 * (c ^ ((nn >> 2) & 7)));
        *(u32x4*)(dst + (size_t)(drow0 + nn) * ldk + dk0 + 8 * c) = w; }
    asm volatile("s_waitcnt lgkmcnt(0)" ::: "memory");
}
constexpr int CV_A_IN = 2 * 16 * 24, CV_A_OUT = 2 * 256, CV_B_IN = 16 * 48, CV_B_OUT = 256, CV_C_IN = 16 * 8, CV_C_UQ = 4 * 24, CV_C_UKV = 2 * 32, CV_C_OUT = 256;
constexpr int CV_SMALL = CV_A_IN + CV_A_OUT + CV_B_IN + CV_B_OUT + CV_C_IN + CV_C_UQ + CV_C_UKV + CV_C_OUT;
constexpr int CV_LAYER = NEXP * 3 * 256;
constexpr int CV_TOTAL = CV_SMALL + DEPTH * CV_LAYER;
constexpr int CV_CHUNK = 32;
__device__ __forceinline__ void conv_dispatch(PK P, int item, LAS unsigned* scr, int lane) {
    int r = item; const float* src; bf16_t* dst; int N, kb, nb, ldk = D, drow_off = 0, dk_off = 0;
    if (r < CV_A_IN) return;
    else if ((r -= CV_A_IN) < CV_A_OUT) { const int s = r / 256, it = r % 256; kb = it / 16; nb = it % 16; src = P->in[10] + (size_t)s * D * D; N = D; dst = WSP(bf16_t, WS_WA_OUT) + (size_t)s * D * D; }
    else if ((r -= CV_A_OUT) < CV_B_IN) return;
    else if ((r -= CV_B_IN) < CV_B_OUT) { kb = r / 16; nb = r % 16; src = P->in[13]; N = D; dst = WSP(bf16_t, WS_WB_OUT); }
    else if ((r -= CV_B_OUT) < CV_C_IN) { kb = r / 8; nb = r % 8; src = P->in[15]; N = C_IN; dst = WSP(bf16_t, WS_WC_IN); }
    else if ((r -= CV_C_IN) < CV_C_UQ) { kb = r / 24; nb = r % 24; src = P->in[18]; N = 1536; dst = WSP(bf16_t, WS_WC_UP); ldk = C_UPK; }
    else if ((r -= CV_C_UQ) < CV_C_UKV) { kb = r / 32; nb = r % 32; src = P->in[19]; N = 2048; dst = WSP(bf16_t, WS_WC_UP); ldk = C_UPK; drow_off = 1536; dk_off = 256; }
    else { r -= CV_C_UKV; kb = r / 16; nb = r % 16; src = P->in[20]; N = D; dst = WSP(bf16_t, WS_WC_OUT); }
    conv_item(src, N, N, 64 * kb, 64 * nb, dst, ldk, drow_off + 64 * nb, dk_off + 64 * kb, scr, lane);
}
__device__ __forceinline__ void conv_down_item(PK P, int L, int di, LAS unsigned* scr, int lane) {
    const int le = L * NEXP + (di >> 8), it = di & 255, kb = it >> 4, nb = it & 15;
    conv_item(P->in[27] + (size_t)le * D * D, D, D, 64 * kb, 64 * nb, WSP(bf16_t, WS_WD) + (size_t)le * D * D, D, 64 * nb, 64 * kb, scr, lane);
}
__device__ __forceinline__ void conv_q8_block(const float* src0, int N, unsigned char* dstq, float* dsts, LAS unsigned char* lds, int tid) {
    const int lane = tid & 63, wid = __builtin_amdgcn_readfirstlane(tid >> 6), q = lane >> 4, nl = lane & 15;
    const float* src = src0 + 4 * nl;
    f32x4 v[32];
#pragma unroll
    for (int r = 0; r < 32; ++r) { const int k = 128 * wid + 16 * (r >> 2) + 4 * q + (r & 3); v[r] = __builtin_nontemporal_load((const f32x4*)(src + (size_t)k * N)); }
    float cm[4] = {0.f, 0.f, 0.f, 0.f};
#pragma unroll
    for (int r = 0; r < 32; ++r)
#pragma unroll
        for (int i = 0; i < 4; ++i) cm[i] = fmaxf(cm[i], fabsf(v[r][i]));
    LAS float* cmx = (LAS float*)(lds + 65536);
#pragma unroll
    for (int i = 0; i < 4; ++i) { cm[i] = fmaxf(cm[i], shx(cm[i], 16, lane)); cm[i] = swap32_max(cm[i]); }
    if (q == 0) { *(LAS f32x4*)(cmx + wid * 64 + 4 * nl) = (f32x4){cm[0], cm[1], cm[2], cm[3]}; }
    __syncthreads();
    f32x4 a = *(const LAS f32x4*)(cmx + 4 * nl);
#pragma unroll
    for (int w = 1; w < 8; ++w) { const f32x4 b = *(const LAS f32x4*)(cmx + w * 64 + 4 * nl); a[0] = fmaxf(a[0], b[0]); a[1] = fmaxf(a[1], b[1]); a[2] = fmaxf(a[2], b[2]); a[3] = fmaxf(a[3], b[3]); }
    float inv[4];
#pragma unroll
    for (int i = 0; i < 4; ++i) { a[i] = fmaxf(a[i], 1e-30f); inv[i] = 127.0f / a[i]; }
    if (wid == 0 && q == 0) *(f32x4*)(dsts + 4 * nl) = a * (1.0f / 127.0f);
    LAS unsigned* scr = (LAS unsigned*)(lds + wid * 8192);
#pragma unroll
    for (int rp = 0; rp < 8; ++rp)
#pragma unroll
        for (int i = 0; i < 4; ++i) { const int nn = 4 * nl + i, kw = 4 * rp + q;
            scr[nn * 32 + (kw ^ (4 * ((nn >> 2) & 7)))] = pk_i8x4(v[4 * rp][i], v[4 * rp + 1][i], v[4 * rp + 2][i], v[4 * rp + 3][i], inv[i]); }
    asm volatile("s_waitcnt lgkmcnt(0)" ::: "memory");
    unsigned char* dst = dstq + 128 * wid;
#pragma unroll
    for (int it = 0; it < 8; ++it) { const int nn = 8 * it + (lane >> 3), c = lane & 7;
        const u32x4 w = *(const LAS u32x4*)(scr + nn * 32 + 4 * (c ^ ((nn >> 2) & 7)));
        *(u32x4*)(dst + (size_t)nn * D + 16 * c) = w; }
    __syncthreads();
}
__device__ __forceinline__ void conv_gu_block(PK P, LAS unsigned char* lds, int le, int which, int nb, int tid) {
    const int n0 = 64 * nb, drow0 = 256 * (n0 >> 7) + (n0 & 127) + (which ? 128 : 0);
    conv_q8_block(P->in[which ? 25 : 23] + (size_t)le * D * D + n0, D, WSP(unsigned char, WS_WGU) + ((size_t)le * 2048 + drow0) * D, WSP(float, WS_SBW) + (size_t)le * 2048 + drow0, lds, tid);
}
__device__ __forceinline__ void conv_in_block(PK P, LAS unsigned char* lds, int blk, int tid) {
    if (blk < 48) { const int s = blk / 24, nb = blk % 24;
        conv_q8_block(P->in[9] + (size_t)s * D * A_IN + 64 * nb, A_IN, WSP(unsigned char, WS_WA_IN) + ((size_t)s * A_IN + 64 * nb) * D, WSP(float, WS_SBI) + s * A_IN + 64 * nb, lds, tid); }
    else { const int nb = blk - 48;
        conv_q8_block(P->in[12] + 64 * nb, B_IN, WSP(unsigned char, WS_WB_IN) + (size_t)64 * nb * D, WSP(float, WS_SBI) + 2 * A_IN + 64 * nb, lds, tid); }
}
constexpr int CV_SLOTS = 1536;
__device__ __forceinline__ void conv_slot(PK P, LAS unsigned char* lds, int L, int s, int tid) {
    if (s < 1024) { conv_gu_block(P, lds, L * NEXP + (s >> 5), (s >> 4) & 1, s & 15, tid); return; }
    const int d = s - 1024, le = L * NEXP + (d >> 4), nb = d & 15;
    conv_q8_block(P->in[27] + (size_t)le * D * D + 64 * nb, D, WSP(unsigned char, WS_WD) + ((size_t)le * D + 64 * nb) * D, WSP(float, WS_SBD) + (size_t)le * D + 64 * nb, lds, tid);
}
__device__ __forceinline__ void conv_claim(PK P, LAS unsigned char* lds, int L, int quota, int tid) {
    LAS int* slot = (LAS int*)(lds + MISC_OFF + M_CVB);
    unsigned* ctr = WSP(unsigned, WS_CTL) + CW_CV + L * 16;
    for (int q = 0; q < quota; ++q) {
        __syncthreads();
        if (tid == 0) *slot = (int)__hip_atomic_fetch_add(ctr, 1u, __ATOMIC_RELAXED, __HIP_MEMORY_SCOPE_AGENT);
        __syncthreads();
        const int sl = __builtin_amdgcn_readfirstlane(*slot);
        if (sl >= CV_SLOTS) break;
        conv_slot(P, lds, L, sl, tid);
    }
    __syncthreads();
}
__device__ __forceinline__ void phase_prologue(PK P, LAS unsigned char* lds, int bid, int tid) {
    const int lane = tid & 63, wid = __builtin_amdgcn_readfirstlane(tid >> 6);
    {
        LAS float* S = (LAS float*)lds; LAS float* red = (LAS float*)(lds + 40960);
        for (int idx = tid; idx < 9 * D; idx += 512) { const int r = idx >> 10, d = idx & (D - 1); const float v = r < 8 ? P->in[1][r * D + d] : P->in[3][d];
            S[idx] = v / (1.0f + __builtin_amdgcn_exp2f(-v * LOG2E)); }
        __syncthreads();
        const int l = bid >> 6, c0 = (bid & 63) * 96;
        if (lane < 48) {
            float acc[9][2];
#pragma unroll
            for (int r = 0; r < 9; ++r) { acc[r][0] = 0.f; acc[r][1] = 0.f; }
            const float* wp = P->in[4] + ((size_t)l * D + 128 * wid) * 6144 + c0 + 2 * lane;
            const LAS float* sp = S + 128 * wid;
#pragma unroll 8
            for (int k = 0; k < 128; ++k) { const f32x2 w = *(const f32x2*)(wp + (size_t)k * 6144);
#pragma unroll
                for (int r = 0; r < 9; ++r) { const float s = sp[r * D + k]; acc[r][0] += s * w[0]; acc[r][1] += s * w[1]; } }
#pragma unroll
            for (int r = 0; r < 9; ++r) { red[(wid * 9 + r) * 96 + 2 * lane] = acc[r][0]; red[(wid * 9 + r) * 96 + 2 * lane + 1] = acc[r][1]; }
        }
        __syncthreads();
        float* MOD = WSP(float, WS_MOD);
        for (int idx = tid; idx < 9 * 96; idx += 512) { const int r = idx / 96, cc = idx % 96; float s = 0.f;
#pragma unroll
            for (int w = 0; w < 8; ++w) s += red[(w * 9 + r) * 96 + cc];
            MOD[((size_t)l * 9 + r) * 6144 + c0 + cc] = s + P->in[5][(size_t)l * 6144 + c0 + cc]; }
        __syncthreads();
    }
    {
        const int gt = bid * 512 + tid; float* RA = WSP(float, WS_ROPE_A); float* RC = WSP(float, WS_ROPE_C);
        const float L2T = 13.287712379549449f;
        for (int idx = gt; idx < SEQ * 32; idx += 131072) { const int t = idx >> 5, i = idx & 31; const float pos = (float)(i < 16 ? (t >> 6) : (t & 63));
            const float inv = __builtin_amdgcn_exp2f(-(float)(i & 15) * (1.0f / 16.0f) * L2T); const float ang = pos * inv; RA[2 * idx] = __cosf(ang); RA[2 * idx + 1] = __sinf(ang); }
        for (int idx = gt; idx < SEQ * 16; idx += 131072) { const int t = idx >> 4, i = idx & 15; const float pos = (float)(i < 8 ? (t >> 6) : (t & 63));
            const float inv = __builtin_amdgcn_exp2f(-(float)(i & 7) * (1.0f / 8.0f) * L2T); const float ang = pos * inv; RC[2 * idx] = __cosf(ang); RC[2 * idx + 1] = __sinf(ang); }
        bf16_t* WU = WSP(bf16_t, WS_WC_UP); const u32x4 z = (u32x4){0u, 0u, 0u, 0u};
        for (int idx = gt; idx < 1536 * 16; idx += 131072) *(u32x4*)(WU + (size_t)(idx >> 4) * C_UPK + 256 + 8 * (idx & 15)) = z;
        for (int idx = gt; idx < 2048 * 32; idx += 131072) *(u32x4*)(WU + (size_t)(1536 + (idx >> 5)) * C_UPK + 8 * (idx & 31)) = z;
    }
    {
        LAS unsigned* scr = (LAS unsigned*)(lds + wid * 8192);
        const int gw = bid * 8 + wid;
        for (int item = gw; item < CV_SMALL; item += 2048) conv_dispatch(P, item, scr, lane);
        __syncthreads();
        for (int blk = bid; blk < 96; blk += 256) conv_in_block(P, lds, blk, tid);
        for (int sl = bid; sl < CV_SLOTS; sl += 256) conv_slot(P, lds, 0, sl, tid);
    }
}

constexpr int PH_PRO = 0, PH_N0 = 1, PH_L0 = 2, PH_PER_LAYER = 9, PH_FINAL = PH_L0 + DEPTH * PH_PER_LAYER, NPH = PH_FINAL + 1;
enum { LP_IN = 0, LP_MLANORM = 1, LP_MLAUP = 2, LP_ATT = 3, LP_OUT = 4, LP_RT = 5, LP_GU = 6, LP_DN = 7, LP_CB = 8 };
struct Args { Ptrs P; int p_lo, p_hi, bar_idx, pad; };

__global__ void __launch_bounds__(512, 2) mk_fwd(Args a) {
    extern __shared__ __attribute__((aligned(16))) unsigned char lds_raw[];
    LAS unsigned char* const lds = (LAS unsigned char*)lds_raw;
    LAS unsigned char* const misc = lds + MISC_OFF;
    typedef const __attribute__((address_space(4))) Args* ArgsK;
    const ArgsK ak = (ArgsK)__builtin_amdgcn_kernarg_segment_ptr();
    (void)a;
    const int wid0 = __builtin_amdgcn_readfirstlane((int)threadIdx.x >> 6);
    if (wid0 == 0 && lane_id() < 4) ((LAS unsigned*)(misc + M_BARW))[lane_id()] = 0u;
    __syncthreads();
    XcdBarrier bar;
    { PK P = &ak->P; bar = xcd_barrier_post(WSP(unsigned, WS_CTL) + CW_BAR + ak->bar_idx * XCD_BAR_WORDS, (volatile LAS unsigned*)(misc + M_BARW), wid0 == 0); }
    bool ran = false;
    const int p_lo = ak->p_lo, p_hi = ak->p_hi;
#define PHASE_BEGIN(bit, p, cond) if ((((MK_MASK) >> (bit)) & 1) && p_lo <= (p) && (p) < p_hi && ((p) <= MK_STOP_AFTER || (p) == PH_FINAL) && (cond)) for (int rep_ = 0; rep_ < 1 + (((MK_REP_MASK) >> (bit)) & 1); ++rep_) { if (ran) xcd_barrier(bar); ran = true; \
    int tid = wid0 * 64 + lane_id(); asm volatile("" : "+v"(tid)); int bid = blockIdx.x; asm volatile("" : "+s"(bid)); ArgsK ak_ = ak; asm volatile("" : "+s"(ak_)); PK P = &ak_->P; \
    const int lane = tid & 63, wid = __builtin_amdgcn_readfirstlane(tid >> 6), vcu = (bid & 7) * 32 + (bid >> 3), gw = vcu * 8 + wid; (void)lane; (void)gw; (void)P;
#define PHASE_END }

    PHASE_BEGIN(0, PH_PRO, true) phase_prologue(P, lds, bid, tid); PHASE_END
    PHASE_BEGIN(1, PH_N0, true) phase_first_norm(P, gw, lane); PHASE_END

    for (int l = 0; l < DEPTH; ++l) {
        const int kind = l % 3, slot = l / 3, pb = PH_L0 + l * PH_PER_LAYER;
        const bool last = (l == DEPTH - 1);
        const int nMrows = last ? NL / 256 : NT / 256;
        PHASE_BEGIN(2, pb + LP_IN, kind == 0) {
            pg8::Gemm g{WSP(const void, WS_H), WSP(const unsigned char, WS_WA_IN) + (size_t)slot * A_IN * D, D, 0, nullptr};
            pg8::DenseOrder S{nMrows, 6, vcu, last ? 8 : 0, 4, 2};
            pg8::EpiQkvA8 E{WSP(bf16_t, WS_QKV), WSP(const float, WS_ROPE_A), WSP(const float, WS_SAH), WSP(const float, WS_SBI) + slot * A_IN};
            pg8::gemm_phase<pg8::EpiQkvA8, pg8::DenseOrder, false, true>(lds, g, S, E, tid);
            if (l >= 1 && S.short_one()) conv_claim(P, lds, l, MK_Q_IN, tid);
        } PHASE_END
        PHASE_BEGIN(3, pb + LP_IN, kind == 1) {
            pg8::Gemm g{WSP(const void, WS_H), WSP(const unsigned char, WS_WB_IN), D, 0, nullptr};
            pg8::DenseOrder S{NT / 256, 12, vcu, 0, 0, 0};
            pg8::EpiBf16Plain8 E{WSP(bf16_t, WS_QKV), B_IN, 4, 0.125f * LOG2E, WSP(const float, WS_SAH), WSP(const float, WS_SBI) + 2 * A_IN};
            pg8::gemm_phase<pg8::EpiBf16Plain8, pg8::DenseOrder, false, true>(lds, g, S, E, tid);
            if (S.short_one()) conv_claim(P, lds, l, MK_Q_IN, tid);
        } PHASE_END
        PHASE_BEGIN(4, pb + LP_IN, kind == 2) {
            pg8::Gemm g{WSP(const bf16_t, WS_H), WSP(const bf16_t, WS_WC_IN), D, 0, nullptr};
            pg8::DenseOrder S{NT / 256, 2, vcu, 0, 0, 0};
            pg8::EpiF32Plain E{WSP(float, WS_Y416), C_INP};
            pg8::gemm_phase<pg8::EpiF32Plain, pg8::DenseOrder, false>(lds, g, S, E, tid);
        } PHASE_END
        PHASE_BEGIN(5, pb + LP_MLANORM, kind == 2) phase_mla_norm(P, gw, lane); PHASE_END
        PHASE_BEGIN(6, pb + LP_MLAUP, kind == 2) {
            pg8::Gemm g{WSP(const bf16_t, WS_CQKV), WSP(const bf16_t, WS_WC_UP), C_UPK, 0, nullptr};
            pg8::DenseOrder S{NT / 256, 14, vcu, 0, 0, 0};
            pg8::EpiMlaUp E{WSP(bf16_t, WS_QKV), WSP(const float, WS_ROPE_C)};
            pg8::gemm_phase<pg8::EpiMlaUp, pg8::DenseOrder, false>(lds, g, S, E, tid);
        } PHASE_END
        PHASE_BEGIN(7, pb + LP_ATT, kind == 0) {
            const bf16_t* QKV = WSP(const bf16_t, WS_QKV); bf16_t* O = WSP(bf16_t, WS_O); const float* sink = P->in[11] + slot * 16;
            for (int u = vcu; u < 1024; u += 256) { const int bk = u >> 5; att::attn_A_unit(lds, QKV, O, sink, bk >> 2, bk & 3, u & 31, false, tid); }
            if (!last) for (int u = vcu; u < 128; u += 256) { const int bk = u >> 2; att::attn_A_unit(lds, QKV, O, sink, bk >> 2, bk & 3, u & 3, true, tid); }
        } PHASE_END
        PHASE_BEGIN(8, pb + LP_ATT, kind == 1) {
            const bf16_t* QKV = WSP(const bf16_t, WS_QKV); bf16_t* O = WSP(bf16_t, WS_O); LAS float* tab = (LAS float*)(misc + M_RPB);
            for (int u = vcu; u < 1024; u += 256) { const int bh = u >> 3; att::attn_B_unit(lds, tab, QKV, O, P->in[14], bh >> 4, bh & 15, u & 7, false, tid); }
            for (int u = vcu; u < 128; u += 256) att::attn_B_unit(lds, tab, QKV, O, P->in[14], u >> 4, u & 15, 0, true, tid);
        } PHASE_END
        PHASE_BEGIN(9, pb + LP_ATT, kind == 2) {
            const bf16_t* QKV = WSP(const bf16_t, WS_QKV); bf16_t* O = WSP(bf16_t, WS_O); const bf16_t* KR = WSP(const bf16_t, WS_KR);
            for (int u = vcu; u < 1024; u += 256) { const int bh = u >> 3; att::attn_C_unit(lds, QKV, KR, O, bh >> 4, bh & 15, u & 7, false, tid); }
            for (int u = vcu; u < 128; u += 256) att::attn_C_unit(lds, QKV, KR, O, u >> 4, u & 15, 0, true, tid);
        } PHASE_END
        PHASE_BEGIN(10, pb + LP_OUT, true) {
            const bf16_t* W = kind == 0 ? WSP(const bf16_t, WS_WA_OUT) + (size_t)slot * D * D : (kind == 1 ? WSP(const bf16_t, WS_WB_OUT) : WSP(const bf16_t, WS_WC_OUT));
            pg8::Gemm g{WSP(const bf16_t, WS_O), W, D, 0, nullptr};
            pg8::DenseOrder S{nMrows, 4, vcu, 0, 0, 0};
            pg8::EpiResid E{WSP(bf16_t, WS_XS), WSP(const float, WS_MOD) + (size_t)l * 9 * 6144 + 2048, (rep_ + 1 < 1 + ((MK_REP_MASK >> 10) & 1)) ? WSP(bf16_t, WS_ACT) : WSP(bf16_t, WS_XS)};
            pg8::gemm_phase<pg8::EpiResid, pg8::DenseOrder, false>(lds, g, S, E, tid);
            if (!last && S.short_one()) conv_claim(P, lds, l + 1, MK_Q_OUT, tid);
        } PHASE_END
        PHASE_BEGIN(11, pb + LP_RT, true) { if (l >= 1) conv_claim(P, lds, l, 1 << 30, tid); phase_router(P, lds, l, last ? NL : NT, vcu, tid, rep_); } PHASE_END
        PHASE_BEGIN(12, pb + LP_GU, true) {
            moe_tables(misc, WSP(unsigned, WS_CTL) + CW_CNT + (l * 2 + ((MK_REP_MASK >> 11) & 1)) * 512, tid);
            pg8::Gemm g{WSP(const void, WS_H), WSP(const unsigned char, WS_WGU) + (size_t)l * NEXP * 2 * D * D, D, (size_t)2 * D * D, WSP(const int, WS_ELIST)};
            const bool cvw = !last && MK_CVW_GU > 0 && (vcu & 15) == 15;
            const int Gc = (!last && MK_CVW_GU > 0) ? 240 : 256, ic = (!last && MK_CVW_GU > 0) ? (cvw ? -1 : vcu - (vcu >> 4)) : vcu;
            pg8::MoeOrder S{(const LAS int*)(misc + M_ECNT), (const LAS int*)(misc + M_LBASE), (const LAS int*)(misc + M_CUMT), 8, ic, Gc, (LAS int*)(misc + M_UL)}; S.build(tid);
            pg8::EpiSwiglu8 E{WSP(bf16_t, WS_ACT), P->in[24] + (size_t)l * NEXP * D, P->in[26] + (size_t)l * NEXP * D, WSP(const float, WS_SAL), WSP(const float, WS_SBW) + (size_t)l * NEXP * 2048};
            pg8::gemm_phase<pg8::EpiSwiglu8, pg8::MoeOrder, true, true>(lds, g, S, E, tid);
            if (!last && (cvw || S.short_one())) conv_claim(P, lds, l + 1, cvw ? MK_CVW_GU : MK_Q_GU, tid);
        } PHASE_END
        PHASE_BEGIN(13, pb + LP_DN, true) {
            moe_tables(misc, WSP(unsigned, WS_CTL) + CW_CNT + (l * 2 + ((MK_REP_MASK >> 11) & 1)) * 512, tid);
            phase_requant(P, (const LAS int*)(misc + M_CUMT), gw, lane);
            xcd_barrier(bar);
            const bool cvw = !last && MK_CVW_DN > 0 && (vcu & 15) == 15;
            const int Gc = (!last && MK_CVW_DN > 0) ? 240 : 256, ic = (!last && MK_CVW_DN > 0) ? (cvw ? -1 : vcu - (vcu >> 4)) : vcu;
            pg8::Gemm g{WSP(const void, WS_ACT8), WSP(const unsigned char, WS_WD) + (size_t)l * NEXP * D * D, D, (size_t)D * D, nullptr};
            pg8::MoeOrder S{(const LAS int*)(misc + M_ECNT), (const LAS int*)(misc + M_LBASE), (const LAS int*)(misc + M_CUMT), 4, ic, Gc, (LAS int*)(misc + M_UL)}; S.build(tid);
            pg8::EpiDown8 E{WSP(bf16_t, WS_YS), P->in[28] + (size_t)l * NEXP * D, WSP(const float, WS_SAQ), WSP(const float, WS_SBD) + (size_t)l * NEXP * D};
            pg8::gemm_phase<pg8::EpiDown8, pg8::MoeOrder, false, true>(lds, g, S, E, tid);
            if (!last && (cvw || S.short_one())) conv_claim(P, lds, l + 1, cvw ? MK_CVW_DN : MK_Q_DN, tid);
        } PHASE_END
        PHASE_BEGIN(14, pb + LP_CB, true) phase_combine(P, lds, l, last ? NL : NT, gw, tid, (rep_ + 1 < 1 + ((MK_REP_MASK >> 14) & 1))); PHASE_END
    }
    PHASE_BEGIN(15, PH_FINAL, MK_STOP_AFTER < PH_FINAL - 1) phase_final_norm(P, gw, lane); PHASE_END
#undef PHASE_BEGIN
#undef PHASE_END
}

extern "C" void kernel_launch(void* const* d_in, const int* in_sizes, int n_in, void* d_out, int out_size, void* d_ws, size_t ws_size, hipStream_t stream) {
    static int grid = 0;
    if (grid == 0) {
        if (n_in != 29 || out_size != NL * D || ws_size < WS_END) { fprintf(stderr, "kernel_launch: expected 29 inputs, out %d, ws >= %zu; got n_in %d out %d ws %zu\n", NL * D, (size_t)WS_END, n_in, out_size, ws_size); grid = -1; return; }
        int dev = 0, cus = 0, per_cu = 0;
        if (hipGetDevice(&dev) != hipSuccess || hipDeviceGetAttribute(&cus, hipDeviceAttributeMultiprocessorCount, dev) != hipSuccess) { grid = -1; return; }
        if (hipFuncSetAttribute((const void*)mk_fwd, hipFuncAttributeMaxDynamicSharedMemorySize, LDS_BYTES) != hipSuccess) { fprintf(stderr, "kernel_launch: hipFuncSetAttribute failed\n"); grid = -1; return; }
        if (hipOccupancyMaxActiveBlocksPerMultiprocessor(&per_cu, (const void*)mk_fwd, 512, LDS_BYTES) != hipSuccess || per_cu < 1) fprintf(stderr, "kernel_launch: occupancy query says %d\n", per_cu);
        (void)hipGetLastError();
        grid = 256;
        if (cus < 256) { fprintf(stderr, "kernel_launch: needs 256 CUs, device has %d\n", cus); grid = -1; return; }
    }
    if (grid < 0) return;
    if (hipMemsetAsync((char*)d_ws + WS_CTL, 0, CTL_BYTES, stream) != hipSuccess) return;
    Args a{};
    for (int i = 0; i < 29; ++i) a.P.in[i] = (const float*)d_in[i];
    a.P.out = (float*)d_out; a.P.ws = (unsigned char*)d_ws; a.pad = 0;
#if MK_PER_PHASE
    for (int p = 0; p < NPH; ++p) { a.p_lo = p; a.p_hi = p + 1; a.bar_idx = 0; hipLaunchKernelGGL(mk_fwd, dim3(grid), dim3(512), LDS_BYTES, stream, a); }
#else
    a.p_lo = 0; a.p_hi = NPH; a.bar_idx = 0;
    hipLaunchKernelGGL(mk_fwd, dim3(grid), dim3(512), LDS_BYTES, stream, a);
#endif
    const hipError_t le = hipPeekAtLastError();
    if (le != hipSuccess) fprintf(stderr, "kernel_launch: launch failed: %s\n", hipGetErrorName(le));
}
```

```cpp
#include <hip/hip_runtime.h>
#include <cstdio>
#include <cstdint>

#ifndef MK_PER_PHASE
#define MK_PER_PHASE 0
#endif
#ifndef MK_MASK
#define MK_MASK 0xFFFF
#endif
#ifndef MK_REP_MASK
#define MK_REP_MASK 0
#endif
#ifndef MK_Q_OUT
#define MK_Q_OUT 1
#endif
#ifndef MK_Q_GU
#define MK_Q_GU 1
#endif
#ifndef MK_Q_DN
#define MK_Q_DN 1
#endif
#ifndef MK_Q_IN
#define MK_Q_IN 1
#endif
#ifndef MK_MT_MAJOR
#define MK_MT_MAJOR 1
#endif
#ifndef MK_CVW_GU
#define MK_CVW_GU 0
#endif
#ifndef MK_CVW_DN
#define MK_CVW_DN 0
#endif
#ifndef MK_STOP_AFTER
#define MK_STOP_AFTER 9999
#endif

#define LAS __attribute__((address_space(3)))
#define GAS __attribute__((address_space(1)))
typedef unsigned short bf16_t;
typedef short bf16x8 __attribute__((ext_vector_type(8)));
typedef short s16x4 __attribute__((ext_vector_type(4)));
typedef _Float16 f16x8 __attribute__((ext_vector_type(8)));
typedef _Float16 f16x2 __attribute__((ext_vector_type(2)));
typedef float f32x2 __attribute__((ext_vector_type(2)));
typedef float f32x4 __attribute__((ext_vector_type(4)));
typedef float f32x16 __attribute__((ext_vector_type(16)));
typedef unsigned u32x2 __attribute__((ext_vector_type(2)));
typedef unsigned u32x4 __attribute__((ext_vector_type(4)));
typedef int i32x4 __attribute__((ext_vector_type(4)));

constexpr int D = 1024, NB = 8, SEQ = 2048, CTXL = 256, DEPTH = 4;
constexpr int NL = NB * SEQ;
constexpr int NC = NB * CTXL;
constexpr int NT = NL + NC;
constexpr int NEXP = 32, TOPK = 4;
constexpr int MAXSLOT = 81920;
constexpr float NORM_EPS = 1e-6f;
constexpr float LOG2E = 1.4426950408889634f;
constexpr int A_IN = 1536, B_IN = 3072, C_IN = 416, C_INP = 512, C_UPK = 384, C_UPN = 3584;

constexpr size_t MiB = 1u << 20;
constexpr size_t WS_CTL = 0, CTL_BYTES = 1 * MiB;
constexpr size_t WS_MOD = 1 * MiB;
constexpr size_t WS_ROPE_A = 2 * MiB;
constexpr size_t WS_ROPE_C = 2 * MiB + 512 * 1024;
constexpr size_t WS_TOPE = 3 * MiB;
constexpr size_t WS_POS = 3 * MiB + 512 * 1024;
constexpr size_t WS_GATE = 4 * MiB;
constexpr size_t WS_ELIST = 5 * MiB;
constexpr size_t WS_KR = 8 * MiB;
constexpr size_t WS_CQKV = 10 * MiB;
constexpr size_t WS_Y416 = 24 * MiB;
constexpr size_t WS_XS = 60 * MiB;
constexpr size_t WS_H = 132 * MiB;
constexpr size_t WS_O = 168 * MiB;
constexpr size_t WS_QKV = 204 * MiB;
constexpr size_t WS_ACT = 330 * MiB;
constexpr size_t WS_YS = 490 * MiB;
constexpr size_t WS_WA_IN = 650 * MiB;
constexpr size_t WS_WA_OUT = 656 * MiB;
constexpr size_t WS_WB_IN = 660 * MiB;
constexpr size_t WS_WB_OUT = 666 * MiB;
constexpr size_t WS_WC_IN = 668 * MiB;
constexpr size_t WS_WC_UP = 669 * MiB;
constexpr size_t WS_WC_OUT = 672 * MiB;
constexpr size_t WS_WGU = 676 * MiB;
constexpr size_t WS_WD = 1188 * MiB;
constexpr size_t WS_G16 = 1444 * MiB;
constexpr size_t WS_RC = 1447 * MiB;
constexpr size_t WS_SBW = 1448 * MiB;
constexpr size_t WS_SAL = 1449 * MiB;
constexpr size_t WS_SAH = 1452 * MiB;
constexpr size_t WS_SBI = 1452 * MiB + 128 * 1024;
constexpr size_t WS_ACT8 = 1453 * MiB;
constexpr size_t WS_SAQ = 1533 * MiB;
constexpr size_t WS_SBD = 1533 * MiB + 512 * 1024;
constexpr size_t WS_END = 1535 * MiB;

constexpr int CW_CV = 512;
constexpr int CW_CNT = 1024;
constexpr int CW_BAR = 65536;

constexpr int RING_BYTES = 131072;
constexpr int MISC_OFF = RING_BYTES;
constexpr int M_BARW = 0, M_LCNT = 64, M_LBASE = 192, M_CUMT = 320, M_ECNT = 512, M_GBASE = 640, M_CVB = 768, M_UL = 6656, M_RSA = 7424, M_EPF = 8192, M_RPB = 1024, M_REC = 3072;
constexpr int LDS_BYTES = 147456;

#define XB_TMO      128
#define XB_XCNT(j)  (256  + 64 * (j))
#define XB_XSUB(j)  (1280 + 64 * (j))
#define XB_XGEN(j)  (2304 + 64 * (j))
#define XB_TOP      3328
#define XB_TOPGEN   3392
#define XCD_BAR_WORDS 3456
#define XB_SPIN_CAP (1u << 18)

__device__ __forceinline__ unsigned xb_ld(unsigned* p)              { return __hip_atomic_load(p, __ATOMIC_RELAXED, __HIP_MEMORY_SCOPE_AGENT); }
__device__ __forceinline__ unsigned xb_add(unsigned* p, unsigned v) { return __hip_atomic_fetch_add(p, v, __ATOMIC_RELAXED, __HIP_MEMORY_SCOPE_AGENT); }
__device__ __forceinline__ unsigned xb_xcc_id() { return (unsigned)__builtin_amdgcn_s_getreg((3 << 11) | 20) & 0xFu; }
#define XB_SPIN(cond, bar) do { unsigned _sp = 0; while (cond) { __builtin_amdgcn_s_sleep(1); \
    if ((++_sp & 255u) == 0u) { if (xb_ld(&(bar)[XB_TMO])) break; if (_sp > XB_SPIN_CAP) { atomicAdd(&(bar)[XB_TMO], 1u); break; } } } } while (0)

__device__ __forceinline__ int lane_id() { int r; asm volatile("v_mbcnt_lo_u32_b32 %0, -1, 0\n\tv_mbcnt_hi_u32_b32 %0, -1, %0" : "=v"(r)); return r; }
struct XcdBarrier {
    unsigned* bar; unsigned x;
    volatile LAS unsigned* st;
    bool lead;
};
__device__ __forceinline__ XcdBarrier xcd_barrier_post(unsigned* bar, volatile LAS unsigned* st, bool lead) {
    XcdBarrier b; b.bar = bar; b.x = xb_xcc_id(); b.st = st; b.lead = lead;
    if (lead && lane_id() == 0) (void)xb_add(&bar[XB_XCNT(b.x)], 1u);
    return b;
}
__device__ __forceinline__ void xcd_barrier_complete(unsigned* bar, unsigned x, unsigned& nloc, unsigned& nx) {
    const unsigned G = gridDim.x * gridDim.y * gridDim.z;
    unsigned sum, cnt, mine, sp = 0u;
    for (;;) {
        sum = 0u; cnt = 0u; mine = 0u;
#pragma unroll
        for (unsigned j = 0; j < 16; ++j) { const unsigned c = xb_ld(&bar[XB_XCNT(j)]); sum += c; cnt += (c > 0u) ? 1u : 0u; mine = (j == x) ? c : mine; }
        if (sum == G) break;
        __builtin_amdgcn_s_sleep(1);
        if ((++sp & 255u) == 0u) { if (xb_ld(&bar[XB_TMO])) break; if (sp > XB_SPIN_CAP) { atomicAdd(&bar[XB_TMO], 1u); break; } }
    }
    nloc = mine > 0u ? mine : 1u; nx = cnt > 0u ? cnt : 1u;
}
__device__ __forceinline__ void xcd_barrier(const XcdBarrier& b) {
    asm volatile("s_waitcnt vmcnt(0)" ::: "memory");
    __syncthreads();
    if (b.lead && lane_id() == 0) {
        unsigned* bar = b.bar;
        __builtin_amdgcn_s_waitcnt(0);
        unsigned nloc = b.st[0], nx = b.st[1];
        if (nloc == 0u) { xcd_barrier_complete(bar, b.x, nloc, nx); b.st[0] = nloc; b.st[1] = nx; }
        const unsigned old = xb_add(&bar[XB_XSUB(b.x)], 1u);
        const unsigned gen = old / nloc;
        if (old + 1u == (gen + 1u) * nloc) {
            __builtin_amdgcn_fence(__ATOMIC_RELEASE, "agent");
            asm volatile("s_waitcnt vmcnt(0)" ::: "memory");
            const unsigned og = xb_add(&bar[XB_TOP], 1u);
            const unsigned tg = og / nx;
            if (og + 1u == (tg + 1u) * nx) xb_add(&bar[XB_TOPGEN], 1u);
            else XB_SPIN(xb_ld(&bar[XB_TOPGEN]) == tg, bar);
            __builtin_amdgcn_fence(__ATOMIC_ACQUIRE, "agent");
            xb_add(&bar[XB_XGEN(b.x)], 1u);
            asm volatile("s_waitcnt vmcnt(0)" ::: "memory");
        } else {
            XB_SPIN(xb_ld(&bar[XB_XGEN(b.x)]) == gen, bar);
            __builtin_amdgcn_fence(__ATOMIC_ACQUIRE, "agent");
            asm volatile("s_waitcnt vmcnt(0)" ::: "memory");
        }
    }
    __syncthreads();
}

__device__ __forceinline__ unsigned cvt_pk_bf16(float lo, float hi) { unsigned r; asm volatile("v_cvt_pk_bf16_f32 %0, %1, %2" : "=v"(r) : "v"(lo), "v"(hi)); return r; }
__device__ __forceinline__ float bf_lo(unsigned w) { return __uint_as_float(w << 16); }
__device__ __forceinline__ float bf_hi(unsigned w) { return __uint_as_float(w & 0xffff0000u); }
__device__ __forceinline__ float shx(float v, int mask, int lane) { return __int_as_float(__builtin_amdgcn_ds_bpermute((lane ^ mask) << 2, __float_as_int(v))); }
__device__ __forceinline__ float wave_sum(float v, int lane) {
#pragma unroll
    for (int o = 1; o < 64; o <<= 1) v += shx(v, o, lane);
    return v;
}
__device__ __forceinline__ float wave_max(float v, int lane) {
#pragma unroll
    for (int o = 1; o < 64; o <<= 1) v = fmaxf(v, shx(v, o, lane));
    return v;
}
__device__ __forceinline__ float swap32_max(float m) { auto rr = __builtin_amdgcn_permlane32_swap(__float_as_uint(m), __float_as_uint(m), false, false); return fmaxf(__uint_as_float(rr[0]), __uint_as_float(rr[1])); }
__device__ __forceinline__ float swap32_sum(float m) { auto rr = __builtin_amdgcn_permlane32_swap(__float_as_uint(m), __float_as_uint(m), false, false); return __uint_as_float(rr[0]) + __uint_as_float(rr[1]); }

namespace pg8 {
constexpr int BM = 256, BK = 64, HALF = 128, HTB = HALF * BK * 2, STAGE_BYTES = 8 * HTB;
__host__ __device__ __forceinline__ int lds_byte(int r, int c) { const int st = (r >> 4) * 2 + (c >> 5), rr = r & 15, cc = c & 31, ob = rr * 64 + cc * 2; return st * 1024 + (ob ^ (((ob >> 9) & 1) << 5)); }
__host__ __device__ __forceinline__ void stage_rc(int b, int& R, int& C) { const int st = b / 1024, sb = b % 1024, swz = sb ^ (((sb >> 9) & 1) << 5); R = (st >> 1) * 16 + swz / 64; C = (st & 1) * 32 + (swz % 64) / 2; }
__host__ __device__ __forceinline__ int perm32(int rho) { const int n = rho >> 4, i = rho & 15; return 8 * (i >> 2) + 4 * n + (i & 3); }

struct Unit { int pm, pn, e, mt, cnt; };
struct Gemm { const void* A; const void* Bt; int K; size_t bstride; const int* list; };

template <bool I8> struct AccSel { typedef f32x4 type; };
template <> struct AccSel<true> { typedef i32x4 type; };
template <class Epi, class Sched, bool GATHER, bool I8 = false>
__device__ __forceinline__ void gemm_phase(LAS unsigned char* lds, const Gemm g, const Sched& S, const Epi& E, const int tid) {
    const int wid = __builtin_amdgcn_readfirstlane(tid >> 6), lane = tid & 63, wr = wid >> 2, wc = wid & 3, fr = lane & 15, fq = lane >> 4;
    typedef typename AccSel<I8>::type acc_t;
    const int K = g.K, RB = I8 ? K : 2 * K, nt = RB / (BK * 2);
    unsigned voffA[2], voffB[2];
#pragma unroll
    for (int i = 0; i < 2; ++i) { int R, C; stage_rc(tid * 16 + i * 8192, R, C); const int Rb = Epi::PERM ? ((R & ~31) + perm32(R & 31)) : R;
        voffA[i] = (unsigned)(R * RB + C * 2); voffB[i] = (unsigned)(Rb * RB + C * 2); }
#define PG8_RC(i, R_, C_) int R_, C_; { int _t = tid; asm volatile("" : "+v"(_t)); stage_rc(_t * 16 + (i) * 8192, R_, C_); }
    const size_t kstep = (size_t)(BK * 2);
    const size_t hstep = (size_t)HALF * RB;
    const size_t tstep = 2 * hstep;
    const unsigned ldsw = (unsigned)wid * 1024u;
    const int aoff = lds_byte(wr * 64 + fr, fq * 8), boff = lds_byte(wc * 32 + fr, fq * 8);
#define PG8_SA(b, h) (((b) * 2 + (h)) * HTB)
#define PG8_SB(b, h) ((4 + (b) * 2 + (h)) * HTB)
#define PG8_STAGE(bufoff, gbase, voff) do { _Pragma("unroll") for (int _i = 0; _i < 2; ++_i) \
        __builtin_amdgcn_global_load_lds((const unsigned*)((const char*)(gbase) + (voff)[_i]), (LAS unsigned*)(lds + (bufoff) + ldsw + _i * 8192), 16, 0, 0); } while (0)
#define PG8_STAGE_A(bufoff, SELN, H, KOFF) do { if constexpr (GATHER) { unsigned _vo[2]; _vo[0] = (SELN) ? voN[H][0] : voC[H][0]; _vo[1] = (SELN) ? voN[H][1] : voC[H][1]; \
            PG8_STAGE(bufoff, (const char*)g.A + (KOFF), _vo); } else { PG8_STAGE(bufoff, ((SELN) ? nA : cA) + (H) * hstep + (KOFF), voffA); } } while (0)
#define PG8_LDA(dst, b, h) do { _Pragma("unroll") for (int m = 0; m < 4; ++m) _Pragma("unroll") for (int k = 0; k < 2; ++k) dst[m][k] = *(const LAS bf16x8*)(lds + PG8_SA(b, h) + aoff + m * 2048 + k * 1024); } while (0)
#define PG8_LDB(dst, b, h) do { _Pragma("unroll") for (int n = 0; n < 2; ++n) _Pragma("unroll") for (int k = 0; k < 2; ++k) dst[n][k] = *(const LAS bf16x8*)(lds + PG8_SB(b, h) + boff + n * 2048 + k * 1024); } while (0)
#define PG8_MMA(ai, bj, At, Bt) do { __builtin_amdgcn_s_setprio(1); _Pragma("unroll") for (int m = 0; m < 4; ++m) _Pragma("unroll") for (int n = 0; n < 2; ++n) _Pragma("unroll") for (int k = 0; k < 2; ++k) \
        { if constexpr (I8) acc[ai][bj][m][n] = __builtin_amdgcn_mfma_i32_16x16x64_i8(__builtin_bit_cast(i32x4, Bt[n][k]), __builtin_bit_cast(i32x4, At[m][k]), acc[ai][bj][m][n], 0, 0, 0); \
          else acc[ai][bj][m][n] = __builtin_amdgcn_mfma_f32_16x16x32_bf16(Bt[n][k], At[m][k], acc[ai][bj][m][n], 0, 0, 0); } __builtin_amdgcn_s_setprio(0); } while (0)
#define PG8_WAIT_V(n) asm volatile("s_waitcnt vmcnt(" #n ")" ::: "memory")
#define PG8_WAIT_L(n) asm volatile("s_waitcnt lgkmcnt(" #n ")" ::: "memory")
#define PG8_BAR __builtin_amdgcn_s_barrier()
#define PG8_SCHED __builtin_amdgcn_sched_barrier(0)
#define PG8_GATH(U, VO) do { _Pragma("unroll") for (int _h = 0; _h < 2; ++_h) _Pragma("unroll") for (int _i = 0; _i < 2; ++_i) { \
        PG8_RC(_i, _R, _C); int _r = (U).mt * 256 + _h * 128 + _R; _r = _r < (U).cnt ? _r : 0; const int _tok = g.list[(size_t)(U).e * NT + _r]; VO[_h][_i] = (unsigned)(_tok * RB + _C * 2); } } while (0)
    Unit cur, nxt; int ui = 0;
    if (!S.next(0, cur)) return;
    acc_t acc[2][2][4][2];
#pragma unroll
    for (int a = 0; a < 2; ++a)
#pragma unroll
        for (int b = 0; b < 2; ++b)
#pragma unroll
            for (int m = 0; m < 4; ++m)
#pragma unroll
                for (int n = 0; n < 2; ++n) acc[a][b][m][n] = (acc_t){0, 0, 0, 0};
    bf16x8 At[4][2], B0[2][2], B1[2][2];
    unsigned voC[2][2] = {{0u, 0u}, {0u, 0u}}, voN[2][2] = {{0u, 0u}, {0u, 0u}};
    if constexpr (GATHER) { PG8_GATH(cur, voC); }
    const char* cA = GATHER ? (const char*)g.A : (const char*)g.A + (size_t)cur.pm * tstep;
    const size_t bsb = I8 ? g.bstride : 2 * g.bstride;
    const char* cB = (const char*)g.Bt + (size_t)cur.e * bsb + (size_t)cur.pn * tstep;
    const char* nA = cA; const char* nB = cB;
    PG8_STAGE(PG8_SB(0, 0), cB, voffB); PG8_STAGE(PG8_SB(0, 1), cB + hstep, voffB); PG8_STAGE_A(PG8_SA(0, 0), false, 0, 0); PG8_STAGE_A(PG8_SA(0, 1), false, 1, 0);
    if (wr == 1) PG8_BAR;
    PG8_WAIT_V(2); PG8_BAR;
    PG8_STAGE(PG8_SB(1, 0), cB + kstep, voffB); PG8_STAGE_A(PG8_SA(1, 0), false, 0, kstep); PG8_STAGE(PG8_SB(1, 1), cB + hstep + kstep, voffB);
    PG8_WAIT_V(6); PG8_BAR;
    for (;;) {
        const bool has_next = S.next(ui + 1, nxt);
        nA = GATHER ? (const char*)g.A : (has_next ? (const char*)g.A + (size_t)nxt.pm * tstep : cA);
        nB = has_next ? (const char*)g.Bt + (size_t)nxt.e * bsb + (size_t)nxt.pn * tstep : cB;
        int tokN[2][2] = {{0, 0}, {0, 0}};
        if constexpr (GATHER) { if (has_next) {
#pragma unroll
            for (int _h = 0; _h < 2; ++_h)
#pragma unroll
                for (int _i = 0; _i < 2; ++_i) { PG8_RC(_i, _R, _C); (void)_C; int _r = nxt.mt * 256 + _h * 128 + _R; _r = _r < nxt.cnt ? _r : 0; const int* _p = g.list + (size_t)nxt.e * NT + _r;
                    asm volatile("global_load_dword %0, %1, off" : "=v"(tokN[_h][_i]) : "v"(_p) : "memory"); } } }
        unsigned epf[2] = {0u, 0u};
        if constexpr (Epi::PF > 0) {
#pragma unroll
            for (int _k = 0; _k < Epi::PF; ++_k) { const float* _p = E.pf_addr(cur, tid, _k); asm volatile("global_load_dword %0, %1, off" : "=v"(epf[_k]) : "v"(_p) : "memory"); } }
        for (int t = 0; t < nt; t += 2) {
            const bool last = (t == nt - 2);
            const size_t k1 = (size_t)(t + 1) * kstep;
            const size_t k2 = last ? 0 : (size_t)(t + 2) * kstep;
            const size_t k3 = k2 + kstep;
            const char* b2 = (last ? nB : cB) + k2; const char* b3 = b2 + kstep;
            PG8_LDB(B0, 0, 0); PG8_LDB(B1, 0, 1); PG8_SCHED; PG8_LDA(At, 0, 0); PG8_STAGE_A(PG8_SA(1, 1), false, 1, k1);
            PG8_WAIT_V(8); PG8_WAIT_L(0); PG8_BAR; PG8_MMA(0, 0, At, B0); PG8_MMA(0, 1, At, B1); PG8_BAR; PG8_SCHED;
            if constexpr (GATHER) { if (last) { if (has_next) {
                asm volatile("" : "+v"(tokN[0][0]), "+v"(tokN[0][1]), "+v"(tokN[1][0]), "+v"(tokN[1][1]));
                { PG8_RC(0, _R0, _C0); PG8_RC(1, _R1, _C1); (void)_R0; (void)_R1;
#pragma unroll
                for (int _h = 0; _h < 2; ++_h) { voN[_h][0] = (unsigned)(tokN[_h][0] * RB + _C0 * 2); voN[_h][1] = (unsigned)(tokN[_h][1] * RB + _C1 * 2); } } } else {
#pragma unroll
                for (int _h = 0; _h < 2; ++_h) { voN[_h][0] = voC[_h][0]; voN[_h][1] = voC[_h][1]; } } } }
            if constexpr (Epi::PF > 0) { if (last) { asm volatile("" : "+v"(epf[0]), "+v"(epf[1]));
#pragma unroll
                for (int _k = 0; _k < Epi::PF; ++_k) *(LAS unsigned*)(lds + MISC_OFF + M_EPF + (_k * 512 + tid) * 4) = epf[_k]; } }
            PG8_LDA(At, 0, 1); PG8_STAGE(PG8_SB(0, 0), b2, voffB); PG8_STAGE(PG8_SB(0, 1), b2 + hstep, voffB); PG8_STAGE_A(PG8_SA(0, 0), last, 0, k2);
            PG8_WAIT_V(8); PG8_WAIT_L(0); PG8_BAR; PG8_MMA(1, 0, At, B0); PG8_MMA(1, 1, At, B1); PG8_BAR; PG8_SCHED;
            PG8_LDB(B0, 1, 0); PG8_LDB(B1, 1, 1); PG8_SCHED; PG8_LDA(At, 1, 0); PG8_STAGE_A(PG8_SA(0, 1), last, 1, k2);
            PG8_WAIT_V(8); PG8_WAIT_L(0); PG8_BAR; PG8_MMA(0, 0, At, B0); PG8_MMA(0, 1, At, B1); PG8_BAR; PG8_SCHED;
            PG8_LDA(At, 1, 1); PG8_STAGE(PG8_SB(1, 0), b3, voffB); PG8_STAGE(PG8_SB(1, 1), b3 + hstep, voffB); PG8_STAGE_A(PG8_SA(1, 0), last, 0, k3);
            PG8_WAIT_V(8); PG8_WAIT_L(0); PG8_BAR; PG8_MMA(1, 0, At, B0); PG8_MMA(1, 1, At, B1); PG8_BAR; PG8_SCHED;
        }
        if (wr == 0) PG8_BAR;
        { const int ln_ = lane_id(); E(acc, cur, wr, wc, ln_ & 15, ln_ >> 4); }
        if (!has_next) break;
#pragma unroll
        for (int a = 0; a < 2; ++a)
#pragma unroll
            for (int b = 0; b < 2; ++b)
#pragma unroll
                for (int m = 0; m < 4; ++m)
#pragma unroll
                    for (int n = 0; n < 2; ++n) acc[a][b][m][n] = (acc_t){0, 0, 0, 0};
        cur = nxt; cA = nA; cB = nB; ++ui;
        if constexpr (GATHER) {
#pragma unroll
            for (int _h = 0; _h < 2; ++_h) { voC[_h][0] = voN[_h][0]; voC[_h][1] = voN[_h][1]; } }
        if (wr == 1) PG8_BAR;
    }
    PG8_WAIT_V(0);
    PG8_BAR;
#undef PG8_SA
#undef PG8_SB
#undef PG8_STAGE
#undef PG8_STAGE_A
#undef PG8_LDA
#undef PG8_LDB
#undef PG8_MMA
#undef PG8_WAIT_V
#undef PG8_WAIT_L
#undef PG8_BAR
#undef PG8_SCHED
#undef PG8_GATH
#undef PG8_RC
}
}

namespace pg8 {
struct EpiBf16Plain {
    static constexpr bool PERM = true; static constexpr int PF = 0;
    bf16_t* O; int ldc; int qtiles; float qscale;
    __device__ __forceinline__ void operator()(const f32x4 (&acc)[2][2][4][2], const Unit& u, int wr, int wc, int fr, int fq) const {
        const int row0 = u.pm * BM + wr * 64 + fr, col0 = u.pn * BM + wc * 32 + 8 * fq;
        const float qs = u.pn < qtiles ? qscale : 1.0f;
#pragma unroll
        for (int ai = 0; ai < 2; ++ai)
#pragma unroll
            for (int m = 0; m < 4; ++m) { bf16_t* rowp = O + (size_t)(row0 + ai * HALF + m * 16) * ldc + col0;
#pragma unroll
                for (int bj = 0; bj < 2; ++bj) { const f32x4 v0 = acc[ai][bj][m][0] * qs, v1 = acc[ai][bj][m][1] * qs;
                    u32x4 w; w.x = cvt_pk_bf16(v0[0], v0[1]); w.y = cvt_pk_bf16(v0[2], v0[3]); w.z = cvt_pk_bf16(v1[0], v1[1]); w.w = cvt_pk_bf16(v1[2], v1[3]);
                    *(u32x4*)(rowp + bj * HALF) = w; } }
    }
};
struct EpiBf16Plain8 {
    static constexpr bool PERM = true; static constexpr int PF = 1;
    bf16_t* O; int ldc; int qtiles; float qscale; const float* sa; const float* sb; const LAS float* epf;
    __device__ __forceinline__ const float* pf_addr(const Unit& u, int tid, int) const { return tid < 256 ? sb + u.pn * BM + tid : sa + u.pm * BM + (tid - 256); }
    __device__ __forceinline__ void operator()(const i32x4 (&acc)[2][2][4][2], const Unit& u, int wr, int wc, int fr, int fq) const {
        const int row0 = u.pm * BM + wr * 64 + fr, col0 = u.pn * BM + wc * 32 + 8 * fq;
        const float qs = u.pn < qtiles ? qscale : 1.0f;
        f32x4 cs[2][2];
#pragma unroll
        for (int bj = 0; bj < 2; ++bj)
#pragma unroll
            for (int n = 0; n < 2; ++n) cs[bj][n] = *(const LAS f32x4*)(epf + wc * 32 + 8 * fq + bj * HALF + 4 * n) * qs;
#pragma unroll
        for (int ai = 0; ai < 2; ++ai)
#pragma unroll
            for (int m = 0; m < 4; ++m) { const int row = row0 + ai * HALF + m * 16; bf16_t* rowp = O + (size_t)row * ldc + col0; const float sr = epf[256 + wr * 64 + fr + ai * HALF + m * 16];
#pragma unroll
                for (int bj = 0; bj < 2; ++bj) { f32x4 v0, v1;
#pragma unroll
                    for (int j = 0; j < 4; ++j) { v0[j] = (float)acc[ai][bj][m][0][j] * (sr * cs[bj][0][j]); v1[j] = (float)acc[ai][bj][m][1][j] * (sr * cs[bj][1][j]); }
                    u32x4 w; w.x = cvt_pk_bf16(v0[0], v0[1]); w.y = cvt_pk_bf16(v0[2], v0[3]); w.z = cvt_pk_bf16(v1[0], v1[1]); w.w = cvt_pk_bf16(v1[2], v1[3]);
                    *(u32x4*)(rowp + bj * HALF) = w; }
                asm volatile("" ::: "memory"); }
    }
};
struct EpiF32Plain {
    static constexpr bool PERM = false; static constexpr int PF = 0;
    float* C; int ldc;
    __device__ __forceinline__ void operator()(const f32x4 (&acc)[2][2][4][2], const Unit& u, int wr, int wc, int fr, int fq) const {
        const int row0 = u.pm * BM + wr * 64 + fr, col0 = u.pn * BM + wc * 32 + 4 * fq;
#pragma unroll
        for (int ai = 0; ai < 2; ++ai)
#pragma unroll
            for (int m = 0; m < 4; ++m) { float* rowp = C + (size_t)(row0 + ai * HALF + m * 16) * ldc + col0;
#pragma unroll
                for (int bj = 0; bj < 2; ++bj)
#pragma unroll
                    for (int n = 0; n < 2; ++n) *(f32x4*)(rowp + bj * HALF + n * 16) = acc[ai][bj][m][n]; }
    }
};
__device__ __forceinline__ void rope8(f32x4& v0, f32x4& v1, const float* cs) {
    const f32x4 a = *(const f32x4*)cs, b = *(const f32x4*)(cs + 4);
    const float x0 = v0[0], x1 = v0[1], x2 = v0[2], x3 = v0[3], y0 = v1[0], y1 = v1[1], y2 = v1[2], y3 = v1[3];
    v0[0] = x0 * a[0] - x1 * a[1]; v0[1] = x0 * a[1] + x1 * a[0];
    v0[2] = x2 * a[2] - x3 * a[3]; v0[3] = x2 * a[3] + x3 * a[2];
    v1[0] = y0 * b[0] - y1 * b[1]; v1[1] = y0 * b[1] + y1 * b[0];
    v1[2] = y2 * b[2] - y3 * b[3]; v1[3] = y2 * b[3] + y3 * b[2];
}
struct EpiQkvA {
    static constexpr bool PERM = true; static constexpr int PF = 0;
    bf16_t* O; const float* rope;
    __device__ __forceinline__ void operator()(const f32x4 (&acc)[2][2][4][2], const Unit& u, int wr, int wc, int fr, int fq) const {
        const int row0 = u.pm * BM + wr * 64 + fr, col0 = u.pn * BM + wc * 32 + 8 * fq;
        const bool do_rope = (u.pm < NL / 256) && (u.pn < 5);
        const float qs = u.pn < 4 ? 0.125f * LOG2E : 1.0f;
#pragma unroll
        for (int ai = 0; ai < 2; ++ai)
#pragma unroll
            for (int m = 0; m < 4; ++m) { const int row = row0 + ai * HALF + m * 16; bf16_t* rowp = O + (size_t)row * A_IN + col0;
#pragma unroll
                for (int bj = 0; bj < 2; ++bj) { f32x4 v0 = acc[ai][bj][m][0], v1 = acc[ai][bj][m][1];
                    if (do_rope) { const int d = (col0 + bj * HALF) & 63; rope8(v0, v1, rope + ((size_t)(row & (SEQ - 1)) * 32 + (d >> 1)) * 2); }
                    v0 = v0 * qs; v1 = v1 * qs;
                    u32x4 w; w.x = cvt_pk_bf16(v0[0], v0[1]); w.y = cvt_pk_bf16(v0[2], v0[3]); w.z = cvt_pk_bf16(v1[0], v1[1]); w.w = cvt_pk_bf16(v1[2], v1[3]);
                    *(u32x4*)(rowp + bj * HALF) = w; }
                asm volatile("" ::: "memory"); }
    }
};
struct EpiQkvA8 {
    static constexpr bool PERM = true; static constexpr int PF = 1;
    bf16_t* O; const float* rope; const float* sa; const float* sb; const LAS float* epf;
    __device__ __forceinline__ const float* pf_addr(const Unit& u, int tid, int) const { return tid < 256 ? sb + u.pn * BM + tid : sa + u.pm * BM + (tid - 256); }
    __device__ __forceinline__ void operator()(const i32x4 (&acc)[2][2][4][2], const Unit& u, int wr, int wc, int fr, int fq) const {
        const int row0 = u.pm * BM + wr * 64 + fr, col0 = u.pn * BM + wc * 32 + 8 * fq;
        const bool do_rope = (u.pm < NL / 256) && (u.pn < 5);
        const float qs = u.pn < 4 ? 0.125f * LOG2E : 1.0f;
        f32x4 cs[2][2];
#pragma unroll
        for (int bj = 0; bj < 2; ++bj)
#pragma unroll
            for (int n = 0; n < 2; ++n) cs[bj][n] = *(const LAS f32x4*)(epf + wc * 32 + 8 * fq + bj * HALF + 4 * n) * qs;
#pragma unroll
        for (int ai = 0; ai < 2; ++ai)
#pragma unroll
            for (int m = 0; m < 4; ++m) { const int row = row0 + ai * HALF + m * 16; bf16_t* rowp = O + (size_t)row * A_IN + col0; const float sr = epf[256 + wr * 64 + fr + ai * HALF + m * 16];
#pragma unroll
                for (int bj = 0; bj < 2; ++bj) { f32x4 v0, v1;
#pragma unroll
                    for (int j = 0; j < 4; ++j) { v0[j] = (float)acc[ai][bj][m][0][j] * (sr * cs[bj][0][j]); v1[j] = (float)acc[ai][bj][m][1][j] * (sr * cs[bj][1][j]); }
                    if (do_rope) { const int d = (col0 + bj * HALF) & 63; rope8(v0, v1, rope + ((size_t)(row & (SEQ - 1)) * 32 + (d >> 1)) * 2); }
                    u32x4 w; w.x = cvt_pk_bf16(v0[0], v0[1]); w.y = cvt_pk_bf16(v0[2], v0[3]); w.z = cvt_pk_bf16(v1[0], v1[1]); w.w = cvt_pk_bf16(v1[2], v1[3]);
                    *(u32x4*)(rowp + bj * HALF) = w; }
                asm volatile("" ::: "memory"); }
    }
};
struct EpiMlaUp {
    static constexpr bool PERM = true; static constexpr int PF = 0;
    bf16_t* O; const float* rope;
    __device__ __forceinline__ void operator()(const f32x4 (&acc)[2][2][4][2], const Unit& u, int wr, int wc, int fr, int fq) const {
        const int row0 = u.pm * BM + wr * 64 + fr, col0 = u.pn * BM + wc * 32 + 8 * fq;
        const bool qtile = (u.pm < NL / 256) && (u.pn < 6);
        const float qs = u.pn < 6 ? 0.10206207261596575f * LOG2E : 1.0f;
#pragma unroll
        for (int ai = 0; ai < 2; ++ai)
#pragma unroll
            for (int m = 0; m < 4; ++m) { const int row = row0 + ai * HALF + m * 16; bf16_t* rowp = O + (size_t)row * C_UPN + col0;
#pragma unroll
                for (int bj = 0; bj < 2; ++bj) { f32x4 v0 = acc[ai][bj][m][0], v1 = acc[ai][bj][m][1];
                    const int d96 = (col0 + bj * HALF) % 96;
                    if (qtile && d96 >= 64) rope8(v0, v1, rope + ((size_t)(row & (SEQ - 1)) * 16 + ((d96 - 64) >> 1)) * 2);
                    v0 = v0 * qs; v1 = v1 * qs;
                    u32x4 w; w.x = cvt_pk_bf16(v0[0], v0[1]); w.y = cvt_pk_bf16(v0[2], v0[3]); w.z = cvt_pk_bf16(v1[0], v1[1]); w.w = cvt_pk_bf16(v1[2], v1[3]);
                    *(u32x4*)(rowp + bj * HALF) = w; }
                asm volatile("" ::: "memory"); }
    }
};
struct EpiResid {
    static constexpr bool PERM = false; static constexpr int PF = 1;
    const LAS float* epf;
    __device__ __forceinline__ const float* pf_addr(const Unit& u, int tid, int) const { return gmod + (size_t)(u.pm < NL / 256 ? (u.pm >> 3) : 8) * 6144 + u.pn * BM + (tid & 255); }
    bf16_t* XS; const float* gmod; bf16_t* XSo;
    __device__ __forceinline__ void operator()(const f32x4 (&acc)[2][2][4][2], const Unit& u, int wr, int wc, int fr, int fq) const {
        const int row0 = u.pm * BM + wr * 64 + fr, col0 = u.pn * BM + wc * 32 + 4 * fq;
        f32x4 gg[2][2];
#pragma unroll
        for (int bj = 0; bj < 2; ++bj)
#pragma unroll
            for (int n = 0; n < 2; ++n) gg[bj][n] = *(const LAS f32x4*)(epf + wc * 32 + 4 * fq + bj * HALF + n * 16);
#pragma unroll
        for (int ai = 0; ai < 2; ++ai)
#pragma unroll
            for (int m = 0; m < 4; ++m) { const size_t off = (size_t)(row0 + ai * HALF + m * 16) * D + col0;
#pragma unroll
                for (int bj = 0; bj < 2; ++bj)
#pragma unroll
                    for (int n = 0; n < 2; ++n) { const u32x2 w = *(const u32x2*)(XS + off + bj * HALF + n * 16);
                        const f32x4 v = (f32x4){bf_lo(w.x), bf_hi(w.x), bf_lo(w.y), bf_hi(w.y)} + gg[bj][n] * acc[ai][bj][m][n];
                        u32x2 o; o.x = cvt_pk_bf16(v[0], v[1]); o.y = cvt_pk_bf16(v[2], v[3]); *(u32x2*)(XSo + off + bj * HALF + n * 16) = o; } }
    }
};
struct EpiSwiglu {
    static constexpr bool PERM = true; static constexpr int PF = 0;
    bf16_t* ACT; const float* bg; const float* bu;
    __device__ __forceinline__ void operator()(const f32x4 (&acc)[2][2][4][2], const Unit& u, int wr, int wc, int fr, int fq) const {
        const int row0 = u.pm * BM + wr * 64 + fr, col0 = u.pn * HALF + wc * 32 + 8 * fq;
        const float* pg = bg + (size_t)u.e * D + col0; const float* pu = bu + (size_t)u.e * D + col0;
        const f32x4 g0 = *(const f32x4*)pg, g1 = *(const f32x4*)(pg + 4), u0 = *(const f32x4*)pu, u1 = *(const f32x4*)(pu + 4);
#pragma unroll
        for (int ai = 0; ai < 2; ++ai)
#pragma unroll
            for (int m = 0; m < 4; ++m) { bf16_t* rowp = ACT + (size_t)(row0 + ai * HALF + m * 16) * D + col0;
                float r[8];
#pragma unroll
                for (int n = 0; n < 2; ++n)
#pragma unroll
                    for (int j = 0; j < 4; ++j) {
                        float g = acc[ai][0][m][n][j] + (n ? g1[j] : g0[j]); float uu = acc[ai][1][m][n][j] + (n ? u1[j] : u0[j]);
                        g = fminf(g, 7.0f); uu = fminf(fmaxf(uu, -7.0f), 7.0f);
                        const float sg = __builtin_amdgcn_rcpf(1.0f + __builtin_amdgcn_exp2f(-1.702f * LOG2E * g));
                        r[n * 4 + j] = g * sg * (uu + 1.0f); }
                u32x4 w; w.x = cvt_pk_bf16(r[0], r[1]); w.y = cvt_pk_bf16(r[2], r[3]); w.z = cvt_pk_bf16(r[4], r[5]); w.w = cvt_pk_bf16(r[6], r[7]);
                *(u32x4*)rowp = w; }
    }
};
struct EpiSwiglu8 {
    static constexpr bool PERM = true; static constexpr int PF = 2;
    bf16_t* ACT; const float* bg; const float* bu; const float* sal; const float* sbw; const LAS float* epf;
    __device__ __forceinline__ const float* pf_addr(const Unit& u, int tid, int k) const {
        if (k == 1) { const int t = tid & 255; return sal + (size_t)u.e * NT + ((u.mt * 256 + t) < u.cnt ? u.mt * 256 + t : u.mt * 256); }
        const int t = tid & 127;
        return tid < 128 ? bg + (size_t)u.e * D + u.pn * HALF + t : (tid < 256 ? bu + (size_t)u.e * D + u.pn * HALF + t : sbw + (size_t)u.e * 2048 + u.pn * BM + (tid < 384 ? 0 : HALF) + t); }
    __device__ __forceinline__ void operator()(const i32x4 (&acc)[2][2][4][2], const Unit& u, int wr, int wc, int fr, int fq) const {
        const int lr0 = wr * 64 + fr, row0 = u.pm * BM + lr0, col0 = u.pn * HALF + wc * 32 + 8 * fq;
#pragma unroll
        for (int n = 0; n < 2; ++n) {
            const LAS float* pe = epf + wc * 32 + 8 * fq + 4 * n;
            const f32x4 gb = *(const LAS f32x4*)pe, ub = *(const LAS f32x4*)(pe + 128), sg = *(const LAS f32x4*)(pe + 256), su = *(const LAS f32x4*)(pe + 384);
#pragma unroll
            for (int ai = 0; ai < 2; ++ai)
#pragma unroll
                for (int m = 0; m < 4; ++m) { const int lr = lr0 + ai * HALF + m * 16; const float sa_ = epf[512 + lr];
                    float r[4];
#pragma unroll
                    for (int j = 0; j < 4; ++j) {
                        float g = (float)acc[ai][0][m][n][j] * (sa_ * sg[j]) + gb[j];
                        float uu = (float)acc[ai][1][m][n][j] * (sa_ * su[j]) + ub[j];
                        g = fminf(g, 7.0f); uu = fminf(fmaxf(uu, -7.0f), 7.0f);
                        const float sgm = __builtin_amdgcn_rcpf(1.0f + __builtin_amdgcn_exp2f(-1.702f * LOG2E * g));
                        r[j] = g * sgm * (uu + 1.0f); }
                    u32x2 w; w.x = cvt_pk_bf16(r[0], r[1]); w.y = cvt_pk_bf16(r[2], r[3]);
                    *(u32x2*)(ACT + (size_t)(row0 + ai * HALF + m * 16) * D + col0 + 4 * n) = w; }
            asm volatile("" ::: "memory");
        }
    }
};
struct EpiDown {
    static constexpr bool PERM = true; static constexpr int PF = 0;
    bf16_t* YS; const float* bd;
    __device__ __forceinline__ void operator()(const f32x4 (&acc)[2][2][4][2], const Unit& u, int wr, int wc, int fr, int fq) const {
        const int row0 = u.pm * BM + wr * 64 + fr, col0 = u.pn * BM + wc * 32 + 8 * fq;
        const float* pb = bd + (size_t)u.e * D + col0;
        f32x4 bv[2][2];
#pragma unroll
        for (int bj = 0; bj < 2; ++bj)
#pragma unroll
            for (int n = 0; n < 2; ++n) bv[bj][n] = *(const f32x4*)(pb + bj * HALF + 4 * n);
#pragma unroll
        for (int ai = 0; ai < 2; ++ai)
#pragma unroll
            for (int m = 0; m < 4; ++m) { bf16_t* rowp = YS + (size_t)(row0 + ai * HALF + m * 16) * D + col0;
#pragma unroll
                for (int bj = 0; bj < 2; ++bj) { const f32x4 v0 = acc[ai][bj][m][0] + bv[bj][0], v1 = acc[ai][bj][m][1] + bv[bj][1];
                    u32x4 w; w.x = cvt_pk_bf16(v0[0], v0[1]); w.y = cvt_pk_bf16(v0[2], v0[3]); w.z = cvt_pk_bf16(v1[0], v1[1]); w.w = cvt_pk_bf16(v1[2], v1[3]);
                    *(u32x4*)(rowp + bj * HALF) = w; } }
    }
};

struct EpiDown8 {
    static constexpr bool PERM = true; static constexpr int PF = 2;
    bf16_t* YS; const float* bd; const float* saq; const float* sbd; const LAS float* epf;
    __device__ __forceinline__ const float* pf_addr(const Unit& u, int tid, int k) const {
        if (k == 1) return saq + (size_t)u.pm * BM + (tid & 255);
        return (tid < 256 ? bd : sbd) + (size_t)u.e * D + u.pn * BM + (tid & 255); }
    __device__ __forceinline__ void operator()(const i32x4 (&acc)[2][2][4][2], const Unit& u, int wr, int wc, int fr, int fq) const {
        const int row0 = u.pm * BM + wr * 64 + fr, col0 = u.pn * BM + wc * 32 + 8 * fq;
#pragma unroll
        for (int bj = 0; bj < 2; ++bj) {
            const LAS float* pe = epf + wc * 32 + 8 * fq + bj * HALF;
            const f32x4 b0 = *(const LAS f32x4*)pe, b1 = *(const LAS f32x4*)(pe + 4), s0 = *(const LAS f32x4*)(pe + 256), s1 = *(const LAS f32x4*)(pe + 260);
#pragma unroll
            for (int ai = 0; ai < 2; ++ai)
#pragma unroll
                for (int m = 0; m < 4; ++m) { const int row = row0 + ai * HALF + m * 16; const float sr = epf[512 + wr * 64 + fr + ai * HALF + m * 16]; f32x4 v0, v1;
#pragma unroll
                    for (int j = 0; j < 4; ++j) { v0[j] = (float)acc[ai][bj][m][0][j] * (sr * s0[j]) + b0[j]; v1[j] = (float)acc[ai][bj][m][1][j] * (sr * s1[j]) + b1[j]; }
                    u32x4 w; w.x = cvt_pk_bf16(v0[0], v0[1]); w.y = cvt_pk_bf16(v0[2], v0[3]); w.z = cvt_pk_bf16(v1[0], v1[1]); w.w = cvt_pk_bf16(v1[2], v1[3]);
                    *(u32x4*)(YS + (size_t)row * D + col0 + bj * HALF) = w; }
            asm volatile("" ::: "memory");
        }
    }
};
struct DenseOrder {
    int nM, nN, vcu, xM, xN0, xNn;
    __device__ __forceinline__ bool short_one() const { const int U = nM * nN + xM * xNn, R = (U + 255) >> 8; return (U & 255) != 0 && vcu >= U - (R - 1) * 256; }
    __device__ __forceinline__ bool next(int i, Unit& u) const {
        int L = i * 256 + vcu; const int nmain = nM * nN;
        if (L < nmain) { const int nig = 8 * nN, gid = L / nig, fm = gid * 8, rem = nM - fm, gsz = rem < 8 ? rem : 8, w = L % nig; u.pm = fm + w % gsz; u.pn = w / gsz; }
        else { L -= nmain; if (L >= xM * xNn) return false; u.pm = nM + L % xM; u.pn = xN0 + L / xM; }
        u.e = 0; u.mt = 0; u.cnt = 0; return true;
    }
};
struct MoeOrder {
    const LAS int* ecnt; const LAS int* lbase; const LAS int* cumt; int nN, idx, G; LAS int* ul;
    __device__ __forceinline__ bool short_one() const { const int U = cumt[32] * nN, R = (U + G - 1) / G; return (U % G) != 0 && idx >= U - (R - 1) * G; }
    __device__ __forceinline__ void build(int tid) const {
        if (tid < 16) { const int L = tid * G + idx; int e = -1, pn = 0, mt = 0, pm = 0, c = 0;
            if (idx >= 0 && L < cumt[32] * nN) { e = 0; while (cumt[e + 1] * nN <= L) ++e; const int r = L - cumt[e] * nN; c = ecnt[e]; const int mte = (c + 255) >> 8;
                if (MK_MT_MAJOR & (nN == 4 ? 1 : 2)) { pn = r % nN; mt = r / nN; } else { pn = r / mte; mt = r % mte; } pm = (lbase[e] >> 8) + mt; }
            ul[tid * 8 + 0] = e; ul[tid * 8 + 1] = pn; ul[tid * 8 + 2] = mt; ul[tid * 8 + 3] = pm; ul[tid * 8 + 4] = c; }
        __syncthreads();
    }
    __device__ __forceinline__ bool next(int i, Unit& u) const {
        if (i >= 16) return false;
        const int e = __builtin_amdgcn_readfirstlane(ul[i * 8 + 0]);
        if (e < 0) return false;
        u.e = e; u.pn = __builtin_amdgcn_readfirstlane(ul[i * 8 + 1]); u.mt = __builtin_amdgcn_readfirstlane(ul[i * 8 + 2]); u.pm = __builtin_amdgcn_readfirstlane(ul[i * 8 + 3]); u.cnt = __builtin_amdgcn_readfirstlane(ul[i * 8 + 4]); return true;
    }
};
}

namespace att {
constexpr int VSTR = 144;
template <int DQK> struct Cfg { static constexpr int KSTR = DQK * 2 + 16, KB = 64 * KSTR, VB = 64 * VSTR, STAGE = KB + VB, CPR = DQK / 8, NKS = DQK / 16; };
__device__ __forceinline__ int crow(int r, int hi) { return (r & 3) + 8 * (r >> 2) + 4 * hi; }

template <int DQK, bool MLA>
__device__ __forceinline__ void fetchK(u32x4 (&r)[2], const bf16_t* Kb, const bf16_t* KRb, int pitch, int row0, int tid) {
    typedef Cfg<DQK> C;
    { const int key = tid / C::CPR, ch = tid % C::CPR;
      const bf16_t* src = (MLA && ch >= 8) ? KRb + (size_t)(row0 + key) * 32 + (ch - 8) * 8 : Kb + (size_t)(row0 + key) * pitch + ch * 8;
      r[0] = *(const u32x4*)src; }
    if constexpr (DQK == 96) { if (tid < 256) { const int c = 512 + tid, key = c / C::CPR, ch = c % C::CPR;
      const bf16_t* src = (MLA && ch >= 8) ? KRb + (size_t)(row0 + key) * 32 + (ch - 8) * 8 : Kb + (size_t)(row0 + key) * pitch + ch * 8;
      r[1] = *(const u32x4*)src; } }
}
__device__ __forceinline__ void fetchV(u32x4& r, const bf16_t* Vb, int pitch, int row0, int tid) { const int key = tid >> 3, ch = tid & 7; r = *(const u32x4*)(Vb + (size_t)(row0 + key) * pitch + ch * 8); }
template <int DQK>
__device__ __forceinline__ void stashK(LAS unsigned char* kst, const u32x4 (&r)[2], int tid) {
    typedef Cfg<DQK> C;
    { const int key = tid / C::CPR, ch = tid % C::CPR; *(LAS u32x4*)(kst + key * C::KSTR + ch * 16) = r[0]; }
    if constexpr (DQK == 96) { if (tid < 256) { const int c = 512 + tid, key = c / C::CPR, ch = c % C::CPR; *(LAS u32x4*)(kst + key * C::KSTR + ch * 16) = r[1]; } }
}
__device__ __forceinline__ void stashV(LAS unsigned char* vst, const u32x4& r, int tid) { const int key = tid >> 3, ch = tid & 7; *(LAS u32x4*)(vst + key * VSTR + ch * 16) = r; }
template <int DQK, bool MLA>
__device__ __forceinline__ void fetch(u32x4 (&r)[3], const bf16_t* Kb, const bf16_t* Vb, const bf16_t* KRb, int pitch, int row0, int tid) {
    u32x4 k2[2]; k2[1] = (u32x4){0u, 0u, 0u, 0u}; fetchK<DQK, MLA>(k2, Kb, KRb, pitch, row0, tid); r[0] = k2[0]; r[1] = k2[1]; fetchV(r[2], Vb, pitch, row0, tid);
}
template <int DQK>
__device__ __forceinline__ void stash(LAS unsigned char* st, const u32x4 (&r)[3], int tid) {
    const u32x4 k2[2] = {r[0], r[1]}; stashK<DQK>(st, k2, tid); stashV(st + Cfg<DQK>::KB, r[2], tid);
}
template <int DQK>
__device__ __forceinline__ f32x16 qk(const LAS unsigned char* kst, int koff, const bf16x8 (&qr)[DQK / 16], int r32, int hi) {
    typedef Cfg<DQK> C;
    f32x16 p;
#pragma unroll
    for (int r = 0; r < 16; ++r) p[r] = 0.f;
    const LAS unsigned char* kb = kst + (koff + r32) * C::KSTR + hi * 16;
#pragma unroll
    for (int ks = 0; ks < C::NKS; ++ks) { const bf16x8 kf = *(const LAS bf16x8*)(kb + ks * 32); p = __builtin_amdgcn_mfma_f32_32x32x16_bf16(kf, qr[ks], p, 0, 0, 0); }
    return p;
}
__device__ __forceinline__ s16x4 vtr(const LAS unsigned char* p) { return __builtin_bit_cast(s16x4, __builtin_amdgcn_ds_read_tr16_b64_v4i16((LAS s16x4*)p)); }
typedef __bf16 bf16x2_t __attribute__((ext_vector_type(2)));
__device__ __forceinline__ unsigned cvtpk_s(float lo, float hi) { const f32x2 v = {lo, hi}; const bf16x2_t b = __builtin_convertvector(v, bf16x2_t); return __builtin_bit_cast(unsigned, b); }
template <int NS>
__device__ __forceinline__ void sm_max(const f32x16 (&t)[NS], const float sc, f32x16 (&o)[2], float& m, float& l) {
    float mx = t[0][0];
#pragma unroll
    for (int s = 0; s < NS; ++s)
#pragma unroll
        for (int r = 0; r < 16; ++r) mx = fmaxf(mx, t[s][r]);
    mx = swap32_max(mx) * sc;
    if (__any(mx > m + 8.0f)) { const float mn = fmaxf(m, mx); const float a = __builtin_amdgcn_exp2f(m - mn); m = mn; l *= a;
#pragma unroll
        for (int r = 0; r < 16; ++r) { o[0][r] *= a; o[1][r] *= a; } }
}
template <int NS>
__device__ __forceinline__ void sm_exp_pv(f32x16 (&t)[NS], const float sc, const LAS unsigned char* vst, const int (&voff)[NS], f32x16 (&o)[2], const float m, float& l, int lane) {
    const int hi = lane >> 5;
    float rs = 0.f;
#pragma unroll
    for (int s = 0; s < NS; ++s)
#pragma unroll
        for (int r = 0; r < 16; ++r) { t[s][r] = __builtin_amdgcn_exp2f(__builtin_fmaf(t[s][r], sc, -m)); rs += t[s][r]; }
    l += rs;
    const int q4 = (lane & 15) >> 2, p4 = lane & 3, blk = (lane >> 4) & 1;
#pragma unroll
    for (int s = 0; s < NS; ++s) {
        const LAS unsigned char* vb = vst + (voff[s] + 4 * hi + q4) * VSTR + (16 * blk + 4 * p4) * 2;
#pragma unroll
        for (int kk = 0; kk < 2; ++kk) {
            u32x4 pw; pw.x = cvtpk_s(t[s][8 * kk + 0], t[s][8 * kk + 1]); pw.y = cvtpk_s(t[s][8 * kk + 2], t[s][8 * kk + 3]);
            pw.z = cvtpk_s(t[s][8 * kk + 4], t[s][8 * kk + 5]); pw.w = cvtpk_s(t[s][8 * kk + 6], t[s][8 * kk + 7]);
            const bf16x8 pb = __builtin_bit_cast(bf16x8, pw);
#pragma unroll
            for (int c = 0; c < 2; ++c) {
                const s16x4 lo = vtr(vb + (16 * kk) * VSTR + c * 64), h8 = vtr(vb + (16 * kk + 8) * VSTR + c * 64);
                const bf16x8 va = (bf16x8){lo[0], lo[1], lo[2], lo[3], h8[0], h8[1], h8[2], h8[3]};
                o[c] = __builtin_amdgcn_mfma_f32_32x32x16_bf16(va, pb, o[c], 0, 0, 0);
            }
        }
    }
}
template <int NS>
__device__ __forceinline__ void sm_pv(f32x16 (&t)[NS], const float sc, const LAS unsigned char* vst, const int (&voff)[NS], f32x16 (&o)[2], float& m, float& l, int lane) {
    sm_max<NS>(t, sc, o, m, l); sm_exp_pv<NS>(t, sc, vst, voff, o, m, l, lane);
}
template <int DQK>
__device__ __forceinline__ f32x16 qkn(const LAS unsigned char* kst, int koff, const bf16x8 (&qr)[DQK / 16], const f32x16& negm, int r32, int hi) {
    typedef Cfg<DQK> C;
    f32x16 p = negm;
    const LAS unsigned char* kb = kst + (koff + r32) * C::KSTR + hi * 16;
#pragma unroll
    for (int ks = 0; ks < C::NKS; ++ks) { const bf16x8 kf = *(const LAS bf16x8*)(kb + ks * 32); p = __builtin_amdgcn_mfma_f32_32x32x16_bf16(kf, qr[ks], p, 0, 0, 0); }
    return p;
}
__device__ __forceinline__ void sm_max_n(f32x16 (&t)[2], f32x16 (&o)[2], f32x16& osum, float& m, f32x16& negm, bool first) {
    float a0 = fmaxf(fmaxf(t[0][0], t[0][1]), t[0][2]), a1 = fmaxf(fmaxf(t[1][0], t[1][1]), t[1][2]);
#pragma unroll
    for (int r = 3; r < 15; r += 2) { a0 = fmaxf(fmaxf(a0, t[0][r]), t[0][r + 1]); a1 = fmaxf(fmaxf(a1, t[1][r]), t[1][r + 1]); }
    float mx = fmaxf(fmaxf(a0, a1), fmaxf(t[0][15], t[1][15]));
    mx = swap32_max(mx);
    if (first || __any(mx > 8.0f)) { const float d = first ? mx : fmaxf(mx, 0.f); const float a = first ? 1.0f : __builtin_amdgcn_exp2f(-d); m += d;
#pragma unroll
        for (int r = 0; r < 16; ++r) { t[0][r] -= d; t[1][r] -= d; o[0][r] *= a; o[1][r] *= a; osum[r] *= a; negm[r] = -m; } }
}
__device__ __forceinline__ void sm_exp_pv_n(f32x16 (&t)[2], const LAS unsigned char* vst, f32x16 (&o)[2], f32x16& osum, int lane) {
    const int hi = lane >> 5, q4 = (lane & 15) >> 2, p4 = lane & 3, blk = (lane >> 4) & 1;
    const LAS unsigned char* vb = vst + (4 * hi + q4) * VSTR + (16 * blk + 4 * p4) * 2;
    bf16x8 va[2][2][2];
#pragma unroll
    for (int s = 0; s < 2; ++s)
#pragma unroll
        for (int kk = 0; kk < 2; ++kk)
#pragma unroll
            for (int c = 0; c < 2; ++c) { const s16x4 lo = vtr(vb + (32 * s + 16 * kk) * VSTR + c * 64), h8 = vtr(vb + (32 * s + 16 * kk + 8) * VSTR + c * 64);
                va[s][kk][c] = (bf16x8){lo[0], lo[1], lo[2], lo[3], h8[0], h8[1], h8[2], h8[3]}; }
    const bf16x8 ones = (bf16x8){0x3F80, 0x3F80, 0x3F80, 0x3F80, 0x3F80, 0x3F80, 0x3F80, 0x3F80};
#pragma unroll
    for (int s = 0; s < 2; ++s)
#pragma unroll
        for (int kk = 0; kk < 2; ++kk) {
            float e[8];
#pragma unroll
            for (int j = 0; j < 8; ++j) e[j] = __builtin_amdgcn_exp2f(t[s][8 * kk + j]);
            u32x4 pw; pw.x = cvtpk_s(e[0], e[1]); pw.y = cvtpk_s(e[2], e[3]); pw.z = cvtpk_s(e[4], e[5]); pw.w = cvtpk_s(e[6], e[7]);
            const bf16x8 pb = __builtin_bit_cast(bf16x8, pw);
            o[0] = __builtin_amdgcn_mfma_f32_32x32x16_bf16(va[s][kk][0], pb, o[0], 0, 0, 0);
            o[1] = __builtin_amdgcn_mfma_f32_32x32x16_bf16(va[s][kk][1], pb, o[1], 0, 0, 0);
            osum = __builtin_amdgcn_mfma_f32_32x32x16_bf16(ones, pb, osum, 0, 0, 0);
        }
}
__device__ __forceinline__ void finalize_n(const f32x16 (&o)[2], const f32x16& osum, bf16_t* orow, int hi) {
    const float inv = 1.0f / osum[0];
#pragma unroll
    for (int c = 0; c < 2; ++c)
#pragma unroll
        for (int g = 0; g < 4; ++g) { u32x2 w; w.x = cvt_pk_bf16(o[c][4 * g] * inv, o[c][4 * g + 1] * inv); w.y = cvt_pk_bf16(o[c][4 * g + 2] * inv, o[c][4 * g + 3] * inv);
            *(u32x2*)(orow + 32 * c + 8 * g + 4 * hi) = w; }
}
__device__ __forceinline__ void finalize(const f32x16 (&o)[2], float l, bf16_t* orow, int hi) {
    l = swap32_sum(l); const float inv = 1.0f / l;
#pragma unroll
    for (int c = 0; c < 2; ++c)
#pragma unroll
        for (int g = 0; g < 4; ++g) { u32x2 w; w.x = cvt_pk_bf16(o[c][4 * g] * inv, o[c][4 * g + 1] * inv); w.y = cvt_pk_bf16(o[c][4 * g + 2] * inv, o[c][4 * g + 3] * inv);
            *(u32x2*)(orow + 32 * c + 8 * g + 4 * hi) = w; }
}
#define ATT_PIPE_BEGIN(DQK, MLA, ROW0_OF) \
    u32x4 pre[3]; pre[1] = (u32x4){0u, 0u, 0u, 0u}; \
    fetch<DQK, MLA>(pre, Kb, Vb, KRb, pitch, ROW0_OF(0), tid); stash<DQK>(lds, pre, tid); __syncthreads(); \
    for (int i = 0; i < ntiles; ++i) { \
        if (i + 1 < ntiles) fetch<DQK, MLA>(pre, Kb, Vb, KRb, pitch, ROW0_OF(i + 1), tid); \
        const LAS unsigned char* kst = lds + (i & 1) * Cfg<DQK>::STAGE; const LAS unsigned char* vst = kst + Cfg<DQK>::KB;
#define ATT_PIPE_END(DQK) \
        if (i + 1 < ntiles) stash<DQK>(lds + ((i + 1) & 1) * Cfg<DQK>::STAGE, pre, tid); \
        __syncthreads(); }

#define ATT2_RUN(DQK, MLA, ROW0_OF, QK2, FIRST) \
    { typedef Cfg<DQK> C_; LAS unsigned char* const kb_ = lds; LAS unsigned char* const vb_ = lds + 2 * C_::KB; \
    u32x4 pk_[2], pv_; pk_[1] = (u32x4){0u, 0u, 0u, 0u}; \
    fetchK<DQK, MLA>(pk_, Kb, KRb, pitch, ROW0_OF(0), tid); fetchV(pv_, Vb, pitch, ROW0_OF(0), tid); stashK<DQK>(kb_, pk_, tid); stashV(vb_, pv_, tid); \
    if (ntiles > 1) { fetchK<DQK, MLA>(pk_, Kb, KRb, pitch, ROW0_OF(1), tid); stashK<DQK>(kb_ + C_::KB, pk_, tid); } \
    __syncthreads(); \
    f32x16 t[2]; QK2(t, kb_, 0); \
    __syncthreads();     \
    for (int i = 0; i + 1 < ntiles; ++i) { \
        if (i + 2 < ntiles) fetchK<DQK, MLA>(pk_, Kb, KRb, pitch, ROW0_OF(i + 2), tid); \
        fetchV(pv_, Vb, pitch, ROW0_OF(i + 1), tid); \
        sm_max_n(t, o, osum, m, negm, (FIRST) && i == 0); \
        f32x16 tn[2]; QK2(tn, kb_ + ((i + 1) & 1) * C_::KB, i + 1);     \
        sm_exp_pv_n(t, vb_ + (i & 1) * C_::VB, o, osum, lane); \
        t[0] = tn[0]; t[1] = tn[1]; \
        if (i + 2 < ntiles) stashK<DQK>(kb_ + (i & 1) * C_::KB, pk_, tid); \
        stashV(vb_ + ((i + 1) & 1) * C_::VB, pv_, tid); \
        __syncthreads(); } \
    sm_max_n(t, o, osum, m, negm, (FIRST) && ntiles == 1); \
    sm_exp_pv_n(t, vb_ + ((ntiles - 1) & 1) * C_::VB, o, osum, lane); \
    __syncthreads(); }

__device__ __forceinline__ void attn_A_unit(LAS unsigned char* lds, const bf16_t* QKV, bf16_t* O, const float* sink, int b, int kvh, int qb, bool ctxq, int tid) {
    const int lane = tid & 63, wid = __builtin_amdgcn_readfirstlane(tid >> 6), r32 = lane & 31, hi = lane >> 5;
    const int head = kvh * 4 + (wid >> 1), qoff = 32 * (wid & 1) + r32, t0 = qb * 64;
    const int qrow = ctxq ? NL + b * CTXL + t0 + qoff : b * SEQ + t0 + qoff;
    bf16x8 qr[4];
    { const bf16_t* qp = QKV + (size_t)qrow * A_IN + head * 64 + hi * 8;
#pragma unroll
      for (int ks = 0; ks < 4; ++ks) qr[ks] = *(const bf16x8*)(qp + ks * 16); }
    int jlo = 0, nloc = 0;
    if (!ctxq) { jlo = t0 >= 128 ? 0 : (t0 == 64 ? 1 : 2); int jhi = (2112 - t0) / 64; jhi = jhi > 4 ? 4 : jhi; nloc = jhi - jlo + 1; }
    const int ntiles = 4 + nloc, cbase = NL + b * CTXL, lbase = b * SEQ + t0 - 128 + 64 * jlo;
    const bf16_t* Kb = QKV + 1024 + kvh * 64; const bf16_t* Vb = QKV + 1280 + kvh * 64; const bf16_t* KRb = nullptr; const int pitch = A_IN;
    float m = sink[head] * LOG2E;
    f32x16 o[2], osum, negm;
#pragma unroll
    for (int r = 0; r < 16; ++r) { o[0][r] = 0.f; o[1][r] = 0.f; osum[r] = 1.0f; negm[r] = -m; }
#define A_ROW0(i) ((i) < 4 ? cbase + 64 * (i) : lbase + 64 * ((i) - 4))
#define A_QK2(dst, kst, ti) { dst[0] = qkn<64>(kst, 0, qr, negm, r32, hi); dst[1] = qkn<64>(kst, 32, qr, negm, r32, hi); const int j_ = (ti) < 4 ? 2 : jlo + (ti) - 4; \
        if (j_ == 0 || j_ == 4) { _Pragma("unroll") for (int s = 0; s < 2; ++s) _Pragma("unroll") for (int r = 0; r < 16; ++r) { const int kk = 32 * s + crow(r, hi); \
            if (j_ == 0 ? (kk < qoff) : (kk > qoff)) dst[s][r] = -1e30f; } } }
    ATT2_RUN(64, false, A_ROW0, A_QK2, false)
#undef A_QK2
#undef A_ROW0
    finalize_n(o, osum, O + (size_t)qrow * D + head * 64, hi);
}

__device__ __forceinline__ void attn_B_unit(LAS unsigned char* lds, LAS float* tab, const bf16_t* QKV, bf16_t* O, const float* rpb, int b, int h, int rq, bool ctxq, int tid) {
    const int lane = tid & 63, wid = __builtin_amdgcn_readfirstlane(tid >> 6), r32 = lane & 31, hi = lane >> 5;
    const int jb = wid & 3, rp = wid >> 2;
    const int rqa = 4 * rq + 2 * rp + (r32 >> 4), qcol = 16 * jb + (r32 & 15);
    const int qrow = ctxq ? NL + b * CTXL + 32 * wid + r32 : b * SEQ + rqa * 64 + qcol;
    for (int idx = tid; idx < 15 * 31; idx += 512) tab[(idx / 31) * 32 + idx % 31] = rpb[h * 465 + idx] * LOG2E;
    bf16x8 qr[4];
    { const bf16_t* qp = QKV + (size_t)qrow * B_IN + h * 64 + hi * 8;
#pragma unroll
      for (int ks = 0; ks < 4; ++ks) qr[ks] = *(const bf16x8*)(qp + ks * 16); }
    int klo = 0, nloc = 0;
    if (!ctxq) { klo = 4 * rq - 4; klo = klo < 0 ? 0 : (klo > 24 ? 24 : klo); int khi = 4 * rq - 1; khi = khi < 0 ? 0 : (khi > 24 ? 24 : khi); khi += 7; nloc = khi - klo + 1; }
    const int ntiles = 4 + nloc, cbase = NL + b * CTXL, lbase = b * SEQ;
    int r0q = rqa - 4; r0q = r0q < 0 ? 0 : (r0q > 24 ? 24 : r0q);
    int wst = qcol - 8; wst = wst < 0 ? 0 : (wst > 48 ? 48 : wst);
    int cst = 16 * jb - 8; cst = cst < 0 ? 0 : (cst > 32 ? 32 : cst);
    const int lo = wst - cst;
    int wr0 = 4 * rq + 2 * rp - 4; wr0 = wr0 < 0 ? 0 : (wr0 > 24 ? 24 : wr0);
    int wr1 = 4 * rq + 2 * rp + 1 - 4; wr1 = wr1 < 0 ? 0 : (wr1 > 24 ? 24 : wr1); wr1 += 7;
    const bf16_t* Kb = QKV + 1024 + h * 64; const bf16_t* Vb = QKV + 2048 + h * 64; const bf16_t* KRb = nullptr; const int pitch = B_IN;
    float m = -1e30f, l = 0.f;
    f32x16 o[2];
#pragma unroll
    for (int r = 0; r < 16; ++r) { o[0][r] = 0.f; o[1][r] = 0.f; }
    const float sc = 0.125f * LOG2E;
#define B_ROW0(i) ((i) < 4 ? cbase + 64 * (i) : lbase + 64 * (klo + (i) - 4))
    ATT_PIPE_BEGIN(64, false, B_ROW0)
        if (i < 4) {
            f32x16 t[2];
            t[0] = qk<64>(kst, 0, qr, r32, hi); t[1] = qk<64>(kst, 32, qr, r32, hi);
#pragma unroll
            for (int s = 0; s < 2; ++s)
#pragma unroll
                for (int r = 0; r < 16; ++r) t[s][r] *= 1.0f;
            const int voff[2] = {0, 32};
            sm_pv<2>(t, 1.0f, vst, voff, o, m, l, lane);
        } else {
            const int kr = klo + i - 4;
            if (kr >= wr0 && kr <= wr1) {
                f32x16 t[1];
                t[0] = qk<64>(kst, cst, qr, r32, hi);
                const bool rowok = (kr >= r0q) && (kr < r0q + 8);
                const int bidx0 = (kr - rqa + 7) * 32 + cst - qcol + 15;
#pragma unroll
                for (int r = 0; r < 16; ++r) { const int kidx = crow(r, hi); const bool ok = rowok && ((unsigned)(kidx - lo) < 16u);
                    int bi = bidx0 + kidx; bi = bi < 0 ? 0 : (bi > 479 ? 479 : bi);
                    const float bias = tab[bi];
                    t[0][r] = ok ? t[0][r] + bias : -1e30f; }
                const int voff[1] = {cst};
                sm_pv<1>(t, 1.0f, vst, voff, o, m, l, lane);
            }
        }
    ATT_PIPE_END(64)
#undef B_ROW0
    finalize(o, l, O + (size_t)qrow * D + h * 64, hi);
}

__device__ __forceinline__ void attn_C_unit(LAS unsigned char* lds, const bf16_t* Q2, const bf16_t* KR, bf16_t* O, int b, int h, int qb, bool ctxq, int tid) {
    const int lane = tid & 63, wid = __builtin_amdgcn_readfirstlane(tid >> 6), r32 = lane & 31, hi = lane >> 5;
    const int qrow = ctxq ? NL + b * CTXL + 32 * wid + r32 : b * SEQ + qb * 256 + 32 * wid + r32;
    bf16x8 qr[6];
    { const bf16_t* qp = Q2 + (size_t)qrow * C_UPN + h * 96 + hi * 8;
#pragma unroll
      for (int ks = 0; ks < 6; ++ks) qr[ks] = *(const bf16x8*)(qp + ks * 16); }
    const int ntiles = ctxq ? 4 : 36, cbase = NL + b * CTXL, lbase = b * SEQ;
    const bf16_t* Kb = Q2 + 1536 + h * 128; const bf16_t* Vb = Kb + 64; const bf16_t* KRb = KR; const int pitch = C_UPN;
    float m = 0.f;
    f32x16 o[2], osum, negm;
#pragma unroll
    for (int r = 0; r < 16; ++r) { o[0][r] = 0.f; o[1][r] = 0.f; osum[r] = 0.f; negm[r] = 0.f; }
#define C_ROW0(i) ((i) < 4 ? cbase + 64 * (i) : lbase + 64 * ((i) - 4))
#define C_QK2(dst, kst, ti) { dst[0] = qkn<96>(kst, 0, qr, negm, r32, hi); dst[1] = qkn<96>(kst, 32, qr, negm, r32, hi); }
    ATT2_RUN(96, true, C_ROW0, C_QK2, true)
#undef C_QK2
#undef C_ROW0
    finalize_n(o, osum, O + (size_t)qrow * D + h * 64, hi);
}
}

struct Row4 { f32x4 v[4]; };
__device__ __forceinline__ void row_load(Row4& x, const float* p, int lane) {
#pragma unroll
    for (int j = 0; j < 4; ++j) x.v[j] = *(const f32x4*)(p + 4 * lane + 256 * j);
}
__device__ __forceinline__ void row_store(const Row4& x, float* p, int lane) {
#pragma unroll
    for (int j = 0; j < 4; ++j) *(f32x4*)(p + 4 * lane + 256 * j) = x.v[j];
}
__device__ __forceinline__ void row_load_bf(Row4& x, const bf16_t* p, int lane) {
#pragma unroll
    for (int j = 0; j < 4; ++j) { const u32x2 w = *(const u32x2*)(p + 4 * lane + 256 * j); x.v[j] = (f32x4){bf_lo(w.x), bf_hi(w.x), bf_lo(w.y), bf_hi(w.y)}; }
}
__device__ __forceinline__ void row_store_bf(const Row4& x, bf16_t* p, int lane) {
#pragma unroll
    for (int j = 0; j < 4; ++j) { u32x2 w; w.x = cvt_pk_bf16(x.v[j][0], x.v[j][1]); w.y = cvt_pk_bf16(x.v[j][2], x.v[j][3]); *(u32x2*)(p + 4 * lane + 256 * j) = w; }
}
__device__ __forceinline__ float row_rstd(const Row4& x, int lane) {
    float s = 0.f;
#pragma unroll
    for (int j = 0; j < 4; ++j) s += (x.v[j][0] * x.v[j][0] + x.v[j][1] * x.v[j][1]) + (x.v[j][2] * x.v[j][2] + x.v[j][3] * x.v[j][3]);
    s = wave_sum(s, lane);
    return 1.0f / sqrtf(s * (1.0f / D) + NORM_EPS);
}
__device__ __forceinline__ void norm_mod(const Row4& x, float rstd, const float* g, const float* sh, const float* sc, bf16_t* out, int lane, Row4& hv) {
#pragma unroll
    for (int j = 0; j < 4; ++j) { const int c = 4 * lane + 256 * j;
        const f32x4 gg = *(const f32x4*)(g + c), s1 = *(const f32x4*)(sc + c), s0 = *(const f32x4*)(sh + c);
        const f32x4 h = (x.v[j] * rstd * gg) * (s1 + 1.0f) + s0; hv.v[j] = h;
        u32x2 w; w.x = cvt_pk_bf16(h[0], h[1]); w.y = cvt_pk_bf16(h[2], h[3]); *(u32x2*)(out + c) = w; }
}

__device__ __forceinline__ unsigned pk_i8x4(float a, float b, float c, float d, float inv) {
    const int q0 = (int)rintf(a * inv), q1 = (int)rintf(b * inv), q2 = (int)rintf(c * inv), q3 = (int)rintf(d * inv);
    return (unsigned)(q0 & 255) | ((unsigned)(q1 & 255) << 8) | ((unsigned)(q2 & 255) << 16) | ((unsigned)q3 << 24);
}
__device__ __forceinline__ void norm_mod8(const Row4& x, float rstd, const float* g, const float* sh, const float* sc, unsigned char* out, float* sarow, int lane) {
    Row4 hv; float am = 0.f;
#pragma unroll
    for (int j = 0; j < 4; ++j) { const int c = 4 * lane + 256 * j;
        const f32x4 gg = *(const f32x4*)(g + c), s1 = *(const f32x4*)(sc + c), s0 = *(const f32x4*)(sh + c);
        const f32x4 h = (x.v[j] * rstd * gg) * (s1 + 1.0f) + s0; hv.v[j] = h;
        am = fmaxf(fmaxf(am, fmaxf(fabsf(h[0]), fabsf(h[1]))), fmaxf(fabsf(h[2]), fabsf(h[3]))); }
    am = fmaxf(wave_max(am, lane), 1e-20f); const float inv = 127.0f / am;
#pragma unroll
    for (int j = 0; j < 4; ++j) *(unsigned*)(out + 4 * lane + 256 * j) = pk_i8x4(hv.v[j][0], hv.v[j][1], hv.v[j][2], hv.v[j][3], inv);
    if (lane == 0) *sarow = am * (1.0f / 127.0f);
}

struct Ptrs {
    const float* in[29]; float* out; unsigned char* ws;
};
typedef const __attribute__((address_space(4))) Ptrs* PK;
#define WSP(T, off) ((T*)(P->ws + (off)))

__device__ __forceinline__ unsigned pk_f16(float a, float b) { const f32x2 v = {a, b}; const f16x2 h = __builtin_convertvector(v, f16x2); return __builtin_bit_cast(unsigned, h); }
__device__ __forceinline__ void phase_first_norm(PK P, int gw, int lane) {
    const float* MOD = WSP(const float, WS_MOD);
    {
        const int gt = gw * 64 + lane;
        for (int q = gt; q < DEPTH * 9 * 4096; q += 131072) { const int lb = q >> 12, cc = q & 4095, c = cc >> 5, e = cc & 31, l = lb / 9, b = lb - 9 * l;
            const float* g = P->in[7] + (size_t)l * D + 8 * c; const float* sc = MOD + ((size_t)l * 9 + b) * 6144 + 4096 + 8 * c; const float* w = P->in[21] + ((size_t)l * D + 8 * c) * NEXP + e;
            float v[8];
#pragma unroll
            for (int j = 0; j < 8; ++j) v[j] = g[j] * (1.0f + sc[j]) * w[j * NEXP];
            u32x4 o; o.x = pk_f16(v[0], v[1]); o.y = pk_f16(v[2], v[3]); o.z = pk_f16(v[4], v[5]); o.w = pk_f16(v[6], v[7]);
            *(u32x4*)(WSP(unsigned char, WS_G16) + (size_t)lb * 65536 + e * 2048 + ((c ^ (e & 15)) * 16)) = o; }
        for (int q = gw; q < DEPTH * 9 * 32; q += 2048) { const int lb = q >> 5, e = q & 31, l = lb / 9, b = lb - 9 * l;
            const float* sh = MOD + ((size_t)l * 9 + b) * 6144 + 3072; const float* w = P->in[21] + (size_t)l * D * NEXP + e; float t = 0.f;
#pragma unroll
            for (int j = 0; j < 16; ++j) { const int k = lane + 64 * j; t += sh[k] * w[(size_t)k * NEXP]; }
            t = wave_sum(t, lane);
            if (lane == 0) WSP(float, WS_RC)[q] = t + P->in[22][l * NEXP + e]; }
    }
    for (int r0 = gw; r0 < NT; r0 += 4096) {
        const int rr[2] = {r0, (r0 + 2048 < NT) ? r0 + 2048 : r0};
        Row4 x[2];
#pragma unroll
        for (int u = 0; u < 2; ++u) { const int r = rr[u]; const float* src = r < NL ? P->in[0] + (size_t)r * D : P->in[2] + (size_t)(r - NL) * D; row_load(x[u], src, lane); }
#pragma unroll
        for (int u = 0; u < 2; ++u) { const int r = rr[u]; row_store_bf(x[u], WSP(bf16_t, WS_XS) + (size_t)r * D, lane);
            const float rstd = row_rstd(x[u], lane); const int rb = r < NL ? (r >> 11) : 8; const float* mod = MOD + (size_t)rb * 6144;
            norm_mod8(x[u], rstd, P->in[6], mod, mod + 1024, WSP(unsigned char, WS_H) + (size_t)r * D, WSP(float, WS_SAH) + r, lane); }
    }
}
__device__ __forceinline__ void phase_mla_norm(PK P, int gw, int lane) {
    const float* Y = WSP(const float, WS_Y416); bf16_t* CQ = WSP(bf16_t, WS_CQKV); bf16_t* KR = WSP(bf16_t, WS_KR);
    const float* qn = P->in[16]; const float* kn = P->in[17]; const float* rope = WSP(const float, WS_ROPE_C);
    for (int r0 = gw; r0 < NT; r0 += 4096) {
        const int rr[2] = {r0, (r0 + 2048 < NT) ? r0 + 2048 : r0};
        f32x4 vq[2]; f32x2 vk[2], vr[2];
#pragma unroll
        for (int u = 0; u < 2; ++u) { const float* y = Y + (size_t)rr[u] * C_INP; vq[u] = *(const f32x4*)(y + 4 * lane); vk[u] = *(const f32x2*)(y + 256 + 2 * lane); vr[u] = *(const f32x2*)(y + 384 + 2 * (lane & 15)); }
#pragma unroll
        for (int u = 0; u < 2; ++u) { const int r = rr[u]; const f32x4 v = vq[u];
            const float ss = wave_sum((v[0] * v[0] + v[1] * v[1]) + (v[2] * v[2] + v[3] * v[3]), lane);
            const float rq = 1.0f / sqrtf(ss * (1.0f / 256.0f) + NORM_EPS);
            const f32x4 g = *(const f32x4*)(qn + 4 * lane);
            u32x2 w; w.x = cvt_pk_bf16(v[0] * rq * g[0], v[1] * rq * g[1]); w.y = cvt_pk_bf16(v[2] * rq * g[2], v[3] * rq * g[3]);
            *(u32x2*)(CQ + (size_t)r * C_UPK + 4 * lane) = w;
            const f32x2 k2 = vk[u];
            const float s2 = wave_sum(k2[0] * k2[0] + k2[1] * k2[1], lane);
            const float rk = 1.0f / sqrtf(s2 * (1.0f / 128.0f) + NORM_EPS);
            const f32x2 g2 = *(const f32x2*)(kn + 2 * lane);
            *(unsigned*)(CQ + (size_t)r * C_UPK + 256 + 2 * lane) = cvt_pk_bf16(k2[0] * rk * g2[0], k2[1] * rk * g2[1]);
            if (lane < 16) { f32x2 p = vr[u];
                if (r < NL) { const f32x2 cs = *(const f32x2*)(rope + ((size_t)(r & (SEQ - 1)) * 16 + lane) * 2); const float a = p[0], b = p[1]; p[0] = a * cs[0] - b * cs[1]; p[1] = a * cs[1] + b * cs[0]; }
                *(unsigned*)(KR + (size_t)r * 32 + 2 * lane) = cvt_pk_bf16(p[0], p[1]); }
        }
    }
}
__device__ __forceinline__ void moe_tables(LAS unsigned char* misc, unsigned* gcnt, int tid) {
    LAS int* ecnt = (LAS int*)(misc + M_ECNT); LAS int* lbase = (LAS int*)(misc + M_LBASE); LAS int* cumt = (LAS int*)(misc + M_CUMT);
    if (tid < 32) ecnt[tid] = (int)__hip_atomic_load(gcnt + tid * 16, __ATOMIC_RELAXED, __HIP_MEMORY_SCOPE_AGENT);
    __syncthreads();
    if (tid == 0) { int s = 0, t = 0; for (int e = 0; e < 32; ++e) { lbase[e] = s; cumt[e] = t; const int mt = (ecnt[e] + 255) >> 8; s += mt * 256; t += mt; } cumt[32] = t; }
    __syncthreads();
}
constexpr int RT_PLOG = 65536, RT_LOGIT = 98304, RT_SSQ = 102912, RT_RSTD = 103936, RT_CVEC = 104064, RT_AMX = 104192;
__device__ __forceinline__ void phase_router(PK P, LAS unsigned char* lds, int l, int nrows, int vcu, int tid, int cset) {
    const int lane = tid & 63, wid = __builtin_amdgcn_readfirstlane(tid >> 6), i32 = lane & 31, hi = lane >> 5;
    LAS unsigned char* misc = lds + MISC_OFF;
    LAS int* lcnt = (LAS int*)(misc + M_LCNT); LAS int* gbase = (LAS int*)(misc + M_GBASE); LAS int* rec = (LAS int*)(misc + M_REC);
    LAS float* plog = (LAS float*)(lds + RT_PLOG); LAS float* logit = (LAS float*)(lds + RT_LOGIT); LAS float* ssq = (LAS float*)(lds + RT_SSQ);
    LAS float* rstd_s = (LAS float*)(lds + RT_RSTD); LAS float* cvec = (LAS float*)(lds + RT_CVEC); LAS float* amx = (LAS float*)(lds + RT_AMX); LAS float* rowsa = (LAS float*)(misc + M_RSA);
    const bool last = (nrows == NL);
    const int nb = (!last && vcu < 64) ? 3 : 2;
    const float* MOD = WSP(const float, WS_MOD) + (size_t)l * 9 * 6144;
    const bf16_t* XS = WSP(const bf16_t, WS_XS); unsigned char* H8 = WSP(unsigned char, WS_H);
    int* TOPE = WSP(int, WS_TOPE); float* GATE = WSP(float, WS_GATE);
    const float* gn = P->in[7] + (size_t)l * D;
    if (tid < 32) lcnt[tid] = 0;
    u32x4 nw[8];
#define RT_ROW0(b) ((b) < 2 ? 64 * vcu + 32 * (b) : NL + 32 * vcu)
    { const bf16_t* xp0 = XS + (size_t)(RT_ROW0(0) + i32) * D + 128 * wid + 8 * hi;
#pragma unroll
      for (int s = 0; s < 8; ++s) nw[s] = *(const u32x4*)(xp0 + 16 * s); }
    for (int bi = 0; bi < nb; ++bi) {
        const int rb = bi < 2 ? (vcu >> 5) : 8;
        const int row0 = RT_ROW0(bi);
        if (bi != 1) {
            __syncthreads();
            const u32x4* gsrc = (const u32x4*)(WSP(const unsigned char, WS_G16) + (size_t)(l * 9 + rb) * 65536);
#pragma unroll
            for (int c = 0; c < 8; ++c) *(LAS u32x4*)(lds + (size_t)(tid + 512 * c) * 16) = gsrc[tid + 512 * c];
            if (tid < 32) cvec[tid] = WSP(const float, WS_RC)[(l * 9 + rb) * 32 + tid];
            __syncthreads();
        }
        const int r = row0 + i32;
        f32x4 xa[8], xb[8];
#pragma unroll
        for (int s = 0; s < 8; ++s) { const u32x4 w = nw[s];
            xa[s] = (f32x4){bf_lo(w.x), bf_hi(w.x), bf_lo(w.y), bf_hi(w.y)}; xb[s] = (f32x4){bf_lo(w.z), bf_hi(w.z), bf_lo(w.w), bf_hi(w.w)}; }
        if (bi + 1 < nb) { const bf16_t* xpn = XS + (size_t)(RT_ROW0(bi + 1) + i32) * D + 128 * wid + 8 * hi;
#pragma unroll
            for (int s = 0; s < 8; ++s) nw[s] = *(const u32x4*)(xpn + 16 * s); }
        float ss = 0.f;
        f32x16 acc;
#pragma unroll
        for (int q = 0; q < 16; ++q) acc[q] = 0.f;
#pragma unroll
        for (int s = 0; s < 8; ++s) {
            ss += (xa[s][0] * xa[s][0] + xa[s][1] * xa[s][1]) + (xa[s][2] * xa[s][2] + xa[s][3] * xa[s][3]) + (xb[s][0] * xb[s][0] + xb[s][1] * xb[s][1]) + (xb[s][2] * xb[s][2] + xb[s][3] * xb[s][3]);
            u32x4 aw; aw.x = pk_f16(xa[s][0], xa[s][1]); aw.y = pk_f16(xa[s][2], xa[s][3]); aw.z = pk_f16(xb[s][0], xb[s][1]); aw.w = pk_f16(xb[s][2], xb[s][3]);
            const int c = 16 * wid + 2 * s + hi;
            const f16x8 bf = *(const LAS f16x8*)(lds + i32 * 2048 + ((c ^ (i32 & 15)) * 16));
            acc = __builtin_amdgcn_mfma_f32_32x32x16_f16(__builtin_bit_cast(f16x8, aw), bf, acc, 0, 0, 0);
        }
        ss = swap32_sum(ss);
        if (hi == 0) ssq[wid * 32 + i32] = ss;
#pragma unroll
        for (int q = 0; q < 16; ++q) plog[(wid * 32 + att::crow(q, hi)) * 32 + i32] = acc[q];
        __syncthreads();
        if (tid < 32) { float t = 0.f;
#pragma unroll
            for (int w = 0; w < 8; ++w) t += ssq[w * 32 + tid];
            rstd_s[tid] = 1.0f / sqrtf(t * (1.0f / D) + NORM_EPS); }
        __syncthreads();
#pragma unroll
        for (int u = 0; u < 2; ++u) { const int idx = tid + 512 * u, rr = idx >> 5, e = idx & 31; float t = 0.f;
#pragma unroll
            for (int w = 0; w < 8; ++w) t += plog[(w * 32 + rr) * 32 + e];
            logit[rr * 33 + e] = rstd_s[rr] * t + cvec[e]; }
        { const float rs = rstd_s[i32]; const float* mod = MOD + (size_t)rb * 6144; const int k0 = 128 * wid + 8 * hi; float am = 0.f;
#pragma unroll
          for (int s = 0; s < 8; ++s) { const int k = k0 + 16 * s;
              const f32x4 g0 = *(const f32x4*)(gn + k), g1 = *(const f32x4*)(gn + k + 4), c0 = *(const f32x4*)(mod + 4096 + k), c1 = *(const f32x4*)(mod + 4096 + k + 4);
              const f32x4 s0 = *(const f32x4*)(mod + 3072 + k), s1 = *(const f32x4*)(mod + 3072 + k + 4);
              const f32x4 h0 = (xa[s] * rs * g0) * (c0 + 1.0f) + s0, h1 = (xb[s] * rs * g1) * (c1 + 1.0f) + s1; xa[s] = h0; xb[s] = h1;
              am = fmaxf(fmaxf(fmaxf(am, fabsf(h0[0])), fmaxf(fabsf(h0[1]), fabsf(h0[2]))), fmaxf(fmaxf(fabsf(h0[3]), fabsf(h1[0])), fmaxf(fabsf(h1[1]), fmaxf(fabsf(h1[2]), fabsf(h1[3]))))); }
          am = swap32_max(am);
          if (hi == 0) amx[wid * 32 + i32] = am; }
        __syncthreads();
        { float a = amx[i32];
#pragma unroll
          for (int w = 1; w < 8; ++w) a = fmaxf(a, amx[w * 32 + i32]);
          a = fmaxf(a, 1e-20f); const float inv = 127.0f / a;
          if (wid == 0 && hi == 0) rowsa[32 * bi + i32] = a * (1.0f / 127.0f);
          unsigned char* hp = H8 + (size_t)r * D + 128 * wid + 8 * hi;
#pragma unroll
          for (int s = 0; s < 8; ++s) { u32x2 w; w.x = pk_i8x4(xa[s][0], xa[s][1], xa[s][2], xa[s][3], inv); w.y = pk_i8x4(xb[s][0], xb[s][1], xb[s][2], xb[s][3], inv); *(u32x2*)(hp + 16 * s) = w; } }
        if (tid < 32) {
            float t0 = -INFINITY, t1 = -INFINITY, t2 = -INFINITY, t3 = -INFINITY; int e0 = 0, e1 = 0, e2 = 0, e3 = 0;
#pragma unroll 4
            for (int e = 0; e < 32; ++e) { const float v = logit[tid * 33 + e];
                if (v > t3) { if (v > t2) { t3 = t2; e3 = e2; if (v > t1) { t2 = t1; e2 = e1; if (v > t0) { t1 = t0; e1 = e0; t0 = v; e0 = e; } else { t1 = v; e1 = e; } } else { t2 = v; e2 = e; } } else { t3 = v; e3 = e; } } }
            const float x1 = __expf(t1 - t0), x2 = __expf(t2 - t0), x3 = __expf(t3 - t0); const float inv = 1.0f / (1.0f + x1 + x2 + x3);
            const int rr = row0 + tid, lr = 32 * bi + tid;
            *(int4*)(TOPE + (size_t)rr * 4) = make_int4(e0, e1, e2, e3);
            *(f32x4*)(GATE + (size_t)rr * 4) = (f32x4){inv, x1 * inv, x2 * inv, x3 * inv};
            const int ee[4] = {e0, e1, e2, e3};
#pragma unroll
            for (int k = 0; k < 4; ++k) { const int lp = __hip_atomic_fetch_add(lcnt + ee[k], 1, __ATOMIC_RELAXED, __HIP_MEMORY_SCOPE_WORKGROUP); rec[2 * (lr * 4 + k)] = ee[k]; rec[2 * (lr * 4 + k) + 1] = lp; }
        }
    }
    __syncthreads();
    unsigned* gcnt = WSP(unsigned, WS_CTL) + CW_CNT + (l * 2 + cset) * 512;
    if (tid < 32) { const int c = lcnt[tid]; gbase[tid] = c ? (int)__hip_atomic_fetch_add(gcnt + tid * 16, (unsigned)c, __ATOMIC_RELAXED, __HIP_MEMORY_SCOPE_AGENT) : 0; }
    __syncthreads();
    int* ELIST = WSP(int, WS_ELIST); int* POS = WSP(int, WS_POS);
    for (int idx = tid; idx < nb * 128; idx += 512) { const int e = rec[2 * idx], pos = gbase[e] + rec[2 * idx + 1]; const int lr = idx >> 2; const int r = lr < 64 ? 64 * vcu + lr : NL + 32 * vcu + (lr - 64);
        ELIST[(size_t)e * NT + pos] = r; POS[(size_t)r * 4 + (idx & 3)] = pos; WSP(float, WS_SAL)[(size_t)e * NT + pos] = rowsa[lr]; }
    __syncthreads();
}
__device__ __forceinline__ void phase_requant(PK P, const LAS int* cumt, int gw, int lane) {
    const int nrows = cumt[32] * 256;
    const bf16_t* ACT = WSP(const bf16_t, WS_ACT); unsigned char* A8 = WSP(unsigned char, WS_ACT8); float* SAQ = WSP(float, WS_SAQ);
    for (int r0 = gw; r0 < nrows; r0 += 4 * 2048) {
        int rr[4]; u32x4 a[4], b[4];
#pragma unroll
        for (int u = 0; u < 4; ++u) { rr[u] = (r0 + u * 2048 < nrows) ? r0 + u * 2048 : r0;
            a[u] = *(const u32x4*)(ACT + (size_t)rr[u] * D + 8 * lane); b[u] = *(const u32x4*)(ACT + (size_t)rr[u] * D + 512 + 8 * lane); }
#pragma unroll
        for (int u = 0; u < 4; ++u) {
            float v[16];
            v[0] = bf_lo(a[u].x); v[1] = bf_hi(a[u].x); v[2] = bf_lo(a[u].y); v[3] = bf_hi(a[u].y); v[4] = bf_lo(a[u].z); v[5] = bf_hi(a[u].z); v[6] = bf_lo(a[u].w); v[7] = bf_hi(a[u].w);
            v[8] = bf_lo(b[u].x); v[9] = bf_hi(b[u].x); v[10] = bf_lo(b[u].y); v[11] = bf_hi(b[u].y); v[12] = bf_lo(b[u].z); v[13] = bf_hi(b[u].z); v[14] = bf_lo(b[u].w); v[15] = bf_hi(b[u].w);
            float am = 0.f;
#pragma unroll
            for (int j = 0; j < 16; ++j) am = fmaxf(am, fabsf(v[j]));
            am = fmaxf(wave_max(am, lane), 1e-20f); const float inv = 127.0f / am;
            u32x2 w0, w1; w0.x = pk_i8x4(v[0], v[1], v[2], v[3], inv); w0.y = pk_i8x4(v[4], v[5], v[6], v[7], inv); w1.x = pk_i8x4(v[8], v[9], v[10], v[11], inv); w1.y = pk_i8x4(v[12], v[13], v[14], v[15], inv);
            *(u32x2*)(A8 + (size_t)rr[u] * D + 8 * lane) = w0; *(u32x2*)(A8 + (size_t)rr[u] * D + 512 + 8 * lane) = w1;
            if (lane == 0) SAQ[rr[u]] = am * (1.0f / 127.0f);
        }
    }
}
__device__ __forceinline__ void phase_combine(PK P, LAS unsigned char* lds, int l, int nrows, int gw, int tid, bool dry) {
    const int lane = tid & 63;
    LAS unsigned char* misc = lds + MISC_OFF;
    moe_tables(misc, WSP(unsigned, WS_CTL) + CW_CNT + (l * 2 + ((MK_REP_MASK >> 11) & 1)) * 512, tid);
    const size_t dryoff = dry ? (WS_ACT - WS_XS) / 2 : 0;
    const LAS int* lbase = (const LAS int*)(misc + M_LBASE);
    const float* MOD = WSP(const float, WS_MOD); const float* g2 = MOD + (size_t)l * 9 * 6144 + 5120;
    bf16_t* XS = WSP(bf16_t, WS_XS); const bf16_t* YS = WSP(const bf16_t, WS_YS);
    const int* TOPE = WSP(const int, WS_TOPE); const int* POS = WSP(const int, WS_POS); const float* GATE = WSP(const float, WS_GATE);
    const bool last = (l == DEPTH - 1);
    for (int r0 = gw; r0 < nrows; r0 += 4096) {
        const int rr[2] = {r0, (r0 + 2048 < nrows) ? r0 + 2048 : r0};
        int slot[2]; float gate[2];
#pragma unroll
        for (int u = 0; u < 2; ++u) { slot[u] = 0; gate[u] = 0.f;
            if (lane < 4) { slot[u] = lbase[TOPE[(size_t)rr[u] * 4 + lane]] + POS[(size_t)rr[u] * 4 + lane]; gate[u] = GATE[(size_t)rr[u] * 4 + lane]; } }
        u32x2 xw[2][4], yw[2][4][4];
#pragma unroll
        for (int u = 0; u < 2; ++u) {
#pragma unroll
            for (int j = 0; j < 4; ++j) xw[u][j] = *(const u32x2*)(XS + (size_t)rr[u] * D + 4 * lane + 256 * j);
#pragma unroll
            for (int k = 0; k < 4; ++k) { const int sk = __builtin_amdgcn_readlane(slot[u], k); const bf16_t* yr = YS + (size_t)sk * D;
#pragma unroll
                for (int j = 0; j < 4; ++j) yw[u][k][j] = *(const u32x2*)(yr + 4 * lane + 256 * j); } }
#pragma unroll
        for (int u = 0; u < 2; ++u) {
            const int r = rr[u];
            Row4 x, f;
#pragma unroll
            for (int j = 0; j < 4; ++j) { x.v[j] = (f32x4){bf_lo(xw[u][j].x), bf_hi(xw[u][j].x), bf_lo(xw[u][j].y), bf_hi(xw[u][j].y)}; f.v[j] = (f32x4){0.f, 0.f, 0.f, 0.f}; }
#pragma unroll
            for (int k = 0; k < 4; ++k) { const float gk = __int_as_float(__builtin_amdgcn_readlane(__float_as_int(gate[u]), k));
#pragma unroll
                for (int j = 0; j < 4; ++j) { const u32x2 w = yw[u][k][j];
                    f.v[j][0] += gk * bf_lo(w.x); f.v[j][1] += gk * bf_hi(w.x); f.v[j][2] += gk * bf_lo(w.y); f.v[j][3] += gk * bf_hi(w.y); } }
            const int rb = r < NL ? (r >> 11) : 8;
#pragma unroll
            for (int j = 0; j < 4; ++j) { const f32x4 gg = *(const f32x4*)(g2 + (size_t)rb * 6144 + 4 * lane + 256 * j); x.v[j] = x.v[j] + gg * f.v[j]; }
            const float rstd = row_rstd(x, lane);
            if (last) {
#pragma unroll
                for (int j = 0; j < 4; ++j) { const int c = 4 * lane + 256 * j; const f32x4 gn = *(const f32x4*)(P->in[8] + c); *(f32x4*)((dry ? WSP(float, WS_ACT) : P->out) + (size_t)r * D + c) = x.v[j] * rstd * gn; }
            } else {
                row_store_bf(x, XS + dryoff + (size_t)r * D, lane);
                Row4 hv; const float* mod = MOD + (size_t)(l + 1) * 9 * 6144 + (size_t)rb * 6144;
                if ((l + 1) % 3 == 2) norm_mod(x, rstd, P->in[6] + (size_t)(l + 1) * D, mod, mod + 1024, (dry ? WSP(bf16_t, WS_ACT + 80 * MiB) : WSP(bf16_t, WS_H)) + (size_t)r * D, lane, hv);
                else norm_mod8(x, rstd, P->in[6] + (size_t)(l + 1) * D, mod, mod + 1024, (dry ? WSP(unsigned char, WS_ACT + 80 * MiB) : WSP(unsigned char, WS_H)) + (size_t)r * D, (dry ? WSP(float, WS_ACT + 120 * MiB) : WSP(float, WS_SAH)) + r, lane);
            }
        }
    }
}
__device__ __forceinline__ void phase_final_norm(PK P, int gw, int lane) {
    for (int r = gw; r < NL; r += 2048) { Row4 x; row_load_bf(x, WSP(const bf16_t, WS_XS) + (size_t)r * D, lane); const float rstd = row_rstd(x, lane);
#pragma unroll
        for (int j = 0; j < 4; ++j) { const int c = 4 * lane + 256 * j; const f32x4 gn = *(const f32x4*)(P->in[8] + c); *(f32x4*)(P->out + (size_t)r * D + c) = x.v[j] * rstd * gn; } }
}

__device__ __forceinline__ void conv_item(const float* src, int N, int nvalid, int k0, int n0, bf16_t* dst, int ldk, int drow0, int dk0, LAS unsigned* scr, int lane) {
    const int q = lane >> 4, nl = lane & 15, n = n0 + 4 * nl;
    f32x4 v[16];
#pragma unroll
    for (int r = 0; r < 16; ++r) { const int k = k0 + 8 * (r >> 1) + 2 * q + (r & 1);
        v[r] = (n < nvalid) ? __builtin_nontemporal_load((const f32x4*)(src + (size_t)k * N + n)) : (f32x4){0.f, 0.f, 0.f, 0.f}; }
#pragma unroll
    for (int rp = 0; rp < 8; ++rp)
#pragma unroll
        for (int i = 0; i < 4; ++i) { const int nn = 4 * nl + i, kw = 4 * rp + q; scr[nn * 32 + (kw ^ (4 * ((nn >> 2) & 7)))] = cvt_pk_bf16(v[2 * rp][i], v[2 * rp + 1][i]); }
    asm volatile("s_waitcnt lgkmcnt(0)" ::: "memory");
#pragma unroll
    for (int it = 0; it < 8; ++it) { const int nn = 8 * it + (lane >> 3), c = lane & 7;
        const u32x4 w = *(const LAS u32x4*)(scr + nn * 32 + 4 * (c ^ ((nn >> 2) & 7)));
        *(u32x4*)(dst + (size_t)(drow0 + nn) * ldk + dk0 + 8 * c) = w; }
    asm volatile("s_waitcnt lgkmcnt(0)" ::: "memory");
}
constexpr int CV_A_IN = 2 * 16 * 24, CV_A_OUT = 2 * 256, CV_B_IN = 16 * 48, CV_B_OUT = 256, CV_C_IN = 16 * 8, CV_C_UQ = 4 * 24, CV_C_UKV = 2 * 32, CV_C_OUT = 256;
constexpr int CV_SMALL = CV_A_IN + CV_A_OUT + CV_B_IN + CV_B_OUT + CV_C_IN + CV_C_UQ + CV_C_UKV + CV_C_OUT;
constexpr int CV_LAYER = NEXP * 3 * 256;
constexpr int CV_TOTAL = CV_SMALL + DEPTH * CV_LAYER;
constexpr int CV_CHUNK = 32;
__device__ __forceinline__ void conv_dispatch(PK P, int item, LAS unsigned* scr, int lane) {
    int r = item; const float* src; bf16_t* dst; int N, kb, nb, ldk = D, drow_off = 0, dk_off = 0;
    if (r < CV_A_IN) return;
    else if ((r -= CV_A_IN) < CV_A_OUT) { const int s = r / 256, it = r % 256; kb = it / 16; nb = it % 16; src = P->in[10] + (size_t)s * D * D; N = D; dst = WSP(bf16_t, WS_WA_OUT) + (size_t)s * D * D; }
    else if ((r -= CV_A_OUT) < CV_B_IN) return;
    else if ((r -= CV_B_IN) < CV_B_OUT) { kb = r / 16; nb = r % 16; src = P->in[13]; N = D; dst = WSP(bf16_t, WS_WB_OUT); }
    else if ((r -= CV_B_OUT) < CV_C_IN) { kb = r / 8; nb = r % 8; src = P->in[15]; N = C_IN; dst = WSP(bf16_t, WS_WC_IN); }
    else if ((r -= CV_C_IN) < CV_C_UQ) { kb = r / 24; nb = r % 24; src = P->in[18]; N = 1536; dst = WSP(bf16_t, WS_WC_UP); ldk = C_UPK; }
    else if ((r -= CV_C_UQ) < CV_C_UKV) { kb = r / 32; nb = r % 32; src = P->in[19]; N = 2048; dst = WSP(bf16_t, WS_WC_UP); ldk = C_UPK; drow_off = 1536; dk_off = 256; }
    else { r -= CV_C_UKV; kb = r / 16; nb = r % 16; src = P->in[20]; N = D; dst = WSP(bf16_t, WS_WC_OUT); }
    conv_item(src, N, N, 64 * kb, 64 * nb, dst, ldk, drow_off + 64 * nb, dk_off + 64 * kb, scr, lane);
}
__device__ __forceinline__ void conv_down_item(PK P, int L, int di, LAS unsigned* scr, int lane) {
    const int le = L * NEXP + (di >> 8), it = di & 255, kb = it >> 4, nb = it & 15;
    conv_item(P->in[27] + (size_t)le * D * D, D, D, 64 * kb, 64 * nb, WSP(bf16_t, WS_WD) + (size_t)le * D * D, D, 64 * nb, 64 * kb, scr, lane);
}
__device__ __forceinline__ void conv_q8_block(const float* src0, int N, unsigned char* dstq, float* dsts, LAS unsigned char* lds, int tid) {
    const int lane = tid & 63, wid = __builtin_amdgcn_readfirstlane(tid >> 6), q = lane >> 4, nl = lane & 15;
    const float* src = src0 + 4 * nl;
    f32x4 v[32];
#pragma unroll
    for (int r = 0; r < 32; ++r) { const int k = 128 * wid + 16 * (r >> 2) + 4 * q + (r & 3); v[r] = __builtin_nontemporal_load((const f32x4*)(src + (size_t)k * N)); }
    float cm[4] = {0.f, 0.f, 0.f, 0.f};
#pragma unroll
    for (int r = 0; r < 32; ++r)
#pragma unroll
        for (int i = 0; i < 4; ++i) cm[i] = fmaxf(cm[i], fabsf(v[r][i]));
    LAS float* cmx = (LAS float*)(lds + 65536);
#pragma unroll
    for (int i = 0; i < 4; ++i) { cm[i] = fmaxf(cm[i], shx(cm[i], 16, lane)); cm[i] = swap32_max(cm[i]); }
    if (q == 0) { *(LAS f32x4*)(cmx + wid * 64 + 4 * nl) = (f32x4){cm[0], cm[1], cm[2], cm[3]}; }
    __syncthreads();
    f32x4 a = *(const LAS f32x4*)(cmx + 4 * nl);
#pragma unroll
    for (int w = 1; w < 8; ++w) { const f32x4 b = *(const LAS f32x4*)(cmx + w * 64 + 4 * nl); a[0] = fmaxf(a[0], b[0]); a[1] = fmaxf(a[1], b[1]); a[2] = fmaxf(a[2], b[2]); a[3] = fmaxf(a[3], b[3]); }
    float inv[4];
#pragma unroll
    for (int i = 0; i < 4; ++i) { a[i] = fmaxf(a[i], 1e-30f); inv[i] = 127.0f / a[i]; }
    if (wid == 0 && q == 0) *(f32x4*)(dsts + 4 * nl) = a * (1.0f / 127.0f);
    LAS unsigned* scr = (LAS unsigned*)(lds + wid * 8192);
#pragma unroll
    for (int rp = 0; rp < 8; ++rp)
#pragma unroll
        for (int i = 0; i < 4; ++i) { const int nn = 4 * nl + i, kw = 4 * rp + q;
            scr[nn * 32 + (kw ^ (4 * ((nn >> 2) & 7)))] = pk_i8x4(v[4 * rp][i], v[4 * rp + 1][i], v[4 * rp + 2][i], v[4 * rp + 3][i], inv[i]); }
    asm volatile("s_waitcnt lgkmcnt(0)" ::: "memory");
    unsigned char* dst = dstq + 128 * wid;
#pragma unroll
    for (int it = 0; it < 8; ++it) { const int nn = 8 * it + (lane >> 3), c = lane & 7;
        const u32x4 w = *(const LAS u32x4*)(scr + nn * 32 + 4 * (c ^ ((nn >> 2) & 7)));
        *(u32x4*)(dst + (size_t)nn * D + 16 * c) = w; }
    __syncthreads();
}
__device__ __forceinline__ void conv_gu_block(PK P, LAS unsigned char* lds, int le, int which, int nb, int tid) {
    const int n0 = 64 * nb, drow0 = 256 * (n0 >> 7) + (n0 & 127) + (which ? 128 : 0);
    conv_q8_block(P->in[which ? 25 : 23] + (size_t)le * D * D + n0, D, WSP(unsigned char, WS_WGU) + ((size_t)le * 2048 + drow0) * D, WSP(float, WS_SBW) + (size_t)le * 2048 + drow0, lds, tid);
}
__device__ __forceinline__ void conv_in_block(PK P, LAS unsigned char* lds, int blk, int tid) {
    if (blk < 48) { const int s = blk / 24, nb = blk % 24;
        conv_q8_block(P->in[9] + (size_t)s * D * A_IN + 64 * nb, A_IN, WSP(unsigned char, WS_WA_IN) + ((size_t)s * A_IN + 64 * nb) * D, WSP(float, WS_SBI) + s * A_IN + 64 * nb, lds, tid); }
    else { const int nb = blk - 48;
        conv_q8_block(P->in[12] + 64 * nb, B_IN, WSP(unsigned char, WS_WB_IN) + (size_t)64 * nb * D, WSP(float, WS_SBI) + 2 * A_IN + 64 * nb, lds, tid); }
}
constexpr int CV_SLOTS = 1536;
__device__ __forceinline__ void conv_slot(PK P, LAS unsigned char* lds, int L, int s, int tid) {
    if (s < 1024) { conv_gu_block(P, lds, L * NEXP + (s >> 5), (s >> 4) & 1, s & 15, tid); return; }
    const int d = s - 1024, le = L * NEXP + (d >> 4), nb = d & 15;
    conv_q8_block(P->in[27] + (size_t)le * D * D + 64 * nb, D, WSP(unsigned char, WS_WD) + ((size_t)le * D + 64 * nb) * D, WSP(float, WS_SBD) + (size_t)le * D + 64 * nb, lds, tid);
}
__device__ __forceinline__ void conv_claim(PK P, LAS unsigned char* lds, int L, int quota, int tid) {
    LAS int* slot = (LAS int*)(lds + MISC_OFF + M_CVB);
    unsigned* ctr = WSP(unsigned, WS_CTL) + CW_CV + L * 16;
    for (int q = 0; q < quota; ++q) {
        __syncthreads();
        if (tid == 0) *slot = (int)__hip_atomic_fetch_add(ctr, 1u, __ATOMIC_RELAXED, __HIP_MEMORY_SCOPE_AGENT);
        __syncthreads();
        const int sl = __builtin_amdgcn_readfirstlane(*slot);
        if (sl >= CV_SLOTS) break;
        conv_slot(P, lds, L, sl, tid);
    }
    __syncthreads();
}
__device__ __forceinline__ void phase_prologue(PK P, LAS unsigned char* lds, int bid, int tid) {
    const int lane = tid & 63, wid = __builtin_amdgcn_readfirstlane(tid >> 6);
    {
        LAS float* S = (LAS float*)lds; LAS float* red = (LAS float*)(lds + 40960);
        for (int idx = tid; idx < 9 * D; idx += 512) { const int r = idx >> 10, d = idx & (D - 1); const float v = r < 8 ? P->in[1][r * D + d] : P->in[3][d];
            S[idx] = v / (1.0f + __builtin_amdgcn_exp2f(-v * LOG2E)); }
        __syncthreads();
        const int l = bid >> 6, c0 = (bid & 63) * 96;
        if (lane < 48) {
            float acc[9][2];
#pragma unroll
            for (int r = 0; r < 9; ++r) { acc[r][0] = 0.f; acc[r][1] = 0.f; }
            const float* wp = P->in[4] + ((size_t)l * D + 128 * wid) * 6144 + c0 + 2 * lane;
            const LAS float* sp = S + 128 * wid;
#pragma unroll 8
            for (int k = 0; k < 128; ++k) { const f32x2 w = *(const f32x2*)(wp + (size_t)k * 6144);
#pragma unroll
                for (int r = 0; r < 9; ++r) { const float s = sp[r * D + k]; acc[r][0] += s * w[0]; acc[r][1] += s * w[1]; } }
#pragma unroll
            for (int r = 0; r < 9; ++r) { red[(wid * 9 + r) * 96 + 2 * lane] = acc[r][0]; red[(wid * 9 + r) * 96 + 2 * lane + 1] = acc[r][1]; }
        }
        __syncthreads();
        float* MOD = WSP(float, WS_MOD);
        for (int idx = tid; idx < 9 * 96; idx += 512) { const int r = idx / 96, cc = idx % 96; float s = 0.f;
#pragma unroll
            for (int w = 0; w < 8; ++w) s += red[(w * 9 + r) * 96 + cc];
            MOD[((size_t)l * 9 + r) * 6144 + c0 + cc] = s + P->in[5][(size_t)l * 6144 + c0 + cc]; }
        __syncthreads();
    }
    {
        const int gt = bid * 512 + tid; float* RA = WSP(float, WS_ROPE_A); float* RC = WSP(float, WS_ROPE_C);
        const float L2T = 13.287712379549449f;
        for (int idx = gt; idx < SEQ * 32; idx += 131072) { const int t = idx >> 5, i = idx & 31; const float pos = (float)(i < 16 ? (t >> 6) : (t & 63));
            const float inv = __builtin_amdgcn_exp2f(-(float)(i & 15) * (1.0f / 16.0f) * L2T); const float ang = pos * inv; RA[2 * idx] = __cosf(ang); RA[2 * idx + 1] = __sinf(ang); }
        for (int idx = gt; idx < SEQ * 16; idx += 131072) { const int t = idx >> 4, i = idx & 15; const float pos = (float)(i < 8 ? (t >> 6) : (t & 63));
            const float inv = __builtin_amdgcn_exp2f(-(float)(i & 7) * (1.0f / 8.0f) * L2T); const float ang = pos * inv; RC[2 * idx] = __cosf(ang); RC[2 * idx + 1] = __sinf(ang); }
        bf16_t* WU = WSP(bf16_t, WS_WC_UP); const u32x4 z = (u32x4){0u, 0u, 0u, 0u};
        for (int idx = gt; idx < 1536 * 16; idx += 131072) *(u32x4*)(WU + (size_t)(idx >> 4) * C_UPK + 256 + 8 * (idx & 15)) = z;
        for (int idx = gt; idx < 2048 * 32; idx += 131072) *(u32x4*)(WU + (size_t)(1536 + (idx >> 5)) * C_UPK + 8 * (idx & 31)) = z;
    }
    {
        LAS unsigned* scr = (LAS unsigned*)(lds + wid * 8192);
        const int gw = bid * 8 + wid;
        for (int item = gw; item < CV_SMALL; item += 2048) conv_dispatch(P, item, scr, lane);
        __syncthreads();
        for (int blk = bid; blk < 96; blk += 256) conv_in_block(P, lds, blk, tid);
        for (int sl = bid; sl < CV_SLOTS; sl += 256) conv_slot(P, lds, 0, sl, tid);
    }
}

constexpr int PH_PRO = 0, PH_N0 = 1, PH_L0 = 2, PH_PER_LAYER = 9, PH_FINAL = PH_L0 + DEPTH * PH_PER_LAYER, NPH = PH_FINAL + 1;
enum { LP_IN = 0, LP_MLANORM = 1, LP_MLAUP = 2, LP_ATT = 3, LP_OUT = 4, LP_RT = 5, LP_GU = 6, LP_DN = 7, LP_CB = 8 };
struct Args { Ptrs P; int p_lo, p_hi, bar_idx, pad; };

__global__ void __launch_bounds__(512, 2) mk_fwd(Args a) {
    extern __shared__ __attribute__((aligned(16))) unsigned char lds_raw[];
    LAS unsigned char* const lds = (LAS unsigned char*)lds_raw;
    LAS unsigned char* const misc = lds + MISC_OFF;
    typedef const __attribute__((address_space(4))) Args* ArgsK;
    const ArgsK ak = (ArgsK)__builtin_amdgcn_kernarg_segment_ptr();
    (void)a;
    const int wid0 = __builtin_amdgcn_readfirstlane((int)threadIdx.x >> 6);
    if (wid0 == 0 && lane_id() < 4) ((LAS unsigned*)(misc + M_BARW))[lane_id()] = 0u;
    __syncthreads();
    XcdBarrier bar;
    { PK P = &ak->P; bar = xcd_barrier_post(WSP(unsigned, WS_CTL) + CW_BAR + ak->bar_idx * XCD_BAR_WORDS, (volatile LAS unsigned*)(misc + M_BARW), wid0 == 0); }
    bool ran = false;
    const int p_lo = ak->p_lo, p_hi = ak->p_hi;
#define PHASE_BEGIN(bit, p, cond) if ((((MK_MASK) >> (bit)) & 1) && p_lo <= (p) && (p) < p_hi && ((p) <= MK_STOP_AFTER || (p) == PH_FINAL) && (cond)) for (int rep_ = 0; rep_ < 1 + (((MK_REP_MASK) >> (bit)) & 1); ++rep_) { if (ran) xcd_barrier(bar); ran = true; \
    int tid = wid0 * 64 + lane_id(); asm volatile("" : "+v"(tid)); int bid = blockIdx.x; asm volatile("" : "+s"(bid)); ArgsK ak_ = ak; asm volatile("" : "+s"(ak_)); PK P = &ak_->P; \
    const int lane = tid & 63, wid = __builtin_amdgcn_readfirstlane(tid >> 6), vcu = (bid & 7) * 32 + (bid >> 3), gw = vcu * 8 + wid; (void)lane; (void)gw; (void)P;
#define PHASE_END }

    PHASE_BEGIN(0, PH_PRO, true) phase_prologue(P, lds, bid, tid); PHASE_END
    PHASE_BEGIN(1, PH_N0, true) phase_first_norm(P, gw, lane); PHASE_END

    for (int l = 0; l < DEPTH; ++l) {
        const int kind = l % 3, slot = l / 3, pb = PH_L0 + l * PH_PER_LAYER;
        const bool last = (l == DEPTH - 1);
        const int nMrows = last ? NL / 256 : NT / 256;
        PHASE_BEGIN(2, pb + LP_IN, kind == 0) {
            pg8::Gemm g{WSP(const void, WS_H), WSP(const unsigned char, WS_WA_IN) + (size_t)slot * A_IN * D, D, 0, nullptr};
            pg8::DenseOrder S{nMrows, 6, vcu, last ? 8 : 0, 4, 2};
            pg8::EpiQkvA8 E{WSP(bf16_t, WS_QKV), WSP(const float, WS_ROPE_A), WSP(const float, WS_SAH), WSP(const float, WS_SBI) + slot * A_IN, (const LAS float*)(misc + M_EPF)};
            pg8::gemm_phase<pg8::EpiQkvA8, pg8::DenseOrder, false, true>(lds, g, S, E, tid);
            if (l >= 1 && S.short_one()) conv_claim(P, lds, l, MK_Q_IN, tid);
        } PHASE_END
        PHASE_BEGIN(3, pb + LP_IN, kind == 1) {
            pg8::Gemm g{WSP(const void, WS_H), WSP(const unsigned char, WS_WB_IN), D, 0, nullptr};
            pg8::DenseOrder S{NT / 256, 12, vcu, 0, 0, 0};
            pg8::EpiBf16Plain8 E{WSP(bf16_t, WS_QKV), B_IN, 4, 0.125f * LOG2E, WSP(const float, WS_SAH), WSP(const float, WS_SBI) + 2 * A_IN, (const LAS float*)(misc + M_EPF)};
            pg8::gemm_phase<pg8::EpiBf16Plain8, pg8::DenseOrder, false, true>(lds, g, S, E, tid);
            if (S.short_one()) conv_claim(P, lds, l, MK_Q_IN, tid);
        } PHASE_END
        PHASE_BEGIN(4, pb + LP_IN, kind == 2) {
            pg8::Gemm g{WSP(const bf16_t, WS_H), WSP(const bf16_t, WS_WC_IN), D, 0, nullptr};
            pg8::DenseOrder S{NT / 256, 2, vcu, 0, 0, 0};
            pg8::EpiF32Plain E{WSP(float, WS_Y416), C_INP};
            pg8::gemm_phase<pg8::EpiF32Plain, pg8::DenseOrder, false>(lds, g, S, E, tid);
        } PHASE_END
        PHASE_BEGIN(5, pb + LP_MLANORM, kind == 2) phase_mla_norm(P, gw, lane); PHASE_END
        PHASE_BEGIN(6, pb + LP_MLAUP, kind == 2) {
            pg8::Gemm g{WSP(const bf16_t, WS_CQKV), WSP(const bf16_t, WS_WC_UP), C_UPK, 0, nullptr};
            pg8::DenseOrder S{NT / 256, 14, vcu, 0, 0, 0};
            pg8::EpiMlaUp E{WSP(bf16_t, WS_QKV), WSP(const float, WS_ROPE_C)};
            pg8::gemm_phase<pg8::EpiMlaUp, pg8::DenseOrder, false>(lds, g, S, E, tid);
        } PHASE_END
        PHASE_BEGIN(7, pb + LP_ATT, kind == 0) {
            const bf16_t* QKV = WSP(const bf16_t, WS_QKV); bf16_t* O = WSP(bf16_t, WS_O); const float* sink = P->in[11] + slot * 16;
            for (int u = vcu; u < 1024; u += 256) { const int bk = u >> 5; att::attn_A_unit(lds, QKV, O, sink, bk >> 2, bk & 3, u & 31, false, tid); }
            if (!last) for (int u = vcu; u < 128; u += 256) { const int bk = u >> 2; att::attn_A_unit(lds, QKV, O, sink, bk >> 2, bk & 3, u & 3, true, tid); }
        } PHASE_END
        PHASE_BEGIN(8, pb + LP_ATT, kind == 1) {
            const bf16_t* QKV = WSP(const bf16_t, WS_QKV); bf16_t* O = WSP(bf16_t, WS_O); LAS float* tab = (LAS float*)(misc + M_RPB);
            for (int u = vcu; u < 1024; u += 256) { const int bh = u >> 3; att::attn_B_unit(lds, tab, QKV, O, P->in[14], bh >> 4, bh & 15, u & 7, false, tid); }
            for (int u = vcu; u < 128; u += 256) att::attn_B_unit(lds, tab, QKV, O, P->in[14], u >> 4, u & 15, 0, true, tid);
        } PHASE_END
        PHASE_BEGIN(9, pb + LP_ATT, kind == 2) {
            const bf16_t* QKV = WSP(const bf16_t, WS_QKV); bf16_t* O = WSP(bf16_t, WS_O); const bf16_t* KR = WSP(const bf16_t, WS_KR);
            for (int u = vcu; u < 1024; u += 256) { const int bh = u >> 3; att::attn_C_unit(lds, QKV, KR, O, bh >> 4, bh & 15, u & 7, false, tid); }
            for (int u = vcu; u < 128; u += 256) att::attn_C_unit(lds, QKV, KR, O, u >> 4, u & 15, 0, true, tid);
        } PHASE_END
        PHASE_BEGIN(10, pb + LP_OUT, true) {
            const bf16_t* W = kind == 0 ? WSP(const bf16_t, WS_WA_OUT) + (size_t)slot * D * D : (kind == 1 ? WSP(const bf16_t, WS_WB_OUT) : WSP(const bf16_t, WS_WC_OUT));
            pg8::Gemm g{WSP(const bf16_t, WS_O), W, D, 0, nullptr};
            pg8::DenseOrder S{nMrows, 4, vcu, 0, 0, 0};
            pg8::EpiResid E{(const LAS float*)(misc + M_EPF), WSP(bf16_t, WS_XS), WSP(const float, WS_MOD) + (size_t)l * 9 * 6144 + 2048, (rep_ + 1 < 1 + ((MK_REP_MASK >> 10) & 1)) ? WSP(bf16_t, WS_ACT) : WSP(bf16_t, WS_XS)};
            pg8::gemm_phase<pg8::EpiResid, pg8::DenseOrder, false>(lds, g, S, E, tid);
            if (!last && S.short_one()) conv_claim(P, lds, l + 1, MK_Q_OUT, tid);
        } PHASE_END
        PHASE_BEGIN(11, pb + LP_RT, true) { if (l >= 1) conv_claim(P, lds, l, 1 << 30, tid); phase_router(P, lds, l, last ? NL : NT, vcu, tid, rep_); } PHASE_END
        PHASE_BEGIN(12, pb + LP_GU, true) {
            moe_tables(misc, WSP(unsigned, WS_CTL) + CW_CNT + (l * 2 + ((MK_REP_MASK >> 11) & 1)) * 512, tid);
            pg8::Gemm g{WSP(const void, WS_H), WSP(const unsigned char, WS_WGU) + (size_t)l * NEXP * 2 * D * D, D, (size_t)2 * D * D, WSP(const int, WS_ELIST)};
            const bool cvw = !last && MK_CVW_GU > 0 && (vcu & 15) == 15;
            const int Gc = (!last && MK_CVW_GU > 0) ? 240 : 256, ic = (!last && MK_CVW_GU > 0) ? (cvw ? -1 : vcu - (vcu >> 4)) : vcu;
            pg8::MoeOrder S{(const LAS int*)(misc + M_ECNT), (const LAS int*)(misc + M_LBASE), (const LAS int*)(misc + M_CUMT), 8, ic, Gc, (LAS int*)(misc + M_UL)}; S.build(tid);
            pg8::EpiSwiglu8 E{WSP(bf16_t, WS_ACT), P->in[24] + (size_t)l * NEXP * D, P->in[26] + (size_t)l * NEXP * D, WSP(const float, WS_SAL), WSP(const float, WS_SBW) + (size_t)l * NEXP * 2048, (const LAS float*)(misc + M_EPF)};
            pg8::gemm_phase<pg8::EpiSwiglu8, pg8::MoeOrder, true, true>(lds, g, S, E, tid);
            if (!last && (cvw || S.short_one())) conv_claim(P, lds, l + 1, cvw ? MK_CVW_GU : MK_Q_GU, tid);
        } PHASE_END
        PHASE_BEGIN(13, pb + LP_DN, true) {
            moe_tables(misc, WSP(unsigned, WS_CTL) + CW_CNT + (l * 2 + ((MK_REP_MASK >> 11) & 1)) * 512, tid);
            phase_requant(P, (const LAS int*)(misc + M_CUMT), gw, lane);
            xcd_barrier(bar);
            const bool cvw = !last && MK_CVW_DN > 0 && (vcu & 15) == 15;
            const int Gc = (!last && MK_CVW_DN > 0) ? 240 : 256, ic = (!last && MK_CVW_DN > 0) ? (cvw ? -1 : vcu - (vcu >> 4)) : vcu;
            pg8::Gemm g{WSP(const void, WS_ACT8), WSP(const unsigned char, WS_WD) + (size_t)l * NEXP * D * D, D, (size_t)D * D, nullptr};
            pg8::MoeOrder S{(const LAS int*)(misc + M_ECNT), (const LAS int*)(misc + M_LBASE), (const LAS int*)(misc + M_CUMT), 4, ic, Gc, (LAS int*)(misc + M_UL)}; S.build(tid);
            pg8::EpiDown8 E{WSP(bf16_t, WS_YS), P->in[28] + (size_t)l * NEXP * D, WSP(const float, WS_SAQ), WSP(const float, WS_SBD) + (size_t)l * NEXP * D, (const LAS float*)(misc + M_EPF)};
            pg8::gemm_phase<pg8::EpiDown8, pg8::MoeOrder, false, true>(lds, g, S, E, tid);
            if (!last && (cvw || S.short_one())) conv_claim(P, lds, l + 1, cvw ? MK_CVW_DN : MK_Q_DN, tid);
        } PHASE_END
        PHASE_BEGIN(14, pb + LP_CB, true) phase_combine(P, lds, l, last ? NL : NT, gw, tid, (rep_ + 1 < 1 + ((MK_REP_MASK >> 14) & 1))); PHASE_END
    }
    PHASE_BEGIN(15, PH_FINAL, MK_STOP_AFTER < PH_FINAL - 1) phase_final_norm(P, gw, lane); PHASE_END
#undef PHASE_BEGIN
#undef PHASE_END
}

extern "C" void kernel_launch(void* const* d_in, const int* in_sizes, int n_in, void* d_out, int out_size, void* d_ws, size_t ws_size, hipStream_t stream) {
    static int grid = 0;
    if (grid == 0) {
        if (n_in != 29 || out_size != NL * D || ws_size < WS_END) { fprintf(stderr, "kernel_launch: expected 29 inputs, out %d, ws >= %zu; got n_in %d out %d ws %zu\n", NL * D, (size_t)WS_END, n_in, out_size, ws_size); grid = -1; return; }
        int dev = 0, cus = 0, per_cu = 0;
        if (hipGetDevice(&dev) != hipSuccess || hipDeviceGetAttribute(&cus, hipDeviceAttributeMultiprocessorCount, dev) != hipSuccess) { grid = -1; return; }
        if (hipFuncSetAttribute((const void*)mk_fwd, hipFuncAttributeMaxDynamicSharedMemorySize, LDS_BYTES) != hipSuccess) { fprintf(stderr, "kernel_launch: hipFuncSetAttribute failed\n"); grid = -1; return; }
        if (hipOccupancyMaxActiveBlocksPerMultiprocessor(&per_cu, (const void*)mk_fwd, 512, LDS_BYTES) != hipSuccess || per_cu < 1) fprintf(stderr, "kernel_launch: occupancy query says %d\n", per_cu);
        (void)hipGetLastError();
        grid = 256;
        if (cus < 256) { fprintf(stderr, "kernel_launch: needs 256 CUs, device has %d\n", cus); grid = -1; return; }
    }
    if (grid < 0) return;
    if (hipMemsetAsync((char*)d_ws + WS_CTL, 0, CTL_BYTES, stream) != hipSuccess) return;
    Args a{};
    for (int i = 0; i < 29; ++i) a.P.in[i] = (const float*)d_in[i];
    a.P.out = (float*)d_out; a.P.ws = (unsigned char*)d_ws; a.pad = 0;
#if MK_PER_PHASE
    for (int p = 0; p < NPH; ++p) { a.p_lo = p; a.p_hi = p + 1; a.bar_idx = 0; hipLaunchKernelGGL(mk_fwd, dim3(grid), dim3(512), LDS_BYTES, stream, a); }
#else
    a.p_lo = 0; a.p_hi = NPH; a.bar_idx = 0;
    hipLaunchKernelGGL(mk_fwd, dim3(grid), dim3(512), LDS_BYTES, stream, a);
#endif
    const hipError_t le = hipPeekAtLastError();
    if (le != hipSuccess) fprintf(stderr, "kernel_launch: launch failed: %s\n", hipGetErrorName(le));
}
```

```cpp
#include <hip/hip_runtime.h>
#include <cstdio>
#include <cstdint>

#ifndef MK_PER_PHASE
#define MK_PER_PHASE 0
#endif
#ifndef MK_MASK
#define MK_MASK 0xFFFF
#endif
#ifndef MK_REP_MASK
#define MK_REP_MASK 0
#endif
#ifndef MK_Q_OUT
#define MK_Q_OUT 1
#endif
#ifndef MK_Q_GU
#define MK_Q_GU 1
#endif
#ifndef MK_Q_DN
#define MK_Q_DN 1
#endif
#ifndef MK_Q_IN
#define MK_Q_IN 1
#endif
#ifndef MK_MT_MAJOR
#define MK_MT_MAJOR 1
#endif
#ifndef MK_CVW_GU
#define MK_CVW_GU 0
#endif
#ifndef MK_CVW_DN
#define MK_CVW_DN 0
#endif
#ifndef MK_STOP_AFTER
#define MK_STOP_AFTER 9999
#endif

#define LAS __attribute__((address_space(3)))
#define GAS __attribute__((address_space(1)))
typedef unsigned short bf16_t;
typedef short bf16x8 __attribute__((ext_vector_type(8)));
typedef short s16x4 __attribute__((ext_vector_type(4)));
typedef _Float16 f16x8 __attribute__((ext_vector_type(8)));
typedef _Float16 f16x2 __attribute__((ext_vector_type(2)));
typedef float f32x2 __attribute__((ext_vector_type(2)));
typedef float f32x4 __attribute__((ext_vector_type(4)));
typedef float f32x16 __attribute__((ext_vector_type(16)));
typedef unsigned u32x2 __attribute__((ext_vector_type(2)));
typedef unsigned u32x4 __attribute__((ext_vector_type(4)));
typedef int i32x4 __attribute__((ext_vector_type(4)));

constexpr int D = 1024, NB = 8, SEQ = 2048, CTXL = 256, DEPTH = 4;
constexpr int NL = NB * SEQ;
constexpr int NC = NB * CTXL;
constexpr int NT = NL + NC;
constexpr int NEXP = 32, TOPK = 4;
constexpr int MAXSLOT = 81920;
constexpr float NORM_EPS = 1e-6f;
constexpr float LOG2E = 1.4426950408889634f;
constexpr int A_IN = 1536, B_IN = 3072, C_IN = 416, C_INP = 512, C_UPK = 384, C_UPN = 3584;

constexpr size_t MiB = 1u << 20;
constexpr size_t WS_CTL = 0, CTL_BYTES = 1 * MiB;
constexpr size_t WS_MOD = 1 * MiB;
constexpr size_t WS_ROPE_A = 2 * MiB;
constexpr size_t WS_ROPE_C = 2 * MiB + 512 * 1024;
constexpr size_t WS_TOPE = 3 * MiB;
constexpr size_t WS_POS = 3 * MiB + 512 * 1024;
constexpr size_t WS_GATE = 4 * MiB;
constexpr size_t WS_ELIST = 5 * MiB;
constexpr size_t WS_KR = 8 * MiB;
constexpr size_t WS_CQKV = 10 * MiB;
constexpr size_t WS_Y416 = 24 * MiB;
constexpr size_t WS_XS = 60 * MiB;
constexpr size_t WS_H = 132 * MiB;
constexpr size_t WS_O = 168 * MiB;
constexpr size_t WS_QKV = 204 * MiB;
constexpr size_t WS_ACT = 330 * MiB;
constexpr size_t WS_YS = 490 * MiB;
constexpr size_t WS_WA_IN = 650 * MiB;
constexpr size_t WS_WA_OUT = 656 * MiB;
constexpr size_t WS_WB_IN = 660 * MiB;
constexpr size_t WS_WB_OUT = 666 * MiB;
constexpr size_t WS_WC_IN = 668 * MiB;
constexpr size_t WS_WC_UP = 669 * MiB;
constexpr size_t WS_WC_OUT = 672 * MiB;
constexpr size_t WS_WGU = 676 * MiB;
constexpr size_t WS_WD = 1188 * MiB;
constexpr size_t WS_G16 = 1444 * MiB;
constexpr size_t WS_RC = 1447 * MiB;
constexpr size_t WS_SBW = 1448 * MiB;
constexpr size_t WS_SAL = 1449 * MiB;
constexpr size_t WS_SAH = 1452 * MiB;
constexpr size_t WS_SBI = 1452 * MiB + 128 * 1024;
constexpr size_t WS_ACT8 = 1453 * MiB;
constexpr size_t WS_SAQ = 1533 * MiB;
constexpr size_t WS_SBD = 1533 * MiB + 512 * 1024;
constexpr size_t WS_END = 1535 * MiB;

constexpr int CW_CV = 512;
constexpr int CW_CNT = 1024;
constexpr int CW_BAR = 65536;

constexpr int RING_BYTES = 131072;
constexpr int MISC_OFF = RING_BYTES;
constexpr int M_BARW = 0, M_LCNT = 64, M_LBASE = 192, M_CUMT = 320, M_ECNT = 512, M_GBASE = 640, M_CVB = 768, M_UL = 6656, M_RSA = 7424, M_EPF = 8192, M_RPB = 1024, M_REC = 3072;
constexpr int LDS_BYTES = 147456;

#define XB_TMO      128
#define XB_XCNT(j)  (256  + 64 * (j))
#define XB_XSUB(j)  (1280 + 64 * (j))
#define XB_XGEN(j)  (2304 + 64 * (j))
#define XB_TOP      3328
#define XB_TOPGEN   3392
#define XCD_BAR_WORDS 3456
#define XB_SPIN_CAP (1u << 18)

__device__ __forceinline__ unsigned xb_ld(unsigned* p)              { return __hip_atomic_load(p, __ATOMIC_RELAXED, __HIP_MEMORY_SCOPE_AGENT); }
__device__ __forceinline__ unsigned xb_add(unsigned* p, unsigned v) { return __hip_atomic_fetch_add(p, v, __ATOMIC_RELAXED, __HIP_MEMORY_SCOPE_AGENT); }
__device__ __forceinline__ unsigned xb_xcc_id() { return (unsigned)__builtin_amdgcn_s_getreg((3 << 11) | 20) & 0xFu; }
#define XB_SPIN(cond, bar) do { unsigned _sp = 0; while (cond) { __builtin_amdgcn_s_sleep(1); \
    if ((++_sp & 255u) == 0u) { if (xb_ld(&(bar)[XB_TMO])) break; if (_sp > XB_SPIN_CAP) { atomicAdd(&(bar)[XB_TMO], 1u); break; } } } } while (0)

__device__ __forceinline__ int lane_id() { int r; asm volatile("v_mbcnt_lo_u32_b32 %0, -1, 0\n\tv_mbcnt_hi_u32_b32 %0, -1, %0" : "=v"(r)); return r; }
struct XcdBarrier {
    unsigned* bar; unsigned x;
    volatile LAS unsigned* st;
    bool lead;
};
__device__ __forceinline__ XcdBarrier xcd_barrier_post(unsigned* bar, volatile LAS unsigned* st, bool lead) {
    XcdBarrier b; b.bar = bar; b.x = xb_xcc_id(); b.st = st; b.lead = lead;
    if (lead && lane_id() == 0) (void)xb_add(&bar[XB_XCNT(b.x)], 1u);
    return b;
}
__device__ __forceinline__ void xcd_barrier_complete(unsigned* bar, unsigned x, unsigned& nloc, unsigned& nx) {
    const unsigned G = gridDim.x * gridDim.y * gridDim.z;
    unsigned sum, cnt, mine, sp = 0u;
    for (;;) {
        sum = 0u; cnt = 0u; mine = 0u;
#pragma unroll
        for (unsigned j = 0; j < 16; ++j) { const unsigned c = xb_ld(&bar[XB_XCNT(j)]); sum += c; cnt += (c > 0u) ? 1u : 0u; mine = (j == x) ? c : mine; }
        if (sum == G) break;
        __builtin_amdgcn_s_sleep(1);
        if ((++sp & 255u) == 0u) { if (xb_ld(&bar[XB_TMO])) break; if (sp > XB_SPIN_CAP) { atomicAdd(&bar[XB_TMO], 1u); break; } }
    }
    nloc = mine > 0u ? mine : 1u; nx = cnt > 0u ? cnt : 1u;
}
__device__ __forceinline__ void xcd_barrier(const XcdBarrier& b) {
    asm volatile("s_waitcnt vmcnt(0)" ::: "memory");
    __syncthreads();
    if (b.lead && lane_id() == 0) {
        unsigned* bar = b.bar;
        __builtin_amdgcn_s_waitcnt(0);
        unsigned nloc = b.st[0], nx = b.st[1];
        if (nloc == 0u) { xcd_barrier_complete(bar, b.x, nloc, nx); b.st[0] = nloc; b.st[1] = nx; }
        const unsigned old = xb_add(&bar[XB_XSUB(b.x)], 1u);
        const unsigned gen = old / nloc;
        if (old + 1u == (gen + 1u) * nloc) {
            __builtin_amdgcn_fence(__ATOMIC_RELEASE, "agent");
            asm volatile("s_waitcnt vmcnt(0)" ::: "memory");
            const unsigned og = xb_add(&bar[XB_TOP], 1u);
            const unsigned tg = og / nx;
            if (og + 1u == (tg + 1u) * nx) xb_add(&bar[XB_TOPGEN], 1u);
            else XB_SPIN(xb_ld(&bar[XB_TOPGEN]) == tg, bar);
            __builtin_amdgcn_fence(__ATOMIC_ACQUIRE, "agent");
            xb_add(&bar[XB_XGEN(b.x)], 1u);
            asm volatile("s_waitcnt vmcnt(0)" ::: "memory");
        } else {
            XB_SPIN(xb_ld(&bar[XB_XGEN(b.x)]) == gen, bar);
            __builtin_amdgcn_fence(__ATOMIC_ACQUIRE, "agent");
            asm volatile("s_waitcnt vmcnt(0)" ::: "memory");
        }
    }
    __syncthreads();
}

__device__ __forceinline__ unsigned cvt_pk_bf16(float lo, float hi) { unsigned r; asm volatile("v_cvt_pk_bf16_f32 %0, %1, %2" : "=v"(r) : "v"(lo), "v"(hi)); return r; }
__device__ __forceinline__ float bf_lo(unsigned w) { return __uint_as_float(w << 16); }
__device__ __forceinline__ float bf_hi(unsigned w) { return __uint_as_float(w & 0xffff0000u); }
__device__ __forceinline__ float shx(float v, int mask, int lane) { return __int_as_float(__builtin_amdgcn_ds_bpermute((lane ^ mask) << 2, __float_as_int(v))); }
__device__ __forceinline__ float wave_sum(float v, int lane) {
#pragma unroll
    for (int o = 1; o < 64; o <<= 1) v += shx(v, o, lane);
    return v;
}
__device__ __forceinline__ float wave_max(float v, int lane) {
#pragma unroll
    for (int o = 1; o < 64; o <<= 1) v = fmaxf(v, shx(v, o, lane));
    return v;
}
__device__ __forceinline__ float swap32_max(float m) { auto rr = __builtin_amdgcn_permlane32_swap(__float_as_uint(m), __float_as_uint(m), false, false); return fmaxf(__uint_as_float(rr[0]), __uint_as_float(rr[1])); }
__device__ __forceinline__ float swap32_sum(float m) { auto rr = __builtin_amdgcn_permlane32_swap(__float_as_uint(m), __float_as_uint(m), false, false); return __uint_as_float(rr[0]) + __uint_as_float(rr[1]); }

namespace pg8 {
constexpr int BM = 256, BK = 64, HALF = 128, HTB = HALF * BK * 2, STAGE_BYTES = 8 * HTB;
__host__ __device__ __forceinline__ int lds_byte(int r, int c) { const int st = (r >> 4) * 2 + (c >> 5), rr = r & 15, cc = c & 31, ob = rr * 64 + cc * 2; return st * 1024 + (ob ^ (((ob >> 9) & 1) << 5)); }
__host__ __device__ __forceinline__ void stage_rc(int b, int& R, int& C) { const int st = b / 1024, sb = b % 1024, swz = sb ^ (((sb >> 9) & 1) << 5); R = (st >> 1) * 16 + swz / 64; C = (st & 1) * 32 + (swz % 64) / 2; }
__host__ __device__ __forceinline__ int perm32(int rho) { const int n = rho >> 4, i = rho & 15; return 8 * (i >> 2) + 4 * n + (i & 3); }

struct Unit { int pm, pn, e, mt, cnt; };
struct Gemm { const void* A; const void* Bt; int K; size_t bstride; const int* list; };

template <bool I8> struct AccSel { typedef f32x4 type; };
template <> struct AccSel<true> { typedef i32x4 type; };
template <class Epi, class Sched, bool GATHER, bool I8 = false>
__device__ __forceinline__ void gemm_phase(LAS unsigned char* lds, const Gemm g, const Sched& S, const Epi& E, const int tid) {
    const int wid = __builtin_amdgcn_readfirstlane(tid >> 6), lane = tid & 63, wr = wid >> 2, wc = wid & 3, fr = lane & 15, fq = lane >> 4;
    typedef typename AccSel<I8>::type acc_t;
    const int K = g.K, RB = I8 ? K : 2 * K, nt = RB / (BK * 2);
    unsigned voffA[2], voffB[2];
#pragma unroll
    for (int i = 0; i < 2; ++i) { int R, C; stage_rc(tid * 16 + i * 8192, R, C); const int Rb = Epi::PERM ? ((R & ~31) + perm32(R & 31)) : R;
        voffA[i] = (unsigned)(R * RB + C * 2); voffB[i] = (unsigned)(Rb * RB + C * 2); }
#define PG8_RC(i, R_, C_) int R_, C_; { int _t = tid; asm volatile("" : "+v"(_t)); stage_rc(_t * 16 + (i) * 8192, R_, C_); }
    const size_t kstep = (size_t)(BK * 2);
    const size_t hstep = (size_t)HALF * RB;
    const size_t tstep = 2 * hstep;
    const unsigned ldsw = (unsigned)wid * 1024u;
    const int aoff = lds_byte(wr * 64 + fr, fq * 8), boff = lds_byte(wc * 32 + fr, fq * 8);
#define PG8_SA(b, h) (((b) * 2 + (h)) * HTB)
#define PG8_SB(b, h) ((4 + (b) * 2 + (h)) * HTB)
#define PG8_STAGE(bufoff, gbase, voff) do { _Pragma("unroll") for (int _i = 0; _i < 2; ++_i) \
        __builtin_amdgcn_global_load_lds((const unsigned*)((const char*)(gbase) + (voff)[_i]), (LAS unsigned*)(lds + (bufoff) + ldsw + _i * 8192), 16, 0, 0); } while (0)
#define PG8_STAGE_A(bufoff, SELN, H, KOFF) do { if constexpr (GATHER) { unsigned _vo[2]; _vo[0] = (SELN) ? voN[H][0] : voC[H][0]; _vo[1] = (SELN) ? voN[H][1] : voC[H][1]; \
            PG8_STAGE(bufoff, (const char*)g.A + (KOFF), _vo); } else { PG8_STAGE(bufoff, ((SELN) ? nA : cA) + (H) * hstep + (KOFF), voffA); } } while (0)
#define PG8_LDA(dst, b, h) do { _Pragma("unroll") for (int m = 0; m < 4; ++m) _Pragma("unroll") for (int k = 0; k < 2; ++k) dst[m][k] = *(const LAS bf16x8*)(lds + PG8_SA(b, h) + aoff + m * 2048 + k * 1024); } while (0)
#define PG8_LDB(dst, b, h) do { _Pragma("unroll") for (int n = 0; n < 2; ++n) _Pragma("unroll") for (int k = 0; k < 2; ++k) dst[n][k] = *(const LAS bf16x8*)(lds + PG8_SB(b, h) + boff + n * 2048 + k * 1024); } while (0)
#define PG8_MMA(ai, bj, At, Bt) do { __builtin_amdgcn_s_setprio(1); _Pragma("unroll") for (int m = 0; m < 4; ++m) _Pragma("unroll") for (int n = 0; n < 2; ++n) _Pragma("unroll") for (int k = 0; k < 2; ++k) \
        { if constexpr (I8) acc[ai][bj][m][n] = __builtin_amdgcn_mfma_i32_16x16x64_i8(__builtin_bit_cast(i32x4, Bt[n][k]), __builtin_bit_cast(i32x4, At[m][k]), acc[ai][bj][m][n], 0, 0, 0); \
          else acc[ai][bj][m][n] = __builtin_amdgcn_mfma_f32_16x16x32_bf16(Bt[n][k], At[m][k], acc[ai][bj][m][n], 0, 0, 0); } __builtin_amdgcn_s_setprio(0); } while (0)
#define PG8_WAIT_V(n) asm volatile("s_waitcnt vmcnt(" #n ")" ::: "memory")
#define PG8_WAIT_L(n) asm volatile("s_waitcnt lgkmcnt(" #n ")" ::: "memory")
#define PG8_BAR __builtin_amdgcn_s_barrier()
#define PG8_SCHED __builtin_amdgcn_sched_barrier(0)
#define PG8_GATH(U, VO) do { _Pragma("unroll") for (int _h = 0; _h < 2; ++_h) _Pragma("unroll") for (int _i = 0; _i < 2; ++_i) { \
        PG8_RC(_i, _R, _C); int _r = (U).mt * 256 + _h * 128 + _R; _r = _r < (U).cnt ? _r : 0; const int _tok = g.list[(size_t)(U).e * NT + _r]; VO[_h][_i] = (unsigned)(_tok * RB + _C * 2); } } while (0)
    Unit cur, nxt; int ui = 0;
    if (!S.next(0, cur)) return;
    acc_t acc[2][2][4][2];
#pragma unroll
    for (int a = 0; a < 2; ++a)
#pragma unroll
        for (int b = 0; b < 2; ++b)
#pragma unroll
            for (int m = 0; m < 4; ++m)
#pragma unroll
                for (int n = 0; n < 2; ++n) acc[a][b][m][n] = (acc_t){0, 0, 0, 0};
    bf16x8 At[4][2], B0[2][2], B1[2][2];
    unsigned voC[2][2] = {{0u, 0u}, {0u, 0u}}, voN[2][2] = {{0u, 0u}, {0u, 0u}};
    if constexpr (GATHER) { PG8_GATH(cur, voC); }
    const char* cA = GATHER ? (const char*)g.A : (const char*)g.A + (size_t)cur.pm * tstep;
    const size_t bsb = I8 ? g.bstride : 2 * g.bstride;
    const char* cB = (const char*)g.Bt + (size_t)cur.e * bsb + (size_t)cur.pn * tstep;
    const char* nA = cA; const char* nB = cB;
    PG8_STAGE(PG8_SB(0, 0), cB, voffB); PG8_STAGE(PG8_SB(0, 1), cB + hstep, voffB); PG8_STAGE_A(PG8_SA(0, 0), false, 0, 0); PG8_STAGE_A(PG8_SA(0, 1), false, 1, 0);
    if (wr == 1) PG8_BAR;
    PG8_WAIT_V(2); PG8_BAR;
    PG8_STAGE(PG8_SB(1, 0), cB + kstep, voffB); PG8_STAGE_A(PG8_SA(1, 0), false, 0, kstep); PG8_STAGE(PG8_SB(1, 1), cB + hstep + kstep, voffB);
    PG8_WAIT_V(6); PG8_BAR;
    for (;;) {
        const bool has_next = S.next(ui + 1, nxt);
        nA = GATHER ? (const char*)g.A : (has_next ? (const char*)g.A + (size_t)nxt.pm * tstep : cA);
        nB = has_next ? (const char*)g.Bt + (size_t)nxt.e * bsb + (size_t)nxt.pn * tstep : cB;
        int tokN[2][2] = {{0, 0}, {0, 0}};
        if constexpr (GATHER) { if (has_next) {
#pragma unroll
            for (int _h = 0; _h < 2; ++_h)
#pragma unroll
                for (int _i = 0; _i < 2; ++_i) { PG8_RC(_i, _R, _C); (void)_C; int _r = nxt.mt * 256 + _h * 128 + _R; _r = _r < nxt.cnt ? _r : 0; const int* _p = g.list + (size_t)nxt.e * NT + _r;
                    asm volatile("global_load_dword %0, %1, off" : "=v"(tokN[_h][_i]) : "v"(_p) : "memory"); } } }
        unsigned epf[2] = {0u, 0u};
        if constexpr (Epi::PF > 0) {
#pragma unroll
            for (int _k = 0; _k < Epi::PF; ++_k) { const float* _p = E.pf_addr(cur, tid, _k); asm volatile("global_load_dword %0, %1, off" : "=v"(epf[_k]) : "v"(_p) : "memory"); } }
        for (int t = 0; t < nt; t += 2) {
            const bool last = (t == nt - 2);
            const size_t k1 = (size_t)(t + 1) * kstep;
            const size_t k2 = last ? 0 : (size_t)(t + 2) * kstep;
            const size_t k3 = k2 + kstep;
            const char* b2 = (last ? nB : cB) + k2; const char* b3 = b2 + kstep;
            PG8_LDB(B0, 0, 0); PG8_LDB(B1, 0, 1); PG8_SCHED; PG8_LDA(At, 0, 0); PG8_STAGE_A(PG8_SA(1, 1), false, 1, k1);
            PG8_WAIT_V(8); PG8_WAIT_L(0); PG8_BAR; PG8_MMA(0, 0, At, B0); PG8_MMA(0, 1, At, B1); PG8_BAR; PG8_SCHED;
            if constexpr (GATHER) { if (last) { if (has_next) {
                asm volatile("" : "+v"(tokN[0][0]), "+v"(tokN[0][1]), "+v"(tokN[1][0]), "+v"(tokN[1][1]));
                { PG8_RC(0, _R0, _C0); PG8_RC(1, _R1, _C1); (void)_R0; (void)_R1;
#pragma unroll
                for (int _h = 0; _h < 2; ++_h) { voN[_h][0] = (unsigned)(tokN[_h][0] * RB + _C0 * 2); voN[_h][1] = (unsigned)(tokN[_h][1] * RB + _C1 * 2); } } } else {
#pragma unroll
                for (int _h = 0; _h < 2; ++_h) { voN[_h][0] = voC[_h][0]; voN[_h][1] = voC[_h][1]; } } } }
            if constexpr (Epi::PF > 0) { if (last) { asm volatile("" : "+v"(epf[0]), "+v"(epf[1]));
#pragma unroll
                for (int _k = 0; _k < Epi::PF; ++_k) *(LAS unsigned*)(lds + MISC_OFF + M_EPF + (_k * 512 + tid) * 4) = epf[_k]; } }
            PG8_LDA(At, 0, 1); PG8_STAGE(PG8_SB(0, 0), b2, voffB); PG8_STAGE(PG8_SB(0, 1), b2 + hstep, voffB); PG8_STAGE_A(PG8_SA(0, 0), last, 0, k2);
            PG8_WAIT_V(8); PG8_WAIT_L(0); PG8_BAR; PG8_MMA(1, 0, At, B0); PG8_MMA(1, 1, At, B1); PG8_BAR; PG8_SCHED;
            PG8_LDB(B0, 1, 0); PG8_LDB(B1, 1, 1); PG8_SCHED; PG8_LDA(At, 1, 0); PG8_STAGE_A(PG8_SA(0, 1), last, 1, k2);
            PG8_WAIT_V(8); PG8_WAIT_L(0); PG8_BAR; PG8_MMA(0, 0, At, B0); PG8_MMA(0, 1, At, B1); PG8_BAR; PG8_SCHED;
            PG8_LDA(At, 1, 1); PG8_STAGE(PG8_SB(1, 0), b3, voffB); PG8_STAGE(PG8_SB(1, 1), b3 + hstep, voffB); PG8_STAGE_A(PG8_SA(1, 0), last, 0, k3);
            PG8_WAIT_V(8); PG8_WAIT_L(0); PG8_BAR; PG8_MMA(1, 0, At, B0); PG8_MMA(1, 1, At, B1); PG8_BAR; PG8_SCHED;
        }
        if (wr == 0) PG8_BAR;
        { const int ln_ = lane_id(); E(acc, cur, wr, wc, ln_ & 15, ln_ >> 4); }
        if (!has_next) break;
#pragma unroll
        for (int a = 0; a < 2; ++a)
#pragma unroll
            for (int b = 0; b < 2; ++b)
#pragma unroll
                for (int m = 0; m < 4; ++m)
#pragma unroll
                    for (int n = 0; n < 2; ++n) acc[a][b][m][n] = (acc_t){0, 0, 0, 0};
        cur = nxt; cA = nA; cB = nB; ++ui;
        if constexpr (GATHER) {
#pragma unroll
            for (int _h = 0; _h < 2; ++_h) { voC[_h][0] = voN[_h][0]; voC[_h][1] = voN[_h][1]; } }
        if (wr == 1) PG8_BAR;
    }
    PG8_WAIT_V(0);
    PG8_BAR;
#undef PG8_SA
#undef PG8_SB
#undef PG8_STAGE
#undef PG8_STAGE_A
#undef PG8_LDA
#undef PG8_LDB
#undef PG8_MMA
#undef PG8_WAIT_V
#undef PG8_WAIT_L
#undef PG8_BAR
#undef PG8_SCHED
#undef PG8_GATH
#undef PG8_RC
}
}

namespace pg8 {
struct EpiBf16Plain {
    static constexpr bool PERM = true; static constexpr int PF = 0;
    bf16_t* O; int ldc; int qtiles; float qscale;
    __device__ __forceinline__ void operator()(const f32x4 (&acc)[2][2][4][2], const Unit& u, int wr, int wc, int fr, int fq) const {
        const int row0 = u.pm * BM + wr * 64 + fr, col0 = u.pn * BM + wc * 32 + 8 * fq;
        const float qs = u.pn < qtiles ? qscale : 1.0f;
#pragma unroll
        for (int ai = 0; ai < 2; ++ai)
#pragma unroll
            for (int m = 0; m < 4; ++m) { bf16_t* rowp = O + (size_t)(row0 + ai * HALF + m * 16) * ldc + col0;
#pragma unroll
                for (int bj = 0; bj < 2; ++bj) { const f32x4 v0 = acc[ai][bj][m][0] * qs, v1 = acc[ai][bj][m][1] * qs;
                    u32x4 w; w.x = cvt_pk_bf16(v0[0], v0[1]); w.y = cvt_pk_bf16(v0[2], v0[3]); w.z = cvt_pk_bf16(v1[0], v1[1]); w.w = cvt_pk_bf16(v1[2], v1[3]);
                    *(u32x4*)(rowp + bj * HALF) = w; } }
    }
};
struct EpiBf16Plain8 {
    static constexpr bool PERM = true; static constexpr int PF = 1;
    bf16_t* O; int ldc; int qtiles; float qscale; const float* sa; const float* sb; const LAS float* epf;
    __device__ __forceinline__ const float* pf_addr(const Unit& u, int tid, int) const { return tid < 256 ? sb + u.pn * BM + tid : sa + u.pm * BM + (tid - 256); }
    __device__ __forceinline__ void operator()(const i32x4 (&acc)[2][2][4][2], const Unit& u, int wr, int wc, int fr, int fq) const {
        const int row0 = u.pm * BM + wr * 64 + fr, col0 = u.pn * BM + wc * 32 + 8 * fq;
        const float qs = u.pn < qtiles ? qscale : 1.0f;
        f32x4 cs[2][2];
#pragma unroll
        for (int bj = 0; bj < 2; ++bj)
#pragma unroll
            for (int n = 0; n < 2; ++n) cs[bj][n] = *(const LAS f32x4*)(epf + wc * 32 + 8 * fq + bj * HALF + 4 * n) * qs;
#pragma unroll
        for (int ai = 0; ai < 2; ++ai)
#pragma unroll
            for (int m = 0; m < 4; ++m) { const int row = row0 + ai * HALF + m * 16; bf16_t* rowp = O + (size_t)row * ldc + col0; const float sr = epf[256 + wr * 64 + fr + ai * HALF + m * 16];
#pragma unroll
                for (int bj = 0; bj < 2; ++bj) { f32x4 v0, v1;
#pragma unroll
                    for (int j = 0; j < 4; ++j) { v0[j] = (float)acc[ai][bj][m][0][j] * (sr * cs[bj][0][j]); v1[j] = (float)acc[ai][bj][m][1][j] * (sr * cs[bj][1][j]); }
                    u32x4 w; w.x = cvt_pk_bf16(v0[0], v0[1]); w.y = cvt_pk_bf16(v0[2], v0[3]); w.z = cvt_pk_bf16(v1[0], v1[1]); w.w = cvt_pk_bf16(v1[2], v1[3]);
                    *(u32x4*)(rowp + bj * HALF) = w; }
                asm volatile("" ::: "memory"); }
    }
};
struct EpiF32Plain {
    static constexpr bool PERM = false; static constexpr int PF = 0;
    float* C; int ldc;
    __device__ __forceinline__ void operator()(const f32x4 (&acc)[2][2][4][2], const Unit& u, int wr, int wc, int fr, int fq) const {
        const int row0 = u.pm * BM + wr * 64 + fr, col0 = u.pn * BM + wc * 32 + 4 * fq;
#pragma unroll
        for (int ai = 0; ai < 2; ++ai)
#pragma unroll
            for (int m = 0; m < 4; ++m) { float* rowp = C + (size_t)(row0 + ai * HALF + m * 16) * ldc + col0;
#pragma unroll
                for (int bj = 0; bj < 2; ++bj)
#pragma unroll
                    for (int n = 0; n < 2; ++n) *(f32x4*)(rowp + bj * HALF + n * 16) = acc[ai][bj][m][n]; }
    }
};
__device__ __forceinline__ void rope8(f32x4& v0, f32x4& v1, const float* cs) {
    const f32x4 a = *(const f32x4*)cs, b = *(const f32x4*)(cs + 4);
    const float x0 = v0[0], x1 = v0[1], x2 = v0[2], x3 = v0[3], y0 = v1[0], y1 = v1[1], y2 = v1[2], y3 = v1[3];
    v0[0] = x0 * a[0] - x1 * a[1]; v0[1] = x0 * a[1] + x1 * a[0];
    v0[2] = x2 * a[2] - x3 * a[3]; v0[3] = x2 * a[3] + x3 * a[2];
    v1[0] = y0 * b[0] - y1 * b[1]; v1[1] = y0 * b[1] + y1 * b[0];
    v1[2] = y2 * b[2] - y3 * b[3]; v1[3] = y2 * b[3] + y3 * b[2];
}
struct EpiQkvA {
    static constexpr bool PERM = true; static constexpr int PF = 0;
    bf16_t* O; const float* rope;
    __device__ __forceinline__ void operator()(const f32x4 (&acc)[2][2][4][2], const Unit& u, int wr, int wc, int fr, int fq) const {
        const int row0 = u.pm * BM + wr * 64 + fr, col0 = u.pn * BM + wc * 32 + 8 * fq;
        const bool do_rope = (u.pm < NL / 256) && (u.pn < 5);
        const float qs = u.pn < 4 ? 0.125f * LOG2E : 1.0f;
#pragma unroll
        for (int ai = 0; ai < 2; ++ai)
#pragma unroll
            for (int m = 0; m < 4; ++m) { const int row = row0 + ai * HALF + m * 16; bf16_t* rowp = O + (size_t)row * A_IN + col0;
#pragma unroll
                for (int bj = 0; bj < 2; ++bj) { f32x4 v0 = acc[ai][bj][m][0], v1 = acc[ai][bj][m][1];
                    if (do_rope) { const int d = (col0 + bj * HALF) & 63; rope8(v0, v1, rope + ((size_t)(row & (SEQ - 1)) * 32 + (d >> 1)) * 2); }
                    v0 = v0 * qs; v1 = v1 * qs;
                    u32x4 w; w.x = cvt_pk_bf16(v0[0], v0[1]); w.y = cvt_pk_bf16(v0[2], v0[3]); w.z = cvt_pk_bf16(v1[0], v1[1]); w.w = cvt_pk_bf16(v1[2], v1[3]);
                    *(u32x4*)(rowp + bj * HALF) = w; }
                asm volatile("" ::: "memory"); }
    }
};
struct EpiQkvA8 {
    static constexpr bool PERM = true; static constexpr int PF = 1;
    bf16_t* O; const float* rope; const float* sa; const float* sb; const LAS float* epf;
    __device__ __forceinline__ const float* pf_addr(const Unit& u, int tid, int) const { return tid < 256 ? sb + u.pn * BM + tid : sa + u.pm * BM + (tid - 256); }
    __device__ __forceinline__ void operator()(const i32x4 (&acc)[2][2][4][2], const Unit& u, int wr, int wc, int fr, int fq) const {
        const int row0 = u.pm * BM + wr * 64 + fr, col0 = u.pn * BM + wc * 32 + 8 * fq;
        const bool do_rope = (u.pm < NL / 256) && (u.pn < 5);
        const float qs = u.pn < 4 ? 0.125f * LOG2E : 1.0f;
        f32x4 cs[2][2];
#pragma unroll
        for (int bj = 0; bj < 2; ++bj)
#pragma unroll
            for (int n = 0; n < 2; ++n) cs[bj][n] = *(const LAS f32x4*)(epf + wc * 32 + 8 * fq + bj * HALF + 4 * n) * qs;
#pragma unroll
        for (int ai = 0; ai < 2; ++ai)
#pragma unroll
            for (int m = 0; m < 4; ++m) { const int row = row0 + ai * HALF + m * 16; bf16_t* rowp = O + (size_t)row * A_IN + col0; const float sr = epf[256 + wr * 64 + fr + ai * HALF + m * 16];
#pragma unroll
                for (int bj = 0; bj < 2; ++bj) { f32x4 v0, v1;
#pragma unroll
                    for (int j = 0; j < 4; ++j) { v0[j] = (float)acc[ai][bj][m][0][j] * (sr * cs[bj][0][j]); v1[j] = (float)acc[ai][bj][m][1][j] * (sr * cs[bj][1][j]); }
                    if (do_rope) { const int d = (col0 + bj * HALF) & 63; rope8(v0, v1, rope + ((size_t)(row & (SEQ - 1)) * 32 + (d >> 1)) * 2); }
                    u32x4 w; w.x = cvt_pk_bf16(v0[0], v0[1]); w.y = cvt_pk_bf16(v0[2], v0[3]); w.z = cvt_pk_bf16(v1[0], v1[1]); w.w = cvt_pk_bf16(v1[2], v1[3]);
                    *(u32x4*)(rowp + bj * HALF) = w; }
                asm volatile("" ::: "memory"); }
    }
};
struct EpiMlaUp {
    static constexpr bool PERM = true; static constexpr int PF = 0;
    bf16_t* O; const float* rope;
    __device__ __forceinline__ void operator()(const f32x4 (&acc)[2][2][4][2], const Unit& u, int wr, int wc, int fr, int fq) const {
        const int row0 = u.pm * BM + wr * 64 + fr, col0 = u.pn * BM + wc * 32 + 8 * fq;
        const bool qtile = (u.pm < NL / 256) && (u.pn < 6);
        const float qs = u.pn < 6 ? 0.10206207261596575f * LOG2E : 1.0f;
#pragma unroll
        for (int ai = 0; ai < 2; ++ai)
#pragma unroll
            for (int m = 0; m < 4; ++m) { const int row = row0 + ai * HALF + m * 16; bf16_t* rowp = O + (size_t)row * C_UPN + col0;
#pragma unroll
                for (int bj = 0; bj < 2; ++bj) { f32x4 v0 = acc[ai][bj][m][0], v1 = acc[ai][bj][m][1];
                    const int d96 = (col0 + bj * HALF) % 96;
                    if (qtile && d96 >= 64) rope8(v0, v1, rope + ((size_t)(row & (SEQ - 1)) * 16 + ((d96 - 64) >> 1)) * 2);
                    v0 = v0 * qs; v1 = v1 * qs;
                    u32x4 w; w.x = cvt_pk_bf16(v0[0], v0[1]); w.y = cvt_pk_bf16(v0[2], v0[3]); w.z = cvt_pk_bf16(v1[0], v1[1]); w.w = cvt_pk_bf16(v1[2], v1[3]);
                    *(u32x4*)(rowp + bj * HALF) = w; }
                asm volatile("" ::: "memory"); }
    }
};
struct EpiResid {
    static constexpr bool PERM = false; static constexpr int PF = 1;
    const LAS float* epf;
    __device__ __forceinline__ const float* pf_addr(const Unit& u, int tid, int) const { return gmod + (size_t)(u.pm < NL / 256 ? (u.pm >> 3) : 8) * 6144 + u.pn * BM + (tid & 255); }
    bf16_t* XS; const float* gmod; bf16_t* XSo;
    __device__ __forceinline__ void operator()(const f32x4 (&acc)[2][2][4][2], const Unit& u, int wr, int wc, int fr, int fq) const {
        const int row0 = u.pm * BM + wr * 64 + fr, col0 = u.pn * BM + wc * 32 + 4 * fq;
        f32x4 gg[2][2];
#pragma unroll
        for (int bj = 0; bj < 2; ++bj)
#pragma unroll
            for (int n = 0; n < 2; ++n) gg[bj][n] = *(const LAS f32x4*)(epf + wc * 32 + 4 * fq + bj * HALF + n * 16);
#pragma unroll
        for (int ai = 0; ai < 2; ++ai)
#pragma unroll
            for (int m = 0; m < 4; ++m) { const size_t off = (size_t)(row0 + ai * HALF + m * 16) * D + col0;
#pragma unroll
                for (int bj = 0; bj < 2; ++bj)
#pragma unroll
                    for (int n = 0; n < 2; ++n) { const u32x2 w = *(const u32x2*)(XS + off + bj * HALF + n * 16);
                        const f32x4 v = (f32x4){bf_lo(w.x), bf_hi(w.x), bf_lo(w.y), bf_hi(w.y)} + gg[bj][n] * acc[ai][bj][m][n];
                        u32x2 o; o.x = cvt_pk_bf16(v[0], v[1]); o.y = cvt_pk_bf16(v[2], v[3]); *(u32x2*)(XSo + off + bj * HALF + n * 16) = o; } }
    }
};
struct EpiSwiglu {
    static constexpr bool PERM = true; static constexpr int PF = 0;
    bf16_t* ACT; const float* bg; const float* bu;
    __device__ __forceinline__ void operator()(const f32x4 (&acc)[2][2][4][2], const Unit& u, int wr, int wc, int fr, int fq) const {
        const int row0 = u.pm * BM + wr * 64 + fr, col0 = u.pn * HALF + wc * 32 + 8 * fq;
        const float* pg = bg + (size_t)u.e * D + col0; const float* pu = bu + (size_t)u.e * D + col0;
        const f32x4 g0 = *(const f32x4*)pg, g1 = *(const f32x4*)(pg + 4), u0 = *(const f32x4*)pu, u1 = *(const f32x4*)(pu + 4);
#pragma unroll
        for (int ai = 0; ai < 2; ++ai)
#pragma unroll
            for (int m = 0; m < 4; ++m) { bf16_t* rowp = ACT + (size_t)(row0 + ai * HALF + m * 16) * D + col0;
                float r[8];
#pragma unroll
                for (int n = 0; n < 2; ++n)
#pragma unroll
                    for (int j = 0; j < 4; ++j) {
                        float g = acc[ai][0][m][n][j] + (n ? g1[j] : g0[j]); float uu = acc[ai][1][m][n][j] + (n ? u1[j] : u0[j]);
                        g = fminf(g, 7.0f); uu = fminf(fmaxf(uu, -7.0f), 7.0f);
                        const float sg = __builtin_amdgcn_rcpf(1.0f + __builtin_amdgcn_exp2f(-1.702f * LOG2E * g));
                        r[n * 4 + j] = g * sg * (uu + 1.0f); }
                u32x4 w; w.x = cvt_pk_bf16(r[0], r[1]); w.y = cvt_pk_bf16(r[2], r[3]); w.z = cvt_pk_bf16(r[4], r[5]); w.w = cvt_pk_bf16(r[6], r[7]);
                *(u32x4*)rowp = w; }
    }
};
struct EpiSwiglu8 {
    static constexpr bool PERM = true; static constexpr int PF = 2;
    bf16_t* ACT; const float* bg; const float* bu; const float* sal; const float* sbw; const LAS float* epf;
    __device__ __forceinline__ const float* pf_addr(const Unit& u, int tid, int k) const {
        if (k == 1) { const int t = tid & 255; return sal + (size_t)u.e * NT + ((u.mt * 256 + t) < u.cnt ? u.mt * 256 + t : u.mt * 256); }
        const int t = tid & 127;
        return tid < 128 ? bg + (size_t)u.e * D + u.pn * HALF + t : (tid < 256 ? bu + (size_t)u.e * D + u.pn * HALF + t : sbw + (size_t)u.e * 2048 + u.pn * BM + (tid < 384 ? 0 : HALF) + t); }
    __device__ __forceinline__ void operator()(const i32x4 (&acc)[2][2][4][2], const Unit& u, int wr, int wc, int fr, int fq) const {
        const int lr0 = wr * 64 + fr, row0 = u.pm * BM + lr0, col0 = u.pn * HALF + wc * 32 + 8 * fq;
#pragma unroll
        for (int n = 0; n < 2; ++n) {
            const LAS float* pe = epf + wc * 32 + 8 * fq + 4 * n;
            const f32x4 gb = *(const LAS f32x4*)pe, ub = *(const LAS f32x4*)(pe + 128), sg = *(const LAS f32x4*)(pe + 256), su = *(const LAS f32x4*)(pe + 384);
#pragma unroll
            for (int ai = 0; ai < 2; ++ai)
#pragma unroll
                for (int m = 0; m < 4; ++m) { const int lr = lr0 + ai * HALF + m * 16; const float sa_ = epf[512 + lr];
                    float r[4];
#pragma unroll
                    for (int j = 0; j < 4; ++j) {
                        float g = (float)acc[ai][0][m][n][j] * (sa_ * sg[j]) + gb[j];
                        float uu = (float)acc[ai][1][m][n][j] * (sa_ * su[j]) + ub[j];
                        g = fminf(g, 7.0f); uu = fminf(fmaxf(uu, -7.0f), 7.0f);
                        const float sgm = __builtin_amdgcn_rcpf(1.0f + __builtin_amdgcn_exp2f(-1.702f * LOG2E * g));
                        r[j] = g * sgm * (uu + 1.0f); }
                    u32x2 w; w.x = cvt_pk_bf16(r[0], r[1]); w.y = cvt_pk_bf16(r[2], r[3]);
                    *(u32x2*)(ACT + (size_t)(row0 + ai * HALF + m * 16) * D + col0 + 4 * n) = w; }
            asm volatile("" ::: "memory");
        }
    }
};
struct EpiDown {
    static constexpr bool PERM = true; static constexpr int PF = 0;
    bf16_t* YS; const float* bd;
    __device__ __forceinline__ void operator()(const f32x4 (&acc)[2][2][4][2], const Unit& u, int wr, int wc, int fr, int fq) const {
        const int row0 = u.pm * BM + wr * 64 + fr, col0 = u.pn * BM + wc * 32 + 8 * fq;
        const float* pb = bd + (size_t)u.e * D + col0;
        f32x4 bv[2][2];
#pragma unroll
        for (int bj = 0; bj < 2; ++bj)
#pragma unroll
            for (int n = 0; n < 2; ++n) bv[bj][n] = *(const f32x4*)(pb + bj * HALF + 4 * n);
#pragma unroll
        for (int ai = 0; ai < 2; ++ai)
#pragma unroll
            for (int m = 0; m < 4; ++m) { bf16_t* rowp = YS + (size_t)(row0 + ai * HALF + m * 16) * D + col0;
#pragma unroll
                for (int bj = 0; bj < 2; ++bj) { const f32x4 v0 = acc[ai][bj][m][0] + bv[bj][0], v1 = acc[ai][bj][m][1] + bv[bj][1];
                    u32x4 w; w.x = cvt_pk_bf16(v0[0], v0[1]); w.y = cvt_pk_bf16(v0[2], v0[3]); w.z = cvt_pk_bf16(v1[0], v1[1]); w.w = cvt_pk_bf16(v1[2], v1[3]);
                    *(u32x4*)(rowp + bj * HALF) = w; } }
    }
};

struct EpiDown8 {
    static constexpr bool PERM = true; static constexpr int PF = 2;
    bf16_t* YS; const float* bd; const float* saq; const float* sbd; const LAS float* epf;
    __device__ __forceinline__ const float* pf_addr(const Unit& u, int tid, int k) const {
        if (k == 1) return saq + (size_t)u.pm * BM + (tid & 255);
        return (tid < 256 ? bd : sbd) + (size_t)u.e * D + u.pn * BM + (tid & 255); }
    __device__ __forceinline__ void operator()(const i32x4 (&acc)[2][2][4][2], const Unit& u, int wr, int wc, int fr, int fq) const {
        const int row0 = u.pm * BM + wr * 64 + fr, col0 = u.pn * BM + wc * 32 + 8 * fq;
#pragma unroll
        for (int bj = 0; bj < 2; ++bj) {
            const LAS float* pe = epf + wc * 32 + 8 * fq + bj * HALF;
            const f32x4 b0 = *(const LAS f32x4*)pe, b1 = *(const LAS f32x4*)(pe + 4), s0 = *(const LAS f32x4*)(pe + 256), s1 = *(const LAS f32x4*)(pe + 260);
#pragma unroll
            for (int ai = 0; ai < 2; ++ai)
#pragma unroll
                for (int m = 0; m < 4; ++m) { const int row = row0 + ai * HALF + m * 16; const float sr = epf[512 + wr * 64 + fr + ai * HALF + m * 16]; f32x4 v0, v1;
#pragma unroll
                    for (int j = 0; j < 4; ++j) { v0[j] = (float)acc[ai][bj][m][0][j] * (sr * s0[j]) + b0[j]; v1[j] = (float)acc[ai][bj][m][1][j] * (sr * s1[j]) + b1[j]; }
                    u32x4 w; w.x = cvt_pk_bf16(v0[0], v0[1]); w.y = cvt_pk_bf16(v0[2], v0[3]); w.z = cvt_pk_bf16(v1[0], v1[1]); w.w = cvt_pk_bf16(v1[2], v1[3]);
                    *(u32x4*)(YS + (size_t)row * D + col0 + bj * HALF) = w; }
            asm volatile("" ::: "memory");
        }
    }
};
struct DenseOrder {
    int nM, nN, vcu, xM, xN0, xNn;
    __device__ __forceinline__ bool short_one() const { const int U = nM * nN + xM * xNn, R = (U + 255) >> 8; return (U & 255) != 0 && vcu >= U - (R - 1) * 256; }
    __device__ __forceinline__ bool next(int i, Unit& u) const {
        int L = i * 256 + vcu; const int nmain = nM * nN;
        if (L < nmain) { const int nig = 8 * nN, gid = L / nig, fm = gid * 8, rem = nM - fm, gsz = rem < 8 ? rem : 8, w = L % nig; u.pm = fm + w % gsz; u.pn = w / gsz; }
        else { L -= nmain; if (L >= xM * xNn) return false; u.pm = nM + L % xM; u.pn = xN0 + L / xM; }
        u.e = 0; u.mt = 0; u.cnt = 0; return true;
    }
};
struct MoeOrder {
    const LAS int* ecnt; const LAS int* lbase; const LAS int* cumt; int nN, idx, G; LAS int* ul;
    __device__ __forceinline__ bool short_one() const { const int U = cumt[32] * nN, R = (U + G - 1) / G; return (U % G) != 0 && idx >= U - (R - 1) * G; }
    __device__ __forceinline__ void build(int tid) const {
        if (tid < 16) { const int L = tid * G + idx; int e = -1, pn = 0, mt = 0, pm = 0, c = 0;
            if (idx >= 0 && L < cumt[32] * nN) { e = 0; while (cumt[e + 1] * nN <= L) ++e; const int r = L - cumt[e] * nN; c = ecnt[e]; const int mte = (c + 255) >> 8;
                if (MK_MT_MAJOR & (nN == 4 ? 1 : 2)) { pn = r % nN; mt = r / nN; } else { pn = r / mte; mt = r % mte; } pm = (lbase[e] >> 8) + mt; }
            ul[tid * 8 + 0] = e; ul[tid * 8 + 1] = pn; ul[tid * 8 + 2] = mt; ul[tid * 8 + 3] = pm; ul[tid * 8 + 4] = c; }
        __syncthreads();
    }
    __device__ __forceinline__ bool next(int i, Unit& u) const {
        if (i >= 16) return false;
        const int e = __builtin_amdgcn_readfirstlane(ul[i * 8 + 0]);
        if (e < 0) return false;
        u.e = e; u.pn = __builtin_amdgcn_readfirstlane(ul[i * 8 + 1]); u.mt = __builtin_amdgcn_readfirstlane(ul[i * 8 + 2]); u.pm = __builtin_amdgcn_readfirstlane(ul[i * 8 + 3]); u.cnt = __builtin_amdgcn_readfirstlane(ul[i * 8 + 4]); return true;
    }
};
}

namespace att {
constexpr int VSTR = 144;
template <int DQK> struct Cfg { static constexpr int KSTR = DQK * 2 + 16, KB = 64 * KSTR, VB = 64 * VSTR, STAGE = KB + VB, CPR = DQK / 8, NKS = DQK / 16; };
__device__ __forceinline__ int crow(int r, int hi) { return (r & 3) + 8 * (r >> 2) + 4 * hi; }

template <int DQK, bool MLA>
__device__ __forceinline__ void fetchK(u32x4 (&r)[2], const bf16_t* Kb, const bf16_t* KRb, int pitch, int row0, int tid) {
    typedef Cfg<DQK> C;
    { const int key = tid / C::CPR, ch = tid % C::CPR;
      const bf16_t* src = (MLA && ch >= 8) ? KRb + (size_t)(row0 + key) * 32 + (ch - 8) * 8 : Kb + (size_t)(row0 + key) * pitch + ch * 8;
      r[0] = *(const u32x4*)src; }
    if constexpr (DQK == 96) { if (tid < 256) { const int c = 512 + tid, key = c / C::CPR, ch = c % C::CPR;
      const bf16_t* src = (MLA && ch >= 8) ? KRb + (size_t)(row0 + key) * 32 + (ch - 8) * 8 : Kb + (size_t)(row0 + key) * pitch + ch * 8;
      r[1] = *(const u32x4*)src; } }
}
__device__ __forceinline__ void fetchV(u32x4& r, const bf16_t* Vb, int pitch, int row0, int tid) { const int key = tid >> 3, ch = tid & 7; r = *(const u32x4*)(Vb + (size_t)(row0 + key) * pitch + ch * 8); }
template <int DQK>
__device__ __forceinline__ void stashK(LAS unsigned char* kst, const u32x4 (&r)[2], int tid) {
    typedef Cfg<DQK> C;
    { const int key = tid / C::CPR, ch = tid % C::CPR; *(LAS u32x4*)(kst + key * C::KSTR + ch * 16) = r[0]; }
    if constexpr (DQK == 96) { if (tid < 256) { const int c = 512 + tid, key = c / C::CPR, ch = c % C::CPR; *(LAS u32x4*)(kst + key * C::KSTR + ch * 16) = r[1]; } }
}
__device__ __forceinline__ void stashV(LAS unsigned char* vst, const u32x4& r, int tid) { const int key = tid >> 3, ch = tid & 7; *(LAS u32x4*)(vst + key * VSTR + ch * 16) = r; }
template <int DQK, bool MLA>
__device__ __forceinline__ void fetch(u32x4 (&r)[3], const bf16_t* Kb, const bf16_t* Vb, const bf16_t* KRb, int pitch, int row0, int tid) {
    u32x4 k2[2]; k2[1] = (u32x4){0u, 0u, 0u, 0u}; fetchK<DQK, MLA>(k2, Kb, KRb, pitch, row0, tid); r[0] = k2[0]; r[1] = k2[1]; fetchV(r[2], Vb, pitch, row0, tid);
}
template <int DQK>
__device__ __forceinline__ void stash(LAS unsigned char* st, const u32x4 (&r)[3], int tid) {
    const u32x4 k2[2] = {r[0], r[1]}; stashK<DQK>(st, k2, tid); stashV(st + Cfg<DQK>::KB, r[2], tid);
}
template <int DQK>
__device__ __forceinline__ f32x16 qk(const LAS unsigned char* kst, int koff, const bf16x8 (&qr)[DQK / 16], int r32, int hi) {
    typedef Cfg<DQK> C;
    f32x16 p;
#pragma unroll
    for (int r = 0; r < 16; ++r) p[r] = 0.f;
    const LAS unsigned char* kb = kst + (koff + r32) * C::KSTR + hi * 16;
#pragma unroll
    for (int ks = 0; ks < C::NKS; ++ks) { const bf16x8 kf = *(const LAS bf16x8*)(kb + ks * 32); p = __builtin_amdgcn_mfma_f32_32x32x16_bf16(kf, qr[ks], p, 0, 0, 0); }
    return p;
}
__device__ __forceinline__ s16x4 vtr(const LAS unsigned char* p) { return __builtin_bit_cast(s16x4, __builtin_amdgcn_ds_read_tr16_b64_v4i16((LAS s16x4*)p)); }
typedef __bf16 bf16x2_t __attribute__((ext_vector_type(2)));
__device__ __forceinline__ unsigned cvtpk_s(float lo, float hi) { const f32x2 v = {lo, hi}; const bf16x2_t b = __builtin_convertvector(v, bf16x2_t); return __builtin_bit_cast(unsigned, b); }
template <int NS>
__device__ __forceinline__ void sm_max(const f32x16 (&t)[NS], const float sc, f32x16 (&o)[2], float& m, float& l) {
    float mx = t[0][0];
#pragma unroll
    for (int s = 0; s < NS; ++s)
#pragma unroll
        for (int r = 0; r < 16; ++r) mx = fmaxf(mx, t[s][r]);
    mx = swap32_max(mx) * sc;
    if (__any(mx > m + 8.0f)) { const float mn = fmaxf(m, mx); const float a = __builtin_amdgcn_exp2f(m - mn); m = mn; l *= a;
#pragma unroll
        for (int r = 0; r < 16; ++r) { o[0][r] *= a; o[1][r] *= a; } }
}
template <int NS>
__device__ __forceinline__ void sm_exp_pv(f32x16 (&t)[NS], const float sc, const LAS unsigned char* vst, const int (&voff)[NS], f32x16 (&o)[2], const float m, float& l, int lane) {
    const int hi = lane >> 5;
    float rs = 0.f;
#pragma unroll
    for (int s = 0; s < NS; ++s)
#pragma unroll
        for (int r = 0; r < 16; ++r) { t[s][r] = __builtin_amdgcn_exp2f(__builtin_fmaf(t[s][r], sc, -m)); rs += t[s][r]; }
    l += rs;
    const int q4 = (lane & 15) >> 2, p4 = lane & 3, blk = (lane >> 4) & 1;
#pragma unroll
    for (int s = 0; s < NS; ++s) {
        const LAS unsigned char* vb = vst + (voff[s] + 4 * hi + q4) * VSTR + (16 * blk + 4 * p4) * 2;
#pragma unroll
        for (int kk = 0; kk < 2; ++kk) {
            u32x4 pw; pw.x = cvtpk_s(t[s][8 * kk + 0], t[s][8 * kk + 1]); pw.y = cvtpk_s(t[s][8 * kk + 2], t[s][8 * kk + 3]);
            pw.z = cvtpk_s(t[s][8 * kk + 4], t[s][8 * kk + 5]); pw.w = cvtpk_s(t[s][8 * kk + 6], t[s][8 * kk + 7]);
            const bf16x8 pb = __builtin_bit_cast(bf16x8, pw);
#pragma unroll
            for (int c = 0; c < 2; ++c) {
                const s16x4 lo = vtr(vb + (16 * kk) * VSTR + c * 64), h8 = vtr(vb + (16 * kk + 8) * VSTR + c * 64);
                const bf16x8 va = (bf16x8){lo[0], lo[1], lo[2], lo[3], h8[0], h8[1], h8[2], h8[3]};
                o[c] = __builtin_amdgcn_mfma_f32_32x32x16_bf16(va, pb, o[c], 0, 0, 0);
            }
        }
    }
}
template <int NS>
__device__ __forceinline__ void sm_pv(f32x16 (&t)[NS], const float sc, const LAS unsigned char* vst, const int (&voff)[NS], f32x16 (&o)[2], float& m, float& l, int lane) {
    sm_max<NS>(t, sc, o, m, l); sm_exp_pv<NS>(t, sc, vst, voff, o, m, l, lane);
}
template <int DQK>
__device__ __forceinline__ f32x16 qkn(const LAS unsigned char* kst, int koff, const bf16x8 (&qr)[DQK / 16], const float negm, int r32, int hi) {
    typedef Cfg<DQK> C;
    f32x16 p;
#pragma unroll
    for (int r = 0; r < 16; ++r) p[r] = negm;
    const LAS unsigned char* kb0 = kst + (koff + r32) * C::KSTR + hi * 16;
    bf16x8 kf[C::NKS];
#pragma unroll
    for (int ks = 0; ks < C::NKS; ++ks) kf[ks] = *(const LAS bf16x8*)(kb0 + ks * 32);
    __builtin_amdgcn_sched_barrier(0);
#pragma unroll
    for (int ks = 0; ks < C::NKS; ++ks) p = __builtin_amdgcn_mfma_f32_32x32x16_bf16(kf[ks], qr[ks], p, 0, 0, 0);
    return p;
}
template <int DQK>
__device__ __forceinline__ f32x16 qkn_old(const LAS unsigned char* kst, int koff, const bf16x8 (&qr)[DQK / 16], const f32x16& negm, int r32, int hi) {
    typedef Cfg<DQK> C;
    f32x16 p = negm;
    const LAS unsigned char* kb = kst + (koff + r32) * C::KSTR + hi * 16;
#pragma unroll
    for (int ks = 0; ks < C::NKS; ++ks) { const bf16x8 kf = *(const LAS bf16x8*)(kb + ks * 32); p = __builtin_amdgcn_mfma_f32_32x32x16_bf16(kf, qr[ks], p, 0, 0, 0); }
    return p;
}
__device__ __forceinline__ void sm_max_n(f32x16 (&t)[2], f32x16 (&o)[2], f32x16& osum, float& m, float& negm, bool first) {
    float a0 = fmaxf(fmaxf(t[0][0], t[0][1]), t[0][2]), a1 = fmaxf(fmaxf(t[1][0], t[1][1]), t[1][2]);
#pragma unroll
    for (int r = 3; r < 15; r += 2) { a0 = fmaxf(fmaxf(a0, t[0][r]), t[0][r + 1]); a1 = fmaxf(fmaxf(a1, t[1][r]), t[1][r + 1]); }
    float mx = fmaxf(fmaxf(a0, a1), fmaxf(t[0][15], t[1][15]));
    mx = swap32_max(mx);
    if (first || __any(mx > 8.0f)) { const float d = first ? mx : fmaxf(mx, 0.f); const float a = first ? 1.0f : __builtin_amdgcn_exp2f(-d); m += d;
#pragma unroll
        for (int r = 0; r < 16; ++r) { t[0][r] -= d; t[1][r] -= d; o[0][r] *= a; o[1][r] *= a; osum[r] *= a; } negm = -m; }
}
__device__ __forceinline__ void sm_exp_pv_n(f32x16 (&t)[2], const LAS unsigned char* vst, f32x16 (&o)[2], f32x16& osum, int lane) {
    const int hi = lane >> 5, q4 = (lane & 15) >> 2, p4 = lane & 3, blk = (lane >> 4) & 1;
    const LAS unsigned char* vb = vst + (4 * hi + q4) * VSTR + (16 * blk + 4 * p4) * 2;
    const bf16x8 ones = (bf16x8){0x3F80, 0x3F80, 0x3F80, 0x3F80, 0x3F80, 0x3F80, 0x3F80, 0x3F80};
#pragma unroll
    for (int s = 0; s < 2; ++s) {
        bf16x8 va[2][2];
#pragma unroll
        for (int kk = 0; kk < 2; ++kk)
#pragma unroll
            for (int c = 0; c < 2; ++c) { const s16x4 lo = vtr(vb + (32 * s + 16 * kk) * VSTR + c * 64), h8 = vtr(vb + (32 * s + 16 * kk + 8) * VSTR + c * 64);
                va[kk][c] = (bf16x8){lo[0], lo[1], lo[2], lo[3], h8[0], h8[1], h8[2], h8[3]}; }
        __builtin_amdgcn_sched_barrier(0);
#pragma unroll
        for (int kk = 0; kk < 2; ++kk) {
            float e[8];
#pragma unroll
            for (int j = 0; j < 8; ++j) e[j] = __builtin_amdgcn_exp2f(t[s][8 * kk + j]);
            u32x4 pw; pw.x = cvtpk_s(e[0], e[1]); pw.y = cvtpk_s(e[2], e[3]); pw.z = cvtpk_s(e[4], e[5]); pw.w = cvtpk_s(e[6], e[7]);
            const bf16x8 pb = __builtin_bit_cast(bf16x8, pw);
            o[0] = __builtin_amdgcn_mfma_f32_32x32x16_bf16(va[kk][0], pb, o[0], 0, 0, 0);
            o[1] = __builtin_amdgcn_mfma_f32_32x32x16_bf16(va[kk][1], pb, o[1], 0, 0, 0);
            osum = __builtin_amdgcn_mfma_f32_32x32x16_bf16(ones, pb, osum, 0, 0, 0);
        }
    }
}
__device__ __forceinline__ void finalize_n(const f32x16 (&o)[2], const f32x16& osum, bf16_t* orow, int hi) {
    const float inv = 1.0f / osum[0];
#pragma unroll
    for (int c = 0; c < 2; ++c)
#pragma unroll
        for (int g = 0; g < 4; ++g) { u32x2 w; w.x = cvt_pk_bf16(o[c][4 * g] * inv, o[c][4 * g + 1] * inv); w.y = cvt_pk_bf16(o[c][4 * g + 2] * inv, o[c][4 * g + 3] * inv);
            *(u32x2*)(orow + 32 * c + 8 * g + 4 * hi) = w; }
}
__device__ __forceinline__ void finalize(const f32x16 (&o)[2], float l, bf16_t* orow, int hi) {
    l = swap32_sum(l); const float inv = 1.0f / l;
#pragma unroll
    for (int c = 0; c < 2; ++c)
#pragma unroll
        for (int g = 0; g < 4; ++g) { u32x2 w; w.x = cvt_pk_bf16(o[c][4 * g] * inv, o[c][4 * g + 1] * inv); w.y = cvt_pk_bf16(o[c][4 * g + 2] * inv, o[c][4 * g + 3] * inv);
            *(u32x2*)(orow + 32 * c + 8 * g + 4 * hi) = w; }
}
#define ATT_PIPE_BEGIN(DQK, MLA, ROW0_OF) \
    u32x4 pre[3]; pre[1] = (u32x4){0u, 0u, 0u, 0u}; \
    fetch<DQK, MLA>(pre, Kb, Vb, KRb, pitch, ROW0_OF(0), tid); stash<DQK>(lds, pre, tid); __syncthreads(); \
    for (int i = 0; i < ntiles; ++i) { \
        if (i + 1 < ntiles) fetch<DQK, MLA>(pre, Kb, Vb, KRb, pitch, ROW0_OF(i + 1), tid); \
        const LAS unsigned char* kst = lds + (i & 1) * Cfg<DQK>::STAGE; const LAS unsigned char* vst = kst + Cfg<DQK>::KB;
#define ATT_PIPE_END(DQK) \
        if (i + 1 < ntiles) stash<DQK>(lds + ((i + 1) & 1) * Cfg<DQK>::STAGE, pre, tid); \
        __syncthreads(); }

#define ATT2_RUN(DQK, MLA, ROW0_OF, QK2, FIRST) \
    { typedef Cfg<DQK> C_; LAS unsigned char* const kb_ = lds; LAS unsigned char* const vb_ = lds + 2 * C_::KB; \
    u32x4 pk_[2], pv_; pk_[1] = (u32x4){0u, 0u, 0u, 0u}; \
    fetchK<DQK, MLA>(pk_, Kb, KRb, pitch, ROW0_OF(0), tid); fetchV(pv_, Vb, pitch, ROW0_OF(0), tid); stashK<DQK>(kb_, pk_, tid); stashV(vb_, pv_, tid); \
    if (ntiles > 1) { fetchK<DQK, MLA>(pk_, Kb, KRb, pitch, ROW0_OF(1), tid); stashK<DQK>(kb_ + C_::KB, pk_, tid); } \
    __syncthreads(); \
    f32x16 t[2]; QK2(t, kb_, 0); \
    sm_max_n(t, o, osum, m, negm, (FIRST)); \
    __syncthreads();     \
    for (int i = 0; i + 1 < ntiles; ++i) { \
        if (i + 2 < ntiles) fetchK<DQK, MLA>(pk_, Kb, KRb, pitch, ROW0_OF(i + 2), tid); \
        fetchV(pv_, Vb, pitch, ROW0_OF(i + 1), tid); \
        f32x16 tn[2]; QK2(tn, kb_ + ((i + 1) & 1) * C_::KB, i + 1);     \
        sm_exp_pv_n(t, vb_ + (i & 1) * C_::VB, o, osum, lane); \
        t[0] = tn[0]; t[1] = tn[1]; \
        sm_max_n(t, o, osum, m, negm, false);                                 \
        if (i + 2 < ntiles) stashK<DQK>(kb_ + (i & 1) * C_::KB, pk_, tid); \
        stashV(vb_ + ((i + 1) & 1) * C_::VB, pv_, tid); \
        __syncthreads(); } \
    sm_exp_pv_n(t, vb_ + ((ntiles - 1) & 1) * C_::VB, o, osum, lane); \
    __syncthreads(); }

__device__ __forceinline__ void attn_A_unit(LAS unsigned char* lds, const bf16_t* QKV, bf16_t* O, const float* sink, int b, int kvh, int qb, bool ctxq, int tid) {
    const int lane = tid & 63, wid = __builtin_amdgcn_readfirstlane(tid >> 6), r32 = lane & 31, hi = lane >> 5;
    const int head = kvh * 4 + (wid >> 1), qoff = 32 * (wid & 1) + r32, t0 = qb * 64;
    const int qrow = ctxq ? NL + b * CTXL + t0 + qoff : b * SEQ + t0 + qoff;
    bf16x8 qr[4];
    { const bf16_t* qp = QKV + (size_t)qrow * A_IN + head * 64 + hi * 8;
#pragma unroll
      for (int ks = 0; ks < 4; ++ks) qr[ks] = *(const bf16x8*)(qp + ks * 16); }
    int jlo = 0, nloc = 0;
    if (!ctxq) { jlo = t0 >= 128 ? 0 : (t0 == 64 ? 1 : 2); int jhi = (2112 - t0) / 64; jhi = jhi > 4 ? 4 : jhi; nloc = jhi - jlo + 1; }
    const int ntiles = 4 + nloc, cbase = NL + b * CTXL, lbase = b * SEQ + t0 - 128 + 64 * jlo;
    const bf16_t* Kb = QKV + 1024 + kvh * 64; const bf16_t* Vb = QKV + 1280 + kvh * 64; const bf16_t* KRb = nullptr; const int pitch = A_IN;
    float m = sink[head] * LOG2E;
    f32x16 o[2], osum; float negm = -m;
#pragma unroll
    for (int r = 0; r < 16; ++r) { o[0][r] = 0.f; o[1][r] = 0.f; osum[r] = 1.0f; }
#define A_ROW0(i) ((i) < 4 ? cbase + 64 * (i) : lbase + 64 * ((i) - 4))
#define A_QK2(dst, kst, ti) { dst[0] = qkn<64>(kst, 0, qr, negm, r32, hi); dst[1] = qkn<64>(kst, 32, qr, negm, r32, hi); const int j_ = (ti) < 4 ? 2 : jlo + (ti) - 4; \
        if (j_ == 0 || j_ == 4) { _Pragma("unroll") for (int s = 0; s < 2; ++s) _Pragma("unroll") for (int r = 0; r < 16; ++r) { const int kk = 32 * s + crow(r, hi); \
            if (j_ == 0 ? (kk < qoff) : (kk > qoff)) dst[s][r] = -1e30f; } } }
    ATT2_RUN(64, false, A_ROW0, A_QK2, false)
#undef A_QK2
#undef A_ROW0
    finalize_n(o, osum, O + (size_t)qrow * D + head * 64, hi);
}

__device__ __forceinline__ void attn_B_unit(LAS unsigned char* lds, LAS float* tab, const bf16_t* QKV, bf16_t* O, const float* rpb, int b, int h, int rq, bool ctxq, int tid) {
    const int lane = tid & 63, wid = __builtin_amdgcn_readfirstlane(tid >> 6), r32 = lane & 31, hi = lane >> 5;
    const int jb = wid & 3, rp = wid >> 2;
    const int rqa = 4 * rq + 2 * rp + (r32 >> 4), qcol = 16 * jb + (r32 & 15);
    const int qrow = ctxq ? NL + b * CTXL + 32 * wid + r32 : b * SEQ + rqa * 64 + qcol;
    for (int idx = tid; idx < 15 * 31; idx += 512) tab[(idx / 31) * 32 + idx % 31] = rpb[h * 465 + idx] * LOG2E;
    bf16x8 qr[4];
    { const bf16_t* qp = QKV + (size_t)qrow * B_IN + h * 64 + hi * 8;
#pragma unroll
      for (int ks = 0; ks < 4; ++ks) qr[ks] = *(const bf16x8*)(qp + ks * 16); }
    int klo = 0, nloc = 0;
    if (!ctxq) { klo = 4 * rq - 4; klo = klo < 0 ? 0 : (klo > 24 ? 24 : klo); int khi = 4 * rq - 1; khi = khi < 0 ? 0 : (khi > 24 ? 24 : khi); khi += 7; nloc = khi - klo + 1; }
    const int ntiles = 4 + nloc, cbase = NL + b * CTXL, lbase = b * SEQ;
    int r0q = rqa - 4; r0q = r0q < 0 ? 0 : (r0q > 24 ? 24 : r0q);
    int wst = qcol - 8; wst = wst < 0 ? 0 : (wst > 48 ? 48 : wst);
    int cst = 16 * jb - 8; cst = cst < 0 ? 0 : (cst > 32 ? 32 : cst);
    const int lo = wst - cst;
    int wr0 = 4 * rq + 2 * rp - 4; wr0 = wr0 < 0 ? 0 : (wr0 > 24 ? 24 : wr0);
    int wr1 = 4 * rq + 2 * rp + 1 - 4; wr1 = wr1 < 0 ? 0 : (wr1 > 24 ? 24 : wr1); wr1 += 7;
    const bf16_t* Kb = QKV + 1024 + h * 64; const bf16_t* Vb = QKV + 2048 + h * 64; const bf16_t* KRb = nullptr; const int pitch = B_IN;
    float m = -1e30f, l = 0.f;
    f32x16 o[2];
#pragma unroll
    for (int r = 0; r < 16; ++r) { o[0][r] = 0.f; o[1][r] = 0.f; }
    const float sc = 0.125f * LOG2E;
#define B_ROW0(i) ((i) < 4 ? cbase + 64 * (i) : lbase + 64 * (klo + (i) - 4))
    ATT_PIPE_BEGIN(64, false, B_ROW0)
        if (i < 4) {
            f32x16 t[2];
            t[0] = qk<64>(kst, 0, qr, r32, hi); t[1] = qk<64>(kst, 32, qr, r32, hi);
#pragma unroll
            for (int s = 0; s < 2; ++s)
#pragma unroll
                for (int r = 0; r < 16; ++r) t[s][r] *= 1.0f;
            const int voff[2] = {0, 32};
            sm_pv<2>(t, 1.0f, vst, voff, o, m, l, lane);
        } else {
            const int kr = klo + i - 4;
            if (kr >= wr0 && kr <= wr1) {
                f32x16 t[1];
                t[0] = qk<64>(kst, cst, qr, r32, hi);
                const bool rowok = (kr >= r0q) && (kr < r0q + 8);
                const int bidx0 = (kr - rqa + 7) * 32 + cst - qcol + 15;
#pragma unroll
                for (int r = 0; r < 16; ++r) { const int kidx = crow(r, hi); const bool ok = rowok && ((unsigned)(kidx - lo) < 16u);
                    int bi = bidx0 + kidx; bi = bi < 0 ? 0 : (bi > 479 ? 479 : bi);
                    const float bias = tab[bi];
                    t[0][r] = ok ? t[0][r] + bias : -1e30f; }
                const int voff[1] = {cst};
                sm_pv<1>(t, 1.0f, vst, voff, o, m, l, lane);
            }
        }
    ATT_PIPE_END(64)
#undef B_ROW0
    finalize(o, l, O + (size_t)qrow * D + h * 64, hi);
}

__device__ __forceinline__ void attn_C_unit(LAS unsigned char* lds, const bf16_t* Q2, const bf16_t* KR, bf16_t* O, int b, int h, int qb, bool ctxq, int tid) {
    const int lane = tid & 63, wid = __builtin_amdgcn_readfirstlane(tid >> 6), r32 = lane & 31, hi = lane >> 5;
    const int qrow = ctxq ? NL + b * CTXL + 32 * wid + r32 : b * SEQ + qb * 256 + 32 * wid + r32;
    bf16x8 qr[6];
    { const bf16_t* qp = Q2 + (size_t)qrow * C_UPN + h * 96 + hi * 8;
#pragma unroll
      for (int ks = 0; ks < 6; ++ks) qr[ks] = *(const bf16x8*)(qp + ks * 16); }
    const int ntiles = ctxq ? 4 : 36, cbase = NL + b * CTXL, lbase = b * SEQ;
    const bf16_t* Kb = Q2 + 1536 + h * 128; const bf16_t* Vb = Kb + 64; const bf16_t* KRb = KR; const int pitch = C_UPN;
    float m = 0.f;
    f32x16 o[2], osum; float negm = 0.f;
#pragma unroll
    for (int r = 0; r < 16; ++r) { o[0][r] = 0.f; o[1][r] = 0.f; osum[r] = 0.f; }
#define C_ROW0(i) ((i) < 4 ? cbase + 64 * (i) : lbase + 64 * ((i) - 4))
#define C_QK2(dst, kst, ti) { dst[0] = qkn<96>(kst, 0, qr, negm, r32, hi); dst[1] = qkn<96>(kst, 32, qr, negm, r32, hi); }
    ATT2_RUN(96, true, C_ROW0, C_QK2, true)
#undef C_QK2
#undef C_ROW0
    finalize_n(o, osum, O + (size_t)qrow * D + h * 64, hi);
}
}

struct Row4 { f32x4 v[4]; };
__device__ __forceinline__ void row_load(Row4& x, const float* p, int lane) {
#pragma unroll
    for (int j = 0; j < 4; ++j) x.v[j] = *(const f32x4*)(p + 4 * lane + 256 * j);
}
__device__ __forceinline__ void row_store(const Row4& x, float* p, int lane) {
#pragma unroll
    for (int j = 0; j < 4; ++j) *(f32x4*)(p + 4 * lane + 256 * j) = x.v[j];
}
__device__ __forceinline__ void row_load_bf(Row4& x, const bf16_t* p, int lane) {
#pragma unroll
    for (int j = 0; j < 4; ++j) { const u32x2 w = *(const u32x2*)(p + 4 * lane + 256 * j); x.v[j] = (f32x4){bf_lo(w.x), bf_hi(w.x), bf_lo(w.y), bf_hi(w.y)}; }
}
__device__ __forceinline__ void row_store_bf(const Row4& x, bf16_t* p, int lane) {
#pragma unroll
    for (int j = 0; j < 4; ++j) { u32x2 w; w.x = cvt_pk_bf16(x.v[j][0], x.v[j][1]); w.y = cvt_pk_bf16(x.v[j][2], x.v[j][3]); *(u32x2*)(p + 4 * lane + 256 * j) = w; }
}
__device__ __forceinline__ float row_rstd(const Row4& x, int lane) {
    float s = 0.f;
#pragma unroll
    for (int j = 0; j < 4; ++j) s += (x.v[j][0] * x.v[j][0] + x.v[j][1] * x.v[j][1]) + (x.v[j][2] * x.v[j][2] + x.v[j][3] * x.v[j][3]);
    s = wave_sum(s, lane);
    return 1.0f / sqrtf(s * (1.0f / D) + NORM_EPS);
}
__device__ __forceinline__ void norm_mod(const Row4& x, float rstd, const float* g, const float* sh, const float* sc, bf16_t* out, int lane, Row4& hv) {
#pragma unroll
    for (int j = 0; j < 4; ++j) { const int c = 4 * lane + 256 * j;
        const f32x4 gg = *(const f32x4*)(g + c), s1 = *(const f32x4*)(sc + c), s0 = *(const f32x4*)(sh + c);
        const f32x4 h = (x.v[j] * rstd * gg) * (s1 + 1.0f) + s0; hv.v[j] = h;
        u32x2 w; w.x = cvt_pk_bf16(h[0], h[1]); w.y = cvt_pk_bf16(h[2], h[3]); *(u32x2*)(out + c) = w; }
}

__device__ __forceinline__ unsigned pk_i8x4(float a, float b, float c, float d, float inv) {
    const int q0 = (int)rintf(a * inv), q1 = (int)rintf(b * inv), q2 = (int)rintf(c * inv), q3 = (int)rintf(d * inv);
    return (unsigned)(q0 & 255) | ((unsigned)(q1 & 255) << 8) | ((unsigned)(q2 & 255) << 16) | ((unsigned)q3 << 24);
}
__device__ __forceinline__ void norm_mod8(const Row4& x, float rstd, const float* g, const float* sh, const float* sc, unsigned char* out, float* sarow, int lane) {
    Row4 hv; float am = 0.f;
#pragma unroll
    for (int j = 0; j < 4; ++j) { const int c = 4 * lane + 256 * j;
        const f32x4 gg = *(const f32x4*)(g + c), s1 = *(const f32x4*)(sc + c), s0 = *(const f32x4*)(sh + c);
        const f32x4 h = (x.v[j] * rstd * gg) * (s1 + 1.0f) + s0; hv.v[j] = h;
        am = fmaxf(fmaxf(am, fmaxf(fabsf(h[0]), fabsf(h[1]))), fmaxf(fabsf(h[2]), fabsf(h[3]))); }
    am = fmaxf(wave_max(am, lane), 1e-20f); const float inv = 127.0f / am;
#pragma unroll
    for (int j = 0; j < 4; ++j) *(unsigned*)(out + 4 * lane + 256 * j) = pk_i8x4(hv.v[j][0], hv.v[j][1], hv.v[j][2], hv.v[j][3], inv);
    if (lane == 0) *sarow = am * (1.0f / 127.0f);
}

struct Ptrs {
    const float* in[29]; float* out; unsigned char* ws;
};
typedef const __attribute__((address_space(4))) Ptrs* PK;
#define WSP(T, off) ((T*)(P->ws + (off)))

__device__ __forceinline__ unsigned pk_f16(float a, float b) { const f32x2 v = {a, b}; const f16x2 h = __builtin_convertvector(v, f16x2); return __builtin_bit_cast(unsigned, h); }
__device__ __forceinline__ void phase_first_norm(PK P, int gw, int lane) {
    const float* MOD = WSP(const float, WS_MOD);
    {
        const int gt = gw * 64 + lane;
        for (int q = gt; q < DEPTH * 9 * 4096; q += 131072) { const int lb = q >> 12, cc = q & 4095, c = cc >> 5, e = cc & 31, l = lb / 9, b = lb - 9 * l;
            const float* g = P->in[7] + (size_t)l * D + 8 * c; const float* sc = MOD + ((size_t)l * 9 + b) * 6144 + 4096 + 8 * c; const float* w = P->in[21] + ((size_t)l * D + 8 * c) * NEXP + e;
            float v[8];
#pragma unroll
            for (int j = 0; j < 8; ++j) v[j] = g[j] * (1.0f + sc[j]) * w[j * NEXP];
            u32x4 o; o.x = pk_f16(v[0], v[1]); o.y = pk_f16(v[2], v[3]); o.z = pk_f16(v[4], v[5]); o.w = pk_f16(v[6], v[7]);
            *(u32x4*)(WSP(unsigned char, WS_G16) + (size_t)lb * 65536 + e * 2048 + ((c ^ (e & 15)) * 16)) = o; }
        for (int q = gw; q < DEPTH * 9 * 32; q += 2048) { const int lb = q >> 5, e = q & 31, l = lb / 9, b = lb - 9 * l;
            const float* sh = MOD + ((size_t)l * 9 + b) * 6144 + 3072; const float* w = P->in[21] + (size_t)l * D * NEXP + e; float t = 0.f;
#pragma unroll
            for (int j = 0; j < 16; ++j) { const int k = lane + 64 * j; t += sh[k] * w[(size_t)k * NEXP]; }
            t = wave_sum(t, lane);
            if (lane == 0) WSP(float, WS_RC)[q] = t + P->in[22][l * NEXP + e]; }
    }
    for (int r0 = gw; r0 < NT; r0 += 4096) {
        const int rr[2] = {r0, (r0 + 2048 < NT) ? r0 + 2048 : r0};
        Row4 x[2];
#pragma unroll
        for (int u = 0; u < 2; ++u) { const int r = rr[u]; const float* src = r < NL ? P->in[0] + (size_t)r * D : P->in[2] + (size_t)(r - NL) * D; row_load(x[u], src, lane); }
#pragma unroll
        for (int u = 0; u < 2; ++u) { const int r = rr[u]; row_store_bf(x[u], WSP(bf16_t, WS_XS) + (size_t)r * D, lane);
            const float rstd = row_rstd(x[u], lane); const int rb = r < NL ? (r >> 11) : 8; const float* mod = MOD + (size_t)rb * 6144;
            norm_mod8(x[u], rstd, P->in[6], mod, mod + 1024, WSP(unsigned char, WS_H) + (size_t)r * D, WSP(float, WS_SAH) + r, lane); }
    }
}
__device__ __forceinline__ void phase_mla_norm(PK P, int gw, int lane) {
    const float* Y = WSP(const float, WS_Y416); bf16_t* CQ = WSP(bf16_t, WS_CQKV); bf16_t* KR = WSP(bf16_t, WS_KR);
    const float* qn = P->in[16]; const float* kn = P->in[17]; const float* rope = WSP(const float, WS_ROPE_C);
    for (int r0 = gw; r0 < NT; r0 += 4096) {
        const int rr[2] = {r0, (r0 + 2048 < NT) ? r0 + 2048 : r0};
        f32x4 vq[2]; f32x2 vk[2], vr[2];
#pragma unroll
        for (int u = 0; u < 2; ++u) { const float* y = Y + (size_t)rr[u] * C_INP; vq[u] = *(const f32x4*)(y + 4 * lane); vk[u] = *(const f32x2*)(y + 256 + 2 * lane); vr[u] = *(const f32x2*)(y + 384 + 2 * (lane & 15)); }
#pragma unroll
        for (int u = 0; u < 2; ++u) { const int r = rr[u]; const f32x4 v = vq[u];
            const float ss = wave_sum((v[0] * v[0] + v[1] * v[1]) + (v[2] * v[2] + v[3] * v[3]), lane);
            const float rq = 1.0f / sqrtf(ss * (1.0f / 256.0f) + NORM_EPS);
            const f32x4 g = *(const f32x4*)(qn + 4 * lane);
            u32x2 w; w.x = cvt_pk_bf16(v[0] * rq * g[0], v[1] * rq * g[1]); w.y = cvt_pk_bf16(v[2] * rq * g[2], v[3] * rq * g[3]);
            *(u32x2*)(CQ + (size_t)r * C_UPK + 4 * lane) = w;
            const f32x2 k2 = vk[u];
            const float s2 = wave_sum(k2[0] * k2[0] + k2[1] * k2[1], lane);
            const float rk = 1.0f / sqrtf(s2 * (1.0f / 128.0f) + NORM_EPS);
            const f32x2 g2 = *(const f32x2*)(kn + 2 * lane);
            *(unsigned*)(CQ + (size_t)r * C_UPK + 256 + 2 * lane) = cvt_pk_bf16(k2[0] * rk * g2[0], k2[1] * rk * g2[1]);
            if (lane < 16) { f32x2 p = vr[u];
                if (r < NL) { const f32x2 cs = *(const f32x2*)(rope + ((size_t)(r & (SEQ - 1)) * 16 + lane) * 2); const float a = p[0], b = p[1]; p[0] = a * cs[0] - b * cs[1]; p[1] = a * cs[1] + b * cs[0]; }
                *(unsigned*)(KR + (size_t)r * 32 + 2 * lane) = cvt_pk_bf16(p[0], p[1]); }
        }
    }
}
__device__ __forceinline__ void moe_tables(LAS unsigned char* misc, unsigned* gcnt, int tid) {
    LAS int* ecnt = (LAS int*)(misc + M_ECNT); LAS int* lbase = (LAS int*)(misc + M_LBASE); LAS int* cumt = (LAS int*)(misc + M_CUMT);
    if (tid < 32) ecnt[tid] = (int)__hip_atomic_load(gcnt + tid * 16, __ATOMIC_RELAXED, __HIP_MEMORY_SCOPE_AGENT);
    __syncthreads();
    if (tid == 0) { int s = 0, t = 0; for (int e = 0; e < 32; ++e) { lbase[e] = s; cumt[e] = t; const int mt = (ecnt[e] + 255) >> 8; s += mt * 256; t += mt; } cumt[32] = t; }
    __syncthreads();
}
constexpr int RT_PLOG = 65536, RT_LOGIT = 98304, RT_SSQ = 102912, RT_RSTD = 103936, RT_CVEC = 104064, RT_AMX = 104192;
__device__ __forceinline__ void phase_router(PK P, LAS unsigned char* lds, int l, int nrows, int vcu, int tid, int cset) {
    const int lane = tid & 63, wid = __builtin_amdgcn_readfirstlane(tid >> 6), i32 = lane & 31, hi = lane >> 5;
    LAS unsigned char* misc = lds + MISC_OFF;
    LAS int* lcnt = (LAS int*)(misc + M_LCNT); LAS int* gbase = (LAS int*)(misc + M_GBASE); LAS int* rec = (LAS int*)(misc + M_REC);
    LAS float* plog = (LAS float*)(lds + RT_PLOG); LAS float* logit = (LAS float*)(lds + RT_LOGIT); LAS float* ssq = (LAS float*)(lds + RT_SSQ);
    LAS float* rstd_s = (LAS float*)(lds + RT_RSTD); LAS float* cvec = (LAS float*)(lds + RT_CVEC); LAS float* amx = (LAS float*)(lds + RT_AMX); LAS float* rowsa = (LAS float*)(misc + M_RSA);
    const bool last = (nrows == NL);
    const int nb = (!last && vcu < 64) ? 3 : 2;
    const float* MOD = WSP(const float, WS_MOD) + (size_t)l * 9 * 6144;
    const bf16_t* XS = WSP(const bf16_t, WS_XS); unsigned char* H8 = WSP(unsigned char, WS_H);
    int* TOPE = WSP(int, WS_TOPE); float* GATE = WSP(float, WS_GATE);
    const float* gn = P->in[7] + (size_t)l * D;
    if (tid < 32) lcnt[tid] = 0;
    u32x4 nw[8];
#define RT_ROW0(b) ((b) < 2 ? 64 * vcu + 32 * (b) : NL + 32 * vcu)
    { const bf16_t* xp0 = XS + (size_t)(RT_ROW0(0) + i32) * D + 128 * wid + 8 * hi;
#pragma unroll
      for (int s = 0; s < 8; ++s) nw[s] = *(const u32x4*)(xp0 + 16 * s); }
    for (int bi = 0; bi < nb; ++bi) {
        const int rb = bi < 2 ? (vcu >> 5) : 8;
        const int row0 = RT_ROW0(bi);
        if (bi != 1) {
            __syncthreads();
            const u32x4* gsrc = (const u32x4*)(WSP(const unsigned char, WS_G16) + (size_t)(l * 9 + rb) * 65536);
#pragma unroll
            for (int c = 0; c < 8; ++c) *(LAS u32x4*)(lds + (size_t)(tid + 512 * c) * 16) = gsrc[tid + 512 * c];
            if (tid < 32) cvec[tid] = WSP(const float, WS_RC)[(l * 9 + rb) * 32 + tid];
            __syncthreads();
        }
        const int r = row0 + i32;
        f32x4 xa[8], xb[8];
#pragma unroll
        for (int s = 0; s < 8; ++s) { const u32x4 w = nw[s];
            xa[s] = (f32x4){bf_lo(w.x), bf_hi(w.x), bf_lo(w.y), bf_hi(w.y)}; xb[s] = (f32x4){bf_lo(w.z), bf_hi(w.z), bf_lo(w.w), bf_hi(w.w)}; }
        if (bi + 1 < nb) { const bf16_t* xpn = XS + (size_t)(RT_ROW0(bi + 1) + i32) * D + 128 * wid + 8 * hi;
#pragma unroll
            for (int s = 0; s < 8; ++s) nw[s] = *(const u32x4*)(xpn + 16 * s); }
        float ss = 0.f;
        f32x16 acc;
#pragma unroll
        for (int q = 0; q < 16; ++q) acc[q] = 0.f;
#pragma unroll
        for (int s = 0; s < 8; ++s) {
            ss += (xa[s][0] * xa[s][0] + xa[s][1] * xa[s][1]) + (xa[s][2] * xa[s][2] + xa[s][3] * xa[s][3]) + (xb[s][0] * xb[s][0] + xb[s][1] * xb[s][1]) + (xb[s][2] * xb[s][2] + xb[s][3] * xb[s][3]);
            u32x4 aw; aw.x = pk_f16(xa[s][0], xa[s][1]); aw.y = pk_f16(xa[s][2], xa[s][3]); aw.z = pk_f16(xb[s][0], xb[s][1]); aw.w = pk_f16(xb[s][2], xb[s][3]);
            const int c = 16 * wid + 2 * s + hi;
            const f16x8 bf = *(const LAS f16x8*)(lds + i32 * 2048 + ((c ^ (i32 & 15)) * 16));
            acc = __builtin_amdgcn_mfma_f32_32x32x16_f16(__builtin_bit_cast(f16x8, aw), bf, acc, 0, 0, 0);
        }
        ss = swap32_sum(ss);
        if (hi == 0) ssq[wid * 32 + i32] = ss;
#pragma unroll
        for (int q = 0; q < 16; ++q) plog[(wid * 32 + att::crow(q, hi)) * 32 + i32] = acc[q];
        __syncthreads();
        if (tid < 32) { float t = 0.f;
#pragma unroll
            for (int w = 0; w < 8; ++w) t += ssq[w * 32 + tid];
            rstd_s[tid] = 1.0f / sqrtf(t * (1.0f / D) + NORM_EPS); }
        __syncthreads();
#pragma unroll
        for (int u = 0; u < 2; ++u) { const int idx = tid + 512 * u, rr = idx >> 5, e = idx & 31; float t = 0.f;
#pragma unroll
            for (int w = 0; w < 8; ++w) t += plog[(w * 32 + rr) * 32 + e];
            logit[rr * 33 + e] = rstd_s[rr] * t + cvec[e]; }
        { const float rs = rstd_s[i32]; const float* mod = MOD + (size_t)rb * 6144; const int k0 = 128 * wid + 8 * hi; float am = 0.f;
#pragma unroll
          for (int s = 0; s < 8; ++s) { const int k = k0 + 16 * s;
              const f32x4 g0 = *(const f32x4*)(gn + k), g1 = *(const f32x4*)(gn + k + 4), c0 = *(const f32x4*)(mod + 4096 + k), c1 = *(const f32x4*)(mod + 4096 + k + 4);
              const f32x4 s0 = *(const f32x4*)(mod + 3072 + k), s1 = *(const f32x4*)(mod + 3072 + k + 4);
              const f32x4 h0 = (xa[s] * rs * g0) * (c0 + 1.0f) + s0, h1 = (xb[s] * rs * g1) * (c1 + 1.0f) + s1; xa[s] = h0; xb[s] = h1;
              am = fmaxf(fmaxf(fmaxf(am, fabsf(h0[0])), fmaxf(fabsf(h0[1]), fabsf(h0[2]))), fmaxf(fmaxf(fabsf(h0[3]), fabsf(h1[0])), fmaxf(fabsf(h1[1]), fmaxf(fabsf(h1[2]), fabsf(h1[3]))))); }
          am = swap32_max(am);
          if (hi == 0) amx[wid * 32 + i32] = am; }
        __syncthreads();
        { float a = amx[i32];
#pragma unroll
          for (int w = 1; w < 8; ++w) a = fmaxf(a, amx[w * 32 + i32]);
          a = fmaxf(a, 1e-20f); const float inv = 127.0f / a;
          if (wid == 0 && hi == 0) rowsa[32 * bi + i32] = a * (1.0f / 127.0f);
          unsigned char* hp = H8 + (size_t)r * D + 128 * wid + 8 * hi;
#pragma unroll
          for (int s = 0; s < 8; ++s) { u32x2 w; w.x = pk_i8x4(xa[s][0], xa[s][1], xa[s][2], xa[s][3], inv); w.y = pk_i8x4(xb[s][0], xb[s][1], xb[s][2], xb[s][3], inv); *(u32x2*)(hp + 16 * s) = w; } }
        if (tid < 32) {
            float t0 = -INFINITY, t1 = -INFINITY, t2 = -INFINITY, t3 = -INFINITY; int e0 = 0, e1 = 0, e2 = 0, e3 = 0;
#pragma unroll 4
            for (int e = 0; e < 32; ++e) { const float v = logit[tid * 33 + e];
                if (v > t3) { if (v > t2) { t3 = t2; e3 = e2; if (v > t1) { t2 = t1; e2 = e1; if (v > t0) { t1 = t0; e1 = e0; t0 = v; e0 = e; } else { t1 = v; e1 = e; } } else { t2 = v; e2 = e; } } else { t3 = v; e3 = e; } } }
            const float x1 = __expf(t1 - t0), x2 = __expf(t2 - t0), x3 = __expf(t3 - t0); const float inv = 1.0f / (1.0f + x1 + x2 + x3);
            const int rr = row0 + tid, lr = 32 * bi + tid;
            *(int4*)(TOPE + (size_t)rr * 4) = make_int4(e0, e1, e2, e3);
            *(f32x4*)(GATE + (size_t)rr * 4) = (f32x4){inv, x1 * inv, x2 * inv, x3 * inv};
            const int ee[4] = {e0, e1, e2, e3};
#pragma unroll
            for (int k = 0; k < 4; ++k) { const int lp = __hip_atomic_fetch_add(lcnt + ee[k], 1, __ATOMIC_RELAXED, __HIP_MEMORY_SCOPE_WORKGROUP); rec[2 * (lr * 4 + k)] = ee[k]; rec[2 * (lr * 4 + k) + 1] = lp; }
        }
    }
    __syncthreads();
    unsigned* gcnt = WSP(unsigned, WS_CTL) + CW_CNT + (l * 2 + cset) * 512;
    if (tid < 32) { const int c = lcnt[tid]; gbase[tid] = c ? (int)__hip_atomic_fetch_add(gcnt + tid * 16, (unsigned)c, __ATOMIC_RELAXED, __HIP_MEMORY_SCOPE_AGENT) : 0; }
    __syncthreads();
    int* ELIST = WSP(int, WS_ELIST); int* POS = WSP(int, WS_POS);
    for (int idx = tid; idx < nb * 128; idx += 512) { const int e = rec[2 * idx], pos = gbase[e] + rec[2 * idx + 1]; const int lr = idx >> 2; const int r = lr < 64 ? 64 * vcu + lr : NL + 32 * vcu + (lr - 64);
        ELIST[(size_t)e * NT + pos] = r; POS[(size_t)r * 4 + (idx & 3)] = pos; WSP(float, WS_SAL)[(size_t)e * NT + pos] = rowsa[lr]; }
    __syncthreads();
}
__device__ __forceinline__ void phase_requant(PK P, const LAS int* cumt, int gw, int lane) {
    const int nrows = cumt[32] * 256;
    const bf16_t* ACT = WSP(const bf16_t, WS_ACT); unsigned char* A8 = WSP(unsigned char, WS_ACT8); float* SAQ = WSP(float, WS_SAQ);
    for (int r0 = gw; r0 < nrows; r0 += 4 * 2048) {
        int rr[4]; u32x4 a[4], b[4];
#pragma unroll
        for (int u = 0; u < 4; ++u) { rr[u] = (r0 + u * 2048 < nrows) ? r0 + u * 2048 : r0;
            a[u] = *(const u32x4*)(ACT + (size_t)rr[u] * D + 8 * lane); b[u] = *(const u32x4*)(ACT + (size_t)rr[u] * D + 512 + 8 * lane); }
#pragma unroll
        for (int u = 0; u < 4; ++u) {
            float v[16];
            v[0] = bf_lo(a[u].x); v[1] = bf_hi(a[u].x); v[2] = bf_lo(a[u].y); v[3] = bf_hi(a[u].y); v[4] = bf_lo(a[u].z); v[5] = bf_hi(a[u].z); v[6] = bf_lo(a[u].w); v[7] = bf_hi(a[u].w);
            v[8] = bf_lo(b[u].x); v[9] = bf_hi(b[u].x); v[10] = bf_lo(b[u].y); v[11] = bf_hi(b[u].y); v[12] = bf_lo(b[u].z); v[13] = bf_hi(b[u].z); v[14] = bf_lo(b[u].w); v[15] = bf_hi(b[u].w);
            float am = 0.f;
#pragma unroll
            for (int j = 0; j < 16; ++j) am = fmaxf(am, fabsf(v[j]));
            am = fmaxf(wave_max(am, lane), 1e-20f); const float inv = 127.0f / am;
            u32x2 w0, w1; w0.x = pk_i8x4(v[0], v[1], v[2], v[3], inv); w0.y = pk_i8x4(v[4], v[5], v[6], v[7], inv); w1.x = pk_i8x4(v[8], v[9], v[10], v[11], inv); w1.y = pk_i8x4(v[12], v[13], v[14], v[15], inv);
            *(u32x2*)(A8 + (size_t)rr[u] * D + 8 * lane) = w0; *(u32x2*)(A8 + (size_t)rr[u] * D + 512 + 8 * lane) = w1;
            if (lane == 0) SAQ[rr[u]] = am * (1.0f / 127.0f);
        }
    }
}
constexpr int CBU = 3;
__device__ __forceinline__ void phase_combine(PK P, LAS unsigned char* lds, int l, int nrows, int gw, int tid, bool dry) {
    const int lane = tid & 63;
    LAS unsigned char* misc = lds + MISC_OFF;
    if (MK_PER_PHASE) moe_tables(misc, WSP(unsigned, WS_CTL) + CW_CNT + (l * 2 + ((MK_REP_MASK >> 11) & 1)) * 512, tid);
    const size_t dryoff = dry ? (WS_ACT - WS_XS) / 2 : 0;
    const LAS int* lbase = (const LAS int*)(misc + M_LBASE);
    const float* MOD = WSP(const float, WS_MOD); const float* g2 = MOD + (size_t)l * 9 * 6144 + 5120;
    bf16_t* XS = WSP(bf16_t, WS_XS); const bf16_t* YS = WSP(const bf16_t, WS_YS);
    const int* TOPE = WSP(const int, WS_TOPE); const int* POS = WSP(const int, WS_POS); const float* GATE = WSP(const float, WS_GATE);
    const bool last = (l == DEPTH - 1);
    for (int r0 = gw; r0 < nrows; r0 += CBU * 2048) {
        int rr[CBU];
#pragma unroll
        for (int u = 0; u < CBU; ++u) rr[u] = (r0 + u * 2048 < nrows) ? r0 + u * 2048 : r0;
        int slot[CBU]; float gate[CBU];
#pragma unroll
        for (int u = 0; u < CBU; ++u) { slot[u] = 0; gate[u] = 0.f;
            if (lane < 4) { slot[u] = lbase[TOPE[(size_t)rr[u] * 4 + lane]] + POS[(size_t)rr[u] * 4 + lane]; gate[u] = GATE[(size_t)rr[u] * 4 + lane]; } }
        u32x2 xw[CBU][4], yw[CBU][4][4];
#pragma unroll
        for (int u = 0; u < CBU; ++u) {
#pragma unroll
            for (int j = 0; j < 4; ++j) xw[u][j] = *(const u32x2*)(XS + (size_t)rr[u] * D + 4 * lane + 256 * j);
#pragma unroll
            for (int k = 0; k < 4; ++k) { const int sk = __builtin_amdgcn_readlane(slot[u], k); const bf16_t* yr = YS + (size_t)sk * D;
#pragma unroll
                for (int j = 0; j < 4; ++j) yw[u][k][j] = *(const u32x2*)(yr + 4 * lane + 256 * j); } }
#pragma unroll
        for (int u = 0; u < CBU; ++u) {
            const int r = rr[u];
            Row4 x, f;
#pragma unroll
            for (int j = 0; j < 4; ++j) { x.v[j] = (f32x4){bf_lo(xw[u][j].x), bf_hi(xw[u][j].x), bf_lo(xw[u][j].y), bf_hi(xw[u][j].y)}; f.v[j] = (f32x4){0.f, 0.f, 0.f, 0.f}; }
#pragma unroll
            for (int k = 0; k < 4; ++k) { const float gk = __int_as_float(__builtin_amdgcn_readlane(__float_as_int(gate[u]), k));
#pragma unroll
                for (int j = 0; j < 4; ++j) { const u32x2 w = yw[u][k][j];
                    f.v[j][0] += gk * bf_lo(w.x); f.v[j][1] += gk * bf_hi(w.x); f.v[j][2] += gk * bf_lo(w.y); f.v[j][3] += gk * bf_hi(w.y); } }
            const int rb = r < NL ? (r >> 11) : 8;
#pragma unroll
            for (int j = 0; j < 4; ++j) { const f32x4 gg = *(const f32x4*)(g2 + (size_t)rb * 6144 + 4 * lane + 256 * j); x.v[j] = x.v[j] + gg * f.v[j]; }
            const float rstd = row_rstd(x, lane);
            if (last) {
#pragma unroll
                for (int j = 0; j < 4; ++j) { const int c = 4 * lane + 256 * j; const f32x4 gn = *(const f32x4*)(P->in[8] + c); *(f32x4*)((dry ? WSP(float, WS_ACT) : P->out) + (size_t)r * D + c) = x.v[j] * rstd * gn; }
            } else {
                row_store_bf(x, XS + dryoff + (size_t)r * D, lane);
                Row4 hv; const float* mod = MOD + (size_t)(l + 1) * 9 * 6144 + (size_t)rb * 6144;
                if ((l + 1) % 3 == 2) norm_mod(x, rstd, P->in[6] + (size_t)(l + 1) * D, mod, mod + 1024, (dry ? WSP(bf16_t, WS_ACT + 80 * MiB) : WSP(bf16_t, WS_H)) + (size_t)r * D, lane, hv);
                else norm_mod8(x, rstd, P->in[6] + (size_t)(l + 1) * D, mod, mod + 1024, (dry ? WSP(unsigned char, WS_ACT + 80 * MiB) : WSP(unsigned char, WS_H)) + (size_t)r * D, (dry ? WSP(float, WS_ACT + 120 * MiB) : WSP(float, WS_SAH)) + r, lane);
            }
        }
    }
}
__device__ __forceinline__ void phase_final_norm(PK P, int gw, int lane) {
    for (int r = gw; r < NL; r += 2048) { Row4 x; row_load_bf(x, WSP(const bf16_t, WS_XS) + (size_t)r * D, lane); const float rstd = row_rstd(x, lane);
#pragma unroll
        for (int j = 0; j < 4; ++j) { const int c = 4 * lane + 256 * j; const f32x4 gn = *(const f32x4*)(P->in[8] + c); *(f32x4*)(P->out + (size_t)r * D + c) = x.v[j] * rstd * gn; } }
}

__device__ __forceinline__ void conv_item(const float* src, int N, int nvalid, int k0, int n0, bf16_t* dst, int ldk, int drow0, int dk0, LAS unsigned* scr, int lane) {
    const int q = lane >> 4, nl = lane & 15, n = n0 + 4 * nl;
    f32x4 v[16];
#pragma unroll
    for (int r = 0; r < 16; ++r) { const int k = k0 + 8 * (r >> 1) + 2 * q + (r & 1);
        v[r] = (n < nvalid) ? __builtin_nontemporal_load((const f32x4*)(src + (size_t)k * N + n)) : (f32x4){0.f, 0.f, 0.f, 0.f}; }
#pragma unroll
    for (int rp = 0; rp < 8; ++rp)
#pragma unroll
        for (int i = 0; i < 4; ++i) { const int nn = 4 * nl + i, kw = 4 * rp + q; scr[nn * 32 + (kw ^ (4 * ((nn >> 2) & 7)))] = cvt_pk_bf16(v[2 * rp][i], v[2 * rp + 1][i]); }
    asm volatile("s_waitcnt lgkmcnt(0)" ::: "memory");
#pragma unroll
    for (int it = 0; it < 8; ++it) { const int nn = 8 * it + (lane >> 3), c = lane & 7;
        const u32x4 w = *(const LAS u32x4*)(scr + nn * 32 + 4 * (c ^ ((nn >> 2) & 7)));
        *(u32x4*)(dst + (size_t)(drow0 + nn) * ldk + dk0 + 8 * c) = w; }
    asm volatile("s_waitcnt lgkmcnt(0)" ::: "memory");
}
constexpr int CV_A_IN = 2 * 16 * 24, CV_A_OUT = 2 * 256, CV_B_IN = 16 * 48, CV_B_OUT = 256, CV_C_IN = 16 * 8, CV_C_UQ = 4 * 24, CV_C_UKV = 2 * 32, CV_C_OUT = 256;
constexpr int CV_SMALL = CV_A_IN + CV_A_OUT + CV_B_IN + CV_B_OUT + CV_C_IN + CV_C_UQ + CV_C_UKV + CV_C_OUT;
constexpr int CV_LAYER = NEXP * 3 * 256;
constexpr int CV_TOTAL = CV_SMALL + DEPTH * CV_LAYER;
constexpr int CV_CHUNK = 32;
__device__ __forceinline__ void conv_dispatch(PK P, int item, LAS unsigned* scr, int lane) {
    int r = item; const float* src; bf16_t* dst; int N, kb, nb, ldk = D, drow_off = 0, dk_off = 0;
    if (r < CV_A_IN) return;
    else if ((r -= CV_A_IN) < CV_A_OUT) { const int s = r / 256, it = r % 256; kb = it / 16; nb = it % 16; src = P->in[10] + (size_t)s * D * D; N = D; dst = WSP(bf16_t, WS_WA_OUT) + (size_t)s * D * D; }
    else if ((r -= CV_A_OUT) < CV_B_IN) return;
    else if ((r -= CV_B_IN) < CV_B_OUT) { kb = r / 16; nb = r % 16; src = P->in[13]; N = D; dst = WSP(bf16_t, WS_WB_OUT); }
    else if ((r -= CV_B_OUT) < CV_C_IN) { kb = r / 8; nb = r % 8; src = P->in[15]; N = C_IN; dst = WSP(bf16_t, WS_WC_IN); }
    else if ((r -= CV_C_IN) < CV_C_UQ) { kb = r / 24; nb = r % 24; src = P->in[18]; N = 1536; dst = WSP(bf16_t, WS_WC_UP); ldk = C_UPK; }
    else if ((r -= CV_C_UQ) < CV_C_UKV) { kb = r / 32; nb = r % 32; src = P->in[19]; N = 2048; dst = WSP(bf16_t, WS_WC_UP); ldk = C_UPK; drow_off = 1536; dk_off = 256; }
    else { r -= CV_C_UKV; kb = r / 16; nb = r % 16; src = P->in[20]; N = D; dst = WSP(bf16_t, WS_WC_OUT); }
    conv_item(src, N, N, 64 * kb, 64 * nb, dst, ldk, drow_off + 64 * nb, dk_off + 64 * kb, scr, lane);
}
__device__ __forceinline__ void conv_down_item(PK P, int L, int di, LAS unsigned* scr, int lane) {
    const int le = L * NEXP + (di >> 8), it = di & 255, kb = it >> 4, nb = it & 15;
    conv_item(P->in[27] + (size_t)le * D * D, D, D, 64 * kb, 64 * nb, WSP(bf16_t, WS_WD) + (size_t)le * D * D, D, 64 * nb, 64 * kb, scr, lane);
}
__device__ __forceinline__ void conv_q8_block(const float* src0, int N, unsigned char* dstq, float* dsts, LAS unsigned char* lds, int tid) {
    const int lane = tid & 63, wid = __builtin_amdgcn_readfirstlane(tid >> 6), q = lane >> 4, nl = lane & 15;
    const float* src = src0 + 4 * nl;
    f32x4 v[32];
#pragma unroll
    for (int r = 0; r < 32; ++r) { const int k = 128 * wid + 16 * (r >> 2) + 4 * q + (r & 3); v[r] = __builtin_nontemporal_load((const f32x4*)(src + (size_t)k * N)); }
    float cm[4] = {0.f, 0.f, 0.f, 0.f};
#pragma unroll
    for (int r = 0; r < 32; ++r)
#pragma unroll
        for (int i = 0; i < 4; ++i) cm[i] = fmaxf(cm[i], fabsf(v[r][i]));
    LAS float* cmx = (LAS float*)(lds + 65536);
#pragma unroll
    for (int i = 0; i < 4; ++i) { cm[i] = fmaxf(cm[i], shx(cm[i], 16, lane)); cm[i] = swap32_max(cm[i]); }
    if (q == 0) { *(LAS f32x4*)(cmx + wid * 64 + 4 * nl) = (f32x4){cm[0], cm[1], cm[2], cm[3]}; }
    __syncthreads();
    f32x4 a = *(const LAS f32x4*)(cmx + 4 * nl);
#pragma unroll
    for (int w = 1; w < 8; ++w) { const f32x4 b = *(const LAS f32x4*)(cmx + w * 64 + 4 * nl); a[0] = fmaxf(a[0], b[0]); a[1] = fmaxf(a[1], b[1]); a[2] = fmaxf(a[2], b[2]); a[3] = fmaxf(a[3], b[3]); }
    float inv[4];
#pragma unroll
    for (int i = 0; i < 4; ++i) { a[i] = fmaxf(a[i], 1e-30f); inv[i] = 127.0f / a[i]; }
    if (wid == 0 && q == 0) *(f32x4*)(dsts + 4 * nl) = a * (1.0f / 127.0f);
    LAS unsigned* scr = (LAS unsigned*)(lds + wid * 8192);
#pragma unroll
    for (int rp = 0; rp < 8; ++rp)
#pragma unroll
        for (int i = 0; i < 4; ++i) { const int nn = 4 * nl + i, kw = 4 * rp + q;
            scr[nn * 32 + (kw ^ (4 * ((nn >> 2) & 7)))] = pk_i8x4(v[4 * rp][i], v[4 * rp + 1][i], v[4 * rp + 2][i], v[4 * rp + 3][i], inv[i]); }
    asm volatile("s_waitcnt lgkmcnt(0)" ::: "memory");
    unsigned char* dst = dstq + 128 * wid;
#pragma unroll
    for (int it = 0; it < 8; ++it) { const int nn = 8 * it + (lane >> 3), c = lane & 7;
        const u32x4 w = *(const LAS u32x4*)(scr + nn * 32 + 4 * (c ^ ((nn >> 2) & 7)));
        *(u32x4*)(dst + (size_t)nn * D + 16 * c) = w; }
    __syncthreads();
}
__device__ __forceinline__ void conv_gu_block(PK P, LAS unsigned char* lds, int le, int which, int nb, int tid) {
    const int n0 = 64 * nb, drow0 = 256 * (n0 >> 7) + (n0 & 127) + (which ? 128 : 0);
    conv_q8_block(P->in[which ? 25 : 23] + (size_t)le * D * D + n0, D, WSP(unsigned char, WS_WGU) + ((size_t)le * 2048 + drow0) * D, WSP(float, WS_SBW) + (size_t)le * 2048 + drow0, lds, tid);
}
__device__ __forceinline__ void conv_in_block(PK P, LAS unsigned char* lds, int blk, int tid) {
    if (blk < 48) { const int s = blk / 24, nb = blk % 24;
        conv_q8_block(P->in[9] + (size_t)s * D * A_IN + 64 * nb, A_IN, WSP(unsigned char, WS_WA_IN) + ((size_t)s * A_IN + 64 * nb) * D, WSP(float, WS_SBI) + s * A_IN + 64 * nb, lds, tid); }
    else { const int nb = blk - 48;
        conv_q8_block(P->in[12] + 64 * nb, B_IN, WSP(unsigned char, WS_WB_IN) + (size_t)64 * nb * D, WSP(float, WS_SBI) + 2 * A_IN + 64 * nb, lds, tid); }
}
constexpr int CV_SLOTS = 1536;
__device__ __forceinline__ void conv_slot(PK P, LAS unsigned char* lds, int L, int s, int tid) {
    if (s < 1024) { conv_gu_block(P, lds, L * NEXP + (s >> 5), (s >> 4) & 1, s & 15, tid); return; }
    const int d = s - 1024, le = L * NEXP + (d >> 4), nb = d & 15;
    conv_q8_block(P->in[27] + (size_t)le * D * D + 64 * nb, D, WSP(unsigned char, WS_WD) + ((size_t)le * D + 64 * nb) * D, WSP(float, WS_SBD) + (size_t)le * D + 64 * nb, lds, tid);
}
__device__ __forceinline__ void conv_claim(PK P, LAS unsigned char* lds, int L, int quota, int tid) {
    LAS int* slot = (LAS int*)(lds + MISC_OFF + M_CVB);
    unsigned* ctr = WSP(unsigned, WS_CTL) + CW_CV + L * 16;
    for (int q = 0; q < quota; ++q) {
        __syncthreads();
        if (tid == 0) *slot = (int)__hip_atomic_fetch_add(ctr, 1u, __ATOMIC_RELAXED, __HIP_MEMORY_SCOPE_AGENT);
        __syncthreads();
        const int sl = __builtin_amdgcn_readfirstlane(*slot);
        if (sl >= CV_SLOTS) break;
        conv_slot(P, lds, L, sl, tid);
    }
    __syncthreads();
}
__device__ __forceinline__ void phase_prologue(PK P, LAS unsigned char* lds, int bid, int tid) {
    const int lane = tid & 63, wid = __builtin_amdgcn_readfirstlane(tid >> 6);
    {
        LAS float* S = (LAS float*)lds; LAS float* red = (LAS float*)(lds + 40960);
        for (int idx = tid; idx < 9 * D; idx += 512) { const int r = idx >> 10, d = idx & (D - 1); const float v = r < 8 ? P->in[1][r * D + d] : P->in[3][d];
            S[idx] = v / (1.0f + __builtin_amdgcn_exp2f(-v * LOG2E)); }
        __syncthreads();
        const int l = bid >> 6, c0 = (bid & 63) * 96;
        if (lane < 48) {
            float acc[9][2];
#pragma unroll
            for (int r = 0; r < 9; ++r) { acc[r][0] = 0.f; acc[r][1] = 0.f; }
            const float* wp = P->in[4] + ((size_t)l * D + 128 * wid) * 6144 + c0 + 2 * lane;
            const LAS float* sp = S + 128 * wid;
            for (int kb = 0; kb < 128; kb += 32) {
                f32x2 w[32];
#pragma unroll
                for (int k = 0; k < 32; ++k) w[k] = __builtin_nontemporal_load((const f32x2*)(wp + (size_t)(kb + k) * 6144));
#pragma unroll
                for (int k = 0; k < 32; ++k)
#pragma unroll
                    for (int r = 0; r < 9; ++r) { const float s = sp[r * D + kb + k]; acc[r][0] += s * w[k][0]; acc[r][1] += s * w[k][1]; } }
#pragma unroll
            for (int r = 0; r < 9; ++r) { red[(wid * 9 + r) * 96 + 2 * lane] = acc[r][0]; red[(wid * 9 + r) * 96 + 2 * lane + 1] = acc[r][1]; }
        }
        __syncthreads();
        float* MOD = WSP(float, WS_MOD);
        for (int idx = tid; idx < 9 * 96; idx += 512) { const int r = idx / 96, cc = idx % 96; float s = 0.f;
#pragma unroll
            for (int w = 0; w < 8; ++w) s += red[(w * 9 + r) * 96 + cc];
            MOD[((size_t)l * 9 + r) * 6144 + c0 + cc] = s + P->in[5][(size_t)l * 6144 + c0 + cc]; }
        __syncthreads();
    }
    {
        const int gt = bid * 512 + tid; float* RA = WSP(float, WS_ROPE_A); float* RC = WSP(float, WS_ROPE_C);
        const float L2T = 13.287712379549449f;
        for (int idx = gt; idx < SEQ * 32; idx += 131072) { const int t = idx >> 5, i = idx & 31; const float pos = (float)(i < 16 ? (t >> 6) : (t & 63));
            const float inv = __builtin_amdgcn_exp2f(-(float)(i & 15) * (1.0f / 16.0f) * L2T); const float ang = pos * inv; RA[2 * idx] = __cosf(ang); RA[2 * idx + 1] = __sinf(ang); }
        for (int idx = gt; idx < SEQ * 16; idx += 131072) { const int t = idx >> 4, i = idx & 15; const float pos = (float)(i < 8 ? (t >> 6) : (t & 63));
            const float inv = __builtin_amdgcn_exp2f(-(float)(i & 7) * (1.0f / 8.0f) * L2T); const float ang = pos * inv; RC[2 * idx] = __cosf(ang); RC[2 * idx + 1] = __sinf(ang); }
        bf16_t* WU = WSP(bf16_t, WS_WC_UP); const u32x4 z = (u32x4){0u, 0u, 0u, 0u};
        for (int idx = gt; idx < 1536 * 16; idx += 131072) *(u32x4*)(WU + (size_t)(idx >> 4) * C_UPK + 256 + 8 * (idx & 15)) = z;
        for (int idx = gt; idx < 2048 * 32; idx += 131072) *(u32x4*)(WU + (size_t)(1536 + (idx >> 5)) * C_UPK + 8 * (idx & 31)) = z;
    }
    {
        LAS unsigned* scr = (LAS unsigned*)(lds + wid * 8192);
        const int gw = bid * 8 + wid;
        for (int item = gw; item < CV_SMALL; item += 2048) conv_dispatch(P, item, scr, lane);
        __syncthreads();
        for (int blk = bid; blk < 96; blk += 256) conv_in_block(P, lds, blk, tid);
        for (int sl = bid; sl < CV_SLOTS; sl += 256) conv_slot(P, lds, 0, sl, tid);
    }
}

constexpr int PH_PRO = 0, PH_N0 = 1, PH_L0 = 2, PH_PER_LAYER = 9, PH_FINAL = PH_L0 + DEPTH * PH_PER_LAYER, NPH = PH_FINAL + 1;
enum { LP_IN = 0, LP_MLANORM = 1, LP_MLAUP = 2, LP_ATT = 3, LP_OUT = 4, LP_RT = 5, LP_GU = 6, LP_DN = 7, LP_CB = 8 };
struct Args { Ptrs P; int p_lo, p_hi, bar_idx, pad; };

__global__ void __launch_bounds__(512, 2) mk_fwd(Args a) {
    extern __shared__ __attribute__((aligned(16))) unsigned char lds_raw[];
    LAS unsigned char* const lds = (LAS unsigned char*)lds_raw;
    LAS unsigned char* const misc = lds + MISC_OFF;
    typedef const __attribute__((address_space(4))) Args* ArgsK;
    const ArgsK ak = (ArgsK)__builtin_amdgcn_kernarg_segment_ptr();
    (void)a;
    const int wid0 = __builtin_amdgcn_readfirstlane((int)threadIdx.x >> 6);
    if (wid0 == 0 && lane_id() < 4) ((LAS unsigned*)(misc + M_BARW))[lane_id()] = 0u;
    __syncthreads();
    XcdBarrier bar;
    { PK P = &ak->P; bar = xcd_barrier_post(WSP(unsigned, WS_CTL) + CW_BAR + ak->bar_idx * XCD_BAR_WORDS, (volatile LAS unsigned*)(misc + M_BARW), wid0 == 0); }
    bool ran = false;
    const int p_lo = ak->p_lo, p_hi = ak->p_hi;
#define PHASE_BEGIN(bit, p, cond) if ((((MK_MASK) >> (bit)) & 1) && p_lo <= (p) && (p) < p_hi && ((p) <= MK_STOP_AFTER || (p) == PH_FINAL) && (cond)) for (int rep_ = 0; rep_ < 1 + (((MK_REP_MASK) >> (bit)) & 1); ++rep_) { if (ran) xcd_barrier(bar); ran = true; \
    int tid = wid0 * 64 + lane_id(); asm volatile("" : "+v"(tid)); int bid = blockIdx.x; asm volatile("" : "+s"(bid)); ArgsK ak_ = ak; asm volatile("" : "+s"(ak_)); PK P = &ak_->P; \
    const int lane = tid & 63, wid = __builtin_amdgcn_readfirstlane(tid >> 6), vcu = (bid & 7) * 32 + (bid >> 3), gw = vcu * 8 + wid; (void)lane; (void)gw; (void)P;
#define PHASE_END }

    PHASE_BEGIN(0, PH_PRO, true) phase_prologue(P, lds, bid, tid); PHASE_END
    PHASE_BEGIN(1, PH_N0, true) phase_first_norm(P, gw, lane); PHASE_END

    for (int l = 0; l < DEPTH; ++l) {
        const int kind = l % 3, slot = l / 3, pb = PH_L0 + l * PH_PER_LAYER;
        const bool last = (l == DEPTH - 1);
        const int nMrows = last ? NL / 256 : NT / 256;
        PHASE_BEGIN(2, pb + LP_IN, kind == 0) {
            pg8::Gemm g{WSP(const void, WS_H), WSP(const unsigned char, WS_WA_IN) + (size_t)slot * A_IN * D, D, 0, nullptr};
            pg8::DenseOrder S{nMrows, 6, vcu, last ? 8 : 0, 4, 2};
            pg8::EpiQkvA8 E{WSP(bf16_t, WS_QKV), WSP(const float, WS_ROPE_A), WSP(const float, WS_SAH), WSP(const float, WS_SBI) + slot * A_IN, (const LAS float*)(misc + M_EPF)};
            pg8::gemm_phase<pg8::EpiQkvA8, pg8::DenseOrder, false, true>(lds, g, S, E, tid);
            if (l >= 1 && S.short_one()) conv_claim(P, lds, l, MK_Q_IN, tid);
        } PHASE_END
        PHASE_BEGIN(3, pb + LP_IN, kind == 1) {
            pg8::Gemm g{WSP(const void, WS_H), WSP(const unsigned char, WS_WB_IN), D, 0, nullptr};
            pg8::DenseOrder S{NT / 256, 12, vcu, 0, 0, 0};
            pg8::EpiBf16Plain8 E{WSP(bf16_t, WS_QKV), B_IN, 4, 0.125f * LOG2E, WSP(const float, WS_SAH), WSP(const float, WS_SBI) + 2 * A_IN, (const LAS float*)(misc + M_EPF)};
            pg8::gemm_phase<pg8::EpiBf16Plain8, pg8::DenseOrder, false, true>(lds, g, S, E, tid);
            if (S.short_one()) conv_claim(P, lds, l, MK_Q_IN, tid);
        } PHASE_END
        PHASE_BEGIN(4, pb + LP_IN, kind == 2) {
            pg8::Gemm g{WSP(const bf16_t, WS_H), WSP(const bf16_t, WS_WC_IN), D, 0, nullptr};
            pg8::DenseOrder S{NT / 256, 2, vcu, 0, 0, 0};
            pg8::EpiF32Plain E{WSP(float, WS_Y416), C_INP};
            pg8::gemm_phase<pg8::EpiF32Plain, pg8::DenseOrder, false>(lds, g, S, E, tid);
        } PHASE_END
        PHASE_BEGIN(5, pb + LP_MLANORM, kind == 2) phase_mla_norm(P, gw, lane); PHASE_END
        PHASE_BEGIN(6, pb + LP_MLAUP, kind == 2) {
            pg8::Gemm g{WSP(const bf16_t, WS_CQKV), WSP(const bf16_t, WS_WC_UP), C_UPK, 0, nullptr};
            pg8::DenseOrder S{NT / 256, 14, vcu, 0, 0, 0};
            pg8::EpiMlaUp E{WSP(bf16_t, WS_QKV), WSP(const float, WS_ROPE_C)};
            pg8::gemm_phase<pg8::EpiMlaUp, pg8::DenseOrder, false>(lds, g, S, E, tid);
        } PHASE_END
        PHASE_BEGIN(7, pb + LP_ATT, kind == 0) {
            const bf16_t* QKV = WSP(const bf16_t, WS_QKV); bf16_t* O = WSP(bf16_t, WS_O); const float* sink = P->in[11] + slot * 16;
            for (int u = vcu; u < 1024; u += 256) { const int bk = u >> 5; att::attn_A_unit(lds, QKV, O, sink, bk >> 2, bk & 3, u & 31, false, tid); }
            if (!last) for (int u = vcu; u < 128; u += 256) { const int bk = u >> 2; att::attn_A_unit(lds, QKV, O, sink, bk >> 2, bk & 3, u & 3, true, tid); }
        } PHASE_END
        PHASE_BEGIN(8, pb + LP_ATT, kind == 1) {
            const bf16_t* QKV = WSP(const bf16_t, WS_QKV); bf16_t* O = WSP(bf16_t, WS_O); LAS float* tab = (LAS float*)(misc + M_RPB);
            for (int u = vcu; u < 1024; u += 256) { const int bh = u >> 3; att::attn_B_unit(lds, tab, QKV, O, P->in[14], bh >> 4, bh & 15, u & 7, false, tid); }
            for (int u = vcu; u < 128; u += 256) att::attn_B_unit(lds, tab, QKV, O, P->in[14], u >> 4, u & 15, 0, true, tid);
        } PHASE_END
        PHASE_BEGIN(9, pb + LP_ATT, kind == 2) {
            const bf16_t* QKV = WSP(const bf16_t, WS_QKV); bf16_t* O = WSP(bf16_t, WS_O); const bf16_t* KR = WSP(const bf16_t, WS_KR);
            for (int u = vcu; u < 1024; u += 256) { const int bh = u >> 3; att::attn_C_unit(lds, QKV, KR, O, bh >> 4, bh & 15, u & 7, false, tid); }
            for (int u = vcu; u < 128; u += 256) att::attn_C_unit(lds, QKV, KR, O, u >> 4, u & 15, 0, true, tid);
        } PHASE_END
        PHASE_BEGIN(10, pb + LP_OUT, true) {
            const bf16_t* W = kind == 0 ? WSP(const bf16_t, WS_WA_OUT) + (size_t)slot * D * D : (kind == 1 ? WSP(const bf16_t, WS_WB_OUT) : WSP(const bf16_t, WS_WC_OUT));
            pg8::Gemm g{WSP(const bf16_t, WS_O), W, D, 0, nullptr};
            pg8::DenseOrder S{nMrows, 4, vcu, 0, 0, 0};
            pg8::EpiResid E{(const LAS float*)(misc + M_EPF), WSP(bf16_t, WS_XS), WSP(const float, WS_MOD) + (size_t)l * 9 * 6144 + 2048, (rep_ + 1 < 1 + ((MK_REP_MASK >> 10) & 1)) ? WSP(bf16_t, WS_ACT) : WSP(bf16_t, WS_XS)};
            pg8::gemm_phase<pg8::EpiResid, pg8::DenseOrder, false>(lds, g, S, E, tid);
            if (!last && S.short_one()) conv_claim(P, lds, l + 1, MK_Q_OUT, tid);
        } PHASE_END
        PHASE_BEGIN(11, pb + LP_RT, true) { if (l >= 1) conv_claim(P, lds, l, 1 << 30, tid); phase_router(P, lds, l, last ? NL : NT, vcu, tid, rep_); } PHASE_END
        PHASE_BEGIN(12, pb + LP_GU, true) {
            moe_tables(misc, WSP(unsigned, WS_CTL) + CW_CNT + (l * 2 + ((MK_REP_MASK >> 11) & 1)) * 512, tid);
            pg8::Gemm g{WSP(const void, WS_H), WSP(const unsigned char, WS_WGU) + (size_t)l * NEXP * 2 * D * D, D, (size_t)2 * D * D, WSP(const int, WS_ELIST)};
            const bool cvw = !last && MK_CVW_GU > 0 && (vcu & 15) == 15;
            const int Gc = (!last && MK_CVW_GU > 0) ? 240 : 256, ic = (!last && MK_CVW_GU > 0) ? (cvw ? -1 : vcu - (vcu >> 4)) : vcu;
            pg8::MoeOrder S{(const LAS int*)(misc + M_ECNT), (const LAS int*)(misc + M_LBASE), (const LAS int*)(misc + M_CUMT), 8, ic, Gc, (LAS int*)(misc + M_UL)}; S.build(tid);
            pg8::EpiSwiglu8 E{WSP(bf16_t, WS_ACT), P->in[24] + (size_t)l * NEXP * D, P->in[26] + (size_t)l * NEXP * D, WSP(const float, WS_SAL), WSP(const float, WS_SBW) + (size_t)l * NEXP * 2048, (const LAS float*)(misc + M_EPF)};
            pg8::gemm_phase<pg8::EpiSwiglu8, pg8::MoeOrder, true, true>(lds, g, S, E, tid);
            if (!last && (cvw || S.short_one())) conv_claim(P, lds, l + 1, cvw ? MK_CVW_GU : MK_Q_GU, tid);
        } PHASE_END
        PHASE_BEGIN(13, pb + LP_DN, true) {
            if (MK_PER_PHASE) moe_tables(misc, WSP(unsigned, WS_CTL) + CW_CNT + (l * 2 + ((MK_REP_MASK >> 11) & 1)) * 512, tid);
            phase_requant(P, (const LAS int*)(misc + M_CUMT), gw, lane);
            xcd_barrier(bar);
            const bool cvw = !last && MK_CVW_DN > 0 && (vcu & 15) == 15;
            const int Gc = (!last && MK_CVW_DN > 0) ? 240 : 256, ic = (!last && MK_CVW_DN > 0) ? (cvw ? -1 : vcu - (vcu >> 4)) : vcu;
            pg8::Gemm g{WSP(const void, WS_ACT8), WSP(const unsigned char, WS_WD) + (size_t)l * NEXP * D * D, D, (size_t)D * D, nullptr};
            pg8::MoeOrder S{(const LAS int*)(misc + M_ECNT), (const LAS int*)(misc + M_LBASE), (const LAS int*)(misc + M_CUMT), 4, ic, Gc, (LAS int*)(misc + M_UL)}; S.build(tid);
            pg8::EpiDown8 E{WSP(bf16_t, WS_YS), P->in[28] + (size_t)l * NEXP * D, WSP(const float, WS_SAQ), WSP(const float, WS_SBD) + (size_t)l * NEXP * D, (const LAS float*)(misc + M_EPF)};
            pg8::gemm_phase<pg8::EpiDown8, pg8::MoeOrder, false, true>(lds, g, S, E, tid);
            if (!last && (cvw || S.short_one())) conv_claim(P, lds, l + 1, cvw ? MK_CVW_DN : MK_Q_DN, tid);
        } PHASE_END
        PHASE_BEGIN(14, pb + LP_CB, true) phase_combine(P, lds, l, last ? NL : NT, gw, tid, (rep_ + 1 < 1 + ((MK_REP_MASK >> 14) & 1))); PHASE_END
    }
    PHASE_BEGIN(15, PH_FINAL, MK_STOP_AFTER < PH_FINAL - 1) phase_final_norm(P, gw, lane); PHASE_END
#undef PHASE_BEGIN
#undef PHASE_END
}

extern "C" void kernel_launch(void* const* d_in, const int* in_sizes, int n_in, void* d_out, int out_size, void* d_ws, size_t ws_size, hipStream_t stream) {
    static int grid = 0;
    if (grid == 0) {
        if (n_in != 29 || out_size != NL * D || ws_size < WS_END) { fprintf(stderr, "kernel_launch: expected 29 inputs, out %d, ws >= %zu; got n_in %d out %d ws %zu\n", NL * D, (size_t)WS_END, n_in, out_size, ws_size); grid = -1; return; }
        int dev = 0, cus = 0, per_cu = 0;
        if (hipGetDevice(&dev) != hipSuccess || hipDeviceGetAttribute(&cus, hipDeviceAttributeMultiprocessorCount, dev) != hipSuccess) { grid = -1; return; }
        if (hipFuncSetAttribute((const void*)mk_fwd, hipFuncAttributeMaxDynamicSharedMemorySize, LDS_BYTES) != hipSuccess) { fprintf(stderr, "kernel_launch: hipFuncSetAttribute failed\n"); grid = -1; return; }
        if (hipOccupancyMaxActiveBlocksPerMultiprocessor(&per_cu, (const void*)mk_fwd, 512, LDS_BYTES) != hipSuccess || per_cu < 1) fprintf(stderr, "kernel_launch: occupancy query says %d\n", per_cu);
        (void)hipGetLastError();
        grid = 256;
        if (cus < 256) { fprintf(stderr, "kernel_launch: needs 256 CUs, device has %d\n", cus); grid = -1; return; }
    }
    if (grid < 0) return;
    if (hipMemsetAsync((char*)d_ws + WS_CTL, 0, CTL_BYTES, stream) != hipSuccess) return;
    Args a{};
    for (int i = 0; i < 29; ++i) a.P.in[i] = (const float*)d_in[i];
    a.P.out = (float*)d_out; a.P.ws = (unsigned char*)d_ws; a.pad = 0;
#if MK_PER_PHASE
    for (int p = 0; p < NPH; ++p) { a.p_lo = p; a.p_hi = p + 1; a.bar_idx = 0; hipLaunchKernelGGL(mk_fwd, dim3(grid), dim3(512), LDS_BYTES, stream, a); }
#else
    a.p_lo = 0; a.p_hi = NPH; a.bar_idx = 0;
    hipLaunchKernelGGL(mk_fwd, dim3(grid), dim3(512), LDS_BYTES, stream, a);
#endif
    const hipError_t le = hipPeekAtLastError();
    if (le != hipSuccess) fprintf(stderr, "kernel_launch: launch failed: %s\n", hipGetErrorName(le));
}
```

```cpp
#include <hip/hip_runtime.h>
#include <cstdio>
#include <cstdint>

#ifndef MK_PER_PHASE
#define MK_PER_PHASE 0
#endif
#ifndef MK_MASK
#define MK_MASK 0xFFFF
#endif
#ifndef MK_REP_MASK
#define MK_REP_MASK 0
#endif
#ifndef MK_Q_OUT
#define MK_Q_OUT 1
#endif
#ifndef MK_Q_GU
#define MK_Q_GU 1
#endif
#ifndef MK_Q_DN
#define MK_Q_DN 1
#endif
#ifndef MK_Q_IN
#define MK_Q_IN 1
#endif
#ifndef MK_MT_MAJOR
#define MK_MT_MAJOR 1
#endif
#ifndef MK_Q_ATT
#define MK_Q_ATT 1
#endif
#ifndef MK_OSUM_MFMA
#define MK_OSUM_MFMA 0
#endif
#ifndef MK_Q_STAG
#define MK_Q_STAG 1
#endif
#ifndef MK_EPI2
#define MK_EPI2 0
#endif
#ifndef MK_ATT_STAGGER
#define MK_ATT_STAGGER 3
#endif
#ifndef MK_O_ROWS
#define MK_O_ROWS 1
#endif
#ifndef MK_CVW_GU
#define MK_CVW_GU 0
#endif
#ifndef MK_CVW_DN
#define MK_CVW_DN 0
#endif
#ifndef MK_TIME_PHASE
#define MK_TIME_PHASE -1
#endif
#ifndef MK_STOP_AFTER
#define MK_STOP_AFTER 9999
#endif

#define LAS __attribute__((address_space(3)))
#define GAS __attribute__((address_space(1)))
typedef unsigned short bf16_t;
typedef short bf16x8 __attribute__((ext_vector_type(8)));
typedef short s16x4 __attribute__((ext_vector_type(4)));
typedef _Float16 f16x8 __attribute__((ext_vector_type(8)));
typedef _Float16 f16x2 __attribute__((ext_vector_type(2)));
typedef float f32x2 __attribute__((ext_vector_type(2)));
typedef float f32x4 __attribute__((ext_vector_type(4)));
typedef float f32x16 __attribute__((ext_vector_type(16)));
typedef unsigned u32x2 __attribute__((ext_vector_type(2)));
typedef unsigned u32x4 __attribute__((ext_vector_type(4)));
typedef int i32x4 __attribute__((ext_vector_type(4)));

constexpr int D = 1024, NB = 8, SEQ = 2048, CTXL = 256, DEPTH = 4;
constexpr int NL = NB * SEQ;
constexpr int NC = NB * CTXL;
constexpr int NT = NL + NC;
constexpr int NEXP = 32, TOPK = 4;
constexpr int MAXSLOT = 81920;
constexpr float NORM_EPS = 1e-6f;
constexpr float LOG2E = 1.4426950408889634f;
constexpr int A_IN = 1536, B_IN = 3072, C_IN = 416, C_INP = 512, C_UPK = 384, C_UPN = 3584;

constexpr size_t MiB = 1u << 20;
constexpr size_t WS_CTL = 0, CTL_BYTES = 1 * MiB;
constexpr size_t WS_MOD = 1 * MiB;
constexpr size_t WS_ROPE_A = 2 * MiB;
constexpr size_t WS_ROPE_C = 2 * MiB + 512 * 1024;
constexpr size_t WS_TOPE = 3 * MiB;
constexpr size_t WS_POS = 3 * MiB + 512 * 1024;
constexpr size_t WS_GATE = 4 * MiB;
constexpr size_t WS_ELIST = 5 * MiB;
constexpr size_t WS_KR = 8 * MiB;
constexpr size_t WS_CQKV = 10 * MiB;
constexpr size_t WS_Y416 = 24 * MiB;
constexpr size_t WS_XS = 60 * MiB;
constexpr size_t WS_H = 132 * MiB;
constexpr size_t WS_O = 168 * MiB;
constexpr size_t WS_QKV = 204 * MiB;
constexpr size_t WS_ACT = 330 * MiB;
constexpr size_t WS_SBLK = 426 * MiB;
constexpr size_t WS_YS = 490 * MiB;
constexpr size_t WS_YSB = 586 * MiB;
constexpr size_t WS_WA_IN = 650 * MiB;
constexpr size_t WS_WA_OUT = 656 * MiB;
constexpr size_t WS_WB_IN = 660 * MiB;
constexpr size_t WS_WB_OUT = 666 * MiB;
constexpr size_t WS_WC_IN = 668 * MiB;
constexpr size_t WS_WC_UP = 669 * MiB;
constexpr size_t WS_WC_OUT = 672 * MiB;
constexpr size_t WS_WGU = 676 * MiB;
constexpr size_t WS_WD = 1188 * MiB;
constexpr size_t WS_G16 = 1444 * MiB;
constexpr size_t WS_RC = 1447 * MiB;
constexpr size_t WS_SBW = 1448 * MiB;
constexpr size_t WS_SAL = 1449 * MiB;
constexpr size_t WS_SAH = 1452 * MiB;
constexpr size_t WS_SBI = 1452 * MiB + 128 * 1024;
constexpr size_t WS_ACT8 = 1453 * MiB;
constexpr size_t WS_SAQ = 1533 * MiB;
constexpr size_t WS_SBD = 1533 * MiB + 512 * 1024;
constexpr size_t WS_END = 1535 * MiB;

constexpr int CW_CV = 512;
constexpr int CW_CNT = 1024;
constexpr int CW_BAR = 65536;

constexpr int RING_BYTES = 131072;
constexpr int MISC_OFF = RING_BYTES;
constexpr int M_BARW = 0, M_LCNT = 64, M_LBASE = 192, M_CUMT = 320, M_ECNT = 512, M_GBASE = 640, M_CVB = 768, M_UL = 6656, M_RSA = 7424, M_EPF = 8192, M_RPB = 1024, M_REC = 3072;
constexpr int LDS_BYTES = 147456;

#define XB_TMO      128
#define XB_XCNT(j)  (256  + 64 * (j))
#define XB_XSUB(j)  (1280 + 64 * (j))
#define XB_XGEN(j)  (2304 + 64 * (j))
#define XB_TOP      3328
#define XB_TOPGEN   3392
#define XCD_BAR_WORDS 3456
#define XB_SPIN_CAP (1u << 18)

__device__ __forceinline__ unsigned xb_ld(unsigned* p)              { return __hip_atomic_load(p, __ATOMIC_RELAXED, __HIP_MEMORY_SCOPE_AGENT); }
__device__ __forceinline__ unsigned xb_add(unsigned* p, unsigned v) { return __hip_atomic_fetch_add(p, v, __ATOMIC_RELAXED, __HIP_MEMORY_SCOPE_AGENT); }
__device__ __forceinline__ unsigned xb_xcc_id() { return (unsigned)__builtin_amdgcn_s_getreg((3 << 11) | 20) & 0xFu; }
#define XB_SPIN(cond, bar) do { unsigned _sp = 0; while (cond) { __builtin_amdgcn_s_sleep(1); \
    if ((++_sp & 255u) == 0u) { if (xb_ld(&(bar)[XB_TMO])) break; if (_sp > XB_SPIN_CAP) { atomicAdd(&(bar)[XB_TMO], 1u); break; } } } } while (0)

__device__ __forceinline__ int lane_id() { int r; asm volatile("v_mbcnt_lo_u32_b32 %0, -1, 0\n\tv_mbcnt_hi_u32_b32 %0, -1, %0" : "=v"(r)); return r; }
struct XcdBarrier {
    unsigned* bar; unsigned x;
    volatile LAS unsigned* st;
    bool lead;
};
__device__ __forceinline__ XcdBarrier xcd_barrier_post(unsigned* bar, volatile LAS unsigned* st, bool lead) {
    XcdBarrier b; b.bar = bar; b.x = xb_xcc_id(); b.st = st; b.lead = lead;
    if (lead && lane_id() == 0) (void)xb_add(&bar[XB_XCNT(b.x)], 1u);
    return b;
}
__device__ __forceinline__ void xcd_barrier_complete(unsigned* bar, unsigned x, unsigned& nloc, unsigned& nx) {
    const unsigned G = gridDim.x * gridDim.y * gridDim.z;
    unsigned sum, cnt, mine, sp = 0u;
    for (;;) {
        sum = 0u; cnt = 0u; mine = 0u;
#pragma unroll
        for (unsigned j = 0; j < 16; ++j) { const unsigned c = xb_ld(&bar[XB_XCNT(j)]); sum += c; cnt += (c > 0u) ? 1u : 0u; mine = (j == x) ? c : mine; }
        if (sum == G) break;
        __builtin_amdgcn_s_sleep(1);
        if ((++sp & 255u) == 0u) { if (xb_ld(&bar[XB_TMO])) break; if (sp > XB_SPIN_CAP) { atomicAdd(&bar[XB_TMO], 1u); break; } }
    }
    nloc = mine > 0u ? mine : 1u; nx = cnt > 0u ? cnt : 1u;
}
__device__ __forceinline__ void xcd_barrier(const XcdBarrier& b) {
    asm volatile("s_waitcnt vmcnt(0)" ::: "memory");
    __syncthreads();
    if (b.lead && lane_id() == 0) {
        unsigned* bar = b.bar;
        __builtin_amdgcn_s_waitcnt(0);
        unsigned nloc = b.st[0], nx = b.st[1];
        if (nloc == 0u) { xcd_barrier_complete(bar, b.x, nloc, nx); b.st[0] = nloc; b.st[1] = nx; }
        const unsigned old = xb_add(&bar[XB_XSUB(b.x)], 1u);
        const unsigned gen = old / nloc;
        if (old + 1u == (gen + 1u) * nloc) {
            __builtin_amdgcn_fence(__ATOMIC_RELEASE, "agent");
            asm volatile("s_waitcnt vmcnt(0)" ::: "memory");
            const unsigned og = xb_add(&bar[XB_TOP], 1u);
            const unsigned tg = og / nx;
            if (og + 1u == (tg + 1u) * nx) xb_add(&bar[XB_TOPGEN], 1u);
            else XB_SPIN(xb_ld(&bar[XB_TOPGEN]) == tg, bar);
            __builtin_amdgcn_fence(__ATOMIC_ACQUIRE, "agent");
            xb_add(&bar[XB_XGEN(b.x)], 1u);
            asm volatile("s_waitcnt vmcnt(0)" ::: "memory");
        } else {
            XB_SPIN(xb_ld(&bar[XB_XGEN(b.x)]) == gen, bar);
            __builtin_amdgcn_fence(__ATOMIC_ACQUIRE, "agent");
            asm volatile("s_waitcnt vmcnt(0)" ::: "memory");
        }
    }
    __syncthreads();
}

__device__ __forceinline__ unsigned cvt_pk_bf16(float lo, float hi) { unsigned r; asm volatile("v_cvt_pk_bf16_f32 %0, %1, %2" : "=v"(r) : "v"(lo), "v"(hi)); return r; }
__device__ __forceinline__ float bf_lo(unsigned w) { return __uint_as_float(w << 16); }
__device__ __forceinline__ float bf_hi(unsigned w) { return __uint_as_float(w & 0xffff0000u); }
__device__ __forceinline__ float shx(float v, int mask, int lane) { return __int_as_float(__builtin_amdgcn_ds_bpermute((lane ^ mask) << 2, __float_as_int(v))); }
__device__ __forceinline__ float wave_sum(float v, int lane) {
#pragma unroll
    for (int o = 1; o < 64; o <<= 1) v += shx(v, o, lane);
    return v;
}
__device__ __forceinline__ float wave_max(float v, int lane) {
#pragma unroll
    for (int o = 1; o < 64; o <<= 1) v = fmaxf(v, shx(v, o, lane));
    return v;
}
__device__ __forceinline__ float swap32_max(float m) { auto rr = __builtin_amdgcn_permlane32_swap(__float_as_uint(m), __float_as_uint(m), false, false); return fmaxf(__uint_as_float(rr[0]), __uint_as_float(rr[1])); }
__device__ __forceinline__ float swap16_max(float m) { auto rr = __builtin_amdgcn_permlane16_swap(__float_as_uint(m), __float_as_uint(m), false, false); return fmaxf(__uint_as_float(rr[0]), __uint_as_float(rr[1])); }
__device__ __forceinline__ float swap32_sum(float m) { auto rr = __builtin_amdgcn_permlane32_swap(__float_as_uint(m), __float_as_uint(m), false, false); return __uint_as_float(rr[0]) + __uint_as_float(rr[1]); }

namespace pg8 {
constexpr int BM = 256, BK = 64, HALF = 128, HTB = HALF * BK * 2, STAGE_BYTES = 8 * HTB;
__host__ __device__ __forceinline__ int lds_byte(int r, int c) { const int st = (r >> 4) * 2 + (c >> 5), rr = r & 15, cc = c & 31, ob = rr * 64 + cc * 2; return st * 1024 + (ob ^ (((ob >> 9) & 1) << 5)); }
__host__ __device__ __forceinline__ void stage_rc(int b, int& R, int& C) { const int st = b / 1024, sb = b % 1024, swz = sb ^ (((sb >> 9) & 1) << 5); R = (st >> 1) * 16 + swz / 64; C = (st & 1) * 32 + (swz % 64) / 2; }
__host__ __device__ __forceinline__ int perm32(int rho) { const int n = rho >> 4, i = rho & 15; return 8 * (i >> 2) + 4 * n + (i & 3); }

struct Unit { int pm, pn, e, mt, cnt; };
struct Gemm { const void* A; const void* Bt; int K; size_t bstride; const int* list; };

template <bool I8> struct AccSel { typedef f32x4 type; };
template <> struct AccSel<true> { typedef i32x4 type; };
template <class Epi, class Sched, bool GATHER, bool I8 = false>
__device__ __forceinline__ void gemm_phase(LAS unsigned char* lds, const Gemm g, const Sched& S, const Epi& E, const int tid) {
    const int wid = __builtin_amdgcn_readfirstlane(tid >> 6), lane = tid & 63, wr = wid >> 2, wc = wid & 3, fr = lane & 15, fq = lane >> 4;
    typedef typename AccSel<I8>::type acc_t;
    const int K = g.K, RB = I8 ? K : 2 * K, nt = RB / (BK * 2);
    unsigned voffA[2], voffB[2];
#pragma unroll
    for (int i = 0; i < 2; ++i) { int R, C; stage_rc(tid * 16 + i * 8192, R, C); const int Rb = Epi::PERM ? ((R & ~31) + perm32(R & 31)) : R;
        voffA[i] = (unsigned)(R * RB + C * 2); voffB[i] = (unsigned)(Rb * RB + C * 2); }
#define PG8_RC(i, R_, C_) int R_, C_; { int _t = tid; asm volatile("" : "+v"(_t)); stage_rc(_t * 16 + (i) * 8192, R_, C_); }
    const size_t kstep = (size_t)(BK * 2);
    const size_t hstep = (size_t)HALF * RB;
    const size_t tstep = 2 * hstep;
    const unsigned ldsw = (unsigned)wid * 1024u;
    const int aoff = lds_byte(wr * 64 + fr, fq * 8), boff = lds_byte(wc * 32 + fr, fq * 8);
#define PG8_SA(b, h) (((b) * 2 + (h)) * HTB)
#define PG8_SB(b, h) ((4 + (b) * 2 + (h)) * HTB)
#define PG8_STAGE(bufoff, gbase, voff) do { _Pragma("unroll") for (int _i = 0; _i < 2; ++_i) \
        __builtin_amdgcn_global_load_lds((const unsigned*)((const char*)(gbase) + (voff)[_i]), (LAS unsigned*)(lds + (bufoff) + ldsw + _i * 8192), 16, 0, 0); } while (0)
#define PG8_STAGE_A(bufoff, SELN, H, KOFF) do { if constexpr (GATHER) { unsigned _vo[2]; _vo[0] = (SELN) ? voN[H][0] : voC[H][0]; _vo[1] = (SELN) ? voN[H][1] : voC[H][1]; \
            PG8_STAGE(bufoff, (const char*)g.A + (KOFF), _vo); } else { PG8_STAGE(bufoff, ((SELN) ? nA : cA) + (H) * hstep + (KOFF), voffA); } } while (0)
#define PG8_LDA(dst, b, h) do { _Pragma("unroll") for (int m = 0; m < 4; ++m) _Pragma("unroll") for (int k = 0; k < 2; ++k) dst[m][k] = *(const LAS bf16x8*)(lds + PG8_SA(b, h) + aoff + m * 2048 + k * 1024); } while (0)
#define PG8_LDB(dst, b, h) do { _Pragma("unroll") for (int n = 0; n < 2; ++n) _Pragma("unroll") for (int k = 0; k < 2; ++k) dst[n][k] = *(const LAS bf16x8*)(lds + PG8_SB(b, h) + boff + n * 2048 + k * 1024); } while (0)
#define PG8_MMA(ai, bj, At, Bt) do { __builtin_amdgcn_s_setprio(1); _Pragma("unroll") for (int m = 0; m < 4; ++m) _Pragma("unroll") for (int n = 0; n < 2; ++n) _Pragma("unroll") for (int k = 0; k < 2; ++k) \
        { if constexpr (I8) acc[ai][bj][m][n] = __builtin_amdgcn_mfma_i32_16x16x64_i8(__builtin_bit_cast(i32x4, Bt[n][k]), __builtin_bit_cast(i32x4, At[m][k]), acc[ai][bj][m][n], 0, 0, 0); \
          else acc[ai][bj][m][n] = __builtin_amdgcn_mfma_f32_16x16x32_bf16(Bt[n][k], At[m][k], acc[ai][bj][m][n], 0, 0, 0); } __builtin_amdgcn_s_setprio(0); } while (0)
#define PG8_WAIT_V(n) asm volatile("s_waitcnt vmcnt(" #n ")" ::: "memory")
#define PG8_WAIT_L(n) asm volatile("s_waitcnt lgkmcnt(" #n ")" ::: "memory")
#define PG8_BAR __builtin_amdgcn_s_barrier()
#define PG8_SCHED __builtin_amdgcn_sched_barrier(0)
#define PG8_GATH(U, VO) do { _Pragma("unroll") for (int _h = 0; _h < 2; ++_h) _Pragma("unroll") for (int _i = 0; _i < 2; ++_i) { \
        PG8_RC(_i, _R, _C); int _r = (U).mt * 256 + _h * 128 + _R; _r = _r < (U).cnt ? _r : 0; const int _tok = g.list[(size_t)(U).e * NT + _r]; VO[_h][_i] = (unsigned)(_tok * RB + _C * 2); } } while (0)
    Unit cur, nxt; int ui = 0;
    if (!S.next(0, cur)) return;
    acc_t acc[2][2][4][2];
#pragma unroll
    for (int a = 0; a < 2; ++a)
#pragma unroll
        for (int b = 0; b < 2; ++b)
#pragma unroll
            for (int m = 0; m < 4; ++m)
#pragma unroll
                for (int n = 0; n < 2; ++n) acc[a][b][m][n] = (acc_t){0, 0, 0, 0};
    bf16x8 At[4][2], B0[2][2], B1[2][2];
    unsigned voC[2][2] = {{0u, 0u}, {0u, 0u}}, voN[2][2] = {{0u, 0u}, {0u, 0u}};
    if constexpr (GATHER) { PG8_GATH(cur, voC); }
    const char* cA = GATHER ? (const char*)g.A : (const char*)g.A + (size_t)cur.pm * tstep;
    const size_t bsb = I8 ? g.bstride : 2 * g.bstride;
    const char* cB = (const char*)g.Bt + (size_t)cur.e * bsb + (size_t)cur.pn * tstep;
    const char* nA = cA; const char* nB = cB;
    PG8_STAGE(PG8_SB(0, 0), cB, voffB); PG8_STAGE(PG8_SB(0, 1), cB + hstep, voffB); PG8_STAGE_A(PG8_SA(0, 0), false, 0, 0); PG8_STAGE_A(PG8_SA(0, 1), false, 1, 0);
    if (wr == 1) PG8_BAR;
    PG8_WAIT_V(2); PG8_BAR;
    PG8_STAGE(PG8_SB(1, 0), cB + kstep, voffB); PG8_STAGE_A(PG8_SA(1, 0), false, 0, kstep); PG8_STAGE(PG8_SB(1, 1), cB + hstep + kstep, voffB);
    PG8_WAIT_V(6); PG8_BAR;
    for (;;) {
        const bool has_next = S.next(ui + 1, nxt);
        nA = GATHER ? (const char*)g.A : (has_next ? (const char*)g.A + (size_t)nxt.pm * tstep : cA);
        nB = has_next ? (const char*)g.Bt + (size_t)nxt.e * bsb + (size_t)nxt.pn * tstep : cB;
        int tokN[2][2] = {{0, 0}, {0, 0}};
        if constexpr (GATHER) { if (has_next) {
#pragma unroll
            for (int _h = 0; _h < 2; ++_h)
#pragma unroll
                for (int _i = 0; _i < 2; ++_i) { PG8_RC(_i, _R, _C); (void)_C; int _r = nxt.mt * 256 + _h * 128 + _R; _r = _r < nxt.cnt ? _r : 0; const int* _p = g.list + (size_t)nxt.e * NT + _r;
                    asm volatile("global_load_dword %0, %1, off" : "=v"(tokN[_h][_i]) : "v"(_p) : "memory"); } } }
        unsigned epf[2] = {0u, 0u};
        if constexpr (Epi::PF > 0) {
#pragma unroll
            for (int _k = 0; _k < Epi::PF; ++_k) { const float* _p = E.pf_addr(cur, tid, _k); asm volatile("global_load_dword %0, %1, off" : "=v"(epf[_k]) : "v"(_p) : "memory"); } }
        for (int t = 0; t < nt; t += 2) {
            const bool last = (t == nt - 2);
            const size_t k1 = (size_t)(t + 1) * kstep;
            const size_t k2 = last ? 0 : (size_t)(t + 2) * kstep;
            const size_t k3 = k2 + kstep;
            const char* b2 = (last ? nB : cB) + k2; const char* b3 = b2 + kstep;
            PG8_LDB(B0, 0, 0); PG8_LDB(B1, 0, 1); PG8_SCHED; PG8_LDA(At, 0, 0); PG8_STAGE_A(PG8_SA(1, 1), false, 1, k1);
            PG8_WAIT_V(8); PG8_WAIT_L(0); PG8_BAR; PG8_MMA(0, 0, At, B0); PG8_MMA(0, 1, At, B1); PG8_BAR; PG8_SCHED;
            if constexpr (GATHER) { if (last) { if (has_next) {
                asm volatile("" : "+v"(tokN[0][0]), "+v"(tokN[0][1]), "+v"(tokN[1][0]), "+v"(tokN[1][1]));
                { PG8_RC(0, _R0, _C0); PG8_RC(1, _R1, _C1); (void)_R0; (void)_R1;
#pragma unroll
                for (int _h = 0; _h < 2; ++_h) { voN[_h][0] = (unsigned)(tokN[_h][0] * RB + _C0 * 2); voN[_h][1] = (unsigned)(tokN[_h][1] * RB + _C1 * 2); } } } else {
#pragma unroll
                for (int _h = 0; _h < 2; ++_h) { voN[_h][0] = voC[_h][0]; voN[_h][1] = voC[_h][1]; } } } }
            if constexpr (Epi::PF > 0) { if (last) { asm volatile("" : "+v"(epf[0]), "+v"(epf[1]));
#pragma unroll
                for (int _k = 0; _k < Epi::PF; ++_k) *(LAS unsigned*)(lds + MISC_OFF + M_EPF + (_k * 512 + tid) * 4) = epf[_k]; } }
            PG8_LDA(At, 0, 1); PG8_STAGE(PG8_SB(0, 0), b2, voffB); PG8_STAGE(PG8_SB(0, 1), b2 + hstep, voffB); PG8_STAGE_A(PG8_SA(0, 0), last, 0, k2);
            PG8_WAIT_V(8); PG8_WAIT_L(0); PG8_BAR; PG8_MMA(1, 0, At, B0); PG8_MMA(1, 1, At, B1); PG8_BAR; PG8_SCHED;
            PG8_LDB(B0, 1, 0); PG8_LDB(B1, 1, 1); PG8_SCHED; PG8_LDA(At, 1, 0); PG8_STAGE_A(PG8_SA(0, 1), last, 1, k2);
            PG8_WAIT_V(8); PG8_WAIT_L(0); PG8_BAR; PG8_MMA(0, 0, At, B0); PG8_MMA(0, 1, At, B1); PG8_BAR; PG8_SCHED;
            PG8_LDA(At, 1, 1); PG8_STAGE(PG8_SB(1, 0), b3, voffB); PG8_STAGE(PG8_SB(1, 1), b3 + hstep, voffB); PG8_STAGE_A(PG8_SA(1, 0), last, 0, k3);
            PG8_WAIT_V(8); PG8_WAIT_L(0); PG8_BAR; PG8_MMA(1, 0, At, B0); PG8_MMA(1, 1, At, B1); PG8_BAR; PG8_SCHED;
        }
        if (wr == 0) PG8_BAR;
        { const int ln_ = lane_id(); E(acc, cur, wr, wc, ln_ & 15, ln_ >> 4); }
        if constexpr (MK_EPI2 != 0) { if (Epi::PF == 2) { asm volatile("" ::: "memory"); const int ln_ = lane_id(); E(acc, cur, wr, wc, ln_ & 15, ln_ >> 4); } }
        if (!has_next) break;
#pragma unroll
        for (int a = 0; a < 2; ++a)
#pragma unroll
            for (int b = 0; b < 2; ++b)
#pragma unroll
                for (int m = 0; m < 4; ++m)
#pragma unroll
                    for (int n = 0; n < 2; ++n) acc[a][b][m][n] = (acc_t){0, 0, 0, 0};
        cur = nxt; cA = nA; cB = nB; ++ui;
        if constexpr (GATHER) {
#pragma unroll
            for (int _h = 0; _h < 2; ++_h) { voC[_h][0] = voN[_h][0]; voC[_h][1] = voN[_h][1]; } }
        if (wr == 1) PG8_BAR;
    }
    PG8_WAIT_V(0);
    PG8_BAR;
#undef PG8_SA
#undef PG8_SB
#undef PG8_STAGE
#undef PG8_STAGE_A
#undef PG8_LDA
#undef PG8_LDB
#undef PG8_MMA
#undef PG8_WAIT_V
#undef PG8_WAIT_L
#undef PG8_BAR
#undef PG8_SCHED
#undef PG8_GATH
#undef PG8_RC
}
}

namespace pg8 {
struct EpiBf16Plain {
    static constexpr bool PERM = true; static constexpr int PF = 0;
    bf16_t* O; int ldc; int qtiles; float qscale;
    __device__ __forceinline__ void operator()(const f32x4 (&acc)[2][2][4][2], const Unit& u, int wr, int wc, int fr, int fq) const {
        const int row0 = u.pm * BM + wr * 64 + fr, col0 = u.pn * BM + wc * 32 + 8 * fq;
        const float qs = u.pn < qtiles ? qscale : 1.0f;
#pragma unroll
        for (int ai = 0; ai < 2; ++ai)
#pragma unroll
            for (int m = 0; m < 4; ++m) { bf16_t* rowp = O + (size_t)(row0 + ai * HALF + m * 16) * ldc + col0;
#pragma unroll
                for (int bj = 0; bj < 2; ++bj) { const f32x4 v0 = acc[ai][bj][m][0] * qs, v1 = acc[ai][bj][m][1] * qs;
                    u32x4 w; w.x = cvt_pk_bf16(v0[0], v0[1]); w.y = cvt_pk_bf16(v0[2], v0[3]); w.z = cvt_pk_bf16(v1[0], v1[1]); w.w = cvt_pk_bf16(v1[2], v1[3]);
                    *(u32x4*)(rowp + bj * HALF) = w; } }
    }
};
struct EpiBf16Plain8 {
    static constexpr bool PERM = true; static constexpr int PF = 1;
    bf16_t* O; int ldc; int qtiles; float qscale; const float* sa; const float* sb; const LAS float* epf;
    __device__ __forceinline__ const float* pf_addr(const Unit& u, int tid, int) const { return tid < 256 ? sb + u.pn * BM + tid : sa + u.pm * BM + (tid - 256); }
    __device__ __forceinline__ void operator()(const i32x4 (&acc)[2][2][4][2], const Unit& u, int wr, int wc, int fr, int fq) const {
        const int row0 = u.pm * BM + wr * 64 + fr, col0 = u.pn * BM + wc * 32 + 8 * fq;
        const float qs = u.pn < qtiles ? qscale : 1.0f;
        f32x4 cs[2][2];
#pragma unroll
        for (int bj = 0; bj < 2; ++bj)
#pragma unroll
            for (int n = 0; n < 2; ++n) cs[bj][n] = *(const LAS f32x4*)(epf + wc * 32 + 8 * fq + bj * HALF + 4 * n) * qs;
#pragma unroll
        for (int ai = 0; ai < 2; ++ai)
#pragma unroll
            for (int m = 0; m < 4; ++m) { const int row = row0 + ai * HALF + m * 16; bf16_t* rowp = O + (size_t)row * ldc + col0; const float sr = epf[256 + wr * 64 + fr + ai * HALF + m * 16];
#pragma unroll
                for (int bj = 0; bj < 2; ++bj) { f32x4 v0, v1;
#pragma unroll
                    for (int j = 0; j < 4; ++j) { v0[j] = (float)acc[ai][bj][m][0][j]; v1[j] = (float)acc[ai][bj][m][1][j]; }
                    v0 = v0 * (cs[bj][0] * sr); v1 = v1 * (cs[bj][1] * sr);
                    u32x4 w; w.x = cvt_pk_bf16(v0[0], v0[1]); w.y = cvt_pk_bf16(v0[2], v0[3]); w.z = cvt_pk_bf16(v1[0], v1[1]); w.w = cvt_pk_bf16(v1[2], v1[3]);
                    *(u32x4*)(rowp + bj * HALF) = w; }
                asm volatile("" ::: "memory"); }
    }
};
struct EpiF32Plain {
    static constexpr bool PERM = false; static constexpr int PF = 0;
    float* C; int ldc;
    __device__ __forceinline__ void operator()(const f32x4 (&acc)[2][2][4][2], const Unit& u, int wr, int wc, int fr, int fq) const {
        const int row0 = u.pm * BM + wr * 64 + fr, col0 = u.pn * BM + wc * 32 + 4 * fq;
#pragma unroll
        for (int ai = 0; ai < 2; ++ai)
#pragma unroll
            for (int m = 0; m < 4; ++m) { float* rowp = C + (size_t)(row0 + ai * HALF + m * 16) * ldc + col0;
#pragma unroll
                for (int bj = 0; bj < 2; ++bj)
#pragma unroll
                    for (int n = 0; n < 2; ++n) *(f32x4*)(rowp + bj * HALF + n * 16) = acc[ai][bj][m][n]; }
    }
};
__device__ __forceinline__ void rope8(f32x4& v0, f32x4& v1, const float* cs) {
    const f32x4 a = *(const f32x4*)cs, b = *(const f32x4*)(cs + 4);
    const float x0 = v0[0], x1 = v0[1], x2 = v0[2], x3 = v0[3], y0 = v1[0], y1 = v1[1], y2 = v1[2], y3 = v1[3];
    v0[0] = x0 * a[0] - x1 * a[1]; v0[1] = x0 * a[1] + x1 * a[0];
    v0[2] = x2 * a[2] - x3 * a[3]; v0[3] = x2 * a[3] + x3 * a[2];
    v1[0] = y0 * b[0] - y1 * b[1]; v1[1] = y0 * b[1] + y1 * b[0];
    v1[2] = y2 * b[2] - y3 * b[3]; v1[3] = y2 * b[3] + y3 * b[2];
}
struct EpiQkvA {
    static constexpr bool PERM = true; static constexpr int PF = 0;
    bf16_t* O; const float* rope;
    __device__ __forceinline__ void operator()(const f32x4 (&acc)[2][2][4][2], const Unit& u, int wr, int wc, int fr, int fq) const {
        const int row0 = u.pm * BM + wr * 64 + fr, col0 = u.pn * BM + wc * 32 + 8 * fq;
        const bool do_rope = (u.pm < NL / 256) && (u.pn < 5);
        const float qs = u.pn < 4 ? 0.125f * LOG2E : 1.0f;
#pragma unroll
        for (int ai = 0; ai < 2; ++ai)
#pragma unroll
            for (int m = 0; m < 4; ++m) { const int row = row0 + ai * HALF + m * 16; bf16_t* rowp = O + (size_t)row * A_IN + col0;
#pragma unroll
                for (int bj = 0; bj < 2; ++bj) { f32x4 v0 = acc[ai][bj][m][0], v1 = acc[ai][bj][m][1];
                    if (do_rope) { const int d = (col0 + bj * HALF) & 63; rope8(v0, v1, rope + ((size_t)(row & (SEQ - 1)) * 32 + (d >> 1)) * 2); }
                    v0 = v0 * qs; v1 = v1 * qs;
                    u32x4 w; w.x = cvt_pk_bf16(v0[0], v0[1]); w.y = cvt_pk_bf16(v0[2], v0[3]); w.z = cvt_pk_bf16(v1[0], v1[1]); w.w = cvt_pk_bf16(v1[2], v1[3]);
                    *(u32x4*)(rowp + bj * HALF) = w; }
                asm volatile("" ::: "memory"); }
    }
};
struct EpiQkvA8 {
    static constexpr bool PERM = true; static constexpr int PF = 1;
    bf16_t* O; const float* rope; const float* sa; const float* sb; const LAS float* epf;
    __device__ __forceinline__ const float* pf_addr(const Unit& u, int tid, int) const { return tid < 256 ? sb + u.pn * BM + tid : sa + u.pm * BM + (tid - 256); }
    __device__ __forceinline__ void operator()(const i32x4 (&acc)[2][2][4][2], const Unit& u, int wr, int wc, int fr, int fq) const {
        const int row0 = u.pm * BM + wr * 64 + fr, col0 = u.pn * BM + wc * 32 + 8 * fq;
        const bool do_rope = (u.pm < NL / 256) && (u.pn < 5);
        const float qs = u.pn < 4 ? 0.125f * LOG2E : 1.0f;
        f32x4 cs[2][2];
#pragma unroll
        for (int bj = 0; bj < 2; ++bj)
#pragma unroll
            for (int n = 0; n < 2; ++n) cs[bj][n] = *(const LAS f32x4*)(epf + wc * 32 + 8 * fq + bj * HALF + 4 * n) * qs;
#pragma unroll
        for (int ai = 0; ai < 2; ++ai)
#pragma unroll
            for (int m = 0; m < 4; ++m) { const int row = row0 + ai * HALF + m * 16; bf16_t* rowp = O + (size_t)row * A_IN + col0; const float sr = epf[256 + wr * 64 + fr + ai * HALF + m * 16];
#pragma unroll
                for (int bj = 0; bj < 2; ++bj) { f32x4 v0, v1;
#pragma unroll
                    for (int j = 0; j < 4; ++j) { v0[j] = (float)acc[ai][bj][m][0][j]; v1[j] = (float)acc[ai][bj][m][1][j]; }
                    v0 = v0 * (cs[bj][0] * sr); v1 = v1 * (cs[bj][1] * sr);
                    if (do_rope) { const int d = (col0 + bj * HALF) & 63; rope8(v0, v1, rope + ((size_t)(row & (SEQ - 1)) * 32 + (d >> 1)) * 2); }
                    u32x4 w; w.x = cvt_pk_bf16(v0[0], v0[1]); w.y = cvt_pk_bf16(v0[2], v0[3]); w.z = cvt_pk_bf16(v1[0], v1[1]); w.w = cvt_pk_bf16(v1[2], v1[3]);
                    *(u32x4*)(rowp + bj * HALF) = w; }
                asm volatile("" ::: "memory"); }
    }
};
struct EpiMlaUp {
    static constexpr bool PERM = true; static constexpr int PF = 0;
    bf16_t* O; const float* rope;
    __device__ __forceinline__ void operator()(const f32x4 (&acc)[2][2][4][2], const Unit& u, int wr, int wc, int fr, int fq) const {
        const int row0 = u.pm * BM + wr * 64 + fr, col0 = u.pn * BM + wc * 32 + 8 * fq;
        const bool qtile = (u.pm < NL / 256) && (u.pn < 6);
        const float qs = u.pn < 6 ? 0.10206207261596575f * LOG2E : 1.0f;
#pragma unroll
        for (int ai = 0; ai < 2; ++ai)
#pragma unroll
            for (int m = 0; m < 4; ++m) { const int row = row0 + ai * HALF + m * 16; bf16_t* rowp = O + (size_t)row * C_UPN + col0;
#pragma unroll
                for (int bj = 0; bj < 2; ++bj) { f32x4 v0 = acc[ai][bj][m][0], v1 = acc[ai][bj][m][1];
                    const int d96 = (col0 + bj * HALF) % 96;
                    if (qtile && d96 >= 64) rope8(v0, v1, rope + ((size_t)(row & (SEQ - 1)) * 16 + ((d96 - 64) >> 1)) * 2);
                    v0 = v0 * qs; v1 = v1 * qs;
                    u32x4 w; w.x = cvt_pk_bf16(v0[0], v0[1]); w.y = cvt_pk_bf16(v0[2], v0[3]); w.z = cvt_pk_bf16(v1[0], v1[1]); w.w = cvt_pk_bf16(v1[2], v1[3]);
                    *(u32x4*)(rowp + bj * HALF) = w; }
                asm volatile("" ::: "memory"); }
    }
};
struct EpiResid {
    static constexpr bool PERM = false; static constexpr int PF = 1;
    const LAS float* epf;
    __device__ __forceinline__ const float* pf_addr(const Unit& u, int tid, int) const { return gmod + (size_t)(u.pm < NL / 256 ? (u.pm >> 3) : 8) * 6144 + u.pn * BM + (tid & 255); }
    bf16_t* XS; const float* gmod; bf16_t* XSo;
    __device__ __forceinline__ void operator()(const f32x4 (&acc)[2][2][4][2], const Unit& u, int wr, int wc, int fr, int fq) const {
        const int row0 = u.pm * BM + wr * 64 + fr, col0 = u.pn * BM + wc * 32 + 4 * fq;
        f32x4 gg[2][2];
#pragma unroll
        for (int bj = 0; bj < 2; ++bj)
#pragma unroll
            for (int n = 0; n < 2; ++n) gg[bj][n] = *(const LAS f32x4*)(epf + wc * 32 + 4 * fq + bj * HALF + n * 16);
#pragma unroll
        for (int ai = 0; ai < 2; ++ai)
#pragma unroll
            for (int m = 0; m < 4; ++m) { const size_t off = (size_t)(row0 + ai * HALF + m * 16) * D + col0;
#pragma unroll
                for (int bj = 0; bj < 2; ++bj)
#pragma unroll
                    for (int n = 0; n < 2; ++n) { const u32x2 w = *(const u32x2*)(XS + off + bj * HALF + n * 16);
                        const f32x4 v = (f32x4){bf_lo(w.x), bf_hi(w.x), bf_lo(w.y), bf_hi(w.y)} + gg[bj][n] * acc[ai][bj][m][n];
                        u32x2 o; o.x = cvt_pk_bf16(v[0], v[1]); o.y = cvt_pk_bf16(v[2], v[3]); *(u32x2*)(XSo + off + bj * HALF + n * 16) = o; } }
    }
};
struct EpiSwiglu {
    static constexpr bool PERM = true; static constexpr int PF = 0;
    bf16_t* ACT; const float* bg; const float* bu;
    __device__ __forceinline__ void operator()(const f32x4 (&acc)[2][2][4][2], const Unit& u, int wr, int wc, int fr, int fq) const {
        const int row0 = u.pm * BM + wr * 64 + fr, col0 = u.pn * HALF + wc * 32 + 8 * fq;
        const float* pg = bg + (size_t)u.e * D + col0; const float* pu = bu + (size_t)u.e * D + col0;
        const f32x4 g0 = *(const f32x4*)pg, g1 = *(const f32x4*)(pg + 4), u0 = *(const f32x4*)pu, u1 = *(const f32x4*)(pu + 4);
#pragma unroll
        for (int ai = 0; ai < 2; ++ai)
#pragma unroll
            for (int m = 0; m < 4; ++m) { bf16_t* rowp = ACT + (size_t)(row0 + ai * HALF + m * 16) * D + col0;
                float r[8];
#pragma unroll
                for (int n = 0; n < 2; ++n)
#pragma unroll
                    for (int j = 0; j < 4; ++j) {
                        float g = acc[ai][0][m][n][j] + (n ? g1[j] : g0[j]); float uu = acc[ai][1][m][n][j] + (n ? u1[j] : u0[j]);
                        g = fminf(g, 7.0f); uu = fminf(fmaxf(uu, -7.0f), 7.0f);
                        const float sg = __builtin_amdgcn_rcpf(1.0f + __builtin_amdgcn_exp2f(-1.702f * LOG2E * g));
                        r[n * 4 + j] = g * sg * (uu + 1.0f); }
                u32x4 w; w.x = cvt_pk_bf16(r[0], r[1]); w.y = cvt_pk_bf16(r[2], r[3]); w.z = cvt_pk_bf16(r[4], r[5]); w.w = cvt_pk_bf16(r[6], r[7]);
                *(u32x4*)rowp = w; }
    }
};
struct EpiSwiglu8 {
    static constexpr bool PERM = true; static constexpr int PF = 2;
    unsigned char* ACTQ; float* SBLK; const float* bg; const float* bu; const float* sal; const float* sbw; const LAS float* epf;
    __device__ __forceinline__ const float* pf_addr(const Unit& u, int tid, int k) const {
        if (k == 1) { const int t = tid & 255; return sal + (size_t)u.e * NT + ((u.mt * 256 + t) < u.cnt ? u.mt * 256 + t : u.mt * 256); }
        const int t = tid & 127;
        return tid < 128 ? bg + (size_t)u.e * D + u.pn * HALF + t : (tid < 256 ? bu + (size_t)u.e * D + u.pn * HALF + t : sbw + (size_t)u.e * 2048 + u.pn * BM + (tid < 384 ? 0 : HALF) + t); }
    __device__ __forceinline__ void operator()(const i32x4 (&acc)[2][2][4][2], const Unit& u, int wr, int wc, int fr, int fq) const {
        const int lr0 = wr * 64 + fr, row0 = u.pm * BM + lr0, col0 = u.pn * HALF + wc * 32 + 8 * fq;
        constexpr float K1 = 1.702f * LOG2E;
        f32x2 r[2][4][4];
#pragma unroll
        for (int n = 0; n < 2; ++n) {
            const LAS float* pe = epf + wc * 32 + 8 * fq + 4 * n;
            const f32x4 gb = *(const LAS f32x4*)pe * (-K1), ub = *(const LAS f32x4*)(pe + 128) + 1.0f, sg = *(const LAS f32x4*)(pe + 256) * (-K1), su = *(const LAS f32x4*)(pe + 384);
#pragma unroll
            for (int ai = 0; ai < 2; ++ai)
#pragma unroll
                for (int m = 0; m < 4; ++m) { const int lr = lr0 + ai * HALF + m * 16; const float sa_ = epf[512 + lr]; const f32x2 sa2 = {sa_, sa_};
#pragma unroll
                    for (int jp = 0; jp < 2; ++jp) {
                        const f32x2 ag = {(float)acc[ai][0][m][n][2 * jp], (float)acc[ai][0][m][n][2 * jp + 1]}, au = {(float)acc[ai][1][m][n][2 * jp], (float)acc[ai][1][m][n][2 * jp + 1]};
                        f32x2 h = (ag * (f32x2){sg[2 * jp], sg[2 * jp + 1]}) * sa2 + (f32x2){gb[2 * jp], gb[2 * jp + 1]};
                        f32x2 u1 = (au * (f32x2){su[2 * jp], su[2 * jp + 1]}) * sa2 + (f32x2){ub[2 * jp], ub[2 * jp + 1]};
                        h[0] = fmaxf(h[0], -7.0f * K1); h[1] = fmaxf(h[1], -7.0f * K1);
                        u1[0] = __builtin_amdgcn_fmed3f(u1[0], -6.0f, 8.0f); u1[1] = __builtin_amdgcn_fmed3f(u1[1], -6.0f, 8.0f);
                        const f32x2 e = {__builtin_amdgcn_exp2f(h[0]), __builtin_amdgcn_exp2f(h[1])};
                        const f32x2 d = e * (f32x2){-K1, -K1} + (f32x2){-K1, -K1};
                        const f32x2 rc = {__builtin_amdgcn_rcpf(d[0]), __builtin_amdgcn_rcpf(d[1])};
                        r[ai][m][2 * n + jp] = (h * u1) * rc; } }
        }
        float ams[8];
#pragma unroll
        for (int ai = 0; ai < 2; ++ai)
#pragma unroll
            for (int m = 0; m < 4; ++m) {
                float am = fmaxf(fmaxf(fmaxf(fabsf(r[ai][m][0][0]), fabsf(r[ai][m][0][1])), fmaxf(fabsf(r[ai][m][1][0]), fabsf(r[ai][m][1][1]))), fmaxf(fmaxf(fabsf(r[ai][m][2][0]), fabsf(r[ai][m][2][1])), fmaxf(fabsf(r[ai][m][3][0]), fabsf(r[ai][m][3][1]))));
                am = swap16_max(am); am = swap32_max(am); am = fmaxf(am, 1e-20f);
                const float inv = 127.0f * __builtin_amdgcn_rcpf(am); const f32x2 inv2 = {inv, inv}, mg = {12582912.0f + 128.0f, 12582912.0f + 128.0f};
                unsigned q[4];
#pragma unroll
                for (int k = 0; k < 4; ++k) { const f32x2 t = r[ai][m][k] * inv2 + mg; q[k] = __builtin_amdgcn_perm(__float_as_uint(t[1]), __float_as_uint(t[0]), 0x0c0c0400u); }
                u32x2 w; w.x = q[0] | (q[1] << 16); w.y = q[2] | (q[3] << 16);
                const size_t row = (size_t)(row0 + ai * HALF + m * 16);
                *(u32x2*)(ACTQ + row * D + col0) = w;
                ams[ai * 4 + m] = am * (1.0f / 127.0f); }
        if (fq == 0) {
#pragma unroll
            for (int i = 0; i < 8; ++i) SBLK[(size_t)(row0 + (i >> 2) * HALF + (i & 3) * 16) * 32 + u.pn * 4 + wc] = ams[i]; }
    }
};
struct EpiDown {
    static constexpr bool PERM = true; static constexpr int PF = 0;
    bf16_t* YS; const float* bd;
    __device__ __forceinline__ void operator()(const f32x4 (&acc)[2][2][4][2], const Unit& u, int wr, int wc, int fr, int fq) const {
        const int row0 = u.pm * BM + wr * 64 + fr, col0 = u.pn * BM + wc * 32 + 8 * fq;
        const float* pb = bd + (size_t)u.e * D + col0;
        f32x4 bv[2][2];
#pragma unroll
        for (int bj = 0; bj < 2; ++bj)
#pragma unroll
            for (int n = 0; n < 2; ++n) bv[bj][n] = *(const f32x4*)(pb + bj * HALF + 4 * n);
#pragma unroll
        for (int ai = 0; ai < 2; ++ai)
#pragma unroll
            for (int m = 0; m < 4; ++m) { bf16_t* rowp = YS + (size_t)(row0 + ai * HALF + m * 16) * D + col0;
#pragma unroll
                for (int bj = 0; bj < 2; ++bj) { const f32x4 v0 = acc[ai][bj][m][0] + bv[bj][0], v1 = acc[ai][bj][m][1] + bv[bj][1];
                    u32x4 w; w.x = cvt_pk_bf16(v0[0], v0[1]); w.y = cvt_pk_bf16(v0[2], v0[3]); w.z = cvt_pk_bf16(v1[0], v1[1]); w.w = cvt_pk_bf16(v1[2], v1[3]);
                    *(u32x4*)(rowp + bj * HALF) = w; } }
    }
};

struct EpiDown8 {
    static constexpr bool PERM = true; static constexpr int PF = 2;
    unsigned char* YSQ; float* YSB; const float* bd; const float* saq; const float* sbd; const LAS float* epf;
    __device__ __forceinline__ const float* pf_addr(const Unit& u, int tid, int k) const {
        if (k == 1) return saq + (size_t)u.pm * BM + (tid & 255);
        return (tid < 256 ? bd : sbd) + (size_t)u.e * D + u.pn * BM + (tid & 255); }
    __device__ __forceinline__ void operator()(const i32x4 (&acc)[2][2][4][2], const Unit& u, int wr, int wc, int fr, int fq) const {
        const int row0 = u.pm * BM + wr * 64 + fr, col0 = u.pn * BM + wc * 32 + 8 * fq;
#pragma unroll
        for (int bj = 0; bj < 2; ++bj) {
            const LAS float* pe = epf + wc * 32 + 8 * fq + bj * HALF;
            const f32x4 b0 = *(const LAS f32x4*)pe, b1 = *(const LAS f32x4*)(pe + 4), s0 = *(const LAS f32x4*)(pe + 256), s1 = *(const LAS f32x4*)(pe + 260);
            float ams[8];
#pragma unroll
            for (int ai = 0; ai < 2; ++ai)
#pragma unroll
                for (int m = 0; m < 4; ++m) { const int row = row0 + ai * HALF + m * 16; const float sr = epf[512 + wr * 64 + fr + ai * HALF + m * 16]; f32x4 v0, v1;
#pragma unroll
                    for (int j = 0; j < 4; ++j) { v0[j] = (float)acc[ai][bj][m][0][j]; v1[j] = (float)acc[ai][bj][m][1][j]; }
                    v0 = v0 * (s0 * sr) + b0; v1 = v1 * (s1 * sr) + b1;
                    float am = fmaxf(fmaxf(fmaxf(fabsf(v0[0]), fabsf(v0[1])), fmaxf(fabsf(v0[2]), fabsf(v0[3]))), fmaxf(fmaxf(fabsf(v1[0]), fabsf(v1[1])), fmaxf(fabsf(v1[2]), fabsf(v1[3]))));
                    am = swap16_max(am); am = swap32_max(am); am = fmaxf(am, 1e-30f);
                    const float inv = 127.0f * __builtin_amdgcn_rcpf(am); const f32x2 inv2 = {inv, inv}, mg = {12582912.0f + 128.0f, 12582912.0f + 128.0f};
                    const f32x2 t0 = (f32x2){v0[0], v0[1]} * inv2 + mg, t1 = (f32x2){v0[2], v0[3]} * inv2 + mg, t2 = (f32x2){v1[0], v1[1]} * inv2 + mg, t3 = (f32x2){v1[2], v1[3]} * inv2 + mg;
                    u32x2 w;
                    w.x = __builtin_amdgcn_perm(__float_as_uint(t0[1]), __float_as_uint(t0[0]), 0x0c0c0400u) | (__builtin_amdgcn_perm(__float_as_uint(t1[1]), __float_as_uint(t1[0]), 0x0c0c0400u) << 16);
                    w.y = __builtin_amdgcn_perm(__float_as_uint(t2[1]), __float_as_uint(t2[0]), 0x0c0c0400u) | (__builtin_amdgcn_perm(__float_as_uint(t3[1]), __float_as_uint(t3[0]), 0x0c0c0400u) << 16);
                    *(u32x2*)(YSQ + (size_t)row * D + col0 + bj * HALF) = w;
                    ams[ai * 4 + m] = am * (1.0f / 127.0f); }
            if (fq == 0) {
#pragma unroll
                for (int i = 0; i < 8; ++i) YSB[(size_t)(row0 + (i >> 2) * HALF + (i & 3) * 16) * 32 + u.pn * 8 + bj * 4 + wc] = ams[i]; }
            asm volatile("" ::: "memory");
        }
    }
};
struct DenseOrder {
    int nM, nN, vcu, xM, xN0, xNn;
    __device__ __forceinline__ bool short_one() const { const int U = nM * nN + xM * xNn, R = (U + 255) >> 8; return (U & 255) != 0 && vcu >= U - (R - 1) * 256; }
    __device__ __forceinline__ bool next(int i, Unit& u) const {
        int L = i * 256 + vcu; const int nmain = nM * nN;
        if (L < nmain) { const int nig = 8 * nN, gid = L / nig, fm = gid * 8, rem = nM - fm, gsz = rem < 8 ? rem : 8, w = L % nig; u.pm = fm + w % gsz; u.pn = w / gsz; }
        else { L -= nmain; if (L >= xM * xNn) return false; u.pm = nM + L % xM; u.pn = xN0 + L / xM; }
        u.e = 0; u.mt = 0; u.cnt = 0; return true;
    }
};
struct MoeOrder {
    const LAS int* ecnt; const LAS int* lbase; const LAS int* cumt; int nN, idx, G; LAS int* ul;
    __device__ __forceinline__ bool short_one() const { const int U = cumt[32] * nN, R = (U + G - 1) / G; return (U % G) != 0 && idx >= U - (R - 1) * G; }
    __device__ __forceinline__ void build(int tid) const {
        if (tid < 16) { const int L = tid * G + idx; int e = -1, pn = 0, mt = 0, pm = 0, c = 0;
            if (idx >= 0 && L < cumt[32] * nN) { e = 0; while (cumt[e + 1] * nN <= L) ++e; const int r = L - cumt[e] * nN; c = ecnt[e]; const int mte = (c + 255) >> 8;
                if (MK_MT_MAJOR & (nN == 4 ? 1 : 2)) { pn = r % nN; mt = r / nN; } else { pn = r / mte; mt = r % mte; } pm = (lbase[e] >> 8) + mt; }
            ul[tid * 8 + 0] = e; ul[tid * 8 + 1] = pn; ul[tid * 8 + 2] = mt; ul[tid * 8 + 3] = pm; ul[tid * 8 + 4] = c; }
        __syncthreads();
    }
    __device__ __forceinline__ bool next(int i, Unit& u) const {
        if (i >= 16) return false;
        const int e = __builtin_amdgcn_readfirstlane(ul[i * 8 + 0]);
        if (e < 0) return false;
        u.e = e; u.pn = __builtin_amdgcn_readfirstlane(ul[i * 8 + 1]); u.mt = __builtin_amdgcn_readfirstlane(ul[i * 8 + 2]); u.pm = __builtin_amdgcn_readfirstlane(ul[i * 8 + 3]); u.cnt = __builtin_amdgcn_readfirstlane(ul[i * 8 + 4]); return true;
    }
};
}

namespace att {
constexpr int VSTR = 144;
template <int DQK> struct Cfg { static constexpr int KSTR = DQK * 2 + 16, KB = 64 * KSTR, VB = 64 * VSTR, STAGE = KB + VB, CPR = DQK / 8, NKS = DQK / 16; };
__device__ __forceinline__ int crow(int r, int hi) { return (r & 3) + 8 * (r >> 2) + 4 * hi; }

template <int DQK, bool MLA>
__device__ __forceinline__ void fetchK(u32x4 (&r)[2], const bf16_t* Kb, const bf16_t* KRb, int pitch, int row0, int tid) {
    typedef Cfg<DQK> C;
    { const int key = tid / C::CPR, ch = tid % C::CPR;
      const bf16_t* src = (MLA && ch >= 8) ? KRb + (size_t)(row0 + key) * 32 + (ch - 8) * 8 : Kb + (size_t)(row0 + key) * pitch + ch * 8;
      r[0] = *(const u32x4*)src; }
    if constexpr (DQK == 96) { if (tid < 256) { const int c = 512 + tid, key = c / C::CPR, ch = c % C::CPR;
      const bf16_t* src = (MLA && ch >= 8) ? KRb + (size_t)(row0 + key) * 32 + (ch - 8) * 8 : Kb + (size_t)(row0 + key) * pitch + ch * 8;
      r[1] = *(const u32x4*)src; } }
}
__device__ __forceinline__ void fetchV(u32x4& r, const bf16_t* Vb, int pitch, int row0, int tid) { const int key = tid >> 3, ch = tid & 7; r = *(const u32x4*)(Vb + (size_t)(row0 + key) * pitch + ch * 8); }
template <int DQK>
__device__ __forceinline__ void stashK(LAS unsigned char* kst, const u32x4 (&r)[2], int tid) {
    typedef Cfg<DQK> C;
    { const int key = tid / C::CPR, ch = tid % C::CPR; *(LAS u32x4*)(kst + key * C::KSTR + ch * 16) = r[0]; }
    if constexpr (DQK == 96) { if (tid < 256) { const int c = 512 + tid, key = c / C::CPR, ch = c % C::CPR; *(LAS u32x4*)(kst + key * C::KSTR + ch * 16) = r[1]; } }
}
__device__ __forceinline__ void stashV(LAS unsigned char* vst, const u32x4& r, int tid) { const int key = tid >> 3, ch = tid & 7; *(LAS u32x4*)(vst + key * VSTR + ch * 16) = r; }
template <int DQK, bool MLA>
__device__ __forceinline__ void fetch(u32x4 (&r)[3], const bf16_t* Kb, const bf16_t* Vb, const bf16_t* KRb, int pitch, int row0, int tid) {
    u32x4 k2[2]; k2[1] = (u32x4){0u, 0u, 0u, 0u}; fetchK<DQK, MLA>(k2, Kb, KRb, pitch, row0, tid); r[0] = k2[0]; r[1] = k2[1]; fetchV(r[2], Vb, pitch, row0, tid);
}
template <int DQK>
__device__ __forceinline__ void stash(LAS unsigned char* st, const u32x4 (&r)[3], int tid) {
    const u32x4 k2[2] = {r[0], r[1]}; stashK<DQK>(st, k2, tid); stashV(st + Cfg<DQK>::KB, r[2], tid);
}
template <int DQK>
__device__ __forceinline__ f32x16 qk(const LAS unsigned char* kst, int koff, const bf16x8 (&qr)[DQK / 16], int r32, int hi) {
    typedef Cfg<DQK> C;
    f32x16 p;
#pragma unroll
    for (int r = 0; r < 16; ++r) p[r] = 0.f;
    const LAS unsigned char* kb = kst + (koff + r32) * C::KSTR + hi * 16;
#pragma unroll
    for (int ks = 0; ks < C::NKS; ++ks) { const bf16x8 kf = *(const LAS bf16x8*)(kb + ks * 32); p = __builtin_amdgcn_mfma_f32_32x32x16_bf16(kf, qr[ks], p, 0, 0, 0); }
    return p;
}
__device__ __forceinline__ s16x4 vtr(const LAS unsigned char* p) { return __builtin_bit_cast(s16x4, __builtin_amdgcn_ds_read_tr16_b64_v4i16((LAS s16x4*)p)); }
typedef __bf16 bf16x2_t __attribute__((ext_vector_type(2)));
__device__ __forceinline__ unsigned cvtpk_s(float lo, float hi) { const f32x2 v = {lo, hi}; const bf16x2_t b = __builtin_convertvector(v, bf16x2_t); return __builtin_bit_cast(unsigned, b); }
template <int NS>
__device__ __forceinline__ void sm_max(const f32x16 (&t)[NS], const float sc, f32x16 (&o)[2], float& m, float& l) {
    float mx = t[0][0];
#pragma unroll
    for (int s = 0; s < NS; ++s)
#pragma unroll
        for (int r = 0; r < 16; ++r) mx = fmaxf(mx, t[s][r]);
    mx = swap32_max(mx) * sc;
    if (__any(mx > m + 8.0f)) { const float mn = fmaxf(m, mx); const float a = __builtin_amdgcn_exp2f(m - mn); m = mn; l *= a;
#pragma unroll
        for (int r = 0; r < 16; ++r) { o[0][r] *= a; o[1][r] *= a; } }
}
template <int NS>
__device__ __forceinline__ void sm_exp_pv(f32x16 (&t)[NS], const float sc, const LAS unsigned char* vst, const int (&voff)[NS], f32x16 (&o)[2], const float m, float& l, int lane) {
    const int hi = lane >> 5;
    float rs = 0.f;
#pragma unroll
    for (int s = 0; s < NS; ++s)
#pragma unroll
        for (int r = 0; r < 16; ++r) { t[s][r] = __builtin_amdgcn_exp2f(__builtin_fmaf(t[s][r], sc, -m)); rs += t[s][r]; }
    l += rs;
    const int q4 = (lane & 15) >> 2, p4 = lane & 3, blk = (lane >> 4) & 1;
#pragma unroll
    for (int s = 0; s < NS; ++s) {
        const LAS unsigned char* vb = vst + (voff[s] + 4 * hi + q4) * VSTR + (16 * blk + 4 * p4) * 2;
#pragma unroll
        for (int kk = 0; kk < 2; ++kk) {
            u32x4 pw; pw.x = cvtpk_s(t[s][8 * kk + 0], t[s][8 * kk + 1]); pw.y = cvtpk_s(t[s][8 * kk + 2], t[s][8 * kk + 3]);
            pw.z = cvtpk_s(t[s][8 * kk + 4], t[s][8 * kk + 5]); pw.w = cvtpk_s(t[s][8 * kk + 6], t[s][8 * kk + 7]);
            const bf16x8 pb = __builtin_bit_cast(bf16x8, pw);
#pragma unroll
            for (int c = 0; c < 2; ++c) {
                const s16x4 lo = vtr(vb + (16 * kk) * VSTR + c * 64), h8 = vtr(vb + (16 * kk + 8) * VSTR + c * 64);
                const bf16x8 va = (bf16x8){lo[0], lo[1], lo[2], lo[3], h8[0], h8[1], h8[2], h8[3]};
                o[c] = __builtin_amdgcn_mfma_f32_32x32x16_bf16(va, pb, o[c], 0, 0, 0);
            }
        }
    }
}
template <int NS>
__device__ __forceinline__ void sm_pv(f32x16 (&t)[NS], const float sc, const LAS unsigned char* vst, const int (&voff)[NS], f32x16 (&o)[2], float& m, float& l, int lane) {
    sm_max<NS>(t, sc, o, m, l); sm_exp_pv<NS>(t, sc, vst, voff, o, m, l, lane);
}
template <int DQK>
__device__ __forceinline__ f32x16 qkn(const LAS unsigned char* kst, int koff, const bf16x8 (&qr)[DQK / 16], const float negm, int r32, int hi) {
    typedef Cfg<DQK> C;
    f32x16 p;
#pragma unroll
    for (int r = 0; r < 16; ++r) p[r] = negm;
    const LAS unsigned char* kb0 = kst + (koff + r32) * C::KSTR + hi * 16;
    bf16x8 kf[C::NKS];
#pragma unroll
    for (int ks = 0; ks < C::NKS; ++ks) kf[ks] = *(const LAS bf16x8*)(kb0 + ks * 32);
    __builtin_amdgcn_sched_barrier(0);
#pragma unroll
    for (int ks = 0; ks < C::NKS; ++ks) p = __builtin_amdgcn_mfma_f32_32x32x16_bf16(kf[ks], qr[ks], p, 0, 0, 0);
    return p;
}
template <int DQK>
__device__ __forceinline__ f32x16 qkn_old(const LAS unsigned char* kst, int koff, const bf16x8 (&qr)[DQK / 16], const f32x16& negm, int r32, int hi) {
    typedef Cfg<DQK> C;
    f32x16 p = negm;
    const LAS unsigned char* kb = kst + (koff + r32) * C::KSTR + hi * 16;
#pragma unroll
    for (int ks = 0; ks < C::NKS; ++ks) { const bf16x8 kf = *(const LAS bf16x8*)(kb + ks * 32); p = __builtin_amdgcn_mfma_f32_32x32x16_bf16(kf, qr[ks], p, 0, 0, 0); }
    return p;
}
__device__ __forceinline__ void sm_max_n(f32x16 (&t)[2], f32x16 (&o)[2], f32x16& osum, float& m, float& negm, bool first) {
    float a0 = fmaxf(fmaxf(t[0][0], t[0][1]), t[0][2]), a1 = fmaxf(fmaxf(t[1][0], t[1][1]), t[1][2]);
#pragma unroll
    for (int r = 3; r < 15; r += 2) { a0 = fmaxf(fmaxf(a0, t[0][r]), t[0][r + 1]); a1 = fmaxf(fmaxf(a1, t[1][r]), t[1][r + 1]); }
    float mx = fmaxf(fmaxf(a0, a1), fmaxf(t[0][15], t[1][15]));
    mx = swap32_max(mx);
    if (first || __any(mx > 8.0f)) { const float d = first ? mx : fmaxf(mx, 0.f); const float a = first ? 1.0f : __builtin_amdgcn_exp2f(-d); m += d;
#pragma unroll
        for (int r = 0; r < 16; ++r) { t[0][r] -= d; t[1][r] -= d; o[0][r] *= a; o[1][r] *= a; osum[r] *= a; } negm = -m; }
}
__device__ __forceinline__ void sm_exp_pv_n(f32x16 (&t)[2], const LAS unsigned char* vst, f32x16 (&o)[2], f32x16& osum, int lane) {
    const int hi = lane >> 5, q4 = (lane & 15) >> 2, p4 = lane & 3, blk = (lane >> 4) & 1;
    const LAS unsigned char* vb = vst + (4 * hi + q4) * VSTR + (16 * blk + 4 * p4) * 2;
    const bf16x8 ones = (bf16x8){0x3F80, 0x3F80, 0x3F80, 0x3F80, 0x3F80, 0x3F80, 0x3F80, 0x3F80};
#pragma unroll
    for (int s = 0; s < 2; ++s) {
        bf16x8 va[2][2];
#pragma unroll
        for (int kk = 0; kk < 2; ++kk)
#pragma unroll
            for (int c = 0; c < 2; ++c) { const s16x4 lo = vtr(vb + (32 * s + 16 * kk) * VSTR + c * 64), h8 = vtr(vb + (32 * s + 16 * kk + 8) * VSTR + c * 64);
                va[kk][c] = (bf16x8){lo[0], lo[1], lo[2], lo[3], h8[0], h8[1], h8[2], h8[3]}; }
        __builtin_amdgcn_sched_barrier(0);
#pragma unroll
        for (int kk = 0; kk < 2; ++kk) {
            float e[8];
#pragma unroll
            for (int j = 0; j < 8; ++j) e[j] = __builtin_amdgcn_exp2f(t[s][8 * kk + j]);
            u32x4 pw; pw.x = cvtpk_s(e[0], e[1]); pw.y = cvtpk_s(e[2], e[3]); pw.z = cvtpk_s(e[4], e[5]); pw.w = cvtpk_s(e[6], e[7]);
            const bf16x8 pb = __builtin_bit_cast(bf16x8, pw);
            o[0] = __builtin_amdgcn_mfma_f32_32x32x16_bf16(va[kk][0], pb, o[0], 0, 0, 0);
            o[1] = __builtin_amdgcn_mfma_f32_32x32x16_bf16(va[kk][1], pb, o[1], 0, 0, 0);
            if (MK_OSUM_MFMA) osum = __builtin_amdgcn_mfma_f32_32x32x16_bf16(ones, pb, osum, 0, 0, 0);
            else { const f32x2 rs = ((f32x2){e[0], e[1]} + (f32x2){e[2], e[3]}) + ((f32x2){e[4], e[5]} + (f32x2){e[6], e[7]}); osum[0] += rs[0] + rs[1]; }
        }
    }
}
__device__ __forceinline__ void finalize_n_rows(const f32x16 (&o)[2], const f32x16& osum, bf16_t* obase, LAS unsigned char* st, int lane) {
    const int r32 = lane & 31, hi = lane >> 5;
    const float inv = 1.0f / (MK_OSUM_MFMA ? osum[0] : swap32_sum(osum[0]));
#pragma unroll
    for (int c = 0; c < 2; ++c)
#pragma unroll
        for (int g = 0; g < 4; ++g) { u32x2 w; w.x = cvt_pk_bf16(o[c][4 * g] * inv, o[c][4 * g + 1] * inv); w.y = cvt_pk_bf16(o[c][4 * g + 2] * inv, o[c][4 * g + 3] * inv);
            *(LAS u32x2*)(st + r32 * 144 + (32 * c + 8 * g + 4 * hi) * 2) = w; }
    asm volatile("s_waitcnt lgkmcnt(0)" ::: "memory");
#pragma unroll
    for (int k = 0; k < 4; ++k) { const int row = 8 * k + (lane >> 3), ch = lane & 7;
        const u32x4 w = *(const LAS u32x4*)(st + row * 144 + ch * 16);
        *(u32x4*)(obase + (size_t)row * D + ch * 8) = w; }
}
__device__ __forceinline__ void finalize_n(const f32x16 (&o)[2], const f32x16& osum, bf16_t* orow, int hi) {
    const float inv = 1.0f / (MK_OSUM_MFMA ? osum[0] : swap32_sum(osum[0]));
#pragma unroll
    for (int c = 0; c < 2; ++c)
#pragma unroll
        for (int g = 0; g < 4; ++g) { u32x2 w; w.x = cvt_pk_bf16(o[c][4 * g] * inv, o[c][4 * g + 1] * inv); w.y = cvt_pk_bf16(o[c][4 * g + 2] * inv, o[c][4 * g + 3] * inv);
            *(u32x2*)(orow + 32 * c + 8 * g + 4 * hi) = w; }
}
__device__ __forceinline__ void finalize(const f32x16 (&o)[2], float l, bf16_t* orow, int hi) {
    l = swap32_sum(l); const float inv = 1.0f / l;
#pragma unroll
    for (int c = 0; c < 2; ++c)
#pragma unroll
        for (int g = 0; g < 4; ++g) { u32x2 w; w.x = cvt_pk_bf16(o[c][4 * g] * inv, o[c][4 * g + 1] * inv); w.y = cvt_pk_bf16(o[c][4 * g + 2] * inv, o[c][4 * g + 3] * inv);
            *(u32x2*)(orow + 32 * c + 8 * g + 4 * hi) = w; }
}
#define ATT_PIPE_BEGIN(DQK, MLA, ROW0_OF) \
    u32x4 pre[3]; pre[1] = (u32x4){0u, 0u, 0u, 0u}; \
    fetch<DQK, MLA>(pre, Kb, Vb, KRb, pitch, ROW0_OF(0), tid); stash<DQK>(lds, pre, tid); __syncthreads(); \
    for (int i = 0; i < ntiles; ++i) { \
        if (i + 1 < ntiles) fetch<DQK, MLA>(pre, Kb, Vb, KRb, pitch, ROW0_OF(i + 1), tid); \
        const LAS unsigned char* kst = lds + (i & 1) * Cfg<DQK>::STAGE; const LAS unsigned char* vst = kst + Cfg<DQK>::KB;
#define ATT_PIPE_END(DQK) \
        if (i + 1 < ntiles) stash<DQK>(lds + ((i + 1) & 1) * Cfg<DQK>::STAGE, pre, tid); \
        __syncthreads(); }

#define ATT2_RUN(DQK, MLA, ROW0_OF, QK2, FIRST, STAG) \
    { typedef Cfg<DQK> C_; LAS unsigned char* const kb_ = lds; LAS unsigned char* const vb_ = lds + 2 * C_::KB; \
    u32x4 pk_[2], pv_; pk_[1] = (u32x4){0u, 0u, 0u, 0u}; \
    fetchK<DQK, MLA>(pk_, Kb, KRb, pitch, ROW0_OF(0), tid); fetchV(pv_, Vb, pitch, ROW0_OF(0), tid); stashK<DQK>(kb_, pk_, tid); stashV(vb_, pv_, tid); \
    if (ntiles > 1) { fetchK<DQK, MLA>(pk_, Kb, KRb, pitch, ROW0_OF(1), tid); stashK<DQK>(kb_ + C_::KB, pk_, tid); } \
    __syncthreads(); \
    f32x16 t[2]; QK2(t, kb_, 0); \
    sm_max_n(t, o, osum, m, negm, (FIRST)); \
    __syncthreads();     \
    for (int i = 0; i + 1 < ntiles; ++i) { \
        if (i + 2 < ntiles) fetchK<DQK, MLA>(pk_, Kb, KRb, pitch, ROW0_OF(i + 2), tid); \
        fetchV(pv_, Vb, pitch, ROW0_OF(i + 1), tid); \
        f32x16 tn[2]; \
        if (!(STAG) || wid < 4) { QK2(tn, kb_ + ((i + 1) & 1) * C_::KB, i + 1); }     \
        sm_exp_pv_n(t, vb_ + (i & 1) * C_::VB, o, osum, lane); \
        if ((STAG) && wid >= 4) { QK2(tn, kb_ + ((i + 1) & 1) * C_::KB, i + 1); }     \
        t[0] = tn[0]; t[1] = tn[1]; \
        sm_max_n(t, o, osum, m, negm, false);                                 \
        if (i + 2 < ntiles) stashK<DQK>(kb_ + (i & 1) * C_::KB, pk_, tid); \
        stashV(vb_ + ((i + 1) & 1) * C_::VB, pv_, tid); \
        __syncthreads(); } \
    sm_exp_pv_n(t, vb_ + ((ntiles - 1) & 1) * C_::VB, o, osum, lane); \
    __syncthreads(); }

__device__ __forceinline__ void attn_A_unit(LAS unsigned char* lds, const bf16_t* QKV, bf16_t* O, const float* sink, int b, int kvh, int qb, bool ctxq, int tid) {
    const int lane = tid & 63, wid = __builtin_amdgcn_readfirstlane(tid >> 6), r32 = lane & 31, hi = lane >> 5;
    const int head = kvh * 4 + (wid >> 1), qoff = 32 * (wid & 1) + r32, t0 = qb * 64;
    const int qrow = ctxq ? NL + b * CTXL + t0 + qoff : b * SEQ + t0 + qoff;
    bf16x8 qr[4];
    { const bf16_t* qp = QKV + (size_t)qrow * A_IN + head * 64 + hi * 8;
#pragma unroll
      for (int ks = 0; ks < 4; ++ks) qr[ks] = *(const bf16x8*)(qp + ks * 16); }
    int jlo = 0, nloc = 0;
    if (!ctxq) { jlo = t0 >= 128 ? 0 : (t0 == 64 ? 1 : 2); int jhi = (2112 - t0) / 64; jhi = jhi > 4 ? 4 : jhi; nloc = jhi - jlo + 1; }
    const int ntiles = 4 + nloc, cbase = NL + b * CTXL, lbase = b * SEQ + t0 - 128 + 64 * jlo;
    const bf16_t* Kb = QKV + 1024 + kvh * 64; const bf16_t* Vb = QKV + 1280 + kvh * 64; const bf16_t* KRb = nullptr; const int pitch = A_IN;
    float m = sink[head] * LOG2E;
    f32x16 o[2], osum; float negm = -m;
#pragma unroll
    for (int r = 0; r < 16; ++r) { o[0][r] = 0.f; o[1][r] = 0.f; osum[r] = MK_OSUM_MFMA ? 1.0f : 0.5f; }
#define A_ROW0(i) ((i) < 4 ? cbase + 64 * (i) : lbase + 64 * ((i) - 4))
#define A_QK2(dst, kst, ti) { dst[0] = qkn<64>(kst, 0, qr, negm, r32, hi); dst[1] = qkn<64>(kst, 32, qr, negm, r32, hi); const int j_ = (ti) < 4 ? 2 : jlo + (ti) - 4; \
        if (j_ == 0 || j_ == 4) { _Pragma("unroll") for (int s = 0; s < 2; ++s) _Pragma("unroll") for (int r = 0; r < 16; ++r) { const int kk = 32 * s + crow(r, hi); \
            if (j_ == 0 ? (kk < qoff) : (kk > qoff)) dst[s][r] = -1e30f; } } }
    ATT2_RUN(64, false, A_ROW0, A_QK2, false, (MK_ATT_STAGGER & 1))
#undef A_QK2
#undef A_ROW0
    if (MK_O_ROWS) finalize_n_rows(o, osum, O + (size_t)(qrow - r32) * D + head * 64, lds + 65536 + wid * 4608, lane); else finalize_n(o, osum, O + (size_t)qrow * D + head * 64, hi);
}

__device__ __forceinline__ void attn_B_unit(LAS unsigned char* lds, LAS float* tab, const bf16_t* QKV, bf16_t* O, const float* rpb, int b, int h, int rq, bool ctxq, int tid) {
    const int lane = tid & 63, wid = __builtin_amdgcn_readfirstlane(tid >> 6), r32 = lane & 31, hi = lane >> 5;
    const int jb = wid & 3, rp = wid >> 2;
    const int rqa = 4 * rq + 2 * rp + (r32 >> 4), qcol = 16 * jb + (r32 & 15);
    const int qrow = ctxq ? NL + b * CTXL + 32 * wid + r32 : b * SEQ + rqa * 64 + qcol;
    for (int idx = tid; idx < 15 * 31; idx += 512) tab[(idx / 31) * 32 + idx % 31] = rpb[h * 465 + idx] * LOG2E;
    bf16x8 qr[4];
    { const bf16_t* qp = QKV + (size_t)qrow * B_IN + h * 64 + hi * 8;
#pragma unroll
      for (int ks = 0; ks < 4; ++ks) qr[ks] = *(const bf16x8*)(qp + ks * 16); }
    int klo = 0, nloc = 0;
    if (!ctxq) { klo = 4 * rq - 4; klo = klo < 0 ? 0 : (klo > 24 ? 24 : klo); int khi = 4 * rq - 1; khi = khi < 0 ? 0 : (khi > 24 ? 24 : khi); khi += 7; nloc = khi - klo + 1; }
    const int ntiles = 4 + nloc, cbase = NL + b * CTXL, lbase = b * SEQ;
    int r0q = rqa - 4; r0q = r0q < 0 ? 0 : (r0q > 24 ? 24 : r0q);
    int wst = qcol - 8; wst = wst < 0 ? 0 : (wst > 48 ? 48 : wst);
    int cst = 16 * jb - 8; cst = cst < 0 ? 0 : (cst > 32 ? 32 : cst);
    const int lo = wst - cst;
    int wr0 = 4 * rq + 2 * rp - 4; wr0 = wr0 < 0 ? 0 : (wr0 > 24 ? 24 : wr0);
    int wr1 = 4 * rq + 2 * rp + 1 - 4; wr1 = wr1 < 0 ? 0 : (wr1 > 24 ? 24 : wr1); wr1 += 7;
    const bf16_t* Kb = QKV + 1024 + h * 64; const bf16_t* Vb = QKV + 2048 + h * 64; const bf16_t* KRb = nullptr; const int pitch = B_IN;
    float m = -1e30f, l = 0.f;
    f32x16 o[2];
#pragma unroll
    for (int r = 0; r < 16; ++r) { o[0][r] = 0.f; o[1][r] = 0.f; }
    const float sc = 0.125f * LOG2E;
#define B_ROW0(i) ((i) < 4 ? cbase + 64 * (i) : lbase + 64 * (klo + (i) - 4))
    ATT_PIPE_BEGIN(64, false, B_ROW0)
        if (i < 4) {
            f32x16 t[2];
            t[0] = qk<64>(kst, 0, qr, r32, hi); t[1] = qk<64>(kst, 32, qr, r32, hi);
#pragma unroll
            for (int s = 0; s < 2; ++s)
#pragma unroll
                for (int r = 0; r < 16; ++r) t[s][r] *= 1.0f;
            const int voff[2] = {0, 32};
            sm_pv<2>(t, 1.0f, vst, voff, o, m, l, lane);
        } else {
            const int kr = klo + i - 4;
            if (kr >= wr0 && kr <= wr1) {
                f32x16 t[1];
                t[0] = qk<64>(kst, cst, qr, r32, hi);
                const bool rowok = (kr >= r0q) && (kr < r0q + 8);
                const int bidx0 = (kr - rqa + 7) * 32 + cst - qcol + 15;
#pragma unroll
                for (int r = 0; r < 16; ++r) { const int kidx = crow(r, hi); const bool ok = rowok && ((unsigned)(kidx - lo) < 16u);
                    int bi = bidx0 + kidx; bi = bi < 0 ? 0 : (bi > 479 ? 479 : bi);
                    const float bias = tab[bi];
                    t[0][r] = ok ? t[0][r] + bias : -1e30f; }
                const int voff[1] = {cst};
                sm_pv<1>(t, 1.0f, vst, voff, o, m, l, lane);
            }
        }
    ATT_PIPE_END(64)
#undef B_ROW0
    finalize(o, l, O + (size_t)qrow * D + h * 64, hi);
}

__device__ __forceinline__ void attn_C_unit(LAS unsigned char* lds, const bf16_t* Q2, const bf16_t* KR, bf16_t* O, int b, int h, int qb, bool ctxq, int tid) {
    const int lane = tid & 63, wid = __builtin_amdgcn_readfirstlane(tid >> 6), r32 = lane & 31, hi = lane >> 5;
    const int qrow = ctxq ? NL + b * CTXL + 32 * wid + r32 : b * SEQ + qb * 256 + 32 * wid + r32;
    bf16x8 qr[6];
    { const bf16_t* qp = Q2 + (size_t)qrow * C_UPN + h * 96 + hi * 8;
#pragma unroll
      for (int ks = 0; ks < 6; ++ks) qr[ks] = *(const bf16x8*)(qp + ks * 16); }
    const int ntiles = ctxq ? 4 : 36, cbase = NL + b * CTXL, lbase = b * SEQ;
    const bf16_t* Kb = Q2 + 1536 + h * 128; const bf16_t* Vb = Kb + 64; const bf16_t* KRb = KR; const int pitch = C_UPN;
    float m = 0.f;
    f32x16 o[2], osum; float negm = 0.f;
#pragma unroll
    for (int r = 0; r < 16; ++r) { o[0][r] = 0.f; o[1][r] = 0.f; osum[r] = 0.f; }
#define C_ROW0(i) ((i) < 4 ? cbase + 64 * (i) : lbase + 64 * ((i) - 4))
#define C_QK2(dst, kst, ti) { dst[0] = qkn<96>(kst, 0, qr, negm, r32, hi); dst[1] = qkn<96>(kst, 32, qr, negm, r32, hi); }
    ATT2_RUN(96, true, C_ROW0, C_QK2, true, (MK_ATT_STAGGER & 2))
#undef C_QK2
#undef C_ROW0
    if (MK_O_ROWS) finalize_n_rows(o, osum, O + (size_t)(qrow - r32) * D + h * 64, lds + 65536 + wid * 4608, lane); else finalize_n(o, osum, O + (size_t)qrow * D + h * 64, hi);
}
}

struct Row4 { f32x4 v[4]; };
__device__ __forceinline__ void row_load(Row4& x, const float* p, int lane) {
#pragma unroll
    for (int j = 0; j < 4; ++j) x.v[j] = *(const f32x4*)(p + 4 * lane + 256 * j);
}
__device__ __forceinline__ void row_store(const Row4& x, float* p, int lane) {
#pragma unroll
    for (int j = 0; j < 4; ++j) *(f32x4*)(p + 4 * lane + 256 * j) = x.v[j];
}
__device__ __forceinline__ void row_load_bf(Row4& x, const bf16_t* p, int lane) {
#pragma unroll
    for (int j = 0; j < 4; ++j) { const u32x2 w = *(const u32x2*)(p + 4 * lane + 256 * j); x.v[j] = (f32x4){bf_lo(w.x), bf_hi(w.x), bf_lo(w.y), bf_hi(w.y)}; }
}
__device__ __forceinline__ void row_store_bf(const Row4& x, bf16_t* p, int lane) {
#pragma unroll
    for (int j = 0; j < 4; ++j) { u32x2 w; w.x = cvt_pk_bf16(x.v[j][0], x.v[j][1]); w.y = cvt_pk_bf16(x.v[j][2], x.v[j][3]); *(u32x2*)(p + 4 * lane + 256 * j) = w; }
}
__device__ __forceinline__ float row_rstd(const Row4& x, int lane) {
    float s = 0.f;
#pragma unroll
    for (int j = 0; j < 4; ++j) s += (x.v[j][0] * x.v[j][0] + x.v[j][1] * x.v[j][1]) + (x.v[j][2] * x.v[j][2] + x.v[j][3] * x.v[j][3]);
    s = wave_sum(s, lane);
    return 1.0f / sqrtf(s * (1.0f / D) + NORM_EPS);
}
__device__ __forceinline__ void norm_mod(const Row4& x, float rstd, const float* g, const float* sh, const float* sc, bf16_t* out, int lane, Row4& hv) {
#pragma unroll
    for (int j = 0; j < 4; ++j) { const int c = 4 * lane + 256 * j;
        const f32x4 gg = *(const f32x4*)(g + c), s1 = *(const f32x4*)(sc + c), s0 = *(const f32x4*)(sh + c);
        const f32x4 h = (x.v[j] * rstd * gg) * (s1 + 1.0f) + s0; hv.v[j] = h;
        u32x2 w; w.x = cvt_pk_bf16(h[0], h[1]); w.y = cvt_pk_bf16(h[2], h[3]); *(u32x2*)(out + c) = w; }
}

__device__ __forceinline__ unsigned pk_i8x4(float a, float b, float c, float d, float inv) {
    const f32x2 i2 = {inv, inv}, m2 = {12582912.0f, 12582912.0f};
    const f32x2 t01 = (f32x2){a, b} * i2 + m2, t23 = (f32x2){c, d} * i2 + m2;
    const unsigned lo = __builtin_amdgcn_perm(__float_as_uint(t01[1]), __float_as_uint(t01[0]), 0x0c0c0400u), hi = __builtin_amdgcn_perm(__float_as_uint(t23[1]), __float_as_uint(t23[0]), 0x0c0c0400u);
    return lo | (hi << 16);
}
__device__ __forceinline__ void norm_mod8(const Row4& x, float rstd, const float* g, const float* sh, const float* sc, unsigned char* out, float* sarow, int lane) {
    Row4 hv; float am = 0.f;
#pragma unroll
    for (int j = 0; j < 4; ++j) { const int c = 4 * lane + 256 * j;
        const f32x4 gg = *(const f32x4*)(g + c), s1 = *(const f32x4*)(sc + c), s0 = *(const f32x4*)(sh + c);
        const f32x4 h = (x.v[j] * rstd * gg) * (s1 + 1.0f) + s0; hv.v[j] = h;
        am = fmaxf(fmaxf(am, fmaxf(fabsf(h[0]), fabsf(h[1]))), fmaxf(fabsf(h[2]), fabsf(h[3]))); }
    am = fmaxf(wave_max(am, lane), 1e-20f); const float inv = 127.0f / am;
#pragma unroll
    for (int j = 0; j < 4; ++j) *(unsigned*)(out + 4 * lane + 256 * j) = pk_i8x4(hv.v[j][0], hv.v[j][1], hv.v[j][2], hv.v[j][3], inv);
    if (lane == 0) *sarow = am * (1.0f / 127.0f);
}

struct Ptrs {
    const float* in[29]; float* out; unsigned char* ws;
};
typedef const __attribute__((address_space(4))) Ptrs* PK;
#define WSP(T, off) ((T*)(P->ws + (off)))

__device__ __forceinline__ unsigned pk_f16(float a, float b) { const f32x2 v = {a, b}; const f16x2 h = __builtin_convertvector(v, f16x2); return __builtin_bit_cast(unsigned, h); }
__device__ __forceinline__ void phase_first_norm(PK P, LAS unsigned char* lds, int gw, int tid) {
    const float* MOD = WSP(const float, WS_MOD);
    { const int lane = tid & 63;
    {
        const int gt = gw * 64 + lane;
        for (int q = gt; q < DEPTH * 9 * 4096; q += 131072) { const int lb = q >> 12, cc = q & 4095, c = cc >> 5, e = cc & 31, l = lb / 9, b = lb - 9 * l;
            const float* g = P->in[7] + (size_t)l * D + 8 * c; const float* sc = MOD + ((size_t)l * 9 + b) * 6144 + 4096 + 8 * c; const float* w = P->in[21] + ((size_t)l * D + 8 * c) * NEXP + e;
            float v[8];
#pragma unroll
            for (int j = 0; j < 8; ++j) v[j] = g[j] * (1.0f + sc[j]) * w[j * NEXP];
            u32x4 o; o.x = pk_f16(v[0], v[1]); o.y = pk_f16(v[2], v[3]); o.z = pk_f16(v[4], v[5]); o.w = pk_f16(v[6], v[7]);
            *(u32x4*)(WSP(unsigned char, WS_G16) + (size_t)lb * 65536 + e * 2048 + ((c ^ (e & 15)) * 16)) = o; }
        for (int q = gw; q < DEPTH * 9 * 32; q += 2048) { const int lb = q >> 5, e = q & 31, l = lb / 9, b = lb - 9 * l;
            const float* sh = MOD + ((size_t)l * 9 + b) * 6144 + 3072; const float* w = P->in[21] + (size_t)l * D * NEXP + e; float t = 0.f;
#pragma unroll
            for (int j = 0; j < 16; ++j) { const int k = lane + 64 * j; t += sh[k] * w[(size_t)k * NEXP]; }
            t = wave_sum(t, lane);
            if (lane == 0) WSP(float, WS_RC)[q] = t + P->in[22][l * NEXP + e]; }
    } }
    const int lane = tid & 63, vcu = gw >> 3, wid = gw & 7, bb = vcu >> 5;
    LAS float* vec = (LAS float*)lds;
    for (int i = tid; i < 1024; i += 512) { const int set = i >> 9, v = (i >> 8) & 1, k = 4 * (i & 255); const float* mod = MOD + (size_t)(set ? 8 : bb) * 6144;
        *(LAS f32x4*)(vec + set * 2048 + v * 1024 + k) = v ? *(const f32x4*)(mod + k) : *(const f32x4*)(P->in[6] + k) * (*(const f32x4*)(mod + 1024 + k) + 1.0f); }
    __syncthreads();
    const int rbase = bb * 2048 + (vcu & 31) * 64 + wid * 8;
    for (int p = 0; p < 3; ++p) {
        int rr[3]; Row4 x[3];
#pragma unroll
        for (int u = 0; u < 3; ++u) { const int q = 3 * p + u; rr[u] = q < 8 ? rbase + q : NL + vcu * 8 + wid;
            const int r = rr[u]; const float* src = r < NL ? P->in[0] + (size_t)r * D : P->in[2] + (size_t)(r - NL) * D; row_load(x[u], src, lane); }
#pragma unroll
        for (int u = 0; u < 3; ++u) { const int r = rr[u]; row_store_bf(x[u], WSP(bf16_t, WS_XS) + (size_t)r * D, lane);
            const float rstd = row_rstd(x[u], lane); const LAS float* vv = vec + (r < NL ? 0 : 2048) + 4 * lane;
            Row4 hv; float am = 0.f;
#pragma unroll
            for (int j = 0; j < 4; ++j) { const f32x4 h = (x[u].v[j] * rstd) * *(const LAS f32x4*)(vv + 256 * j) + *(const LAS f32x4*)(vv + 1024 + 256 * j); hv.v[j] = h;
                am = fmaxf(fmaxf(am, fmaxf(fabsf(h[0]), fabsf(h[1]))), fmaxf(fabsf(h[2]), fabsf(h[3]))); }
            am = fmaxf(wave_max(am, lane), 1e-20f); const float inv = 127.0f / am; unsigned char* out = WSP(unsigned char, WS_H) + (size_t)r * D;
#pragma unroll
            for (int j = 0; j < 4; ++j) *(unsigned*)(out + 4 * lane + 256 * j) = pk_i8x4(hv.v[j][0], hv.v[j][1], hv.v[j][2], hv.v[j][3], inv);
            if (lane == 0) WSP(float, WS_SAH)[r] = am * (1.0f / 127.0f); }
    }
}
__device__ __forceinline__ void phase_mla_norm(PK P, int gw, int lane) {
    const float* Y = WSP(const float, WS_Y416); bf16_t* CQ = WSP(bf16_t, WS_CQKV); bf16_t* KR = WSP(bf16_t, WS_KR);
    const float* qn = P->in[16]; const float* kn = P->in[17]; const float* rope = WSP(const float, WS_ROPE_C);
    const f32x4 g = *(const f32x4*)(qn + 4 * lane); const f32x2 g2 = *(const f32x2*)(kn + 2 * lane);
    for (int r0 = gw; r0 < NT; r0 += 4096) {
        const int rr[2] = {r0, (r0 + 2048 < NT) ? r0 + 2048 : r0};
        f32x4 vq[2]; f32x2 vk[2], vr[2];
#pragma unroll
        for (int u = 0; u < 2; ++u) { const float* y = Y + (size_t)rr[u] * C_INP; vq[u] = *(const f32x4*)(y + 4 * lane); vk[u] = *(const f32x2*)(y + 256 + 2 * lane); vr[u] = *(const f32x2*)(y + 384 + 2 * (lane & 15)); }
#pragma unroll
        for (int u = 0; u < 2; ++u) { const int r = rr[u]; const f32x4 v = vq[u];
            const float ss = wave_sum((v[0] * v[0] + v[1] * v[1]) + (v[2] * v[2] + v[3] * v[3]), lane);
            const float rq = 1.0f / sqrtf(ss * (1.0f / 256.0f) + NORM_EPS);
            u32x2 w; w.x = cvt_pk_bf16(v[0] * rq * g[0], v[1] * rq * g[1]); w.y = cvt_pk_bf16(v[2] * rq * g[2], v[3] * rq * g[3]);
            *(u32x2*)(CQ + (size_t)r * C_UPK + 4 * lane) = w;
            const f32x2 k2 = vk[u];
            const float s2 = wave_sum(k2[0] * k2[0] + k2[1] * k2[1], lane);
            const float rk = 1.0f / sqrtf(s2 * (1.0f / 128.0f) + NORM_EPS);
            *(unsigned*)(CQ + (size_t)r * C_UPK + 256 + 2 * lane) = cvt_pk_bf16(k2[0] * rk * g2[0], k2[1] * rk * g2[1]);
            if (lane < 16) { f32x2 p = vr[u];
                if (r < NL) { const f32x2 cs = *(const f32x2*)(rope + ((size_t)(r & (SEQ - 1)) * 16 + lane) * 2); const float a = p[0], b = p[1]; p[0] = a * cs[0] - b * cs[1]; p[1] = a * cs[1] + b * cs[0]; }
                *(unsigned*)(KR + (size_t)r * 32 + 2 * lane) = cvt_pk_bf16(p[0], p[1]); }
        }
    }
}
__device__ __forceinline__ void moe_tables(LAS unsigned char* misc, unsigned* gcnt, int tid) {
    LAS int* ecnt = (LAS int*)(misc + M_ECNT); LAS int* lbase = (LAS int*)(misc + M_LBASE); LAS int* cumt = (LAS int*)(misc + M_CUMT);
    if (tid < 32) ecnt[tid] = (int)__hip_atomic_load(gcnt + tid * 16, __ATOMIC_RELAXED, __HIP_MEMORY_SCOPE_AGENT);
    __syncthreads();
    if (tid == 0) { int s = 0, t = 0; for (int e = 0; e < 32; ++e) { lbase[e] = s; cumt[e] = t; const int mt = (ecnt[e] + 255) >> 8; s += mt * 256; t += mt; } cumt[32] = t; }
    __syncthreads();
}
constexpr int RT_PLOG = 65536, RT_LOGIT = 98304, RT_SSQ = 102912, RT_RSTD = 103936, RT_CVEC = 104064, RT_AMX = 104192, RT_TOPV = 105216, RT_TOPE = 105728, RT_VA = 106496, RT_VB = 110592;
__device__ __forceinline__ void phase_router(PK P, LAS unsigned char* lds, int l, int nrows, int vcu, int tid, int cset) {
    const int lane = tid & 63, wid = __builtin_amdgcn_readfirstlane(tid >> 6), i32 = lane & 31, hi = lane >> 5;
    LAS unsigned char* misc = lds + MISC_OFF;
    LAS int* lcnt = (LAS int*)(misc + M_LCNT); LAS int* gbase = (LAS int*)(misc + M_GBASE); LAS int* rec = (LAS int*)(misc + M_REC);
    LAS float* plog = (LAS float*)(lds + RT_PLOG); LAS float* logit = (LAS float*)(lds + RT_LOGIT); LAS float* ssq = (LAS float*)(lds + RT_SSQ);
    LAS float* rstd_s = (LAS float*)(lds + RT_RSTD); LAS float* cvec = (LAS float*)(lds + RT_CVEC); LAS float* amx = (LAS float*)(lds + RT_AMX); LAS float* rowsa = (LAS float*)(misc + M_RSA); LAS float* topv = (LAS float*)(lds + RT_TOPV); LAS int* tope = (LAS int*)(lds + RT_TOPE);
    const bool last = (nrows == NL);
    const int nb = (!last && vcu < 64) ? 3 : 2;
    const float* MOD = WSP(const float, WS_MOD) + (size_t)l * 9 * 6144;
    const bf16_t* XS = WSP(const bf16_t, WS_XS); unsigned char* H8 = WSP(unsigned char, WS_H);
    int* TOPE = WSP(int, WS_TOPE); float* GATE = WSP(float, WS_GATE);
    const float* gn = P->in[7] + (size_t)l * D;
    if (tid < 32) lcnt[tid] = 0;
    u32x4 nw[8];
#define RT_ROW0(b) ((b) < 2 ? 64 * vcu + 32 * (b) : NL + 32 * vcu)
    { const bf16_t* xp0 = XS + (size_t)(RT_ROW0(0) + i32) * D + 128 * wid + 8 * hi;
#pragma unroll
      for (int s = 0; s < 8; ++s) nw[s] = *(const u32x4*)(xp0 + 16 * s); }
    for (int bi = 0; bi < nb; ++bi) {
        const int rb = bi < 2 ? (vcu >> 5) : 8;
        const int row0 = RT_ROW0(bi);
        if (bi != 1) {
            __syncthreads();
            const u32x4* gsrc = (const u32x4*)(WSP(const unsigned char, WS_G16) + (size_t)(l * 9 + rb) * 65536);
#pragma unroll
            for (int c = 0; c < 8; ++c) *(LAS u32x4*)(lds + (size_t)(tid + 512 * c) * 16) = gsrc[tid + 512 * c];
            if (tid < 32) cvec[tid] = WSP(const float, WS_RC)[(l * 9 + rb) * 32 + tid];
            { const float* mod = MOD + (size_t)rb * 6144; const int k = 4 * (tid & 255);
              if (tid < 256) *(LAS f32x4*)(lds + RT_VA + 4 * k) = *(const f32x4*)(gn + k) * (*(const f32x4*)(mod + 4096 + k) + 1.0f);
              else *(LAS f32x4*)(lds + RT_VB + 4 * k) = *(const f32x4*)(mod + 3072 + k); }
            __syncthreads();
        }
        const int r = row0 + i32;
        f32x4 xa[8], xb[8];
#pragma unroll
        for (int s = 0; s < 8; ++s) { const u32x4 w = nw[s];
            xa[s] = (f32x4){bf_lo(w.x), bf_hi(w.x), bf_lo(w.y), bf_hi(w.y)}; xb[s] = (f32x4){bf_lo(w.z), bf_hi(w.z), bf_lo(w.w), bf_hi(w.w)}; }
        if (bi + 1 < nb) { const bf16_t* xpn = XS + (size_t)(RT_ROW0(bi + 1) + i32) * D + 128 * wid + 8 * hi;
#pragma unroll
            for (int s = 0; s < 8; ++s) nw[s] = *(const u32x4*)(xpn + 16 * s); }
        float ss = 0.f;
        f32x16 acc;
#pragma unroll
        for (int q = 0; q < 16; ++q) acc[q] = 0.f;
#pragma unroll
        for (int s = 0; s < 8; ++s) {
            ss += (xa[s][0] * xa[s][0] + xa[s][1] * xa[s][1]) + (xa[s][2] * xa[s][2] + xa[s][3] * xa[s][3]) + (xb[s][0] * xb[s][0] + xb[s][1] * xb[s][1]) + (xb[s][2] * xb[s][2] + xb[s][3] * xb[s][3]);
            u32x4 aw; aw.x = pk_f16(xa[s][0], xa[s][1]); aw.y = pk_f16(xa[s][2], xa[s][3]); aw.z = pk_f16(xb[s][0], xb[s][1]); aw.w = pk_f16(xb[s][2], xb[s][3]);
            const int c = 16 * wid + 2 * s + hi;
            const f16x8 bf = *(const LAS f16x8*)(lds + i32 * 2048 + ((c ^ (i32 & 15)) * 16));
            acc = __builtin_amdgcn_mfma_f32_32x32x16_f16(__builtin_bit_cast(f16x8, aw), bf, acc, 0, 0, 0);
        }
        ss = swap32_sum(ss);
        if (hi == 0) ssq[wid * 32 + i32] = ss;
#pragma unroll
        for (int q = 0; q < 16; ++q) plog[(wid * 32 + att::crow(q, hi)) * 32 + i32] = acc[q];
        __syncthreads();
        if (tid < 32) { float t = 0.f;
#pragma unroll
            for (int w = 0; w < 8; ++w) t += ssq[w * 32 + tid];
            rstd_s[tid] = 1.0f / sqrtf(t * (1.0f / D) + NORM_EPS); }
        __syncthreads();
#pragma unroll
        for (int u = 0; u < 2; ++u) { const int idx = tid + 512 * u, rr = idx >> 5, e = idx & 31; float t = 0.f;
#pragma unroll
            for (int w = 0; w < 8; ++w) t += plog[(w * 32 + rr) * 32 + e];
            logit[rr * 33 + e] = rstd_s[rr] * t + cvec[e]; }
        { const float rs = rstd_s[i32]; const int k0 = 128 * wid + 8 * hi; float am = 0.f;
          const LAS float* va = (const LAS float*)(lds + RT_VA); const LAS float* vb = (const LAS float*)(lds + RT_VB);
#pragma unroll
          for (int s = 0; s < 8; ++s) { const int k = k0 + 16 * s;
              const f32x4 a0 = *(const LAS f32x4*)(va + k), a1 = *(const LAS f32x4*)(va + k + 4), s0 = *(const LAS f32x4*)(vb + k), s1 = *(const LAS f32x4*)(vb + k + 4);
              const f32x4 h0 = (xa[s] * rs) * a0 + s0, h1 = (xb[s] * rs) * a1 + s1; xa[s] = h0; xb[s] = h1;
              am = fmaxf(fmaxf(fmaxf(am, fabsf(h0[0])), fmaxf(fabsf(h0[1]), fabsf(h0[2]))), fmaxf(fmaxf(fabsf(h0[3]), fabsf(h1[0])), fmaxf(fabsf(h1[1]), fmaxf(fabsf(h1[2]), fabsf(h1[3]))))); }
          am = swap32_max(am);
          if (hi == 0) amx[wid * 32 + i32] = am; }
        __syncthreads();
        { float a = amx[i32];
#pragma unroll
          for (int w = 1; w < 8; ++w) a = fmaxf(a, amx[w * 32 + i32]);
          a = fmaxf(a, 1e-20f); const float inv = 127.0f / a;
          if (wid == 0 && hi == 0) rowsa[32 * bi + i32] = a * (1.0f / 127.0f);
          unsigned char* hp = H8 + (size_t)r * D + 128 * wid + 8 * hi;
#pragma unroll
          for (int s = 0; s < 8; ++s) { u32x2 w; w.x = pk_i8x4(xa[s][0], xa[s][1], xa[s][2], xa[s][3], inv); w.y = pk_i8x4(xb[s][0], xb[s][1], xb[s][2], xb[s][3], inv); *(u32x2*)(hp + 16 * s) = w; } }
#pragma unroll
        for (int u = 0; u < 2; ++u) { const int idx = tid + 512 * u, rr = idx >> 5, e = idx & 31; const float v = logit[rr * 33 + e]; int rank = 0;
#pragma unroll 8
            for (int e2 = 0; e2 < 32; ++e2) { const float v2 = logit[rr * 33 + e2]; rank += (v2 > v || (v2 == v && e2 < e)) ? 1 : 0; }
            if (rank < 4) { topv[rr * 4 + rank] = v; tope[rr * 4 + rank] = e; } }
        __syncthreads();
        if (tid < 32) {
            const float t0 = topv[tid * 4], t1 = topv[tid * 4 + 1], t2 = topv[tid * 4 + 2], t3 = topv[tid * 4 + 3]; const int e0 = tope[tid * 4], e1 = tope[tid * 4 + 1], e2 = tope[tid * 4 + 2], e3 = tope[tid * 4 + 3];
            const float x1 = __expf(t1 - t0), x2 = __expf(t2 - t0), x3 = __expf(t3 - t0); const float inv = 1.0f / (1.0f + x1 + x2 + x3);
            const int rr = row0 + tid, lr = 32 * bi + tid;
            *(int4*)(TOPE + (size_t)rr * 4) = make_int4(e0, e1, e2, e3);
            *(f32x4*)(GATE + (size_t)rr * 4) = (f32x4){inv, x1 * inv, x2 * inv, x3 * inv};
            const int ee[4] = {e0, e1, e2, e3};
#pragma unroll
            for (int k = 0; k < 4; ++k) { const int lp = __hip_atomic_fetch_add(lcnt + ee[k], 1, __ATOMIC_RELAXED, __HIP_MEMORY_SCOPE_WORKGROUP); rec[2 * (lr * 4 + k)] = ee[k]; rec[2 * (lr * 4 + k) + 1] = lp; }
        }
    }
    __syncthreads();
    unsigned* gcnt = WSP(unsigned, WS_CTL) + CW_CNT + (l * 2 + cset) * 512;
    if (tid < 32) { const int c = lcnt[tid]; gbase[tid] = c ? (int)__hip_atomic_fetch_add(gcnt + tid * 16, (unsigned)c, __ATOMIC_RELAXED, __HIP_MEMORY_SCOPE_AGENT) : 0; }
    __syncthreads();
    int* ELIST = WSP(int, WS_ELIST); int* POS = WSP(int, WS_POS);
    for (int idx = tid; idx < nb * 128; idx += 512) { const int e = rec[2 * idx], pos = gbase[e] + rec[2 * idx + 1]; const int lr = idx >> 2; const int r = lr < 64 ? 64 * vcu + lr : NL + 32 * vcu + (lr - 64);
        ELIST[(size_t)e * NT + pos] = r; POS[(size_t)r * 4 + (idx & 3)] = pos; WSP(float, WS_SAL)[(size_t)e * NT + pos] = rowsa[lr]; }
    __syncthreads();
}
constexpr int RQU = 8;
__device__ __forceinline__ unsigned rq4(unsigned w, float fac, float c0) {
    const float t0 = (float)(w & 255u) * fac + c0, t1 = (float)((w >> 8) & 255u) * fac + c0, t2 = (float)((w >> 16) & 255u) * fac + c0, t3 = (float)(w >> 24) * fac + c0;
    const unsigned lo = __builtin_amdgcn_perm(__float_as_uint(t1), __float_as_uint(t0), 0x0c0c0400u), hi = __builtin_amdgcn_perm(__float_as_uint(t3), __float_as_uint(t2), 0x0c0c0400u);
    return lo | (hi << 16);
}
__device__ __forceinline__ void phase_requant(PK P, const LAS int* cumt, int gw, int lane) {
    const int nrows = __builtin_amdgcn_readfirstlane(cumt[32]) * 256;
    const int per = (nrows + 2047) >> 11, np = (per + RQU - 1) / RQU, nu = np > 0 ? (per + np - 1) / np : 0;
    const unsigned char* AQ = WSP(const unsigned char, WS_ACT); const float* SB = WSP(const float, WS_SBLK); unsigned char* A8 = WSP(unsigned char, WS_ACT8); float* SAQ = WSP(float, WS_SAQ);
    for (int r0 = gw; r0 < nrows; r0 += nu * 2048) {
        u32x4 a[RQU]; float sb[RQU];
#pragma unroll
        for (int u = 0; u < RQU; ++u) { const int r = r0 + u * 2048; a[u] = (u32x4){0u, 0u, 0u, 0u}; sb[u] = 1.0f;
            if (u < nu && r < nrows) { a[u] = *(const u32x4*)(AQ + (size_t)r * D + 16 * lane); sb[u] = SB[(size_t)r * 32 + (lane >> 1)]; } }
#pragma unroll
        for (int u = 0; u < RQU; ++u) { const int r = r0 + u * 2048;
            if (u < nu && r < nrows) {
                const float srow = wave_max(sb[u], lane); const float fac = sb[u] * __builtin_amdgcn_rcpf(srow), c0 = 12582912.0f - 128.0f * fac;
                u32x4 w; w.x = rq4(a[u].x, fac, c0); w.y = rq4(a[u].y, fac, c0); w.z = rq4(a[u].z, fac, c0); w.w = rq4(a[u].w, fac, c0);
                *(u32x4*)(A8 + (size_t)r * D + 16 * lane) = w;
                if (lane == 0) SAQ[r] = srow; }
        }
    }
}
constexpr int CBU = 3;
__device__ __forceinline__ void phase_combine(PK P, LAS unsigned char* lds, int l, int nrows, int gw, int tid, bool dry) {
    (void)dry; (void)nrows;
    const int lane = tid & 63, vcu = gw >> 3, wid = gw & 7;
    LAS unsigned char* misc = lds + MISC_OFF;
    if (MK_PER_PHASE) moe_tables(misc, WSP(unsigned, WS_CTL) + CW_CNT + (l * 2 + ((MK_REP_MASK >> 11) & 1)) * 512, tid);
    const LAS int* lbase = (const LAS int*)(misc + M_LBASE);
    const float* MOD = WSP(const float, WS_MOD);
    bf16_t* XS = WSP(bf16_t, WS_XS); const unsigned char* YSQ = WSP(const unsigned char, WS_YS); const float* YSB = WSP(const float, WS_YSB);
    const int* TOPE = WSP(const int, WS_TOPE); const int* POS = WSP(const int, WS_POS); const float* GATE = WSP(const float, WS_GATE);
    const bool last = (l == DEPTH - 1);
    const int bb = vcu >> 5;
    LAS float* vec = (LAS float*)lds;
    for (int i = tid; i < (last ? 1 : 2) * 768; i += 512) { const int set = i / 768, v = (i % 768) >> 8, k = 4 * (i & 255), rb = set ? 8 : bb;
        f32x4 w;
        if (v == 0) w = *(const f32x4*)(MOD + (size_t)l * 9 * 6144 + 5120 + (size_t)rb * 6144 + k);
        else if (last) w = *(const f32x4*)(P->in[8] + k);
        else { const float* mod = MOD + (size_t)(l + 1) * 9 * 6144 + (size_t)rb * 6144;
            w = (v == 1) ? *(const f32x4*)(P->in[6] + (size_t)(l + 1) * D + k) * (*(const f32x4*)(mod + 1024 + k) + 1.0f) : *(const f32x4*)(mod + k); }
        *(LAS f32x4*)(vec + set * 3072 + v * 1024 + k) = w; }
    __syncthreads();
    const int rbase = bb * 2048 + (vcu & 31) * 64 + wid * 8;
    for (int p = 0; p < 3; ++p) {
        int rr[CBU]; int vs[CBU];
#pragma unroll
        for (int u = 0; u < CBU; ++u) { const int q = 3 * p + u; const bool cx = (q == 8) && !last;
            rr[u] = q < 8 ? rbase + q : (last ? rbase + 6 : NL + vcu * 8 + wid); vs[u] = cx ? 3072 : 0; }
        int slot[CBU]; float gate[CBU];
#pragma unroll
        for (int u = 0; u < CBU; ++u) { slot[u] = 0; gate[u] = 0.f;
            if (lane < 4 && !(last && 3 * p + u == 8)) { slot[u] = lbase[TOPE[(size_t)rr[u] * 4 + lane]] + POS[(size_t)rr[u] * 4 + lane]; gate[u] = GATE[(size_t)rr[u] * 4 + lane]; } }
        u32x2 xw[CBU][4]; unsigned yw[CBU][4][4]; float ys[CBU][4][4];
#pragma unroll
        for (int u = 0; u < CBU; ++u) { if (last && 3 * p + u == 8) continue;
#pragma unroll
            for (int j = 0; j < 4; ++j) xw[u][j] = *(const u32x2*)(XS + (size_t)rr[u] * D + 4 * lane + 256 * j);
#pragma unroll
            for (int k = 0; k < 4; ++k) { const int sk = __builtin_amdgcn_readlane(slot[u], k); const unsigned char* yr = YSQ + (size_t)sk * D; const float* yb = YSB + (size_t)sk * 32 + (lane >> 3);
#pragma unroll
                for (int j = 0; j < 4; ++j) { yw[u][k][j] = *(const unsigned*)(yr + 4 * lane + 256 * j); ys[u][k][j] = yb[8 * j]; } } }
#pragma unroll
        for (int u = 0; u < CBU; ++u) { if (last && 3 * p + u == 8) continue;
            const int r = rr[u]; const LAS float* vv = vec + vs[u] + 4 * lane;
            Row4 x, f;
#pragma unroll
            for (int j = 0; j < 4; ++j) { x.v[j] = (f32x4){bf_lo(xw[u][j].x), bf_hi(xw[u][j].x), bf_lo(xw[u][j].y), bf_hi(xw[u][j].y)}; f.v[j] = (f32x4){0.f, 0.f, 0.f, 0.f}; }
#pragma unroll
            for (int k = 0; k < 4; ++k) { const float gk = __int_as_float(__builtin_amdgcn_readlane(__float_as_int(gate[u]), k));
#pragma unroll
                for (int j = 0; j < 4; ++j) { const unsigned w = yw[u][k][j]; const float gs = gk * ys[u][k][j], g0 = -128.0f * gs;
                    f.v[j][0] += (float)(w & 255u) * gs + g0; f.v[j][1] += (float)((w >> 8) & 255u) * gs + g0; f.v[j][2] += (float)((w >> 16) & 255u) * gs + g0; f.v[j][3] += (float)(w >> 24) * gs + g0; } }
#pragma unroll
            for (int j = 0; j < 4; ++j) { const f32x4 gg = *(const LAS f32x4*)(vv + 256 * j); x.v[j] = x.v[j] + gg * f.v[j]; }
            const float rstd = row_rstd(x, lane);
            if (last) {
#pragma unroll
                for (int j = 0; j < 4; ++j) { const int c = 4 * lane + 256 * j; *(f32x4*)(P->out + (size_t)r * D + c) = (x.v[j] * rstd) * *(const LAS f32x4*)(vv + 1024 + 256 * j); }
            } else {
                row_store_bf(x, XS + (size_t)r * D, lane);
                Row4 hv; float am = 0.f;
#pragma unroll
                for (int j = 0; j < 4; ++j) { const f32x4 h = (x.v[j] * rstd) * *(const LAS f32x4*)(vv + 1024 + 256 * j) + *(const LAS f32x4*)(vv + 2048 + 256 * j); hv.v[j] = h;
                    am = fmaxf(fmaxf(am, fmaxf(fabsf(h[0]), fabsf(h[1]))), fmaxf(fabsf(h[2]), fabsf(h[3]))); }
                if ((l + 1) % 3 == 2) row_store_bf(hv, WSP(bf16_t, WS_H) + (size_t)r * D, lane);
                else { am = fmaxf(wave_max(am, lane), 1e-20f); const float inv = 127.0f / am; unsigned char* out = WSP(unsigned char, WS_H) + (size_t)r * D;
#pragma unroll
                    for (int j = 0; j < 4; ++j) *(unsigned*)(out + 4 * lane + 256 * j) = pk_i8x4(hv.v[j][0], hv.v[j][1], hv.v[j][2], hv.v[j][3], inv);
                    if (lane == 0) WSP(float, WS_SAH)[r] = am * (1.0f / 127.0f); }
            }
        }
    }
}
__device__ __forceinline__ void phase_final_norm(PK P, int gw, int lane) {
    for (int r = gw; r < NL; r += 2048) { Row4 x; row_load_bf(x, WSP(const bf16_t, WS_XS) + (size_t)r * D, lane); const float rstd = row_rstd(x, lane);
#pragma unroll
        for (int j = 0; j < 4; ++j) { const int c = 4 * lane + 256 * j; const f32x4 gn = *(const f32x4*)(P->in[8] + c); *(f32x4*)(P->out + (size_t)r * D + c) = x.v[j] * rstd * gn; } }
}

__device__ __forceinline__ void conv_item(const float* src, int N, int nvalid, int k0, int n0, bf16_t* dst, int ldk, int drow0, int dk0, LAS unsigned* scr, int lane) {
    const int q = lane >> 4, nl = lane & 15, n = n0 + 4 * nl;
    f32x4 v[16];
#pragma unroll
    for (int r = 0; r < 16; ++r) { const int k = k0 + 8 * (r >> 1) + 2 * q + (r & 1);
        v[r] = (n < nvalid) ? __builtin_nontemporal_load((const f32x4*)(src + (size_t)k * N + n)) : (f32x4){0.f, 0.f, 0.f, 0.f}; }
#pragma unroll
    for (int rp = 0; rp < 8; ++rp)
#pragma unroll
        for (int i = 0; i < 4; ++i) { const int nn = 4 * nl + i, kw = 4 * rp + q; scr[nn * 32 + (kw ^ (4 * ((nn >> 2) & 7)))] = cvt_pk_bf16(v[2 * rp][i], v[2 * rp + 1][i]); }
    asm volatile("s_waitcnt lgkmcnt(0)" ::: "memory");
#pragma unroll
    for (int it = 0; it < 8; ++it) { const int nn = 8 * it + (lane >> 3), c = lane & 7;
        const u32x4 w = *(const LAS u32x4*)(scr + nn * 32 + 4 * (c ^ ((nn >> 2) & 7)));
        *(u32x4*)(dst + (size_t)(drow0 + nn) * ldk + dk0 + 8 * c) = w; }
    asm volatile("s_waitcnt lgkmcnt(0)" ::: "memory");
}
constexpr int CV_A_IN = 2 * 16 * 24, CV_A_OUT = 2 * 256, CV_B_IN = 16 * 48, CV_B_OUT = 256, CV_C_IN = 16 * 8, CV_C_UQ = 4 * 24, CV_C_UKV = 2 * 32, CV_C_OUT = 256;
constexpr int CV_SMALL = CV_A_IN + CV_A_OUT + CV_B_IN + CV_B_OUT + CV_C_IN + CV_C_UQ + CV_C_UKV + CV_C_OUT;
constexpr int CV_LAYER = NEXP * 3 * 256;
constexpr int CV_TOTAL = CV_SMALL + DEPTH * CV_LAYER;
constexpr int CV_CHUNK = 32;
__device__ __forceinline__ void conv_dispatch(PK P, int item, LAS unsigned* scr, int lane) {
    int r = item; const float* src; bf16_t* dst; int N, kb, nb, ldk = D, drow_off = 0, dk_off = 0;
    if (r < CV_A_IN) return;
    else if ((r -= CV_A_IN) < CV_A_OUT) { const int s = r / 256, it = r % 256; kb = it / 16; nb = it % 16; src = P->in[10] + (size_t)s * D * D; N = D; dst = WSP(bf16_t, WS_WA_OUT) + (size_t)s * D * D; }
    else if ((r -= CV_A_OUT) < CV_B_IN) return;
    else if ((r -= CV_B_IN) < CV_B_OUT) { kb = r / 16; nb = r % 16; src = P->in[13]; N = D; dst = WSP(bf16_t, WS_WB_OUT); }
    else if ((r -= CV_B_OUT) < CV_C_IN) { kb = r / 8; nb = r % 8; src = P->in[15]; N = C_IN; dst = WSP(bf16_t, WS_WC_IN); }
    else if ((r -= CV_C_IN) < CV_C_UQ) { kb = r / 24; nb = r % 24; src = P->in[18]; N = 1536; dst = WSP(bf16_t, WS_WC_UP); ldk = C_UPK; }
    else if ((r -= CV_C_UQ) < CV_C_UKV) { kb = r / 32; nb = r % 32; src = P->in[19]; N = 2048; dst = WSP(bf16_t, WS_WC_UP); ldk = C_UPK; drow_off = 1536; dk_off = 256; }
    else { r -= CV_C_UKV; kb = r / 16; nb = r % 16; src = P->in[20]; N = D; dst = WSP(bf16_t, WS_WC_OUT); }
    conv_item(src, N, N, 64 * kb, 64 * nb, dst, ldk, drow_off + 64 * nb, dk_off + 64 * kb, scr, lane);
}
__device__ __forceinline__ void conv_down_item(PK P, int L, int di, LAS unsigned* scr, int lane) {
    const int le = L * NEXP + (di >> 8), it = di & 255, kb = it >> 4, nb = it & 15;
    conv_item(P->in[27] + (size_t)le * D * D, D, D, 64 * kb, 64 * nb, WSP(bf16_t, WS_WD) + (size_t)le * D * D, D, 64 * nb, 64 * kb, scr, lane);
}
__device__ __forceinline__ void conv_q8_block(const float* src0, int N, unsigned char* dstq, float* dsts, LAS unsigned char* lds, int tid) {
    const int lane = tid & 63, wid = __builtin_amdgcn_readfirstlane(tid >> 6), q = lane >> 4, nl = lane & 15;
    const float* src = src0 + 4 * nl;
    f32x4 v[32];
#pragma unroll
    for (int r = 0; r < 32; ++r) { const int k = 128 * wid + 16 * (r >> 2) + 4 * q + (r & 3); v[r] = __builtin_nontemporal_load((const f32x4*)(src + (size_t)k * N)); }
    float cm[4] = {0.f, 0.f, 0.f, 0.f};
#pragma unroll
    for (int r = 0; r < 32; ++r)
#pragma unroll
        for (int i = 0; i < 4; ++i) cm[i] = fmaxf(cm[i], fabsf(v[r][i]));
    LAS float* cmx = (LAS float*)(lds + 65536);
#pragma unroll
    for (int i = 0; i < 4; ++i) { cm[i] = fmaxf(cm[i], shx(cm[i], 16, lane)); cm[i] = swap32_max(cm[i]); }
    if (q == 0) { *(LAS f32x4*)(cmx + wid * 64 + 4 * nl) = (f32x4){cm[0], cm[1], cm[2], cm[3]}; }
    __syncthreads();
    f32x4 a = *(const LAS f32x4*)(cmx + 4 * nl);
#pragma unroll
    for (int w = 1; w < 8; ++w) { const f32x4 b = *(const LAS f32x4*)(cmx + w * 64 + 4 * nl); a[0] = fmaxf(a[0], b[0]); a[1] = fmaxf(a[1], b[1]); a[2] = fmaxf(a[2], b[2]); a[3] = fmaxf(a[3], b[3]); }
    float inv[4];
#pragma unroll
    for (int i = 0; i < 4; ++i) { a[i] = fmaxf(a[i], 1e-30f); inv[i] = 127.0f / a[i]; }
    if (wid == 0 && q == 0) *(f32x4*)(dsts + 4 * nl) = a * (1.0f / 127.0f);
    LAS unsigned* scr = (LAS unsigned*)(lds + wid * 8192);
#pragma unroll
    for (int rp = 0; rp < 8; ++rp)
#pragma unroll
        for (int i = 0; i < 4; ++i) { const int nn = 4 * nl + i, kw = 4 * rp + q;
            scr[nn * 32 + (kw ^ (4 * ((nn >> 2) & 7)))] = pk_i8x4(v[4 * rp][i], v[4 * rp + 1][i], v[4 * rp + 2][i], v[4 * rp + 3][i], inv[i]); }
    asm volatile("s_waitcnt lgkmcnt(0)" ::: "memory");
    unsigned char* dst = dstq + 128 * wid;
#pragma unroll
    for (int it = 0; it < 8; ++it) { const int nn = 8 * it + (lane >> 3), c = lane & 7;
        const u32x4 w = *(const LAS u32x4*)(scr + nn * 32 + 4 * (c ^ ((nn >> 2) & 7)));
        *(u32x4*)(dst + (size_t)nn * D + 16 * c) = w; }
    __syncthreads();
}
__device__ __forceinline__ void conv_gu_block(PK P, LAS unsigned char* lds, int le, int which, int nb, int tid) {
    const int n0 = 64 * nb, drow0 = 256 * (n0 >> 7) + (n0 & 127) + (which ? 128 : 0);
    conv_q8_block(P->in[which ? 25 : 23] + (size_t)le * D * D + n0, D, WSP(unsigned char, WS_WGU) + ((size_t)le * 2048 + drow0) * D, WSP(float, WS_SBW) + (size_t)le * 2048 + drow0, lds, tid);
}
__device__ __forceinline__ void conv_in_block(PK P, LAS unsigned char* lds, int blk, int tid) {
    if (blk < 48) { const int s = blk / 24, nb = blk % 24;
        conv_q8_block(P->in[9] + (size_t)s * D * A_IN + 64 * nb, A_IN, WSP(unsigned char, WS_WA_IN) + ((size_t)s * A_IN + 64 * nb) * D, WSP(float, WS_SBI) + s * A_IN + 64 * nb, lds, tid); }
    else { const int nb = blk - 48;
        conv_q8_block(P->in[12] + 64 * nb, B_IN, WSP(unsigned char, WS_WB_IN) + (size_t)64 * nb * D, WSP(float, WS_SBI) + 2 * A_IN + 64 * nb, lds, tid); }
}
constexpr int CV_SLOTS = 1536;
__device__ __forceinline__ void conv_slot(PK P, LAS unsigned char* lds, int L, int s, int tid) {
    if (s < 1024) { conv_gu_block(P, lds, L * NEXP + (s >> 5), (s >> 4) & 1, s & 15, tid); return; }
    const int d = s - 1024, le = L * NEXP + (d >> 4), nb = d & 15;
    conv_q8_block(P->in[27] + (size_t)le * D * D + 64 * nb, D, WSP(unsigned char, WS_WD) + ((size_t)le * D + 64 * nb) * D, WSP(float, WS_SBD) + (size_t)le * D + 64 * nb, lds, tid);
}
__device__ __forceinline__ void conv_claim(PK P, LAS unsigned char* lds, int L, int quota, int tid) {
    LAS int* slot = (LAS int*)(lds + MISC_OFF + M_CVB);
    unsigned* ctr = WSP(unsigned, WS_CTL) + CW_CV + L * 16;
    for (int q = 0; q < quota; ++q) {
        __syncthreads();
        if (tid == 0) *slot = (int)__hip_atomic_fetch_add(ctr, 1u, __ATOMIC_RELAXED, __HIP_MEMORY_SCOPE_AGENT);
        __syncthreads();
        const int sl = __builtin_amdgcn_readfirstlane(*slot);
        if (sl >= CV_SLOTS) break;
        conv_slot(P, lds, L, sl, tid);
    }
    __syncthreads();
}
__device__ __forceinline__ void phase_prologue(PK P, LAS unsigned char* lds, int bid, int tid) {
    const int lane = tid & 63, wid = __builtin_amdgcn_readfirstlane(tid >> 6);
    {
        LAS float* S = (LAS float*)lds; LAS float* red = (LAS float*)(lds + 40960);
        for (int idx = tid; idx < 9 * D; idx += 512) { const int r = idx >> 10, d = idx & (D - 1); const float v = r < 8 ? P->in[1][r * D + d] : P->in[3][d];
            S[idx] = v / (1.0f + __builtin_amdgcn_exp2f(-v * LOG2E)); }
        __syncthreads();
        const int l = bid >> 6, c0 = (bid & 63) * 96;
        if (lane < 48) {
            float acc[9][2];
#pragma unroll
            for (int r = 0; r < 9; ++r) { acc[r][0] = 0.f; acc[r][1] = 0.f; }
            const float* wp = P->in[4] + ((size_t)l * D + 128 * wid) * 6144 + c0 + 2 * lane;
            const LAS float* sp = S + 128 * wid;
            for (int kb = 0; kb < 128; kb += 32) {
                f32x2 w[32];
#pragma unroll
                for (int k = 0; k < 32; ++k) w[k] = __builtin_nontemporal_load((const f32x2*)(wp + (size_t)(kb + k) * 6144));
#pragma unroll
                for (int k = 0; k < 32; ++k)
#pragma unroll
                    for (int r = 0; r < 9; ++r) { const float s = sp[r * D + kb + k]; acc[r][0] += s * w[k][0]; acc[r][1] += s * w[k][1]; } }
#pragma unroll
            for (int r = 0; r < 9; ++r) { red[(wid * 9 + r) * 96 + 2 * lane] = acc[r][0]; red[(wid * 9 + r) * 96 + 2 * lane + 1] = acc[r][1]; }
        }
        __syncthreads();
        float* MOD = WSP(float, WS_MOD);
        for (int idx = tid; idx < 9 * 96; idx += 512) { const int r = idx / 96, cc = idx % 96; float s = 0.f;
#pragma unroll
            for (int w = 0; w < 8; ++w) s += red[(w * 9 + r) * 96 + cc];
            MOD[((size_t)l * 9 + r) * 6144 + c0 + cc] = s + P->in[5][(size_t)l * 6144 + c0 + cc]; }
        __syncthreads();
    }
    {
        const int gt = bid * 512 + tid; float* RA = WSP(float, WS_ROPE_A); float* RC = WSP(float, WS_ROPE_C);
        const float L2T = 13.287712379549449f;
        for (int idx = gt; idx < SEQ * 32; idx += 131072) { const int t = idx >> 5, i = idx & 31; const float pos = (float)(i < 16 ? (t >> 6) : (t & 63));
            const float inv = __builtin_amdgcn_exp2f(-(float)(i & 15) * (1.0f / 16.0f) * L2T); const float ang = pos * inv; RA[2 * idx] = __cosf(ang); RA[2 * idx + 1] = __sinf(ang); }
        for (int idx = gt; idx < SEQ * 16; idx += 131072) { const int t = idx >> 4, i = idx & 15; const float pos = (float)(i < 8 ? (t >> 6) : (t & 63));
            const float inv = __builtin_amdgcn_exp2f(-(float)(i & 7) * (1.0f / 8.0f) * L2T); const float ang = pos * inv; RC[2 * idx] = __cosf(ang); RC[2 * idx + 1] = __sinf(ang); }
        bf16_t* WU = WSP(bf16_t, WS_WC_UP); const u32x4 z = (u32x4){0u, 0u, 0u, 0u};
        for (int idx = gt; idx < 1536 * 16; idx += 131072) *(u32x4*)(WU + (size_t)(idx >> 4) * C_UPK + 256 + 8 * (idx & 15)) = z;
        for (int idx = gt; idx < 2048 * 32; idx += 131072) *(u32x4*)(WU + (size_t)(1536 + (idx >> 5)) * C_UPK + 8 * (idx & 31)) = z;
    }
    {
        LAS unsigned* scr = (LAS unsigned*)(lds + wid * 8192);
        const int gw = bid * 8 + wid;
        for (int item = gw; item < CV_SMALL; item += 2048) conv_dispatch(P, item, scr, lane);
        __syncthreads();
        for (int blk = bid; blk < 96; blk += 256) conv_in_block(P, lds, blk, tid);
        for (int sl = bid; sl < CV_SLOTS; sl += 256) conv_slot(P, lds, 0, sl, tid);
    }
}

constexpr int PH_PRO = 0, PH_N0 = 1, PH_L0 = 2, PH_PER_LAYER = 9, PH_FINAL = PH_L0 + DEPTH * PH_PER_LAYER, NPH = PH_FINAL + 1;
enum { LP_IN = 0, LP_MLANORM = 1, LP_MLAUP = 2, LP_ATT = 3, LP_OUT = 4, LP_RT = 5, LP_GU = 6, LP_DN = 7, LP_CB = 8 };
struct Args { Ptrs P; int p_lo, p_hi, bar_idx, pad; };

__global__ void __launch_bounds__(512, 2) mk_fwd(Args a) {
    extern __shared__ __attribute__((aligned(16))) unsigned char lds_raw[];
    LAS unsigned char* const lds = (LAS unsigned char*)lds_raw;
    LAS unsigned char* const misc = lds + MISC_OFF;
    typedef const __attribute__((address_space(4))) Args* ArgsK;
    const ArgsK ak = (ArgsK)__builtin_amdgcn_kernarg_segment_ptr();
    (void)a;
    const int wid0 = __builtin_amdgcn_readfirstlane((int)threadIdx.x >> 6);
    if (wid0 == 0 && lane_id() < 4) ((LAS unsigned*)(misc + M_BARW))[lane_id()] = 0u;
    __syncthreads();
    XcdBarrier bar;
    { PK P = &ak->P; bar = xcd_barrier_post(WSP(unsigned, WS_CTL) + CW_BAR + ak->bar_idx * XCD_BAR_WORDS, (volatile LAS unsigned*)(misc + M_BARW), wid0 == 0); }
    bool ran = false;
    const int p_lo = ak->p_lo, p_hi = ak->p_hi;
    int pcnt = 0; unsigned long long ts0 = 0ull, tsd = 0ull; (void)pcnt; (void)ts0; (void)tsd;
#define STAMP_HERE() do { if (MK_TIME_PHASE >= 0 && MK_TIME_PHASE < 1000) { if (pcnt == MK_TIME_PHASE) ts0 = __builtin_amdgcn_s_memrealtime(); if (pcnt == MK_TIME_PHASE + 1) tsd = __builtin_amdgcn_s_memrealtime() - ts0; ++pcnt; } } while (0)
#define PHASE_BEGIN(bit, p, cond) if ((((MK_MASK) >> (bit)) & 1) && p_lo <= (p) && (p) < p_hi && ((p) <= MK_STOP_AFTER || (p) == PH_FINAL) && (cond)) for (int rep_ = 0; rep_ < 1 + (((MK_REP_MASK) >> (bit)) & 1); ++rep_) { if (ran) xcd_barrier(bar); ran = true; STAMP_HERE(); \
    int tid = wid0 * 64 + lane_id(); asm volatile("" : "+v"(tid)); int bid = blockIdx.x; asm volatile("" : "+s"(bid)); ArgsK ak_ = ak; asm volatile("" : "+s"(ak_)); PK P = &ak_->P; \
    const int lane = tid & 63, wid = __builtin_amdgcn_readfirstlane(tid >> 6), vcu = (bid & 7) * 32 + (bid >> 3), gw = vcu * 8 + wid; (void)lane; (void)gw; (void)P;
#define PHASE_END }

    PHASE_BEGIN(0, PH_PRO, true) phase_prologue(P, lds, bid, tid); PHASE_END
    PHASE_BEGIN(1, PH_N0, true) phase_first_norm(P, lds, gw, tid); PHASE_END

    for (int l = 0; l < DEPTH; ++l) {
        const int kind = l % 3, slot = l / 3, pb = PH_L0 + l * PH_PER_LAYER;
        const bool last = (l == DEPTH - 1);
        const int nMrows = last ? NL / 256 : NT / 256;
        PHASE_BEGIN(2, pb + LP_IN, kind == 0) {
            pg8::Gemm g{WSP(const void, WS_H), WSP(const unsigned char, WS_WA_IN) + (size_t)slot * A_IN * D, D, 0, nullptr};
            pg8::DenseOrder S{nMrows, 6, vcu, last ? 8 : 0, 4, 2};
            pg8::EpiQkvA8 E{WSP(bf16_t, WS_QKV), WSP(const float, WS_ROPE_A), WSP(const float, WS_SAH), WSP(const float, WS_SBI) + slot * A_IN, (const LAS float*)(misc + M_EPF)};
            pg8::gemm_phase<pg8::EpiQkvA8, pg8::DenseOrder, false, true>(lds, g, S, E, tid);
            if (l >= 1 && S.short_one()) conv_claim(P, lds, l, MK_Q_IN, tid);
        } PHASE_END
        PHASE_BEGIN(3, pb + LP_IN, kind == 1) {
            pg8::Gemm g{WSP(const void, WS_H), WSP(const unsigned char, WS_WB_IN), D, 0, nullptr};
            pg8::DenseOrder S{NT / 256, 12, vcu, 0, 0, 0};
            pg8::EpiBf16Plain8 E{WSP(bf16_t, WS_QKV), B_IN, 4, 0.125f * LOG2E, WSP(const float, WS_SAH), WSP(const float, WS_SBI) + 2 * A_IN, (const LAS float*)(misc + M_EPF)};
            pg8::gemm_phase<pg8::EpiBf16Plain8, pg8::DenseOrder, false, true>(lds, g, S, E, tid);
            if (S.short_one()) conv_claim(P, lds, l, MK_Q_IN, tid);
        } PHASE_END
        PHASE_BEGIN(4, pb + LP_IN, kind == 2) {
            pg8::Gemm g{WSP(const bf16_t, WS_H), WSP(const bf16_t, WS_WC_IN), D, 0, nullptr};
            pg8::DenseOrder S{NT / 256, 2, vcu, 0, 0, 0};
            pg8::EpiF32Plain E{WSP(float, WS_Y416), C_INP};
            pg8::gemm_phase<pg8::EpiF32Plain, pg8::DenseOrder, false>(lds, g, S, E, tid);
            if (vcu >= 144) conv_claim(P, lds, l, 2 * MK_Q_ATT, tid);
        } PHASE_END
        PHASE_BEGIN(5, pb + LP_MLANORM, kind == 2) phase_mla_norm(P, gw, lane); PHASE_END
        PHASE_BEGIN(6, pb + LP_MLAUP, kind == 2) {
            pg8::Gemm g{WSP(const bf16_t, WS_CQKV), WSP(const bf16_t, WS_WC_UP), C_UPK, 0, nullptr};
            pg8::DenseOrder S{NT / 256, 14, vcu, 0, 0, 0};
            pg8::EpiMlaUp E{WSP(bf16_t, WS_QKV), WSP(const float, WS_ROPE_C)};
            pg8::gemm_phase<pg8::EpiMlaUp, pg8::DenseOrder, false>(lds, g, S, E, tid);
        } PHASE_END
        PHASE_BEGIN(7, pb + LP_ATT, kind == 0) {
            const bf16_t* QKV = WSP(const bf16_t, WS_QKV); bf16_t* O = WSP(bf16_t, WS_O); const float* sink = P->in[11] + slot * 16;
            for (int u = vcu, k = 0; u < 1024; u += 256, ++k) { int t_ = wid0 * 64 + lane_id(); asm volatile("" : "+v"(t_)); const int bk = u >> 5; att::attn_A_unit(lds, QKV, O, sink, bk >> 2, bk & 3, u & 31, false, t_);
                if (MK_Q_STAG > 0 && (vcu & 3) == k) conv_claim(P, lds, l >= 1 ? l : 1, MK_Q_STAG, t_); }
            if (!last) for (int u = vcu; u < 128; u += 256) { const int bk = u >> 2; att::attn_A_unit(lds, QKV, O, sink, bk >> 2, bk & 3, u & 3, true, tid); }
            if (!last && vcu >= 128) conv_claim(P, lds, l >= 1 ? l : 1, MK_Q_ATT, tid);
        } PHASE_END
        PHASE_BEGIN(8, pb + LP_ATT, kind == 1) {
            const bf16_t* QKV = WSP(const bf16_t, WS_QKV); bf16_t* O = WSP(bf16_t, WS_O); LAS float* tab = (LAS float*)(misc + M_RPB);
            for (int u = vcu, k = 0; u < 1024; u += 256, ++k) { int t_ = wid0 * 64 + lane_id(); asm volatile("" : "+v"(t_)); const int bh = u >> 3; att::attn_B_unit(lds, tab, QKV, O, P->in[14], bh >> 4, bh & 15, u & 7, false, t_);
                if (MK_Q_STAG > 0 && (vcu & 3) == k) conv_claim(P, lds, l, MK_Q_STAG, t_); }
            for (int u = vcu; u < 128; u += 256) att::attn_B_unit(lds, tab, QKV, O, P->in[14], u >> 4, u & 15, 0, true, tid);
            if (vcu >= 128) conv_claim(P, lds, l, MK_Q_ATT, tid);
        } PHASE_END
        PHASE_BEGIN(9, pb + LP_ATT, kind == 2) {
            const bf16_t* QKV = WSP(const bf16_t, WS_QKV); bf16_t* O = WSP(bf16_t, WS_O); const bf16_t* KR = WSP(const bf16_t, WS_KR);
            for (int u = vcu, k = 0; u < 1024; u += 256, ++k) { int t_ = wid0 * 64 + lane_id(); asm volatile("" : "+v"(t_)); const int bh = u >> 3; att::attn_C_unit(lds, QKV, KR, O, bh >> 4, bh & 15, u & 7, false, t_);
                if (MK_Q_STAG > 0 && (vcu & 3) == k) conv_claim(P, lds, l, MK_Q_STAG, t_); }
            for (int u = vcu; u < 128; u += 256) att::attn_C_unit(lds, QKV, KR, O, u >> 4, u & 15, 0, true, tid);
            if (vcu >= 128) conv_claim(P, lds, l, MK_Q_ATT, tid);
        } PHASE_END
        PHASE_BEGIN(10, pb + LP_OUT, true) {
            const bf16_t* W = kind == 0 ? WSP(const bf16_t, WS_WA_OUT) + (size_t)slot * D * D : (kind == 1 ? WSP(const bf16_t, WS_WB_OUT) : WSP(const bf16_t, WS_WC_OUT));
            pg8::Gemm g{WSP(const bf16_t, WS_O), W, D, 0, nullptr};
            pg8::DenseOrder S{nMrows, 4, vcu, 0, 0, 0};
            pg8::EpiResid E{(const LAS float*)(misc + M_EPF), WSP(bf16_t, WS_XS), WSP(const float, WS_MOD) + (size_t)l * 9 * 6144 + 2048, (rep_ + 1 < 1 + ((MK_REP_MASK >> 10) & 1)) ? WSP(bf16_t, WS_ACT) : WSP(bf16_t, WS_XS)};
            pg8::gemm_phase<pg8::EpiResid, pg8::DenseOrder, false>(lds, g, S, E, tid);
            if (!last && S.short_one()) conv_claim(P, lds, l + 1, MK_Q_OUT, tid);
        } PHASE_END
        PHASE_BEGIN(11, pb + LP_RT, true) { if (l >= 1) conv_claim(P, lds, l, 1 << 30, tid); phase_router(P, lds, l, last ? NL : NT, vcu, tid, rep_); } PHASE_END
        PHASE_BEGIN(12, pb + LP_GU, true) {
            moe_tables(misc, WSP(unsigned, WS_CTL) + CW_CNT + (l * 2 + ((MK_REP_MASK >> 11) & 1)) * 512, tid);
            pg8::Gemm g{WSP(const void, WS_H), WSP(const unsigned char, WS_WGU) + (size_t)l * NEXP * 2 * D * D, D, (size_t)2 * D * D, WSP(const int, WS_ELIST)};
            const int Ugu = __builtin_amdgcn_readfirstlane(((const LAS int*)(misc + M_CUMT))[32]) * 8, Rgu = (Ugu + 255) >> 8, Gmin = (Ugu + Rgu - 1) / (Rgu > 0 ? Rgu : 1);
            const int cpx = (!last && MK_CVW_GU > 0) ? ((256 - Gmin) >> 3) : 0;
            const bool cvw = (vcu & 31) >= 32 - cpx;
            const int Gc = 256 - 8 * cpx, ic = cvw ? -1 : vcu - cpx * (vcu >> 5);
            pg8::MoeOrder S{(const LAS int*)(misc + M_ECNT), (const LAS int*)(misc + M_LBASE), (const LAS int*)(misc + M_CUMT), 8, ic, Gc, (LAS int*)(misc + M_UL)}; S.build(tid);
            pg8::EpiSwiglu8 E{WSP(unsigned char, WS_ACT), WSP(float, WS_SBLK), P->in[24] + (size_t)l * NEXP * D, P->in[26] + (size_t)l * NEXP * D, WSP(const float, WS_SAL), WSP(const float, WS_SBW) + (size_t)l * NEXP * 2048, (const LAS float*)(misc + M_EPF)};
            pg8::gemm_phase<pg8::EpiSwiglu8, pg8::MoeOrder, true, true>(lds, g, S, E, tid);
            if (!last && (cvw || S.short_one())) conv_claim(P, lds, l + 1, cvw ? (Rgu * MK_CVW_GU) >> 1 : MK_Q_GU, tid);
        } PHASE_END
        PHASE_BEGIN(13, pb + LP_DN, true) {
            if (MK_PER_PHASE) moe_tables(misc, WSP(unsigned, WS_CTL) + CW_CNT + (l * 2 + ((MK_REP_MASK >> 11) & 1)) * 512, tid);
            if (MK_TIME_PHASE == 1000 + l) ts0 = __builtin_amdgcn_s_memrealtime();
            phase_requant(P, (const LAS int*)(misc + M_CUMT), gw, lane);
            xcd_barrier(bar);
            if (MK_TIME_PHASE == 1000 + l) tsd = __builtin_amdgcn_s_memrealtime() - ts0;
            const int Udn = __builtin_amdgcn_readfirstlane(((const LAS int*)(misc + M_CUMT))[32]) * 4, Rdn = (Udn + 255) >> 8, Gmin = (Udn + Rdn - 1) / (Rdn > 0 ? Rdn : 1);
            const int cpx = (!last && MK_CVW_DN > 0) ? ((256 - Gmin) >> 3) : 0;
            const bool cvw = (vcu & 31) >= 32 - cpx;
            const int Gc = 256 - 8 * cpx, ic = cvw ? -1 : vcu - cpx * (vcu >> 5);
            pg8::Gemm g{WSP(const void, WS_ACT8), WSP(const unsigned char, WS_WD) + (size_t)l * NEXP * D * D, D, (size_t)D * D, nullptr};
            pg8::MoeOrder S{(const LAS int*)(misc + M_ECNT), (const LAS int*)(misc + M_LBASE), (const LAS int*)(misc + M_CUMT), 4, ic, Gc, (LAS int*)(misc + M_UL)}; S.build(tid);
            pg8::EpiDown8 E{WSP(unsigned char, WS_YS), WSP(float, WS_YSB), P->in[28] + (size_t)l * NEXP * D, WSP(const float, WS_SAQ), WSP(const float, WS_SBD) + (size_t)l * NEXP * D, (const LAS float*)(misc + M_EPF)};
            pg8::gemm_phase<pg8::EpiDown8, pg8::MoeOrder, false, true>(lds, g, S, E, tid);
            if (!last && (cvw || S.short_one())) conv_claim(P, lds, l + 1, cvw ? (Rdn * MK_CVW_DN) >> 1 : MK_Q_DN, tid);
        } PHASE_END
        PHASE_BEGIN(14, pb + LP_CB, true) phase_combine(P, lds, l, last ? NL : NT, gw, tid, (rep_ + 1 < 1 + ((MK_REP_MASK >> 14) & 1))); PHASE_END
    }
    PHASE_BEGIN(15, PH_FINAL, MK_STOP_AFTER < PH_FINAL - 1) phase_final_norm(P, gw, lane); PHASE_END
    if (MK_TIME_PHASE >= 0) {
        xcd_barrier(bar); STAMP_HERE();
        ArgsK ak_ = ak; PK P = &ak_->P; unsigned* tw = WSP(unsigned, WS_CTL) + 300;
        if (blockIdx.x == 0 && wid0 == 0 && lane_id() == 0) __hip_atomic_store(tw, (unsigned)tsd, __ATOMIC_RELAXED, __HIP_MEMORY_SCOPE_AGENT);
        xcd_barrier(bar);
        const float us = (float)__hip_atomic_load(tw, __ATOMIC_RELAXED, __HIP_MEMORY_SCOPE_AGENT) * 0.01f; const float sv = log2f(fmaxf(us, 1.0f));
        const int gt = blockIdx.x * 512 + wid0 * 64 + lane_id();
        for (int i = gt; i < NL * D / 4; i += 131072) ((f32x4*)P->out)[i] = (f32x4){sv, sv, sv, sv};
    }
#undef PHASE_BEGIN
#undef PHASE_END
}

extern "C" void kernel_launch(void* const* d_in, const int* in_sizes, int n_in, void* d_out, int out_size, void* d_ws, size_t ws_size, hipStream_t stream) {
    static int grid = 0;
    if (grid == 0) {
        if (n_in != 29 || out_size != NL * D || ws_size < WS_END) { fprintf(stderr, "kernel_launch: expected 29 inputs, out %d, ws >= %zu; got n_in %d out %d ws %zu\n", NL * D, (size_t)WS_END, n_in, out_size, ws_size); grid = -1; return; }
        int dev = 0, cus = 0, per_cu = 0;
        if (hipGetDevice(&dev) != hipSuccess || hipDeviceGetAttribute(&cus, hipDeviceAttributeMultiprocessorCount, dev) != hipSuccess) { grid = -1; return; }
        if (hipFuncSetAttribute((const void*)mk_fwd, hipFuncAttributeMaxDynamicSharedMemorySize, LDS_BYTES) != hipSuccess) { fprintf(stderr, "kernel_launch: hipFuncSetAttribute failed\n"); grid = -1; return; }
        if (hipOccupancyMaxActiveBlocksPerMultiprocessor(&per_cu, (const void*)mk_fwd, 512, LDS_BYTES) != hipSuccess || per_cu < 1) fprintf(stderr, "kernel_launch: occupancy query says %d\n", per_cu);
        (void)hipGetLastError();
        grid = 256;
        if (cus < 256) { fprintf(stderr, "kernel_launch: needs 256 CUs, device has %d\n", cus); grid = -1; return; }
    }
    if (grid < 0) return;
    if (hipMemsetAsync((char*)d_ws + WS_CTL, 0, CTL_BYTES, stream) != hipSuccess) return;
    Args a{};
    for (int i = 0; i < 29; ++i) a.P.in[i] = (const float*)d_in[i];
    a.P.out = (float*)d_out; a.P.ws = (unsigned char*)d_ws; a.pad = 0;
#if MK_PER_PHASE
    for (int p = 0; p < NPH; ++p) { a.p_lo = p; a.p_hi = p + 1; a.bar_idx = 0; hipLaunchKernelGGL(mk_fwd, dim3(grid), dim3(512), LDS_BYTES, stream, a); }
#else
    a.p_lo = 0; a.p_hi = NPH; a.bar_idx = 0;
    hipLaunchKernelGGL(mk_fwd, dim3(grid), dim3(512), LDS_BYTES, stream, a);
#endif
    const hipError_t le = hipPeekAtLastError();
    if (le != hipSuccess) fprintf(stderr, "kernel_launch: launch failed: %s\n", hipGetErrorName(le));
}
```

```cpp
#include <hip/hip_runtime.h>
#include <cstdio>
#include <cstdint>

#ifndef MK_PER_PHASE
#define MK_PER_PHASE 0
#endif
#ifndef MK_MASK
#define MK_MASK 0xFFFF
#endif
#ifndef MK_REP_MASK
#define MK_REP_MASK 0
#endif
#ifndef MK_Q_OUT
#define MK_Q_OUT 1
#endif
#ifndef MK_Q_GU
#define MK_Q_GU 1
#endif
#ifndef MK_Q_DN
#define MK_Q_DN 1
#endif
#ifndef MK_Q_IN
#define MK_Q_IN 1
#endif
#ifndef MK_MT_MAJOR
#define MK_MT_MAJOR 1
#endif
#ifndef MK_Q_ATT
#define MK_Q_ATT 1
#endif
#ifndef MK_OSUM_MFMA
#define MK_OSUM_MFMA 0
#endif
#ifndef MK_Q_STAG
#define MK_Q_STAG 1
#endif
#ifndef MK_EPI2
#define MK_EPI2 0
#endif
#ifndef MK_ATT_STAGGER
#define MK_ATT_STAGGER 3
#endif
#ifndef MK_CVW_GU
#define MK_CVW_GU 0
#endif
#ifndef MK_CVW_DN
#define MK_CVW_DN 0
#endif
#ifndef MK_TIME_PHASE
#define MK_TIME_PHASE -1
#endif
#ifndef MK_STOP_AFTER
#define MK_STOP_AFTER 9999
#endif

#define LAS __attribute__((address_space(3)))
#define GAS __attribute__((address_space(1)))
typedef unsigned short bf16_t;
typedef short bf16x8 __attribute__((ext_vector_type(8)));
typedef short s16x4 __attribute__((ext_vector_type(4)));
typedef _Float16 f16x8 __attribute__((ext_vector_type(8)));
typedef _Float16 f16x2 __attribute__((ext_vector_type(2)));
typedef float f32x2 __attribute__((ext_vector_type(2)));
typedef float f32x4 __attribute__((ext_vector_type(4)));
typedef float f32x16 __attribute__((ext_vector_type(16)));
typedef unsigned u32x2 __attribute__((ext_vector_type(2)));
typedef unsigned u32x4 __attribute__((ext_vector_type(4)));
typedef int i32x4 __attribute__((ext_vector_type(4)));

constexpr int D = 1024, NB = 8, SEQ = 2048, CTXL = 256, DEPTH = 4;
constexpr int NL = NB * SEQ;
constexpr int NC = NB * CTXL;
constexpr int NT = NL + NC;
constexpr int NEXP = 32, TOPK = 4;
constexpr int MAXSLOT = 81920;
constexpr float NORM_EPS = 1e-6f;
constexpr float LOG2E = 1.4426950408889634f;
constexpr int A_IN = 1536, B_IN = 3072, C_IN = 416, C_INP = 512, C_UPK = 384, C_UPN = 3584;

constexpr size_t MiB = 1u << 20;
constexpr size_t WS_CTL = 0, CTL_BYTES = 1 * MiB;
constexpr size_t WS_MOD = 1 * MiB;
constexpr size_t WS_ROPE_A = 2 * MiB;
constexpr size_t WS_ROPE_C = 2 * MiB + 512 * 1024;
constexpr size_t WS_TOPE = 3 * MiB;
constexpr size_t WS_POS = 3 * MiB + 512 * 1024;
constexpr size_t WS_GATE = 4 * MiB;
constexpr size_t WS_ELIST = 5 * MiB;
constexpr size_t WS_KR = 8 * MiB;
constexpr size_t WS_CQKV = 10 * MiB;
constexpr size_t WS_Y416 = 24 * MiB;
constexpr size_t WS_XS = 60 * MiB;
constexpr size_t WS_H = 132 * MiB;
constexpr size_t WS_O = 168 * MiB;
constexpr size_t WS_QKV = 204 * MiB;
constexpr size_t WS_ACT = 330 * MiB;
constexpr size_t WS_SBLK = 426 * MiB;
constexpr size_t WS_YS = 490 * MiB;
constexpr size_t WS_YSB = 586 * MiB;
constexpr size_t WS_WA_IN = 650 * MiB;
constexpr size_t WS_WA_OUT = 656 * MiB;
constexpr size_t WS_WB_IN = 660 * MiB;
constexpr size_t WS_WB_OUT = 666 * MiB;
constexpr size_t WS_WC_IN = 668 * MiB;
constexpr size_t WS_WC_UP = 669 * MiB;
constexpr size_t WS_WC_OUT = 672 * MiB;
constexpr size_t WS_WGU = 676 * MiB;
constexpr size_t WS_WD = 1188 * MiB;
constexpr size_t WS_G16 = 1444 * MiB;
constexpr size_t WS_RC = 1447 * MiB;
constexpr size_t WS_SBW = 1448 * MiB;
constexpr size_t WS_SAL = 1449 * MiB;
constexpr size_t WS_SAH = 1452 * MiB;
constexpr size_t WS_SBI = 1452 * MiB + 128 * 1024;
constexpr size_t WS_ACT8 = 1453 * MiB;
constexpr size_t WS_SAQ = 1533 * MiB;
constexpr size_t WS_SBD = 1533 * MiB + 512 * 1024;
constexpr size_t WS_END = 1535 * MiB;

constexpr int CW_CV = 512;
constexpr int CW_CNT = 1024;
constexpr int CW_BAR = 65536;

constexpr int RING_BYTES = 131072;
constexpr int MISC_OFF = RING_BYTES;
constexpr int M_BARW = 0, M_LCNT = 64, M_LBASE = 192, M_CUMT = 320, M_ECNT = 512, M_GBASE = 640, M_CVB = 768, M_UL = 6656, M_RSA = 7424, M_EPF = 8192, M_RPB = 1024, M_REC = 3072;
constexpr int LDS_BYTES = 147456;

#define XB_TMO      128
#define XB_XCNT(j)  (256  + 64 * (j))
#define XB_XSUB(j)  (1280 + 64 * (j))
#define XB_XGEN(j)  (2304 + 64 * (j))
#define XB_TOP      3328
#define XB_TOPGEN   3392
#define XCD_BAR_WORDS 3456
#define XB_SPIN_CAP (1u << 18)

__device__ __forceinline__ unsigned xb_ld(unsigned* p)              { return __hip_atomic_load(p, __ATOMIC_RELAXED, __HIP_MEMORY_SCOPE_AGENT); }
__device__ __forceinline__ unsigned xb_add(unsigned* p, unsigned v) { return __hip_atomic_fetch_add(p, v, __ATOMIC_RELAXED, __HIP_MEMORY_SCOPE_AGENT); }
__device__ __forceinline__ unsigned xb_xcc_id() { return (unsigned)__builtin_amdgcn_s_getreg((3 << 11) | 20) & 0xFu; }
#define XB_SPIN(cond, bar) do { unsigned _sp = 0; while (cond) { __builtin_amdgcn_s_sleep(1); \
    if ((++_sp & 255u) == 0u) { if (xb_ld(&(bar)[XB_TMO])) break; if (_sp > XB_SPIN_CAP) { atomicAdd(&(bar)[XB_TMO], 1u); break; } } } } while (0)

__device__ __forceinline__ int lane_id() { int r; asm volatile("v_mbcnt_lo_u32_b32 %0, -1, 0\n\tv_mbcnt_hi_u32_b32 %0, -1, %0" : "=v"(r)); return r; }
struct XcdBarrier {
    unsigned* bar; unsigned x;
    volatile LAS unsigned* st;
    bool lead;
};
__device__ __forceinline__ XcdBarrier xcd_barrier_post(unsigned* bar, volatile LAS unsigned* st, bool lead) {
    XcdBarrier b; b.bar = bar; b.x = xb_xcc_id(); b.st = st; b.lead = lead;
    if (lead && lane_id() == 0) (void)xb_add(&bar[XB_XCNT(b.x)], 1u);
    return b;
}
__device__ __forceinline__ void xcd_barrier_complete(unsigned* bar, unsigned x, unsigned& nloc, unsigned& nx) {
    const unsigned G = gridDim.x * gridDim.y * gridDim.z;
    unsigned sum, cnt, mine, sp = 0u;
    for (;;) {
        sum = 0u; cnt = 0u; mine = 0u;
#pragma unroll
        for (unsigned j = 0; j < 16; ++j) { const unsigned c = xb_ld(&bar[XB_XCNT(j)]); sum += c; cnt += (c > 0u) ? 1u : 0u; mine = (j == x) ? c : mine; }
        if (sum == G) break;
        __builtin_amdgcn_s_sleep(1);
        if ((++sp & 255u) == 0u) { if (xb_ld(&bar[XB_TMO])) break; if (sp > XB_SPIN_CAP) { atomicAdd(&bar[XB_TMO], 1u); break; } }
    }
    nloc = mine > 0u ? mine : 1u; nx = cnt > 0u ? cnt : 1u;
}
__device__ __forceinline__ void xcd_barrier(const XcdBarrier& b) {
    asm volatile("s_waitcnt vmcnt(0)" ::: "memory");
    __syncthreads();
    if (b.lead && lane_id() == 0) {
        unsigned* bar = b.bar;
        __builtin_amdgcn_s_waitcnt(0);
        unsigned nloc = b.st[0], nx = b.st[1];
        if (nloc == 0u) { xcd_barrier_complete(bar, b.x, nloc, nx); b.st[0] = nloc; b.st[1] = nx; }
        const unsigned old = xb_add(&bar[XB_XSUB(b.x)], 1u);
        const unsigned gen = old / nloc;
        if (old + 1u == (gen + 1u) * nloc) {
            __builtin_amdgcn_fence(__ATOMIC_RELEASE, "agent");
            asm volatile("s_waitcnt vmcnt(0)" ::: "memory");
            const unsigned og = xb_add(&bar[XB_TOP], 1u);
            const unsigned tg = og / nx;
            if (og + 1u == (tg + 1u) * nx) xb_add(&bar[XB_TOPGEN], 1u);
            else XB_SPIN(xb_ld(&bar[XB_TOPGEN]) == tg, bar);
            __builtin_amdgcn_fence(__ATOMIC_ACQUIRE, "agent");
            xb_add(&bar[XB_XGEN(b.x)], 1u);
            asm volatile("s_waitcnt vmcnt(0)" ::: "memory");
        } else {
            XB_SPIN(xb_ld(&bar[XB_XGEN(b.x)]) == gen, bar);
            __builtin_amdgcn_fence(__ATOMIC_ACQUIRE, "agent");
            asm volatile("s_waitcnt vmcnt(0)" ::: "memory");
        }
    }
    __syncthreads();
}

__device__ __forceinline__ unsigned cvt_pk_bf16(float lo, float hi) { unsigned r; asm volatile("v_cvt_pk_bf16_f32 %0, %1, %2" : "=v"(r) : "v"(lo), "v"(hi)); return r; }
__device__ __forceinline__ float bf_lo(unsigned w) { return __uint_as_float(w << 16); }
__device__ __forceinline__ float bf_hi(unsigned w) { return __uint_as_float(w & 0xffff0000u); }
__device__ __forceinline__ float shx(float v, int mask, int lane) { return __int_as_float(__builtin_amdgcn_ds_bpermute((lane ^ mask) << 2, __float_as_int(v))); }
__device__ __forceinline__ float wave_sum(float v, int lane) {
#pragma unroll
    for (int o = 1; o < 64; o <<= 1) v += shx(v, o, lane);
    return v;
}
__device__ __forceinline__ float wave_max(float v, int lane) {
#pragma unroll
    for (int o = 1; o < 64; o <<= 1) v = fmaxf(v, shx(v, o, lane));
    return v;
}
__device__ __forceinline__ float swap32_max(float m) { auto rr = __builtin_amdgcn_permlane32_swap(__float_as_uint(m), __float_as_uint(m), false, false); return fmaxf(__uint_as_float(rr[0]), __uint_as_float(rr[1])); }
__device__ __forceinline__ float swap16_max(float m) { auto rr = __builtin_amdgcn_permlane16_swap(__float_as_uint(m), __float_as_uint(m), false, false); return fmaxf(__uint_as_float(rr[0]), __uint_as_float(rr[1])); }
__device__ __forceinline__ float swap32_sum(float m) { auto rr = __builtin_amdgcn_permlane32_swap(__float_as_uint(m), __float_as_uint(m), false, false); return __uint_as_float(rr[0]) + __uint_as_float(rr[1]); }

namespace pg8 {
constexpr int BM = 256, BK = 64, HALF = 128, HTB = HALF * BK * 2, STAGE_BYTES = 8 * HTB;
__host__ __device__ __forceinline__ int lds_byte(int r, int c) { const int st = (r >> 4) * 2 + (c >> 5), rr = r & 15, cc = c & 31, ob = rr * 64 + cc * 2; return st * 1024 + (ob ^ (((ob >> 9) & 1) << 5)); }
__host__ __device__ __forceinline__ void stage_rc(int b, int& R, int& C) { const int st = b / 1024, sb = b % 1024, swz = sb ^ (((sb >> 9) & 1) << 5); R = (st >> 1) * 16 + swz / 64; C = (st & 1) * 32 + (swz % 64) / 2; }
__host__ __device__ __forceinline__ int perm32(int rho) { const int n = rho >> 4, i = rho & 15; return 8 * (i >> 2) + 4 * n + (i & 3); }

struct Unit { int pm, pn, e, mt, cnt; };
struct Gemm { const void* A; const void* Bt; int K; size_t bstride; const int* list; };

template <bool I8> struct AccSel { typedef f32x4 type; };
template <> struct AccSel<true> { typedef i32x4 type; };
template <class Epi, class Sched, bool GATHER, bool I8 = false>
__device__ __forceinline__ void gemm_phase(LAS unsigned char* lds, const Gemm g, const Sched& S, const Epi& E, const int tid) {
    const int wid = __builtin_amdgcn_readfirstlane(tid >> 6), lane = tid & 63, wr = wid >> 2, wc = wid & 3, fr = lane & 15, fq = lane >> 4;
    typedef typename AccSel<I8>::type acc_t;
    const int K = g.K, RB = I8 ? K : 2 * K, nt = RB / (BK * 2);
    unsigned voffA[2], voffB[2];
#pragma unroll
    for (int i = 0; i < 2; ++i) { int R, C; stage_rc(tid * 16 + i * 8192, R, C); const int Rb = Epi::PERM ? ((R & ~31) + perm32(R & 31)) : R;
        voffA[i] = (unsigned)(R * RB + C * 2); voffB[i] = (unsigned)(Rb * RB + C * 2); }
#define PG8_RC(i, R_, C_) int R_, C_; { int _t = tid; asm volatile("" : "+v"(_t)); stage_rc(_t * 16 + (i) * 8192, R_, C_); }
    const size_t kstep = (size_t)(BK * 2);
    const size_t hstep = (size_t)HALF * RB;
    const size_t tstep = 2 * hstep;
    const unsigned ldsw = (unsigned)wid * 1024u;
    const int aoff = lds_byte(wr * 64 + fr, fq * 8), boff = lds_byte(wc * 32 + fr, fq * 8);
#define PG8_SA(b, h) (((b) * 2 + (h)) * HTB)
#define PG8_SB(b, h) ((4 + (b) * 2 + (h)) * HTB)
#define PG8_STAGE(bufoff, gbase, voff) do { _Pragma("unroll") for (int _i = 0; _i < 2; ++_i) \
        __builtin_amdgcn_global_load_lds((const unsigned*)((const char*)(gbase) + (voff)[_i]), (LAS unsigned*)(lds + (bufoff) + ldsw + _i * 8192), 16, 0, 0); } while (0)
#define PG8_STAGE_A(bufoff, SELN, H, KOFF) do { if constexpr (GATHER) { unsigned _vo[2]; _vo[0] = (SELN) ? voN[H][0] : voC[H][0]; _vo[1] = (SELN) ? voN[H][1] : voC[H][1]; \
            PG8_STAGE(bufoff, (const char*)g.A + (KOFF), _vo); } else { PG8_STAGE(bufoff, ((SELN) ? nA : cA) + (H) * hstep + (KOFF), voffA); } } while (0)
#define PG8_LDA(dst, b, h) do { _Pragma("unroll") for (int m = 0; m < 4; ++m) _Pragma("unroll") for (int k = 0; k < 2; ++k) dst[m][k] = *(const LAS bf16x8*)(lds + PG8_SA(b, h) + aoff + m * 2048 + k * 1024); } while (0)
#define PG8_LDB(dst, b, h) do { _Pragma("unroll") for (int n = 0; n < 2; ++n) _Pragma("unroll") for (int k = 0; k < 2; ++k) dst[n][k] = *(const LAS bf16x8*)(lds + PG8_SB(b, h) + boff + n * 2048 + k * 1024); } while (0)
#define PG8_MMA(ai, bj, At, Bt) do { __builtin_amdgcn_s_setprio(1); _Pragma("unroll") for (int m = 0; m < 4; ++m) _Pragma("unroll") for (int n = 0; n < 2; ++n) _Pragma("unroll") for (int k = 0; k < 2; ++k) \
        { if constexpr (I8) acc[ai][bj][m][n] = __builtin_amdgcn_mfma_i32_16x16x64_i8(__builtin_bit_cast(i32x4, Bt[n][k]), __builtin_bit_cast(i32x4, At[m][k]), acc[ai][bj][m][n], 0, 0, 0); \
          else acc[ai][bj][m][n] = __builtin_amdgcn_mfma_f32_16x16x32_bf16(Bt[n][k], At[m][k], acc[ai][bj][m][n], 0, 0, 0); } __builtin_amdgcn_s_setprio(0); } while (0)
#define PG8_WAIT_V(n) asm volatile("s_waitcnt vmcnt(" #n ")" ::: "memory")
#define PG8_WAIT_L(n) asm volatile("s_waitcnt lgkmcnt(" #n ")" ::: "memory")
#define PG8_BAR __builtin_amdgcn_s_barrier()
#define PG8_SCHED __builtin_amdgcn_sched_barrier(0)
#define PG8_GATH(U, VO) do { _Pragma("unroll") for (int _h = 0; _h < 2; ++_h) _Pragma("unroll") for (int _i = 0; _i < 2; ++_i) { \
        PG8_RC(_i, _R, _C); int _r = (U).mt * 256 + _h * 128 + _R; _r = _r < (U).cnt ? _r : 0; const int _tok = g.list[(size_t)(U).e * NT + _r]; VO[_h][_i] = (unsigned)(_tok * RB + _C * 2); } } while (0)
    Unit cur, nxt; int ui = 0;
    if (!S.next(0, cur)) return;
    acc_t acc[2][2][4][2];
#pragma unroll
    for (int a = 0; a < 2; ++a)
#pragma unroll
        for (int b = 0; b < 2; ++b)
#pragma unroll
            for (int m = 0; m < 4; ++m)
#pragma unroll
                for (int n = 0; n < 2; ++n) acc[a][b][m][n] = (acc_t){0, 0, 0, 0};
    bf16x8 At[4][2], B0[2][2], B1[2][2];
    unsigned voC[2][2] = {{0u, 0u}, {0u, 0u}}, voN[2][2] = {{0u, 0u}, {0u, 0u}};
    if constexpr (GATHER) { PG8_GATH(cur, voC); }
    const char* cA = GATHER ? (const char*)g.A : (const char*)g.A + (size_t)cur.pm * tstep;
    const size_t bsb = I8 ? g.bstride : 2 * g.bstride;
    const char* cB = (const char*)g.Bt + (size_t)cur.e * bsb + (size_t)cur.pn * tstep;
    const char* nA = cA; const char* nB = cB;
    PG8_STAGE(PG8_SB(0, 0), cB, voffB); PG8_STAGE(PG8_SB(0, 1), cB + hstep, voffB); PG8_STAGE_A(PG8_SA(0, 0), false, 0, 0); PG8_STAGE_A(PG8_SA(0, 1), false, 1, 0);
    if (wr == 1) PG8_BAR;
    PG8_WAIT_V(2); PG8_BAR;
    PG8_STAGE(PG8_SB(1, 0), cB + kstep, voffB); PG8_STAGE_A(PG8_SA(1, 0), false, 0, kstep); PG8_STAGE(PG8_SB(1, 1), cB + hstep + kstep, voffB);
    PG8_WAIT_V(6); PG8_BAR;
    for (;;) {
        const bool has_next = S.next(ui + 1, nxt);
        nA = GATHER ? (const char*)g.A : (has_next ? (const char*)g.A + (size_t)nxt.pm * tstep : cA);
        nB = has_next ? (const char*)g.Bt + (size_t)nxt.e * bsb + (size_t)nxt.pn * tstep : cB;
        int tokN[2][2] = {{0, 0}, {0, 0}};
        if constexpr (GATHER) { if (has_next) {
#pragma unroll
            for (int _h = 0; _h < 2; ++_h)
#pragma unroll
                for (int _i = 0; _i < 2; ++_i) { PG8_RC(_i, _R, _C); (void)_C; int _r = nxt.mt * 256 + _h * 128 + _R; _r = _r < nxt.cnt ? _r : 0; const int* _p = g.list + (size_t)nxt.e * NT + _r;
                    asm volatile("global_load_dword %0, %1, off" : "=v"(tokN[_h][_i]) : "v"(_p) : "memory"); } } }
        unsigned epf[2] = {0u, 0u};
        if constexpr (Epi::PF > 0) {
#pragma unroll
            for (int _k = 0; _k < Epi::PF; ++_k) { const float* _p = E.pf_addr(cur, tid, _k); asm volatile("global_load_dword %0, %1, off" : "=v"(epf[_k]) : "v"(_p) : "memory"); } }
        for (int t = 0; t < nt; t += 2) {
            const bool last = (t == nt - 2);
            const size_t k1 = (size_t)(t + 1) * kstep;
            const size_t k2 = last ? 0 : (size_t)(t + 2) * kstep;
            const size_t k3 = k2 + kstep;
            const char* b2 = (last ? nB : cB) + k2; const char* b3 = b2 + kstep;
            PG8_LDB(B0, 0, 0); PG8_LDB(B1, 0, 1); PG8_SCHED; PG8_LDA(At, 0, 0); PG8_STAGE_A(PG8_SA(1, 1), false, 1, k1);
            PG8_WAIT_V(8); PG8_WAIT_L(0); PG8_BAR; PG8_MMA(0, 0, At, B0); PG8_MMA(0, 1, At, B1); PG8_BAR; PG8_SCHED;
            if constexpr (GATHER) { if (last) { if (has_next) {
                asm volatile("" : "+v"(tokN[0][0]), "+v"(tokN[0][1]), "+v"(tokN[1][0]), "+v"(tokN[1][1]));
                { PG8_RC(0, _R0, _C0); PG8_RC(1, _R1, _C1); (void)_R0; (void)_R1;
#pragma unroll
                for (int _h = 0; _h < 2; ++_h) { voN[_h][0] = (unsigned)(tokN[_h][0] * RB + _C0 * 2); voN[_h][1] = (unsigned)(tokN[_h][1] * RB + _C1 * 2); } } } else {
#pragma unroll
                for (int _h = 0; _h < 2; ++_h) { voN[_h][0] = voC[_h][0]; voN[_h][1] = voC[_h][1]; } } } }
            if constexpr (Epi::PF > 0) { if (last) { asm volatile("" : "+v"(epf[0]), "+v"(epf[1]));
#pragma unroll
                for (int _k = 0; _k < Epi::PF; ++_k) *(LAS unsigned*)(lds + MISC_OFF + M_EPF + (_k * 512 + tid) * 4) = epf[_k]; } }
            PG8_LDA(At, 0, 1); PG8_STAGE(PG8_SB(0, 0), b2, voffB); PG8_STAGE(PG8_SB(0, 1), b2 + hstep, voffB); PG8_STAGE_A(PG8_SA(0, 0), last, 0, k2);
            PG8_WAIT_V(8); PG8_WAIT_L(0); PG8_BAR; PG8_MMA(1, 0, At, B0); PG8_MMA(1, 1, At, B1); PG8_BAR; PG8_SCHED;
            PG8_LDB(B0, 1, 0); PG8_LDB(B1, 1, 1); PG8_SCHED; PG8_LDA(At, 1, 0); PG8_STAGE_A(PG8_SA(0, 1), last, 1, k2);
            PG8_WAIT_V(8); PG8_WAIT_L(0); PG8_BAR; PG8_MMA(0, 0, At, B0); PG8_MMA(0, 1, At, B1); PG8_BAR; PG8_SCHED;
            PG8_LDA(At, 1, 1); PG8_STAGE(PG8_SB(1, 0), b3, voffB); PG8_STAGE(PG8_SB(1, 1), b3 + hstep, voffB); PG8_STAGE_A(PG8_SA(1, 0), last, 0, k3);
            PG8_WAIT_V(8); PG8_WAIT_L(0); PG8_BAR; PG8_MMA(1, 0, At, B0); PG8_MMA(1, 1, At, B1); PG8_BAR; PG8_SCHED;
        }
        if (wr == 0) PG8_BAR;
        { const int ln_ = lane_id(); E(acc, cur, wr, wc, ln_ & 15, ln_ >> 4); }
        if constexpr (MK_EPI2 != 0) { if (Epi::PF == 2) { asm volatile("" ::: "memory"); const int ln_ = lane_id(); E(acc, cur, wr, wc, ln_ & 15, ln_ >> 4); } }
        if (!has_next) break;
#pragma unroll
        for (int a = 0; a < 2; ++a)
#pragma unroll
            for (int b = 0; b < 2; ++b)
#pragma unroll
                for (int m = 0; m < 4; ++m)
#pragma unroll
                    for (int n = 0; n < 2; ++n) acc[a][b][m][n] = (acc_t){0, 0, 0, 0};
        cur = nxt; cA = nA; cB = nB; ++ui;
        if constexpr (GATHER) {
#pragma unroll
            for (int _h = 0; _h < 2; ++_h) { voC[_h][0] = voN[_h][0]; voC[_h][1] = voN[_h][1]; } }
        if (wr == 1) PG8_BAR;
    }
    PG8_WAIT_V(0);
    PG8_BAR;
#undef PG8_SA
#undef PG8_SB
#undef PG8_STAGE
#undef PG8_STAGE_A
#undef PG8_LDA
#undef PG8_LDB
#undef PG8_MMA
#undef PG8_WAIT_V
#undef PG8_WAIT_L
#undef PG8_BAR
#undef PG8_SCHED
#undef PG8_GATH
#undef PG8_RC
}
}

namespace pg8 {
struct EpiBf16Plain {
    static constexpr bool PERM = true; static constexpr int PF = 0;
    bf16_t* O; int ldc; int qtiles; float qscale;
    __device__ __forceinline__ void operator()(const f32x4 (&acc)[2][2][4][2], const Unit& u, int wr, int wc, int fr, int fq) const {
        const int row0 = u.pm * BM + wr * 64 + fr, col0 = u.pn * BM + wc * 32 + 8 * fq;
        const float qs = u.pn < qtiles ? qscale : 1.0f;
#pragma unroll
        for (int ai = 0; ai < 2; ++ai)
#pragma unroll
            for (int m = 0; m < 4; ++m) { bf16_t* rowp = O + (size_t)(row0 + ai * HALF + m * 16) * ldc + col0;
#pragma unroll
                for (int bj = 0; bj < 2; ++bj) { const f32x4 v0 = acc[ai][bj][m][0] * qs, v1 = acc[ai][bj][m][1] * qs;
                    u32x4 w; w.x = cvt_pk_bf16(v0[0], v0[1]); w.y = cvt_pk_bf16(v0[2], v0[3]); w.z = cvt_pk_bf16(v1[0], v1[1]); w.w = cvt_pk_bf16(v1[2], v1[3]);
                    *(u32x4*)(rowp + bj * HALF) = w; } }
    }
};
struct EpiBf16Plain8 {
    static constexpr bool PERM = true; static constexpr int PF = 1;
    bf16_t* O; int ldc; int qtiles; float qscale; const float* sa; const float* sb; const LAS float* epf;
    __device__ __forceinline__ const float* pf_addr(const Unit& u, int tid, int) const { return tid < 256 ? sb + u.pn * BM + tid : sa + u.pm * BM + (tid - 256); }
    __device__ __forceinline__ void operator()(const i32x4 (&acc)[2][2][4][2], const Unit& u, int wr, int wc, int fr, int fq) const {
        const int row0 = u.pm * BM + wr * 64 + fr, col0 = u.pn * BM + wc * 32 + 8 * fq;
        const float qs = u.pn < qtiles ? qscale : 1.0f;
        f32x4 cs[2][2];
#pragma unroll
        for (int bj = 0; bj < 2; ++bj)
#pragma unroll
            for (int n = 0; n < 2; ++n) cs[bj][n] = *(const LAS f32x4*)(epf + wc * 32 + 8 * fq + bj * HALF + 4 * n) * qs;
#pragma unroll
        for (int ai = 0; ai < 2; ++ai)
#pragma unroll
            for (int m = 0; m < 4; ++m) { const int row = row0 + ai * HALF + m * 16; bf16_t* rowp = O + (size_t)row * ldc + col0; const float sr = epf[256 + wr * 64 + fr + ai * HALF + m * 16];
#pragma unroll
                for (int bj = 0; bj < 2; ++bj) { f32x4 v0, v1;
#pragma unroll
                    for (int j = 0; j < 4; ++j) { v0[j] = (float)acc[ai][bj][m][0][j]; v1[j] = (float)acc[ai][bj][m][1][j]; }
                    v0 = v0 * (cs[bj][0] * sr); v1 = v1 * (cs[bj][1] * sr);
                    u32x4 w; w.x = cvt_pk_bf16(v0[0], v0[1]); w.y = cvt_pk_bf16(v0[2], v0[3]); w.z = cvt_pk_bf16(v1[0], v1[1]); w.w = cvt_pk_bf16(v1[2], v1[3]);
                    *(u32x4*)(rowp + bj * HALF) = w; }
                asm volatile("" ::: "memory"); }
    }
};
struct EpiF32Plain {
    static constexpr bool PERM = false; static constexpr int PF = 0;
    float* C; int ldc;
    __device__ __forceinline__ void operator()(const f32x4 (&acc)[2][2][4][2], const Unit& u, int wr, int wc, int fr, int fq) const {
        const int row0 = u.pm * BM + wr * 64 + fr, col0 = u.pn * BM + wc * 32 + 4 * fq;
#pragma unroll
        for (int ai = 0; ai < 2; ++ai)
#pragma unroll
            for (int m = 0; m < 4; ++m) { float* rowp = C + (size_t)(row0 + ai * HALF + m * 16) * ldc + col0;
#pragma unroll
                for (int bj = 0; bj < 2; ++bj)
#pragma unroll
                    for (int n = 0; n < 2; ++n) *(f32x4*)(rowp + bj * HALF + n * 16) = acc[ai][bj][m][n]; }
    }
};
__device__ __forceinline__ void rope8(f32x4& v0, f32x4& v1, const float* cs) {
    const f32x4 a = *(const f32x4*)cs, b = *(const f32x4*)(cs + 4);
    const float x0 = v0[0], x1 = v0[1], x2 = v0[2], x3 = v0[3], y0 = v1[0], y1 = v1[1], y2 = v1[2], y3 = v1[3];
    v0[0] = x0 * a[0] - x1 * a[1]; v0[1] = x0 * a[1] + x1 * a[0];
    v0[2] = x2 * a[2] - x3 * a[3]; v0[3] = x2 * a[3] + x3 * a[2];
    v1[0] = y0 * b[0] - y1 * b[1]; v1[1] = y0 * b[1] + y1 * b[0];
    v1[2] = y2 * b[2] - y3 * b[3]; v1[3] = y2 * b[3] + y3 * b[2];
}
struct EpiQkvA {
    static constexpr bool PERM = true; static constexpr int PF = 0;
    bf16_t* O; const float* rope;
    __device__ __forceinline__ void operator()(const f32x4 (&acc)[2][2][4][2], const Unit& u, int wr, int wc, int fr, int fq) const {
        const int row0 = u.pm * BM + wr * 64 + fr, col0 = u.pn * BM + wc * 32 + 8 * fq;
        const bool do_rope = (u.pm < NL / 256) && (u.pn < 5);
        const float qs = u.pn < 4 ? 0.125f * LOG2E : 1.0f;
#pragma unroll
        for (int ai = 0; ai < 2; ++ai)
#pragma unroll
            for (int m = 0; m < 4; ++m) { const int row = row0 + ai * HALF + m * 16; bf16_t* rowp = O + (size_t)row * A_IN + col0;
#pragma unroll
                for (int bj = 0; bj < 2; ++bj) { f32x4 v0 = acc[ai][bj][m][0], v1 = acc[ai][bj][m][1];
                    if (do_rope) { const int d = (col0 + bj * HALF) & 63; rope8(v0, v1, rope + ((size_t)(row & (SEQ - 1)) * 32 + (d >> 1)) * 2); }
                    v0 = v0 * qs; v1 = v1 * qs;
                    u32x4 w; w.x = cvt_pk_bf16(v0[0], v0[1]); w.y = cvt_pk_bf16(v0[2], v0[3]); w.z = cvt_pk_bf16(v1[0], v1[1]); w.w = cvt_pk_bf16(v1[2], v1[3]);
                    *(u32x4*)(rowp + bj * HALF) = w; }
                asm volatile("" ::: "memory"); }
    }
};
struct EpiQkvA8 {
    static constexpr bool PERM = true; static constexpr int PF = 1;
    bf16_t* O; const float* rope; const float* sa; const float* sb; const LAS float* epf;
    __device__ __forceinline__ const float* pf_addr(const Unit& u, int tid, int) const { return tid < 256 ? sb + u.pn * BM + tid : sa + u.pm * BM + (tid - 256); }
    __device__ __forceinline__ void operator()(const i32x4 (&acc)[2][2][4][2], const Unit& u, int wr, int wc, int fr, int fq) const {
        const int row0 = u.pm * BM + wr * 64 + fr, col0 = u.pn * BM + wc * 32 + 8 * fq;
        const bool do_rope = (u.pm < NL / 256) && (u.pn < 5);
        const float qs = u.pn < 4 ? 0.125f * LOG2E : 1.0f;
        f32x4 cs[2][2];
#pragma unroll
        for (int bj = 0; bj < 2; ++bj)
#pragma unroll
            for (int n = 0; n < 2; ++n) cs[bj][n] = *(const LAS f32x4*)(epf + wc * 32 + 8 * fq + bj * HALF + 4 * n) * qs;
#pragma unroll
        for (int ai = 0; ai < 2; ++ai)
#pragma unroll
            for (int m = 0; m < 4; ++m) { const int row = row0 + ai * HALF + m * 16; bf16_t* rowp = O + (size_t)row * A_IN + col0; const float sr = epf[256 + wr * 64 + fr + ai * HALF + m * 16];
#pragma unroll
                for (int bj = 0; bj < 2; ++bj) { f32x4 v0, v1;
#pragma unroll
                    for (int j = 0; j < 4; ++j) { v0[j] = (float)acc[ai][bj][m][0][j]; v1[j] = (float)acc[ai][bj][m][1][j]; }
                    v0 = v0 * (cs[bj][0] * sr); v1 = v1 * (cs[bj][1] * sr);
                    if (do_rope) { const int d = (col0 + bj * HALF) & 63; rope8(v0, v1, rope + ((size_t)(row & (SEQ - 1)) * 32 + (d >> 1)) * 2); }
                    u32x4 w; w.x = cvt_pk_bf16(v0[0], v0[1]); w.y = cvt_pk_bf16(v0[2], v0[3]); w.z = cvt_pk_bf16(v1[0], v1[1]); w.w = cvt_pk_bf16(v1[2], v1[3]);
                    *(u32x4*)(rowp + bj * HALF) = w; }
                asm volatile("" ::: "memory"); }
    }
};
struct EpiMlaUp {
    static constexpr bool PERM = true; static constexpr int PF = 0;
    bf16_t* O; const float* rope;
    __device__ __forceinline__ void operator()(const f32x4 (&acc)[2][2][4][2], const Unit& u, int wr, int wc, int fr, int fq) const {
        const int row0 = u.pm * BM + wr * 64 + fr, col0 = u.pn * BM + wc * 32 + 8 * fq;
        const bool qtile = (u.pm < NL / 256) && (u.pn < 6);
        const float qs = u.pn < 6 ? 0.10206207261596575f * LOG2E : 1.0f;
#pragma unroll
        for (int ai = 0; ai < 2; ++ai)
#pragma unroll
            for (int m = 0; m < 4; ++m) { const int row = row0 + ai * HALF + m * 16; bf16_t* rowp = O + (size_t)row * C_UPN + col0;
#pragma unroll
                for (int bj = 0; bj < 2; ++bj) { f32x4 v0 = acc[ai][bj][m][0], v1 = acc[ai][bj][m][1];
                    const int d96 = (col0 + bj * HALF) % 96;
                    if (qtile && d96 >= 64) rope8(v0, v1, rope + ((size_t)(row & (SEQ - 1)) * 16 + ((d96 - 64) >> 1)) * 2);
                    v0 = v0 * qs; v1 = v1 * qs;
                    u32x4 w; w.x = cvt_pk_bf16(v0[0], v0[1]); w.y = cvt_pk_bf16(v0[2], v0[3]); w.z = cvt_pk_bf16(v1[0], v1[1]); w.w = cvt_pk_bf16(v1[2], v1[3]);
                    *(u32x4*)(rowp + bj * HALF) = w; }
                asm volatile("" ::: "memory"); }
    }
};
struct EpiResid {
    static constexpr bool PERM = false; static constexpr int PF = 1;
    const LAS float* epf;
    __device__ __forceinline__ const float* pf_addr(const Unit& u, int tid, int) const { return gmod + (size_t)(u.pm < NL / 256 ? (u.pm >> 3) : 8) * 6144 + u.pn * BM + (tid & 255); }
    bf16_t* XS; const float* gmod; bf16_t* XSo;
    __device__ __forceinline__ void operator()(const f32x4 (&acc)[2][2][4][2], const Unit& u, int wr, int wc, int fr, int fq) const {
        const int row0 = u.pm * BM + wr * 64 + fr, col0 = u.pn * BM + wc * 32 + 4 * fq;
        f32x4 gg[2][2];
#pragma unroll
        for (int bj = 0; bj < 2; ++bj)
#pragma unroll
            for (int n = 0; n < 2; ++n) gg[bj][n] = *(const LAS f32x4*)(epf + wc * 32 + 4 * fq + bj * HALF + n * 16);
#pragma unroll
        for (int ai = 0; ai < 2; ++ai)
#pragma unroll
            for (int m = 0; m < 4; ++m) { const size_t off = (size_t)(row0 + ai * HALF + m * 16) * D + col0;
#pragma unroll
                for (int bj = 0; bj < 2; ++bj)
#pragma unroll
                    for (int n = 0; n < 2; ++n) { const u32x2 w = *(const u32x2*)(XS + off + bj * HALF + n * 16);
                        const f32x4 v = (f32x4){bf_lo(w.x), bf_hi(w.x), bf_lo(w.y), bf_hi(w.y)} + gg[bj][n] * acc[ai][bj][m][n];
                        u32x2 o; o.x = cvt_pk_bf16(v[0], v[1]); o.y = cvt_pk_bf16(v[2], v[3]); *(u32x2*)(XSo + off + bj * HALF + n * 16) = o; } }
    }
};
struct EpiSwiglu {
    static constexpr bool PERM = true; static constexpr int PF = 0;
    bf16_t* ACT; const float* bg; const float* bu;
    __device__ __forceinline__ void operator()(const f32x4 (&acc)[2][2][4][2], const Unit& u, int wr, int wc, int fr, int fq) const {
        const int row0 = u.pm * BM + wr * 64 + fr, col0 = u.pn * HALF + wc * 32 + 8 * fq;
        const float* pg = bg + (size_t)u.e * D + col0; const float* pu = bu + (size_t)u.e * D + col0;
        const f32x4 g0 = *(const f32x4*)pg, g1 = *(const f32x4*)(pg + 4), u0 = *(const f32x4*)pu, u1 = *(const f32x4*)(pu + 4);
#pragma unroll
        for (int ai = 0; ai < 2; ++ai)
#pragma unroll
            for (int m = 0; m < 4; ++m) { bf16_t* rowp = ACT + (size_t)(row0 + ai * HALF + m * 16) * D + col0;
                float r[8];
#pragma unroll
                for (int n = 0; n < 2; ++n)
#pragma unroll
                    for (int j = 0; j < 4; ++j) {
                        float g = acc[ai][0][m][n][j] + (n ? g1[j] : g0[j]); float uu = acc[ai][1][m][n][j] + (n ? u1[j] : u0[j]);
                        g = fminf(g, 7.0f); uu = fminf(fmaxf(uu, -7.0f), 7.0f);
                        const float sg = __builtin_amdgcn_rcpf(1.0f + __builtin_amdgcn_exp2f(-1.702f * LOG2E * g));
                        r[n * 4 + j] = g * sg * (uu + 1.0f); }
                u32x4 w; w.x = cvt_pk_bf16(r[0], r[1]); w.y = cvt_pk_bf16(r[2], r[3]); w.z = cvt_pk_bf16(r[4], r[5]); w.w = cvt_pk_bf16(r[6], r[7]);
                *(u32x4*)rowp = w; }
    }
};
struct EpiSwiglu8 {
    static constexpr bool PERM = true; static constexpr int PF = 2;
    unsigned char* ACTQ; float* SBLK; const float* bg; const float* bu; const float* sal; const float* sbw; const LAS float* epf;
    __device__ __forceinline__ const float* pf_addr(const Unit& u, int tid, int k) const {
        if (k == 1) { const int t = tid & 255; return sal + (size_t)u.e * NT + ((u.mt * 256 + t) < u.cnt ? u.mt * 256 + t : u.mt * 256); }
        const int t = tid & 127;
        return tid < 128 ? bg + (size_t)u.e * D + u.pn * HALF + t : (tid < 256 ? bu + (size_t)u.e * D + u.pn * HALF + t : sbw + (size_t)u.e * 2048 + u.pn * BM + (tid < 384 ? 0 : HALF) + t); }
    __device__ __forceinline__ void operator()(const i32x4 (&acc)[2][2][4][2], const Unit& u, int wr, int wc, int fr, int fq) const {
        const int lr0 = wr * 64 + fr, row0 = u.pm * BM + lr0, col0 = u.pn * HALF + wc * 32 + 8 * fq;
        constexpr float K1 = 1.702f * LOG2E;
        f32x2 r[2][4][4];
#pragma unroll
        for (int n = 0; n < 2; ++n) {
            const LAS float* pe = epf + wc * 32 + 8 * fq + 4 * n;
            const f32x4 gb = *(const LAS f32x4*)pe * (-K1), ub = *(const LAS f32x4*)(pe + 128) + 1.0f, sg = *(const LAS f32x4*)(pe + 256) * (-K1), su = *(const LAS f32x4*)(pe + 384);
#pragma unroll
            for (int ai = 0; ai < 2; ++ai)
#pragma unroll
                for (int m = 0; m < 4; ++m) { const int lr = lr0 + ai * HALF + m * 16; const float sa_ = epf[512 + lr]; const f32x2 sa2 = {sa_, sa_};
#pragma unroll
                    for (int jp = 0; jp < 2; ++jp) {
                        const f32x2 ag = {(float)acc[ai][0][m][n][2 * jp], (float)acc[ai][0][m][n][2 * jp + 1]}, au = {(float)acc[ai][1][m][n][2 * jp], (float)acc[ai][1][m][n][2 * jp + 1]};
                        f32x2 h = (ag * (f32x2){sg[2 * jp], sg[2 * jp + 1]}) * sa2 + (f32x2){gb[2 * jp], gb[2 * jp + 1]};
                        f32x2 u1 = (au * (f32x2){su[2 * jp], su[2 * jp + 1]}) * sa2 + (f32x2){ub[2 * jp], ub[2 * jp + 1]};
                        h[0] = fmaxf(h[0], -7.0f * K1); h[1] = fmaxf(h[1], -7.0f * K1);
                        u1[0] = __builtin_amdgcn_fmed3f(u1[0], -6.0f, 8.0f); u1[1] = __builtin_amdgcn_fmed3f(u1[1], -6.0f, 8.0f);
                        const f32x2 e = {__builtin_amdgcn_exp2f(h[0]), __builtin_amdgcn_exp2f(h[1])};
                        const f32x2 d = e * (f32x2){-K1, -K1} + (f32x2){-K1, -K1};
                        const f32x2 rc = {__builtin_amdgcn_rcpf(d[0]), __builtin_amdgcn_rcpf(d[1])};
                        r[ai][m][2 * n + jp] = (h * u1) * rc; } }
        }
        float ams[8];
#pragma unroll
        for (int ai = 0; ai < 2; ++ai)
#pragma unroll
            for (int m = 0; m < 4; ++m) {
                float am = fmaxf(fmaxf(fmaxf(fabsf(r[ai][m][0][0]), fabsf(r[ai][m][0][1])), fmaxf(fabsf(r[ai][m][1][0]), fabsf(r[ai][m][1][1]))), fmaxf(fmaxf(fabsf(r[ai][m][2][0]), fabsf(r[ai][m][2][1])), fmaxf(fabsf(r[ai][m][3][0]), fabsf(r[ai][m][3][1]))));
                am = swap16_max(am); am = swap32_max(am); am = fmaxf(am, 1e-20f);
                const float inv = 127.0f * __builtin_amdgcn_rcpf(am); const f32x2 inv2 = {inv, inv}, mg = {12582912.0f + 128.0f, 12582912.0f + 128.0f};
                unsigned q[4];
#pragma unroll
                for (int k = 0; k < 4; ++k) { const f32x2 t = r[ai][m][k] * inv2 + mg; q[k] = __builtin_amdgcn_perm(__float_as_uint(t[1]), __float_as_uint(t[0]), 0x0c0c0400u); }
                u32x2 w; w.x = q[0] | (q[1] << 16); w.y = q[2] | (q[3] << 16);
                const size_t row = (size_t)(row0 + ai * HALF + m * 16);
                *(u32x2*)(ACTQ + row * D + col0) = w;
                ams[ai * 4 + m] = am * (1.0f / 127.0f); }
        if (fq == 0) {
#pragma unroll
            for (int i = 0; i < 8; ++i) SBLK[(size_t)(row0 + (i >> 2) * HALF + (i & 3) * 16) * 32 + u.pn * 4 + wc] = ams[i]; }
    }
};
struct EpiDown {
    static constexpr bool PERM = true; static constexpr int PF = 0;
    bf16_t* YS; const float* bd;
    __device__ __forceinline__ void operator()(const f32x4 (&acc)[2][2][4][2], const Unit& u, int wr, int wc, int fr, int fq) const {
        const int row0 = u.pm * BM + wr * 64 + fr, col0 = u.pn * BM + wc * 32 + 8 * fq;
        const float* pb = bd + (size_t)u.e * D + col0;
        f32x4 bv[2][2];
#pragma unroll
        for (int bj = 0; bj < 2; ++bj)
#pragma unroll
            for (int n = 0; n < 2; ++n) bv[bj][n] = *(const f32x4*)(pb + bj * HALF + 4 * n);
#pragma unroll
        for (int ai = 0; ai < 2; ++ai)
#pragma unroll
            for (int m = 0; m < 4; ++m) { bf16_t* rowp = YS + (size_t)(row0 + ai * HALF + m * 16) * D + col0;
#pragma unroll
                for (int bj = 0; bj < 2; ++bj) { const f32x4 v0 = acc[ai][bj][m][0] + bv[bj][0], v1 = acc[ai][bj][m][1] + bv[bj][1];
                    u32x4 w; w.x = cvt_pk_bf16(v0[0], v0[1]); w.y = cvt_pk_bf16(v0[2], v0[3]); w.z = cvt_pk_bf16(v1[0], v1[1]); w.w = cvt_pk_bf16(v1[2], v1[3]);
                    *(u32x4*)(rowp + bj * HALF) = w; } }
    }
};

struct EpiDown8 {
    static constexpr bool PERM = true; static constexpr int PF = 2;
    unsigned char* YSQ; float* YSB; const float* bd; const float* saq; const float* sbd; const LAS float* epf;
    __device__ __forceinline__ const float* pf_addr(const Unit& u, int tid, int k) const {
        if (k == 1) return saq + (size_t)u.pm * BM + (tid & 255);
        return (tid < 256 ? bd : sbd) + (size_t)u.e * D + u.pn * BM + (tid & 255); }
    __device__ __forceinline__ void operator()(const i32x4 (&acc)[2][2][4][2], const Unit& u, int wr, int wc, int fr, int fq) const {
        const int row0 = u.pm * BM + wr * 64 + fr, col0 = u.pn * BM + wc * 32 + 8 * fq;
#pragma unroll
        for (int bj = 0; bj < 2; ++bj) {
            const LAS float* pe = epf + wc * 32 + 8 * fq + bj * HALF;
            const f32x4 b0 = *(const LAS f32x4*)pe, b1 = *(const LAS f32x4*)(pe + 4), s0 = *(const LAS f32x4*)(pe + 256), s1 = *(const LAS f32x4*)(pe + 260);
            float ams[8];
#pragma unroll
            for (int ai = 0; ai < 2; ++ai)
#pragma unroll
                for (int m = 0; m < 4; ++m) { const int row = row0 + ai * HALF + m * 16; const float sr = epf[512 + wr * 64 + fr + ai * HALF + m * 16]; f32x4 v0, v1;
#pragma unroll
                    for (int j = 0; j < 4; ++j) { v0[j] = (float)acc[ai][bj][m][0][j]; v1[j] = (float)acc[ai][bj][m][1][j]; }
                    v0 = v0 * (s0 * sr) + b0; v1 = v1 * (s1 * sr) + b1;
                    float am = fmaxf(fmaxf(fmaxf(fabsf(v0[0]), fabsf(v0[1])), fmaxf(fabsf(v0[2]), fabsf(v0[3]))), fmaxf(fmaxf(fabsf(v1[0]), fabsf(v1[1])), fmaxf(fabsf(v1[2]), fabsf(v1[3]))));
                    am = swap16_max(am); am = swap32_max(am); am = fmaxf(am, 1e-30f);
                    const float inv = 127.0f * __builtin_amdgcn_rcpf(am); const f32x2 inv2 = {inv, inv}, mg = {12582912.0f + 128.0f, 12582912.0f + 128.0f};
                    const f32x2 t0 = (f32x2){v0[0], v0[1]} * inv2 + mg, t1 = (f32x2){v0[2], v0[3]} * inv2 + mg, t2 = (f32x2){v1[0], v1[1]} * inv2 + mg, t3 = (f32x2){v1[2], v1[3]} * inv2 + mg;
                    u32x2 w;
                    w.x = __builtin_amdgcn_perm(__float_as_uint(t0[1]), __float_as_uint(t0[0]), 0x0c0c0400u) | (__builtin_amdgcn_perm(__float_as_uint(t1[1]), __float_as_uint(t1[0]), 0x0c0c0400u) << 16);
                    w.y = __builtin_amdgcn_perm(__float_as_uint(t2[1]), __float_as_uint(t2[0]), 0x0c0c0400u) | (__builtin_amdgcn_perm(__float_as_uint(t3[1]), __float_as_uint(t3[0]), 0x0c0c0400u) << 16);
                    *(u32x2*)(YSQ + (size_t)row * D + col0 + bj * HALF) = w;
                    ams[ai * 4 + m] = am * (1.0f / 127.0f); }
            if (fq == 0) {
#pragma unroll
                for (int i = 0; i < 8; ++i) YSB[(size_t)(row0 + (i >> 2) * HALF + (i & 3) * 16) * 32 + u.pn * 8 + bj * 4 + wc] = ams[i]; }
            asm volatile("" ::: "memory");
        }
    }
};
struct DenseOrder {
    int nM, nN, vcu, xM, xN0, xNn;
    __device__ __forceinline__ bool short_one() const { const int U = nM * nN + xM * xNn, R = (U + 255) >> 8; return (U & 255) != 0 && vcu >= U - (R - 1) * 256; }
    __device__ __forceinline__ bool next(int i, Unit& u) const {
        int L = i * 256 + vcu; const int nmain = nM * nN;
        if (L < nmain) { const int nig = 8 * nN, gid = L / nig, fm = gid * 8, rem = nM - fm, gsz = rem < 8 ? rem : 8, w = L % nig; u.pm = fm + w % gsz; u.pn = w / gsz; }
        else { L -= nmain; if (L >= xM * xNn) return false; u.pm = nM + L % xM; u.pn = xN0 + L / xM; }
        u.e = 0; u.mt = 0; u.cnt = 0; return true;
    }
};
struct MoeOrder {
    const LAS int* ecnt; const LAS int* lbase; const LAS int* cumt; int nN, idx, G; LAS int* ul;
    __device__ __forceinline__ bool short_one() const { const int U = cumt[32] * nN, R = (U + G - 1) / G; return (U % G) != 0 && idx >= U - (R - 1) * G; }
    __device__ __forceinline__ void build(int tid) const {
        if (tid < 16) { const int L = tid * G + idx; int e = -1, pn = 0, mt = 0, pm = 0, c = 0;
            if (idx >= 0 && L < cumt[32] * nN) { e = 0; while (cumt[e + 1] * nN <= L) ++e; const int r = L - cumt[e] * nN; c = ecnt[e]; const int mte = (c + 255) >> 8;
                if (MK_MT_MAJOR & (nN == 4 ? 1 : 2)) { pn = r % nN; mt = r / nN; } else { pn = r / mte; mt = r % mte; } pm = (lbase[e] >> 8) + mt; }
            ul[tid * 8 + 0] = e; ul[tid * 8 + 1] = pn; ul[tid * 8 + 2] = mt; ul[tid * 8 + 3] = pm; ul[tid * 8 + 4] = c; }
        __syncthreads();
    }
    __device__ __forceinline__ bool next(int i, Unit& u) const {
        if (i >= 16) return false;
        const int e = __builtin_amdgcn_readfirstlane(ul[i * 8 + 0]);
        if (e < 0) return false;
        u.e = e; u.pn = __builtin_amdgcn_readfirstlane(ul[i * 8 + 1]); u.mt = __builtin_amdgcn_readfirstlane(ul[i * 8 + 2]); u.pm = __builtin_amdgcn_readfirstlane(ul[i * 8 + 3]); u.cnt = __builtin_amdgcn_readfirstlane(ul[i * 8 + 4]); return true;
    }
};
}

namespace att {
constexpr int VSTR = 144;
template <int DQK> struct Cfg { static constexpr int KSTR = DQK * 2 + 16, KB = 64 * KSTR, VB = 64 * VSTR, STAGE = KB + VB, CPR = DQK / 8, NKS = DQK / 16; };
__device__ __forceinline__ int crow(int r, int hi) { return (r & 3) + 8 * (r >> 2) + 4 * hi; }

template <int DQK, bool MLA>
__device__ __forceinline__ void fetchK(u32x4 (&r)[2], const bf16_t* Kb, const bf16_t* KRb, int pitch, int row0, int tid) {
    typedef Cfg<DQK> C;
    { const int key = tid / C::CPR, ch = tid % C::CPR;
      const bf16_t* src = (MLA && ch >= 8) ? KRb + (size_t)(row0 + key) * 32 + (ch - 8) * 8 : Kb + (size_t)(row0 + key) * pitch + ch * 8;
      r[0] = *(const u32x4*)src; }
    if constexpr (DQK == 96) { if (tid < 256) { const int c = 512 + tid, key = c / C::CPR, ch = c % C::CPR;
      const bf16_t* src = (MLA && ch >= 8) ? KRb + (size_t)(row0 + key) * 32 + (ch - 8) * 8 : Kb + (size_t)(row0 + key) * pitch + ch * 8;
      r[1] = *(const u32x4*)src; } }
}
__device__ __forceinline__ void fetchV(u32x4& r, const bf16_t* Vb, int pitch, int row0, int tid) { const int key = tid >> 3, ch = tid & 7; r = *(const u32x4*)(Vb + (size_t)(row0 + key) * pitch + ch * 8); }
template <int DQK>
__device__ __forceinline__ void stashK(LAS unsigned char* kst, const u32x4 (&r)[2], int tid) {
    typedef Cfg<DQK> C;
    { const int key = tid / C::CPR, ch = tid % C::CPR; *(LAS u32x4*)(kst + key * C::KSTR + ch * 16) = r[0]; }
    if constexpr (DQK == 96) { if (tid < 256) { const int c = 512 + tid, key = c / C::CPR, ch = c % C::CPR; *(LAS u32x4*)(kst + key * C::KSTR + ch * 16) = r[1]; } }
}
__device__ __forceinline__ void stashV(LAS unsigned char* vst, const u32x4& r, int tid) { const int key = tid >> 3, ch = tid & 7; *(LAS u32x4*)(vst + key * VSTR + ch * 16) = r; }
template <int DQK, bool MLA>
__device__ __forceinline__ void fetch(u32x4 (&r)[3], const bf16_t* Kb, const bf16_t* Vb, const bf16_t* KRb, int pitch, int row0, int tid) {
    u32x4 k2[2]; k2[1] = (u32x4){0u, 0u, 0u, 0u}; fetchK<DQK, MLA>(k2, Kb, KRb, pitch, row0, tid); r[0] = k2[0]; r[1] = k2[1]; fetchV(r[2], Vb, pitch, row0, tid);
}
template <int DQK>
__device__ __forceinline__ void stash(LAS unsigned char* st, const u32x4 (&r)[3], int tid) {
    const u32x4 k2[2] = {r[0], r[1]}; stashK<DQK>(st, k2, tid); stashV(st + Cfg<DQK>::KB, r[2], tid);
}
template <int DQK>
__device__ __forceinline__ f32x16 qk(const LAS unsigned char* kst, int koff, const bf16x8 (&qr)[DQK / 16], int r32, int hi) {
    typedef Cfg<DQK> C;
    f32x16 p;
#pragma unroll
    for (int r = 0; r < 16; ++r) p[r] = 0.f;
    const LAS unsigned char* kb = kst + (koff + r32) * C::KSTR + hi * 16;
#pragma unroll
    for (int ks = 0; ks < C::NKS; ++ks) { const bf16x8 kf = *(const LAS bf16x8*)(kb + ks * 32); p = __builtin_amdgcn_mfma_f32_32x32x16_bf16(kf, qr[ks], p, 0, 0, 0); }
    return p;
}
__device__ __forceinline__ s16x4 vtr(const LAS unsigned char* p) { return __builtin_bit_cast(s16x4, __builtin_amdgcn_ds_read_tr16_b64_v4i16((LAS s16x4*)p)); }
typedef __bf16 bf16x2_t __attribute__((ext_vector_type(2)));
__device__ __forceinline__ unsigned cvtpk_s(float lo, float hi) { const f32x2 v = {lo, hi}; const bf16x2_t b = __builtin_convertvector(v, bf16x2_t); return __builtin_bit_cast(unsigned, b); }
template <int NS>
__device__ __forceinline__ void sm_max(const f32x16 (&t)[NS], const float sc, f32x16 (&o)[2], float& m, float& l) {
    float mx = t[0][0];
#pragma unroll
    for (int s = 0; s < NS; ++s)
#pragma unroll
        for (int r = 0; r < 16; ++r) mx = fmaxf(mx, t[s][r]);
    mx = swap32_max(mx) * sc;
    if (__any(mx > m + 8.0f)) { const float mn = fmaxf(m, mx); const float a = __builtin_amdgcn_exp2f(m - mn); m = mn; l *= a;
#pragma unroll
        for (int r = 0; r < 16; ++r) { o[0][r] *= a; o[1][r] *= a; } }
}
template <int NS>
__device__ __forceinline__ void sm_exp_pv(f32x16 (&t)[NS], const float sc, const LAS unsigned char* vst, const int (&voff)[NS], f32x16 (&o)[2], const float m, float& l, int lane) {
    const int hi = lane >> 5;
    float rs = 0.f;
#pragma unroll
    for (int s = 0; s < NS; ++s)
#pragma unroll
        for (int r = 0; r < 16; ++r) { t[s][r] = __builtin_amdgcn_exp2f(__builtin_fmaf(t[s][r], sc, -m)); rs += t[s][r]; }
    l += rs;
    const int q4 = (lane & 15) >> 2, p4 = lane & 3, blk = (lane >> 4) & 1;
#pragma unroll
    for (int s = 0; s < NS; ++s) {
        const LAS unsigned char* vb = vst + (voff[s] + 4 * hi + q4) * VSTR + (16 * blk + 4 * p4) * 2;
#pragma unroll
        for (int kk = 0; kk < 2; ++kk) {
            u32x4 pw; pw.x = cvtpk_s(t[s][8 * kk + 0], t[s][8 * kk + 1]); pw.y = cvtpk_s(t[s][8 * kk + 2], t[s][8 * kk + 3]);
            pw.z = cvtpk_s(t[s][8 * kk + 4], t[s][8 * kk + 5]); pw.w = cvtpk_s(t[s][8 * kk + 6], t[s][8 * kk + 7]);
            const bf16x8 pb = __builtin_bit_cast(bf16x8, pw);
#pragma unroll
            for (int c = 0; c < 2; ++c) {
                const s16x4 lo = vtr(vb + (16 * kk) * VSTR + c * 64), h8 = vtr(vb + (16 * kk + 8) * VSTR + c * 64);
                const bf16x8 va = (bf16x8){lo[0], lo[1], lo[2], lo[3], h8[0], h8[1], h8[2], h8[3]};
                o[c] = __builtin_amdgcn_mfma_f32_32x32x16_bf16(va, pb, o[c], 0, 0, 0);
            }
        }
    }
}
template <int NS>
__device__ __forceinline__ void sm_pv(f32x16 (&t)[NS], const float sc, const LAS unsigned char* vst, const int (&voff)[NS], f32x16 (&o)[2], float& m, float& l, int lane) {
    sm_max<NS>(t, sc, o, m, l); sm_exp_pv<NS>(t, sc, vst, voff, o, m, l, lane);
}
template <int DQK>
__device__ __forceinline__ f32x16 qkn(const LAS unsigned char* kst, int koff, const bf16x8 (&qr)[DQK / 16], const float negm, int r32, int hi) {
    typedef Cfg<DQK> C;
    f32x16 p;
#pragma unroll
    for (int r = 0; r < 16; ++r) p[r] = negm;
    const LAS unsigned char* kb0 = kst + (koff + r32) * C::KSTR + hi * 16;
    bf16x8 kf[C::NKS];
#pragma unroll
    for (int ks = 0; ks < C::NKS; ++ks) kf[ks] = *(const LAS bf16x8*)(kb0 + ks * 32);
    __builtin_amdgcn_sched_barrier(0);
#pragma unroll
    for (int ks = 0; ks < C::NKS; ++ks) p = __builtin_amdgcn_mfma_f32_32x32x16_bf16(kf[ks], qr[ks], p, 0, 0, 0);
    return p;
}
template <int DQK>
__device__ __forceinline__ f32x16 qkn_old(const LAS unsigned char* kst, int koff, const bf16x8 (&qr)[DQK / 16], const f32x16& negm, int r32, int hi) {
    typedef Cfg<DQK> C;
    f32x16 p = negm;
    const LAS unsigned char* kb = kst + (koff + r32) * C::KSTR + hi * 16;
#pragma unroll
    for (int ks = 0; ks < C::NKS; ++ks) { const bf16x8 kf = *(const LAS bf16x8*)(kb + ks * 32); p = __builtin_amdgcn_mfma_f32_32x32x16_bf16(kf, qr[ks], p, 0, 0, 0); }
    return p;
}
__device__ __forceinline__ void sm_max_n(f32x16 (&t)[2], f32x16 (&o)[2], f32x16& osum, float& m, float& negm, bool first) {
    float a0 = fmaxf(fmaxf(t[0][0], t[0][1]), t[0][2]), a1 = fmaxf(fmaxf(t[1][0], t[1][1]), t[1][2]);
#pragma unroll
    for (int r = 3; r < 15; r += 2) { a0 = fmaxf(fmaxf(a0, t[0][r]), t[0][r + 1]); a1 = fmaxf(fmaxf(a1, t[1][r]), t[1][r + 1]); }
    float mx = fmaxf(fmaxf(a0, a1), fmaxf(t[0][15], t[1][15]));
    mx = swap32_max(mx);
    if (first || __any(mx > 8.0f)) { const float d = first ? mx : fmaxf(mx, 0.f); const float a = first ? 1.0f : __builtin_amdgcn_exp2f(-d); m += d;
#pragma unroll
        for (int r = 0; r < 16; ++r) { t[0][r] -= d; t[1][r] -= d; o[0][r] *= a; o[1][r] *= a; osum[r] *= a; } negm = -m; }
}
__device__ __forceinline__ void sm_exp_pv_n(f32x16 (&t)[2], const LAS unsigned char* vst, f32x16 (&o)[2], f32x16& osum, int lane) {
    const int hi = lane >> 5, q4 = (lane & 15) >> 2, p4 = lane & 3, blk = (lane >> 4) & 1;
    const LAS unsigned char* vb = vst + (4 * hi + q4) * VSTR + (16 * blk + 4 * p4) * 2;
    const bf16x8 ones = (bf16x8){0x3F80, 0x3F80, 0x3F80, 0x3F80, 0x3F80, 0x3F80, 0x3F80, 0x3F80};
#pragma unroll
    for (int s = 0; s < 2; ++s) {
        bf16x8 va[2][2];
#pragma unroll
        for (int kk = 0; kk < 2; ++kk)
#pragma unroll
            for (int c = 0; c < 2; ++c) { const s16x4 lo = vtr(vb + (32 * s + 16 * kk) * VSTR + c * 64), h8 = vtr(vb + (32 * s + 16 * kk + 8) * VSTR + c * 64);
                va[kk][c] = (bf16x8){lo[0], lo[1], lo[2], lo[3], h8[0], h8[1], h8[2], h8[3]}; }
        __builtin_amdgcn_sched_barrier(0);
#pragma unroll
        for (int kk = 0; kk < 2; ++kk) {
            float e[8];
#pragma unroll
            for (int j = 0; j < 8; ++j) e[j] = __builtin_amdgcn_exp2f(t[s][8 * kk + j]);
            u32x4 pw; pw.x = cvtpk_s(e[0], e[1]); pw.y = cvtpk_s(e[2], e[3]); pw.z = cvtpk_s(e[4], e[5]); pw.w = cvtpk_s(e[6], e[7]);
            const bf16x8 pb = __builtin_bit_cast(bf16x8, pw);
            o[0] = __builtin_amdgcn_mfma_f32_32x32x16_bf16(va[kk][0], pb, o[0], 0, 0, 0);
            o[1] = __builtin_amdgcn_mfma_f32_32x32x16_bf16(va[kk][1], pb, o[1], 0, 0, 0);
            if (MK_OSUM_MFMA) osum = __builtin_amdgcn_mfma_f32_32x32x16_bf16(ones, pb, osum, 0, 0, 0);
            else { const f32x2 rs = ((f32x2){e[0], e[1]} + (f32x2){e[2], e[3]}) + ((f32x2){e[4], e[5]} + (f32x2){e[6], e[7]}); osum[0] += rs[0] + rs[1]; }
        }
    }
}
__device__ __forceinline__ void store_row64(const f32x16 (&o)[2], float inv, bf16_t* orow, int hi) {
#pragma unroll
    for (int c = 0; c < 2; ++c)
#pragma unroll
        for (int g = 0; g < 4; g += 2) {
            u32x2 a, b;
            a.x = cvt_pk_bf16(o[c][4 * g] * inv, o[c][4 * g + 1] * inv); a.y = cvt_pk_bf16(o[c][4 * g + 2] * inv, o[c][4 * g + 3] * inv);
            b.x = cvt_pk_bf16(o[c][4 * g + 4] * inv, o[c][4 * g + 5] * inv); b.y = cvt_pk_bf16(o[c][4 * g + 6] * inv, o[c][4 * g + 7] * inv);
            { auto r = __builtin_amdgcn_permlane32_swap(a.x, b.x, false, false); a.x = r[0]; b.x = r[1]; }
            { auto r = __builtin_amdgcn_permlane32_swap(a.y, b.y, false, false); a.y = r[0]; b.y = r[1]; }
            u32x4 w; w.x = a.x; w.y = a.y; w.z = b.x; w.w = b.y;
            *(u32x4*)(orow + 32 * c + 8 * g + 8 * hi) = w; }
}
__device__ __forceinline__ void finalize_n(const f32x16 (&o)[2], const f32x16& osum, bf16_t* orow, int hi) {
    const float inv = 1.0f / (MK_OSUM_MFMA ? osum[0] : swap32_sum(osum[0]));
    store_row64(o, inv, orow, hi);
}
__device__ __forceinline__ void finalize(const f32x16 (&o)[2], float l, bf16_t* orow, int hi) {
    l = swap32_sum(l); const float inv = 1.0f / l;
    store_row64(o, inv, orow, hi);
}
#define ATT_PIPE_BEGIN(DQK, MLA, ROW0_OF) \
    u32x4 pre[3]; pre[1] = (u32x4){0u, 0u, 0u, 0u}; \
    fetch<DQK, MLA>(pre, Kb, Vb, KRb, pitch, ROW0_OF(0), tid); stash<DQK>(lds, pre, tid); __syncthreads(); \
    for (int i = 0; i < ntiles; ++i) { \
        if (i + 1 < ntiles) fetch<DQK, MLA>(pre, Kb, Vb, KRb, pitch, ROW0_OF(i + 1), tid); \
        const LAS unsigned char* kst = lds + (i & 1) * Cfg<DQK>::STAGE; const LAS unsigned char* vst = kst + Cfg<DQK>::KB;
#define ATT_PIPE_END(DQK) \
        if (i + 1 < ntiles) stash<DQK>(lds + ((i + 1) & 1) * Cfg<DQK>::STAGE, pre, tid); \
        __syncthreads(); }

#define ATT2_RUN(DQK, MLA, ROW0_OF, QK2, FIRST, STAG) \
    { typedef Cfg<DQK> C_; LAS unsigned char* const kb_ = lds; LAS unsigned char* const vb_ = lds + 2 * C_::KB; \
    u32x4 pk_[2], pv_; pk_[1] = (u32x4){0u, 0u, 0u, 0u}; \
    fetchK<DQK, MLA>(pk_, Kb, KRb, pitch, ROW0_OF(0), tid); fetchV(pv_, Vb, pitch, ROW0_OF(0), tid); stashK<DQK>(kb_, pk_, tid); stashV(vb_, pv_, tid); \
    if (ntiles > 1) { fetchK<DQK, MLA>(pk_, Kb, KRb, pitch, ROW0_OF(1), tid); stashK<DQK>(kb_ + C_::KB, pk_, tid); } \
    __syncthreads(); \
    f32x16 t[2]; QK2(t, kb_, 0); \
    sm_max_n(t, o, osum, m, negm, (FIRST)); \
    __syncthreads();     \
    for (int i = 0; i + 1 < ntiles; ++i) { \
        if (i + 2 < ntiles) fetchK<DQK, MLA>(pk_, Kb, KRb, pitch, ROW0_OF(i + 2), tid); \
        fetchV(pv_, Vb, pitch, ROW0_OF(i + 1), tid); \
        f32x16 tn[2]; \
        if (!(STAG) || wid < 4) { QK2(tn, kb_ + ((i + 1) & 1) * C_::KB, i + 1); }     \
        sm_exp_pv_n(t, vb_ + (i & 1) * C_::VB, o, osum, lane); \
        if ((STAG) && wid >= 4) { QK2(tn, kb_ + ((i + 1) & 1) * C_::KB, i + 1); }     \
        t[0] = tn[0]; t[1] = tn[1]; \
        sm_max_n(t, o, osum, m, negm, false);                                 \
        if (i + 2 < ntiles) stashK<DQK>(kb_ + (i & 1) * C_::KB, pk_, tid); \
        stashV(vb_ + ((i + 1) & 1) * C_::VB, pv_, tid); \
        __syncthreads(); } \
    sm_exp_pv_n(t, vb_ + ((ntiles - 1) & 1) * C_::VB, o, osum, lane); \
    __syncthreads(); }

__device__ __forceinline__ void attn_A_unit(LAS unsigned char* lds, const bf16_t* QKV, bf16_t* O, const float* sink, int b, int kvh, int qb, bool ctxq, int tid) {
    const int lane = tid & 63, wid = __builtin_amdgcn_readfirstlane(tid >> 6), r32 = lane & 31, hi = lane >> 5;
    const int head = kvh * 4 + (wid >> 1), qoff = 32 * (wid & 1) + r32, t0 = qb * 64;
    const int qrow = ctxq ? NL + b * CTXL + t0 + qoff : b * SEQ + t0 + qoff;
    bf16x8 qr[4];
    { const bf16_t* qp = QKV + (size_t)qrow * A_IN + head * 64 + hi * 8;
#pragma unroll
      for (int ks = 0; ks < 4; ++ks) qr[ks] = *(const bf16x8*)(qp + ks * 16); }
    int jlo = 0, nloc = 0;
    if (!ctxq) { jlo = t0 >= 128 ? 0 : (t0 == 64 ? 1 : 2); int jhi = (2112 - t0) / 64; jhi = jhi > 4 ? 4 : jhi; nloc = jhi - jlo + 1; }
    const int ntiles = 4 + nloc, cbase = NL + b * CTXL, lbase = b * SEQ + t0 - 128 + 64 * jlo;
    const bf16_t* Kb = QKV + 1024 + kvh * 64; const bf16_t* Vb = QKV + 1280 + kvh * 64; const bf16_t* KRb = nullptr; const int pitch = A_IN;
    float m = sink[head] * LOG2E;
    f32x16 o[2], osum; float negm = -m;
#pragma unroll
    for (int r = 0; r < 16; ++r) { o[0][r] = 0.f; o[1][r] = 0.f; osum[r] = MK_OSUM_MFMA ? 1.0f : 0.5f; }
#define A_ROW0(i) ((i) < 4 ? cbase + 64 * (i) : lbase + 64 * ((i) - 4))
#define A_QK2(dst, kst, ti) { dst[0] = qkn<64>(kst, 0, qr, negm, r32, hi); dst[1] = qkn<64>(kst, 32, qr, negm, r32, hi); const int j_ = (ti) < 4 ? 2 : jlo + (ti) - 4; \
        if (j_ == 0 || j_ == 4) { _Pragma("unroll") for (int s = 0; s < 2; ++s) _Pragma("unroll") for (int r = 0; r < 16; ++r) { const int kk = 32 * s + crow(r, hi); \
            if (j_ == 0 ? (kk < qoff) : (kk > qoff)) dst[s][r] = -1e30f; } } }
    ATT2_RUN(64, false, A_ROW0, A_QK2, false, (MK_ATT_STAGGER & 1))
#undef A_QK2
#undef A_ROW0
    finalize_n(o, osum, O + (size_t)qrow * D + head * 64, hi);
}

__device__ __forceinline__ void attn_B_unit(LAS unsigned char* lds, LAS float* tab, const bf16_t* QKV, bf16_t* O, const float* rpb, int b, int h, int rq, bool ctxq, int tid) {
    const int lane = tid & 63, wid = __builtin_amdgcn_readfirstlane(tid >> 6), r32 = lane & 31, hi = lane >> 5;
    const int jb = wid & 3, rp = wid >> 2;
    const int rqa = 4 * rq + 2 * rp + (r32 >> 4), qcol = 16 * jb + (r32 & 15);
    const int qrow = ctxq ? NL + b * CTXL + 32 * wid + r32 : b * SEQ + rqa * 64 + qcol;
    for (int idx = tid; idx < 15 * 31; idx += 512) tab[(idx / 31) * 32 + idx % 31] = rpb[h * 465 + idx] * LOG2E;
    bf16x8 qr[4];
    { const bf16_t* qp = QKV + (size_t)qrow * B_IN + h * 64 + hi * 8;
#pragma unroll
      for (int ks = 0; ks < 4; ++ks) qr[ks] = *(const bf16x8*)(qp + ks * 16); }
    int klo = 0, nloc = 0;
    if (!ctxq) { klo = 4 * rq - 4; klo = klo < 0 ? 0 : (klo > 24 ? 24 : klo); int khi = 4 * rq - 1; khi = khi < 0 ? 0 : (khi > 24 ? 24 : khi); khi += 7; nloc = khi - klo + 1; }
    const int ntiles = 4 + nloc, cbase = NL + b * CTXL, lbase = b * SEQ;
    int r0q = rqa - 4; r0q = r0q < 0 ? 0 : (r0q > 24 ? 24 : r0q);
    int wst = qcol - 8; wst = wst < 0 ? 0 : (wst > 48 ? 48 : wst);
    int cst = 16 * jb - 8; cst = cst < 0 ? 0 : (cst > 32 ? 32 : cst);
    const int lo = wst - cst;
    int wr0 = 4 * rq + 2 * rp - 4; wr0 = wr0 < 0 ? 0 : (wr0 > 24 ? 24 : wr0);
    int wr1 = 4 * rq + 2 * rp + 1 - 4; wr1 = wr1 < 0 ? 0 : (wr1 > 24 ? 24 : wr1); wr1 += 7;
    const bf16_t* Kb = QKV + 1024 + h * 64; const bf16_t* Vb = QKV + 2048 + h * 64; const bf16_t* KRb = nullptr; const int pitch = B_IN;
    float m = -1e30f, l = 0.f;
    f32x16 o[2];
#pragma unroll
    for (int r = 0; r < 16; ++r) { o[0][r] = 0.f; o[1][r] = 0.f; }
    const float sc = 0.125f * LOG2E;
#define B_ROW0(i) ((i) < 4 ? cbase + 64 * (i) : lbase + 64 * (klo + (i) - 4))
    ATT_PIPE_BEGIN(64, false, B_ROW0)
        if (i < 4) {
            f32x16 t[2];
            t[0] = qk<64>(kst, 0, qr, r32, hi); t[1] = qk<64>(kst, 32, qr, r32, hi);
#pragma unroll
            for (int s = 0; s < 2; ++s)
#pragma unroll
                for (int r = 0; r < 16; ++r) t[s][r] *= 1.0f;
            const int voff[2] = {0, 32};
            sm_pv<2>(t, 1.0f, vst, voff, o, m, l, lane);
        } else {
            const int kr = klo + i - 4;
            if (kr >= wr0 && kr <= wr1) {
                f32x16 t[1];
                t[0] = qk<64>(kst, cst, qr, r32, hi);
                const bool rowok = (kr >= r0q) && (kr < r0q + 8);
                const int bidx0 = (kr - rqa + 7) * 32 + cst - qcol + 15;
#pragma unroll
                for (int r = 0; r < 16; ++r) { const int kidx = crow(r, hi); const bool ok = rowok && ((unsigned)(kidx - lo) < 16u);
                    int bi = bidx0 + kidx; bi = bi < 0 ? 0 : (bi > 479 ? 479 : bi);
                    const float bias = tab[bi];
                    t[0][r] = ok ? t[0][r] + bias : -1e30f; }
                const int voff[1] = {cst};
                sm_pv<1>(t, 1.0f, vst, voff, o, m, l, lane);
            }
        }
    ATT_PIPE_END(64)
#undef B_ROW0
    finalize(o, l, O + (size_t)qrow * D + h * 64, hi);
}

__device__ __forceinline__ void attn_C_unit(LAS unsigned char* lds, const bf16_t* Q2, const bf16_t* KR, bf16_t* O, int b, int h, int qb, bool ctxq, int tid) {
    const int lane = tid & 63, wid = __builtin_amdgcn_readfirstlane(tid >> 6), r32 = lane & 31, hi = lane >> 5;
    const int qrow = ctxq ? NL + b * CTXL + 32 * wid + r32 : b * SEQ + qb * 256 + 32 * wid + r32;
    bf16x8 qr[6];
    { const bf16_t* qp = Q2 + (size_t)qrow * C_UPN + h * 96 + hi * 8;
#pragma unroll
      for (int ks = 0; ks < 6; ++ks) qr[ks] = *(const bf16x8*)(qp + ks * 16); }
    const int ntiles = ctxq ? 4 : 36, cbase = NL + b * CTXL, lbase = b * SEQ;
    const bf16_t* Kb = Q2 + 1536 + h * 128; const bf16_t* Vb = Kb + 64; const bf16_t* KRb = KR; const int pitch = C_UPN;
    float m = 0.f;
    f32x16 o[2], osum; float negm = 0.f;
#pragma unroll
    for (int r = 0; r < 16; ++r) { o[0][r] = 0.f; o[1][r] = 0.f; osum[r] = 0.f; }
#define C_ROW0(i) ((i) < 4 ? cbase + 64 * (i) : lbase + 64 * ((i) - 4))
#define C_QK2(dst, kst, ti) { dst[0] = qkn<96>(kst, 0, qr, negm, r32, hi); dst[1] = qkn<96>(kst, 32, qr, negm, r32, hi); }
    ATT2_RUN(96, true, C_ROW0, C_QK2, true, (MK_ATT_STAGGER & 2))
#undef C_QK2
#undef C_ROW0
    finalize_n(o, osum, O + (size_t)qrow * D + h * 64, hi);
}
}

struct Row4 { f32x4 v[4]; };
__device__ __forceinline__ void row_load(Row4& x, const float* p, int lane) {
#pragma unroll
    for (int j = 0; j < 4; ++j) x.v[j] = *(const f32x4*)(p + 4 * lane + 256 * j);
}
__device__ __forceinline__ void row_store(const Row4& x, float* p, int lane) {
#pragma unroll
    for (int j = 0; j < 4; ++j) *(f32x4*)(p + 4 * lane + 256 * j) = x.v[j];
}
__device__ __forceinline__ void row_load_bf(Row4& x, const bf16_t* p, int lane) {
#pragma unroll
    for (int j = 0; j < 4; ++j) { const u32x2 w = *(const u32x2*)(p + 4 * lane + 256 * j); x.v[j] = (f32x4){bf_lo(w.x), bf_hi(w.x), bf_lo(w.y), bf_hi(w.y)}; }
}
__device__ __forceinline__ void row_store_bf(const Row4& x, bf16_t* p, int lane) {
#pragma unroll
    for (int j = 0; j < 4; ++j) { u32x2 w; w.x = cvt_pk_bf16(x.v[j][0], x.v[j][1]); w.y = cvt_pk_bf16(x.v[j][2], x.v[j][3]); *(u32x2*)(p + 4 * lane + 256 * j) = w; }
}
__device__ __forceinline__ float row_rstd(const Row4& x, int lane) {
    float s = 0.f;
#pragma unroll
    for (int j = 0; j < 4; ++j) s += (x.v[j][0] * x.v[j][0] + x.v[j][1] * x.v[j][1]) + (x.v[j][2] * x.v[j][2] + x.v[j][3] * x.v[j][3]);
    s = wave_sum(s, lane);
    return 1.0f / sqrtf(s * (1.0f / D) + NORM_EPS);
}
__device__ __forceinline__ void norm_mod(const Row4& x, float rstd, const float* g, const float* sh, const float* sc, bf16_t* out, int lane, Row4& hv) {
#pragma unroll
    for (int j = 0; j < 4; ++j) { const int c = 4 * lane + 256 * j;
        const f32x4 gg = *(const f32x4*)(g + c), s1 = *(const f32x4*)(sc + c), s0 = *(const f32x4*)(sh + c);
        const f32x4 h = (x.v[j] * rstd * gg) * (s1 + 1.0f) + s0; hv.v[j] = h;
        u32x2 w; w.x = cvt_pk_bf16(h[0], h[1]); w.y = cvt_pk_bf16(h[2], h[3]); *(u32x2*)(out + c) = w; }
}

__device__ __forceinline__ unsigned pk_i8x4(float a, float b, float c, float d, float inv) {
    const f32x2 i2 = {inv, inv}, m2 = {12582912.0f, 12582912.0f};
    const f32x2 t01 = (f32x2){a, b} * i2 + m2, t23 = (f32x2){c, d} * i2 + m2;
    const unsigned lo = __builtin_amdgcn_perm(__float_as_uint(t01[1]), __float_as_uint(t01[0]), 0x0c0c0400u), hi = __builtin_amdgcn_perm(__float_as_uint(t23[1]), __float_as_uint(t23[0]), 0x0c0c0400u);
    return lo | (hi << 16);
}
__device__ __forceinline__ void norm_mod8(const Row4& x, float rstd, const float* g, const float* sh, const float* sc, unsigned char* out, float* sarow, int lane) {
    Row4 hv; float am = 0.f;
#pragma unroll
    for (int j = 0; j < 4; ++j) { const int c = 4 * lane + 256 * j;
        const f32x4 gg = *(const f32x4*)(g + c), s1 = *(const f32x4*)(sc + c), s0 = *(const f32x4*)(sh + c);
        const f32x4 h = (x.v[j] * rstd * gg) * (s1 + 1.0f) + s0; hv.v[j] = h;
        am = fmaxf(fmaxf(am, fmaxf(fabsf(h[0]), fabsf(h[1]))), fmaxf(fabsf(h[2]), fabsf(h[3]))); }
    am = fmaxf(wave_max(am, lane), 1e-20f); const float inv = 127.0f / am;
#pragma unroll
    for (int j = 0; j < 4; ++j) *(unsigned*)(out + 4 * lane + 256 * j) = pk_i8x4(hv.v[j][0], hv.v[j][1], hv.v[j][2], hv.v[j][3], inv);
    if (lane == 0) *sarow = am * (1.0f / 127.0f);
}

struct Ptrs {
    const float* in[29]; float* out; unsigned char* ws;
};
typedef const __attribute__((address_space(4))) Ptrs* PK;
#define WSP(T, off) ((T*)(P->ws + (off)))

__device__ __forceinline__ unsigned pk_f16(float a, float b) { const f32x2 v = {a, b}; const f16x2 h = __builtin_convertvector(v, f16x2); return __builtin_bit_cast(unsigned, h); }
__device__ __forceinline__ void phase_first_norm(PK P, LAS unsigned char* lds, int gw, int tid) {
    const float* MOD = WSP(const float, WS_MOD);
    { const int lane = tid & 63;
    {
        const int gt = gw * 64 + lane;
        for (int q = gt; q < DEPTH * 9 * 4096; q += 131072) { const int lb = q >> 12, cc = q & 4095, c = cc >> 5, e = cc & 31, l = lb / 9, b = lb - 9 * l;
            const float* g = P->in[7] + (size_t)l * D + 8 * c; const float* sc = MOD + ((size_t)l * 9 + b) * 6144 + 4096 + 8 * c; const float* w = P->in[21] + ((size_t)l * D + 8 * c) * NEXP + e;
            float v[8];
#pragma unroll
            for (int j = 0; j < 8; ++j) v[j] = g[j] * (1.0f + sc[j]) * w[j * NEXP];
            u32x4 o; o.x = pk_f16(v[0], v[1]); o.y = pk_f16(v[2], v[3]); o.z = pk_f16(v[4], v[5]); o.w = pk_f16(v[6], v[7]);
            *(u32x4*)(WSP(unsigned char, WS_G16) + (size_t)lb * 65536 + e * 2048 + ((c ^ (e & 15)) * 16)) = o; }
        for (int q = gw; q < DEPTH * 9 * 32; q += 2048) { const int lb = q >> 5, e = q & 31, l = lb / 9, b = lb - 9 * l;
            const float* sh = MOD + ((size_t)l * 9 + b) * 6144 + 3072; const float* w = P->in[21] + (size_t)l * D * NEXP + e; float t = 0.f;
#pragma unroll
            for (int j = 0; j < 16; ++j) { const int k = lane + 64 * j; t += sh[k] * w[(size_t)k * NEXP]; }
            t = wave_sum(t, lane);
            if (lane == 0) WSP(float, WS_RC)[q] = t + P->in[22][l * NEXP + e]; }
    } }
    const int lane = tid & 63, vcu = gw >> 3, wid = gw & 7, bb = vcu >> 5;
    LAS float* vec = (LAS float*)lds;
    for (int i = tid; i < 1024; i += 512) { const int set = i >> 9, v = (i >> 8) & 1, k = 4 * (i & 255); const float* mod = MOD + (size_t)(set ? 8 : bb) * 6144;
        *(LAS f32x4*)(vec + set * 2048 + v * 1024 + k) = v ? *(const f32x4*)(mod + k) : *(const f32x4*)(P->in[6] + k) * (*(const f32x4*)(mod + 1024 + k) + 1.0f); }
    __syncthreads();
    const int rbase = bb * 2048 + (vcu & 31) * 64 + wid * 8;
    for (int p = 0; p < 3; ++p) {
        int rr[3]; Row4 x[3];
#pragma unroll
        for (int u = 0; u < 3; ++u) { const int q = 3 * p + u; rr[u] = q < 8 ? rbase + q : NL + vcu * 8 + wid;
            const int r = rr[u]; const float* src = r < NL ? P->in[0] + (size_t)r * D : P->in[2] + (size_t)(r - NL) * D; row_load(x[u], src, lane); }
#pragma unroll
        for (int u = 0; u < 3; ++u) { const int r = rr[u]; row_store_bf(x[u], WSP(bf16_t, WS_XS) + (size_t)r * D, lane);
            const float rstd = row_rstd(x[u], lane); const LAS float* vv = vec + (r < NL ? 0 : 2048) + 4 * lane;
            Row4 hv; float am = 0.f;
#pragma unroll
            for (int j = 0; j < 4; ++j) { const f32x4 h = (x[u].v[j] * rstd) * *(const LAS f32x4*)(vv + 256 * j) + *(const LAS f32x4*)(vv + 1024 + 256 * j); hv.v[j] = h;
                am = fmaxf(fmaxf(am, fmaxf(fabsf(h[0]), fabsf(h[1]))), fmaxf(fabsf(h[2]), fabsf(h[3]))); }
            am = fmaxf(wave_max(am, lane), 1e-20f); const float inv = 127.0f / am; unsigned char* out = WSP(unsigned char, WS_H) + (size_t)r * D;
#pragma unroll
            for (int j = 0; j < 4; ++j) *(unsigned*)(out + 4 * lane + 256 * j) = pk_i8x4(hv.v[j][0], hv.v[j][1], hv.v[j][2], hv.v[j][3], inv);
            if (lane == 0) WSP(float, WS_SAH)[r] = am * (1.0f / 127.0f); }
    }
}
__device__ __forceinline__ void phase_mla_norm(PK P, int gw, int lane) {
    const float* Y = WSP(const float, WS_Y416); bf16_t* CQ = WSP(bf16_t, WS_CQKV); bf16_t* KR = WSP(bf16_t, WS_KR);
    const float* qn = P->in[16]; const float* kn = P->in[17]; const float* rope = WSP(const float, WS_ROPE_C);
    const f32x4 g = *(const f32x4*)(qn + 4 * lane); const f32x2 g2 = *(const f32x2*)(kn + 2 * lane);
    for (int r0 = gw; r0 < NT; r0 += 4096) {
        const int rr[2] = {r0, (r0 + 2048 < NT) ? r0 + 2048 : r0};
        f32x4 vq[2]; f32x2 vk[2], vr[2];
#pragma unroll
        for (int u = 0; u < 2; ++u) { const float* y = Y + (size_t)rr[u] * C_INP; vq[u] = *(const f32x4*)(y + 4 * lane); vk[u] = *(const f32x2*)(y + 256 + 2 * lane); vr[u] = *(const f32x2*)(y + 384 + 2 * (lane & 15)); }
#pragma unroll
        for (int u = 0; u < 2; ++u) { const int r = rr[u]; const f32x4 v = vq[u];
            const float ss = wave_sum((v[0] * v[0] + v[1] * v[1]) + (v[2] * v[2] + v[3] * v[3]), lane);
            const float rq = 1.0f / sqrtf(ss * (1.0f / 256.0f) + NORM_EPS);
            u32x2 w; w.x = cvt_pk_bf16(v[0] * rq * g[0], v[1] * rq * g[1]); w.y = cvt_pk_bf16(v[2] * rq * g[2], v[3] * rq * g[3]);
            *(u32x2*)(CQ + (size_t)r * C_UPK + 4 * lane) = w;
            const f32x2 k2 = vk[u];
            const float s2 = wave_sum(k2[0] * k2[0] + k2[1] * k2[1], lane);
            const float rk = 1.0f / sqrtf(s2 * (1.0f / 128.0f) + NORM_EPS);
            *(unsigned*)(CQ + (size_t)r * C_UPK + 256 + 2 * lane) = cvt_pk_bf16(k2[0] * rk * g2[0], k2[1] * rk * g2[1]);
            if (lane < 16) { f32x2 p = vr[u];
                if (r < NL) { const f32x2 cs = *(const f32x2*)(rope + ((size_t)(r & (SEQ - 1)) * 16 + lane) * 2); const float a = p[0], b = p[1]; p[0] = a * cs[0] - b * cs[1]; p[1] = a * cs[1] + b * cs[0]; }
                *(unsigned*)(KR + (size_t)r * 32 + 2 * lane) = cvt_pk_bf16(p[0], p[1]); }
        }
    }
}
__device__ __forceinline__ void moe_tables(LAS unsigned char* misc, unsigned* gcnt, int tid) {
    LAS int* ecnt = (LAS int*)(misc + M_ECNT); LAS int* lbase = (LAS int*)(misc + M_LBASE); LAS int* cumt = (LAS int*)(misc + M_CUMT);
    if (tid < 32) ecnt[tid] = (int)__hip_atomic_load(gcnt + tid * 16, __ATOMIC_RELAXED, __HIP_MEMORY_SCOPE_AGENT);
    __syncthreads();
    if (tid == 0) { int s = 0, t = 0; for (int e = 0; e < 32; ++e) { lbase[e] = s; cumt[e] = t; const int mt = (ecnt[e] + 255) >> 8; s += mt * 256; t += mt; } cumt[32] = t; }
    __syncthreads();
}
constexpr int RT_PLOG = 65536, RT_LOGIT = 98304, RT_SSQ = 102912, RT_RSTD = 103936, RT_CVEC = 104064, RT_AMX = 104192, RT_TOPV = 105216, RT_TOPE = 105728, RT_VA = 106496, RT_VB = 110592;
__device__ __forceinline__ void phase_router(PK P, LAS unsigned char* lds, int l, int nrows, int vcu, int tid, int cset) {
    const int lane = tid & 63, wid = __builtin_amdgcn_readfirstlane(tid >> 6), i32 = lane & 31, hi = lane >> 5;
    LAS unsigned char* misc = lds + MISC_OFF;
    LAS int* lcnt = (LAS int*)(misc + M_LCNT); LAS int* gbase = (LAS int*)(misc + M_GBASE); LAS int* rec = (LAS int*)(misc + M_REC);
    LAS float* plog = (LAS float*)(lds + RT_PLOG); LAS float* logit = (LAS float*)(lds + RT_LOGIT); LAS float* ssq = (LAS float*)(lds + RT_SSQ);
    LAS float* rstd_s = (LAS float*)(lds + RT_RSTD); LAS float* cvec = (LAS float*)(lds + RT_CVEC); LAS float* amx = (LAS float*)(lds + RT_AMX); LAS float* rowsa = (LAS float*)(misc + M_RSA); LAS float* topv = (LAS float*)(lds + RT_TOPV); LAS int* tope = (LAS int*)(lds + RT_TOPE);
    const bool last = (nrows == NL);
    const int nb = (!last && vcu < 64) ? 3 : 2;
    const float* MOD = WSP(const float, WS_MOD) + (size_t)l * 9 * 6144;
    const bf16_t* XS = WSP(const bf16_t, WS_XS); unsigned char* H8 = WSP(unsigned char, WS_H);
    int* TOPE = WSP(int, WS_TOPE); float* GATE = WSP(float, WS_GATE);
    const float* gn = P->in[7] + (size_t)l * D;
    if (tid < 32) lcnt[tid] = 0;
    u32x4 nw[8];
#define RT_ROW0(b) ((b) < 2 ? 64 * vcu + 32 * (b) : NL + 32 * vcu)
    { const bf16_t* xp0 = XS + (size_t)(RT_ROW0(0) + i32) * D + 128 * wid + 8 * hi;
#pragma unroll
      for (int s = 0; s < 8; ++s) nw[s] = *(const u32x4*)(xp0 + 16 * s); }
    for (int bi = 0; bi < nb; ++bi) {
        const int rb = bi < 2 ? (vcu >> 5) : 8;
        const int row0 = RT_ROW0(bi);
        if (bi != 1) {
            __syncthreads();
            const u32x4* gsrc = (const u32x4*)(WSP(const unsigned char, WS_G16) + (size_t)(l * 9 + rb) * 65536);
#pragma unroll
            for (int c = 0; c < 8; ++c) *(LAS u32x4*)(lds + (size_t)(tid + 512 * c) * 16) = gsrc[tid + 512 * c];
            if (tid < 32) cvec[tid] = WSP(const float, WS_RC)[(l * 9 + rb) * 32 + tid];
            { const float* mod = MOD + (size_t)rb * 6144; const int k = 4 * (tid & 255);
              if (tid < 256) *(LAS f32x4*)(lds + RT_VA + 4 * k) = *(const f32x4*)(gn + k) * (*(const f32x4*)(mod + 4096 + k) + 1.0f);
              else *(LAS f32x4*)(lds + RT_VB + 4 * k) = *(const f32x4*)(mod + 3072 + k); }
            __syncthreads();
        }
        const int r = row0 + i32;
        f32x4 xa[8], xb[8];
#pragma unroll
        for (int s = 0; s < 8; ++s) { const u32x4 w = nw[s];
            xa[s] = (f32x4){bf_lo(w.x), bf_hi(w.x), bf_lo(w.y), bf_hi(w.y)}; xb[s] = (f32x4){bf_lo(w.z), bf_hi(w.z), bf_lo(w.w), bf_hi(w.w)}; }
        if (bi + 1 < nb) { const bf16_t* xpn = XS + (size_t)(RT_ROW0(bi + 1) + i32) * D + 128 * wid + 8 * hi;
#pragma unroll
            for (int s = 0; s < 8; ++s) nw[s] = *(const u32x4*)(xpn + 16 * s); }
        float ss = 0.f;
        f32x16 acc;
#pragma unroll
        for (int q = 0; q < 16; ++q) acc[q] = 0.f;
#pragma unroll
        for (int s = 0; s < 8; ++s) {
            ss += (xa[s][0] * xa[s][0] + xa[s][1] * xa[s][1]) + (xa[s][2] * xa[s][2] + xa[s][3] * xa[s][3]) + (xb[s][0] * xb[s][0] + xb[s][1] * xb[s][1]) + (xb[s][2] * xb[s][2] + xb[s][3] * xb[s][3]);
            u32x4 aw; aw.x = pk_f16(xa[s][0], xa[s][1]); aw.y = pk_f16(xa[s][2], xa[s][3]); aw.z = pk_f16(xb[s][0], xb[s][1]); aw.w = pk_f16(xb[s][2], xb[s][3]);
            const int c = 16 * wid + 2 * s + hi;
            const f16x8 bf = *(const LAS f16x8*)(lds + i32 * 2048 + ((c ^ (i32 & 15)) * 16));
            acc = __builtin_amdgcn_mfma_f32_32x32x16_f16(__builtin_bit_cast(f16x8, aw), bf, acc, 0, 0, 0);
        }
        ss = swap32_sum(ss);
        if (hi == 0) ssq[wid * 32 + i32] = ss;
#pragma unroll
        for (int q = 0; q < 16; ++q) plog[(wid * 32 + att::crow(q, hi)) * 32 + i32] = acc[q];
        __syncthreads();
        if (tid < 32) { float t = 0.f;
#pragma unroll
            for (int w = 0; w < 8; ++w) t += ssq[w * 32 + tid];
            rstd_s[tid] = 1.0f / sqrtf(t * (1.0f / D) + NORM_EPS); }
        __syncthreads();
#pragma unroll
        for (int u = 0; u < 2; ++u) { const int idx = tid + 512 * u, rr = idx >> 5, e = idx & 31; float t = 0.f;
#pragma unroll
            for (int w = 0; w < 8; ++w) t += plog[(w * 32 + rr) * 32 + e];
            logit[rr * 33 + e] = rstd_s[rr] * t + cvec[e]; }
        { const float rs = rstd_s[i32]; const int k0 = 128 * wid + 8 * hi; float am = 0.f;
          const LAS float* va = (const LAS float*)(lds + RT_VA); const LAS float* vb = (const LAS float*)(lds + RT_VB);
#pragma unroll
          for (int s = 0; s < 8; ++s) { const int k = k0 + 16 * s;
              const f32x4 a0 = *(const LAS f32x4*)(va + k), a1 = *(const LAS f32x4*)(va + k + 4), s0 = *(const LAS f32x4*)(vb + k), s1 = *(const LAS f32x4*)(vb + k + 4);
              const f32x4 h0 = (xa[s] * rs) * a0 + s0, h1 = (xb[s] * rs) * a1 + s1; xa[s] = h0; xb[s] = h1;
              am = fmaxf(fmaxf(fmaxf(am, fabsf(h0[0])), fmaxf(fabsf(h0[1]), fabsf(h0[2]))), fmaxf(fmaxf(fabsf(h0[3]), fabsf(h1[0])), fmaxf(fabsf(h1[1]), fmaxf(fabsf(h1[2]), fabsf(h1[3]))))); }
          am = swap32_max(am);
          if (hi == 0) amx[wid * 32 + i32] = am; }
        __syncthreads();
        { float a = amx[i32];
#pragma unroll
          for (int w = 1; w < 8; ++w) a = fmaxf(a, amx[w * 32 + i32]);
          a = fmaxf(a, 1e-20f); const float inv = 127.0f / a;
          if (wid == 0 && hi == 0) rowsa[32 * bi + i32] = a * (1.0f / 127.0f);
          unsigned char* hp = H8 + (size_t)r * D + 128 * wid + 8 * hi;
#pragma unroll
          for (int s = 0; s < 8; ++s) { u32x2 w; w.x = pk_i8x4(xa[s][0], xa[s][1], xa[s][2], xa[s][3], inv); w.y = pk_i8x4(xb[s][0], xb[s][1], xb[s][2], xb[s][3], inv); *(u32x2*)(hp + 16 * s) = w; } }
#pragma unroll
        for (int u = 0; u < 2; ++u) { const int idx = tid + 512 * u, rr = idx >> 5, e = idx & 31; const float v = logit[rr * 33 + e]; int rank = 0;
#pragma unroll 8
            for (int e2 = 0; e2 < 32; ++e2) { const float v2 = logit[rr * 33 + e2]; rank += (v2 > v || (v2 == v && e2 < e)) ? 1 : 0; }
            if (rank < 4) { topv[rr * 4 + rank] = v; tope[rr * 4 + rank] = e; } }
        __syncthreads();
        if (tid < 32) {
            const float t0 = topv[tid * 4], t1 = topv[tid * 4 + 1], t2 = topv[tid * 4 + 2], t3 = topv[tid * 4 + 3]; const int e0 = tope[tid * 4], e1 = tope[tid * 4 + 1], e2 = tope[tid * 4 + 2], e3 = tope[tid * 4 + 3];
            const float x1 = __expf(t1 - t0), x2 = __expf(t2 - t0), x3 = __expf(t3 - t0); const float inv = 1.0f / (1.0f + x1 + x2 + x3);
            const int rr = row0 + tid, lr = 32 * bi + tid;
            *(int4*)(TOPE + (size_t)rr * 4) = make_int4(e0, e1, e2, e3);
            *(f32x4*)(GATE + (size_t)rr * 4) = (f32x4){inv, x1 * inv, x2 * inv, x3 * inv};
            const int ee[4] = {e0, e1, e2, e3};
#pragma unroll
            for (int k = 0; k < 4; ++k) { const int lp = __hip_atomic_fetch_add(lcnt + ee[k], 1, __ATOMIC_RELAXED, __HIP_MEMORY_SCOPE_WORKGROUP); rec[2 * (lr * 4 + k)] = ee[k]; rec[2 * (lr * 4 + k) + 1] = lp; }
        }
    }
    __syncthreads();
    unsigned* gcnt = WSP(unsigned, WS_CTL) + CW_CNT + (l * 2 + cset) * 512;
    if (tid < 32) { const int c = lcnt[tid]; gbase[tid] = c ? (int)__hip_atomic_fetch_add(gcnt + tid * 16, (unsigned)c, __ATOMIC_RELAXED, __HIP_MEMORY_SCOPE_AGENT) : 0; }
    __syncthreads();
    int* ELIST = WSP(int, WS_ELIST); int* POS = WSP(int, WS_POS);
    for (int idx = tid; idx < nb * 128; idx += 512) { const int e = rec[2 * idx], pos = gbase[e] + rec[2 * idx + 1]; const int lr = idx >> 2; const int r = lr < 64 ? 64 * vcu + lr : NL + 32 * vcu + (lr - 64);
        ELIST[(size_t)e * NT + pos] = r; POS[(size_t)r * 4 + (idx & 3)] = pos; WSP(float, WS_SAL)[(size_t)e * NT + pos] = rowsa[lr]; }
    __syncthreads();
}
constexpr int RQU = 8;
__device__ __forceinline__ unsigned rq4(unsigned w, float fac, float c0) {
    const float t0 = (float)(w & 255u) * fac + c0, t1 = (float)((w >> 8) & 255u) * fac + c0, t2 = (float)((w >> 16) & 255u) * fac + c0, t3 = (float)(w >> 24) * fac + c0;
    const unsigned lo = __builtin_amdgcn_perm(__float_as_uint(t1), __float_as_uint(t0), 0x0c0c0400u), hi = __builtin_amdgcn_perm(__float_as_uint(t3), __float_as_uint(t2), 0x0c0c0400u);
    return lo | (hi << 16);
}
__device__ __forceinline__ void phase_requant(PK P, const LAS int* cumt, int gw, int lane) {
    const int nrows = __builtin_amdgcn_readfirstlane(cumt[32]) * 256;
    const int per = (nrows + 2047) >> 11, np = (per + RQU - 1) / RQU, nu = np > 0 ? (per + np - 1) / np : 0;
    const unsigned char* AQ = WSP(const unsigned char, WS_ACT); const float* SB = WSP(const float, WS_SBLK); unsigned char* A8 = WSP(unsigned char, WS_ACT8); float* SAQ = WSP(float, WS_SAQ);
    for (int r0 = gw; r0 < nrows; r0 += nu * 2048) {
        u32x4 a[RQU]; float sb[RQU];
#pragma unroll
        for (int u = 0; u < RQU; ++u) { const int r = r0 + u * 2048; a[u] = (u32x4){0u, 0u, 0u, 0u}; sb[u] = 1.0f;
            if (u < nu && r < nrows) { a[u] = *(const u32x4*)(AQ + (size_t)r * D + 16 * lane); sb[u] = SB[(size_t)r * 32 + (lane >> 1)]; } }
#pragma unroll
        for (int u = 0; u < RQU; ++u) { const int r = r0 + u * 2048;
            if (u < nu && r < nrows) {
                const float srow = wave_max(sb[u], lane); const float fac = sb[u] * __builtin_amdgcn_rcpf(srow), c0 = 12582912.0f - 128.0f * fac;
                u32x4 w; w.x = rq4(a[u].x, fac, c0); w.y = rq4(a[u].y, fac, c0); w.z = rq4(a[u].z, fac, c0); w.w = rq4(a[u].w, fac, c0);
                *(u32x4*)(A8 + (size_t)r * D + 16 * lane) = w;
                if (lane == 0) SAQ[r] = srow; }
        }
    }
}
constexpr int CBU = 3;
__device__ __forceinline__ void phase_combine(PK P, LAS unsigned char* lds, int l, int nrows, int gw, int tid, bool dry) {
    (void)dry; (void)nrows;
    const int lane = tid & 63, vcu = gw >> 3, wid = gw & 7;
    LAS unsigned char* misc = lds + MISC_OFF;
    if (MK_PER_PHASE) moe_tables(misc, WSP(unsigned, WS_CTL) + CW_CNT + (l * 2 + ((MK_REP_MASK >> 11) & 1)) * 512, tid);
    const LAS int* lbase = (const LAS int*)(misc + M_LBASE);
    const float* MOD = WSP(const float, WS_MOD);
    bf16_t* XS = WSP(bf16_t, WS_XS); const unsigned char* YSQ = WSP(const unsigned char, WS_YS); const float* YSB = WSP(const float, WS_YSB);
    const int* TOPE = WSP(const int, WS_TOPE); const int* POS = WSP(const int, WS_POS); const float* GATE = WSP(const float, WS_GATE);
    const bool last = (l == DEPTH - 1);
    const int bb = vcu >> 5;
    LAS float* vec = (LAS float*)lds;
    for (int i = tid; i < (last ? 1 : 2) * 768; i += 512) { const int set = i / 768, v = (i % 768) >> 8, k = 4 * (i & 255), rb = set ? 8 : bb;
        f32x4 w;
        if (v == 0) w = *(const f32x4*)(MOD + (size_t)l * 9 * 6144 + 5120 + (size_t)rb * 6144 + k);
        else if (last) w = *(const f32x4*)(P->in[8] + k);
        else { const float* mod = MOD + (size_t)(l + 1) * 9 * 6144 + (size_t)rb * 6144;
            w = (v == 1) ? *(const f32x4*)(P->in[6] + (size_t)(l + 1) * D + k) * (*(const f32x4*)(mod + 1024 + k) + 1.0f) : *(const f32x4*)(mod + k); }
        *(LAS f32x4*)(vec + set * 3072 + v * 1024 + k) = w; }
    __syncthreads();
    const int rbase = bb * 2048 + (vcu & 31) * 64 + wid * 8;
    for (int p = 0; p < 3; ++p) {
        int rr[CBU]; int vs[CBU];
#pragma unroll
        for (int u = 0; u < CBU; ++u) { const int q = 3 * p + u; const bool cx = (q == 8) && !last;
            rr[u] = q < 8 ? rbase + q : (last ? rbase + 6 : NL + vcu * 8 + wid); vs[u] = cx ? 3072 : 0; }
        int slot[CBU]; float gate[CBU];
#pragma unroll
        for (int u = 0; u < CBU; ++u) { slot[u] = 0; gate[u] = 0.f;
            if (lane < 4 && !(last && 3 * p + u == 8)) { slot[u] = lbase[TOPE[(size_t)rr[u] * 4 + lane]] + POS[(size_t)rr[u] * 4 + lane]; gate[u] = GATE[(size_t)rr[u] * 4 + lane]; } }
        u32x2 xw[CBU][4]; unsigned yw[CBU][4][4]; float ys[CBU][4][4];
#pragma unroll
        for (int u = 0; u < CBU; ++u) { if (last && 3 * p + u == 8) continue;
#pragma unroll
            for (int j = 0; j < 4; ++j) xw[u][j] = *(const u32x2*)(XS + (size_t)rr[u] * D + 4 * lane + 256 * j);
#pragma unroll
            for (int k = 0; k < 4; ++k) { const int sk = __builtin_amdgcn_readlane(slot[u], k); const unsigned char* yr = YSQ + (size_t)sk * D; const float* yb = YSB + (size_t)sk * 32 + (lane >> 3);
#pragma unroll
                for (int j = 0; j < 4; ++j) { yw[u][k][j] = *(const unsigned*)(yr + 4 * lane + 256 * j); ys[u][k][j] = yb[8 * j]; } } }
#pragma unroll
        for (int u = 0; u < CBU; ++u) { if (last && 3 * p + u == 8) continue;
            const int r = rr[u]; const LAS float* vv = vec + vs[u] + 4 * lane;
            Row4 x, f;
#pragma unroll
            for (int j = 0; j < 4; ++j) { x.v[j] = (f32x4){bf_lo(xw[u][j].x), bf_hi(xw[u][j].x), bf_lo(xw[u][j].y), bf_hi(xw[u][j].y)}; f.v[j] = (f32x4){0.f, 0.f, 0.f, 0.f}; }
#pragma unroll
            for (int k = 0; k < 4; ++k) { const float gk = __int_as_float(__builtin_amdgcn_readlane(__float_as_int(gate[u]), k));
#pragma unroll
                for (int j = 0; j < 4; ++j) { const unsigned w = yw[u][k][j]; const float gs = gk * ys[u][k][j], g0 = -128.0f * gs;
                    f.v[j][0] += (float)(w & 255u) * gs + g0; f.v[j][1] += (float)((w >> 8) & 255u) * gs + g0; f.v[j][2] += (float)((w >> 16) & 255u) * gs + g0; f.v[j][3] += (float)(w >> 24) * gs + g0; } }
#pragma unroll
            for (int j = 0; j < 4; ++j) { const f32x4 gg = *(const LAS f32x4*)(vv + 256 * j); x.v[j] = x.v[j] + gg * f.v[j]; }
            const float rstd = row_rstd(x, lane);
            if (last) {
#pragma unroll
                for (int j = 0; j < 4; ++j) { const int c = 4 * lane + 256 * j; *(f32x4*)(P->out + (size_t)r * D + c) = (x.v[j] * rstd) * *(const LAS f32x4*)(vv + 1024 + 256 * j); }
            } else {
                row_store_bf(x, XS + (size_t)r * D, lane);
                Row4 hv; float am = 0.f;
#pragma unroll
                for (int j = 0; j < 4; ++j) { const f32x4 h = (x.v[j] * rstd) * *(const LAS f32x4*)(vv + 1024 + 256 * j) + *(const LAS f32x4*)(vv + 2048 + 256 * j); hv.v[j] = h;
                    am = fmaxf(fmaxf(am, fmaxf(fabsf(h[0]), fabsf(h[1]))), fmaxf(fabsf(h[2]), fabsf(h[3]))); }
                if ((l + 1) % 3 == 2) row_store_bf(hv, WSP(bf16_t, WS_H) + (size_t)r * D, lane);
                else { am = fmaxf(wave_max(am, lane), 1e-20f); const float inv = 127.0f / am; unsigned char* out = WSP(unsigned char, WS_H) + (size_t)r * D;
#pragma unroll
                    for (int j = 0; j < 4; ++j) *(unsigned*)(out + 4 * lane + 256 * j) = pk_i8x4(hv.v[j][0], hv.v[j][1], hv.v[j][2], hv.v[j][3], inv);
                    if (lane == 0) WSP(float, WS_SAH)[r] = am * (1.0f / 127.0f); }
            }
        }
    }
}
__device__ __forceinline__ void phase_final_norm(PK P, int gw, int lane) {
    for (int r = gw; r < NL; r += 2048) { Row4 x; row_load_bf(x, WSP(const bf16_t, WS_XS) + (size_t)r * D, lane); const float rstd = row_rstd(x, lane);
#pragma unroll
        for (int j = 0; j < 4; ++j) { const int c = 4 * lane + 256 * j; const f32x4 gn = *(const f32x4*)(P->in[8] + c); *(f32x4*)(P->out + (size_t)r * D + c) = x.v[j] * rstd * gn; } }
}

__device__ __forceinline__ void conv_item(const float* src, int N, int nvalid, int k0, int n0, bf16_t* dst, int ldk, int drow0, int dk0, LAS unsigned* scr, int lane) {
    const int q = lane >> 4, nl = lane & 15, n = n0 + 4 * nl;
    f32x4 v[16];
#pragma unroll
    for (int r = 0; r < 16; ++r) { const int k = k0 + 8 * (r >> 1) + 2 * q + (r & 1);
        v[r] = (n < nvalid) ? __builtin_nontemporal_load((const f32x4*)(src + (size_t)k * N + n)) : (f32x4){0.f, 0.f, 0.f, 0.f}; }
#pragma unroll
    for (int rp = 0; rp < 8; ++rp)
#pragma unroll
        for (int i = 0; i < 4; ++i) { const int nn = 4 * nl + i, kw = 4 * rp + q; scr[nn * 32 + (kw ^ (4 * ((nn >> 2) & 7)))] = cvt_pk_bf16(v[2 * rp][i], v[2 * rp + 1][i]); }
    asm volatile("s_waitcnt lgkmcnt(0)" ::: "memory");
#pragma unroll
    for (int it = 0; it < 8; ++it) { const int nn = 8 * it + (lane >> 3), c = lane & 7;
        const u32x4 w = *(const LAS u32x4*)(scr + nn * 32 + 4 * (c ^ ((nn >> 2) & 7)));
        *(u32x4*)(dst + (size_t)(drow0 + nn) * ldk + dk0 + 8 * c) = w; }
    asm volatile("s_waitcnt lgkmcnt(0)" ::: "memory");
}
constexpr int CV_A_IN = 2 * 16 * 24, CV_A_OUT = 2 * 256, CV_B_IN = 16 * 48, CV_B_OUT = 256, CV_C_IN = 16 * 8, CV_C_UQ = 4 * 24, CV_C_UKV = 2 * 32, CV_C_OUT = 256;
constexpr int CV_SMALL = CV_A_IN + CV_A_OUT + CV_B_IN + CV_B_OUT + CV_C_IN + CV_C_UQ + CV_C_UKV + CV_C_OUT;
constexpr int CV_LAYER = NEXP * 3 * 256;
constexpr int CV_TOTAL = CV_SMALL + DEPTH * CV_LAYER;
constexpr int CV_CHUNK = 32;
__device__ __forceinline__ void conv_dispatch(PK P, int item, LAS unsigned* scr, int lane) {
    int r = item; const float* src; bf16_t* dst; int N, kb, nb, ldk = D, drow_off = 0, dk_off = 0;
    if (r < CV_A_IN) return;
    else if ((r -= CV_A_IN) < CV_A_OUT) { const int s = r / 256, it = r % 256; kb = it / 16; nb = it % 16; src = P->in[10] + (size_t)s * D * D; N = D; dst = WSP(bf16_t, WS_WA_OUT) + (size_t)s * D * D; }
    else if ((r -= CV_A_OUT) < CV_B_IN) return;
    else if ((r -= CV_B_IN) < CV_B_OUT) { kb = r / 16; nb = r % 16; src = P->in[13]; N = D; dst = WSP(bf16_t, WS_WB_OUT); }
    else if ((r -= CV_B_OUT) < CV_C_IN) { kb = r / 8; nb = r % 8; src = P->in[15]; N = C_IN; dst = WSP(bf16_t, WS_WC_IN); }
    else if ((r -= CV_C_IN) < CV_C_UQ) { kb = r / 24; nb = r % 24; src = P->in[18]; N = 1536; dst = WSP(bf16_t, WS_WC_UP); ldk = C_UPK; }
    else if ((r -= CV_C_UQ) < CV_C_UKV) { kb = r / 32; nb = r % 32; src = P->in[19]; N = 2048; dst = WSP(bf16_t, WS_WC_UP); ldk = C_UPK; drow_off = 1536; dk_off = 256; }
    else { r -= CV_C_UKV; kb = r / 16; nb = r % 16; src = P->in[20]; N = D; dst = WSP(bf16_t, WS_WC_OUT); }
    conv_item(src, N, N, 64 * kb, 64 * nb, dst, ldk, drow_off + 64 * nb, dk_off + 64 * kb, scr, lane);
}
__device__ __forceinline__ void conv_down_item(PK P, int L, int di, LAS unsigned* scr, int lane) {
    const int le = L * NEXP + (di >> 8), it = di & 255, kb = it >> 4, nb = it & 15;
    conv_item(P->in[27] + (size_t)le * D * D, D, D, 64 * kb, 64 * nb, WSP(bf16_t, WS_WD) + (size_t)le * D * D, D, 64 * nb, 64 * kb, scr, lane);
}
__device__ __forceinline__ void conv_q8_block(const float* src0, int N, unsigned char* dstq, float* dsts, LAS unsigned char* lds, int tid) {
    const int lane = tid & 63, wid = __builtin_amdgcn_readfirstlane(tid >> 6), q = lane >> 4, nl = lane & 15;
    const float* src = src0 + 4 * nl;
    f32x4 v[32];
#pragma unroll
    for (int r = 0; r < 32; ++r) { const int k = 128 * wid + 16 * (r >> 2) + 4 * q + (r & 3); v[r] = __builtin_nontemporal_load((const f32x4*)(src + (size_t)k * N)); }
    float cm[4] = {0.f, 0.f, 0.f, 0.f};
#pragma unroll
    for (int r = 0; r < 32; ++r)
#pragma unroll
        for (int i = 0; i < 4; ++i) cm[i] = fmaxf(cm[i], fabsf(v[r][i]));
    LAS float* cmx = (LAS float*)(lds + 65536);
#pragma unroll
    for (int i = 0; i < 4; ++i) { cm[i] = fmaxf(cm[i], shx(cm[i], 16, lane)); cm[i] = swap32_max(cm[i]); }
    if (q == 0) { *(LAS f32x4*)(cmx + wid * 64 + 4 * nl) = (f32x4){cm[0], cm[1], cm[2], cm[3]}; }
    __syncthreads();
    f32x4 a = *(const LAS f32x4*)(cmx + 4 * nl);
#pragma unroll
    for (int w = 1; w < 8; ++w) { const f32x4 b = *(const LAS f32x4*)(cmx + w * 64 + 4 * nl); a[0] = fmaxf(a[0], b[0]); a[1] = fmaxf(a[1], b[1]); a[2] = fmaxf(a[2], b[2]); a[3] = fmaxf(a[3], b[3]); }
    float inv[4];
#pragma unroll
    for (int i = 0; i < 4; ++i) { a[i] = fmaxf(a[i], 1e-30f); inv[i] = 127.0f / a[i]; }
    if (wid == 0 && q == 0) *(f32x4*)(dsts + 4 * nl) = a * (1.0f / 127.0f);
    LAS unsigned* scr = (LAS unsigned*)(lds + wid * 8192);
#pragma unroll
    for (int rp = 0; rp < 8; ++rp)
#pragma unroll
        for (int i = 0; i < 4; ++i) { const int nn = 4 * nl + i, kw = 4 * rp + q;
            scr[nn * 32 + (kw ^ (4 * ((nn >> 2) & 7)))] = pk_i8x4(v[4 * rp][i], v[4 * rp + 1][i], v[4 * rp + 2][i], v[4 * rp + 3][i], inv[i]); }
    asm volatile("s_waitcnt lgkmcnt(0)" ::: "memory");
    unsigned char* dst = dstq + 128 * wid;
#pragma unroll
    for (int it = 0; it < 8; ++it) { const int nn = 8 * it + (lane >> 3), c = lane & 7;
        const u32x4 w = *(const LAS u32x4*)(scr + nn * 32 + 4 * (c ^ ((nn >> 2) & 7)));
        *(u32x4*)(dst + (size_t)nn * D + 16 * c) = w; }
    __syncthreads();
}
__device__ __forceinline__ void conv_gu_block(PK P, LAS unsigned char* lds, int le, int which, int nb, int tid) {
    const int n0 = 64 * nb, drow0 = 256 * (n0 >> 7) + (n0 & 127) + (which ? 128 : 0);
    conv_q8_block(P->in[which ? 25 : 23] + (size_t)le * D * D + n0, D, WSP(unsigned char, WS_WGU) + ((size_t)le * 2048 + drow0) * D, WSP(float, WS_SBW) + (size_t)le * 2048 + drow0, lds, tid);
}
__device__ __forceinline__ void conv_in_block(PK P, LAS unsigned char* lds, int blk, int tid) {
    if (blk < 48) { const int s = blk / 24, nb = blk % 24;
        conv_q8_block(P->in[9] + (size_t)s * D * A_IN + 64 * nb, A_IN, WSP(unsigned char, WS_WA_IN) + ((size_t)s * A_IN + 64 * nb) * D, WSP(float, WS_SBI) + s * A_IN + 64 * nb, lds, tid); }
    else { const int nb = blk - 48;
        conv_q8_block(P->in[12] + 64 * nb, B_IN, WSP(unsigned char, WS_WB_IN) + (size_t)64 * nb * D, WSP(float, WS_SBI) + 2 * A_IN + 64 * nb, lds, tid); }
}
constexpr int CV_SLOTS = 1536;
__device__ __forceinline__ void conv_slot(PK P, LAS unsigned char* lds, int L, int s, int tid) {
    if (s < 1024) { conv_gu_block(P, lds, L * NEXP + (s >> 5), (s >> 4) & 1, s & 15, tid); return; }
    const int d = s - 1024, le = L * NEXP + (d >> 4), nb = d & 15;
    conv_q8_block(P->in[27] + (size_t)le * D * D + 64 * nb, D, WSP(unsigned char, WS_WD) + ((size_t)le * D + 64 * nb) * D, WSP(float, WS_SBD) + (size_t)le * D + 64 * nb, lds, tid);
}
__device__ __forceinline__ void conv_claim(PK P, LAS unsigned char* lds, int L, int quota, int tid) {
    LAS int* slot = (LAS int*)(lds + MISC_OFF + M_CVB);
    unsigned* ctr = WSP(unsigned, WS_CTL) + CW_CV + L * 16;
    for (int q = 0; q < quota; ++q) {
        __syncthreads();
        if (tid == 0) *slot = (int)__hip_atomic_fetch_add(ctr, 1u, __ATOMIC_RELAXED, __HIP_MEMORY_SCOPE_AGENT);
        __syncthreads();
        const int sl = __builtin_amdgcn_readfirstlane(*slot);
        if (sl >= CV_SLOTS) break;
        conv_slot(P, lds, L, sl, tid);
    }
    __syncthreads();
}
__device__ __forceinline__ void phase_prologue(PK P, LAS unsigned char* lds, int bid, int tid) {
    const int lane = tid & 63, wid = __builtin_amdgcn_readfirstlane(tid >> 6);
    {
        LAS float* S = (LAS float*)lds; LAS float* red = (LAS float*)(lds + 40960);
        for (int idx = tid; idx < 9 * D; idx += 512) { const int r = idx >> 10, d = idx & (D - 1); const float v = r < 8 ? P->in[1][r * D + d] : P->in[3][d];
            S[idx] = v / (1.0f + __builtin_amdgcn_exp2f(-v * LOG2E)); }
        __syncthreads();
        const int l = bid >> 6, c0 = (bid & 63) * 96;
        if (lane < 48) {
            float acc[9][2];
#pragma unroll
            for (int r = 0; r < 9; ++r) { acc[r][0] = 0.f; acc[r][1] = 0.f; }
            const float* wp = P->in[4] + ((size_t)l * D + 128 * wid) * 6144 + c0 + 2 * lane;
            const LAS float* sp = S + 128 * wid;
            for (int kb = 0; kb < 128; kb += 32) {
                f32x2 w[32];
#pragma unroll
                for (int k = 0; k < 32; ++k) w[k] = __builtin_nontemporal_load((const f32x2*)(wp + (size_t)(kb + k) * 6144));
#pragma unroll
                for (int k = 0; k < 32; ++k)
#pragma unroll
                    for (int r = 0; r < 9; ++r) { const float s = sp[r * D + kb + k]; acc[r][0] += s * w[k][0]; acc[r][1] += s * w[k][1]; } }
#pragma unroll
            for (int r = 0; r < 9; ++r) { red[(wid * 9 + r) * 96 + 2 * lane] = acc[r][0]; red[(wid * 9 + r) * 96 + 2 * lane + 1] = acc[r][1]; }
        }
        __syncthreads();
        float* MOD = WSP(float, WS_MOD);
        for (int idx = tid; idx < 9 * 96; idx += 512) { const int r = idx / 96, cc = idx % 96; float s = 0.f;
#pragma unroll
            for (int w = 0; w < 8; ++w) s += red[(w * 9 + r) * 96 + cc];
            MOD[((size_t)l * 9 + r) * 6144 + c0 + cc] = s + P->in[5][(size_t)l * 6144 + c0 + cc]; }
        __syncthreads();
    }
    {
        const int gt = bid * 512 + tid; float* RA = WSP(float, WS_ROPE_A); float* RC = WSP(float, WS_ROPE_C);
        const float L2T = 13.287712379549449f;
        for (int idx = gt; idx < SEQ * 32; idx += 131072) { const int t = idx >> 5, i = idx & 31; const float pos = (float)(i < 16 ? (t >> 6) : (t & 63));
            const float inv = __builtin_amdgcn_exp2f(-(float)(i & 15) * (1.0f / 16.0f) * L2T); const float ang = pos * inv; RA[2 * idx] = __cosf(ang); RA[2 * idx + 1] = __sinf(ang); }
        for (int idx = gt; idx < SEQ * 16; idx += 131072) { const int t = idx >> 4, i = idx & 15; const float pos = (float)(i < 8 ? (t >> 6) : (t & 63));
            const float inv = __builtin_amdgcn_exp2f(-(float)(i & 7) * (1.0f / 8.0f) * L2T); const float ang = pos * inv; RC[2 * idx] = __cosf(ang); RC[2 * idx + 1] = __sinf(ang); }
        bf16_t* WU = WSP(bf16_t, WS_WC_UP); const u32x4 z = (u32x4){0u, 0u, 0u, 0u};
        for (int idx = gt; idx < 1536 * 16; idx += 131072) *(u32x4*)(WU + (size_t)(idx >> 4) * C_UPK + 256 + 8 * (idx & 15)) = z;
        for (int idx = gt; idx < 2048 * 32; idx += 131072) *(u32x4*)(WU + (size_t)(1536 + (idx >> 5)) * C_UPK + 8 * (idx & 31)) = z;
    }
    {
        LAS unsigned* scr = (LAS unsigned*)(lds + wid * 8192);
        const int gw = bid * 8 + wid;
        for (int item = gw; item < CV_SMALL; item += 2048) conv_dispatch(P, item, scr, lane);
        __syncthreads();
        for (int blk = bid; blk < 96; blk += 256) conv_in_block(P, lds, blk, tid);
        for (int sl = bid; sl < CV_SLOTS; sl += 256) conv_slot(P, lds, 0, sl, tid);
    }
}

constexpr int PH_PRO = 0, PH_N0 = 1, PH_L0 = 2, PH_PER_LAYER = 9, PH_FINAL = PH_L0 + DEPTH * PH_PER_LAYER, NPH = PH_FINAL + 1;
enum { LP_IN = 0, LP_MLANORM = 1, LP_MLAUP = 2, LP_ATT = 3, LP_OUT = 4, LP_RT = 5, LP_GU = 6, LP_DN = 7, LP_CB = 8 };
struct Args { Ptrs P; int p_lo, p_hi, bar_idx, pad; };

__global__ void __launch_bounds__(512, 2) mk_fwd(Args a) {
    extern __shared__ __attribute__((aligned(16))) unsigned char lds_raw[];
    LAS unsigned char* const lds = (LAS unsigned char*)lds_raw;
    LAS unsigned char* const misc = lds + MISC_OFF;
    typedef const __attribute__((address_space(4))) Args* ArgsK;
    const ArgsK ak = (ArgsK)__builtin_amdgcn_kernarg_segment_ptr();
    (void)a;
    const int wid0 = __builtin_amdgcn_readfirstlane((int)threadIdx.x >> 6);
    if (wid0 == 0 && lane_id() < 4) ((LAS unsigned*)(misc + M_BARW))[lane_id()] = 0u;
    __syncthreads();
    XcdBarrier bar;
    { PK P = &ak->P; bar = xcd_barrier_post(WSP(unsigned, WS_CTL) + CW_BAR + ak->bar_idx * XCD_BAR_WORDS, (volatile LAS unsigned*)(misc + M_BARW), wid0 == 0); }
    bool ran = false;
    const int p_lo = ak->p_lo, p_hi = ak->p_hi;
    int pcnt = 0; unsigned long long ts0 = 0ull, tsd = 0ull; (void)pcnt; (void)ts0; (void)tsd;
#define STAMP_HERE() do { if (MK_TIME_PHASE >= 0 && MK_TIME_PHASE < 1000) { if (pcnt == MK_TIME_PHASE) ts0 = __builtin_amdgcn_s_memrealtime(); if (pcnt == MK_TIME_PHASE + 1) tsd = __builtin_amdgcn_s_memrealtime() - ts0; ++pcnt; } } while (0)
#define PHASE_BEGIN(bit, p, cond) if ((((MK_MASK) >> (bit)) & 1) && p_lo <= (p) && (p) < p_hi && ((p) <= MK_STOP_AFTER || (p) == PH_FINAL) && (cond)) for (int rep_ = 0; rep_ < 1 + (((MK_REP_MASK) >> (bit)) & 1); ++rep_) { if (ran) xcd_barrier(bar); ran = true; STAMP_HERE(); \
    int tid = wid0 * 64 + lane_id(); asm volatile("" : "+v"(tid)); int bid = blockIdx.x; asm volatile("" : "+s"(bid)); ArgsK ak_ = ak; asm volatile("" : "+s"(ak_)); PK P = &ak_->P; \
    const int lane = tid & 63, wid = __builtin_amdgcn_readfirstlane(tid >> 6), vcu = (bid & 7) * 32 + (bid >> 3), gw = vcu * 8 + wid; (void)lane; (void)gw; (void)P;
#define PHASE_END }

    PHASE_BEGIN(0, PH_PRO, true) phase_prologue(P, lds, bid, tid); PHASE_END
    PHASE_BEGIN(1, PH_N0, true) phase_first_norm(P, lds, gw, tid); PHASE_END

    for (int l = 0; l < DEPTH; ++l) {
        const int kind = l % 3, slot = l / 3, pb = PH_L0 + l * PH_PER_LAYER;
        const bool last = (l == DEPTH - 1);
        const int nMrows = last ? NL / 256 : NT / 256;
        PHASE_BEGIN(2, pb + LP_IN, kind == 0) {
            pg8::Gemm g{WSP(const void, WS_H), WSP(const unsigned char, WS_WA_IN) + (size_t)slot * A_IN * D, D, 0, nullptr};
            pg8::DenseOrder S{nMrows, 6, vcu, last ? 8 : 0, 4, 2};
            pg8::EpiQkvA8 E{WSP(bf16_t, WS_QKV), WSP(const float, WS_ROPE_A), WSP(const float, WS_SAH), WSP(const float, WS_SBI) + slot * A_IN, (const LAS float*)(misc + M_EPF)};
            pg8::gemm_phase<pg8::EpiQkvA8, pg8::DenseOrder, false, true>(lds, g, S, E, tid);
            if (l >= 1 && S.short_one()) conv_claim(P, lds, l, MK_Q_IN, tid);
        } PHASE_END
        PHASE_BEGIN(3, pb + LP_IN, kind == 1) {
            pg8::Gemm g{WSP(const void, WS_H), WSP(const unsigned char, WS_WB_IN), D, 0, nullptr};
            pg8::DenseOrder S{NT / 256, 12, vcu, 0, 0, 0};
            pg8::EpiBf16Plain8 E{WSP(bf16_t, WS_QKV), B_IN, 4, 0.125f * LOG2E, WSP(const float, WS_SAH), WSP(const float, WS_SBI) + 2 * A_IN, (const LAS float*)(misc + M_EPF)};
            pg8::gemm_phase<pg8::EpiBf16Plain8, pg8::DenseOrder, false, true>(lds, g, S, E, tid);
            if (S.short_one()) conv_claim(P, lds, l, MK_Q_IN, tid);
        } PHASE_END
        PHASE_BEGIN(4, pb + LP_IN, kind == 2) {
            pg8::Gemm g{WSP(const bf16_t, WS_H), WSP(const bf16_t, WS_WC_IN), D, 0, nullptr};
            pg8::DenseOrder S{NT / 256, 2, vcu, 0, 0, 0};
            pg8::EpiF32Plain E{WSP(float, WS_Y416), C_INP};
            pg8::gemm_phase<pg8::EpiF32Plain, pg8::DenseOrder, false>(lds, g, S, E, tid);
            if (vcu >= 144) conv_claim(P, lds, l, 2 * MK_Q_ATT, tid);
        } PHASE_END
        PHASE_BEGIN(5, pb + LP_MLANORM, kind == 2) phase_mla_norm(P, gw, lane); PHASE_END
        PHASE_BEGIN(6, pb + LP_MLAUP, kind == 2) {
            pg8::Gemm g{WSP(const bf16_t, WS_CQKV), WSP(const bf16_t, WS_WC_UP), C_UPK, 0, nullptr};
            pg8::DenseOrder S{NT / 256, 14, vcu, 0, 0, 0};
            pg8::EpiMlaUp E{WSP(bf16_t, WS_QKV), WSP(const float, WS_ROPE_C)};
            pg8::gemm_phase<pg8::EpiMlaUp, pg8::DenseOrder, false>(lds, g, S, E, tid);
        } PHASE_END
        PHASE_BEGIN(7, pb + LP_ATT, kind == 0) {
            const bf16_t* QKV = WSP(const bf16_t, WS_QKV); bf16_t* O = WSP(bf16_t, WS_O); const float* sink = P->in[11] + slot * 16;
            for (int u = vcu, k = 0; u < 1024; u += 256, ++k) { int t_ = wid0 * 64 + lane_id(); asm volatile("" : "+v"(t_)); const int bk = u >> 5; att::attn_A_unit(lds, QKV, O, sink, bk >> 2, bk & 3, u & 31, false, t_);
                if (MK_Q_STAG > 0 && (vcu & 3) == k) conv_claim(P, lds, l >= 1 ? l : 1, MK_Q_STAG, t_); }
            if (!last) for (int u = vcu; u < 128; u += 256) { const int bk = u >> 2; att::attn_A_unit(lds, QKV, O, sink, bk >> 2, bk & 3, u & 3, true, tid); }
            if (!last && vcu >= 128) conv_claim(P, lds, l >= 1 ? l : 1, MK_Q_ATT, tid);
        } PHASE_END
        PHASE_BEGIN(8, pb + LP_ATT, kind == 1) {
            const bf16_t* QKV = WSP(const bf16_t, WS_QKV); bf16_t* O = WSP(bf16_t, WS_O); LAS float* tab = (LAS float*)(misc + M_RPB);
            for (int u = vcu, k = 0; u < 1024; u += 256, ++k) { int t_ = wid0 * 64 + lane_id(); asm volatile("" : "+v"(t_)); const int bh = u >> 3; att::attn_B_unit(lds, tab, QKV, O, P->in[14], bh >> 4, bh & 15, u & 7, false, t_);
                if (MK_Q_STAG > 0 && (vcu & 3) == k) conv_claim(P, lds, l, MK_Q_STAG, t_); }
            for (int u = vcu; u < 128; u += 256) att::attn_B_unit(lds, tab, QKV, O, P->in[14], u >> 4, u & 15, 0, true, tid);
            if (vcu >= 128) conv_claim(P, lds, l, MK_Q_ATT, tid);
        } PHASE_END
        PHASE_BEGIN(9, pb + LP_ATT, kind == 2) {
            const bf16_t* QKV = WSP(const bf16_t, WS_QKV); bf16_t* O = WSP(bf16_t, WS_O); const bf16_t* KR = WSP(const bf16_t, WS_KR);
            for (int u = vcu, k = 0; u < 1024; u += 256, ++k) { int t_ = wid0 * 64 + lane_id(); asm volatile("" : "+v"(t_)); const int bh = u >> 3; att::attn_C_unit(lds, QKV, KR, O, bh >> 4, bh & 15, u & 7, false, t_);
                if (MK_Q_STAG > 0 && (vcu & 3) == k) conv_claim(P, lds, l, MK_Q_STAG, t_); }
            for (int u = vcu; u < 128; u += 256) att::attn_C_unit(lds, QKV, KR, O, u >> 4, u & 15, 0, true, tid);
            if (vcu >= 128) conv_claim(P, lds, l, MK_Q_ATT, tid);
        } PHASE_END
        PHASE_BEGIN(10, pb + LP_OUT, true) {
            const bf16_t* W = kind == 0 ? WSP(const bf16_t, WS_WA_OUT) + (size_t)slot * D * D : (kind == 1 ? WSP(const bf16_t, WS_WB_OUT) : WSP(const bf16_t, WS_WC_OUT));
            pg8::Gemm g{WSP(const bf16_t, WS_O), W, D, 0, nullptr};
            pg8::DenseOrder S{nMrows, 4, vcu, 0, 0, 0};
            pg8::EpiResid E{(const LAS float*)(misc + M_EPF), WSP(bf16_t, WS_XS), WSP(const float, WS_MOD) + (size_t)l * 9 * 6144 + 2048, (rep_ + 1 < 1 + ((MK_REP_MASK >> 10) & 1)) ? WSP(bf16_t, WS_ACT) : WSP(bf16_t, WS_XS)};
            pg8::gemm_phase<pg8::EpiResid, pg8::DenseOrder, false>(lds, g, S, E, tid);
            if (!last && S.short_one()) conv_claim(P, lds, l + 1, MK_Q_OUT, tid);
        } PHASE_END
        PHASE_BEGIN(11, pb + LP_RT, true) { if (l >= 1) conv_claim(P, lds, l, 1 << 30, tid); phase_router(P, lds, l, last ? NL : NT, vcu, tid, rep_); } PHASE_END
        PHASE_BEGIN(12, pb + LP_GU, true) {
            moe_tables(misc, WSP(unsigned, WS_CTL) + CW_CNT + (l * 2 + ((MK_REP_MASK >> 11) & 1)) * 512, tid);
            pg8::Gemm g{WSP(const void, WS_H), WSP(const unsigned char, WS_WGU) + (size_t)l * NEXP * 2 * D * D, D, (size_t)2 * D * D, WSP(const int, WS_ELIST)};
            const int Ugu = __builtin_amdgcn_readfirstlane(((const LAS int*)(misc + M_CUMT))[32]) * 8, Rgu = (Ugu + 255) >> 8, Gmin = (Ugu + Rgu - 1) / (Rgu > 0 ? Rgu : 1);
            const int cpx = (!last && MK_CVW_GU > 0) ? ((256 - Gmin) >> 3) : 0;
            const bool cvw = (vcu & 31) >= 32 - cpx;
            const int Gc = 256 - 8 * cpx, ic = cvw ? -1 : vcu - cpx * (vcu >> 5);
            pg8::MoeOrder S{(const LAS int*)(misc + M_ECNT), (const LAS int*)(misc + M_LBASE), (const LAS int*)(misc + M_CUMT), 8, ic, Gc, (LAS int*)(misc + M_UL)}; S.build(tid);
            pg8::EpiSwiglu8 E{WSP(unsigned char, WS_ACT), WSP(float, WS_SBLK), P->in[24] + (size_t)l * NEXP * D, P->in[26] + (size_t)l * NEXP * D, WSP(const float, WS_SAL), WSP(const float, WS_SBW) + (size_t)l * NEXP * 2048, (const LAS float*)(misc + M_EPF)};
            pg8::gemm_phase<pg8::EpiSwiglu8, pg8::MoeOrder, true, true>(lds, g, S, E, tid);
            if (!last && (cvw || S.short_one())) conv_claim(P, lds, l + 1, cvw ? (Rgu * MK_CVW_GU) >> 1 : MK_Q_GU, tid);
        } PHASE_END
        PHASE_BEGIN(13, pb + LP_DN, true) {
            if (MK_PER_PHASE) moe_tables(misc, WSP(unsigned, WS_CTL) + CW_CNT + (l * 2 + ((MK_REP_MASK >> 11) & 1)) * 512, tid);
            if (MK_TIME_PHASE == 1000 + l) ts0 = __builtin_amdgcn_s_memrealtime();
            phase_requant(P, (const LAS int*)(misc + M_CUMT), gw, lane);
            xcd_barrier(bar);
            if (MK_TIME_PHASE == 1000 + l) tsd = __builtin_amdgcn_s_memrealtime() - ts0;
            const int Udn = __builtin_amdgcn_readfirstlane(((const LAS int*)(misc + M_CUMT))[32]) * 4, Rdn = (Udn + 255) >> 8, Gmin = (Udn + Rdn - 1) / (Rdn > 0 ? Rdn : 1);
            const int cpx = (!last && MK_CVW_DN > 0) ? ((256 - Gmin) >> 3) : 0;
            const bool cvw = (vcu & 31) >= 32 - cpx;
            const int Gc = 256 - 8 * cpx, ic = cvw ? -1 : vcu - cpx * (vcu >> 5);
            pg8::Gemm g{WSP(const void, WS_ACT8), WSP(const unsigned char, WS_WD) + (size_t)l * NEXP * D * D, D, (size_t)D * D, nullptr};
            pg8::MoeOrder S{(const LAS int*)(misc + M_ECNT), (const LAS int*)(misc + M_LBASE), (const LAS int*)(misc + M_CUMT), 4, ic, Gc, (LAS int*)(misc + M_UL)}; S.build(tid);
            pg8::EpiDown8 E{WSP(unsigned char, WS_YS), WSP(float, WS_YSB), P->in[28] + (size_t)l * NEXP * D, WSP(const float, WS_SAQ), WSP(const float, WS_SBD) + (size_t)l * NEXP * D, (const LAS float*)(misc + M_EPF)};
            pg8::gemm_phase<pg8::EpiDown8, pg8::MoeOrder, false, true>(lds, g, S, E, tid);
            if (!last && (cvw || S.short_one())) conv_claim(P, lds, l + 1, cvw ? (Rdn * MK_CVW_DN) >> 1 : MK_Q_DN, tid);
        } PHASE_END
        PHASE_BEGIN(14, pb + LP_CB, true) phase_combine(P, lds, l, last ? NL : NT, gw, tid, (rep_ + 1 < 1 + ((MK_REP_MASK >> 14) & 1))); PHASE_END
    }
    PHASE_BEGIN(15, PH_FINAL, MK_STOP_AFTER < PH_FINAL - 1) phase_final_norm(P, gw, lane); PHASE_END
    if (MK_TIME_PHASE >= 0) {
        xcd_barrier(bar); STAMP_HERE();
        ArgsK ak_ = ak; PK P = &ak_->P; unsigned* tw = WSP(unsigned, WS_CTL) + 300;
        if (blockIdx.x == 0 && wid0 == 0 && lane_id() == 0) __hip_atomic_store(tw, (unsigned)tsd, __ATOMIC_RELAXED, __HIP_MEMORY_SCOPE_AGENT);
        xcd_barrier(bar);
        const float us = (float)__hip_atomic_load(tw, __ATOMIC_RELAXED, __HIP_MEMORY_SCOPE_AGENT) * 0.01f; const float sv = log2f(fmaxf(us, 1.0f));
        const int gt = blockIdx.x * 512 + wid0 * 64 + lane_id();
        for (int i = gt; i < NL * D / 4; i += 131072) ((f32x4*)P->out)[i] = (f32x4){sv, sv, sv, sv};
    }
#undef PHASE_BEGIN
#undef PHASE_END
}

extern "C" void kernel_launch(void* const* d_in, const int* in_sizes, int n_in, void* d_out, int out_size, void* d_ws, size_t ws_size, hipStream_t stream) {
    static int grid = 0;
    if (grid == 0) {
        if (n_in != 29 || out_size != NL * D || ws_size < WS_END) { fprintf(stderr, "kernel_launch: expected 29 inputs, out %d, ws >= %zu; got n_in %d out %d ws %zu\n", NL * D, (size_t)WS_END, n_in, out_size, ws_size); grid = -1; return; }
        int dev = 0, cus = 0, per_cu = 0;
        if (hipGetDevice(&dev) != hipSuccess || hipDeviceGetAttribute(&cus, hipDeviceAttributeMultiprocessorCount, dev) != hipSuccess) { grid = -1; return; }
        if (hipFuncSetAttribute((const void*)mk_fwd, hipFuncAttributeMaxDynamicSharedMemorySize, LDS_BYTES) != hipSuccess) { fprintf(stderr, "kernel_launch: hipFuncSetAttribute failed\n"); grid = -1; return; }
        if (hipOccupancyMaxActiveBlocksPerMultiprocessor(&per_cu, (const void*)mk_fwd, 512, LDS_BYTES) != hipSuccess || per_cu < 1) fprintf(stderr, "kernel_launch: occupancy query says %d\n", per_cu);
        (void)hipGetLastError();
        grid = 256;
        if (cus < 256) { fprintf(stderr, "kernel_launch: needs 256 CUs, device has %d\n", cus); grid = -1; return; }
    }
    if (grid < 0) return;
    if (hipMemsetAsync((char*)d_ws + WS_CTL, 0, CTL_BYTES, stream) != hipSuccess) return;
    Args a{};
    for (int i = 0; i < 29; ++i) a.P.in[i] = (const float*)d_in[i];
    a.P.out = (float*)d_out; a.P.ws = (unsigned char*)d_ws; a.pad = 0;
#if MK_PER_PHASE
    for (int p = 0; p < NPH; ++p) { a.p_lo = p; a.p_hi = p + 1; a.bar_idx = 0; hipLaunchKernelGGL(mk_fwd, dim3(grid), dim3(512), LDS_BYTES, stream, a); }
#else
    a.p_lo = 0; a.p_hi = NPH; a.bar_idx = 0;
    hipLaunchKernelGGL(mk_fwd, dim3(grid), dim3(512), LDS_BYTES, stream, a);
#endif
    const hipError_t le = hipPeekAtLastError();
    if (le != hipSuccess) fprintf(stderr, "kernel_launch: launch failed: %s\n", hipGetErrorName(le));
}
```

```cpp
#include <hip/hip_runtime.h>
#include <cstdio>
#include <cstdint>

#ifndef MK_PER_PHASE
#define MK_PER_PHASE 0
#endif
#ifndef MK_MASK
#define MK_MASK 0xFFFF
#endif
#ifndef MK_REP_MASK
#define MK_REP_MASK 0
#endif
#ifndef MK_Q_OUT
#define MK_Q_OUT 1
#endif
#ifndef MK_Q_GU
#define MK_Q_GU 1
#endif
#ifndef MK_Q_DN
#define MK_Q_DN 1
#endif
#ifndef MK_Q_IN
#define MK_Q_IN 1
#endif
#ifndef MK_MT_MAJOR
#define MK_MT_MAJOR 1
#endif
#ifndef MK_Q_ATT
#define MK_Q_ATT 1
#endif
#ifndef MK_OSUM_MFMA
#define MK_OSUM_MFMA 0
#endif
#ifndef MK_Q_STAG
#define MK_Q_STAG 1
#endif
#ifndef MK_EPI2
#define MK_EPI2 0
#endif
#ifndef MK_ATT_STAGGER
#define MK_ATT_STAGGER 3
#endif
#ifndef MK_FUSE_MLANORM
#define MK_FUSE_MLANORM 1
#endif
#ifndef MK_CVW_GU
#define MK_CVW_GU 0
#endif
#ifndef MK_CVW_DN
#define MK_CVW_DN 0
#endif
#ifndef MK_TIME_PHASE
#define MK_TIME_PHASE -1
#endif
#ifndef MK_STOP_AFTER
#define MK_STOP_AFTER 9999
#endif

#define LAS __attribute__((address_space(3)))
#define GAS __attribute__((address_space(1)))
typedef unsigned short bf16_t;
typedef short bf16x8 __attribute__((ext_vector_type(8)));
typedef short s16x4 __attribute__((ext_vector_type(4)));
typedef _Float16 f16x8 __attribute__((ext_vector_type(8)));
typedef _Float16 f16x2 __attribute__((ext_vector_type(2)));
typedef float f32x2 __attribute__((ext_vector_type(2)));
typedef float f32x4 __attribute__((ext_vector_type(4)));
typedef float f32x16 __attribute__((ext_vector_type(16)));
typedef unsigned u32x2 __attribute__((ext_vector_type(2)));
typedef unsigned u32x4 __attribute__((ext_vector_type(4)));
typedef int i32x4 __attribute__((ext_vector_type(4)));

constexpr int D = 1024, NB = 8, SEQ = 2048, CTXL = 256, DEPTH = 4;
constexpr int NL = NB * SEQ;
constexpr int NC = NB * CTXL;
constexpr int NT = NL + NC;
constexpr int NEXP = 32, TOPK = 4;
constexpr int MAXSLOT = 81920;
constexpr float NORM_EPS = 1e-6f;
constexpr float LOG2E = 1.4426950408889634f;
constexpr int A_IN = 1536, B_IN = 3072, C_IN = 416, C_INP = 512, C_UPK = 384, C_UPN = 3584;

constexpr size_t MiB = 1u << 20;
constexpr size_t WS_CTL = 0, CTL_BYTES = 1 * MiB;
constexpr size_t WS_MOD = 1 * MiB;
constexpr size_t WS_ROPE_A = 2 * MiB;
constexpr size_t WS_ROPE_C = 2 * MiB + 512 * 1024;
constexpr size_t WS_TOPE = 3 * MiB;
constexpr size_t WS_POS = 3 * MiB + 512 * 1024;
constexpr size_t WS_GATE = 4 * MiB;
constexpr size_t WS_ELIST = 5 * MiB;
constexpr size_t WS_KR = 8 * MiB;
constexpr size_t WS_CQKV = 10 * MiB;
constexpr size_t WS_Y416 = 24 * MiB;
constexpr size_t WS_XS = 60 * MiB;
constexpr size_t WS_H = 132 * MiB;
constexpr size_t WS_O = 168 * MiB;
constexpr size_t WS_QKV = 204 * MiB;
constexpr size_t WS_ACT = 330 * MiB;
constexpr size_t WS_SBLK = 426 * MiB;
constexpr size_t WS_YS = 490 * MiB;
constexpr size_t WS_YSB = 586 * MiB;
constexpr size_t WS_WA_IN = 650 * MiB;
constexpr size_t WS_WA_OUT = 656 * MiB;
constexpr size_t WS_WB_IN = 660 * MiB;
constexpr size_t WS_WB_OUT = 666 * MiB;
constexpr size_t WS_WC_IN = 668 * MiB;
constexpr size_t WS_WC_UP = 669 * MiB;
constexpr size_t WS_WC_OUT = 672 * MiB;
constexpr size_t WS_WGU = 676 * MiB;
constexpr size_t WS_WD = 1188 * MiB;
constexpr size_t WS_G16 = 1444 * MiB;
constexpr size_t WS_RC = 1447 * MiB;
constexpr size_t WS_SBW = 1448 * MiB;
constexpr size_t WS_SAL = 1449 * MiB;
constexpr size_t WS_SAH = 1452 * MiB;
constexpr size_t WS_SBI = 1452 * MiB + 128 * 1024;
constexpr size_t WS_ACT8 = 1453 * MiB;
constexpr size_t WS_SAQ = 1533 * MiB;
constexpr size_t WS_SBD = 1533 * MiB + 512 * 1024;
constexpr size_t WS_END = 1535 * MiB;

constexpr int CW_CV = 512;
constexpr int CW_CNT = 1024;
constexpr int CW_BAR = 65536;

constexpr int RING_BYTES = 131072;
constexpr int MISC_OFF = RING_BYTES;
constexpr int M_BARW = 0, M_LCNT = 64, M_LBASE = 192, M_CUMT = 320, M_ECNT = 512, M_GBASE = 640, M_CVB = 768, M_UL = 6656, M_RSA = 7424, M_EPF = 8192, M_RPB = 1024, M_REC = 3072;
constexpr int LDS_BYTES = 147456;

#define XB_TMO      128
#define XB_XCNT(j)  (256  + 64 * (j))
#define XB_XSUB(j)  (1280 + 64 * (j))
#define XB_XGEN(j)  (2304 + 64 * (j))
#define XB_TOP      3328
#define XB_TOPGEN   3392
#define XCD_BAR_WORDS 3456
#define XB_SPIN_CAP (1u << 18)

__device__ __forceinline__ unsigned xb_ld(unsigned* p)              { return __hip_atomic_load(p, __ATOMIC_RELAXED, __HIP_MEMORY_SCOPE_AGENT); }
__device__ __forceinline__ unsigned xb_add(unsigned* p, unsigned v) { return __hip_atomic_fetch_add(p, v, __ATOMIC_RELAXED, __HIP_MEMORY_SCOPE_AGENT); }
__device__ __forceinline__ unsigned xb_xcc_id() { return (unsigned)__builtin_amdgcn_s_getreg((3 << 11) | 20) & 0xFu; }
#define XB_SPIN(cond, bar) do { unsigned _sp = 0; while (cond) { __builtin_amdgcn_s_sleep(1); \
    if ((++_sp & 255u) == 0u) { if (xb_ld(&(bar)[XB_TMO])) break; if (_sp > XB_SPIN_CAP) { atomicAdd(&(bar)[XB_TMO], 1u); break; } } } } while (0)

__device__ __forceinline__ int lane_id() { int r; asm volatile("v_mbcnt_lo_u32_b32 %0, -1, 0\n\tv_mbcnt_hi_u32_b32 %0, -1, %0" : "=v"(r)); return r; }
struct XcdBarrier {
    unsigned* bar; unsigned x;
    volatile LAS unsigned* st;
    bool lead;
};
__device__ __forceinline__ XcdBarrier xcd_barrier_post(unsigned* bar, volatile LAS unsigned* st, bool lead) {
    XcdBarrier b; b.bar = bar; b.x = xb_xcc_id(); b.st = st; b.lead = lead;
    if (lead && lane_id() == 0) (void)xb_add(&bar[XB_XCNT(b.x)], 1u);
    return b;
}
__device__ __forceinline__ void xcd_barrier_complete(unsigned* bar, unsigned x, unsigned& nloc, unsigned& nx) {
    const unsigned G = gridDim.x * gridDim.y * gridDim.z;
    unsigned sum, cnt, mine, sp = 0u;
    for (;;) {
        sum = 0u; cnt = 0u; mine = 0u;
#pragma unroll
        for (unsigned j = 0; j < 16; ++j) { const unsigned c = xb_ld(&bar[XB_XCNT(j)]); sum += c; cnt += (c > 0u) ? 1u : 0u; mine = (j == x) ? c : mine; }
        if (sum == G) break;
        __builtin_amdgcn_s_sleep(1);
        if ((++sp & 255u) == 0u) { if (xb_ld(&bar[XB_TMO])) break; if (sp > XB_SPIN_CAP) { atomicAdd(&bar[XB_TMO], 1u); break; } }
    }
    nloc = mine > 0u ? mine : 1u; nx = cnt > 0u ? cnt : 1u;
}
__device__ __forceinline__ void xcd_barrier(const XcdBarrier& b) {
    asm volatile("s_waitcnt vmcnt(0)" ::: "memory");
    __syncthreads();
    if (b.lead && lane_id() == 0) {
        unsigned* bar = b.bar;
        __builtin_amdgcn_s_waitcnt(0);
        unsigned nloc = b.st[0], nx = b.st[1];
        if (nloc == 0u) { xcd_barrier_complete(bar, b.x, nloc, nx); b.st[0] = nloc; b.st[1] = nx; }
        const unsigned old = xb_add(&bar[XB_XSUB(b.x)], 1u);
        const unsigned gen = old / nloc;
        if (old + 1u == (gen + 1u) * nloc) {
            __builtin_amdgcn_fence(__ATOMIC_RELEASE, "agent");
            asm volatile("s_waitcnt vmcnt(0)" ::: "memory");
            const unsigned og = xb_add(&bar[XB_TOP], 1u);
            const unsigned tg = og / nx;
            if (og + 1u == (tg + 1u) * nx) xb_add(&bar[XB_TOPGEN], 1u);
            else XB_SPIN(xb_ld(&bar[XB_TOPGEN]) == tg, bar);
            __builtin_amdgcn_fence(__ATOMIC_ACQUIRE, "agent");
            xb_add(&bar[XB_XGEN(b.x)], 1u);
            asm volatile("s_waitcnt vmcnt(0)" ::: "memory");
        } else {
            XB_SPIN(xb_ld(&bar[XB_XGEN(b.x)]) == gen, bar);
            __builtin_amdgcn_fence(__ATOMIC_ACQUIRE, "agent");
            asm volatile("s_waitcnt vmcnt(0)" ::: "memory");
        }
    }
    __syncthreads();
}

__device__ __forceinline__ unsigned cvt_pk_bf16(float lo, float hi) { unsigned r; asm volatile("v_cvt_pk_bf16_f32 %0, %1, %2" : "=v"(r) : "v"(lo), "v"(hi)); return r; }
__device__ __forceinline__ float bf_lo(unsigned w) { return __uint_as_float(w << 16); }
__device__ __forceinline__ float bf_hi(unsigned w) { return __uint_as_float(w & 0xffff0000u); }
__device__ __forceinline__ float shx(float v, int mask, int lane) { return __int_as_float(__builtin_amdgcn_ds_bpermute((lane ^ mask) << 2, __float_as_int(v))); }
__device__ __forceinline__ float wave_sum(float v, int lane) {
#pragma unroll
    for (int o = 1; o < 64; o <<= 1) v += shx(v, o, lane);
    return v;
}
__device__ __forceinline__ float wave_max(float v, int lane) {
#pragma unroll
    for (int o = 1; o < 64; o <<= 1) v = fmaxf(v, shx(v, o, lane));
    return v;
}
__device__ __forceinline__ float swap32_max(float m) { auto rr = __builtin_amdgcn_permlane32_swap(__float_as_uint(m), __float_as_uint(m), false, false); return fmaxf(__uint_as_float(rr[0]), __uint_as_float(rr[1])); }
__device__ __forceinline__ float swap16_max(float m) { auto rr = __builtin_amdgcn_permlane16_swap(__float_as_uint(m), __float_as_uint(m), false, false); return fmaxf(__uint_as_float(rr[0]), __uint_as_float(rr[1])); }
__device__ __forceinline__ float swap16_sum(float m) { auto rr = __builtin_amdgcn_permlane16_swap(__float_as_uint(m), __float_as_uint(m), false, false); return __uint_as_float(rr[0]) + __uint_as_float(rr[1]); }
__device__ __forceinline__ float swap32_sum(float m) { auto rr = __builtin_amdgcn_permlane32_swap(__float_as_uint(m), __float_as_uint(m), false, false); return __uint_as_float(rr[0]) + __uint_as_float(rr[1]); }

namespace pg8 {
constexpr int BM = 256, BK = 64, HALF = 128, HTB = HALF * BK * 2, STAGE_BYTES = 8 * HTB;
__host__ __device__ __forceinline__ int lds_byte(int r, int c) { const int st = (r >> 4) * 2 + (c >> 5), rr = r & 15, cc = c & 31, ob = rr * 64 + cc * 2; return st * 1024 + (ob ^ (((ob >> 9) & 1) << 5)); }
__host__ __device__ __forceinline__ void stage_rc(int b, int& R, int& C) { const int st = b / 1024, sb = b % 1024, swz = sb ^ (((sb >> 9) & 1) << 5); R = (st >> 1) * 16 + swz / 64; C = (st & 1) * 32 + (swz % 64) / 2; }
__host__ __device__ __forceinline__ int perm32(int rho) { const int n = rho >> 4, i = rho & 15; return 8 * (i >> 2) + 4 * n + (i & 3); }

struct Unit { int pm, pn, e, mt, cnt; };
struct Gemm { const void* A; const void* Bt; int K; size_t bstride; const int* list; };

template <bool I8> struct AccSel { typedef f32x4 type; };
template <> struct AccSel<true> { typedef i32x4 type; };
template <class Epi, class Sched, bool GATHER, bool I8 = false>
__device__ __forceinline__ void gemm_phase(LAS unsigned char* lds, const Gemm g, const Sched& S, const Epi& E, const int tid) {
    const int wid = __builtin_amdgcn_readfirstlane(tid >> 6), lane = tid & 63, wr = wid >> 2, wc = wid & 3, fr = lane & 15, fq = lane >> 4;
    typedef typename AccSel<I8>::type acc_t;
    const int K = g.K, RB = I8 ? K : 2 * K, nt = RB / (BK * 2);
    unsigned voffA[2], voffB[2];
#pragma unroll
    for (int i = 0; i < 2; ++i) { int R, C; stage_rc(tid * 16 + i * 8192, R, C); const int Rb = Epi::PERM ? ((R & ~31) + perm32(R & 31)) : R;
        voffA[i] = (unsigned)(R * RB + C * 2); voffB[i] = (unsigned)(Rb * RB + C * 2); }
#define PG8_RC(i, R_, C_) int R_, C_; { int _t = tid; asm volatile("" : "+v"(_t)); stage_rc(_t * 16 + (i) * 8192, R_, C_); }
    const size_t kstep = (size_t)(BK * 2);
    const size_t hstep = (size_t)HALF * RB;
    const size_t tstep = 2 * hstep;
    const unsigned ldsw = (unsigned)wid * 1024u;
    const int aoff = lds_byte(wr * 64 + fr, fq * 8), boff = lds_byte(wc * 32 + fr, fq * 8);
#define PG8_SA(b, h) (((b) * 2 + (h)) * HTB)
#define PG8_SB(b, h) ((4 + (b) * 2 + (h)) * HTB)
#define PG8_STAGE(bufoff, gbase, voff) do { _Pragma("unroll") for (int _i = 0; _i < 2; ++_i) \
        __builtin_amdgcn_global_load_lds((const unsigned*)((const char*)(gbase) + (voff)[_i]), (LAS unsigned*)(lds + (bufoff) + ldsw + _i * 8192), 16, 0, 0); } while (0)
#define PG8_STAGE_A(bufoff, SELN, H, KOFF) do { if constexpr (GATHER) { unsigned _vo[2]; _vo[0] = (SELN) ? voN[H][0] : voC[H][0]; _vo[1] = (SELN) ? voN[H][1] : voC[H][1]; \
            PG8_STAGE(bufoff, (const char*)g.A + (KOFF), _vo); } else { PG8_STAGE(bufoff, ((SELN) ? nA : cA) + (H) * hstep + (KOFF), voffA); } } while (0)
#define PG8_LDA(dst, b, h) do { _Pragma("unroll") for (int m = 0; m < 4; ++m) _Pragma("unroll") for (int k = 0; k < 2; ++k) dst[m][k] = *(const LAS bf16x8*)(lds + PG8_SA(b, h) + aoff + m * 2048 + k * 1024); } while (0)
#define PG8_LDB(dst, b, h) do { _Pragma("unroll") for (int n = 0; n < 2; ++n) _Pragma("unroll") for (int k = 0; k < 2; ++k) dst[n][k] = *(const LAS bf16x8*)(lds + PG8_SB(b, h) + boff + n * 2048 + k * 1024); } while (0)
#define PG8_MMA(ai, bj, At, Bt) do { __builtin_amdgcn_s_setprio(1); _Pragma("unroll") for (int m = 0; m < 4; ++m) _Pragma("unroll") for (int n = 0; n < 2; ++n) _Pragma("unroll") for (int k = 0; k < 2; ++k) \
        { if constexpr (I8) acc[ai][bj][m][n] = __builtin_amdgcn_mfma_i32_16x16x64_i8(__builtin_bit_cast(i32x4, Bt[n][k]), __builtin_bit_cast(i32x4, At[m][k]), acc[ai][bj][m][n], 0, 0, 0); \
          else acc[ai][bj][m][n] = __builtin_amdgcn_mfma_f32_16x16x32_bf16(Bt[n][k], At[m][k], acc[ai][bj][m][n], 0, 0, 0); } __builtin_amdgcn_s_setprio(0); } while (0)
#define PG8_WAIT_V(n) asm volatile("s_waitcnt vmcnt(" #n ")" ::: "memory")
#define PG8_WAIT_L(n) asm volatile("s_waitcnt lgkmcnt(" #n ")" ::: "memory")
#define PG8_BAR __builtin_amdgcn_s_barrier()
#define PG8_SCHED __builtin_amdgcn_sched_barrier(0)
#define PG8_GATH(U, VO) do { _Pragma("unroll") for (int _h = 0; _h < 2; ++_h) _Pragma("unroll") for (int _i = 0; _i < 2; ++_i) { \
        PG8_RC(_i, _R, _C); int _r = (U).mt * 256 + _h * 128 + _R; _r = _r < (U).cnt ? _r : 0; const int _tok = g.list[(size_t)(U).e * NT + _r]; VO[_h][_i] = (unsigned)(_tok * RB + _C * 2); } } while (0)
    Unit cur, nxt; int ui = 0;
    if (!S.next(0, cur)) return;
    acc_t acc[2][2][4][2];
#pragma unroll
    for (int a = 0; a < 2; ++a)
#pragma unroll
        for (int b = 0; b < 2; ++b)
#pragma unroll
            for (int m = 0; m < 4; ++m)
#pragma unroll
                for (int n = 0; n < 2; ++n) acc[a][b][m][n] = (acc_t){0, 0, 0, 0};
    bf16x8 At[4][2], B0[2][2], B1[2][2];
    unsigned voC[2][2] = {{0u, 0u}, {0u, 0u}}, voN[2][2] = {{0u, 0u}, {0u, 0u}};
    if constexpr (GATHER) { PG8_GATH(cur, voC); }
    const char* cA = GATHER ? (const char*)g.A : (const char*)g.A + (size_t)cur.pm * tstep;
    const size_t bsb = I8 ? g.bstride : 2 * g.bstride;
    const char* cB = (const char*)g.Bt + (size_t)cur.e * bsb + (size_t)cur.pn * tstep;
    const char* nA = cA; const char* nB = cB;
    PG8_STAGE(PG8_SB(0, 0), cB, voffB); PG8_STAGE(PG8_SB(0, 1), cB + hstep, voffB); PG8_STAGE_A(PG8_SA(0, 0), false, 0, 0); PG8_STAGE_A(PG8_SA(0, 1), false, 1, 0);
    if (wr == 1) PG8_BAR;
    PG8_WAIT_V(2); PG8_BAR;
    PG8_STAGE(PG8_SB(1, 0), cB + kstep, voffB); PG8_STAGE_A(PG8_SA(1, 0), false, 0, kstep); PG8_STAGE(PG8_SB(1, 1), cB + hstep + kstep, voffB);
    PG8_WAIT_V(6); PG8_BAR;
    for (;;) {
        const bool has_next = S.next(ui + 1, nxt);
        nA = GATHER ? (const char*)g.A : (has_next ? (const char*)g.A + (size_t)nxt.pm * tstep : cA);
        nB = has_next ? (const char*)g.Bt + (size_t)nxt.e * bsb + (size_t)nxt.pn * tstep : cB;
        int tokN[2][2] = {{0, 0}, {0, 0}};
        if constexpr (GATHER) { if (has_next) {
#pragma unroll
            for (int _h = 0; _h < 2; ++_h)
#pragma unroll
                for (int _i = 0; _i < 2; ++_i) { PG8_RC(_i, _R, _C); (void)_C; int _r = nxt.mt * 256 + _h * 128 + _R; _r = _r < nxt.cnt ? _r : 0; const int* _p = g.list + (size_t)nxt.e * NT + _r;
                    asm volatile("global_load_dword %0, %1, off" : "=v"(tokN[_h][_i]) : "v"(_p) : "memory"); } } }
        unsigned epf[2] = {0u, 0u};
        if constexpr (Epi::PF > 0) {
#pragma unroll
            for (int _k = 0; _k < Epi::PF; ++_k) { const float* _p = E.pf_addr(cur, tid, _k); asm volatile("global_load_dword %0, %1, off" : "=v"(epf[_k]) : "v"(_p) : "memory"); } }
        for (int t = 0; t < nt; t += 2) {
            const bool last = (t == nt - 2);
            const size_t k1 = (size_t)(t + 1) * kstep;
            const size_t k2 = last ? 0 : (size_t)(t + 2) * kstep;
            const size_t k3 = k2 + kstep;
            const char* b2 = (last ? nB : cB) + k2; const char* b3 = b2 + kstep;
            PG8_LDB(B0, 0, 0); PG8_LDB(B1, 0, 1); PG8_SCHED; PG8_LDA(At, 0, 0); PG8_STAGE_A(PG8_SA(1, 1), false, 1, k1);
            PG8_WAIT_V(8); PG8_WAIT_L(0); PG8_BAR; PG8_MMA(0, 0, At, B0); PG8_MMA(0, 1, At, B1); PG8_BAR; PG8_SCHED;
            if constexpr (GATHER) { if (last) { if (has_next) {
                asm volatile("" : "+v"(tokN[0][0]), "+v"(tokN[0][1]), "+v"(tokN[1][0]), "+v"(tokN[1][1]));
                { PG8_RC(0, _R0, _C0); PG8_RC(1, _R1, _C1); (void)_R0; (void)_R1;
#pragma unroll
                for (int _h = 0; _h < 2; ++_h) { voN[_h][0] = (unsigned)(tokN[_h][0] * RB + _C0 * 2); voN[_h][1] = (unsigned)(tokN[_h][1] * RB + _C1 * 2); } } } else {
#pragma unroll
                for (int _h = 0; _h < 2; ++_h) { voN[_h][0] = voC[_h][0]; voN[_h][1] = voC[_h][1]; } } } }
            if constexpr (Epi::PF > 0) { if (last) { asm volatile("" : "+v"(epf[0]), "+v"(epf[1]));
#pragma unroll
                for (int _k = 0; _k < Epi::PF; ++_k) *(LAS unsigned*)(lds + MISC_OFF + M_EPF + (_k * 512 + tid) * 4) = epf[_k]; } }
            PG8_LDA(At, 0, 1); PG8_STAGE(PG8_SB(0, 0), b2, voffB); PG8_STAGE(PG8_SB(0, 1), b2 + hstep, voffB); PG8_STAGE_A(PG8_SA(0, 0), last, 0, k2);
            PG8_WAIT_V(8); PG8_WAIT_L(0); PG8_BAR; PG8_MMA(1, 0, At, B0); PG8_MMA(1, 1, At, B1); PG8_BAR; PG8_SCHED;
            PG8_LDB(B0, 1, 0); PG8_LDB(B1, 1, 1); PG8_SCHED; PG8_LDA(At, 1, 0); PG8_STAGE_A(PG8_SA(0, 1), last, 1, k2);
            PG8_WAIT_V(8); PG8_WAIT_L(0); PG8_BAR; PG8_MMA(0, 0, At, B0); PG8_MMA(0, 1, At, B1); PG8_BAR; PG8_SCHED;
            PG8_LDA(At, 1, 1); PG8_STAGE(PG8_SB(1, 0), b3, voffB); PG8_STAGE(PG8_SB(1, 1), b3 + hstep, voffB); PG8_STAGE_A(PG8_SA(1, 0), last, 0, k3);
            PG8_WAIT_V(8); PG8_WAIT_L(0); PG8_BAR; PG8_MMA(1, 0, At, B0); PG8_MMA(1, 1, At, B1); PG8_BAR; PG8_SCHED;
        }
        if (wr == 0) PG8_BAR;
        { const int ln_ = lane_id(); E(acc, cur, wr, wc, ln_ & 15, ln_ >> 4); }
        if constexpr (MK_EPI2 != 0) { if (Epi::PF == 2) { asm volatile("" ::: "memory"); const int ln_ = lane_id(); E(acc, cur, wr, wc, ln_ & 15, ln_ >> 4); } }
        if (!has_next) break;
#pragma unroll
        for (int a = 0; a < 2; ++a)
#pragma unroll
            for (int b = 0; b < 2; ++b)
#pragma unroll
                for (int m = 0; m < 4; ++m)
#pragma unroll
                    for (int n = 0; n < 2; ++n) acc[a][b][m][n] = (acc_t){0, 0, 0, 0};
        cur = nxt; cA = nA; cB = nB; ++ui;
        if constexpr (GATHER) {
#pragma unroll
            for (int _h = 0; _h < 2; ++_h) { voC[_h][0] = voN[_h][0]; voC[_h][1] = voN[_h][1]; } }
        if (wr == 1) PG8_BAR;
    }
    PG8_WAIT_V(0);
    PG8_BAR;
#undef PG8_SA
#undef PG8_SB
#undef PG8_STAGE
#undef PG8_STAGE_A
#undef PG8_LDA
#undef PG8_LDB
#undef PG8_MMA
#undef PG8_WAIT_V
#undef PG8_WAIT_L
#undef PG8_BAR
#undef PG8_SCHED
#undef PG8_GATH
#undef PG8_RC
}
}

namespace pg8 {
struct EpiBf16Plain {
    static constexpr bool PERM = true; static constexpr int PF = 0;
    bf16_t* O; int ldc; int qtiles; float qscale;
    __device__ __forceinline__ void operator()(const f32x4 (&acc)[2][2][4][2], const Unit& u, int wr, int wc, int fr, int fq) const {
        const int row0 = u.pm * BM + wr * 64 + fr, col0 = u.pn * BM + wc * 32 + 8 * fq;
        const float qs = u.pn < qtiles ? qscale : 1.0f;
#pragma unroll
        for (int ai = 0; ai < 2; ++ai)
#pragma unroll
            for (int m = 0; m < 4; ++m) { bf16_t* rowp = O + (size_t)(row0 + ai * HALF + m * 16) * ldc + col0;
#pragma unroll
                for (int bj = 0; bj < 2; ++bj) { const f32x4 v0 = acc[ai][bj][m][0] * qs, v1 = acc[ai][bj][m][1] * qs;
                    u32x4 w; w.x = cvt_pk_bf16(v0[0], v0[1]); w.y = cvt_pk_bf16(v0[2], v0[3]); w.z = cvt_pk_bf16(v1[0], v1[1]); w.w = cvt_pk_bf16(v1[2], v1[3]);
                    *(u32x4*)(rowp + bj * HALF) = w; } }
    }
};
struct EpiBf16Plain8 {
    static constexpr bool PERM = true; static constexpr int PF = 1;
    bf16_t* O; int ldc; int qtiles; float qscale; const float* sa; const float* sb; const LAS float* epf;
    __device__ __forceinline__ const float* pf_addr(const Unit& u, int tid, int) const { return tid < 256 ? sb + u.pn * BM + tid : sa + u.pm * BM + (tid - 256); }
    __device__ __forceinline__ void operator()(const i32x4 (&acc)[2][2][4][2], const Unit& u, int wr, int wc, int fr, int fq) const {
        const int row0 = u.pm * BM + wr * 64 + fr, col0 = u.pn * BM + wc * 32 + 8 * fq;
        const float qs = u.pn < qtiles ? qscale : 1.0f;
        f32x4 cs[2][2];
#pragma unroll
        for (int bj = 0; bj < 2; ++bj)
#pragma unroll
            for (int n = 0; n < 2; ++n) cs[bj][n] = *(const LAS f32x4*)(epf + wc * 32 + 8 * fq + bj * HALF + 4 * n) * qs;
#pragma unroll
        for (int ai = 0; ai < 2; ++ai)
#pragma unroll
            for (int m = 0; m < 4; ++m) { const int row = row0 + ai * HALF + m * 16; bf16_t* rowp = O + (size_t)row * ldc + col0; const float sr = epf[256 + wr * 64 + fr + ai * HALF + m * 16];
#pragma unroll
                for (int bj = 0; bj < 2; ++bj) { f32x4 v0, v1;
#pragma unroll
                    for (int j = 0; j < 4; ++j) { v0[j] = (float)acc[ai][bj][m][0][j]; v1[j] = (float)acc[ai][bj][m][1][j]; }
                    v0 = v0 * (cs[bj][0] * sr); v1 = v1 * (cs[bj][1] * sr);
                    u32x4 w; w.x = cvt_pk_bf16(v0[0], v0[1]); w.y = cvt_pk_bf16(v0[2], v0[3]); w.z = cvt_pk_bf16(v1[0], v1[1]); w.w = cvt_pk_bf16(v1[2], v1[3]);
                    *(u32x4*)(rowp + bj * HALF) = w; }
                asm volatile("" ::: "memory"); }
    }
};
struct EpiF32Plain {
    static constexpr bool PERM = false; static constexpr int PF = 0;
    float* C; int ldc;
    __device__ __forceinline__ void operator()(const f32x4 (&acc)[2][2][4][2], const Unit& u, int wr, int wc, int fr, int fq) const {
        const int row0 = u.pm * BM + wr * 64 + fr, col0 = u.pn * BM + wc * 32 + 4 * fq;
#pragma unroll
        for (int ai = 0; ai < 2; ++ai)
#pragma unroll
            for (int m = 0; m < 4; ++m) { float* rowp = C + (size_t)(row0 + ai * HALF + m * 16) * ldc + col0;
#pragma unroll
                for (int bj = 0; bj < 2; ++bj)
#pragma unroll
                    for (int n = 0; n < 2; ++n) *(f32x4*)(rowp + bj * HALF + n * 16) = acc[ai][bj][m][n]; }
    }
};
struct EpiMlaIn {
    static constexpr bool PERM = false; static constexpr int PF = 0;
    bf16_t* CQ; bf16_t* KR; const float* qn; const float* kn; const float* rope; LAS float* P;
    __device__ __forceinline__ void operator()(const f32x4 (&acc)[2][2][4][2], const Unit& u, int wr, int wc, int fr, int fq) const {
        const int lr0 = wr * 64 + fr; const bool isq = (u.pn == 0);
#pragma unroll
        for (int ai = 0; ai < 2; ++ai)
#pragma unroll
            for (int m = 0; m < 4; ++m) { float ss = 0.f;
#pragma unroll
                for (int n = 0; n < 2; ++n) { const f32x4 v = acc[ai][0][m][n]; ss += (v[0] * v[0] + v[1] * v[1]) + (v[2] * v[2] + v[3] * v[3]); }
                if (isq) {
#pragma unroll
                    for (int n = 0; n < 2; ++n) { const f32x4 v = acc[ai][1][m][n]; ss += (v[0] * v[0] + v[1] * v[1]) + (v[2] * v[2] + v[3] * v[3]); } }
                ss = swap16_sum(ss); ss = swap32_sum(ss);
                if (fq == 0) P[(lr0 + ai * HALF + m * 16) * 4 + wc] = ss; }
        asm volatile("s_waitcnt lgkmcnt(0)" ::: "memory"); __builtin_amdgcn_s_barrier(); asm volatile("" ::: "memory");
        const float* g = isq ? qn : kn; const float invn = isq ? (1.0f / 256.0f) : (1.0f / 128.0f); const int cb = isq ? 0 : 256;
        const int c0 = wc * 32 + 4 * fq;
        f32x4 gv[2][2];
#pragma unroll
        for (int n = 0; n < 2; ++n) { gv[0][n] = *(const f32x4*)(g + c0 + 16 * n); gv[1][n] = isq ? *(const f32x4*)(g + HALF + c0 + 16 * n) : (f32x4){0.f, 0.f, 0.f, 0.f}; }
#pragma unroll
        for (int ai = 0; ai < 2; ++ai)
#pragma unroll
            for (int m = 0; m < 4; ++m) { const int lr = lr0 + ai * HALF + m * 16; const size_t row = (size_t)u.pm * BM + lr;
                const f32x4 p4 = *(const LAS f32x4*)(P + lr * 4);
                const float rstd = 1.0f / sqrtf(((p4[0] + p4[1]) + (p4[2] + p4[3])) * invn + NORM_EPS);
#pragma unroll
                for (int bj = 0; bj < 2; ++bj) { if (bj == 1 && !isq) continue;
#pragma unroll
                    for (int n = 0; n < 2; ++n) { const f32x4 v = acc[ai][bj][m][n] * rstd * gv[bj][n];
                        u32x2 w; w.x = cvt_pk_bf16(v[0], v[1]); w.y = cvt_pk_bf16(v[2], v[3]);
                        *(u32x2*)(CQ + row * C_UPK + cb + bj * HALF + c0 + 16 * n) = w; } }
                if (!isq && wc == 0) {
#pragma unroll
                    for (int n = 0; n < 2; ++n) { f32x4 v = acc[ai][1][m][n];
                        if (row < (size_t)NL) { const f32x4 cs = *(const f32x4*)(rope + (((size_t)(row & (SEQ - 1))) * 16 + 8 * n + 2 * fq) * 2);
                            const float a0 = v[0], b0 = v[1], a1 = v[2], b1 = v[3];
                            v[0] = a0 * cs[0] - b0 * cs[1]; v[1] = a0 * cs[1] + b0 * cs[0]; v[2] = a1 * cs[2] - b1 * cs[3]; v[3] = a1 * cs[3] + b1 * cs[2]; }
                        u32x2 w; w.x = cvt_pk_bf16(v[0], v[1]); w.y = cvt_pk_bf16(v[2], v[3]);
                        *(u32x2*)(KR + row * 32 + 16 * n + 4 * fq) = w; } } }
    }
};
__device__ __forceinline__ void rope8(f32x4& v0, f32x4& v1, const float* cs) {
    const f32x4 a = *(const f32x4*)cs, b = *(const f32x4*)(cs + 4);
    const float x0 = v0[0], x1 = v0[1], x2 = v0[2], x3 = v0[3], y0 = v1[0], y1 = v1[1], y2 = v1[2], y3 = v1[3];
    v0[0] = x0 * a[0] - x1 * a[1]; v0[1] = x0 * a[1] + x1 * a[0];
    v0[2] = x2 * a[2] - x3 * a[3]; v0[3] = x2 * a[3] + x3 * a[2];
    v1[0] = y0 * b[0] - y1 * b[1]; v1[1] = y0 * b[1] + y1 * b[0];
    v1[2] = y2 * b[2] - y3 * b[3]; v1[3] = y2 * b[3] + y3 * b[2];
}
struct EpiQkvA {
    static constexpr bool PERM = true; static constexpr int PF = 0;
    bf16_t* O; const float* rope;
    __device__ __forceinline__ void operator()(const f32x4 (&acc)[2][2][4][2], const Unit& u, int wr, int wc, int fr, int fq) const {
        const int row0 = u.pm * BM + wr * 64 + fr, col0 = u.pn * BM + wc * 32 + 8 * fq;
        const bool do_rope = (u.pm < NL / 256) && (u.pn < 5);
        const float qs = u.pn < 4 ? 0.125f * LOG2E : 1.0f;
#pragma unroll
        for (int ai = 0; ai < 2; ++ai)
#pragma unroll
            for (int m = 0; m < 4; ++m) { const int row = row0 + ai * HALF + m * 16; bf16_t* rowp = O + (size_t)row * A_IN + col0;
#pragma unroll
                for (int bj = 0; bj < 2; ++bj) { f32x4 v0 = acc[ai][bj][m][0], v1 = acc[ai][bj][m][1];
                    if (do_rope) { const int d = (col0 + bj * HALF) & 63; rope8(v0, v1, rope + ((size_t)(row & (SEQ - 1)) * 32 + (d >> 1)) * 2); }
                    v0 = v0 * qs; v1 = v1 * qs;
                    u32x4 w; w.x = cvt_pk_bf16(v0[0], v0[1]); w.y = cvt_pk_bf16(v0[2], v0[3]); w.z = cvt_pk_bf16(v1[0], v1[1]); w.w = cvt_pk_bf16(v1[2], v1[3]);
                    *(u32x4*)(rowp + bj * HALF) = w; }
                asm volatile("" ::: "memory"); }
    }
};
struct EpiQkvA8 {
    static constexpr bool PERM = true; static constexpr int PF = 1;
    bf16_t* O; const float* rope; const float* sa; const float* sb; const LAS float* epf;
    __device__ __forceinline__ const float* pf_addr(const Unit& u, int tid, int) const { return tid < 256 ? sb + u.pn * BM + tid : sa + u.pm * BM + (tid - 256); }
    __device__ __forceinline__ void operator()(const i32x4 (&acc)[2][2][4][2], const Unit& u, int wr, int wc, int fr, int fq) const {
        const int row0 = u.pm * BM + wr * 64 + fr, col0 = u.pn * BM + wc * 32 + 8 * fq;
        const bool do_rope = (u.pm < NL / 256) && (u.pn < 5);
        const float qs = u.pn < 4 ? 0.125f * LOG2E : 1.0f;
        f32x4 cs[2][2];
#pragma unroll
        for (int bj = 0; bj < 2; ++bj)
#pragma unroll
            for (int n = 0; n < 2; ++n) cs[bj][n] = *(const LAS f32x4*)(epf + wc * 32 + 8 * fq + bj * HALF + 4 * n) * qs;
#pragma unroll
        for (int ai = 0; ai < 2; ++ai)
#pragma unroll
            for (int m = 0; m < 4; ++m) { const int row = row0 + ai * HALF + m * 16; bf16_t* rowp = O + (size_t)row * A_IN + col0; const float sr = epf[256 + wr * 64 + fr + ai * HALF + m * 16];
#pragma unroll
                for (int bj = 0; bj < 2; ++bj) { f32x4 v0, v1;
#pragma unroll
                    for (int j = 0; j < 4; ++j) { v0[j] = (float)acc[ai][bj][m][0][j]; v1[j] = (float)acc[ai][bj][m][1][j]; }
                    v0 = v0 * (cs[bj][0] * sr); v1 = v1 * (cs[bj][1] * sr);
                    if (do_rope) { const int d = (col0 + bj * HALF) & 63; rope8(v0, v1, rope + ((size_t)(row & (SEQ - 1)) * 32 + (d >> 1)) * 2); }
                    u32x4 w; w.x = cvt_pk_bf16(v0[0], v0[1]); w.y = cvt_pk_bf16(v0[2], v0[3]); w.z = cvt_pk_bf16(v1[0], v1[1]); w.w = cvt_pk_bf16(v1[2], v1[3]);
                    *(u32x4*)(rowp + bj * HALF) = w; }
                asm volatile("" ::: "memory"); }
    }
};
struct EpiMlaUp {
    static constexpr bool PERM = true; static constexpr int PF = 0;
    bf16_t* O; const float* rope;
    __device__ __forceinline__ void operator()(const f32x4 (&acc)[2][2][4][2], const Unit& u, int wr, int wc, int fr, int fq) const {
        const int row0 = u.pm * BM + wr * 64 + fr, col0 = u.pn * BM + wc * 32 + 8 * fq;
        const bool qtile = (u.pm < NL / 256) && (u.pn < 6);
        const float qs = u.pn < 6 ? 0.10206207261596575f * LOG2E : 1.0f;
#pragma unroll
        for (int ai = 0; ai < 2; ++ai)
#pragma unroll
            for (int m = 0; m < 4; ++m) { const int row = row0 + ai * HALF + m * 16; bf16_t* rowp = O + (size_t)row * C_UPN + col0;
#pragma unroll
                for (int bj = 0; bj < 2; ++bj) { f32x4 v0 = acc[ai][bj][m][0], v1 = acc[ai][bj][m][1];
                    const int d96 = (col0 + bj * HALF) % 96;
                    if (qtile && d96 >= 64) rope8(v0, v1, rope + ((size_t)(row & (SEQ - 1)) * 16 + ((d96 - 64) >> 1)) * 2);
                    v0 = v0 * qs; v1 = v1 * qs;
                    u32x4 w; w.x = cvt_pk_bf16(v0[0], v0[1]); w.y = cvt_pk_bf16(v0[2], v0[3]); w.z = cvt_pk_bf16(v1[0], v1[1]); w.w = cvt_pk_bf16(v1[2], v1[3]);
                    *(u32x4*)(rowp + bj * HALF) = w; }
                asm volatile("" ::: "memory"); }
    }
};
struct EpiResid {
    static constexpr bool PERM = false; static constexpr int PF = 1;
    const LAS float* epf;
    __device__ __forceinline__ const float* pf_addr(const Unit& u, int tid, int) const { return gmod + (size_t)(u.pm < NL / 256 ? (u.pm >> 3) : 8) * 6144 + u.pn * BM + (tid & 255); }
    bf16_t* XS; const float* gmod; bf16_t* XSo;
    __device__ __forceinline__ void operator()(const f32x4 (&acc)[2][2][4][2], const Unit& u, int wr, int wc, int fr, int fq) const {
        const int row0 = u.pm * BM + wr * 64 + fr, col0 = u.pn * BM + wc * 32 + 4 * fq;
        f32x4 gg[2][2];
#pragma unroll
        for (int bj = 0; bj < 2; ++bj)
#pragma unroll
            for (int n = 0; n < 2; ++n) gg[bj][n] = *(const LAS f32x4*)(epf + wc * 32 + 4 * fq + bj * HALF + n * 16);
#pragma unroll
        for (int ai = 0; ai < 2; ++ai)
#pragma unroll
            for (int m = 0; m < 4; ++m) { const size_t off = (size_t)(row0 + ai * HALF + m * 16) * D + col0;
#pragma unroll
                for (int bj = 0; bj < 2; ++bj)
#pragma unroll
                    for (int n = 0; n < 2; ++n) { const u32x2 w = *(const u32x2*)(XS + off + bj * HALF + n * 16);
                        const f32x4 v = (f32x4){bf_lo(w.x), bf_hi(w.x), bf_lo(w.y), bf_hi(w.y)} + gg[bj][n] * acc[ai][bj][m][n];
                        u32x2 o; o.x = cvt_pk_bf16(v[0], v[1]); o.y = cvt_pk_bf16(v[2], v[3]); *(u32x2*)(XSo + off + bj * HALF + n * 16) = o; } }
    }
};
struct EpiSwiglu {
    static constexpr bool PERM = true; static constexpr int PF = 0;
    bf16_t* ACT; const float* bg; const float* bu;
    __device__ __forceinline__ void operator()(const f32x4 (&acc)[2][2][4][2], const Unit& u, int wr, int wc, int fr, int fq) const {
        const int row0 = u.pm * BM + wr * 64 + fr, col0 = u.pn * HALF + wc * 32 + 8 * fq;
        const float* pg = bg + (size_t)u.e * D + col0; const float* pu = bu + (size_t)u.e * D + col0;
        const f32x4 g0 = *(const f32x4*)pg, g1 = *(const f32x4*)(pg + 4), u0 = *(const f32x4*)pu, u1 = *(const f32x4*)(pu + 4);
#pragma unroll
        for (int ai = 0; ai < 2; ++ai)
#pragma unroll
            for (int m = 0; m < 4; ++m) { bf16_t* rowp = ACT + (size_t)(row0 + ai * HALF + m * 16) * D + col0;
                float r[8];
#pragma unroll
                for (int n = 0; n < 2; ++n)
#pragma unroll
                    for (int j = 0; j < 4; ++j) {
                        float g = acc[ai][0][m][n][j] + (n ? g1[j] : g0[j]); float uu = acc[ai][1][m][n][j] + (n ? u1[j] : u0[j]);
                        g = fminf(g, 7.0f); uu = fminf(fmaxf(uu, -7.0f), 7.0f);
                        const float sg = __builtin_amdgcn_rcpf(1.0f + __builtin_amdgcn_exp2f(-1.702f * LOG2E * g));
                        r[n * 4 + j] = g * sg * (uu + 1.0f); }
                u32x4 w; w.x = cvt_pk_bf16(r[0], r[1]); w.y = cvt_pk_bf16(r[2], r[3]); w.z = cvt_pk_bf16(r[4], r[5]); w.w = cvt_pk_bf16(r[6], r[7]);
                *(u32x4*)rowp = w; }
    }
};
struct EpiSwiglu8 {
    static constexpr bool PERM = true; static constexpr int PF = 2;
    unsigned char* ACTQ; float* SBLK; const float* bg; const float* bu; const float* sal; const float* sbw; const LAS float* epf;
    __device__ __forceinline__ const float* pf_addr(const Unit& u, int tid, int k) const {
        if (k == 1) { const int t = tid & 255; return sal + (size_t)u.e * NT + ((u.mt * 256 + t) < u.cnt ? u.mt * 256 + t : u.mt * 256); }
        const int t = tid & 127;
        return tid < 128 ? bg + (size_t)u.e * D + u.pn * HALF + t : (tid < 256 ? bu + (size_t)u.e * D + u.pn * HALF + t : sbw + (size_t)u.e * 2048 + u.pn * BM + (tid < 384 ? 0 : HALF) + t); }
    __device__ __forceinline__ void operator()(const i32x4 (&acc)[2][2][4][2], const Unit& u, int wr, int wc, int fr, int fq) const {
        const int lr0 = wr * 64 + fr, row0 = u.pm * BM + lr0, col0 = u.pn * HALF + wc * 32 + 8 * fq;
        constexpr float K1 = 1.702f * LOG2E;
        f32x2 r[2][4][4];
#pragma unroll
        for (int n = 0; n < 2; ++n) {
            const LAS float* pe = epf + wc * 32 + 8 * fq + 4 * n;
            const f32x4 gb = *(const LAS f32x4*)pe * (-K1), ub = *(const LAS f32x4*)(pe + 128) + 1.0f, sg = *(const LAS f32x4*)(pe + 256) * (-K1), su = *(const LAS f32x4*)(pe + 384);
#pragma unroll
            for (int ai = 0; ai < 2; ++ai)
#pragma unroll
                for (int m = 0; m < 4; ++m) { const int lr = lr0 + ai * HALF + m * 16; const float sa_ = epf[512 + lr]; const f32x2 sa2 = {sa_, sa_};
#pragma unroll
                    for (int jp = 0; jp < 2; ++jp) {
                        const f32x2 ag = {(float)acc[ai][0][m][n][2 * jp], (float)acc[ai][0][m][n][2 * jp + 1]}, au = {(float)acc[ai][1][m][n][2 * jp], (float)acc[ai][1][m][n][2 * jp + 1]};
                        f32x2 h = (ag * (f32x2){sg[2 * jp], sg[2 * jp + 1]}) * sa2 + (f32x2){gb[2 * jp], gb[2 * jp + 1]};
                        f32x2 u1 = (au * (f32x2){su[2 * jp], su[2 * jp + 1]}) * sa2 + (f32x2){ub[2 * jp], ub[2 * jp + 1]};
                        h[0] = fmaxf(h[0], -7.0f * K1); h[1] = fmaxf(h[1], -7.0f * K1);
                        u1[0] = __builtin_amdgcn_fmed3f(u1[0], -6.0f, 8.0f); u1[1] = __builtin_amdgcn_fmed3f(u1[1], -6.0f, 8.0f);
                        const f32x2 e = {__builtin_amdgcn_exp2f(h[0]), __builtin_amdgcn_exp2f(h[1])};
                        const f32x2 d = e * (f32x2){-K1, -K1} + (f32x2){-K1, -K1};
                        const f32x2 rc = {__builtin_amdgcn_rcpf(d[0]), __builtin_amdgcn_rcpf(d[1])};
                        r[ai][m][2 * n + jp] = (h * u1) * rc; } }
        }
        float ams[8];
#pragma unroll
        for (int ai = 0; ai < 2; ++ai)
#pragma unroll
            for (int m = 0; m < 4; ++m) {
                float am = fmaxf(fmaxf(fmaxf(fabsf(r[ai][m][0][0]), fabsf(r[ai][m][0][1])), fmaxf(fabsf(r[ai][m][1][0]), fabsf(r[ai][m][1][1]))), fmaxf(fmaxf(fabsf(r[ai][m][2][0]), fabsf(r[ai][m][2][1])), fmaxf(fabsf(r[ai][m][3][0]), fabsf(r[ai][m][3][1]))));
                am = swap16_max(am); am = swap32_max(am); am = fmaxf(am, 1e-20f);
                const float inv = 127.0f * __builtin_amdgcn_rcpf(am); const f32x2 inv2 = {inv, inv}, mg = {12582912.0f + 128.0f, 12582912.0f + 128.0f};
                unsigned q[4];
#pragma unroll
                for (int k = 0; k < 4; ++k) { const f32x2 t = r[ai][m][k] * inv2 + mg; q[k] = __builtin_amdgcn_perm(__float_as_uint(t[1]), __float_as_uint(t[0]), 0x0c0c0400u); }
                u32x2 w; w.x = q[0] | (q[1] << 16); w.y = q[2] | (q[3] << 16);
                const size_t row = (size_t)(row0 + ai * HALF + m * 16);
                *(u32x2*)(ACTQ + row * D + col0) = w;
                ams[ai * 4 + m] = am * (1.0f / 127.0f); }
        if (fq == 0) {
#pragma unroll
            for (int i = 0; i < 8; ++i) SBLK[(size_t)(row0 + (i >> 2) * HALF + (i & 3) * 16) * 32 + u.pn * 4 + wc] = ams[i]; }
    }
};
struct EpiDown {
    static constexpr bool PERM = true; static constexpr int PF = 0;
    bf16_t* YS; const float* bd;
    __device__ __forceinline__ void operator()(const f32x4 (&acc)[2][2][4][2], const Unit& u, int wr, int wc, int fr, int fq) const {
        const int row0 = u.pm * BM + wr * 64 + fr, col0 = u.pn * BM + wc * 32 + 8 * fq;
        const float* pb = bd + (size_t)u.e * D + col0;
        f32x4 bv[2][2];
#pragma unroll
        for (int bj = 0; bj < 2; ++bj)
#pragma unroll
            for (int n = 0; n < 2; ++n) bv[bj][n] = *(const f32x4*)(pb + bj * HALF + 4 * n);
#pragma unroll
        for (int ai = 0; ai < 2; ++ai)
#pragma unroll
            for (int m = 0; m < 4; ++m) { bf16_t* rowp = YS + (size_t)(row0 + ai * HALF + m * 16) * D + col0;
#pragma unroll
                for (int bj = 0; bj < 2; ++bj) { const f32x4 v0 = acc[ai][bj][m][0] + bv[bj][0], v1 = acc[ai][bj][m][1] + bv[bj][1];
                    u32x4 w; w.x = cvt_pk_bf16(v0[0], v0[1]); w.y = cvt_pk_bf16(v0[2], v0[3]); w.z = cvt_pk_bf16(v1[0], v1[1]); w.w = cvt_pk_bf16(v1[2], v1[3]);
                    *(u32x4*)(rowp + bj * HALF) = w; } }
    }
};

struct EpiDown8 {
    static constexpr bool PERM = true; static constexpr int PF = 2;
    unsigned char* YSQ; float* YSB; const float* bd; const float* saq; const float* sbd; const LAS float* epf;
    __device__ __forceinline__ const float* pf_addr(const Unit& u, int tid, int k) const {
        if (k == 1) return saq + (size_t)u.pm * BM + (tid & 255);
        return (tid < 256 ? bd : sbd) + (size_t)u.e * D + u.pn * BM + (tid & 255); }
    __device__ __forceinline__ void operator()(const i32x4 (&acc)[2][2][4][2], const Unit& u, int wr, int wc, int fr, int fq) const {
        const int row0 = u.pm * BM + wr * 64 + fr, col0 = u.pn * BM + wc * 32 + 8 * fq;
#pragma unroll
        for (int bj = 0; bj < 2; ++bj) {
            const LAS float* pe = epf + wc * 32 + 8 * fq + bj * HALF;
            const f32x4 b0 = *(const LAS f32x4*)pe, b1 = *(const LAS f32x4*)(pe + 4), s0 = *(const LAS f32x4*)(pe + 256), s1 = *(const LAS f32x4*)(pe + 260);
            float ams[8];
#pragma unroll
            for (int ai = 0; ai < 2; ++ai)
#pragma unroll
                for (int m = 0; m < 4; ++m) { const int row = row0 + ai * HALF + m * 16; const float sr = epf[512 + wr * 64 + fr + ai * HALF + m * 16]; f32x4 v0, v1;
#pragma unroll
                    for (int j = 0; j < 4; ++j) { v0[j] = (float)acc[ai][bj][m][0][j]; v1[j] = (float)acc[ai][bj][m][1][j]; }
                    v0 = v0 * (s0 * sr) + b0; v1 = v1 * (s1 * sr) + b1;
                    float am = fmaxf(fmaxf(fmaxf(fabsf(v0[0]), fabsf(v0[1])), fmaxf(fabsf(v0[2]), fabsf(v0[3]))), fmaxf(fmaxf(fabsf(v1[0]), fabsf(v1[1])), fmaxf(fabsf(v1[2]), fabsf(v1[3]))));
                    am = swap16_max(am); am = swap32_max(am); am = fmaxf(am, 1e-30f);
                    const float inv = 127.0f * __builtin_amdgcn_rcpf(am); const f32x2 inv2 = {inv, inv}, mg = {12582912.0f + 128.0f, 12582912.0f + 128.0f};
                    const f32x2 t0 = (f32x2){v0[0], v0[1]} * inv2 + mg, t1 = (f32x2){v0[2], v0[3]} * inv2 + mg, t2 = (f32x2){v1[0], v1[1]} * inv2 + mg, t3 = (f32x2){v1[2], v1[3]} * inv2 + mg;
                    u32x2 w;
                    w.x = __builtin_amdgcn_perm(__float_as_uint(t0[1]), __float_as_uint(t0[0]), 0x0c0c0400u) | (__builtin_amdgcn_perm(__float_as_uint(t1[1]), __float_as_uint(t1[0]), 0x0c0c0400u) << 16);
                    w.y = __builtin_amdgcn_perm(__float_as_uint(t2[1]), __float_as_uint(t2[0]), 0x0c0c0400u) | (__builtin_amdgcn_perm(__float_as_uint(t3[1]), __float_as_uint(t3[0]), 0x0c0c0400u) << 16);
                    *(u32x2*)(YSQ + (size_t)row * D + col0 + bj * HALF) = w;
                    ams[ai * 4 + m] = am * (1.0f / 127.0f); }
            if (fq == 0) {
#pragma unroll
                for (int i = 0; i < 8; ++i) YSB[(size_t)(row0 + (i >> 2) * HALF + (i & 3) * 16) * 32 + u.pn * 8 + bj * 4 + wc] = ams[i]; }
            asm volatile("" ::: "memory");
        }
    }
};
struct DenseOrder {
    int nM, nN, vcu, xM, xN0, xNn;
    __device__ __forceinline__ bool short_one() const { const int U = nM * nN + xM * xNn, R = (U + 255) >> 8; return (U & 255) != 0 && vcu >= U - (R - 1) * 256; }
    __device__ __forceinline__ bool next(int i, Unit& u) const {
        int L = i * 256 + vcu; const int nmain = nM * nN;
        if (L < nmain) { const int nig = 8 * nN, gid = L / nig, fm = gid * 8, rem = nM - fm, gsz = rem < 8 ? rem : 8, w = L % nig; u.pm = fm + w % gsz; u.pn = w / gsz; }
        else { L -= nmain; if (L >= xM * xNn) return false; u.pm = nM + L % xM; u.pn = xN0 + L / xM; }
        u.e = 0; u.mt = 0; u.cnt = 0; return true;
    }
};
struct MoeOrder {
    const LAS int* ecnt; const LAS int* lbase; const LAS int* cumt; int nN, idx, G; LAS int* ul;
    __device__ __forceinline__ bool short_one() const { const int U = cumt[32] * nN, R = (U + G - 1) / G; return (U % G) != 0 && idx >= U - (R - 1) * G; }
    __device__ __forceinline__ void build(int tid) const {
        if (tid < 16) { const int L = tid * G + idx; int e = -1, pn = 0, mt = 0, pm = 0, c = 0;
            if (idx >= 0 && L < cumt[32] * nN) { e = 0; while (cumt[e + 1] * nN <= L) ++e; const int r = L - cumt[e] * nN; c = ecnt[e]; const int mte = (c + 255) >> 8;
                if (MK_MT_MAJOR & (nN == 4 ? 1 : 2)) { pn = r % nN; mt = r / nN; } else { pn = r / mte; mt = r % mte; } pm = (lbase[e] >> 8) + mt; }
            ul[tid * 8 + 0] = e; ul[tid * 8 + 1] = pn; ul[tid * 8 + 2] = mt; ul[tid * 8 + 3] = pm; ul[tid * 8 + 4] = c; }
        __syncthreads();
    }
    __device__ __forceinline__ bool next(int i, Unit& u) const {
        if (i >= 16) return false;
        const int e = __builtin_amdgcn_readfirstlane(ul[i * 8 + 0]);
        if (e < 0) return false;
        u.e = e; u.pn = __builtin_amdgcn_readfirstlane(ul[i * 8 + 1]); u.mt = __builtin_amdgcn_readfirstlane(ul[i * 8 + 2]); u.pm = __builtin_amdgcn_readfirstlane(ul[i * 8 + 3]); u.cnt = __builtin_amdgcn_readfirstlane(ul[i * 8 + 4]); return true;
    }
};
}

namespace att {
constexpr int VSTR = 144;
template <int DQK> struct Cfg { static constexpr int KSTR = DQK * 2 + 16, KB = 64 * KSTR, VB = 64 * VSTR, STAGE = KB + VB, CPR = DQK / 8, NKS = DQK / 16; };
__device__ __forceinline__ int crow(int r, int hi) { return (r & 3) + 8 * (r >> 2) + 4 * hi; }

template <int DQK, bool MLA>
__device__ __forceinline__ void fetchK(u32x4 (&r)[2], const bf16_t* Kb, const bf16_t* KRb, int pitch, int row0, int tid) {
    typedef Cfg<DQK> C;
    { const int key = tid / C::CPR, ch = tid % C::CPR;
      const bf16_t* src = (MLA && ch >= 8) ? KRb + (size_t)(row0 + key) * 32 + (ch - 8) * 8 : Kb + (size_t)(row0 + key) * pitch + ch * 8;
      r[0] = *(const u32x4*)src; }
    if constexpr (DQK == 96) { if (tid < 256) { const int c = 512 + tid, key = c / C::CPR, ch = c % C::CPR;
      const bf16_t* src = (MLA && ch >= 8) ? KRb + (size_t)(row0 + key) * 32 + (ch - 8) * 8 : Kb + (size_t)(row0 + key) * pitch + ch * 8;
      r[1] = *(const u32x4*)src; } }
}
__device__ __forceinline__ void fetchV(u32x4& r, const bf16_t* Vb, int pitch, int row0, int tid) { const int key = tid >> 3, ch = tid & 7; r = *(const u32x4*)(Vb + (size_t)(row0 + key) * pitch + ch * 8); }
template <int DQK>
__device__ __forceinline__ void stashK(LAS unsigned char* kst, const u32x4 (&r)[2], int tid) {
    typedef Cfg<DQK> C;
    { const int key = tid / C::CPR, ch = tid % C::CPR; *(LAS u32x4*)(kst + key * C::KSTR + ch * 16) = r[0]; }
    if constexpr (DQK == 96) { if (tid < 256) { const int c = 512 + tid, key = c / C::CPR, ch = c % C::CPR; *(LAS u32x4*)(kst + key * C::KSTR + ch * 16) = r[1]; } }
}
__device__ __forceinline__ void stashV(LAS unsigned char* vst, const u32x4& r, int tid) { const int key = tid >> 3, ch = tid & 7; *(LAS u32x4*)(vst + key * VSTR + ch * 16) = r; }
template <int DQK, bool MLA>
__device__ __forceinline__ void fetch(u32x4 (&r)[3], const bf16_t* Kb, const bf16_t* Vb, const bf16_t* KRb, int pitch, int row0, int tid) {
    u32x4 k2[2]; k2[1] = (u32x4){0u, 0u, 0u, 0u}; fetchK<DQK, MLA>(k2, Kb, KRb, pitch, row0, tid); r[0] = k2[0]; r[1] = k2[1]; fetchV(r[2], Vb, pitch, row0, tid);
}
template <int DQK>
__device__ __forceinline__ void stash(LAS unsigned char* st, const u32x4 (&r)[3], int tid) {
    const u32x4 k2[2] = {r[0], r[1]}; stashK<DQK>(st, k2, tid); stashV(st + Cfg<DQK>::KB, r[2], tid);
}
template <int DQK>
__device__ __forceinline__ f32x16 qk(const LAS unsigned char* kst, int koff, const bf16x8 (&qr)[DQK / 16], int r32, int hi) {
    typedef Cfg<DQK> C;
    f32x16 p;
#pragma unroll
    for (int r = 0; r < 16; ++r) p[r] = 0.f;
    const LAS unsigned char* kb = kst + (koff + r32) * C::KSTR + hi * 16;
#pragma unroll
    for (int ks = 0; ks < C::NKS; ++ks) { const bf16x8 kf = *(const LAS bf16x8*)(kb + ks * 32); p = __builtin_amdgcn_mfma_f32_32x32x16_bf16(kf, qr[ks], p, 0, 0, 0); }
    return p;
}
__device__ __forceinline__ s16x4 vtr(const LAS unsigned char* p) { return __builtin_bit_cast(s16x4, __builtin_amdgcn_ds_read_tr16_b64_v4i16((LAS s16x4*)p)); }
typedef __bf16 bf16x2_t __attribute__((ext_vector_type(2)));
__device__ __forceinline__ unsigned cvtpk_s(float lo, float hi) { const f32x2 v = {lo, hi}; const bf16x2_t b = __builtin_convertvector(v, bf16x2_t); return __builtin_bit_cast(unsigned, b); }
template <int NS>
__device__ __forceinline__ void sm_max(const f32x16 (&t)[NS], const float sc, f32x16 (&o)[2], float& m, float& l) {
    float mx = t[0][0];
#pragma unroll
    for (int s = 0; s < NS; ++s)
#pragma unroll
        for (int r = 0; r < 16; ++r) mx = fmaxf(mx, t[s][r]);
    mx = swap32_max(mx) * sc;
    if (__any(mx > m + 8.0f)) { const float mn = fmaxf(m, mx); const float a = __builtin_amdgcn_exp2f(m - mn); m = mn; l *= a;
#pragma unroll
        for (int r = 0; r < 16; ++r) { o[0][r] *= a; o[1][r] *= a; } }
}
template <int NS>
__device__ __forceinline__ void sm_exp_pv(f32x16 (&t)[NS], const float sc, const LAS unsigned char* vst, const int (&voff)[NS], f32x16 (&o)[2], const float m, float& l, int lane) {
    const int hi = lane >> 5;
    float rs = 0.f;
#pragma unroll
    for (int s = 0; s < NS; ++s)
#pragma unroll
        for (int r = 0; r < 16; ++r) { t[s][r] = __builtin_amdgcn_exp2f(__builtin_fmaf(t[s][r], sc, -m)); rs += t[s][r]; }
    l += rs;
    const int q4 = (lane & 15) >> 2, p4 = lane & 3, blk = (lane >> 4) & 1;
#pragma unroll
    for (int s = 0; s < NS; ++s) {
        const LAS unsigned char* vb = vst + (voff[s] + 4 * hi + q4) * VSTR + (16 * blk + 4 * p4) * 2;
#pragma unroll
        for (int kk = 0; kk < 2; ++kk) {
            u32x4 pw; pw.x = cvtpk_s(t[s][8 * kk + 0], t[s][8 * kk + 1]); pw.y = cvtpk_s(t[s][8 * kk + 2], t[s][8 * kk + 3]);
            pw.z = cvtpk_s(t[s][8 * kk + 4], t[s][8 * kk + 5]); pw.w = cvtpk_s(t[s][8 * kk + 6], t[s][8 * kk + 7]);
            const bf16x8 pb = __builtin_bit_cast(bf16x8, pw);
#pragma unroll
            for (int c = 0; c < 2; ++c) {
                const s16x4 lo = vtr(vb + (16 * kk) * VSTR + c * 64), h8 = vtr(vb + (16 * kk + 8) * VSTR + c * 64);
                const bf16x8 va = (bf16x8){lo[0], lo[1], lo[2], lo[3], h8[0], h8[1], h8[2], h8[3]};
                o[c] = __builtin_amdgcn_mfma_f32_32x32x16_bf16(va, pb, o[c], 0, 0, 0);
            }
        }
    }
}
template <int NS>
__device__ __forceinline__ void sm_pv(f32x16 (&t)[NS], const float sc, const LAS unsigned char* vst, const int (&voff)[NS], f32x16 (&o)[2], float& m, float& l, int lane) {
    sm_max<NS>(t, sc, o, m, l); sm_exp_pv<NS>(t, sc, vst, voff, o, m, l, lane);
}
template <int DQK>
__device__ __forceinline__ f32x16 qkn(const LAS unsigned char* kst, int koff, const bf16x8 (&qr)[DQK / 16], const float negm, int r32, int hi) {
    typedef Cfg<DQK> C;
    f32x16 p;
#pragma unroll
    for (int r = 0; r < 16; ++r) p[r] = negm;
    const LAS unsigned char* kb0 = kst + (koff + r32) * C::KSTR + hi * 16;
    bf16x8 kf[C::NKS];
#pragma unroll
    for (int ks = 0; ks < C::NKS; ++ks) kf[ks] = *(const LAS bf16x8*)(kb0 + ks * 32);
    __builtin_amdgcn_sched_barrier(0);
#pragma unroll
    for (int ks = 0; ks < C::NKS; ++ks) p = __builtin_amdgcn_mfma_f32_32x32x16_bf16(kf[ks], qr[ks], p, 0, 0, 0);
    return p;
}
template <int DQK>
__device__ __forceinline__ f32x16 qkn_old(const LAS unsigned char* kst, int koff, const bf16x8 (&qr)[DQK / 16], const f32x16& negm, int r32, int hi) {
    typedef Cfg<DQK> C;
    f32x16 p = negm;
    const LAS unsigned char* kb = kst + (koff + r32) * C::KSTR + hi * 16;
#pragma unroll
    for (int ks = 0; ks < C::NKS; ++ks) { const bf16x8 kf = *(const LAS bf16x8*)(kb + ks * 32); p = __builtin_amdgcn_mfma_f32_32x32x16_bf16(kf, qr[ks], p, 0, 0, 0); }
    return p;
}
__device__ __forceinline__ void sm_max_n(f32x16 (&t)[2], f32x16 (&o)[2], f32x16& osum, float& m, float& negm, bool first) {
    float a0 = fmaxf(fmaxf(t[0][0], t[0][1]), t[0][2]), a1 = fmaxf(fmaxf(t[1][0], t[1][1]), t[1][2]);
#pragma unroll
    for (int r = 3; r < 15; r += 2) { a0 = fmaxf(fmaxf(a0, t[0][r]), t[0][r + 1]); a1 = fmaxf(fmaxf(a1, t[1][r]), t[1][r + 1]); }
    float mx = fmaxf(fmaxf(a0, a1), fmaxf(t[0][15], t[1][15]));
    mx = swap32_max(mx);
    if (first || __any(mx > 8.0f)) { const float d = first ? mx : fmaxf(mx, 0.f); const float a = first ? 1.0f : __builtin_amdgcn_exp2f(-d); m += d;
#pragma unroll
        for (int r = 0; r < 16; ++r) { t[0][r] -= d; t[1][r] -= d; o[0][r] *= a; o[1][r] *= a; osum[r] *= a; } negm = -m; }
}
__device__ __forceinline__ void sm_exp_pv_n(f32x16 (&t)[2], const LAS unsigned char* vst, f32x16 (&o)[2], f32x16& osum, int lane) {
    const int hi = lane >> 5, q4 = (lane & 15) >> 2, p4 = lane & 3, blk = (lane >> 4) & 1;
    const LAS unsigned char* vb = vst + (4 * hi + q4) * VSTR + (16 * blk + 4 * p4) * 2;
    const bf16x8 ones = (bf16x8){0x3F80, 0x3F80, 0x3F80, 0x3F80, 0x3F80, 0x3F80, 0x3F80, 0x3F80};
#pragma unroll
    for (int s = 0; s < 2; ++s) {
        bf16x8 va[2][2];
#pragma unroll
        for (int kk = 0; kk < 2; ++kk)
#pragma unroll
            for (int c = 0; c < 2; ++c) { const s16x4 lo = vtr(vb + (32 * s + 16 * kk) * VSTR + c * 64), h8 = vtr(vb + (32 * s + 16 * kk + 8) * VSTR + c * 64);
                va[kk][c] = (bf16x8){lo[0], lo[1], lo[2], lo[3], h8[0], h8[1], h8[2], h8[3]}; }
        __builtin_amdgcn_sched_barrier(0);
#pragma unroll
        for (int kk = 0; kk < 2; ++kk) {
            float e[8];
#pragma unroll
            for (int j = 0; j < 8; ++j) e[j] = __builtin_amdgcn_exp2f(t[s][8 * kk + j]);
            u32x4 pw; pw.x = cvtpk_s(e[0], e[1]); pw.y = cvtpk_s(e[2], e[3]); pw.z = cvtpk_s(e[4], e[5]); pw.w = cvtpk_s(e[6], e[7]);
            const bf16x8 pb = __builtin_bit_cast(bf16x8, pw);
            o[0] = __builtin_amdgcn_mfma_f32_32x32x16_bf16(va[kk][0], pb, o[0], 0, 0, 0);
            o[1] = __builtin_amdgcn_mfma_f32_32x32x16_bf16(va[kk][1], pb, o[1], 0, 0, 0);
            if (MK_OSUM_MFMA) osum = __builtin_amdgcn_mfma_f32_32x32x16_bf16(ones, pb, osum, 0, 0, 0);
            else { const f32x2 rs = ((f32x2){e[0], e[1]} + (f32x2){e[2], e[3]}) + ((f32x2){e[4], e[5]} + (f32x2){e[6], e[7]}); osum[0] += rs[0] + rs[1]; }
        }
    }
}
__device__ __forceinline__ void store_row64(const f32x16 (&o)[2], float inv, bf16_t* orow, int hi) {
#pragma unroll
    for (int c = 0; c < 2; ++c)
#pragma unroll
        for (int g = 0; g < 4; g += 2) {
            u32x2 a, b;
            a.x = cvt_pk_bf16(o[c][4 * g] * inv, o[c][4 * g + 1] * inv); a.y = cvt_pk_bf16(o[c][4 * g + 2] * inv, o[c][4 * g + 3] * inv);
            b.x = cvt_pk_bf16(o[c][4 * g + 4] * inv, o[c][4 * g + 5] * inv); b.y = cvt_pk_bf16(o[c][4 * g + 6] * inv, o[c][4 * g + 7] * inv);
            { auto r = __builtin_amdgcn_permlane32_swap(a.x, b.x, false, false); a.x = r[0]; b.x = r[1]; }
            { auto r = __builtin_amdgcn_permlane32_swap(a.y, b.y, false, false); a.y = r[0]; b.y = r[1]; }
            u32x4 w; w.x = a.x; w.y = a.y; w.z = b.x; w.w = b.y;
            *(u32x4*)(orow + 32 * c + 8 * g + 8 * hi) = w; }
}
__device__ __forceinline__ void finalize_n(const f32x16 (&o)[2], const f32x16& osum, bf16_t* orow, int hi) {
    const float inv = 1.0f / (MK_OSUM_MFMA ? osum[0] : swap32_sum(osum[0]));
    store_row64(o, inv, orow, hi);
}
__device__ __forceinline__ void finalize(const f32x16 (&o)[2], float l, bf16_t* orow, int hi) {
    l = swap32_sum(l); const float inv = 1.0f / l;
    store_row64(o, inv, orow, hi);
}
#define ATT_PIPE_BEGIN(DQK, MLA, ROW0_OF) \
    u32x4 pre[3]; pre[1] = (u32x4){0u, 0u, 0u, 0u}; \
    fetch<DQK, MLA>(pre, Kb, Vb, KRb, pitch, ROW0_OF(0), tid); stash<DQK>(lds, pre, tid); __syncthreads(); \
    for (int i = 0; i < ntiles; ++i) { \
        if (i + 1 < ntiles) fetch<DQK, MLA>(pre, Kb, Vb, KRb, pitch, ROW0_OF(i + 1), tid); \
        const LAS unsigned char* kst = lds + (i & 1) * Cfg<DQK>::STAGE; const LAS unsigned char* vst = kst + Cfg<DQK>::KB;
#define ATT_PIPE_END(DQK) \
        if (i + 1 < ntiles) stash<DQK>(lds + ((i + 1) & 1) * Cfg<DQK>::STAGE, pre, tid); \
        __syncthreads(); }

#define ATT2_RUN(DQK, MLA, ROW0_OF, QK2, FIRST, STAG) \
    { typedef Cfg<DQK> C_; LAS unsigned char* const kb_ = lds; LAS unsigned char* const vb_ = lds + 2 * C_::KB; \
    u32x4 pk_[2], pv_; pk_[1] = (u32x4){0u, 0u, 0u, 0u}; \
    fetchK<DQK, MLA>(pk_, Kb, KRb, pitch, ROW0_OF(0), tid); fetchV(pv_, Vb, pitch, ROW0_OF(0), tid); stashK<DQK>(kb_, pk_, tid); stashV(vb_, pv_, tid); \
    if (ntiles > 1) { fetchK<DQK, MLA>(pk_, Kb, KRb, pitch, ROW0_OF(1), tid); stashK<DQK>(kb_ + C_::KB, pk_, tid); } \
    __syncthreads(); \
    f32x16 t[2]; QK2(t, kb_, 0); \
    sm_max_n(t, o, osum, m, negm, (FIRST)); \
    __syncthreads();     \
    for (int i = 0; i + 1 < ntiles; ++i) { \
        if (i + 2 < ntiles) fetchK<DQK, MLA>(pk_, Kb, KRb, pitch, ROW0_OF(i + 2), tid); \
        fetchV(pv_, Vb, pitch, ROW0_OF(i + 1), tid); \
        f32x16 tn[2]; \
        if (!(STAG) || wid < 4) { QK2(tn, kb_ + ((i + 1) & 1) * C_::KB, i + 1); }     \
        sm_exp_pv_n(t, vb_ + (i & 1) * C_::VB, o, osum, lane); \
        if ((STAG) && wid >= 4) { QK2(tn, kb_ + ((i + 1) & 1) * C_::KB, i + 1); }     \
        t[0] = tn[0]; t[1] = tn[1]; \
        sm_max_n(t, o, osum, m, negm, false);                                 \
        if (i + 2 < ntiles) stashK<DQK>(kb_ + (i & 1) * C_::KB, pk_, tid); \
        stashV(vb_ + ((i + 1) & 1) * C_::VB, pv_, tid); \
        __syncthreads(); } \
    sm_exp_pv_n(t, vb_ + ((ntiles - 1) & 1) * C_::VB, o, osum, lane); \
    __syncthreads(); }

__device__ __forceinline__ void attn_A_unit(LAS unsigned char* lds, const bf16_t* QKV, bf16_t* O, const float* sink, int b, int kvh, int qb, bool ctxq, int tid) {
    const int lane = tid & 63, wid = __builtin_amdgcn_readfirstlane(tid >> 6), r32 = lane & 31, hi = lane >> 5;
    const int head = kvh * 4 + (wid >> 1), qoff = 32 * (wid & 1) + r32, t0 = qb * 64;
    const int qrow = ctxq ? NL + b * CTXL + t0 + qoff : b * SEQ + t0 + qoff;
    bf16x8 qr[4];
    { const bf16_t* qp = QKV + (size_t)qrow * A_IN + head * 64 + hi * 8;
#pragma unroll
      for (int ks = 0; ks < 4; ++ks) qr[ks] = *(const bf16x8*)(qp + ks * 16); }
    int jlo = 0, nloc = 0;
    if (!ctxq) { jlo = t0 >= 128 ? 0 : (t0 == 64 ? 1 : 2); int jhi = (2112 - t0) / 64; jhi = jhi > 4 ? 4 : jhi; nloc = jhi - jlo + 1; }
    const int ntiles = 4 + nloc, cbase = NL + b * CTXL, lbase = b * SEQ + t0 - 128 + 64 * jlo;
    const bf16_t* Kb = QKV + 1024 + kvh * 64; const bf16_t* Vb = QKV + 1280 + kvh * 64; const bf16_t* KRb = nullptr; const int pitch = A_IN;
    float m = sink[head] * LOG2E;
    f32x16 o[2], osum; float negm = -m;
#pragma unroll
    for (int r = 0; r < 16; ++r) { o[0][r] = 0.f; o[1][r] = 0.f; osum[r] = MK_OSUM_MFMA ? 1.0f : 0.5f; }
#define A_ROW0(i) ((i) < 4 ? cbase + 64 * (i) : lbase + 64 * ((i) - 4))
#define A_QK2(dst, kst, ti) { dst[0] = qkn<64>(kst, 0, qr, negm, r32, hi); dst[1] = qkn<64>(kst, 32, qr, negm, r32, hi); const int j_ = (ti) < 4 ? 2 : jlo + (ti) - 4; \
        if (j_ == 0 || j_ == 4) { _Pragma("unroll") for (int s = 0; s < 2; ++s) _Pragma("unroll") for (int r = 0; r < 16; ++r) { const int kk = 32 * s + crow(r, hi); \
            if (j_ == 0 ? (kk < qoff) : (kk > qoff)) dst[s][r] = -1e30f; } } }
    ATT2_RUN(64, false, A_ROW0, A_QK2, false, (MK_ATT_STAGGER & 1))
#undef A_QK2
#undef A_ROW0
    finalize_n(o, osum, O + (size_t)qrow * D + head * 64, hi);
}

__device__ __forceinline__ void attn_B_unit(LAS unsigned char* lds, LAS float* tab, const bf16_t* QKV, bf16_t* O, const float* rpb, int b, int h, int rq, bool ctxq, int tid) {
    const int lane = tid & 63, wid = __builtin_amdgcn_readfirstlane(tid >> 6), r32 = lane & 31, hi = lane >> 5;
    const int jb = wid & 3, rp = wid >> 2;
    const int rqa = 4 * rq + 2 * rp + (r32 >> 4), qcol = 16 * jb + (r32 & 15);
    const int qrow = ctxq ? NL + b * CTXL + 32 * wid + r32 : b * SEQ + rqa * 64 + qcol;
    for (int idx = tid; idx < 15 * 31; idx += 512) tab[(idx / 31) * 32 + idx % 31] = rpb[h * 465 + idx] * LOG2E;
    bf16x8 qr[4];
    { const bf16_t* qp = QKV + (size_t)qrow * B_IN + h * 64 + hi * 8;
#pragma unroll
      for (int ks = 0; ks < 4; ++ks) qr[ks] = *(const bf16x8*)(qp + ks * 16); }
    int klo = 0, nloc = 0;
    if (!ctxq) { klo = 4 * rq - 4; klo = klo < 0 ? 0 : (klo > 24 ? 24 : klo); int khi = 4 * rq - 1; khi = khi < 0 ? 0 : (khi > 24 ? 24 : khi); khi += 7; nloc = khi - klo + 1; }
    const int ntiles = 4 + nloc, cbase = NL + b * CTXL, lbase = b * SEQ;
    int r0q = rqa - 4; r0q = r0q < 0 ? 0 : (r0q > 24 ? 24 : r0q);
    int wst = qcol - 8; wst = wst < 0 ? 0 : (wst > 48 ? 48 : wst);
    int cst = 16 * jb - 8; cst = cst < 0 ? 0 : (cst > 32 ? 32 : cst);
    const int lo = wst - cst;
    int wr0 = 4 * rq + 2 * rp - 4; wr0 = wr0 < 0 ? 0 : (wr0 > 24 ? 24 : wr0);
    int wr1 = 4 * rq + 2 * rp + 1 - 4; wr1 = wr1 < 0 ? 0 : (wr1 > 24 ? 24 : wr1); wr1 += 7;
    const bf16_t* Kb = QKV + 1024 + h * 64; const bf16_t* Vb = QKV + 2048 + h * 64; const bf16_t* KRb = nullptr; const int pitch = B_IN;
    float m = -1e30f, l = 0.f;
    f32x16 o[2];
#pragma unroll
    for (int r = 0; r < 16; ++r) { o[0][r] = 0.f; o[1][r] = 0.f; }
    const float sc = 0.125f * LOG2E;
#define B_ROW0(i) ((i) < 4 ? cbase + 64 * (i) : lbase + 64 * (klo + (i) - 4))
    ATT_PIPE_BEGIN(64, false, B_ROW0)
        if (i < 4) {
            f32x16 t[2];
            t[0] = qk<64>(kst, 0, qr, r32, hi); t[1] = qk<64>(kst, 32, qr, r32, hi);
#pragma unroll
            for (int s = 0; s < 2; ++s)
#pragma unroll
                for (int r = 0; r < 16; ++r) t[s][r] *= 1.0f;
            const int voff[2] = {0, 32};
            sm_pv<2>(t, 1.0f, vst, voff, o, m, l, lane);
        } else {
            const int kr = klo + i - 4;
            if (kr >= wr0 && kr <= wr1) {
                f32x16 t[1];
                t[0] = qk<64>(kst, cst, qr, r32, hi);
                const bool rowok = (kr >= r0q) && (kr < r0q + 8);
                const int bidx0 = (kr - rqa + 7) * 32 + cst - qcol + 15;
#pragma unroll
                for (int r = 0; r < 16; ++r) { const int kidx = crow(r, hi); const bool ok = rowok && ((unsigned)(kidx - lo) < 16u);
                    int bi = bidx0 + kidx; bi = bi < 0 ? 0 : (bi > 479 ? 479 : bi);
                    const float bias = tab[bi];
                    t[0][r] = ok ? t[0][r] + bias : -1e30f; }
                const int voff[1] = {cst};
                sm_pv<1>(t, 1.0f, vst, voff, o, m, l, lane);
            }
        }
    ATT_PIPE_END(64)
#undef B_ROW0
    finalize(o, l, O + (size_t)qrow * D + h * 64, hi);
}

__device__ __forceinline__ void attn_C_unit(LAS unsigned char* lds, const bf16_t* Q2, const bf16_t* KR, bf16_t* O, int b, int h, int qb, bool ctxq, int tid) {
    const int lane = tid & 63, wid = __builtin_amdgcn_readfirstlane(tid >> 6), r32 = lane & 31, hi = lane >> 5;
    const int qrow = ctxq ? NL + b * CTXL + 32 * wid + r32 : b * SEQ + qb * 256 + 32 * wid + r32;
    bf16x8 qr[6];
    { const bf16_t* qp = Q2 + (size_t)qrow * C_UPN + h * 96 + hi * 8;
#pragma unroll
      for (int ks = 0; ks < 6; ++ks) qr[ks] = *(const bf16x8*)(qp + ks * 16); }
    const int ntiles = ctxq ? 4 : 36, cbase = NL + b * CTXL, lbase = b * SEQ;
    const bf16_t* Kb = Q2 + 1536 + h * 128; const bf16_t* Vb = Kb + 64; const bf16_t* KRb = KR; const int pitch = C_UPN;
    float m = 0.f;
    f32x16 o[2], osum; float negm = 0.f;
#pragma unroll
    for (int r = 0; r < 16; ++r) { o[0][r] = 0.f; o[1][r] = 0.f; osum[r] = 0.f; }
#define C_ROW0(i) ((i) < 4 ? cbase + 64 * (i) : lbase + 64 * ((i) - 4))
#define C_QK2(dst, kst, ti) { dst[0] = qkn<96>(kst, 0, qr, negm, r32, hi); dst[1] = qkn<96>(kst, 32, qr, negm, r32, hi); }
    ATT2_RUN(96, true, C_ROW0, C_QK2, true, (MK_ATT_STAGGER & 2))
#undef C_QK2
#undef C_ROW0
    finalize_n(o, osum, O + (size_t)qrow * D + h * 64, hi);
}
}

struct Row4 { f32x4 v[4]; };
__device__ __forceinline__ void row_load(Row4& x, const float* p, int lane) {
#pragma unroll
    for (int j = 0; j < 4; ++j) x.v[j] = *(const f32x4*)(p + 4 * lane + 256 * j);
}
__device__ __forceinline__ void row_store(const Row4& x, float* p, int lane) {
#pragma unroll
    for (int j = 0; j < 4; ++j) *(f32x4*)(p + 4 * lane + 256 * j) = x.v[j];
}
__device__ __forceinline__ void row_load_bf(Row4& x, const bf16_t* p, int lane) {
#pragma unroll
    for (int j = 0; j < 4; ++j) { const u32x2 w = *(const u32x2*)(p + 4 * lane + 256 * j); x.v[j] = (f32x4){bf_lo(w.x), bf_hi(w.x), bf_lo(w.y), bf_hi(w.y)}; }
}
__device__ __forceinline__ void row_store_bf(const Row4& x, bf16_t* p, int lane) {
#pragma unroll
    for (int j = 0; j < 4; ++j) { u32x2 w; w.x = cvt_pk_bf16(x.v[j][0], x.v[j][1]); w.y = cvt_pk_bf16(x.v[j][2], x.v[j][3]); *(u32x2*)(p + 4 * lane + 256 * j) = w; }
}
__device__ __forceinline__ float row_rstd(const Row4& x, int lane) {
    float s = 0.f;
#pragma unroll
    for (int j = 0; j < 4; ++j) s += (x.v[j][0] * x.v[j][0] + x.v[j][1] * x.v[j][1]) + (x.v[j][2] * x.v[j][2] + x.v[j][3] * x.v[j][3]);
    s = wave_sum(s, lane);
    return 1.0f / sqrtf(s * (1.0f / D) + NORM_EPS);
}
__device__ __forceinline__ void norm_mod(const Row4& x, float rstd, const float* g, const float* sh, const float* sc, bf16_t* out, int lane, Row4& hv) {
#pragma unroll
    for (int j = 0; j < 4; ++j) { const int c = 4 * lane + 256 * j;
        const f32x4 gg = *(const f32x4*)(g + c), s1 = *(const f32x4*)(sc + c), s0 = *(const f32x4*)(sh + c);
        const f32x4 h = (x.v[j] * rstd * gg) * (s1 + 1.0f) + s0; hv.v[j] = h;
        u32x2 w; w.x = cvt_pk_bf16(h[0], h[1]); w.y = cvt_pk_bf16(h[2], h[3]); *(u32x2*)(out + c) = w; }
}

__device__ __forceinline__ unsigned pk_i8x4(float a, float b, float c, float d, float inv) {
    const f32x2 i2 = {inv, inv}, m2 = {12582912.0f, 12582912.0f};
    const f32x2 t01 = (f32x2){a, b} * i2 + m2, t23 = (f32x2){c, d} * i2 + m2;
    const unsigned lo = __builtin_amdgcn_perm(__float_as_uint(t01[1]), __float_as_uint(t01[0]), 0x0c0c0400u), hi = __builtin_amdgcn_perm(__float_as_uint(t23[1]), __float_as_uint(t23[0]), 0x0c0c0400u);
    return lo | (hi << 16);
}
__device__ __forceinline__ void norm_mod8(const Row4& x, float rstd, const float* g, const float* sh, const float* sc, unsigned char* out, float* sarow, int lane) {
    Row4 hv; float am = 0.f;
#pragma unroll
    for (int j = 0; j < 4; ++j) { const int c = 4 * lane + 256 * j;
        const f32x4 gg = *(const f32x4*)(g + c), s1 = *(const f32x4*)(sc + c), s0 = *(const f32x4*)(sh + c);
        const f32x4 h = (x.v[j] * rstd * gg) * (s1 + 1.0f) + s0; hv.v[j] = h;
        am = fmaxf(fmaxf(am, fmaxf(fabsf(h[0]), fabsf(h[1]))), fmaxf(fabsf(h[2]), fabsf(h[3]))); }
    am = fmaxf(wave_max(am, lane), 1e-20f); const float inv = 127.0f / am;
#pragma unroll
    for (int j = 0; j < 4; ++j) *(unsigned*)(out + 4 * lane + 256 * j) = pk_i8x4(hv.v[j][0], hv.v[j][1], hv.v[j][2], hv.v[j][3], inv);
    if (lane == 0) *sarow = am * (1.0f / 127.0f);
}

struct Ptrs {
    const float* in[29]; float* out; unsigned char* ws;
};
typedef const __attribute__((address_space(4))) Ptrs* PK;
#define WSP(T, off) ((T*)(P->ws + (off)))

__device__ __forceinline__ unsigned pk_f16(float a, float b) { const f32x2 v = {a, b}; const f16x2 h = __builtin_convertvector(v, f16x2); return __builtin_bit_cast(unsigned, h); }
__device__ __forceinline__ void phase_first_norm(PK P, LAS unsigned char* lds, int gw, int tid) {
    const float* MOD = WSP(const float, WS_MOD);
    { const int lane = tid & 63;
    {
        const int gt = gw * 64 + lane;
        for (int q = gt; q < DEPTH * 9 * 4096; q += 131072) { const int lb = q >> 12, cc = q & 4095, c = cc >> 5, e = cc & 31, l = lb / 9, b = lb - 9 * l;
            const float* g = P->in[7] + (size_t)l * D + 8 * c; const float* sc = MOD + ((size_t)l * 9 + b) * 6144 + 4096 + 8 * c; const float* w = P->in[21] + ((size_t)l * D + 8 * c) * NEXP + e;
            float v[8];
#pragma unroll
            for (int j = 0; j < 8; ++j) v[j] = g[j] * (1.0f + sc[j]) * w[j * NEXP];
            u32x4 o; o.x = pk_f16(v[0], v[1]); o.y = pk_f16(v[2], v[3]); o.z = pk_f16(v[4], v[5]); o.w = pk_f16(v[6], v[7]);
            *(u32x4*)(WSP(unsigned char, WS_G16) + (size_t)lb * 65536 + e * 2048 + ((c ^ (e & 15)) * 16)) = o; }
        for (int q = gw; q < DEPTH * 9 * 32; q += 2048) { const int lb = q >> 5, e = q & 31, l = lb / 9, b = lb - 9 * l;
            const float* sh = MOD + ((size_t)l * 9 + b) * 6144 + 3072; const float* w = P->in[21] + (size_t)l * D * NEXP + e; float t = 0.f;
#pragma unroll
            for (int j = 0; j < 16; ++j) { const int k = lane + 64 * j; t += sh[k] * w[(size_t)k * NEXP]; }
            t = wave_sum(t, lane);
            if (lane == 0) WSP(float, WS_RC)[q] = t + P->in[22][l * NEXP + e]; }
    } }
    const int lane = tid & 63, vcu = gw >> 3, wid = gw & 7, bb = vcu >> 5;
    LAS float* vec = (LAS float*)lds;
    for (int i = tid; i < 1024; i += 512) { const int set = i >> 9, v = (i >> 8) & 1, k = 4 * (i & 255); const float* mod = MOD + (size_t)(set ? 8 : bb) * 6144;
        *(LAS f32x4*)(vec + set * 2048 + v * 1024 + k) = v ? *(const f32x4*)(mod + k) : *(const f32x4*)(P->in[6] + k) * (*(const f32x4*)(mod + 1024 + k) + 1.0f); }
    __syncthreads();
    const int rbase = bb * 2048 + (vcu & 31) * 64 + wid * 8;
    for (int p = 0; p < 3; ++p) {
        int rr[3]; Row4 x[3];
#pragma unroll
        for (int u = 0; u < 3; ++u) { const int q = 3 * p + u; rr[u] = q < 8 ? rbase + q : NL + vcu * 8 + wid;
            const int r = rr[u]; const float* src = r < NL ? P->in[0] + (size_t)r * D : P->in[2] + (size_t)(r - NL) * D; row_load(x[u], src, lane); }
#pragma unroll
        for (int u = 0; u < 3; ++u) { const int r = rr[u]; row_store_bf(x[u], WSP(bf16_t, WS_XS) + (size_t)r * D, lane);
            const float rstd = row_rstd(x[u], lane); const LAS float* vv = vec + (r < NL ? 0 : 2048) + 4 * lane;
            Row4 hv; float am = 0.f;
#pragma unroll
            for (int j = 0; j < 4; ++j) { const f32x4 h = (x[u].v[j] * rstd) * *(const LAS f32x4*)(vv + 256 * j) + *(const LAS f32x4*)(vv + 1024 + 256 * j); hv.v[j] = h;
                am = fmaxf(fmaxf(am, fmaxf(fabsf(h[0]), fabsf(h[1]))), fmaxf(fabsf(h[2]), fabsf(h[3]))); }
            am = fmaxf(wave_max(am, lane), 1e-20f); const float inv = 127.0f / am; unsigned char* out = WSP(unsigned char, WS_H) + (size_t)r * D;
#pragma unroll
            for (int j = 0; j < 4; ++j) *(unsigned*)(out + 4 * lane + 256 * j) = pk_i8x4(hv.v[j][0], hv.v[j][1], hv.v[j][2], hv.v[j][3], inv);
            if (lane == 0) WSP(float, WS_SAH)[r] = am * (1.0f / 127.0f); }
    }
}
__device__ __forceinline__ void phase_mla_norm(PK P, int gw, int lane) {
    const float* Y = WSP(const float, WS_Y416); bf16_t* CQ = WSP(bf16_t, WS_CQKV); bf16_t* KR = WSP(bf16_t, WS_KR);
    const float* qn = P->in[16]; const float* kn = P->in[17]; const float* rope = WSP(const float, WS_ROPE_C);
    const f32x4 g = *(const f32x4*)(qn + 4 * lane); const f32x2 g2 = *(const f32x2*)(kn + 2 * lane);
    for (int r0 = gw; r0 < NT; r0 += 4096) {
        const int rr[2] = {r0, (r0 + 2048 < NT) ? r0 + 2048 : r0};
        f32x4 vq[2]; f32x2 vk[2], vr[2];
#pragma unroll
        for (int u = 0; u < 2; ++u) { const float* y = Y + (size_t)rr[u] * C_INP; vq[u] = *(const f32x4*)(y + 4 * lane); vk[u] = *(const f32x2*)(y + 256 + 2 * lane); vr[u] = *(const f32x2*)(y + 384 + 2 * (lane & 15)); }
#pragma unroll
        for (int u = 0; u < 2; ++u) { const int r = rr[u]; const f32x4 v = vq[u];
            const float ss = wave_sum((v[0] * v[0] + v[1] * v[1]) + (v[2] * v[2] + v[3] * v[3]), lane);
            const float rq = 1.0f / sqrtf(ss * (1.0f / 256.0f) + NORM_EPS);
            u32x2 w; w.x = cvt_pk_bf16(v[0] * rq * g[0], v[1] * rq * g[1]); w.y = cvt_pk_bf16(v[2] * rq * g[2], v[3] * rq * g[3]);
            *(u32x2*)(CQ + (size_t)r * C_UPK + 4 * lane) = w;
            const f32x2 k2 = vk[u];
            const float s2 = wave_sum(k2[0] * k2[0] + k2[1] * k2[1], lane);
            const float rk = 1.0f / sqrtf(s2 * (1.0f / 128.0f) + NORM_EPS);
            *(unsigned*)(CQ + (size_t)r * C_UPK + 256 + 2 * lane) = cvt_pk_bf16(k2[0] * rk * g2[0], k2[1] * rk * g2[1]);
            if (lane < 16) { f32x2 p = vr[u];
                if (r < NL) { const f32x2 cs = *(const f32x2*)(rope + ((size_t)(r & (SEQ - 1)) * 16 + lane) * 2); const float a = p[0], b = p[1]; p[0] = a * cs[0] - b * cs[1]; p[1] = a * cs[1] + b * cs[0]; }
                *(unsigned*)(KR + (size_t)r * 32 + 2 * lane) = cvt_pk_bf16(p[0], p[1]); }
        }
    }
}
__device__ __forceinline__ void moe_tables(LAS unsigned char* misc, unsigned* gcnt, int tid) {
    LAS int* ecnt = (LAS int*)(misc + M_ECNT); LAS int* lbase = (LAS int*)(misc + M_LBASE); LAS int* cumt = (LAS int*)(misc + M_CUMT);
    if (tid < 32) ecnt[tid] = (int)__hip_atomic_load(gcnt + tid * 16, __ATOMIC_RELAXED, __HIP_MEMORY_SCOPE_AGENT);
    __syncthreads();
    if (tid == 0) { int s = 0, t = 0; for (int e = 0; e < 32; ++e) { lbase[e] = s; cumt[e] = t; const int mt = (ecnt[e] + 255) >> 8; s += mt * 256; t += mt; } cumt[32] = t; }
    __syncthreads();
}
constexpr int RT_PLOG = 65536, RT_LOGIT = 98304, RT_SSQ = 102912, RT_RSTD = 103936, RT_CVEC = 104064, RT_AMX = 104192, RT_TOPV = 105216, RT_TOPE = 105728, RT_VA = 106496, RT_VB = 110592;
__device__ __forceinline__ void phase_router(PK P, LAS unsigned char* lds, int l, int nrows, int vcu, int tid, int cset) {
    const int lane = tid & 63, wid = __builtin_amdgcn_readfirstlane(tid >> 6), i32 = lane & 31, hi = lane >> 5;
    LAS unsigned char* misc = lds + MISC_OFF;
    LAS int* lcnt = (LAS int*)(misc + M_LCNT); LAS int* gbase = (LAS int*)(misc + M_GBASE); LAS int* rec = (LAS int*)(misc + M_REC);
    LAS float* plog = (LAS float*)(lds + RT_PLOG); LAS float* logit = (LAS float*)(lds + RT_LOGIT); LAS float* ssq = (LAS float*)(lds + RT_SSQ);
    LAS float* rstd_s = (LAS float*)(lds + RT_RSTD); LAS float* cvec = (LAS float*)(lds + RT_CVEC); LAS float* amx = (LAS float*)(lds + RT_AMX); LAS float* rowsa = (LAS float*)(misc + M_RSA); LAS float* topv = (LAS float*)(lds + RT_TOPV); LAS int* tope = (LAS int*)(lds + RT_TOPE);
    const bool last = (nrows == NL);
    const int nb = (!last && vcu < 64) ? 3 : 2;
    const float* MOD = WSP(const float, WS_MOD) + (size_t)l * 9 * 6144;
    const bf16_t* XS = WSP(const bf16_t, WS_XS); unsigned char* H8 = WSP(unsigned char, WS_H);
    int* TOPE = WSP(int, WS_TOPE); float* GATE = WSP(float, WS_GATE);
    const float* gn = P->in[7] + (size_t)l * D;
    if (tid < 32) lcnt[tid] = 0;
    u32x4 nw[8];
#define RT_ROW0(b) ((b) < 2 ? 64 * vcu + 32 * (b) : NL + 32 * vcu)
    { const bf16_t* xp0 = XS + (size_t)(RT_ROW0(0) + i32) * D + 128 * wid + 8 * hi;
#pragma unroll
      for (int s = 0; s < 8; ++s) nw[s] = *(const u32x4*)(xp0 + 16 * s); }
    for (int bi = 0; bi < nb; ++bi) {
        const int rb = bi < 2 ? (vcu >> 5) : 8;
        const int row0 = RT_ROW0(bi);
        if (bi != 1) {
            __syncthreads();
            const u32x4* gsrc = (const u32x4*)(WSP(const unsigned char, WS_G16) + (size_t)(l * 9 + rb) * 65536);
#pragma unroll
            for (int c = 0; c < 8; ++c) *(LAS u32x4*)(lds + (size_t)(tid + 512 * c) * 16) = gsrc[tid + 512 * c];
            if (tid < 32) cvec[tid] = WSP(const float, WS_RC)[(l * 9 + rb) * 32 + tid];
            { const float* mod = MOD + (size_t)rb * 6144; const int k = 4 * (tid & 255);
              if (tid < 256) *(LAS f32x4*)(lds + RT_VA + 4 * k) = *(const f32x4*)(gn + k) * (*(const f32x4*)(mod + 4096 + k) + 1.0f);
              else *(LAS f32x4*)(lds + RT_VB + 4 * k) = *(const f32x4*)(mod + 3072 + k); }
            __syncthreads();
        }
        const int r = row0 + i32;
        f32x4 xa[8], xb[8];
#pragma unroll
        for (int s = 0; s < 8; ++s) { const u32x4 w = nw[s];
            xa[s] = (f32x4){bf_lo(w.x), bf_hi(w.x), bf_lo(w.y), bf_hi(w.y)}; xb[s] = (f32x4){bf_lo(w.z), bf_hi(w.z), bf_lo(w.w), bf_hi(w.w)}; }
        if (bi + 1 < nb) { const bf16_t* xpn = XS + (size_t)(RT_ROW0(bi + 1) + i32) * D + 128 * wid + 8 * hi;
#pragma unroll
            for (int s = 0; s < 8; ++s) nw[s] = *(const u32x4*)(xpn + 16 * s); }
        float ss = 0.f;
        f32x16 acc;
#pragma unroll
        for (int q = 0; q < 16; ++q) acc[q] = 0.f;
#pragma unroll
        for (int s = 0; s < 8; ++s) {
            ss += (xa[s][0] * xa[s][0] + xa[s][1] * xa[s][1]) + (xa[s][2] * xa[s][2] + xa[s][3] * xa[s][3]) + (xb[s][0] * xb[s][0] + xb[s][1] * xb[s][1]) + (xb[s][2] * xb[s][2] + xb[s][3] * xb[s][3]);
            u32x4 aw; aw.x = pk_f16(xa[s][0], xa[s][1]); aw.y = pk_f16(xa[s][2], xa[s][3]); aw.z = pk_f16(xb[s][0], xb[s][1]); aw.w = pk_f16(xb[s][2], xb[s][3]);
            const int c = 16 * wid + 2 * s + hi;
            const f16x8 bf = *(const LAS f16x8*)(lds + i32 * 2048 + ((c ^ (i32 & 15)) * 16));
            acc = __builtin_amdgcn_mfma_f32_32x32x16_f16(__builtin_bit_cast(f16x8, aw), bf, acc, 0, 0, 0);
        }
        ss = swap32_sum(ss);
        if (hi == 0) ssq[wid * 32 + i32] = ss;
#pragma unroll
        for (int q = 0; q < 16; ++q) plog[(wid * 32 + att::crow(q, hi)) * 32 + i32] = acc[q];
        __syncthreads();
        if (tid < 32) { float t = 0.f;
#pragma unroll
            for (int w = 0; w < 8; ++w) t += ssq[w * 32 + tid];
            rstd_s[tid] = 1.0f / sqrtf(t * (1.0f / D) + NORM_EPS); }
        __syncthreads();
#pragma unroll
        for (int u = 0; u < 2; ++u) { const int idx = tid + 512 * u, rr = idx >> 5, e = idx & 31; float t = 0.f;
#pragma unroll
            for (int w = 0; w < 8; ++w) t += plog[(w * 32 + rr) * 32 + e];
            logit[rr * 33 + e] = rstd_s[rr] * t + cvec[e]; }
        { const float rs = rstd_s[i32]; const int k0 = 128 * wid + 8 * hi; float am = 0.f;
          const LAS float* va = (const LAS float*)(lds + RT_VA); const LAS float* vb = (const LAS float*)(lds + RT_VB);
#pragma unroll
          for (int s = 0; s < 8; ++s) { const int k = k0 + 16 * s;
              const f32x4 a0 = *(const LAS f32x4*)(va + k), a1 = *(const LAS f32x4*)(va + k + 4), s0 = *(const LAS f32x4*)(vb + k), s1 = *(const LAS f32x4*)(vb + k + 4);
              const f32x4 h0 = (xa[s] * rs) * a0 + s0, h1 = (xb[s] * rs) * a1 + s1; xa[s] = h0; xb[s] = h1;
              am = fmaxf(fmaxf(fmaxf(am, fabsf(h0[0])), fmaxf(fabsf(h0[1]), fabsf(h0[2]))), fmaxf(fmaxf(fabsf(h0[3]), fabsf(h1[0])), fmaxf(fabsf(h1[1]), fmaxf(fabsf(h1[2]), fabsf(h1[3]))))); }
          am = swap32_max(am);
          if (hi == 0) amx[wid * 32 + i32] = am; }
        __syncthreads();
        { float a = amx[i32];
#pragma unroll
          for (int w = 1; w < 8; ++w) a = fmaxf(a, amx[w * 32 + i32]);
          a = fmaxf(a, 1e-20f); const float inv = 127.0f / a;
          if (wid == 0 && hi == 0) rowsa[32 * bi + i32] = a * (1.0f / 127.0f);
          unsigned char* hp = H8 + (size_t)r * D + 128 * wid + 8 * hi;
#pragma unroll
          for (int s = 0; s < 8; ++s) { u32x2 w; w.x = pk_i8x4(xa[s][0], xa[s][1], xa[s][2], xa[s][3], inv); w.y = pk_i8x4(xb[s][0], xb[s][1], xb[s][2], xb[s][3], inv); *(u32x2*)(hp + 16 * s) = w; } }
#pragma unroll
        for (int u = 0; u < 2; ++u) { const int idx = tid + 512 * u, rr = idx >> 5, e = idx & 31; const float v = logit[rr * 33 + e]; int rank = 0;
#pragma unroll 8
            for (int e2 = 0; e2 < 32; ++e2) { const float v2 = logit[rr * 33 + e2]; rank += (v2 > v || (v2 == v && e2 < e)) ? 1 : 0; }
            if (rank < 4) { topv[rr * 4 + rank] = v; tope[rr * 4 + rank] = e; } }
        __syncthreads();
        if (tid < 32) {
            const float t0 = topv[tid * 4], t1 = topv[tid * 4 + 1], t2 = topv[tid * 4 + 2], t3 = topv[tid * 4 + 3]; const int e0 = tope[tid * 4], e1 = tope[tid * 4 + 1], e2 = tope[tid * 4 + 2], e3 = tope[tid * 4 + 3];
            const float x1 = __expf(t1 - t0), x2 = __expf(t2 - t0), x3 = __expf(t3 - t0); const float inv = 1.0f / (1.0f + x1 + x2 + x3);
            const int rr = row0 + tid, lr = 32 * bi + tid;
            *(int4*)(TOPE + (size_t)rr * 4) = make_int4(e0, e1, e2, e3);
            *(f32x4*)(GATE + (size_t)rr * 4) = (f32x4){inv, x1 * inv, x2 * inv, x3 * inv};
            const int ee[4] = {e0, e1, e2, e3};
#pragma unroll
            for (int k = 0; k < 4; ++k) { const int lp = __hip_atomic_fetch_add(lcnt + ee[k], 1, __ATOMIC_RELAXED, __HIP_MEMORY_SCOPE_WORKGROUP); rec[2 * (lr * 4 + k)] = ee[k]; rec[2 * (lr * 4 + k) + 1] = lp; }
        }
    }
    __syncthreads();
    unsigned* gcnt = WSP(unsigned, WS_CTL) + CW_CNT + (l * 2 + cset) * 512;
    if (tid < 32) { const int c = lcnt[tid]; gbase[tid] = c ? (int)__hip_atomic_fetch_add(gcnt + tid * 16, (unsigned)c, __ATOMIC_RELAXED, __HIP_MEMORY_SCOPE_AGENT) : 0; }
    __syncthreads();
    int* ELIST = WSP(int, WS_ELIST); int* POS = WSP(int, WS_POS);
    for (int idx = tid; idx < nb * 128; idx += 512) { const int e = rec[2 * idx], pos = gbase[e] + rec[2 * idx + 1]; const int lr = idx >> 2; const int r = lr < 64 ? 64 * vcu + lr : NL + 32 * vcu + (lr - 64);
        ELIST[(size_t)e * NT + pos] = r; POS[(size_t)r * 4 + (idx & 3)] = pos; WSP(float, WS_SAL)[(size_t)e * NT + pos] = rowsa[lr]; }
    __syncthreads();
}
constexpr int RQU = 8;
__device__ __forceinline__ unsigned rq4(unsigned w, float fac, float c0) {
    const float t0 = (float)(w & 255u) * fac + c0, t1 = (float)((w >> 8) & 255u) * fac + c0, t2 = (float)((w >> 16) & 255u) * fac + c0, t3 = (float)(w >> 24) * fac + c0;
    const unsigned lo = __builtin_amdgcn_perm(__float_as_uint(t1), __float_as_uint(t0), 0x0c0c0400u), hi = __builtin_amdgcn_perm(__float_as_uint(t3), __float_as_uint(t2), 0x0c0c0400u);
    return lo | (hi << 16);
}
__device__ __forceinline__ void phase_requant(PK P, const LAS int* cumt, int gw, int lane) {
    const int nrows = __builtin_amdgcn_readfirstlane(cumt[32]) * 256;
    const int per = (nrows + 2047) >> 11, np = (per + RQU - 1) / RQU, nu = np > 0 ? (per + np - 1) / np : 0;
    const unsigned char* AQ = WSP(const unsigned char, WS_ACT); const float* SB = WSP(const float, WS_SBLK); unsigned char* A8 = WSP(unsigned char, WS_ACT8); float* SAQ = WSP(float, WS_SAQ);
    for (int r0 = gw; r0 < nrows; r0 += nu * 2048) {
        u32x4 a[RQU]; float sb[RQU];
#pragma unroll
        for (int u = 0; u < RQU; ++u) { const int r = r0 + u * 2048; a[u] = (u32x4){0u, 0u, 0u, 0u}; sb[u] = 1.0f;
            if (u < nu && r < nrows) { a[u] = *(const u32x4*)(AQ + (size_t)r * D + 16 * lane); sb[u] = SB[(size_t)r * 32 + (lane >> 1)]; } }
#pragma unroll
        for (int u = 0; u < RQU; ++u) { const int r = r0 + u * 2048;
            if (u < nu && r < nrows) {
                const float srow = wave_max(sb[u], lane); const float fac = sb[u] * __builtin_amdgcn_rcpf(srow), c0 = 12582912.0f - 128.0f * fac;
                u32x4 w; w.x = rq4(a[u].x, fac, c0); w.y = rq4(a[u].y, fac, c0); w.z = rq4(a[u].z, fac, c0); w.w = rq4(a[u].w, fac, c0);
                *(u32x4*)(A8 + (size_t)r * D + 16 * lane) = w;
                if (lane == 0) SAQ[r] = srow; }
        }
    }
}
constexpr int CBU = 3;
__device__ __forceinline__ void phase_combine(PK P, LAS unsigned char* lds, int l, int nrows, int gw, int tid, bool dry) {
    (void)dry; (void)nrows;
    const int lane = tid & 63, vcu = gw >> 3, wid = gw & 7;
    LAS unsigned char* misc = lds + MISC_OFF;
    if (MK_PER_PHASE) moe_tables(misc, WSP(unsigned, WS_CTL) + CW_CNT + (l * 2 + ((MK_REP_MASK >> 11) & 1)) * 512, tid);
    const LAS int* lbase = (const LAS int*)(misc + M_LBASE);
    const float* MOD = WSP(const float, WS_MOD);
    bf16_t* XS = WSP(bf16_t, WS_XS); const unsigned char* YSQ = WSP(const unsigned char, WS_YS); const float* YSB = WSP(const float, WS_YSB);
    const int* TOPE = WSP(const int, WS_TOPE); const int* POS = WSP(const int, WS_POS); const float* GATE = WSP(const float, WS_GATE);
    const bool last = (l == DEPTH - 1);
    const int bb = vcu >> 5;
    LAS float* vec = (LAS float*)lds;
    for (int i = tid; i < (last ? 1 : 2) * 768; i += 512) { const int set = i / 768, v = (i % 768) >> 8, k = 4 * (i & 255), rb = set ? 8 : bb;
        f32x4 w;
        if (v == 0) w = *(const f32x4*)(MOD + (size_t)l * 9 * 6144 + 5120 + (size_t)rb * 6144 + k);
        else if (last) w = *(const f32x4*)(P->in[8] + k);
        else { const float* mod = MOD + (size_t)(l + 1) * 9 * 6144 + (size_t)rb * 6144;
            w = (v == 1) ? *(const f32x4*)(P->in[6] + (size_t)(l + 1) * D + k) * (*(const f32x4*)(mod + 1024 + k) + 1.0f) : *(const f32x4*)(mod + k); }
        *(LAS f32x4*)(vec + set * 3072 + v * 1024 + k) = w; }
    __syncthreads();
    const int rbase = bb * 2048 + (vcu & 31) * 64 + wid * 8;
    for (int p = 0; p < 3; ++p) {
        int rr[CBU]; int vs[CBU];
#pragma unroll
        for (int u = 0; u < CBU; ++u) { const int q = 3 * p + u; const bool cx = (q == 8) && !last;
            rr[u] = q < 8 ? rbase + q : (last ? rbase + 6 : NL + vcu * 8 + wid); vs[u] = cx ? 3072 : 0; }
        int slot[CBU]; float gate[CBU];
#pragma unroll
        for (int u = 0; u < CBU; ++u) { slot[u] = 0; gate[u] = 0.f;
            if (lane < 4 && !(last && 3 * p + u == 8)) { slot[u] = lbase[TOPE[(size_t)rr[u] * 4 + lane]] + POS[(size_t)rr[u] * 4 + lane]; gate[u] = GATE[(size_t)rr[u] * 4 + lane]; } }
        u32x2 xw[CBU][4]; unsigned yw[CBU][4][4]; float ys[CBU][4][4];
#pragma unroll
        for (int u = 0; u < CBU; ++u) { if (last && 3 * p + u == 8) continue;
#pragma unroll
            for (int j = 0; j < 4; ++j) xw[u][j] = *(const u32x2*)(XS + (size_t)rr[u] * D + 4 * lane + 256 * j);
#pragma unroll
            for (int k = 0; k < 4; ++k) { const int sk = __builtin_amdgcn_readlane(slot[u], k); const unsigned char* yr = YSQ + (size_t)sk * D; const float* yb = YSB + (size_t)sk * 32 + (lane >> 3);
#pragma unroll
                for (int j = 0; j < 4; ++j) { yw[u][k][j] = *(const unsigned*)(yr + 4 * lane + 256 * j); ys[u][k][j] = yb[8 * j]; } } }
#pragma unroll
        for (int u = 0; u < CBU; ++u) { if (last && 3 * p + u == 8) continue;
            const int r = rr[u]; const LAS float* vv = vec + vs[u] + 4 * lane;
            Row4 x, f;
#pragma unroll
            for (int j = 0; j < 4; ++j) { x.v[j] = (f32x4){bf_lo(xw[u][j].x), bf_hi(xw[u][j].x), bf_lo(xw[u][j].y), bf_hi(xw[u][j].y)}; f.v[j] = (f32x4){0.f, 0.f, 0.f, 0.f}; }
#pragma unroll
            for (int k = 0; k < 4; ++k) { const float gk = __int_as_float(__builtin_amdgcn_readlane(__float_as_int(gate[u]), k));
#pragma unroll
                for (int j = 0; j < 4; ++j) { const unsigned w = yw[u][k][j]; const float gs = gk * ys[u][k][j], g0 = -128.0f * gs;
                    f.v[j][0] += (float)(w & 255u) * gs + g0; f.v[j][1] += (float)((w >> 8) & 255u) * gs + g0; f.v[j][2] += (float)((w >> 16) & 255u) * gs + g0; f.v[j][3] += (float)(w >> 24) * gs + g0; } }
#pragma unroll
            for (int j = 0; j < 4; ++j) { const f32x4 gg = *(const LAS f32x4*)(vv + 256 * j); x.v[j] = x.v[j] + gg * f.v[j]; }
            const float rstd = row_rstd(x, lane);
            if (last) {
#pragma unroll
                for (int j = 0; j < 4; ++j) { const int c = 4 * lane + 256 * j; *(f32x4*)(P->out + (size_t)r * D + c) = (x.v[j] * rstd) * *(const LAS f32x4*)(vv + 1024 + 256 * j); }
            } else {
                row_store_bf(x, XS + (size_t)r * D, lane);
                Row4 hv; float am = 0.f;
#pragma unroll
                for (int j = 0; j < 4; ++j) { const f32x4 h = (x.v[j] * rstd) * *(const LAS f32x4*)(vv + 1024 + 256 * j) + *(const LAS f32x4*)(vv + 2048 + 256 * j); hv.v[j] = h;
                    am = fmaxf(fmaxf(am, fmaxf(fabsf(h[0]), fabsf(h[1]))), fmaxf(fabsf(h[2]), fabsf(h[3]))); }
                if ((l + 1) % 3 == 2) row_store_bf(hv, WSP(bf16_t, WS_H) + (size_t)r * D, lane);
                else { am = fmaxf(wave_max(am, lane), 1e-20f); const float inv = 127.0f / am; unsigned char* out = WSP(unsigned char, WS_H) + (size_t)r * D;
#pragma unroll
                    for (int j = 0; j < 4; ++j) *(unsigned*)(out + 4 * lane + 256 * j) = pk_i8x4(hv.v[j][0], hv.v[j][1], hv.v[j][2], hv.v[j][3], inv);
                    if (lane == 0) WSP(float, WS_SAH)[r] = am * (1.0f / 127.0f); }
            }
        }
    }
}
__device__ __forceinline__ void phase_final_norm(PK P, int gw, int lane) {
    for (int r = gw; r < NL; r += 2048) { Row4 x; row_load_bf(x, WSP(const bf16_t, WS_XS) + (size_t)r * D, lane); const float rstd = row_rstd(x, lane);
#pragma unroll
        for (int j = 0; j < 4; ++j) { const int c = 4 * lane + 256 * j; const f32x4 gn = *(const f32x4*)(P->in[8] + c); *(f32x4*)(P->out + (size_t)r * D + c) = x.v[j] * rstd * gn; } }
}

__device__ __forceinline__ void conv_item(const float* src, int N, int nvalid, int k0, int n0, bf16_t* dst, int ldk, int drow0, int dk0, LAS unsigned* scr, int lane) {
    const int q = lane >> 4, nl = lane & 15, n = n0 + 4 * nl;
    f32x4 v[16];
#pragma unroll
    for (int r = 0; r < 16; ++r) { const int k = k0 + 8 * (r >> 1) + 2 * q + (r & 1);
        v[r] = (n < nvalid) ? __builtin_nontemporal_load((const f32x4*)(src + (size_t)k * N + n)) : (f32x4){0.f, 0.f, 0.f, 0.f}; }
#pragma unroll
    for (int rp = 0; rp < 8; ++rp)
#pragma unroll
        for (int i = 0; i < 4; ++i) { const int nn = 4 * nl + i, kw = 4 * rp + q; scr[nn * 32 + (kw ^ (4 * ((nn >> 2) & 7)))] = cvt_pk_bf16(v[2 * rp][i], v[2 * rp + 1][i]); }
    asm volatile("s_waitcnt lgkmcnt(0)" ::: "memory");
#pragma unroll
    for (int it = 0; it < 8; ++it) { const int nn = 8 * it + (lane >> 3), c = lane & 7;
        const u32x4 w = *(const LAS u32x4*)(scr + nn * 32 + 4 * (c ^ ((nn >> 2) & 7)));
        *(u32x4*)(dst + (size_t)(drow0 + nn) * ldk + dk0 + 8 * c) = w; }
    asm volatile("s_waitcnt lgkmcnt(0)" ::: "memory");
}
constexpr int CV_A_IN = 2 * 16 * 24, CV_A_OUT = 2 * 256, CV_B_IN = 16 * 48, CV_B_OUT = 256, CV_C_IN = 16 * 8, CV_C_UQ = 4 * 24, CV_C_UKV = 2 * 32, CV_C_OUT = 256;
constexpr int CV_SMALL = CV_A_IN + CV_A_OUT + CV_B_IN + CV_B_OUT + CV_C_IN + CV_C_UQ + CV_C_UKV + CV_C_OUT;
constexpr int CV_LAYER = NEXP * 3 * 256;
constexpr int CV_TOTAL = CV_SMALL + DEPTH * CV_LAYER;
constexpr int CV_CHUNK = 32;
__device__ __forceinline__ void conv_dispatch(PK P, int item, LAS unsigned* scr, int lane) {
    int r = item; const float* src; bf16_t* dst; int N, kb, nb, ldk = D, drow_off = 0, dk_off = 0;
    if (r < CV_A_IN) return;
    else if ((r -= CV_A_IN) < CV_A_OUT) { const int s = r / 256, it = r % 256; kb = it / 16; nb = it % 16; src = P->in[10] + (size_t)s * D * D; N = D; dst = WSP(bf16_t, WS_WA_OUT) + (size_t)s * D * D; }
    else if ((r -= CV_A_OUT) < CV_B_IN) return;
    else if ((r -= CV_B_IN) < CV_B_OUT) { kb = r / 16; nb = r % 16; src = P->in[13]; N = D; dst = WSP(bf16_t, WS_WB_OUT); }
    else if ((r -= CV_B_OUT) < CV_C_IN) { kb = r / 8; nb = r % 8; src = P->in[15]; N = C_IN; dst = WSP(bf16_t, WS_WC_IN); }
    else if ((r -= CV_C_IN) < CV_C_UQ) { kb = r / 24; nb = r % 24; src = P->in[18]; N = 1536; dst = WSP(bf16_t, WS_WC_UP); ldk = C_UPK; }
    else if ((r -= CV_C_UQ) < CV_C_UKV) { kb = r / 32; nb = r % 32; src = P->in[19]; N = 2048; dst = WSP(bf16_t, WS_WC_UP); ldk = C_UPK; drow_off = 1536; dk_off = 256; }
    else { r -= CV_C_UKV; kb = r / 16; nb = r % 16; src = P->in[20]; N = D; dst = WSP(bf16_t, WS_WC_OUT); }
    conv_item(src, N, N, 64 * kb, 64 * nb, dst, ldk, drow_off + 64 * nb, dk_off + 64 * kb, scr, lane);
}
__device__ __forceinline__ void conv_down_item(PK P, int L, int di, LAS unsigned* scr, int lane) {
    const int le = L * NEXP + (di >> 8), it = di & 255, kb = it >> 4, nb = it & 15;
    conv_item(P->in[27] + (size_t)le * D * D, D, D, 64 * kb, 64 * nb, WSP(bf16_t, WS_WD) + (size_t)le * D * D, D, 64 * nb, 64 * kb, scr, lane);
}
__device__ __forceinline__ void conv_q8_block(const float* src0, int N, unsigned char* dstq, float* dsts, LAS unsigned char* lds, int tid) {
    const int lane = tid & 63, wid = __builtin_amdgcn_readfirstlane(tid >> 6), q = lane >> 4, nl = lane & 15;
    const float* src = src0 + 4 * nl;
    f32x4 v[32];
#pragma unroll
    for (int r = 0; r < 32; ++r) { const int k = 128 * wid + 16 * (r >> 2) + 4 * q + (r & 3); v[r] = __builtin_nontemporal_load((const f32x4*)(src + (size_t)k * N)); }
    float cm[4] = {0.f, 0.f, 0.f, 0.f};
#pragma unroll
    for (int r = 0; r < 32; ++r)
#pragma unroll
        for (int i = 0; i < 4; ++i) cm[i] = fmaxf(cm[i], fabsf(v[r][i]));
    LAS float* cmx = (LAS float*)(lds + 65536);
#pragma unroll
    for (int i = 0; i < 4; ++i) { cm[i] = fmaxf(cm[i], shx(cm[i], 16, lane)); cm[i] = swap32_max(cm[i]); }
    if (q == 0) { *(LAS f32x4*)(cmx + wid * 64 + 4 * nl) = (f32x4){cm[0], cm[1], cm[2], cm[3]}; }
    __syncthreads();
    f32x4 a = *(const LAS f32x4*)(cmx + 4 * nl);
#pragma unroll
    for (int w = 1; w < 8; ++w) { const f32x4 b = *(const LAS f32x4*)(cmx + w * 64 + 4 * nl); a[0] = fmaxf(a[0], b[0]); a[1] = fmaxf(a[1], b[1]); a[2] = fmaxf(a[2], b[2]); a[3] = fmaxf(a[3], b[3]); }
    float inv[4];
#pragma unroll
    for (int i = 0; i < 4; ++i) { a[i] = fmaxf(a[i], 1e-30f); inv[i] = 127.0f / a[i]; }
    if (wid == 0 && q == 0) *(f32x4*)(dsts + 4 * nl) = a * (1.0f / 127.0f);
    LAS unsigned* scr = (LAS unsigned*)(lds + wid * 8192);
#pragma unroll
    for (int rp = 0; rp < 8; ++rp)
#pragma unroll
        for (int i = 0; i < 4; ++i) { const int nn = 4 * nl + i, kw = 4 * rp + q;
            scr[nn * 32 + (kw ^ (4 * ((nn >> 2) & 7)))] = pk_i8x4(v[4 * rp][i], v[4 * rp + 1][i], v[4 * rp + 2][i], v[4 * rp + 3][i], inv[i]); }
    asm volatile("s_waitcnt lgkmcnt(0)" ::: "memory");
    unsigned char* dst = dstq + 128 * wid;
#pragma unroll
    for (int it = 0; it < 8; ++it) { const int nn = 8 * it + (lane >> 3), c = lane & 7;
        const u32x4 w = *(const LAS u32x4*)(scr + nn * 32 + 4 * (c ^ ((nn >> 2) & 7)));
        *(u32x4*)(dst + (size_t)nn * D + 16 * c) = w; }
    __syncthreads();
}
__device__ __forceinline__ void conv_gu_block(PK P, LAS unsigned char* lds, int le, int which, int nb, int tid) {
    const int n0 = 64 * nb, drow0 = 256 * (n0 >> 7) + (n0 & 127) + (which ? 128 : 0);
    conv_q8_block(P->in[which ? 25 : 23] + (size_t)le * D * D + n0, D, WSP(unsigned char, WS_WGU) + ((size_t)le * 2048 + drow0) * D, WSP(float, WS_SBW) + (size_t)le * 2048 + drow0, lds, tid);
}
__device__ __forceinline__ void conv_in_block(PK P, LAS unsigned char* lds, int blk, int tid) {
    if (blk < 48) { const int s = blk / 24, nb = blk % 24;
        conv_q8_block(P->in[9] + (size_t)s * D * A_IN + 64 * nb, A_IN, WSP(unsigned char, WS_WA_IN) + ((size_t)s * A_IN + 64 * nb) * D, WSP(float, WS_SBI) + s * A_IN + 64 * nb, lds, tid); }
    else { const int nb = blk - 48;
        conv_q8_block(P->in[12] + 64 * nb, B_IN, WSP(unsigned char, WS_WB_IN) + (size_t)64 * nb * D, WSP(float, WS_SBI) + 2 * A_IN + 64 * nb, lds, tid); }
}
constexpr int CV_SLOTS = 1536;
__device__ __forceinline__ void conv_slot(PK P, LAS unsigned char* lds, int L, int s, int tid) {
    if (s < 1024) { conv_gu_block(P, lds, L * NEXP + (s >> 5), (s >> 4) & 1, s & 15, tid); return; }
    const int d = s - 1024, le = L * NEXP + (d >> 4), nb = d & 15;
    conv_q8_block(P->in[27] + (size_t)le * D * D + 64 * nb, D, WSP(unsigned char, WS_WD) + ((size_t)le * D + 64 * nb) * D, WSP(float, WS_SBD) + (size_t)le * D + 64 * nb, lds, tid);
}
__device__ __forceinline__ void conv_claim(PK P, LAS unsigned char* lds, int L, int quota, int tid) {
    LAS int* slot = (LAS int*)(lds + MISC_OFF + M_CVB);
    unsigned* ctr = WSP(unsigned, WS_CTL) + CW_CV + L * 16;
    for (int q = 0; q < quota; ++q) {
        __syncthreads();
        if (tid == 0) *slot = (int)__hip_atomic_fetch_add(ctr, 1u, __ATOMIC_RELAXED, __HIP_MEMORY_SCOPE_AGENT);
        __syncthreads();
        const int sl = __builtin_amdgcn_readfirstlane(*slot);
        if (sl >= CV_SLOTS) break;
        conv_slot(P, lds, L, sl, tid);
    }
    __syncthreads();
}
__device__ __forceinline__ void phase_prologue(PK P, LAS unsigned char* lds, int bid, int tid) {
    const int lane = tid & 63, wid = __builtin_amdgcn_readfirstlane(tid >> 6);
    {
        LAS float* S = (LAS float*)lds; LAS float* red = (LAS float*)(lds + 40960);
        for (int idx = tid; idx < 9 * D; idx += 512) { const int r = idx >> 10, d = idx & (D - 1); const float v = r < 8 ? P->in[1][r * D + d] : P->in[3][d];
            S[idx] = v / (1.0f + __builtin_amdgcn_exp2f(-v * LOG2E)); }
        __syncthreads();
        const int l = bid >> 6, c0 = (bid & 63) * 96;
        if (lane < 48) {
            float acc[9][2];
#pragma unroll
            for (int r = 0; r < 9; ++r) { acc[r][0] = 0.f; acc[r][1] = 0.f; }
            const float* wp = P->in[4] + ((size_t)l * D + 128 * wid) * 6144 + c0 + 2 * lane;
            const LAS float* sp = S + 128 * wid;
            for (int kb = 0; kb < 128; kb += 32) {
                f32x2 w[32];
#pragma unroll
                for (int k = 0; k < 32; ++k) w[k] = __builtin_nontemporal_load((const f32x2*)(wp + (size_t)(kb + k) * 6144));
#pragma unroll
                for (int k = 0; k < 32; ++k)
#pragma unroll
                    for (int r = 0; r < 9; ++r) { const float s = sp[r * D + kb + k]; acc[r][0] += s * w[k][0]; acc[r][1] += s * w[k][1]; } }
#pragma unroll
            for (int r = 0; r < 9; ++r) { red[(wid * 9 + r) * 96 + 2 * lane] = acc[r][0]; red[(wid * 9 + r) * 96 + 2 * lane + 1] = acc[r][1]; }
        }
        __syncthreads();
        float* MOD = WSP(float, WS_MOD);
        for (int idx = tid; idx < 9 * 96; idx += 512) { const int r = idx / 96, cc = idx % 96; float s = 0.f;
#pragma unroll
            for (int w = 0; w < 8; ++w) s += red[(w * 9 + r) * 96 + cc];
            MOD[((size_t)l * 9 + r) * 6144 + c0 + cc] = s + P->in[5][(size_t)l * 6144 + c0 + cc]; }
        __syncthreads();
    }
    {
        const int gt = bid * 512 + tid; float* RA = WSP(float, WS_ROPE_A); float* RC = WSP(float, WS_ROPE_C);
        const float L2T = 13.287712379549449f;
        for (int idx = gt; idx < SEQ * 32; idx += 131072) { const int t = idx >> 5, i = idx & 31; const float pos = (float)(i < 16 ? (t >> 6) : (t & 63));
            const float inv = __builtin_amdgcn_exp2f(-(float)(i & 15) * (1.0f / 16.0f) * L2T); const float ang = pos * inv; RA[2 * idx] = __cosf(ang); RA[2 * idx + 1] = __sinf(ang); }
        for (int idx = gt; idx < SEQ * 16; idx += 131072) { const int t = idx >> 4, i = idx & 15; const float pos = (float)(i < 8 ? (t >> 6) : (t & 63));
            const float inv = __builtin_amdgcn_exp2f(-(float)(i & 7) * (1.0f / 8.0f) * L2T); const float ang = pos * inv; RC[2 * idx] = __cosf(ang); RC[2 * idx + 1] = __sinf(ang); }
        bf16_t* WU = WSP(bf16_t, WS_WC_UP); const u32x4 z = (u32x4){0u, 0u, 0u, 0u};
        for (int idx = gt; idx < 1536 * 16; idx += 131072) *(u32x4*)(WU + (size_t)(idx >> 4) * C_UPK + 256 + 8 * (idx & 15)) = z;
        for (int idx = gt; idx < 2048 * 32; idx += 131072) *(u32x4*)(WU + (size_t)(1536 + (idx >> 5)) * C_UPK + 8 * (idx & 31)) = z;
    }
    {
        LAS unsigned* scr = (LAS unsigned*)(lds + wid * 8192);
        const int gw = bid * 8 + wid;
        for (int item = gw; item < CV_SMALL; item += 2048) conv_dispatch(P, item, scr, lane);
        __syncthreads();
        for (int blk = bid; blk < 96; blk += 256) conv_in_block(P, lds, blk, tid);
        for (int sl = bid; sl < CV_SLOTS; sl += 256) conv_slot(P, lds, 0, sl, tid);
    }
}

constexpr int PH_PRO = 0, PH_N0 = 1, PH_L0 = 2, PH_PER_LAYER = 9, PH_FINAL = PH_L0 + DEPTH * PH_PER_LAYER, NPH = PH_FINAL + 1;
enum { LP_IN = 0, LP_MLANORM = 1, LP_MLAUP = 2, LP_ATT = 3, LP_OUT = 4, LP_RT = 5, LP_GU = 6, LP_DN = 7, LP_CB = 8 };
struct Args { Ptrs P; int p_lo, p_hi, bar_idx, pad; };

__global__ void __launch_bounds__(512, 2) mk_fwd(Args a) {
    extern __shared__ __attribute__((aligned(16))) unsigned char lds_raw[];
    LAS unsigned char* const lds = (LAS unsigned char*)lds_raw;
    LAS unsigned char* const misc = lds + MISC_OFF;
    typedef const __attribute__((address_space(4))) Args* ArgsK;
    const ArgsK ak = (ArgsK)__builtin_amdgcn_kernarg_segment_ptr();
    (void)a;
    const int wid0 = __builtin_amdgcn_readfirstlane((int)threadIdx.x >> 6);
    if (wid0 == 0 && lane_id() < 4) ((LAS unsigned*)(misc + M_BARW))[lane_id()] = 0u;
    __syncthreads();
    XcdBarrier bar;
    { PK P = &ak->P; bar = xcd_barrier_post(WSP(unsigned, WS_CTL) + CW_BAR + ak->bar_idx * XCD_BAR_WORDS, (volatile LAS unsigned*)(misc + M_BARW), wid0 == 0); }
    bool ran = false;
    const int p_lo = ak->p_lo, p_hi = ak->p_hi;
    int pcnt = 0; unsigned long long ts0 = 0ull, tsd = 0ull; (void)pcnt; (void)ts0; (void)tsd;
#define STAMP_HERE() do { if (MK_TIME_PHASE >= 0 && MK_TIME_PHASE < 1000) { if (pcnt == MK_TIME_PHASE) ts0 = __builtin_amdgcn_s_memrealtime(); if (pcnt == MK_TIME_PHASE + 1) tsd = __builtin_amdgcn_s_memrealtime() - ts0; ++pcnt; } } while (0)
#define PHASE_BEGIN(bit, p, cond) if ((((MK_MASK) >> (bit)) & 1) && p_lo <= (p) && (p) < p_hi && ((p) <= MK_STOP_AFTER || (p) == PH_FINAL) && (cond)) for (int rep_ = 0; rep_ < 1 + (((MK_REP_MASK) >> (bit)) & 1); ++rep_) { if (ran) xcd_barrier(bar); ran = true; STAMP_HERE(); \
    int tid = wid0 * 64 + lane_id(); asm volatile("" : "+v"(tid)); int bid = blockIdx.x; asm volatile("" : "+s"(bid)); ArgsK ak_ = ak; asm volatile("" : "+s"(ak_)); PK P = &ak_->P; \
    const int lane = tid & 63, wid = __builtin_amdgcn_readfirstlane(tid >> 6), vcu = (bid & 7) * 32 + (bid >> 3), gw = vcu * 8 + wid; (void)lane; (void)gw; (void)P;
#define PHASE_END }

    PHASE_BEGIN(0, PH_PRO, true) phase_prologue(P, lds, bid, tid); PHASE_END
    PHASE_BEGIN(1, PH_N0, true) phase_first_norm(P, lds, gw, tid); PHASE_END

    for (int l = 0; l < DEPTH; ++l) {
        const int kind = l % 3, slot = l / 3, pb = PH_L0 + l * PH_PER_LAYER;
        const bool last = (l == DEPTH - 1);
        const int nMrows = last ? NL / 256 : NT / 256;
        PHASE_BEGIN(2, pb + LP_IN, kind == 0) {
            pg8::Gemm g{WSP(const void, WS_H), WSP(const unsigned char, WS_WA_IN) + (size_t)slot * A_IN * D, D, 0, nullptr};
            pg8::DenseOrder S{nMrows, 6, vcu, last ? 8 : 0, 4, 2};
            pg8::EpiQkvA8 E{WSP(bf16_t, WS_QKV), WSP(const float, WS_ROPE_A), WSP(const float, WS_SAH), WSP(const float, WS_SBI) + slot * A_IN, (const LAS float*)(misc + M_EPF)};
            pg8::gemm_phase<pg8::EpiQkvA8, pg8::DenseOrder, false, true>(lds, g, S, E, tid);
            if (l >= 1 && S.short_one()) conv_claim(P, lds, l, MK_Q_IN, tid);
        } PHASE_END
        PHASE_BEGIN(3, pb + LP_IN, kind == 1) {
            pg8::Gemm g{WSP(const void, WS_H), WSP(const unsigned char, WS_WB_IN), D, 0, nullptr};
            pg8::DenseOrder S{NT / 256, 12, vcu, 0, 0, 0};
            pg8::EpiBf16Plain8 E{WSP(bf16_t, WS_QKV), B_IN, 4, 0.125f * LOG2E, WSP(const float, WS_SAH), WSP(const float, WS_SBI) + 2 * A_IN, (const LAS float*)(misc + M_EPF)};
            pg8::gemm_phase<pg8::EpiBf16Plain8, pg8::DenseOrder, false, true>(lds, g, S, E, tid);
            if (S.short_one()) conv_claim(P, lds, l, MK_Q_IN, tid);
        } PHASE_END
        PHASE_BEGIN(4, pb + LP_IN, kind == 2) {
            pg8::Gemm g{WSP(const bf16_t, WS_H), WSP(const bf16_t, WS_WC_IN), D, 0, nullptr};
            pg8::DenseOrder S{NT / 256, 2, vcu, 0, 0, 0};
            if (MK_FUSE_MLANORM) { pg8::EpiMlaIn E{WSP(bf16_t, WS_CQKV), WSP(bf16_t, WS_KR), P->in[16], P->in[17], WSP(const float, WS_ROPE_C), (LAS float*)(misc + M_EPF)};
                pg8::gemm_phase<pg8::EpiMlaIn, pg8::DenseOrder, false>(lds, g, S, E, tid); }
            else { pg8::EpiF32Plain E{WSP(float, WS_Y416), C_INP};
                pg8::gemm_phase<pg8::EpiF32Plain, pg8::DenseOrder, false>(lds, g, S, E, tid); }
            if (vcu >= 144) conv_claim(P, lds, l, 2 * MK_Q_ATT, tid);
        } PHASE_END
        PHASE_BEGIN(5, pb + LP_MLANORM, kind == 2 && !MK_FUSE_MLANORM) phase_mla_norm(P, gw, lane); PHASE_END
        PHASE_BEGIN(6, pb + LP_MLAUP, kind == 2) {
            pg8::Gemm g{WSP(const bf16_t, WS_CQKV), WSP(const bf16_t, WS_WC_UP), C_UPK, 0, nullptr};
            pg8::DenseOrder S{NT / 256, 14, vcu, 0, 0, 0};
            pg8::EpiMlaUp E{WSP(bf16_t, WS_QKV), WSP(const float, WS_ROPE_C)};
            pg8::gemm_phase<pg8::EpiMlaUp, pg8::DenseOrder, false>(lds, g, S, E, tid);
        } PHASE_END
        PHASE_BEGIN(7, pb + LP_ATT, kind == 0) {
            const bf16_t* QKV = WSP(const bf16_t, WS_QKV); bf16_t* O = WSP(bf16_t, WS_O); const float* sink = P->in[11] + slot * 16;
            for (int u = vcu, k = 0; u < 1024; u += 256, ++k) { int t_ = wid0 * 64 + lane_id(); asm volatile("" : "+v"(t_)); const int bk = u >> 5; att::attn_A_unit(lds, QKV, O, sink, bk >> 2, bk & 3, u & 31, false, t_);
                if (MK_Q_STAG > 0 && (vcu & 3) == k) conv_claim(P, lds, l >= 1 ? l : 1, MK_Q_STAG, t_); }
            if (!last) for (int u = vcu; u < 128; u += 256) { const int bk = u >> 2; att::attn_A_unit(lds, QKV, O, sink, bk >> 2, bk & 3, u & 3, true, tid); }
            if (!last && vcu >= 128) conv_claim(P, lds, l >= 1 ? l : 1, MK_Q_ATT, tid);
        } PHASE_END
        PHASE_BEGIN(8, pb + LP_ATT, kind == 1) {
            const bf16_t* QKV = WSP(const bf16_t, WS_QKV); bf16_t* O = WSP(bf16_t, WS_O); LAS float* tab = (LAS float*)(misc + M_RPB);
            for (int u = vcu, k = 0; u < 1024; u += 256, ++k) { int t_ = wid0 * 64 + lane_id(); asm volatile("" : "+v"(t_)); const int bh = u >> 3; att::attn_B_unit(lds, tab, QKV, O, P->in[14], bh >> 4, bh & 15, u & 7, false, t_);
                if (MK_Q_STAG > 0 && (vcu & 3) == k) conv_claim(P, lds, l, MK_Q_STAG, t_); }
            for (int u = vcu; u < 128; u += 256) att::attn_B_unit(lds, tab, QKV, O, P->in[14], u >> 4, u & 15, 0, true, tid);
            if (vcu >= 128) conv_claim(P, lds, l, MK_Q_ATT, tid);
        } PHASE_END
        PHASE_BEGIN(9, pb + LP_ATT, kind == 2) {
            const bf16_t* QKV = WSP(const bf16_t, WS_QKV); bf16_t* O = WSP(bf16_t, WS_O); const bf16_t* KR = WSP(const bf16_t, WS_KR);
            for (int u = vcu, k = 0; u < 1024; u += 256, ++k) { int t_ = wid0 * 64 + lane_id(); asm volatile("" : "+v"(t_)); const int bh = u >> 3; att::attn_C_unit(lds, QKV, KR, O, bh >> 4, bh & 15, u & 7, false, t_);
                if (MK_Q_STAG > 0 && (vcu & 3) == k) conv_claim(P, lds, l, MK_Q_STAG, t_); }
            for (int u = vcu; u < 128; u += 256) att::attn_C_unit(lds, QKV, KR, O, u >> 4, u & 15, 0, true, tid);
            if (vcu >= 128) conv_claim(P, lds, l, MK_Q_ATT, tid);
        } PHASE_END
        PHASE_BEGIN(10, pb + LP_OUT, true) {
            const bf16_t* W = kind == 0 ? WSP(const bf16_t, WS_WA_OUT) + (size_t)slot * D * D : (kind == 1 ? WSP(const bf16_t, WS_WB_OUT) : WSP(const bf16_t, WS_WC_OUT));
            pg8::Gemm g{WSP(const bf16_t, WS_O), W, D, 0, nullptr};
            pg8::DenseOrder S{nMrows, 4, vcu, 0, 0, 0};
            pg8::EpiResid E{(const LAS float*)(misc + M_EPF), WSP(bf16_t, WS_XS), WSP(const float, WS_MOD) + (size_t)l * 9 * 6144 + 2048, (rep_ + 1 < 1 + ((MK_REP_MASK >> 10) & 1)) ? WSP(bf16_t, WS_ACT) : WSP(bf16_t, WS_XS)};
            pg8::gemm_phase<pg8::EpiResid, pg8::DenseOrder, false>(lds, g, S, E, tid);
            if (!last && S.short_one()) conv_claim(P, lds, l + 1, MK_Q_OUT, tid);
        } PHASE_END
        PHASE_BEGIN(11, pb + LP_RT, true) { if (l >= 1) conv_claim(P, lds, l, 1 << 30, tid); phase_router(P, lds, l, last ? NL : NT, vcu, tid, rep_); } PHASE_END
        PHASE_BEGIN(12, pb + LP_GU, true) {
            moe_tables(misc, WSP(unsigned, WS_CTL) + CW_CNT + (l * 2 + ((MK_REP_MASK >> 11) & 1)) * 512, tid);
            pg8::Gemm g{WSP(const void, WS_H), WSP(const unsigned char, WS_WGU) + (size_t)l * NEXP * 2 * D * D, D, (size_t)2 * D * D, WSP(const int, WS_ELIST)};
            const int Ugu = __builtin_amdgcn_readfirstlane(((const LAS int*)(misc + M_CUMT))[32]) * 8, Rgu = (Ugu + 255) >> 8, Gmin = (Ugu + Rgu - 1) / (Rgu > 0 ? Rgu : 1);
            const int cpx = (!last && MK_CVW_GU > 0) ? ((256 - Gmin) >> 3) : 0;
            const bool cvw = (vcu & 31) >= 32 - cpx;
            const int Gc = 256 - 8 * cpx, ic = cvw ? -1 : vcu - cpx * (vcu >> 5);
            pg8::MoeOrder S{(const LAS int*)(misc + M_ECNT), (const LAS int*)(misc + M_LBASE), (const LAS int*)(misc + M_CUMT), 8, ic, Gc, (LAS int*)(misc + M_UL)}; S.build(tid);
            pg8::EpiSwiglu8 E{WSP(unsigned char, WS_ACT), WSP(float, WS_SBLK), P->in[24] + (size_t)l * NEXP * D, P->in[26] + (size_t)l * NEXP * D, WSP(const float, WS_SAL), WSP(const float, WS_SBW) + (size_t)l * NEXP * 2048, (const LAS float*)(misc + M_EPF)};
            pg8::gemm_phase<pg8::EpiSwiglu8, pg8::MoeOrder, true, true>(lds, g, S, E, tid);
            if (!last && (cvw || S.short_one())) conv_claim(P, lds, l + 1, cvw ? (Rgu * MK_CVW_GU) >> 1 : MK_Q_GU, tid);
        } PHASE_END
        PHASE_BEGIN(13, pb + LP_DN, true) {
            if (MK_PER_PHASE) moe_tables(misc, WSP(unsigned, WS_CTL) + CW_CNT + (l * 2 + ((MK_REP_MASK >> 11) & 1)) * 512, tid);
            if (MK_TIME_PHASE == 1000 + l) ts0 = __builtin_amdgcn_s_memrealtime();
            phase_requant(P, (const LAS int*)(misc + M_CUMT), gw, lane);
            xcd_barrier(bar);
            if (MK_TIME_PHASE == 1000 + l) tsd = __builtin_amdgcn_s_memrealtime() - ts0;
            const int Udn = __builtin_amdgcn_readfirstlane(((const LAS int*)(misc + M_CUMT))[32]) * 4, Rdn = (Udn + 255) >> 8, Gmin = (Udn + Rdn - 1) / (Rdn > 0 ? Rdn : 1);
            const int cpx = (!last && MK_CVW_DN > 0) ? ((256 - Gmin) >> 3) : 0;
            const bool cvw = (vcu & 31) >= 32 - cpx;
            const int Gc = 256 - 8 * cpx, ic = cvw ? -1 : vcu - cpx * (vcu >> 5);
            pg8::Gemm g{WSP(const void, WS_ACT8), WSP(const unsigned char, WS_WD) + (size_t)l * NEXP * D * D, D, (size_t)D * D, nullptr};
            pg8::MoeOrder S{(const LAS int*)(misc + M_ECNT), (const LAS int*)(misc + M_LBASE), (const LAS int*)(misc + M_CUMT), 4, ic, Gc, (LAS int*)(misc + M_UL)}; S.build(tid);
            pg8::EpiDown8 E{WSP(unsigned char, WS_YS), WSP(float, WS_YSB), P->in[28] + (size_t)l * NEXP * D, WSP(const float, WS_SAQ), WSP(const float, WS_SBD) + (size_t)l * NEXP * D, (const LAS float*)(misc + M_EPF)};
            pg8::gemm_phase<pg8::EpiDown8, pg8::MoeOrder, false, true>(lds, g, S, E, tid);
            if (!last && (cvw || S.short_one())) conv_claim(P, lds, l + 1, cvw ? (Rdn * MK_CVW_DN) >> 1 : MK_Q_DN, tid);
        } PHASE_END
        PHASE_BEGIN(14, pb + LP_CB, true) phase_combine(P, lds, l, last ? NL : NT, gw, tid, (rep_ + 1 < 1 + ((MK_REP_MASK >> 14) & 1))); PHASE_END
    }
    PHASE_BEGIN(15, PH_FINAL, MK_STOP_AFTER < PH_FINAL - 1) phase_final_norm(P, gw, lane); PHASE_END
    if (MK_TIME_PHASE >= 0) {
        xcd_barrier(bar); STAMP_HERE();
        ArgsK ak_ = ak; PK P = &ak_->P; unsigned* tw = WSP(unsigned, WS_CTL) + 300;
        if (blockIdx.x == 0 && wid0 == 0 && lane_id() == 0) __hip_atomic_store(tw, (unsigned)tsd, __ATOMIC_RELAXED, __HIP_MEMORY_SCOPE_AGENT);
        xcd_barrier(bar);
        const float us = (float)__hip_atomic_load(tw, __ATOMIC_RELAXED, __HIP_MEMORY_SCOPE_AGENT) * 0.01f; const float sv = log2f(fmaxf(us, 1.0f));
        const int gt = blockIdx.x * 512 + wid0 * 64 + lane_id();
        for (int i = gt; i < NL * D / 4; i += 131072) ((f32x4*)P->out)[i] = (f32x4){sv, sv, sv, sv};
    }
#undef PHASE_BEGIN
#undef PHASE_END
}

extern "C" void kernel_launch(void* const* d_in, const int* in_sizes, int n_in, void* d_out, int out_size, void* d_ws, size_t ws_size, hipStream_t stream) {
    static int grid = 0;
    if (grid == 0) {
        if (n_in != 29 || out_size != NL * D || ws_size < WS_END) { fprintf(stderr, "kernel_launch: expected 29 inputs, out %d, ws >= %zu; got n_in %d out %d ws %zu\n", NL * D, (size_t)WS_END, n_in, out_size, ws_size); grid = -1; return; }
        int dev = 0, cus = 0, per_cu = 0;
        if (hipGetDevice(&dev) != hipSuccess || hipDeviceGetAttribute(&cus, hipDeviceAttributeMultiprocessorCount, dev) != hipSuccess) { grid = -1; return; }
        if (hipFuncSetAttribute((const void*)mk_fwd, hipFuncAttributeMaxDynamicSharedMemorySize, LDS_BYTES) != hipSuccess) { fprintf(stderr, "kernel_launch: hipFuncSetAttribute failed\n"); grid = -1; return; }
        if (hipOccupancyMaxActiveBlocksPerMultiprocessor(&per_cu, (const void*)mk_fwd, 512, LDS_BYTES) != hipSuccess || per_cu < 1) fprintf(stderr, "kernel_launch: occupancy query says %d\n", per_cu);
        (void)hipGetLastError();
        grid = 256;
        if (cus < 256) { fprintf(stderr, "kernel_launch: needs 256 CUs, device has %d\n", cus); grid = -1; return; }
    }
    if (grid < 0) return;
    if (hipMemsetAsync((char*)d_ws + WS_CTL, 0, CTL_BYTES, stream) != hipSuccess) return;
    Args a{};
    for (int i = 0; i < 29; ++i) a.P.in[i] = (const float*)d_in[i];
    a.P.out = (float*)d_out; a.P.ws = (unsigned char*)d_ws; a.pad = 0;
#if MK_PER_PHASE
    for (int p = 0; p < NPH; ++p) { a.p_lo = p; a.p_hi = p + 1; a.bar_idx = 0; hipLaunchKernelGGL(mk_fwd, dim3(grid), dim3(512), LDS_BYTES, stream, a); }
#else
    a.p_lo = 0; a.p_hi = NPH; a.bar_idx = 0;
    hipLaunchKernelGGL(mk_fwd, dim3(grid), dim3(512), LDS_BYTES, stream, a);
#endif
    const hipError_t le = hipPeekAtLastError();
    if (le != hipSuccess) fprintf(stderr, "kernel_launch: launch failed: %s\n", hipGetErrorName(le));
}
```

```cpp
#include <hip/hip_runtime.h>
#include <cstdio>
#include <cstdint>

#ifndef MK_PER_PHASE
#define MK_PER_PHASE 0
#endif
#ifndef MK_MASK
#define MK_MASK 0xFFFF
#endif
#ifndef MK_REP_MASK
#define MK_REP_MASK 0
#endif
#ifndef MK_Q_OUT
#define MK_Q_OUT 1
#endif
#ifndef MK_Q_GU
#define MK_Q_GU 1
#endif
#ifndef MK_Q_DN
#define MK_Q_DN 1
#endif
#ifndef MK_Q_IN
#define MK_Q_IN 1
#endif
#ifndef MK_MT_MAJOR
#define MK_MT_MAJOR 1
#endif
#ifndef MK_Q_ATT
#define MK_Q_ATT 1
#endif
#ifndef MK_OSUM_MFMA
#define MK_OSUM_MFMA 0
#endif
#ifndef MK_Q_STAG
#define MK_Q_STAG 1
#endif
#ifndef MK_EPI2
#define MK_EPI2 0
#endif
#ifndef MK_ATT_STAGGER
#define MK_ATT_STAGGER 3
#endif
#ifndef MK_FUSE_MLANORM
#define MK_FUSE_MLANORM 1
#endif
#ifndef MK_CVW_GU
#define MK_CVW_GU 0
#endif
#ifndef MK_CVW_DN
#define MK_CVW_DN 0
#endif
#ifndef MK_TIME_PHASE
#define MK_TIME_PHASE -1
#endif
#ifndef MK_STOP_AFTER
#define MK_STOP_AFTER 9999
#endif

#define LAS __attribute__((address_space(3)))
#define GAS __attribute__((address_space(1)))
typedef unsigned short bf16_t;
typedef short bf16x8 __attribute__((ext_vector_type(8)));
typedef short s16x4 __attribute__((ext_vector_type(4)));
typedef _Float16 f16x8 __attribute__((ext_vector_type(8)));
typedef _Float16 f16x2 __attribute__((ext_vector_type(2)));
typedef float f32x2 __attribute__((ext_vector_type(2)));
typedef float f32x4 __attribute__((ext_vector_type(4)));
typedef float f32x16 __attribute__((ext_vector_type(16)));
typedef unsigned u32x2 __attribute__((ext_vector_type(2)));
typedef unsigned u32x4 __attribute__((ext_vector_type(4)));
typedef int i32x4 __attribute__((ext_vector_type(4)));

constexpr int D = 1024, NB = 8, SEQ = 2048, CTXL = 256, DEPTH = 4;
constexpr int NL = NB * SEQ;
constexpr int NC = NB * CTXL;
constexpr int NT = NL + NC;
constexpr int NEXP = 32, TOPK = 4;
constexpr int MAXSLOT = 81920;
constexpr float NORM_EPS = 1e-6f;
constexpr float LOG2E = 1.4426950408889634f;
constexpr int A_IN = 1536, B_IN = 3072, C_IN = 416, C_INP = 512, C_UPK = 384, C_UPN = 3584;

constexpr size_t MiB = 1u << 20;
constexpr size_t WS_CTL = 0, CTL_BYTES = 1 * MiB;
constexpr size_t WS_MOD = 1 * MiB;
constexpr size_t WS_ROPE_A = 2 * MiB;
constexpr size_t WS_ROPE_C = 2 * MiB + 512 * 1024;
constexpr size_t WS_TOPE = 3 * MiB;
constexpr size_t WS_POS = 3 * MiB + 512 * 1024;
constexpr size_t WS_GATE = 4 * MiB;
constexpr size_t WS_ELIST = 5 * MiB;
constexpr size_t WS_KR = 8 * MiB;
constexpr size_t WS_CQKV = 10 * MiB;
constexpr size_t WS_Y416 = 24 * MiB;
constexpr size_t WS_XS = 60 * MiB;
constexpr size_t WS_H = 132 * MiB;
constexpr size_t WS_O = 168 * MiB;
constexpr size_t WS_QKV = 204 * MiB;
constexpr size_t WS_ACT = 330 * MiB;
constexpr size_t WS_SBLK = 426 * MiB;
constexpr size_t WS_YS = 490 * MiB;
constexpr size_t WS_YSB = 586 * MiB;
constexpr size_t WS_WA_IN = 650 * MiB;
constexpr size_t WS_WA_OUT = 656 * MiB;
constexpr size_t WS_WB_IN = 660 * MiB;
constexpr size_t WS_WB_OUT = 666 * MiB;
constexpr size_t WS_WC_IN = 668 * MiB;
constexpr size_t WS_WC_UP = 669 * MiB;
constexpr size_t WS_WC_OUT = 672 * MiB;
constexpr size_t WS_WGU = 676 * MiB;
constexpr size_t WS_WD = 1188 * MiB;
constexpr size_t WS_G16 = 1444 * MiB;
constexpr size_t WS_RC = 1447 * MiB;
constexpr size_t WS_SBW = 1448 * MiB;
constexpr size_t WS_SAL = 1449 * MiB;
constexpr size_t WS_SAH = 1452 * MiB;
constexpr size_t WS_SBI = 1452 * MiB + 128 * 1024;
constexpr size_t WS_ACT8 = 1453 * MiB;
constexpr size_t WS_SAQ = 1533 * MiB;
constexpr size_t WS_SBD = 1533 * MiB + 512 * 1024;
constexpr size_t WS_END = 1535 * MiB;

constexpr int CW_CV = 512;
constexpr int CW_CNT = 1024;
constexpr int CW_BAR = 65536;

constexpr int RING_BYTES = 131072;
constexpr int MISC_OFF = RING_BYTES;
constexpr int M_BARW = 0, M_LCNT = 64, M_LBASE = 192, M_CUMT = 320, M_ECNT = 512, M_GBASE = 640, M_CVB = 768, M_UL = 6656, M_RSA = 7424, M_EPF = 8192, M_RPB = 1024, M_REC = 3072;
constexpr int LDS_BYTES = 147456;

#define XB_TMO      128
#define XB_XCNT(j)  (256  + 64 * (j))
#define XB_XSUB(j)  (1280 + 64 * (j))
#define XB_XGEN(j)  (2304 + 64 * (j))
#define XB_TOP      3328
#define XB_TOPGEN   3392
#define XCD_BAR_WORDS 3456
#define XB_SPIN_CAP (1u << 18)

__device__ __forceinline__ unsigned xb_ld(unsigned* p)              { return __hip_atomic_load(p, __ATOMIC_RELAXED, __HIP_MEMORY_SCOPE_AGENT); }
__device__ __forceinline__ unsigned xb_add(unsigned* p, unsigned v) { return __hip_atomic_fetch_add(p, v, __ATOMIC_RELAXED, __HIP_MEMORY_SCOPE_AGENT); }
__device__ __forceinline__ unsigned xb_xcc_id() { return (unsigned)__builtin_amdgcn_s_getreg((3 << 11) | 20) & 0xFu; }
#define XB_SPIN(cond, bar) do { unsigned _sp = 0; while (cond) { __builtin_amdgcn_s_sleep(1); \
    if ((++_sp & 255u) == 0u) { if (xb_ld(&(bar)[XB_TMO])) break; if (_sp > XB_SPIN_CAP) { atomicAdd(&(bar)[XB_TMO], 1u); break; } } } } while (0)

__device__ __forceinline__ int lane_id() { int r; asm volatile("v_mbcnt_lo_u32_b32 %0, -1, 0\n\tv_mbcnt_hi_u32_b32 %0, -1, %0" : "=v"(r)); return r; }
struct XcdBarrier {
    unsigned* bar; unsigned x;
    volatile LAS unsigned* st;
    bool lead;
};
__device__ __forceinline__ XcdBarrier xcd_barrier_post(unsigned* bar, volatile LAS unsigned* st, bool lead) {
    XcdBarrier b; b.bar = bar; b.x = xb_xcc_id(); b.st = st; b.lead = lead;
    if (lead && lane_id() == 0) (void)xb_add(&bar[XB_XCNT(b.x)], 1u);
    return b;
}
__device__ __forceinline__ void xcd_barrier_complete(unsigned* bar, unsigned x, unsigned& nloc, unsigned& nx) {
    const unsigned G = gridDim.x * gridDim.y * gridDim.z;
    unsigned sum, cnt, mine, sp = 0u;
    for (;;) {
        sum = 0u; cnt = 0u; mine = 0u;
#pragma unroll
        for (unsigned j = 0; j < 16; ++j) { const unsigned c = xb_ld(&bar[XB_XCNT(j)]); sum += c; cnt += (c > 0u) ? 1u : 0u; mine = (j == x) ? c : mine; }
        if (sum == G) break;
        __builtin_amdgcn_s_sleep(1);
        if ((++sp & 255u) == 0u) { if (xb_ld(&bar[XB_TMO])) break; if (sp > XB_SPIN_CAP) { atomicAdd(&bar[XB_TMO], 1u); break; } }
    }
    nloc = mine > 0u ? mine : 1u; nx = cnt > 0u ? cnt : 1u;
}
__device__ __forceinline__ void xcd_barrier(const XcdBarrier& b) {
    asm volatile("s_waitcnt vmcnt(0)" ::: "memory");
    __syncthreads();
    if (b.lead && lane_id() == 0) {
        unsigned* bar = b.bar;
        __builtin_amdgcn_s_waitcnt(0);
        unsigned nloc = b.st[0], nx = b.st[1];
        if (nloc == 0u) { xcd_barrier_complete(bar, b.x, nloc, nx); b.st[0] = nloc; b.st[1] = nx; }
        const unsigned old = xb_add(&bar[XB_XSUB(b.x)], 1u);
        const unsigned gen = old / nloc;
        if (old + 1u == (gen + 1u) * nloc) {
            __builtin_amdgcn_fence(__ATOMIC_RELEASE, "agent");
            asm volatile("s_waitcnt vmcnt(0)" ::: "memory");
            const unsigned og = xb_add(&bar[XB_TOP], 1u);
            const unsigned tg = og / nx;
            if (og + 1u == (tg + 1u) * nx) xb_add(&bar[XB_TOPGEN], 1u);
            else XB_SPIN(xb_ld(&bar[XB_TOPGEN]) == tg, bar);
            __builtin_amdgcn_fence(__ATOMIC_ACQUIRE, "agent");
            xb_add(&bar[XB_XGEN(b.x)], 1u);
            asm volatile("s_waitcnt vmcnt(0)" ::: "memory");
        } else {
            XB_SPIN(xb_ld(&bar[XB_XGEN(b.x)]) == gen, bar);
            __builtin_amdgcn_fence(__ATOMIC_ACQUIRE, "agent");
            asm volatile("s_waitcnt vmcnt(0)" ::: "memory");
        }
    }
    __syncthreads();
}

__device__ __forceinline__ unsigned cvt_pk_bf16(float lo, float hi) { unsigned r; asm volatile("v_cvt_pk_bf16_f32 %0, %1, %2" : "=v"(r) : "v"(lo), "v"(hi)); return r; }
__device__ __forceinline__ float bf_lo(unsigned w) { return __uint_as_float(w << 16); }
__device__ __forceinline__ float bf_hi(unsigned w) { return __uint_as_float(w & 0xffff0000u); }
__device__ __forceinline__ float shx(float v, int mask, int lane) { return __int_as_float(__builtin_amdgcn_ds_bpermute((lane ^ mask) << 2, __float_as_int(v))); }
__device__ __forceinline__ float wave_sum(float v, int lane) {
#pragma unroll
    for (int o = 1; o < 64; o <<= 1) v += shx(v, o, lane);
    return v;
}
__device__ __forceinline__ float wave_max(float v, int lane) {
#pragma unroll
    for (int o = 1; o < 64; o <<= 1) v = fmaxf(v, shx(v, o, lane));
    return v;
}
__device__ __forceinline__ float swap32_max(float m) { auto rr = __builtin_amdgcn_permlane32_swap(__float_as_uint(m), __float_as_uint(m), false, false); return fmaxf(__uint_as_float(rr[0]), __uint_as_float(rr[1])); }
__device__ __forceinline__ float swap16_max(float m) { auto rr = __builtin_amdgcn_permlane16_swap(__float_as_uint(m), __float_as_uint(m), false, false); return fmaxf(__uint_as_float(rr[0]), __uint_as_float(rr[1])); }
__device__ __forceinline__ float swap16_sum(float m) { auto rr = __builtin_amdgcn_permlane16_swap(__float_as_uint(m), __float_as_uint(m), false, false); return __uint_as_float(rr[0]) + __uint_as_float(rr[1]); }
__device__ __forceinline__ float swap32_sum(float m) { auto rr = __builtin_amdgcn_permlane32_swap(__float_as_uint(m), __float_as_uint(m), false, false); return __uint_as_float(rr[0]) + __uint_as_float(rr[1]); }

namespace pg8 {
constexpr int BM = 256, BK = 64, HALF = 128, HTB = HALF * BK * 2, STAGE_BYTES = 8 * HTB;
__host__ __device__ __forceinline__ int lds_byte(int r, int c) { const int st = (r >> 4) * 2 + (c >> 5), rr = r & 15, cc = c & 31, ob = rr * 64 + cc * 2; return st * 1024 + (ob ^ (((ob >> 9) & 1) << 5)); }
__host__ __device__ __forceinline__ void stage_rc(int b, int& R, int& C) { const int st = b / 1024, sb = b % 1024, swz = sb ^ (((sb >> 9) & 1) << 5); R = (st >> 1) * 16 + swz / 64; C = (st & 1) * 32 + (swz % 64) / 2; }
__host__ __device__ __forceinline__ int perm32(int rho) { const int n = rho >> 4, i = rho & 15; return 8 * (i >> 2) + 4 * n + (i & 3); }

struct Unit { int pm, pn, e, mt, cnt; };
struct Gemm { const void* A; const void* Bt; int K; size_t bstride; const int* list; };

template <bool I8> struct AccSel { typedef f32x4 type; };
template <> struct AccSel<true> { typedef i32x4 type; };
template <class Epi, class Sched, bool GATHER, bool I8 = false>
__device__ __forceinline__ void gemm_phase(LAS unsigned char* lds, const Gemm g, const Sched& S, const Epi& E, const int tid) {
    const int wid = __builtin_amdgcn_readfirstlane(tid >> 6), lane = tid & 63, wr = wid >> 2, wc = wid & 3, fr = lane & 15, fq = lane >> 4;
    typedef typename AccSel<I8>::type acc_t;
    const int K = g.K, RB = I8 ? K : 2 * K, nt = RB / (BK * 2);
    unsigned voffA[2], voffB[2];
#pragma unroll
    for (int i = 0; i < 2; ++i) { int R, C; stage_rc(tid * 16 + i * 8192, R, C); const int Rb = Epi::PERM ? ((R & ~31) + perm32(R & 31)) : R;
        voffA[i] = (unsigned)(R * RB + C * 2); voffB[i] = (unsigned)(Rb * RB + C * 2); }
#define PG8_RC(i, R_, C_) int R_, C_; { int _t = tid; asm volatile("" : "+v"(_t)); stage_rc(_t * 16 + (i) * 8192, R_, C_); }
    const size_t kstep = (size_t)(BK * 2);
    const size_t hstep = (size_t)HALF * RB;
    const size_t tstep = 2 * hstep;
    const unsigned ldsw = (unsigned)wid * 1024u;
    const int aoff = lds_byte(wr * 64 + fr, fq * 8), boff = lds_byte(wc * 32 + fr, fq * 8);
#define PG8_SA(b, h) (((b) * 2 + (h)) * HTB)
#define PG8_SB(b, h) ((4 + (b) * 2 + (h)) * HTB)
#define PG8_STAGE(bufoff, gbase, voff) do { _Pragma("unroll") for (int _i = 0; _i < 2; ++_i) \
        __builtin_amdgcn_global_load_lds((const unsigned*)((const char*)(gbase) + (voff)[_i]), (LAS unsigned*)(lds + (bufoff) + ldsw + _i * 8192), 16, 0, 0); } while (0)
#define PG8_STAGE_A(bufoff, SELN, H, KOFF) do { if constexpr (GATHER) { unsigned _vo[2]; _vo[0] = (SELN) ? voN[H][0] : voC[H][0]; _vo[1] = (SELN) ? voN[H][1] : voC[H][1]; \
            PG8_STAGE(bufoff, (const char*)g.A + (KOFF), _vo); } else { PG8_STAGE(bufoff, ((SELN) ? nA : cA) + (H) * hstep + (KOFF), voffA); } } while (0)
#define PG8_LDA(dst, b, h) do { _Pragma("unroll") for (int m = 0; m < 4; ++m) _Pragma("unroll") for (int k = 0; k < 2; ++k) dst[m][k] = *(const LAS bf16x8*)(lds + PG8_SA(b, h) + aoff + m * 2048 + k * 1024); } while (0)
#define PG8_LDB(dst, b, h) do { _Pragma("unroll") for (int n = 0; n < 2; ++n) _Pragma("unroll") for (int k = 0; k < 2; ++k) dst[n][k] = *(const LAS bf16x8*)(lds + PG8_SB(b, h) + boff + n * 2048 + k * 1024); } while (0)
#define PG8_MMA(ai, bj, At, Bt) do { __builtin_amdgcn_s_setprio(1); _Pragma("unroll") for (int m = 0; m < 4; ++m) _Pragma("unroll") for (int n = 0; n < 2; ++n) _Pragma("unroll") for (int k = 0; k < 2; ++k) \
        { if constexpr (I8) acc[ai][bj][m][n] = __builtin_amdgcn_mfma_i32_16x16x64_i8(__builtin_bit_cast(i32x4, Bt[n][k]), __builtin_bit_cast(i32x4, At[m][k]), acc[ai][bj][m][n], 0, 0, 0); \
          else acc[ai][bj][m][n] = __builtin_amdgcn_mfma_f32_16x16x32_bf16(Bt[n][k], At[m][k], acc[ai][bj][m][n], 0, 0, 0); } __builtin_amdgcn_s_setprio(0); } while (0)
#define PG8_WAIT_V(n) asm volatile("s_waitcnt vmcnt(" #n ")" ::: "memory")
#define PG8_WAIT_L(n) asm volatile("s_waitcnt lgkmcnt(" #n ")" ::: "memory")
#define PG8_BAR __builtin_amdgcn_s_barrier()
#define PG8_SCHED __builtin_amdgcn_sched_barrier(0)
#define PG8_GATH(U, VO) do { _Pragma("unroll") for (int _h = 0; _h < 2; ++_h) _Pragma("unroll") for (int _i = 0; _i < 2; ++_i) { \
        PG8_RC(_i, _R, _C); int _r = (U).mt * 256 + _h * 128 + _R; _r = _r < (U).cnt ? _r : 0; const int _tok = g.list[(size_t)(U).e * NT + _r]; VO[_h][_i] = (unsigned)(_tok * RB + _C * 2); } } while (0)
    Unit cur, nxt; int ui = 0;
    if (!S.next(0, cur)) return;
    acc_t acc[2][2][4][2];
#pragma unroll
    for (int a = 0; a < 2; ++a)
#pragma unroll
        for (int b = 0; b < 2; ++b)
#pragma unroll
            for (int m = 0; m < 4; ++m)
#pragma unroll
                for (int n = 0; n < 2; ++n) acc[a][b][m][n] = (acc_t){0, 0, 0, 0};
    bf16x8 At[4][2], B0[2][2], B1[2][2];
    unsigned voC[2][2] = {{0u, 0u}, {0u, 0u}}, voN[2][2] = {{0u, 0u}, {0u, 0u}};
    if constexpr (GATHER) { PG8_GATH(cur, voC); }
    const char* cA = GATHER ? (const char*)g.A : (const char*)g.A + (size_t)cur.pm * tstep;
    const size_t bsb = I8 ? g.bstride : 2 * g.bstride;
    const char* cB = (const char*)g.Bt + (size_t)cur.e * bsb + (size_t)cur.pn * tstep;
    const char* nA = cA; const char* nB = cB;
    PG8_STAGE(PG8_SB(0, 0), cB, voffB); PG8_STAGE(PG8_SB(0, 1), cB + hstep, voffB); PG8_STAGE_A(PG8_SA(0, 0), false, 0, 0); PG8_STAGE_A(PG8_SA(0, 1), false, 1, 0);
    if (wr == 1) PG8_BAR;
    PG8_WAIT_V(2); PG8_BAR;
    PG8_STAGE(PG8_SB(1, 0), cB + kstep, voffB); PG8_STAGE_A(PG8_SA(1, 0), false, 0, kstep); PG8_STAGE(PG8_SB(1, 1), cB + hstep + kstep, voffB);
    PG8_WAIT_V(6); PG8_BAR;
    for (;;) {
        const bool has_next = S.next(ui + 1, nxt);
        nA = GATHER ? (const char*)g.A : (has_next ? (const char*)g.A + (size_t)nxt.pm * tstep : cA);
        nB = has_next ? (const char*)g.Bt + (size_t)nxt.e * bsb + (size_t)nxt.pn * tstep : cB;
        int tokN[2][2] = {{0, 0}, {0, 0}};
        if constexpr (GATHER) { if (has_next) {
#pragma unroll
            for (int _h = 0; _h < 2; ++_h)
#pragma unroll
                for (int _i = 0; _i < 2; ++_i) { PG8_RC(_i, _R, _C); (void)_C; int _r = nxt.mt * 256 + _h * 128 + _R; _r = _r < nxt.cnt ? _r : 0; const int* _p = g.list + (size_t)nxt.e * NT + _r;
                    asm volatile("global_load_dword %0, %1, off" : "=v"(tokN[_h][_i]) : "v"(_p) : "memory"); } } }
        unsigned epf[2] = {0u, 0u};
        if constexpr (Epi::PF > 0) {
#pragma unroll
            for (int _k = 0; _k < Epi::PF; ++_k) { const float* _p = E.pf_addr(cur, tid, _k); asm volatile("global_load_dword %0, %1, off" : "=v"(epf[_k]) : "v"(_p) : "memory"); } }
        for (int t = 0; t < nt; t += 2) {
            const bool last = (t == nt - 2);
            const size_t k1 = (size_t)(t + 1) * kstep;
            const size_t k2 = last ? 0 : (size_t)(t + 2) * kstep;
            const size_t k3 = k2 + kstep;
            const char* b2 = (last ? nB : cB) + k2; const char* b3 = b2 + kstep;
            PG8_LDB(B0, 0, 0); PG8_LDB(B1, 0, 1); PG8_SCHED; PG8_LDA(At, 0, 0); PG8_STAGE_A(PG8_SA(1, 1), false, 1, k1);
            PG8_WAIT_V(8); PG8_WAIT_L(0); PG8_BAR; PG8_MMA(0, 0, At, B0); PG8_MMA(0, 1, At, B1); PG8_BAR; PG8_SCHED;
            if constexpr (GATHER) { if (last) { if (has_next) {
                asm volatile("" : "+v"(tokN[0][0]), "+v"(tokN[0][1]), "+v"(tokN[1][0]), "+v"(tokN[1][1]));
                { PG8_RC(0, _R0, _C0); PG8_RC(1, _R1, _C1); (void)_R0; (void)_R1;
#pragma unroll
                for (int _h = 0; _h < 2; ++_h) { voN[_h][0] = (unsigned)(tokN[_h][0] * RB + _C0 * 2); voN[_h][1] = (unsigned)(tokN[_h][1] * RB + _C1 * 2); } } } else {
#pragma unroll
                for (int _h = 0; _h < 2; ++_h) { voN[_h][0] = voC[_h][0]; voN[_h][1] = voC[_h][1]; } } } }
            if constexpr (Epi::PF > 0) { if (last) { asm volatile("" : "+v"(epf[0]), "+v"(epf[1]));
#pragma unroll
                for (int _k = 0; _k < Epi::PF; ++_k) *(LAS unsigned*)(lds + MISC_OFF + M_EPF + (_k * 512 + tid) * 4) = epf[_k]; } }
            PG8_LDA(At, 0, 1); PG8_STAGE(PG8_SB(0, 0), b2, voffB); PG8_STAGE(PG8_SB(0, 1), b2 + hstep, voffB); PG8_STAGE_A(PG8_SA(0, 0), last, 0, k2);
            PG8_WAIT_V(8); PG8_WAIT_L(0); PG8_BAR; PG8_MMA(1, 0, At, B0); PG8_MMA(1, 1, At, B1); PG8_BAR; PG8_SCHED;
            PG8_LDB(B0, 1, 0); PG8_LDB(B1, 1, 1); PG8_SCHED; PG8_LDA(At, 1, 0); PG8_STAGE_A(PG8_SA(0, 1), last, 1, k2);
            PG8_WAIT_V(8); PG8_WAIT_L(0); PG8_BAR; PG8_MMA(0, 0, At, B0); PG8_MMA(0, 1, At, B1); PG8_BAR; PG8_SCHED;
            PG8_LDA(At, 1, 1); PG8_STAGE(PG8_SB(1, 0), b3, voffB); PG8_STAGE(PG8_SB(1, 1), b3 + hstep, voffB); PG8_STAGE_A(PG8_SA(1, 0), last, 0, k3);
            PG8_WAIT_V(8); PG8_WAIT_L(0); PG8_BAR; PG8_MMA(1, 0, At, B0); PG8_MMA(1, 1, At, B1); PG8_BAR; PG8_SCHED;
        }
        if (wr == 0) PG8_BAR;
        { const int ln_ = lane_id(); E(acc, cur, wr, wc, ln_ & 15, ln_ >> 4); }
        if constexpr (MK_EPI2 != 0) { if (Epi::PF == 2) { asm volatile("" ::: "memory"); const int ln_ = lane_id(); E(acc, cur, wr, wc, ln_ & 15, ln_ >> 4); } }
        if (!has_next) break;
#pragma unroll
        for (int a = 0; a < 2; ++a)
#pragma unroll
            for (int b = 0; b < 2; ++b)
#pragma unroll
                for (int m = 0; m < 4; ++m)
#pragma unroll
                    for (int n = 0; n < 2; ++n) acc[a][b][m][n] = (acc_t){0, 0, 0, 0};
        cur = nxt; cA = nA; cB = nB; ++ui;
        if constexpr (GATHER) {
#pragma unroll
            for (int _h = 0; _h < 2; ++_h) { voC[_h][0] = voN[_h][0]; voC[_h][1] = voN[_h][1]; } }
        if (wr == 1) PG8_BAR;
    }
    PG8_WAIT_V(0);
    PG8_BAR;
#undef PG8_SA
#undef PG8_SB
#undef PG8_STAGE
#undef PG8_STAGE_A
#undef PG8_LDA
#undef PG8_LDB
#undef PG8_MMA
#undef PG8_WAIT_V
#undef PG8_WAIT_L
#undef PG8_BAR
#undef PG8_SCHED
#undef PG8_GATH
#undef PG8_RC
}
}

namespace pg8 {
struct EpiBf16Plain {
    static constexpr bool PERM = true; static constexpr int PF = 0;
    bf16_t* O; int ldc; int qtiles; float qscale;
    __device__ __forceinline__ void operator()(const f32x4 (&acc)[2][2][4][2], const Unit& u, int wr, int wc, int fr, int fq) const {
        const int row0 = u.pm * BM + wr * 64 + fr, col0 = u.pn * BM + wc * 32 + 8 * fq;
        const float qs = u.pn < qtiles ? qscale : 1.0f;
#pragma unroll
        for (int ai = 0; ai < 2; ++ai)
#pragma unroll
            for (int m = 0; m < 4; ++m) { bf16_t* rowp = O + (size_t)(row0 + ai * HALF + m * 16) * ldc + col0;
#pragma unroll
                for (int bj = 0; bj < 2; ++bj) { const f32x4 v0 = acc[ai][bj][m][0] * qs, v1 = acc[ai][bj][m][1] * qs;
                    u32x4 w; w.x = cvt_pk_bf16(v0[0], v0[1]); w.y = cvt_pk_bf16(v0[2], v0[3]); w.z = cvt_pk_bf16(v1[0], v1[1]); w.w = cvt_pk_bf16(v1[2], v1[3]);
                    *(u32x4*)(rowp + bj * HALF) = w; } }
    }
};
struct EpiBf16Plain8 {
    static constexpr bool PERM = true; static constexpr int PF = 1;
    bf16_t* O; int ldc; int qtiles; float qscale; const float* sa; const float* sb; const LAS float* epf;
    __device__ __forceinline__ const float* pf_addr(const Unit& u, int tid, int) const { return tid < 256 ? sb + u.pn * BM + tid : sa + u.pm * BM + (tid - 256); }
    __device__ __forceinline__ void operator()(const i32x4 (&acc)[2][2][4][2], const Unit& u, int wr, int wc, int fr, int fq) const {
        const int row0 = u.pm * BM + wr * 64 + fr, col0 = u.pn * BM + wc * 32 + 8 * fq;
        const float qs = u.pn < qtiles ? qscale : 1.0f;
        f32x4 cs[2][2];
#pragma unroll
        for (int bj = 0; bj < 2; ++bj)
#pragma unroll
            for (int n = 0; n < 2; ++n) cs[bj][n] = *(const LAS f32x4*)(epf + wc * 32 + 8 * fq + bj * HALF + 4 * n) * qs;
#pragma unroll
        for (int ai = 0; ai < 2; ++ai)
#pragma unroll
            for (int m = 0; m < 4; ++m) { const int row = row0 + ai * HALF + m * 16; bf16_t* rowp = O + (size_t)row * ldc + col0; const float sr = epf[256 + wr * 64 + fr + ai * HALF + m * 16];
#pragma unroll
                for (int bj = 0; bj < 2; ++bj) { f32x4 v0, v1;
#pragma unroll
                    for (int j = 0; j < 4; ++j) { v0[j] = (float)acc[ai][bj][m][0][j]; v1[j] = (float)acc[ai][bj][m][1][j]; }
                    v0 = v0 * (cs[bj][0] * sr); v1 = v1 * (cs[bj][1] * sr);
                    u32x4 w; w.x = cvt_pk_bf16(v0[0], v0[1]); w.y = cvt_pk_bf16(v0[2], v0[3]); w.z = cvt_pk_bf16(v1[0], v1[1]); w.w = cvt_pk_bf16(v1[2], v1[3]);
                    *(u32x4*)(rowp + bj * HALF) = w; }
                asm volatile("" ::: "memory"); }
    }
};
struct EpiF32Plain {
    static constexpr bool PERM = false; static constexpr int PF = 0;
    float* C; int ldc;
    __device__ __forceinline__ void operator()(const f32x4 (&acc)[2][2][4][2], const Unit& u, int wr, int wc, int fr, int fq) const {
        const int row0 = u.pm * BM + wr * 64 + fr, col0 = u.pn * BM + wc * 32 + 4 * fq;
#pragma unroll
        for (int ai = 0; ai < 2; ++ai)
#pragma unroll
            for (int m = 0; m < 4; ++m) { float* rowp = C + (size_t)(row0 + ai * HALF + m * 16) * ldc + col0;
#pragma unroll
                for (int bj = 0; bj < 2; ++bj)
#pragma unroll
                    for (int n = 0; n < 2; ++n) *(f32x4*)(rowp + bj * HALF + n * 16) = acc[ai][bj][m][n]; }
    }
};
struct EpiMlaIn {
    static constexpr bool PERM = false; static constexpr int PF = 1;
    bf16_t* CQ; bf16_t* KR; const float* qn; const float* kn; const float* rope; LAS float* P;
    const float* sa; const float* sb; const LAS float* epf;
    __device__ __forceinline__ const float* pf_addr(const Unit& u, int tid, int) const { return tid < 256 ? sb + u.pn * BM + tid : sa + u.pm * BM + (tid - 256); }
    __device__ __forceinline__ void operator()(const i32x4 (&acc)[2][2][4][2], const Unit& u, int wr, int wc, int fr, int fq) const {
        const int lr0 = wr * 64 + fr; const bool isq = (u.pn == 0);
        const int c0 = wc * 32 + 4 * fq;
        f32x4 cs[2][2];
#pragma unroll
        for (int bj = 0; bj < 2; ++bj)
#pragma unroll
            for (int n = 0; n < 2; ++n) cs[bj][n] = *(const LAS f32x4*)(epf + bj * HALF + c0 + 16 * n);
#define MLAIN_V(AI, BJ, M, N, SR) (__builtin_convertvector(acc[AI][BJ][M][N], f32x4) * (cs[BJ][N] * (SR)))
#pragma unroll
        for (int ai = 0; ai < 2; ++ai)
#pragma unroll
            for (int m = 0; m < 4; ++m) { float ss = 0.f; const float sr = epf[256 + lr0 + ai * HALF + m * 16];
#pragma unroll
                for (int n = 0; n < 2; ++n) { const f32x4 v = MLAIN_V(ai, 0, m, n, sr); ss += (v[0] * v[0] + v[1] * v[1]) + (v[2] * v[2] + v[3] * v[3]); }
                if (isq) {
#pragma unroll
                    for (int n = 0; n < 2; ++n) { const f32x4 v = MLAIN_V(ai, 1, m, n, sr); ss += (v[0] * v[0] + v[1] * v[1]) + (v[2] * v[2] + v[3] * v[3]); } }
                ss = swap16_sum(ss); ss = swap32_sum(ss);
                if (fq == 0) P[(lr0 + ai * HALF + m * 16) * 4 + wc] = ss; }
        asm volatile("s_waitcnt lgkmcnt(0)" ::: "memory"); __builtin_amdgcn_s_barrier(); asm volatile("" ::: "memory");
        const float* g = isq ? qn : kn; const float invn = isq ? (1.0f / 256.0f) : (1.0f / 128.0f); const int cb = isq ? 0 : 256;
        f32x4 gv[2][2];
#pragma unroll
        for (int n = 0; n < 2; ++n) { gv[0][n] = *(const f32x4*)(g + c0 + 16 * n); gv[1][n] = isq ? *(const f32x4*)(g + HALF + c0 + 16 * n) : (f32x4){0.f, 0.f, 0.f, 0.f}; }
#pragma unroll
        for (int ai = 0; ai < 2; ++ai)
#pragma unroll
            for (int m = 0; m < 4; ++m) { const int lr = lr0 + ai * HALF + m * 16; const size_t row = (size_t)u.pm * BM + lr; const float sr = epf[256 + lr];
                const f32x4 p4 = *(const LAS f32x4*)(P + lr * 4);
                const float rstd = 1.0f / sqrtf(((p4[0] + p4[1]) + (p4[2] + p4[3])) * invn + NORM_EPS);
#pragma unroll
                for (int bj = 0; bj < 2; ++bj) { if (bj == 1 && !isq) continue;
#pragma unroll
                    for (int n = 0; n < 2; ++n) { const f32x4 v = MLAIN_V(ai, bj, m, n, sr) * rstd * gv[bj][n];
                        u32x2 w; w.x = cvt_pk_bf16(v[0], v[1]); w.y = cvt_pk_bf16(v[2], v[3]);
                        *(u32x2*)(CQ + row * C_UPK + cb + bj * HALF + c0 + 16 * n) = w; } }
                if (!isq && wc == 0) {
#pragma unroll
                    for (int n = 0; n < 2; ++n) { f32x4 v = MLAIN_V(ai, 1, m, n, sr);
                        if (row < (size_t)NL) { const f32x4 rc = *(const f32x4*)(rope + (((size_t)(row & (SEQ - 1))) * 16 + 8 * n + 2 * fq) * 2);
                            const float a0 = v[0], b0 = v[1], a1 = v[2], b1 = v[3];
                            v[0] = a0 * rc[0] - b0 * rc[1]; v[1] = a0 * rc[1] + b0 * rc[0]; v[2] = a1 * rc[2] - b1 * rc[3]; v[3] = a1 * rc[3] + b1 * rc[2]; }
                        u32x2 w; w.x = cvt_pk_bf16(v[0], v[1]); w.y = cvt_pk_bf16(v[2], v[3]);
                        *(u32x2*)(KR + row * 32 + 16 * n + 4 * fq) = w; } } }
#undef MLAIN_V
    }
};
__device__ __forceinline__ void rope8(f32x4& v0, f32x4& v1, const float* cs) {
    const f32x4 a = *(const f32x4*)cs, b = *(const f32x4*)(cs + 4);
    const float x0 = v0[0], x1 = v0[1], x2 = v0[2], x3 = v0[3], y0 = v1[0], y1 = v1[1], y2 = v1[2], y3 = v1[3];
    v0[0] = x0 * a[0] - x1 * a[1]; v0[1] = x0 * a[1] + x1 * a[0];
    v0[2] = x2 * a[2] - x3 * a[3]; v0[3] = x2 * a[3] + x3 * a[2];
    v1[0] = y0 * b[0] - y1 * b[1]; v1[1] = y0 * b[1] + y1 * b[0];
    v1[2] = y2 * b[2] - y3 * b[3]; v1[3] = y2 * b[3] + y3 * b[2];
}
struct EpiQkvA {
    static constexpr bool PERM = true; static constexpr int PF = 0;
    bf16_t* O; const float* rope;
    __device__ __forceinline__ void operator()(const f32x4 (&acc)[2][2][4][2], const Unit& u, int wr, int wc, int fr, int fq) const {
        const int row0 = u.pm * BM + wr * 64 + fr, col0 = u.pn * BM + wc * 32 + 8 * fq;
        const bool do_rope = (u.pm < NL / 256) && (u.pn < 5);
        const float qs = u.pn < 4 ? 0.125f * LOG2E : 1.0f;
#pragma unroll
        for (int ai = 0; ai < 2; ++ai)
#pragma unroll
            for (int m = 0; m < 4; ++m) { const int row = row0 + ai * HALF + m * 16; bf16_t* rowp = O + (size_t)row * A_IN + col0;
#pragma unroll
                for (int bj = 0; bj < 2; ++bj) { f32x4 v0 = acc[ai][bj][m][0], v1 = acc[ai][bj][m][1];
                    if (do_rope) { const int d = (col0 + bj * HALF) & 63; rope8(v0, v1, rope + ((size_t)(row & (SEQ - 1)) * 32 + (d >> 1)) * 2); }
                    v0 = v0 * qs; v1 = v1 * qs;
                    u32x4 w; w.x = cvt_pk_bf16(v0[0], v0[1]); w.y = cvt_pk_bf16(v0[2], v0[3]); w.z = cvt_pk_bf16(v1[0], v1[1]); w.w = cvt_pk_bf16(v1[2], v1[3]);
                    *(u32x4*)(rowp + bj * HALF) = w; }
                asm volatile("" ::: "memory"); }
    }
};
struct EpiQkvA8 {
    static constexpr bool PERM = true; static constexpr int PF = 1;
    bf16_t* O; const float* rope; const float* sa; const float* sb; const LAS float* epf;
    __device__ __forceinline__ const float* pf_addr(const Unit& u, int tid, int) const { return tid < 256 ? sb + u.pn * BM + tid : sa + u.pm * BM + (tid - 256); }
    __device__ __forceinline__ void operator()(const i32x4 (&acc)[2][2][4][2], const Unit& u, int wr, int wc, int fr, int fq) const {
        const int row0 = u.pm * BM + wr * 64 + fr, col0 = u.pn * BM + wc * 32 + 8 * fq;
        const bool do_rope = (u.pm < NL / 256) && (u.pn < 5);
        const float qs = u.pn < 4 ? 0.125f * LOG2E : 1.0f;
        f32x4 cs[2][2];
#pragma unroll
        for (int bj = 0; bj < 2; ++bj)
#pragma unroll
            for (int n = 0; n < 2; ++n) cs[bj][n] = *(const LAS f32x4*)(epf + wc * 32 + 8 * fq + bj * HALF + 4 * n) * qs;
#pragma unroll
        for (int ai = 0; ai < 2; ++ai)
#pragma unroll
            for (int m = 0; m < 4; ++m) { const int row = row0 + ai * HALF + m * 16; bf16_t* rowp = O + (size_t)row * A_IN + col0; const float sr = epf[256 + wr * 64 + fr + ai * HALF + m * 16];
#pragma unroll
                for (int bj = 0; bj < 2; ++bj) { f32x4 v0, v1;
#pragma unroll
                    for (int j = 0; j < 4; ++j) { v0[j] = (float)acc[ai][bj][m][0][j]; v1[j] = (float)acc[ai][bj][m][1][j]; }
                    v0 = v0 * (cs[bj][0] * sr); v1 = v1 * (cs[bj][1] * sr);
                    if (do_rope) { const int d = (col0 + bj * HALF) & 63; rope8(v0, v1, rope + ((size_t)(row & (SEQ - 1)) * 32 + (d >> 1)) * 2); }
                    u32x4 w; w.x = cvt_pk_bf16(v0[0], v0[1]); w.y = cvt_pk_bf16(v0[2], v0[3]); w.z = cvt_pk_bf16(v1[0], v1[1]); w.w = cvt_pk_bf16(v1[2], v1[3]);
                    *(u32x4*)(rowp + bj * HALF) = w; }
                asm volatile("" ::: "memory"); }
    }
};
struct EpiMlaUp {
    static constexpr bool PERM = true; static constexpr int PF = 0;
    bf16_t* O; const float* rope;
    __device__ __forceinline__ void operator()(const f32x4 (&acc)[2][2][4][2], const Unit& u, int wr, int wc, int fr, int fq) const {
        const int row0 = u.pm * BM + wr * 64 + fr, col0 = u.pn * BM + wc * 32 + 8 * fq;
        const bool qtile = (u.pm < NL / 256) && (u.pn < 6);
        const float qs = u.pn < 6 ? 0.10206207261596575f * LOG2E : 1.0f;
#pragma unroll
        for (int ai = 0; ai < 2; ++ai)
#pragma unroll
            for (int m = 0; m < 4; ++m) { const int row = row0 + ai * HALF + m * 16; bf16_t* rowp = O + (size_t)row * C_UPN + col0;
#pragma unroll
                for (int bj = 0; bj < 2; ++bj) { f32x4 v0 = acc[ai][bj][m][0], v1 = acc[ai][bj][m][1];
                    const int d96 = (col0 + bj * HALF) % 96;
                    if (qtile && d96 >= 64) rope8(v0, v1, rope + ((size_t)(row & (SEQ - 1)) * 16 + ((d96 - 64) >> 1)) * 2);
                    v0 = v0 * qs; v1 = v1 * qs;
                    u32x4 w; w.x = cvt_pk_bf16(v0[0], v0[1]); w.y = cvt_pk_bf16(v0[2], v0[3]); w.z = cvt_pk_bf16(v1[0], v1[1]); w.w = cvt_pk_bf16(v1[2], v1[3]);
                    *(u32x4*)(rowp + bj * HALF) = w; }
                asm volatile("" ::: "memory"); }
    }
};
struct EpiResid {
    static constexpr bool PERM = false; static constexpr int PF = 1;
    const LAS float* epf;
    __device__ __forceinline__ const float* pf_addr(const Unit& u, int tid, int) const { return gmod + (size_t)(u.pm < NL / 256 ? (u.pm >> 3) : 8) * 6144 + u.pn * BM + (tid & 255); }
    bf16_t* XS; const float* gmod; bf16_t* XSo;
    __device__ __forceinline__ void operator()(const f32x4 (&acc)[2][2][4][2], const Unit& u, int wr, int wc, int fr, int fq) const {
        const int row0 = u.pm * BM + wr * 64 + fr, col0 = u.pn * BM + wc * 32 + 4 * fq;
        f32x4 gg[2][2];
#pragma unroll
        for (int bj = 0; bj < 2; ++bj)
#pragma unroll
            for (int n = 0; n < 2; ++n) gg[bj][n] = *(const LAS f32x4*)(epf + wc * 32 + 4 * fq + bj * HALF + n * 16);
#pragma unroll
        for (int ai = 0; ai < 2; ++ai)
#pragma unroll
            for (int m = 0; m < 4; ++m) { const size_t off = (size_t)(row0 + ai * HALF + m * 16) * D + col0;
#pragma unroll
                for (int bj = 0; bj < 2; ++bj)
#pragma unroll
                    for (int n = 0; n < 2; ++n) { const u32x2 w = *(const u32x2*)(XS + off + bj * HALF + n * 16);
                        const f32x4 v = (f32x4){bf_lo(w.x), bf_hi(w.x), bf_lo(w.y), bf_hi(w.y)} + gg[bj][n] * acc[ai][bj][m][n];
                        u32x2 o; o.x = cvt_pk_bf16(v[0], v[1]); o.y = cvt_pk_bf16(v[2], v[3]); *(u32x2*)(XSo + off + bj * HALF + n * 16) = o; } }
    }
};
struct EpiSwiglu {
    static constexpr bool PERM = true; static constexpr int PF = 0;
    bf16_t* ACT; const float* bg; const float* bu;
    __device__ __forceinline__ void operator()(const f32x4 (&acc)[2][2][4][2], const Unit& u, int wr, int wc, int fr, int fq) const {
        const int row0 = u.pm * BM + wr * 64 + fr, col0 = u.pn * HALF + wc * 32 + 8 * fq;
        const float* pg = bg + (size_t)u.e * D + col0; const float* pu = bu + (size_t)u.e * D + col0;
        const f32x4 g0 = *(const f32x4*)pg, g1 = *(const f32x4*)(pg + 4), u0 = *(const f32x4*)pu, u1 = *(const f32x4*)(pu + 4);
#pragma unroll
        for (int ai = 0; ai < 2; ++ai)
#pragma unroll
            for (int m = 0; m < 4; ++m) { bf16_t* rowp = ACT + (size_t)(row0 + ai * HALF + m * 16) * D + col0;
                float r[8];
#pragma unroll
                for (int n = 0; n < 2; ++n)
#pragma unroll
                    for (int j = 0; j < 4; ++j) {
                        float g = acc[ai][0][m][n][j] + (n ? g1[j] : g0[j]); float uu = acc[ai][1][m][n][j] + (n ? u1[j] : u0[j]);
                        g = fminf(g, 7.0f); uu = fminf(fmaxf(uu, -7.0f), 7.0f);
                        const float sg = __builtin_amdgcn_rcpf(1.0f + __builtin_amdgcn_exp2f(-1.702f * LOG2E * g));
                        r[n * 4 + j] = g * sg * (uu + 1.0f); }
                u32x4 w; w.x = cvt_pk_bf16(r[0], r[1]); w.y = cvt_pk_bf16(r[2], r[3]); w.z = cvt_pk_bf16(r[4], r[5]); w.w = cvt_pk_bf16(r[6], r[7]);
                *(u32x4*)rowp = w; }
    }
};
struct EpiSwiglu8 {
    static constexpr bool PERM = true; static constexpr int PF = 2;
    unsigned char* ACTQ; float* SBLK; const float* bg; const float* bu; const float* sal; const float* sbw; const LAS float* epf;
    __device__ __forceinline__ const float* pf_addr(const Unit& u, int tid, int k) const {
        if (k == 1) { const int t = tid & 255; return sal + (size_t)u.e * NT + ((u.mt * 256 + t) < u.cnt ? u.mt * 256 + t : u.mt * 256); }
        const int t = tid & 127;
        return tid < 128 ? bg + (size_t)u.e * D + u.pn * HALF + t : (tid < 256 ? bu + (size_t)u.e * D + u.pn * HALF + t : sbw + (size_t)u.e * 2048 + u.pn * BM + (tid < 384 ? 0 : HALF) + t); }
    __device__ __forceinline__ void operator()(const i32x4 (&acc)[2][2][4][2], const Unit& u, int wr, int wc, int fr, int fq) const {
        const int lr0 = wr * 64 + fr, row0 = u.pm * BM + lr0, col0 = u.pn * HALF + wc * 32 + 8 * fq;
        constexpr float K1 = 1.702f * LOG2E;
        f32x2 r[2][4][4];
#pragma unroll
        for (int n = 0; n < 2; ++n) {
            const LAS float* pe = epf + wc * 32 + 8 * fq + 4 * n;
            const f32x4 gb = *(const LAS f32x4*)pe * (-K1), ub = *(const LAS f32x4*)(pe + 128) + 1.0f, sg = *(const LAS f32x4*)(pe + 256) * (-K1), su = *(const LAS f32x4*)(pe + 384);
#pragma unroll
            for (int ai = 0; ai < 2; ++ai)
#pragma unroll
                for (int m = 0; m < 4; ++m) { const int lr = lr0 + ai * HALF + m * 16; const float sa_ = epf[512 + lr]; const f32x2 sa2 = {sa_, sa_};
#pragma unroll
                    for (int jp = 0; jp < 2; ++jp) {
                        const f32x2 ag = {(float)acc[ai][0][m][n][2 * jp], (float)acc[ai][0][m][n][2 * jp + 1]}, au = {(float)acc[ai][1][m][n][2 * jp], (float)acc[ai][1][m][n][2 * jp + 1]};
                        f32x2 h = (ag * (f32x2){sg[2 * jp], sg[2 * jp + 1]}) * sa2 + (f32x2){gb[2 * jp], gb[2 * jp + 1]};
                        f32x2 u1 = (au * (f32x2){su[2 * jp], su[2 * jp + 1]}) * sa2 + (f32x2){ub[2 * jp], ub[2 * jp + 1]};
                        h[0] = fmaxf(h[0], -7.0f * K1); h[1] = fmaxf(h[1], -7.0f * K1);
                        u1[0] = __builtin_amdgcn_fmed3f(u1[0], -6.0f, 8.0f); u1[1] = __builtin_amdgcn_fmed3f(u1[1], -6.0f, 8.0f);
                        const f32x2 e = {__builtin_amdgcn_exp2f(h[0]), __builtin_amdgcn_exp2f(h[1])};
                        const f32x2 d = e * (f32x2){-K1, -K1} + (f32x2){-K1, -K1};
                        const f32x2 rc = {__builtin_amdgcn_rcpf(d[0]), __builtin_amdgcn_rcpf(d[1])};
                        r[ai][m][2 * n + jp] = (h * u1) * rc; } }
        }
        float ams[8];
#pragma unroll
        for (int ai = 0; ai < 2; ++ai)
#pragma unroll
            for (int m = 0; m < 4; ++m) {
                float am = fmaxf(fmaxf(fmaxf(fabsf(r[ai][m][0][0]), fabsf(r[ai][m][0][1])), fmaxf(fabsf(r[ai][m][1][0]), fabsf(r[ai][m][1][1]))), fmaxf(fmaxf(fabsf(r[ai][m][2][0]), fabsf(r[ai][m][2][1])), fmaxf(fabsf(r[ai][m][3][0]), fabsf(r[ai][m][3][1]))));
                am = swap16_max(am); am = swap32_max(am); am = fmaxf(am, 1e-20f);
                const float inv = 127.0f * __builtin_amdgcn_rcpf(am); const f32x2 inv2 = {inv, inv}, mg = {12582912.0f + 128.0f, 12582912.0f + 128.0f};
                unsigned q[4];
#pragma unroll
                for (int k = 0; k < 4; ++k) { const f32x2 t = r[ai][m][k] * inv2 + mg; q[k] = __builtin_amdgcn_perm(__float_as_uint(t[1]), __float_as_uint(t[0]), 0x0c0c0400u); }
                u32x2 w; w.x = q[0] | (q[1] << 16); w.y = q[2] | (q[3] << 16);
                const size_t row = (size_t)(row0 + ai * HALF + m * 16);
                *(u32x2*)(ACTQ + row * D + col0) = w;
                ams[ai * 4 + m] = am * (1.0f / 127.0f); }
        if (fq == 0) {
#pragma unroll
            for (int i = 0; i < 8; ++i) SBLK[(size_t)(row0 + (i >> 2) * HALF + (i & 3) * 16) * 32 + u.pn * 4 + wc] = ams[i]; }
    }
};
struct EpiDown {
    static constexpr bool PERM = true; static constexpr int PF = 0;
    bf16_t* YS; const float* bd;
    __device__ __forceinline__ void operator()(const f32x4 (&acc)[2][2][4][2], const Unit& u, int wr, int wc, int fr, int fq) const {
        const int row0 = u.pm * BM + wr * 64 + fr, col0 = u.pn * BM + wc * 32 + 8 * fq;
        const float* pb = bd + (size_t)u.e * D + col0;
        f32x4 bv[2][2];
#pragma unroll
        for (int bj = 0; bj < 2; ++bj)
#pragma unroll
            for (int n = 0; n < 2; ++n) bv[bj][n] = *(const f32x4*)(pb + bj * HALF + 4 * n);
#pragma unroll
        for (int ai = 0; ai < 2; ++ai)
#pragma unroll
            for (int m = 0; m < 4; ++m) { bf16_t* rowp = YS + (size_t)(row0 + ai * HALF + m * 16) * D + col0;
#pragma unroll
                for (int bj = 0; bj < 2; ++bj) { const f32x4 v0 = acc[ai][bj][m][0] + bv[bj][0], v1 = acc[ai][bj][m][1] + bv[bj][1];
                    u32x4 w; w.x = cvt_pk_bf16(v0[0], v0[1]); w.y = cvt_pk_bf16(v0[2], v0[3]); w.z = cvt_pk_bf16(v1[0], v1[1]); w.w = cvt_pk_bf16(v1[2], v1[3]);
                    *(u32x4*)(rowp + bj * HALF) = w; } }
    }
};

struct EpiDown8 {
    static constexpr bool PERM = true; static constexpr int PF = 2;
    unsigned char* YSQ; float* YSB; const float* bd; const float* saq; const float* sbd; const LAS float* epf;
    __device__ __forceinline__ const float* pf_addr(const Unit& u, int tid, int k) const {
        if (k == 1) return saq + (size_t)u.pm * BM + (tid & 255);
        return (tid < 256 ? bd : sbd) + (size_t)u.e * D + u.pn * BM + (tid & 255); }
    __device__ __forceinline__ void operator()(const i32x4 (&acc)[2][2][4][2], const Unit& u, int wr, int wc, int fr, int fq) const {
        const int row0 = u.pm * BM + wr * 64 + fr, col0 = u.pn * BM + wc * 32 + 8 * fq;
#pragma unroll
        for (int bj = 0; bj < 2; ++bj) {
            const LAS float* pe = epf + wc * 32 + 8 * fq + bj * HALF;
            const f32x4 b0 = *(const LAS f32x4*)pe, b1 = *(const LAS f32x4*)(pe + 4), s0 = *(const LAS f32x4*)(pe + 256), s1 = *(const LAS f32x4*)(pe + 260);
            float ams[8];
#pragma unroll
            for (int ai = 0; ai < 2; ++ai)
#pragma unroll
                for (int m = 0; m < 4; ++m) { const int row = row0 + ai * HALF + m * 16; const float sr = epf[512 + wr * 64 + fr + ai * HALF + m * 16]; f32x4 v0, v1;
#pragma unroll
                    for (int j = 0; j < 4; ++j) { v0[j] = (float)acc[ai][bj][m][0][j]; v1[j] = (float)acc[ai][bj][m][1][j]; }
                    v0 = v0 * (s0 * sr) + b0; v1 = v1 * (s1 * sr) + b1;
                    float am = fmaxf(fmaxf(fmaxf(fabsf(v0[0]), fabsf(v0[1])), fmaxf(fabsf(v0[2]), fabsf(v0[3]))), fmaxf(fmaxf(fabsf(v1[0]), fabsf(v1[1])), fmaxf(fabsf(v1[2]), fabsf(v1[3]))));
                    am = swap16_max(am); am = swap32_max(am); am = fmaxf(am, 1e-30f);
                    const float inv = 127.0f * __builtin_amdgcn_rcpf(am); const f32x2 inv2 = {inv, inv}, mg = {12582912.0f + 128.0f, 12582912.0f + 128.0f};
                    const f32x2 t0 = (f32x2){v0[0], v0[1]} * inv2 + mg, t1 = (f32x2){v0[2], v0[3]} * inv2 + mg, t2 = (f32x2){v1[0], v1[1]} * inv2 + mg, t3 = (f32x2){v1[2], v1[3]} * inv2 + mg;
                    u32x2 w;
                    w.x = __builtin_amdgcn_perm(__float_as_uint(t0[1]), __float_as_uint(t0[0]), 0x0c0c0400u) | (__builtin_amdgcn_perm(__float_as_uint(t1[1]), __float_as_uint(t1[0]), 0x0c0c0400u) << 16);
                    w.y = __builtin_amdgcn_perm(__float_as_uint(t2[1]), __float_as_uint(t2[0]), 0x0c0c0400u) | (__builtin_amdgcn_perm(__float_as_uint(t3[1]), __float_as_uint(t3[0]), 0x0c0c0400u) << 16);
                    *(u32x2*)(YSQ + (size_t)row * D + col0 + bj * HALF) = w;
                    ams[ai * 4 + m] = am * (1.0f / 127.0f); }
            if (fq == 0) {
#pragma unroll
                for (int i = 0; i < 8; ++i) YSB[(size_t)(row0 + (i >> 2) * HALF + (i & 3) * 16) * 32 + u.pn * 8 + bj * 4 + wc] = ams[i]; }
            asm volatile("" ::: "memory");
        }
    }
};
struct DenseOrder {
    int nM, nN, vcu, xM, xN0, xNn;
    __device__ __forceinline__ bool short_one() const { const int U = nM * nN + xM * xNn, R = (U + 255) >> 8; return (U & 255) != 0 && vcu >= U - (R - 1) * 256; }
    __device__ __forceinline__ bool next(int i, Unit& u) const {
        int L = i * 256 + vcu; const int nmain = nM * nN;
        if (L < nmain) { const int nig = 8 * nN, gid = L / nig, fm = gid * 8, rem = nM - fm, gsz = rem < 8 ? rem : 8, w = L % nig; u.pm = fm + w % gsz; u.pn = w / gsz; }
        else { L -= nmain; if (L >= xM * xNn) return false; u.pm = nM + L % xM; u.pn = xN0 + L / xM; }
        u.e = 0; u.mt = 0; u.cnt = 0; return true;
    }
};
struct MoeOrder {
    const LAS int* ecnt; const LAS int* lbase; const LAS int* cumt; int nN, idx, G; LAS int* ul;
    __device__ __forceinline__ bool short_one() const { const int U = cumt[32] * nN, R = (U + G - 1) / G; return (U % G) != 0 && idx >= U - (R - 1) * G; }
    __device__ __forceinline__ void build(int tid) const {
        if (tid < 16) { const int L = tid * G + idx; int e = -1, pn = 0, mt = 0, pm = 0, c = 0;
            if (idx >= 0 && L < cumt[32] * nN) { e = 0; while (cumt[e + 1] * nN <= L) ++e; const int r = L - cumt[e] * nN; c = ecnt[e]; const int mte = (c + 255) >> 8;
                if (MK_MT_MAJOR & (nN == 4 ? 1 : 2)) { pn = r % nN; mt = r / nN; } else { pn = r / mte; mt = r % mte; } pm = (lbase[e] >> 8) + mt; }
            ul[tid * 8 + 0] = e; ul[tid * 8 + 1] = pn; ul[tid * 8 + 2] = mt; ul[tid * 8 + 3] = pm; ul[tid * 8 + 4] = c; }
        __syncthreads();
    }
    __device__ __forceinline__ bool next(int i, Unit& u) const {
        if (i >= 16) return false;
        const int e = __builtin_amdgcn_readfirstlane(ul[i * 8 + 0]);
        if (e < 0) return false;
        u.e = e; u.pn = __builtin_amdgcn_readfirstlane(ul[i * 8 + 1]); u.mt = __builtin_amdgcn_readfirstlane(ul[i * 8 + 2]); u.pm = __builtin_amdgcn_readfirstlane(ul[i * 8 + 3]); u.cnt = __builtin_amdgcn_readfirstlane(ul[i * 8 + 4]); return true;
    }
};
}

namespace att {
constexpr int VSTR = 144;
template <int DQK> struct Cfg { static constexpr int KSTR = DQK * 2 + 16, KB = 64 * KSTR, VB = 64 * VSTR, STAGE = KB + VB, CPR = DQK / 8, NKS = DQK / 16; };
__device__ __forceinline__ int crow(int r, int hi) { return (r & 3) + 8 * (r >> 2) + 4 * hi; }

template <int DQK, bool MLA>
__device__ __forceinline__ void fetchK(u32x4 (&r)[2], const bf16_t* Kb, const bf16_t* KRb, int pitch, int row0, int tid) {
    typedef Cfg<DQK> C;
    { const int key = tid / C::CPR, ch = tid % C::CPR;
      const bf16_t* src = (MLA && ch >= 8) ? KRb + (size_t)(row0 + key) * 32 + (ch - 8) * 8 : Kb + (size_t)(row0 + key) * pitch + ch * 8;
      r[0] = *(const u32x4*)src; }
    if constexpr (DQK == 96) { if (tid < 256) { const int c = 512 + tid, key = c / C::CPR, ch = c % C::CPR;
      const bf16_t* src = (MLA && ch >= 8) ? KRb + (size_t)(row0 + key) * 32 + (ch - 8) * 8 : Kb + (size_t)(row0 + key) * pitch + ch * 8;
      r[1] = *(const u32x4*)src; } }
}
__device__ __forceinline__ void fetchV(u32x4& r, const bf16_t* Vb, int pitch, int row0, int tid) { const int key = tid >> 3, ch = tid & 7; r = *(const u32x4*)(Vb + (size_t)(row0 + key) * pitch + ch * 8); }
template <int DQK>
__device__ __forceinline__ void stashK(LAS unsigned char* kst, const u32x4 (&r)[2], int tid) {
    typedef Cfg<DQK> C;
    { const int key = tid / C::CPR, ch = tid % C::CPR; *(LAS u32x4*)(kst + key * C::KSTR + ch * 16) = r[0]; }
    if constexpr (DQK == 96) { if (tid < 256) { const int c = 512 + tid, key = c / C::CPR, ch = c % C::CPR; *(LAS u32x4*)(kst + key * C::KSTR + ch * 16) = r[1]; } }
}
__device__ __forceinline__ void stashV(LAS unsigned char* vst, const u32x4& r, int tid) { const int key = tid >> 3, ch = tid & 7; *(LAS u32x4*)(vst + key * VSTR + ch * 16) = r; }
template <int DQK, bool MLA>
__device__ __forceinline__ void fetch(u32x4 (&r)[3], const bf16_t* Kb, const bf16_t* Vb, const bf16_t* KRb, int pitch, int row0, int tid) {
    u32x4 k2[2]; k2[1] = (u32x4){0u, 0u, 0u, 0u}; fetchK<DQK, MLA>(k2, Kb, KRb, pitch, row0, tid); r[0] = k2[0]; r[1] = k2[1]; fetchV(r[2], Vb, pitch, row0, tid);
}
template <int DQK>
__device__ __forceinline__ void stash(LAS unsigned char* st, const u32x4 (&r)[3], int tid) {
    const u32x4 k2[2] = {r[0], r[1]}; stashK<DQK>(st, k2, tid); stashV(st + Cfg<DQK>::KB, r[2], tid);
}
template <int DQK>
__device__ __forceinline__ f32x16 qk(const LAS unsigned char* kst, int koff, const bf16x8 (&qr)[DQK / 16], int r32, int hi) {
    typedef Cfg<DQK> C;
    f32x16 p;
#pragma unroll
    for (int r = 0; r < 16; ++r) p[r] = 0.f;
    const LAS unsigned char* kb = kst + (koff + r32) * C::KSTR + hi * 16;
#pragma unroll
    for (int ks = 0; ks < C::NKS; ++ks) { const bf16x8 kf = *(const LAS bf16x8*)(kb + ks * 32); p = __builtin_amdgcn_mfma_f32_32x32x16_bf16(kf, qr[ks], p, 0, 0, 0); }
    return p;
}
__device__ __forceinline__ s16x4 vtr(const LAS unsigned char* p) { return __builtin_bit_cast(s16x4, __builtin_amdgcn_ds_read_tr16_b64_v4i16((LAS s16x4*)p)); }
typedef __bf16 bf16x2_t __attribute__((ext_vector_type(2)));
__device__ __forceinline__ unsigned cvtpk_s(float lo, float hi) { const f32x2 v = {lo, hi}; const bf16x2_t b = __builtin_convertvector(v, bf16x2_t); return __builtin_bit_cast(unsigned, b); }
template <int NS>
__device__ __forceinline__ void sm_max(const f32x16 (&t)[NS], const float sc, f32x16 (&o)[2], float& m, float& l) {
    float mx = t[0][0];
#pragma unroll
    for (int s = 0; s < NS; ++s)
#pragma unroll
        for (int r = 0; r < 16; ++r) mx = fmaxf(mx, t[s][r]);
    mx = swap32_max(mx) * sc;
    if (__any(mx > m + 8.0f)) { const float mn = fmaxf(m, mx); const float a = __builtin_amdgcn_exp2f(m - mn); m = mn; l *= a;
#pragma unroll
        for (int r = 0; r < 16; ++r) { o[0][r] *= a; o[1][r] *= a; } }
}
template <int NS>
__device__ __forceinline__ void sm_exp_pv(f32x16 (&t)[NS], const float sc, const LAS unsigned char* vst, const int (&voff)[NS], f32x16 (&o)[2], const float m, float& l, int lane) {
    const int hi = lane >> 5;
    float rs = 0.f;
#pragma unroll
    for (int s = 0; s < NS; ++s)
#pragma unroll
        for (int r = 0; r < 16; ++r) { t[s][r] = __builtin_amdgcn_exp2f(__builtin_fmaf(t[s][r], sc, -m)); rs += t[s][r]; }
    l += rs;
    const int q4 = (lane & 15) >> 2, p4 = lane & 3, blk = (lane >> 4) & 1;
#pragma unroll
    for (int s = 0; s < NS; ++s) {
        const LAS unsigned char* vb = vst + (voff[s] + 4 * hi + q4) * VSTR + (16 * blk + 4 * p4) * 2;
#pragma unroll
        for (int kk = 0; kk < 2; ++kk) {
            u32x4 pw; pw.x = cvtpk_s(t[s][8 * kk + 0], t[s][8 * kk + 1]); pw.y = cvtpk_s(t[s][8 * kk + 2], t[s][8 * kk + 3]);
            pw.z = cvtpk_s(t[s][8 * kk + 4], t[s][8 * kk + 5]); pw.w = cvtpk_s(t[s][8 * kk + 6], t[s][8 * kk + 7]);
            const bf16x8 pb = __builtin_bit_cast(bf16x8, pw);
#pragma unroll
            for (int c = 0; c < 2; ++c) {
                const s16x4 lo = vtr(vb + (16 * kk) * VSTR + c * 64), h8 = vtr(vb + (16 * kk + 8) * VSTR + c * 64);
                const bf16x8 va = (bf16x8){lo[0], lo[1], lo[2], lo[3], h8[0], h8[1], h8[2], h8[3]};
                o[c] = __builtin_amdgcn_mfma_f32_32x32x16_bf16(va, pb, o[c], 0, 0, 0);
            }
        }
    }
}
template <int NS>
__device__ __forceinline__ void sm_pv(f32x16 (&t)[NS], const float sc, const LAS unsigned char* vst, const int (&voff)[NS], f32x16 (&o)[2], float& m, float& l, int lane) {
    sm_max<NS>(t, sc, o, m, l); sm_exp_pv<NS>(t, sc, vst, voff, o, m, l, lane);
}
template <int DQK>
__device__ __forceinline__ f32x16 qkn(const LAS unsigned char* kst, int koff, const bf16x8 (&qr)[DQK / 16], const float negm, int r32, int hi) {
    typedef Cfg<DQK> C;
    f32x16 p;
#pragma unroll
    for (int r = 0; r < 16; ++r) p[r] = negm;
    const LAS unsigned char* kb0 = kst + (koff + r32) * C::KSTR + hi * 16;
    bf16x8 kf[C::NKS];
#pragma unroll
    for (int ks = 0; ks < C::NKS; ++ks) kf[ks] = *(const LAS bf16x8*)(kb0 + ks * 32);
    __builtin_amdgcn_sched_barrier(0);
#pragma unroll
    for (int ks = 0; ks < C::NKS; ++ks) p = __builtin_amdgcn_mfma_f32_32x32x16_bf16(kf[ks], qr[ks], p, 0, 0, 0);
    return p;
}
template <int DQK>
__device__ __forceinline__ f32x16 qkn_old(const LAS unsigned char* kst, int koff, const bf16x8 (&qr)[DQK / 16], const f32x16& negm, int r32, int hi) {
    typedef Cfg<DQK> C;
    f32x16 p = negm;
    const LAS unsigned char* kb = kst + (koff + r32) * C::KSTR + hi * 16;
#pragma unroll
    for (int ks = 0; ks < C::NKS; ++ks) { const bf16x8 kf = *(const LAS bf16x8*)(kb + ks * 32); p = __builtin_amdgcn_mfma_f32_32x32x16_bf16(kf, qr[ks], p, 0, 0, 0); }
    return p;
}
__device__ __forceinline__ void sm_max_n(f32x16 (&t)[2], f32x16 (&o)[2], f32x16& osum, float& m, float& negm, bool first) {
    float a0 = fmaxf(fmaxf(t[0][0], t[0][1]), t[0][2]), a1 = fmaxf(fmaxf(t[1][0], t[1][1]), t[1][2]);
#pragma unroll
    for (int r = 3; r < 15; r += 2) { a0 = fmaxf(fmaxf(a0, t[0][r]), t[0][r + 1]); a1 = fmaxf(fmaxf(a1, t[1][r]), t[1][r + 1]); }
    float mx = fmaxf(fmaxf(a0, a1), fmaxf(t[0][15], t[1][15]));
    mx = swap32_max(mx);
    if (first || __any(mx > 8.0f)) { const float d = first ? mx : fmaxf(mx, 0.f); const float a = first ? 1.0f : __builtin_amdgcn_exp2f(-d); m += d;
#pragma unroll
        for (int r = 0; r < 16; ++r) { t[0][r] -= d; t[1][r] -= d; o[0][r] *= a; o[1][r] *= a; osum[r] *= a; } negm = -m; }
}
__device__ __forceinline__ void sm_exp_pv_n(f32x16 (&t)[2], const LAS unsigned char* vst, f32x16 (&o)[2], f32x16& osum, int lane) {
    const int hi = lane >> 5, q4 = (lane & 15) >> 2, p4 = lane & 3, blk = (lane >> 4) & 1;
    const LAS unsigned char* vb = vst + (4 * hi + q4) * VSTR + (16 * blk + 4 * p4) * 2;
    const bf16x8 ones = (bf16x8){0x3F80, 0x3F80, 0x3F80, 0x3F80, 0x3F80, 0x3F80, 0x3F80, 0x3F80};
#pragma unroll
    for (int s = 0; s < 2; ++s) {
        bf16x8 va[2][2];
#pragma unroll
        for (int kk = 0; kk < 2; ++kk)
#pragma unroll
            for (int c = 0; c < 2; ++c) { const s16x4 lo = vtr(vb + (32 * s + 16 * kk) * VSTR + c * 64), h8 = vtr(vb + (32 * s + 16 * kk + 8) * VSTR + c * 64);
                va[kk][c] = (bf16x8){lo[0], lo[1], lo[2], lo[3], h8[0], h8[1], h8[2], h8[3]}; }
        __builtin_amdgcn_sched_barrier(0);
#pragma unroll
        for (int kk = 0; kk < 2; ++kk) {
            float e[8];
#pragma unroll
            for (int j = 0; j < 8; ++j) e[j] = __builtin_amdgcn_exp2f(t[s][8 * kk + j]);
            u32x4 pw; pw.x = cvtpk_s(e[0], e[1]); pw.y = cvtpk_s(e[2], e[3]); pw.z = cvtpk_s(e[4], e[5]); pw.w = cvtpk_s(e[6], e[7]);
            const bf16x8 pb = __builtin_bit_cast(bf16x8, pw);
            o[0] = __builtin_amdgcn_mfma_f32_32x32x16_bf16(va[kk][0], pb, o[0], 0, 0, 0);
            o[1] = __builtin_amdgcn_mfma_f32_32x32x16_bf16(va[kk][1], pb, o[1], 0, 0, 0);
            if (MK_OSUM_MFMA) osum = __builtin_amdgcn_mfma_f32_32x32x16_bf16(ones, pb, osum, 0, 0, 0);
            else { const f32x2 rs = ((f32x2){e[0], e[1]} + (f32x2){e[2], e[3]}) + ((f32x2){e[4], e[5]} + (f32x2){e[6], e[7]}); osum[0] += rs[0] + rs[1]; }
        }
    }
}
__device__ __forceinline__ void store_row64(const f32x16 (&o)[2], float inv, bf16_t* orow, int hi) {
#pragma unroll
    for (int c = 0; c < 2; ++c)
#pragma unroll
        for (int g = 0; g < 4; g += 2) {
            u32x2 a, b;
            a.x = cvt_pk_bf16(o[c][4 * g] * inv, o[c][4 * g + 1] * inv); a.y = cvt_pk_bf16(o[c][4 * g + 2] * inv, o[c][4 * g + 3] * inv);
            b.x = cvt_pk_bf16(o[c][4 * g + 4] * inv, o[c][4 * g + 5] * inv); b.y = cvt_pk_bf16(o[c][4 * g + 6] * inv, o[c][4 * g + 7] * inv);
            { auto r = __builtin_amdgcn_permlane32_swap(a.x, b.x, false, false); a.x = r[0]; b.x = r[1]; }
            { auto r = __builtin_amdgcn_permlane32_swap(a.y, b.y, false, false); a.y = r[0]; b.y = r[1]; }
            u32x4 w; w.x = a.x; w.y = a.y; w.z = b.x; w.w = b.y;
            *(u32x4*)(orow + 32 * c + 8 * g + 8 * hi) = w; }
}
__device__ __forceinline__ void finalize_n(const f32x16 (&o)[2], const f32x16& osum, bf16_t* orow, int hi) {
    const float inv = 1.0f / (MK_OSUM_MFMA ? osum[0] : swap32_sum(osum[0]));
    store_row64(o, inv, orow, hi);
}
__device__ __forceinline__ void finalize(const f32x16 (&o)[2], float l, bf16_t* orow, int hi) {
    l = swap32_sum(l); const float inv = 1.0f / l;
    store_row64(o, inv, orow, hi);
}
#define ATT_PIPE_BEGIN(DQK, MLA, ROW0_OF) \
    u32x4 pre[3]; pre[1] = (u32x4){0u, 0u, 0u, 0u}; \
    fetch<DQK, MLA>(pre, Kb, Vb, KRb, pitch, ROW0_OF(0), tid); stash<DQK>(lds, pre, tid); __syncthreads(); \
    for (int i = 0; i < ntiles; ++i) { \
        if (i + 1 < ntiles) fetch<DQK, MLA>(pre, Kb, Vb, KRb, pitch, ROW0_OF(i + 1), tid); \
        const LAS unsigned char* kst = lds + (i & 1) * Cfg<DQK>::STAGE; const LAS unsigned char* vst = kst + Cfg<DQK>::KB;
#define ATT_PIPE_END(DQK) \
        if (i + 1 < ntiles) stash<DQK>(lds + ((i + 1) & 1) * Cfg<DQK>::STAGE, pre, tid); \
        __syncthreads(); }

#define ATT2_RUN(DQK, MLA, ROW0_OF, QK2, FIRST, STAG) \
    { typedef Cfg<DQK> C_; LAS unsigned char* const kb_ = lds; LAS unsigned char* const vb_ = lds + 2 * C_::KB; \
    u32x4 pk_[2], pv_; pk_[1] = (u32x4){0u, 0u, 0u, 0u}; \
    fetchK<DQK, MLA>(pk_, Kb, KRb, pitch, ROW0_OF(0), tid); fetchV(pv_, Vb, pitch, ROW0_OF(0), tid); stashK<DQK>(kb_, pk_, tid); stashV(vb_, pv_, tid); \
    if (ntiles > 1) { fetchK<DQK, MLA>(pk_, Kb, KRb, pitch, ROW0_OF(1), tid); stashK<DQK>(kb_ + C_::KB, pk_, tid); } \
    __syncthreads(); \
    f32x16 t[2]; QK2(t, kb_, 0); \
    sm_max_n(t, o, osum, m, negm, (FIRST)); \
    __syncthreads();     \
    for (int i = 0; i + 1 < ntiles; ++i) { \
        if (i + 2 < ntiles) fetchK<DQK, MLA>(pk_, Kb, KRb, pitch, ROW0_OF(i + 2), tid); \
        fetchV(pv_, Vb, pitch, ROW0_OF(i + 1), tid); \
        f32x16 tn[2]; \
        if (!(STAG) || wid < 4) { QK2(tn, kb_ + ((i + 1) & 1) * C_::KB, i + 1); }     \
        sm_exp_pv_n(t, vb_ + (i & 1) * C_::VB, o, osum, lane); \
        if ((STAG) && wid >= 4) { QK2(tn, kb_ + ((i + 1) & 1) * C_::KB, i + 1); }     \
        t[0] = tn[0]; t[1] = tn[1]; \
        sm_max_n(t, o, osum, m, negm, false);                                 \
        if (i + 2 < ntiles) stashK<DQK>(kb_ + (i & 1) * C_::KB, pk_, tid); \
        stashV(vb_ + ((i + 1) & 1) * C_::VB, pv_, tid); \
        __syncthreads(); } \
    sm_exp_pv_n(t, vb_ + ((ntiles - 1) & 1) * C_::VB, o, osum, lane); \
    __syncthreads(); }

__device__ __forceinline__ void attn_A_unit(LAS unsigned char* lds, const bf16_t* QKV, bf16_t* O, const float* sink, int b, int kvh, int qb, bool ctxq, int tid) {
    const int lane = tid & 63, wid = __builtin_amdgcn_readfirstlane(tid >> 6), r32 = lane & 31, hi = lane >> 5;
    const int head = kvh * 4 + (wid >> 1), qoff = 32 * (wid & 1) + r32, t0 = qb * 64;
    const int qrow = ctxq ? NL + b * CTXL + t0 + qoff : b * SEQ + t0 + qoff;
    bf16x8 qr[4];
    { const bf16_t* qp = QKV + (size_t)qrow * A_IN + head * 64 + hi * 8;
#pragma unroll
      for (int ks = 0; ks < 4; ++ks) qr[ks] = *(const bf16x8*)(qp + ks * 16); }
    int jlo = 0, nloc = 0;
    if (!ctxq) { jlo = t0 >= 128 ? 0 : (t0 == 64 ? 1 : 2); int jhi = (2112 - t0) / 64; jhi = jhi > 4 ? 4 : jhi; nloc = jhi - jlo + 1; }
    const int ntiles = 4 + nloc, cbase = NL + b * CTXL, lbase = b * SEQ + t0 - 128 + 64 * jlo;
    const bf16_t* Kb = QKV + 1024 + kvh * 64; const bf16_t* Vb = QKV + 1280 + kvh * 64; const bf16_t* KRb = nullptr; const int pitch = A_IN;
    float m = sink[head] * LOG2E;
    f32x16 o[2], osum; float negm = -m;
#pragma unroll
    for (int r = 0; r < 16; ++r) { o[0][r] = 0.f; o[1][r] = 0.f; osum[r] = MK_OSUM_MFMA ? 1.0f : 0.5f; }
#define A_ROW0(i) ((i) < 4 ? cbase + 64 * (i) : lbase + 64 * ((i) - 4))
#define A_QK2(dst, kst, ti) { dst[0] = qkn<64>(kst, 0, qr, negm, r32, hi); dst[1] = qkn<64>(kst, 32, qr, negm, r32, hi); const int j_ = (ti) < 4 ? 2 : jlo + (ti) - 4; \
        if (j_ == 0 || j_ == 4) { _Pragma("unroll") for (int s = 0; s < 2; ++s) _Pragma("unroll") for (int r = 0; r < 16; ++r) { const int kk = 32 * s + crow(r, hi); \
            if (j_ == 0 ? (kk < qoff) : (kk > qoff)) dst[s][r] = -1e30f; } } }
    ATT2_RUN(64, false, A_ROW0, A_QK2, false, (MK_ATT_STAGGER & 1))
#undef A_QK2
#undef A_ROW0
    finalize_n(o, osum, O + (size_t)qrow * D + head * 64, hi);
}

__device__ __forceinline__ void attn_B_unit(LAS unsigned char* lds, LAS float* tab, const bf16_t* QKV, bf16_t* O, const float* rpb, int b, int h, int rq, bool ctxq, int tid) {
    const int lane = tid & 63, wid = __builtin_amdgcn_readfirstlane(tid >> 6), r32 = lane & 31, hi = lane >> 5;
    const int jb = wid & 3, rp = wid >> 2;
    const int rqa = 4 * rq + 2 * rp + (r32 >> 4), qcol = 16 * jb + (r32 & 15);
    const int qrow = ctxq ? NL + b * CTXL + 32 * wid + r32 : b * SEQ + rqa * 64 + qcol;
    for (int idx = tid; idx < 15 * 31; idx += 512) tab[(idx / 31) * 32 + idx % 31] = rpb[h * 465 + idx] * LOG2E;
    bf16x8 qr[4];
    { const bf16_t* qp = QKV + (size_t)qrow * B_IN + h * 64 + hi * 8;
#pragma unroll
      for (int ks = 0; ks < 4; ++ks) qr[ks] = *(const bf16x8*)(qp + ks * 16); }
    int klo = 0, nloc = 0;
    if (!ctxq) { klo = 4 * rq - 4; klo = klo < 0 ? 0 : (klo > 24 ? 24 : klo); int khi = 4 * rq - 1; khi = khi < 0 ? 0 : (khi > 24 ? 24 : khi); khi += 7; nloc = khi - klo + 1; }
    const int ntiles = 4 + nloc, cbase = NL + b * CTXL, lbase = b * SEQ;
    int r0q = rqa - 4; r0q = r0q < 0 ? 0 : (r0q > 24 ? 24 : r0q);
    int wst = qcol - 8; wst = wst < 0 ? 0 : (wst > 48 ? 48 : wst);
    int cst = 16 * jb - 8; cst = cst < 0 ? 0 : (cst > 32 ? 32 : cst);
    const int lo = wst - cst;
    int wr0 = 4 * rq + 2 * rp - 4; wr0 = wr0 < 0 ? 0 : (wr0 > 24 ? 24 : wr0);
    int wr1 = 4 * rq + 2 * rp + 1 - 4; wr1 = wr1 < 0 ? 0 : (wr1 > 24 ? 24 : wr1); wr1 += 7;
    const bf16_t* Kb = QKV + 1024 + h * 64; const bf16_t* Vb = QKV + 2048 + h * 64; const bf16_t* KRb = nullptr; const int pitch = B_IN;
    float m = -1e30f, l = 0.f;
    f32x16 o[2];
#pragma unroll
    for (int r = 0; r < 16; ++r) { o[0][r] = 0.f; o[1][r] = 0.f; }
    const float sc = 0.125f * LOG2E;
#define B_ROW0(i) ((i) < 4 ? cbase + 64 * (i) : lbase + 64 * (klo + (i) - 4))
    ATT_PIPE_BEGIN(64, false, B_ROW0)
        if (i < 4) {
            f32x16 t[2];
            t[0] = qk<64>(kst, 0, qr, r32, hi); t[1] = qk<64>(kst, 32, qr, r32, hi);
#pragma unroll
            for (int s = 0; s < 2; ++s)
#pragma unroll
                for (int r = 0; r < 16; ++r) t[s][r] *= 1.0f;
            const int voff[2] = {0, 32};
            sm_pv<2>(t, 1.0f, vst, voff, o, m, l, lane);
        } else {
            const int kr = klo + i - 4;
            if (kr >= wr0 && kr <= wr1) {
                f32x16 t[1];
                t[0] = qk<64>(kst, cst, qr, r32, hi);
                const bool rowok = (kr >= r0q) && (kr < r0q + 8);
                const int bidx0 = (kr - rqa + 7) * 32 + cst - qcol + 15;
#pragma unroll
                for (int r = 0; r < 16; ++r) { const int kidx = crow(r, hi); const bool ok = rowok && ((unsigned)(kidx - lo) < 16u);
                    int bi = bidx0 + kidx; bi = bi < 0 ? 0 : (bi > 479 ? 479 : bi);
                    const float bias = tab[bi];
                    t[0][r] = ok ? t[0][r] + bias : -1e30f; }
                const int voff[1] = {cst};
                sm_pv<1>(t, 1.0f, vst, voff, o, m, l, lane);
            }
        }
    ATT_PIPE_END(64)
#undef B_ROW0
    finalize(o, l, O + (size_t)qrow * D + h * 64, hi);
}

__device__ __forceinline__ void attn_C_unit(LAS unsigned char* lds, const bf16_t* Q2, const bf16_t* KR, bf16_t* O, int b, int h, int qb, bool ctxq, int tid) {
    const int lane = tid & 63, wid = __builtin_amdgcn_readfirstlane(tid >> 6), r32 = lane & 31, hi = lane >> 5;
    const int qrow = ctxq ? NL + b * CTXL + 32 * wid + r32 : b * SEQ + qb * 256 + 32 * wid + r32;
    bf16x8 qr[6];
    { const bf16_t* qp = Q2 + (size_t)qrow * C_UPN + h * 96 + hi * 8;
#pragma unroll
      for (int ks = 0; ks < 6; ++ks) qr[ks] = *(const bf16x8*)(qp + ks * 16); }
    const int ntiles = ctxq ? 4 : 36, cbase = NL + b * CTXL, lbase = b * SEQ;
    const bf16_t* Kb = Q2 + 1536 + h * 128; const bf16_t* Vb = Kb + 64; const bf16_t* KRb = KR; const int pitch = C_UPN;
    float m = 0.f;
    f32x16 o[2], osum; float negm = 0.f;
#pragma unroll
    for (int r = 0; r < 16; ++r) { o[0][r] = 0.f; o[1][r] = 0.f; osum[r] = 0.f; }
#define C_ROW0(i) ((i) < 4 ? cbase + 64 * (i) : lbase + 64 * ((i) - 4))
#define C_QK2(dst, kst, ti) { dst[0] = qkn<96>(kst, 0, qr, negm, r32, hi); dst[1] = qkn<96>(kst, 32, qr, negm, r32, hi); }
    ATT2_RUN(96, true, C_ROW0, C_QK2, true, (MK_ATT_STAGGER & 2))
#undef C_QK2
#undef C_ROW0
    finalize_n(o, osum, O + (size_t)qrow * D + h * 64, hi);
}
}

struct Row4 { f32x4 v[4]; };
__device__ __forceinline__ void row_load(Row4& x, const float* p, int lane) {
#pragma unroll
    for (int j = 0; j < 4; ++j) x.v[j] = *(const f32x4*)(p + 4 * lane + 256 * j);
}
__device__ __forceinline__ void row_store(const Row4& x, float* p, int lane) {
#pragma unroll
    for (int j = 0; j < 4; ++j) *(f32x4*)(p + 4 * lane + 256 * j) = x.v[j];
}
__device__ __forceinline__ void row_load_bf(Row4& x, const bf16_t* p, int lane) {
#pragma unroll
    for (int j = 0; j < 4; ++j) { const u32x2 w = *(const u32x2*)(p + 4 * lane + 256 * j); x.v[j] = (f32x4){bf_lo(w.x), bf_hi(w.x), bf_lo(w.y), bf_hi(w.y)}; }
}
__device__ __forceinline__ void row_store_bf(const Row4& x, bf16_t* p, int lane) {
#pragma unroll
    for (int j = 0; j < 4; ++j) { u32x2 w; w.x = cvt_pk_bf16(x.v[j][0], x.v[j][1]); w.y = cvt_pk_bf16(x.v[j][2], x.v[j][3]); *(u32x2*)(p + 4 * lane + 256 * j) = w; }
}
__device__ __forceinline__ float row_rstd(const Row4& x, int lane) {
    float s = 0.f;
#pragma unroll
    for (int j = 0; j < 4; ++j) s += (x.v[j][0] * x.v[j][0] + x.v[j][1] * x.v[j][1]) + (x.v[j][2] * x.v[j][2] + x.v[j][3] * x.v[j][3]);
    s = wave_sum(s, lane);
    return 1.0f / sqrtf(s * (1.0f / D) + NORM_EPS);
}
__device__ __forceinline__ void norm_mod(const Row4& x, float rstd, const float* g, const float* sh, const float* sc, bf16_t* out, int lane, Row4& hv) {
#pragma unroll
    for (int j = 0; j < 4; ++j) { const int c = 4 * lane + 256 * j;
        const f32x4 gg = *(const f32x4*)(g + c), s1 = *(const f32x4*)(sc + c), s0 = *(const f32x4*)(sh + c);
        const f32x4 h = (x.v[j] * rstd * gg) * (s1 + 1.0f) + s0; hv.v[j] = h;
        u32x2 w; w.x = cvt_pk_bf16(h[0], h[1]); w.y = cvt_pk_bf16(h[2], h[3]); *(u32x2*)(out + c) = w; }
}

__device__ __forceinline__ unsigned pk_i8x4(float a, float b, float c, float d, float inv) {
    const f32x2 i2 = {inv, inv}, m2 = {12582912.0f, 12582912.0f};
    const f32x2 t01 = (f32x2){a, b} * i2 + m2, t23 = (f32x2){c, d} * i2 + m2;
    const unsigned lo = __builtin_amdgcn_perm(__float_as_uint(t01[1]), __float_as_uint(t01[0]), 0x0c0c0400u), hi = __builtin_amdgcn_perm(__float_as_uint(t23[1]), __float_as_uint(t23[0]), 0x0c0c0400u);
    return lo | (hi << 16);
}
__device__ __forceinline__ void norm_mod8(const Row4& x, float rstd, const float* g, const float* sh, const float* sc, unsigned char* out, float* sarow, int lane) {
    Row4 hv; float am = 0.f;
#pragma unroll
    for (int j = 0; j < 4; ++j) { const int c = 4 * lane + 256 * j;
        const f32x4 gg = *(const f32x4*)(g + c), s1 = *(const f32x4*)(sc + c), s0 = *(const f32x4*)(sh + c);
        const f32x4 h = (x.v[j] * rstd * gg) * (s1 + 1.0f) + s0; hv.v[j] = h;
        am = fmaxf(fmaxf(am, fmaxf(fabsf(h[0]), fabsf(h[1]))), fmaxf(fabsf(h[2]), fabsf(h[3]))); }
    am = fmaxf(wave_max(am, lane), 1e-20f); const float inv = 127.0f / am;
#pragma unroll
    for (int j = 0; j < 4; ++j) *(unsigned*)(out + 4 * lane + 256 * j) = pk_i8x4(hv.v[j][0], hv.v[j][1], hv.v[j][2], hv.v[j][3], inv);
    if (lane == 0) *sarow = am * (1.0f / 127.0f);
}

struct Ptrs {
    const float* in[29]; float* out; unsigned char* ws;
};
typedef const __attribute__((address_space(4))) Ptrs* PK;
#define WSP(T, off) ((T*)(P->ws + (off)))

__device__ __forceinline__ unsigned pk_f16(float a, float b) { const f32x2 v = {a, b}; const f16x2 h = __builtin_convertvector(v, f16x2); return __builtin_bit_cast(unsigned, h); }
__device__ __forceinline__ void phase_first_norm(PK P, LAS unsigned char* lds, int gw, int tid) {
    const float* MOD = WSP(const float, WS_MOD);
    { const int lane = tid & 63;
    {
        const int gt = gw * 64 + lane;
        for (int q = gt; q < DEPTH * 9 * 4096; q += 131072) { const int lb = q >> 12, cc = q & 4095, c = cc >> 5, e = cc & 31, l = lb / 9, b = lb - 9 * l;
            const float* g = P->in[7] + (size_t)l * D + 8 * c; const float* sc = MOD + ((size_t)l * 9 + b) * 6144 + 4096 + 8 * c; const float* w = P->in[21] + ((size_t)l * D + 8 * c) * NEXP + e;
            float v[8];
#pragma unroll
            for (int j = 0; j < 8; ++j) v[j] = g[j] * (1.0f + sc[j]) * w[j * NEXP];
            u32x4 o; o.x = pk_f16(v[0], v[1]); o.y = pk_f16(v[2], v[3]); o.z = pk_f16(v[4], v[5]); o.w = pk_f16(v[6], v[7]);
            *(u32x4*)(WSP(unsigned char, WS_G16) + (size_t)lb * 65536 + e * 2048 + ((c ^ (e & 15)) * 16)) = o; }
        for (int q = gw; q < DEPTH * 9 * 32; q += 2048) { const int lb = q >> 5, e = q & 31, l = lb / 9, b = lb - 9 * l;
            const float* sh = MOD + ((size_t)l * 9 + b) * 6144 + 3072; const float* w = P->in[21] + (size_t)l * D * NEXP + e; float t = 0.f;
#pragma unroll
            for (int j = 0; j < 16; ++j) { const int k = lane + 64 * j; t += sh[k] * w[(size_t)k * NEXP]; }
            t = wave_sum(t, lane);
            if (lane == 0) WSP(float, WS_RC)[q] = t + P->in[22][l * NEXP + e]; }
    } }
    const int lane = tid & 63, vcu = gw >> 3, wid = gw & 7, bb = vcu >> 5;
    LAS float* vec = (LAS float*)lds;
    for (int i = tid; i < 1024; i += 512) { const int set = i >> 9, v = (i >> 8) & 1, k = 4 * (i & 255); const float* mod = MOD + (size_t)(set ? 8 : bb) * 6144;
        *(LAS f32x4*)(vec + set * 2048 + v * 1024 + k) = v ? *(const f32x4*)(mod + k) : *(const f32x4*)(P->in[6] + k) * (*(const f32x4*)(mod + 1024 + k) + 1.0f); }
    __syncthreads();
    const int rbase = bb * 2048 + (vcu & 31) * 64 + wid * 8;
    for (int p = 0; p < 3; ++p) {
        int rr[3]; Row4 x[3];
#pragma unroll
        for (int u = 0; u < 3; ++u) { const int q = 3 * p + u; rr[u] = q < 8 ? rbase + q : NL + vcu * 8 + wid;
            const int r = rr[u]; const float* src = r < NL ? P->in[0] + (size_t)r * D : P->in[2] + (size_t)(r - NL) * D; row_load(x[u], src, lane); }
#pragma unroll
        for (int u = 0; u < 3; ++u) { const int r = rr[u]; row_store_bf(x[u], WSP(bf16_t, WS_XS) + (size_t)r * D, lane);
            const float rstd = row_rstd(x[u], lane); const LAS float* vv = vec + (r < NL ? 0 : 2048) + 4 * lane;
            Row4 hv; float am = 0.f;
#pragma unroll
            for (int j = 0; j < 4; ++j) { const f32x4 h = (x[u].v[j] * rstd) * *(const LAS f32x4*)(vv + 256 * j) + *(const LAS f32x4*)(vv + 1024 + 256 * j); hv.v[j] = h;
                am = fmaxf(fmaxf(am, fmaxf(fabsf(h[0]), fabsf(h[1]))), fmaxf(fabsf(h[2]), fabsf(h[3]))); }
            am = fmaxf(wave_max(am, lane), 1e-20f); const float inv = 127.0f / am; unsigned char* out = WSP(unsigned char, WS_H) + (size_t)r * D;
#pragma unroll
            for (int j = 0; j < 4; ++j) *(unsigned*)(out + 4 * lane + 256 * j) = pk_i8x4(hv.v[j][0], hv.v[j][1], hv.v[j][2], hv.v[j][3], inv);
            if (lane == 0) WSP(float, WS_SAH)[r] = am * (1.0f / 127.0f); }
    }
}
__device__ __forceinline__ void phase_mla_norm(PK P, int gw, int lane) {
    const float* Y = WSP(const float, WS_Y416); bf16_t* CQ = WSP(bf16_t, WS_CQKV); bf16_t* KR = WSP(bf16_t, WS_KR);
    const float* qn = P->in[16]; const float* kn = P->in[17]; const float* rope = WSP(const float, WS_ROPE_C);
    const f32x4 g = *(const f32x4*)(qn + 4 * lane); const f32x2 g2 = *(const f32x2*)(kn + 2 * lane);
    for (int r0 = gw; r0 < NT; r0 += 4096) {
        const int rr[2] = {r0, (r0 + 2048 < NT) ? r0 + 2048 : r0};
        f32x4 vq[2]; f32x2 vk[2], vr[2];
#pragma unroll
        for (int u = 0; u < 2; ++u) { const float* y = Y + (size_t)rr[u] * C_INP; vq[u] = *(const f32x4*)(y + 4 * lane); vk[u] = *(const f32x2*)(y + 256 + 2 * lane); vr[u] = *(const f32x2*)(y + 384 + 2 * (lane & 15)); }
#pragma unroll
        for (int u = 0; u < 2; ++u) { const int r = rr[u]; const f32x4 v = vq[u];
            const float ss = wave_sum((v[0] * v[0] + v[1] * v[1]) + (v[2] * v[2] + v[3] * v[3]), lane);
            const float rq = 1.0f / sqrtf(ss * (1.0f / 256.0f) + NORM_EPS);
            u32x2 w; w.x = cvt_pk_bf16(v[0] * rq * g[0], v[1] * rq * g[1]); w.y = cvt_pk_bf16(v[2] * rq * g[2], v[3] * rq * g[3]);
            *(u32x2*)(CQ + (size_t)r * C_UPK + 4 * lane) = w;
            const f32x2 k2 = vk[u];
            const float s2 = wave_sum(k2[0] * k2[0] + k2[1] * k2[1], lane);
            const float rk = 1.0f / sqrtf(s2 * (1.0f / 128.0f) + NORM_EPS);
            *(unsigned*)(CQ + (size_t)r * C_UPK + 256 + 2 * lane) = cvt_pk_bf16(k2[0] * rk * g2[0], k2[1] * rk * g2[1]);
            if (lane < 16) { f32x2 p = vr[u];
                if (r < NL) { const f32x2 cs = *(const f32x2*)(rope + ((size_t)(r & (SEQ - 1)) * 16 + lane) * 2); const float a = p[0], b = p[1]; p[0] = a * cs[0] - b * cs[1]; p[1] = a * cs[1] + b * cs[0]; }
                *(unsigned*)(KR + (size_t)r * 32 + 2 * lane) = cvt_pk_bf16(p[0], p[1]); }
        }
    }
}
__device__ __forceinline__ void moe_tables(LAS unsigned char* misc, unsigned* gcnt, int tid) {
    LAS int* ecnt = (LAS int*)(misc + M_ECNT); LAS int* lbase = (LAS int*)(misc + M_LBASE); LAS int* cumt = (LAS int*)(misc + M_CUMT);
    if (tid < 32) ecnt[tid] = (int)__hip_atomic_load(gcnt + tid * 16, __ATOMIC_RELAXED, __HIP_MEMORY_SCOPE_AGENT);
    __syncthreads();
    if (tid == 0) { int s = 0, t = 0; for (int e = 0; e < 32; ++e) { lbase[e] = s; cumt[e] = t; const int mt = (ecnt[e] + 255) >> 8; s += mt * 256; t += mt; } cumt[32] = t; }
    __syncthreads();
}
constexpr int RT_PLOG = 65536, RT_LOGIT = 98304, RT_SSQ = 102912, RT_RSTD = 103936, RT_CVEC = 104064, RT_AMX = 104192, RT_TOPV = 105216, RT_TOPE = 105728, RT_VA = 106496, RT_VB = 110592;
__device__ __forceinline__ void phase_router(PK P, LAS unsigned char* lds, int l, int nrows, int vcu, int tid, int cset) {
    const int lane = tid & 63, wid = __builtin_amdgcn_readfirstlane(tid >> 6), i32 = lane & 31, hi = lane >> 5;
    LAS unsigned char* misc = lds + MISC_OFF;
    LAS int* lcnt = (LAS int*)(misc + M_LCNT); LAS int* gbase = (LAS int*)(misc + M_GBASE); LAS int* rec = (LAS int*)(misc + M_REC);
    LAS float* plog = (LAS float*)(lds + RT_PLOG); LAS float* logit = (LAS float*)(lds + RT_LOGIT); LAS float* ssq = (LAS float*)(lds + RT_SSQ);
    LAS float* rstd_s = (LAS float*)(lds + RT_RSTD); LAS float* cvec = (LAS float*)(lds + RT_CVEC); LAS float* amx = (LAS float*)(lds + RT_AMX); LAS float* rowsa = (LAS float*)(misc + M_RSA); LAS float* topv = (LAS float*)(lds + RT_TOPV); LAS int* tope = (LAS int*)(lds + RT_TOPE);
    const bool last = (nrows == NL);
    const int nb = (!last && vcu < 64) ? 3 : 2;
    const float* MOD = WSP(const float, WS_MOD) + (size_t)l * 9 * 6144;
    const bf16_t* XS = WSP(const bf16_t, WS_XS); unsigned char* H8 = WSP(unsigned char, WS_H);
    int* TOPE = WSP(int, WS_TOPE); float* GATE = WSP(float, WS_GATE);
    const float* gn = P->in[7] + (size_t)l * D;
    if (tid < 32) lcnt[tid] = 0;
    u32x4 nw[8];
#define RT_ROW0(b) ((b) < 2 ? 64 * vcu + 32 * (b) : NL + 32 * vcu)
    { const bf16_t* xp0 = XS + (size_t)(RT_ROW0(0) + i32) * D + 128 * wid + 8 * hi;
#pragma unroll
      for (int s = 0; s < 8; ++s) nw[s] = *(const u32x4*)(xp0 + 16 * s); }
    for (int bi = 0; bi < nb; ++bi) {
        const int rb = bi < 2 ? (vcu >> 5) : 8;
        const int row0 = RT_ROW0(bi);
        if (bi != 1) {
            __syncthreads();
            const u32x4* gsrc = (const u32x4*)(WSP(const unsigned char, WS_G16) + (size_t)(l * 9 + rb) * 65536);
#pragma unroll
            for (int c = 0; c < 8; ++c) *(LAS u32x4*)(lds + (size_t)(tid + 512 * c) * 16) = gsrc[tid + 512 * c];
            if (tid < 32) cvec[tid] = WSP(const float, WS_RC)[(l * 9 + rb) * 32 + tid];
            { const float* mod = MOD + (size_t)rb * 6144; const int k = 4 * (tid & 255);
              if (tid < 256) *(LAS f32x4*)(lds + RT_VA + 4 * k) = *(const f32x4*)(gn + k) * (*(const f32x4*)(mod + 4096 + k) + 1.0f);
              else *(LAS f32x4*)(lds + RT_VB + 4 * k) = *(const f32x4*)(mod + 3072 + k); }
            __syncthreads();
        }
        const int r = row0 + i32;
        f32x4 xa[8], xb[8];
#pragma unroll
        for (int s = 0; s < 8; ++s) { const u32x4 w = nw[s];
            xa[s] = (f32x4){bf_lo(w.x), bf_hi(w.x), bf_lo(w.y), bf_hi(w.y)}; xb[s] = (f32x4){bf_lo(w.z), bf_hi(w.z), bf_lo(w.w), bf_hi(w.w)}; }
        if (bi + 1 < nb) { const bf16_t* xpn = XS + (size_t)(RT_ROW0(bi + 1) + i32) * D + 128 * wid + 8 * hi;
#pragma unroll
            for (int s = 0; s < 8; ++s) nw[s] = *(const u32x4*)(xpn + 16 * s); }
        float ss = 0.f;
        f32x16 acc;
#pragma unroll
        for (int q = 0; q < 16; ++q) acc[q] = 0.f;
#pragma unroll
        for (int s = 0; s < 8; ++s) {
            ss += (xa[s][0] * xa[s][0] + xa[s][1] * xa[s][1]) + (xa[s][2] * xa[s][2] + xa[s][3] * xa[s][3]) + (xb[s][0] * xb[s][0] + xb[s][1] * xb[s][1]) + (xb[s][2] * xb[s][2] + xb[s][3] * xb[s][3]);
            u32x4 aw; aw.x = pk_f16(xa[s][0], xa[s][1]); aw.y = pk_f16(xa[s][2], xa[s][3]); aw.z = pk_f16(xb[s][0], xb[s][1]); aw.w = pk_f16(xb[s][2], xb[s][3]);
            const int c = 16 * wid + 2 * s + hi;
            const f16x8 bf = *(const LAS f16x8*)(lds + i32 * 2048 + ((c ^ (i32 & 15)) * 16));
            acc = __builtin_amdgcn_mfma_f32_32x32x16_f16(__builtin_bit_cast(f16x8, aw), bf, acc, 0, 0, 0);
        }
        ss = swap32_sum(ss);
        if (hi == 0) ssq[wid * 32 + i32] = ss;
#pragma unroll
        for (int q = 0; q < 16; ++q) plog[(wid * 32 + att::crow(q, hi)) * 32 + i32] = acc[q];
        __syncthreads();
        if (tid < 32) { float t = 0.f;
#pragma unroll
            for (int w = 0; w < 8; ++w) t += ssq[w * 32 + tid];
            rstd_s[tid] = 1.0f / sqrtf(t * (1.0f / D) + NORM_EPS); }
        __syncthreads();
#pragma unroll
        for (int u = 0; u < 2; ++u) { const int idx = tid + 512 * u, rr = idx >> 5, e = idx & 31; float t = 0.f;
#pragma unroll
            for (int w = 0; w < 8; ++w) t += plog[(w * 32 + rr) * 32 + e];
            logit[rr * 33 + e] = rstd_s[rr] * t + cvec[e]; }
        { const float rs = rstd_s[i32]; const int k0 = 128 * wid + 8 * hi; float am = 0.f;
          const LAS float* va = (const LAS float*)(lds + RT_VA); const LAS float* vb = (const LAS float*)(lds + RT_VB);
#pragma unroll
          for (int s = 0; s < 8; ++s) { const int k = k0 + 16 * s;
              const f32x4 a0 = *(const LAS f32x4*)(va + k), a1 = *(const LAS f32x4*)(va + k + 4), s0 = *(const LAS f32x4*)(vb + k), s1 = *(const LAS f32x4*)(vb + k + 4);
              const f32x4 h0 = (xa[s] * rs) * a0 + s0, h1 = (xb[s] * rs) * a1 + s1; xa[s] = h0; xb[s] = h1;
              am = fmaxf(fmaxf(fmaxf(am, fabsf(h0[0])), fmaxf(fabsf(h0[1]), fabsf(h0[2]))), fmaxf(fmaxf(fabsf(h0[3]), fabsf(h1[0])), fmaxf(fabsf(h1[1]), fmaxf(fabsf(h1[2]), fabsf(h1[3]))))); }
          am = swap32_max(am);
          if (hi == 0) amx[wid * 32 + i32] = am; }
        __syncthreads();
        { float a = amx[i32];
#pragma unroll
          for (int w = 1; w < 8; ++w) a = fmaxf(a, amx[w * 32 + i32]);
          a = fmaxf(a, 1e-20f); const float inv = 127.0f / a;
          if (wid == 0 && hi == 0) rowsa[32 * bi + i32] = a * (1.0f / 127.0f);
          unsigned char* hp = H8 + (size_t)r * D + 128 * wid + 8 * hi;
#pragma unroll
          for (int s = 0; s < 8; ++s) { u32x2 w; w.x = pk_i8x4(xa[s][0], xa[s][1], xa[s][2], xa[s][3], inv); w.y = pk_i8x4(xb[s][0], xb[s][1], xb[s][2], xb[s][3], inv); *(u32x2*)(hp + 16 * s) = w; } }
#pragma unroll
        for (int u = 0; u < 2; ++u) { const int idx = tid + 512 * u, rr = idx >> 5, e = idx & 31; const float v = logit[rr * 33 + e]; int rank = 0;
#pragma unroll 8
            for (int e2 = 0; e2 < 32; ++e2) { const float v2 = logit[rr * 33 + e2]; rank += (v2 > v || (v2 == v && e2 < e)) ? 1 : 0; }
            if (rank < 4) { topv[rr * 4 + rank] = v; tope[rr * 4 + rank] = e; } }
        __syncthreads();
        if (tid < 32) {
            const float t0 = topv[tid * 4], t1 = topv[tid * 4 + 1], t2 = topv[tid * 4 + 2], t3 = topv[tid * 4 + 3]; const int e0 = tope[tid * 4], e1 = tope[tid * 4 + 1], e2 = tope[tid * 4 + 2], e3 = tope[tid * 4 + 3];
            const float x1 = __expf(t1 - t0), x2 = __expf(t2 - t0), x3 = __expf(t3 - t0); const float inv = 1.0f / (1.0f + x1 + x2 + x3);
            const int rr = row0 + tid, lr = 32 * bi + tid;
            *(int4*)(TOPE + (size_t)rr * 4) = make_int4(e0, e1, e2, e3);
            *(f32x4*)(GATE + (size_t)rr * 4) = (f32x4){inv, x1 * inv, x2 * inv, x3 * inv};
            const int ee[4] = {e0, e1, e2, e3};
#pragma unroll
            for (int k = 0; k < 4; ++k) { const int lp = __hip_atomic_fetch_add(lcnt + ee[k], 1, __ATOMIC_RELAXED, __HIP_MEMORY_SCOPE_WORKGROUP); rec[2 * (lr * 4 + k)] = ee[k]; rec[2 * (lr * 4 + k) + 1] = lp; }
        }
    }
    __syncthreads();
    unsigned* gcnt = WSP(unsigned, WS_CTL) + CW_CNT + (l * 2 + cset) * 512;
    if (tid < 32) { const int c = lcnt[tid]; gbase[tid] = c ? (int)__hip_atomic_fetch_add(gcnt + tid * 16, (unsigned)c, __ATOMIC_RELAXED, __HIP_MEMORY_SCOPE_AGENT) : 0; }
    __syncthreads();
    int* ELIST = WSP(int, WS_ELIST); int* POS = WSP(int, WS_POS);
    for (int idx = tid; idx < nb * 128; idx += 512) { const int e = rec[2 * idx], pos = gbase[e] + rec[2 * idx + 1]; const int lr = idx >> 2; const int r = lr < 64 ? 64 * vcu + lr : NL + 32 * vcu + (lr - 64);
        ELIST[(size_t)e * NT + pos] = r; POS[(size_t)r * 4 + (idx & 3)] = pos; WSP(float, WS_SAL)[(size_t)e * NT + pos] = rowsa[lr]; }
    __syncthreads();
}
constexpr int RQU = 8;
__device__ __forceinline__ unsigned rq4(unsigned w, float fac, float c0) {
    const float t0 = (float)(w & 255u) * fac + c0, t1 = (float)((w >> 8) & 255u) * fac + c0, t2 = (float)((w >> 16) & 255u) * fac + c0, t3 = (float)(w >> 24) * fac + c0;
    const unsigned lo = __builtin_amdgcn_perm(__float_as_uint(t1), __float_as_uint(t0), 0x0c0c0400u), hi = __builtin_amdgcn_perm(__float_as_uint(t3), __float_as_uint(t2), 0x0c0c0400u);
    return lo | (hi << 16);
}
__device__ __forceinline__ void phase_requant(PK P, const LAS int* cumt, int gw, int lane) {
    const int nrows = __builtin_amdgcn_readfirstlane(cumt[32]) * 256;
    const int per = (nrows + 2047) >> 11, np = (per + RQU - 1) / RQU, nu = np > 0 ? (per + np - 1) / np : 0;
    const unsigned char* AQ = WSP(const unsigned char, WS_ACT); const float* SB = WSP(const float, WS_SBLK); unsigned char* A8 = WSP(unsigned char, WS_ACT8); float* SAQ = WSP(float, WS_SAQ);
    for (int r0 = gw; r0 < nrows; r0 += nu * 2048) {
        u32x4 a[RQU]; float sb[RQU];
#pragma unroll
        for (int u = 0; u < RQU; ++u) { const int r = r0 + u * 2048; a[u] = (u32x4){0u, 0u, 0u, 0u}; sb[u] = 1.0f;
            if (u < nu && r < nrows) { a[u] = *(const u32x4*)(AQ + (size_t)r * D + 16 * lane); sb[u] = SB[(size_t)r * 32 + (lane >> 1)]; } }
#pragma unroll
        for (int u = 0; u < RQU; ++u) { const int r = r0 + u * 2048;
            if (u < nu && r < nrows) {
                const float srow = wave_max(sb[u], lane); const float fac = sb[u] * __builtin_amdgcn_rcpf(srow), c0 = 12582912.0f - 128.0f * fac;
                u32x4 w; w.x = rq4(a[u].x, fac, c0); w.y = rq4(a[u].y, fac, c0); w.z = rq4(a[u].z, fac, c0); w.w = rq4(a[u].w, fac, c0);
                *(u32x4*)(A8 + (size_t)r * D + 16 * lane) = w;
                if (lane == 0) SAQ[r] = srow; }
        }
    }
}
constexpr int CBU = 3;
__device__ __forceinline__ void phase_combine(PK P, LAS unsigned char* lds, int l, int nrows, int gw, int tid, bool dry) {
    (void)dry; (void)nrows;
    const int lane = tid & 63, vcu = gw >> 3, wid = gw & 7;
    LAS unsigned char* misc = lds + MISC_OFF;
    if (MK_PER_PHASE) moe_tables(misc, WSP(unsigned, WS_CTL) + CW_CNT + (l * 2 + ((MK_REP_MASK >> 11) & 1)) * 512, tid);
    const LAS int* lbase = (const LAS int*)(misc + M_LBASE);
    const float* MOD = WSP(const float, WS_MOD);
    bf16_t* XS = WSP(bf16_t, WS_XS); const unsigned char* YSQ = WSP(const unsigned char, WS_YS); const float* YSB = WSP(const float, WS_YSB);
    const int* TOPE = WSP(const int, WS_TOPE); const int* POS = WSP(const int, WS_POS); const float* GATE = WSP(const float, WS_GATE);
    const bool last = (l == DEPTH - 1);
    const int bb = vcu >> 5;
    LAS float* vec = (LAS float*)lds;
    for (int i = tid; i < (last ? 1 : 2) * 768; i += 512) { const int set = i / 768, v = (i % 768) >> 8, k = 4 * (i & 255), rb = set ? 8 : bb;
        f32x4 w;
        if (v == 0) w = *(const f32x4*)(MOD + (size_t)l * 9 * 6144 + 5120 + (size_t)rb * 6144 + k);
        else if (last) w = *(const f32x4*)(P->in[8] + k);
        else { const float* mod = MOD + (size_t)(l + 1) * 9 * 6144 + (size_t)rb * 6144;
            w = (v == 1) ? *(const f32x4*)(P->in[6] + (size_t)(l + 1) * D + k) * (*(const f32x4*)(mod + 1024 + k) + 1.0f) : *(const f32x4*)(mod + k); }
        *(LAS f32x4*)(vec + set * 3072 + v * 1024 + k) = w; }
    __syncthreads();
    const int rbase = bb * 2048 + (vcu & 31) * 64 + wid * 8;
    for (int p = 0; p < 3; ++p) {
        int rr[CBU]; int vs[CBU];
#pragma unroll
        for (int u = 0; u < CBU; ++u) { const int q = 3 * p + u; const bool cx = (q == 8) && !last;
            rr[u] = q < 8 ? rbase + q : (last ? rbase + 6 : NL + vcu * 8 + wid); vs[u] = cx ? 3072 : 0; }
        int slot[CBU]; float gate[CBU];
#pragma unroll
        for (int u = 0; u < CBU; ++u) { slot[u] = 0; gate[u] = 0.f;
            if (lane < 4 && !(last && 3 * p + u == 8)) { slot[u] = lbase[TOPE[(size_t)rr[u] * 4 + lane]] + POS[(size_t)rr[u] * 4 + lane]; gate[u] = GATE[(size_t)rr[u] * 4 + lane]; } }
        u32x2 xw[CBU][4]; unsigned yw[CBU][4][4]; float ys[CBU][4][4];
#pragma unroll
        for (int u = 0; u < CBU; ++u) { if (last && 3 * p + u == 8) continue;
#pragma unroll
            for (int j = 0; j < 4; ++j) xw[u][j] = *(const u32x2*)(XS + (size_t)rr[u] * D + 4 * lane + 256 * j);
#pragma unroll
            for (int k = 0; k < 4; ++k) { const int sk = __builtin_amdgcn_readlane(slot[u], k); const unsigned char* yr = YSQ + (size_t)sk * D; const float* yb = YSB + (size_t)sk * 32 + (lane >> 3);
#pragma unroll
                for (int j = 0; j < 4; ++j) { yw[u][k][j] = *(const unsigned*)(yr + 4 * lane + 256 * j); ys[u][k][j] = yb[8 * j]; } } }
#pragma unroll
        for (int u = 0; u < CBU; ++u) { if (last && 3 * p + u == 8) continue;
            const int r = rr[u]; const LAS float* vv = vec + vs[u] + 4 * lane;
            Row4 x, f;
#pragma unroll
            for (int j = 0; j < 4; ++j) { x.v[j] = (f32x4){bf_lo(xw[u][j].x), bf_hi(xw[u][j].x), bf_lo(xw[u][j].y), bf_hi(xw[u][j].y)}; f.v[j] = (f32x4){0.f, 0.f, 0.f, 0.f}; }
#pragma unroll
            for (int k = 0; k < 4; ++k) { const float gk = __int_as_float(__builtin_amdgcn_readlane(__float_as_int(gate[u]), k));
#pragma unroll
                for (int j = 0; j < 4; ++j) { const unsigned w = yw[u][k][j]; const float gs = gk * ys[u][k][j], g0 = -128.0f * gs;
                    f.v[j][0] += (float)(w & 255u) * gs + g0; f.v[j][1] += (float)((w >> 8) & 255u) * gs + g0; f.v[j][2] += (float)((w >> 16) & 255u) * gs + g0; f.v[j][3] += (float)(w >> 24) * gs + g0; } }
#pragma unroll
            for (int j = 0; j < 4; ++j) { const f32x4 gg = *(const LAS f32x4*)(vv + 256 * j); x.v[j] = x.v[j] + gg * f.v[j]; }
            const float rstd = row_rstd(x, lane);
            if (last) {
#pragma unroll
                for (int j = 0; j < 4; ++j) { const int c = 4 * lane + 256 * j; *(f32x4*)(P->out + (size_t)r * D + c) = (x.v[j] * rstd) * *(const LAS f32x4*)(vv + 1024 + 256 * j); }
            } else {
                row_store_bf(x, XS + (size_t)r * D, lane);
                Row4 hv; float am = 0.f;
#pragma unroll
                for (int j = 0; j < 4; ++j) { const f32x4 h = (x.v[j] * rstd) * *(const LAS f32x4*)(vv + 1024 + 256 * j) + *(const LAS f32x4*)(vv + 2048 + 256 * j); hv.v[j] = h;
                    am = fmaxf(fmaxf(am, fmaxf(fabsf(h[0]), fabsf(h[1]))), fmaxf(fabsf(h[2]), fabsf(h[3]))); }
                { am = fmaxf(wave_max(am, lane), 1e-20f); const float inv = 127.0f / am; unsigned char* out = WSP(unsigned char, WS_H) + (size_t)r * D;
#pragma unroll
                    for (int j = 0; j < 4; ++j) *(unsigned*)(out + 4 * lane + 256 * j) = pk_i8x4(hv.v[j][0], hv.v[j][1], hv.v[j][2], hv.v[j][3], inv);
                    if (lane == 0) WSP(float, WS_SAH)[r] = am * (1.0f / 127.0f); }
            }
        }
    }
}
__device__ __forceinline__ void phase_final_norm(PK P, int gw, int lane) {
    for (int r = gw; r < NL; r += 2048) { Row4 x; row_load_bf(x, WSP(const bf16_t, WS_XS) + (size_t)r * D, lane); const float rstd = row_rstd(x, lane);
#pragma unroll
        for (int j = 0; j < 4; ++j) { const int c = 4 * lane + 256 * j; const f32x4 gn = *(const f32x4*)(P->in[8] + c); *(f32x4*)(P->out + (size_t)r * D + c) = x.v[j] * rstd * gn; } }
}

__device__ __forceinline__ void conv_item(const float* src, int N, int nvalid, int k0, int n0, bf16_t* dst, int ldk, int drow0, int dk0, LAS unsigned* scr, int lane) {
    const int q = lane >> 4, nl = lane & 15, n = n0 + 4 * nl;
    f32x4 v[16];
#pragma unroll
    for (int r = 0; r < 16; ++r) { const int k = k0 + 8 * (r >> 1) + 2 * q + (r & 1);
        v[r] = (n < nvalid) ? __builtin_nontemporal_load((const f32x4*)(src + (size_t)k * N + n)) : (f32x4){0.f, 0.f, 0.f, 0.f}; }
#pragma unroll
    for (int rp = 0; rp < 8; ++rp)
#pragma unroll
        for (int i = 0; i < 4; ++i) { const int nn = 4 * nl + i, kw = 4 * rp + q; scr[nn * 32 + (kw ^ (4 * ((nn >> 2) & 7)))] = cvt_pk_bf16(v[2 * rp][i], v[2 * rp + 1][i]); }
    asm volatile("s_waitcnt lgkmcnt(0)" ::: "memory");
#pragma unroll
    for (int it = 0; it < 8; ++it) { const int nn = 8 * it + (lane >> 3), c = lane & 7;
        const u32x4 w = *(const LAS u32x4*)(scr + nn * 32 + 4 * (c ^ ((nn >> 2) & 7)));
        *(u32x4*)(dst + (size_t)(drow0 + nn) * ldk + dk0 + 8 * c) = w; }
    asm volatile("s_waitcnt lgkmcnt(0)" ::: "memory");
}
constexpr int CV_A_IN = 2 * 16 * 24, CV_A_OUT = 2 * 256, CV_B_IN = 16 * 48, CV_B_OUT = 256, CV_C_IN = 16 * 8, CV_C_UQ = 4 * 24, CV_C_UKV = 2 * 32, CV_C_OUT = 256;
constexpr int CV_SMALL = CV_A_IN + CV_A_OUT + CV_B_IN + CV_B_OUT + CV_C_IN + CV_C_UQ + CV_C_UKV + CV_C_OUT;
constexpr int CV_LAYER = NEXP * 3 * 256;
constexpr int CV_TOTAL = CV_SMALL + DEPTH * CV_LAYER;
constexpr int CV_CHUNK = 32;
__device__ __forceinline__ void conv_dispatch(PK P, int item, LAS unsigned* scr, int lane) {
    int r = item; const float* src; bf16_t* dst; int N, kb, nb, ldk = D, drow_off = 0, dk_off = 0;
    if (r < CV_A_IN) return;
    else if ((r -= CV_A_IN) < CV_A_OUT) { const int s = r / 256, it = r % 256; kb = it / 16; nb = it % 16; src = P->in[10] + (size_t)s * D * D; N = D; dst = WSP(bf16_t, WS_WA_OUT) + (size_t)s * D * D; }
    else if ((r -= CV_A_OUT) < CV_B_IN) return;
    else if ((r -= CV_B_IN) < CV_B_OUT) { kb = r / 16; nb = r % 16; src = P->in[13]; N = D; dst = WSP(bf16_t, WS_WB_OUT); }
    else if ((r -= CV_B_OUT) < CV_C_IN) return;
    else if ((r -= CV_C_IN) < CV_C_UQ) { kb = r / 24; nb = r % 24; src = P->in[18]; N = 1536; dst = WSP(bf16_t, WS_WC_UP); ldk = C_UPK; }
    else if ((r -= CV_C_UQ) < CV_C_UKV) { kb = r / 32; nb = r % 32; src = P->in[19]; N = 2048; dst = WSP(bf16_t, WS_WC_UP); ldk = C_UPK; drow_off = 1536; dk_off = 256; }
    else { r -= CV_C_UKV; kb = r / 16; nb = r % 16; src = P->in[20]; N = D; dst = WSP(bf16_t, WS_WC_OUT); }
    conv_item(src, N, N, 64 * kb, 64 * nb, dst, ldk, drow_off + 64 * nb, dk_off + 64 * kb, scr, lane);
}
__device__ __forceinline__ void conv_down_item(PK P, int L, int di, LAS unsigned* scr, int lane) {
    const int le = L * NEXP + (di >> 8), it = di & 255, kb = it >> 4, nb = it & 15;
    conv_item(P->in[27] + (size_t)le * D * D, D, D, 64 * kb, 64 * nb, WSP(bf16_t, WS_WD) + (size_t)le * D * D, D, 64 * nb, 64 * kb, scr, lane);
}
__device__ __forceinline__ void conv_q8_block(const float* src0, int N, unsigned char* dstq, float* dsts, LAS unsigned char* lds, int tid, int nvalid = 64) {
    const int lane = tid & 63, wid = __builtin_amdgcn_readfirstlane(tid >> 6), q = lane >> 4, nl = lane & 15;
    const float* src = src0 + (4 * nl + 4 <= nvalid ? 4 * nl : nvalid - 4);
    f32x4 v[32];
#pragma unroll
    for (int r = 0; r < 32; ++r) { const int k = 128 * wid + 16 * (r >> 2) + 4 * q + (r & 3); v[r] = __builtin_nontemporal_load((const f32x4*)(src + (size_t)k * N)); }
    float cm[4] = {0.f, 0.f, 0.f, 0.f};
#pragma unroll
    for (int r = 0; r < 32; ++r)
#pragma unroll
        for (int i = 0; i < 4; ++i) cm[i] = fmaxf(cm[i], fabsf(v[r][i]));
    LAS float* cmx = (LAS float*)(lds + 65536);
#pragma unroll
    for (int i = 0; i < 4; ++i) { cm[i] = fmaxf(cm[i], shx(cm[i], 16, lane)); cm[i] = swap32_max(cm[i]); }
    if (q == 0) { *(LAS f32x4*)(cmx + wid * 64 + 4 * nl) = (f32x4){cm[0], cm[1], cm[2], cm[3]}; }
    __syncthreads();
    f32x4 a = *(const LAS f32x4*)(cmx + 4 * nl);
#pragma unroll
    for (int w = 1; w < 8; ++w) { const f32x4 b = *(const LAS f32x4*)(cmx + w * 64 + 4 * nl); a[0] = fmaxf(a[0], b[0]); a[1] = fmaxf(a[1], b[1]); a[2] = fmaxf(a[2], b[2]); a[3] = fmaxf(a[3], b[3]); }
    float inv[4];
#pragma unroll
    for (int i = 0; i < 4; ++i) { a[i] = fmaxf(a[i], 1e-30f); inv[i] = 127.0f / a[i]; }
    if (wid == 0 && q == 0) *(f32x4*)(dsts + 4 * nl) = a * (1.0f / 127.0f);
    LAS unsigned* scr = (LAS unsigned*)(lds + wid * 8192);
#pragma unroll
    for (int rp = 0; rp < 8; ++rp)
#pragma unroll
        for (int i = 0; i < 4; ++i) { const int nn = 4 * nl + i, kw = 4 * rp + q;
            scr[nn * 32 + (kw ^ (4 * ((nn >> 2) & 7)))] = pk_i8x4(v[4 * rp][i], v[4 * rp + 1][i], v[4 * rp + 2][i], v[4 * rp + 3][i], inv[i]); }
    asm volatile("s_waitcnt lgkmcnt(0)" ::: "memory");
    unsigned char* dst = dstq + 128 * wid;
#pragma unroll
    for (int it = 0; it < 8; ++it) { const int nn = 8 * it + (lane >> 3), c = lane & 7;
        const u32x4 w = *(const LAS u32x4*)(scr + nn * 32 + 4 * (c ^ ((nn >> 2) & 7)));
        *(u32x4*)(dst + (size_t)nn * D + 16 * c) = w; }
    __syncthreads();
}
__device__ __forceinline__ void conv_gu_block(PK P, LAS unsigned char* lds, int le, int which, int nb, int tid) {
    const int n0 = 64 * nb, drow0 = 256 * (n0 >> 7) + (n0 & 127) + (which ? 128 : 0);
    conv_q8_block(P->in[which ? 25 : 23] + (size_t)le * D * D + n0, D, WSP(unsigned char, WS_WGU) + ((size_t)le * 2048 + drow0) * D, WSP(float, WS_SBW) + (size_t)le * 2048 + drow0, lds, tid);
}
__device__ __forceinline__ void conv_in_block(PK P, LAS unsigned char* lds, int blk, int tid) {
    if (blk < 48) { const int s = blk / 24, nb = blk % 24;
        conv_q8_block(P->in[9] + (size_t)s * D * A_IN + 64 * nb, A_IN, WSP(unsigned char, WS_WA_IN) + ((size_t)s * A_IN + 64 * nb) * D, WSP(float, WS_SBI) + s * A_IN + 64 * nb, lds, tid); }
    else if (blk < 96) { const int nb = blk - 48;
        conv_q8_block(P->in[12] + 64 * nb, B_IN, WSP(unsigned char, WS_WB_IN) + (size_t)64 * nb * D, WSP(float, WS_SBI) + 2 * A_IN + 64 * nb, lds, tid); }
    else { const int nb = blk - 96;
        conv_q8_block(P->in[15] + 64 * nb, C_IN, WSP(unsigned char, WS_WC_IN) + (size_t)64 * nb * D, WSP(float, WS_SBI) + 2 * A_IN + B_IN + 64 * nb, lds, tid, nb == 6 ? 32 : 64); }
}
constexpr int CV_SLOTS = 1536;
__device__ __forceinline__ void conv_slot(PK P, LAS unsigned char* lds, int L, int s, int tid) {
    if (s < 1024) { conv_gu_block(P, lds, L * NEXP + (s >> 5), (s >> 4) & 1, s & 15, tid); return; }
    const int d = s - 1024, le = L * NEXP + (d >> 4), nb = d & 15;
    conv_q8_block(P->in[27] + (size_t)le * D * D + 64 * nb, D, WSP(unsigned char, WS_WD) + ((size_t)le * D + 64 * nb) * D, WSP(float, WS_SBD) + (size_t)le * D + 64 * nb, lds, tid);
}
__device__ __forceinline__ void conv_claim(PK P, LAS unsigned char* lds, int L, int quota, int tid) {
    LAS int* slot = (LAS int*)(lds + MISC_OFF + M_CVB);
    unsigned* ctr = WSP(unsigned, WS_CTL) + CW_CV + L * 16;
    for (int q = 0; q < quota; ++q) {
        __syncthreads();
        if (tid == 0) *slot = (int)__hip_atomic_fetch_add(ctr, 1u, __ATOMIC_RELAXED, __HIP_MEMORY_SCOPE_AGENT);
        __syncthreads();
        const int sl = __builtin_amdgcn_readfirstlane(*slot);
        if (sl >= CV_SLOTS) break;
        conv_slot(P, lds, L, sl, tid);
    }
    __syncthreads();
}
__device__ __forceinline__ void phase_prologue(PK P, LAS unsigned char* lds, int bid, int tid) {
    const int lane = tid & 63, wid = __builtin_amdgcn_readfirstlane(tid >> 6);
    {
        LAS float* S = (LAS float*)lds; LAS float* red = (LAS float*)(lds + 40960);
        for (int idx = tid; idx < 9 * D; idx += 512) { const int r = idx >> 10, d = idx & (D - 1); const float v = r < 8 ? P->in[1][r * D + d] : P->in[3][d];
            S[idx] = v / (1.0f + __builtin_amdgcn_exp2f(-v * LOG2E)); }
        __syncthreads();
        const int l = bid >> 6, c0 = (bid & 63) * 96;
        if (lane < 48) {
            float acc[9][2];
#pragma unroll
            for (int r = 0; r < 9; ++r) { acc[r][0] = 0.f; acc[r][1] = 0.f; }
            const float* wp = P->in[4] + ((size_t)l * D + 128 * wid) * 6144 + c0 + 2 * lane;
            const LAS float* sp = S + 128 * wid;
            for (int kb = 0; kb < 128; kb += 32) {
                f32x2 w[32];
#pragma unroll
                for (int k = 0; k < 32; ++k) w[k] = __builtin_nontemporal_load((const f32x2*)(wp + (size_t)(kb + k) * 6144));
#pragma unroll
                for (int k = 0; k < 32; ++k)
#pragma unroll
                    for (int r = 0; r < 9; ++r) { const float s = sp[r * D + kb + k]; acc[r][0] += s * w[k][0]; acc[r][1] += s * w[k][1]; } }
#pragma unroll
            for (int r = 0; r < 9; ++r) { red[(wid * 9 + r) * 96 + 2 * lane] = acc[r][0]; red[(wid * 9 + r) * 96 + 2 * lane + 1] = acc[r][1]; }
        }
        __syncthreads();
        float* MOD = WSP(float, WS_MOD);
        for (int idx = tid; idx < 9 * 96; idx += 512) { const int r = idx / 96, cc = idx % 96; float s = 0.f;
#pragma unroll
            for (int w = 0; w < 8; ++w) s += red[(w * 9 + r) * 96 + cc];
            MOD[((size_t)l * 9 + r) * 6144 + c0 + cc] = s + P->in[5][(size_t)l * 6144 + c0 + cc]; }
        __syncthreads();
    }
    {
        const int gt = bid * 512 + tid; float* RA = WSP(float, WS_ROPE_A); float* RC = WSP(float, WS_ROPE_C);
        const float L2T = 13.287712379549449f;
        for (int idx = gt; idx < SEQ * 32; idx += 131072) { const int t = idx >> 5, i = idx & 31; const float pos = (float)(i < 16 ? (t >> 6) : (t & 63));
            const float inv = __builtin_amdgcn_exp2f(-(float)(i & 15) * (1.0f / 16.0f) * L2T); const float ang = pos * inv; RA[2 * idx] = __cosf(ang); RA[2 * idx + 1] = __sinf(ang); }
        for (int idx = gt; idx < SEQ * 16; idx += 131072) { const int t = idx >> 4, i = idx & 15; const float pos = (float)(i < 8 ? (t >> 6) : (t & 63));
            const float inv = __builtin_amdgcn_exp2f(-(float)(i & 7) * (1.0f / 8.0f) * L2T); const float ang = pos * inv; RC[2 * idx] = __cosf(ang); RC[2 * idx + 1] = __sinf(ang); }
        bf16_t* WU = WSP(bf16_t, WS_WC_UP); const u32x4 z = (u32x4){0u, 0u, 0u, 0u};
        for (int idx = gt; idx < 1536 * 16; idx += 131072) *(u32x4*)(WU + (size_t)(idx >> 4) * C_UPK + 256 + 8 * (idx & 15)) = z;
        for (int idx = gt; idx < 2048 * 32; idx += 131072) *(u32x4*)(WU + (size_t)(1536 + (idx >> 5)) * C_UPK + 8 * (idx & 31)) = z;
        for (int idx = gt; idx < 64 * 64; idx += 131072) *(u32x4*)(WSP(unsigned char, WS_WC_IN) + (size_t)448 * D + (size_t)idx * 16) = z;
        if (gt < 64) WSP(float, WS_SBI)[2 * A_IN + B_IN + 448 + gt] = 1.0f;
    }
    {
        LAS unsigned* scr = (LAS unsigned*)(lds + wid * 8192);
        const int gw = bid * 8 + wid;
        for (int item = gw; item < CV_SMALL; item += 2048) conv_dispatch(P, item, scr, lane);
        __syncthreads();
        for (int blk = bid; blk < 103; blk += 256) conv_in_block(P, lds, blk, tid);
        for (int sl = bid; sl < CV_SLOTS; sl += 256) conv_slot(P, lds, 0, sl, tid);
    }
}

constexpr int PH_PRO = 0, PH_N0 = 1, PH_L0 = 2, PH_PER_LAYER = 9, PH_FINAL = PH_L0 + DEPTH * PH_PER_LAYER, NPH = PH_FINAL + 1;
enum { LP_IN = 0, LP_MLANORM = 1, LP_MLAUP = 2, LP_ATT = 3, LP_OUT = 4, LP_RT = 5, LP_GU = 6, LP_DN = 7, LP_CB = 8 };
struct Args { Ptrs P; int p_lo, p_hi, bar_idx, pad; };

__global__ void __launch_bounds__(512, 2) mk_fwd(Args a) {
    extern __shared__ __attribute__((aligned(16))) unsigned char lds_raw[];
    LAS unsigned char* const lds = (LAS unsigned char*)lds_raw;
    LAS unsigned char* const misc = lds + MISC_OFF;
    typedef const __attribute__((address_space(4))) Args* ArgsK;
    const ArgsK ak = (ArgsK)__builtin_amdgcn_kernarg_segment_ptr();
    (void)a;
    const int wid0 = __builtin_amdgcn_readfirstlane((int)threadIdx.x >> 6);
    if (wid0 == 0 && lane_id() < 4) ((LAS unsigned*)(misc + M_BARW))[lane_id()] = 0u;
    __syncthreads();
    XcdBarrier bar;
    { PK P = &ak->P; bar = xcd_barrier_post(WSP(unsigned, WS_CTL) + CW_BAR + ak->bar_idx * XCD_BAR_WORDS, (volatile LAS unsigned*)(misc + M_BARW), wid0 == 0); }
    bool ran = false;
    const int p_lo = ak->p_lo, p_hi = ak->p_hi;
    int pcnt = 0; unsigned long long ts0 = 0ull, tsd = 0ull; (void)pcnt; (void)ts0; (void)tsd;
#define STAMP_HERE() do { if (MK_TIME_PHASE >= 0 && MK_TIME_PHASE < 1000) { if (pcnt == MK_TIME_PHASE) ts0 = __builtin_amdgcn_s_memrealtime(); if (pcnt == MK_TIME_PHASE + 1) tsd = __builtin_amdgcn_s_memrealtime() - ts0; ++pcnt; } } while (0)
#define PHASE_BEGIN(bit, p, cond) if ((((MK_MASK) >> (bit)) & 1) && p_lo <= (p) && (p) < p_hi && ((p) <= MK_STOP_AFTER || (p) == PH_FINAL) && (cond)) for (int rep_ = 0; rep_ < 1 + (((MK_REP_MASK) >> (bit)) & 1); ++rep_) { if (ran) xcd_barrier(bar); ran = true; STAMP_HERE(); \
    int tid = wid0 * 64 + lane_id(); asm volatile("" : "+v"(tid)); int bid = blockIdx.x; asm volatile("" : "+s"(bid)); ArgsK ak_ = ak; asm volatile("" : "+s"(ak_)); PK P = &ak_->P; \
    const int lane = tid & 63, wid = __builtin_amdgcn_readfirstlane(tid >> 6), vcu = (bid & 7) * 32 + (bid >> 3), gw = vcu * 8 + wid; (void)lane; (void)gw; (void)P;
#define PHASE_END }

    PHASE_BEGIN(0, PH_PRO, true) phase_prologue(P, lds, bid, tid); PHASE_END
    PHASE_BEGIN(1, PH_N0, true) phase_first_norm(P, lds, gw, tid); PHASE_END

    for (int l = 0; l < DEPTH; ++l) {
        const int kind = l % 3, slot = l / 3, pb = PH_L0 + l * PH_PER_LAYER;
        const bool last = (l == DEPTH - 1);
        const int nMrows = last ? NL / 256 : NT / 256;
        PHASE_BEGIN(2, pb + LP_IN, kind == 0) {
            pg8::Gemm g{WSP(const void, WS_H), WSP(const unsigned char, WS_WA_IN) + (size_t)slot * A_IN * D, D, 0, nullptr};
            pg8::DenseOrder S{nMrows, 6, vcu, last ? 8 : 0, 4, 2};
            pg8::EpiQkvA8 E{WSP(bf16_t, WS_QKV), WSP(const float, WS_ROPE_A), WSP(const float, WS_SAH), WSP(const float, WS_SBI) + slot * A_IN, (const LAS float*)(misc + M_EPF)};
            pg8::gemm_phase<pg8::EpiQkvA8, pg8::DenseOrder, false, true>(lds, g, S, E, tid);
            if (l >= 1 && S.short_one()) conv_claim(P, lds, l, MK_Q_IN, tid);
        } PHASE_END
        PHASE_BEGIN(3, pb + LP_IN, kind == 1) {
            pg8::Gemm g{WSP(const void, WS_H), WSP(const unsigned char, WS_WB_IN), D, 0, nullptr};
            pg8::DenseOrder S{NT / 256, 12, vcu, 0, 0, 0};
            pg8::EpiBf16Plain8 E{WSP(bf16_t, WS_QKV), B_IN, 4, 0.125f * LOG2E, WSP(const float, WS_SAH), WSP(const float, WS_SBI) + 2 * A_IN, (const LAS float*)(misc + M_EPF)};
            pg8::gemm_phase<pg8::EpiBf16Plain8, pg8::DenseOrder, false, true>(lds, g, S, E, tid);
            if (S.short_one()) conv_claim(P, lds, l, MK_Q_IN, tid);
        } PHASE_END
        PHASE_BEGIN(4, pb + LP_IN, kind == 2) {
            pg8::Gemm g{WSP(const void, WS_H), WSP(const unsigned char, WS_WC_IN), D, 0, nullptr};
            pg8::DenseOrder S{NT / 256, 2, vcu, 0, 0, 0};
            pg8::EpiMlaIn E{WSP(bf16_t, WS_CQKV), WSP(bf16_t, WS_KR), P->in[16], P->in[17], WSP(const float, WS_ROPE_C), (LAS float*)(misc + M_EPF + 4096),
                            WSP(const float, WS_SAH), WSP(const float, WS_SBI) + 2 * A_IN + B_IN, (const LAS float*)(misc + M_EPF)};
            pg8::gemm_phase<pg8::EpiMlaIn, pg8::DenseOrder, false, true>(lds, g, S, E, tid);
            if (vcu >= 144) conv_claim(P, lds, l, 2 * MK_Q_ATT, tid);
        } PHASE_END
        PHASE_BEGIN(5, pb + LP_MLANORM, kind == 2 && !MK_FUSE_MLANORM) phase_mla_norm(P, gw, lane); PHASE_END
        PHASE_BEGIN(6, pb + LP_MLAUP, kind == 2) {
            pg8::Gemm g{WSP(const bf16_t, WS_CQKV), WSP(const bf16_t, WS_WC_UP), C_UPK, 0, nullptr};
            pg8::DenseOrder S{NT / 256, 14, vcu, 0, 0, 0};
            pg8::EpiMlaUp E{WSP(bf16_t, WS_QKV), WSP(const float, WS_ROPE_C)};
            pg8::gemm_phase<pg8::EpiMlaUp, pg8::DenseOrder, false>(lds, g, S, E, tid);
        } PHASE_END
        PHASE_BEGIN(7, pb + LP_ATT, kind == 0) {
            const bf16_t* QKV = WSP(const bf16_t, WS_QKV); bf16_t* O = WSP(bf16_t, WS_O); const float* sink = P->in[11] + slot * 16;
            for (int u = vcu, k = 0; u < 1024; u += 256, ++k) { int t_ = wid0 * 64 + lane_id(); asm volatile("" : "+v"(t_)); const int bk = u >> 5; att::attn_A_unit(lds, QKV, O, sink, bk >> 2, bk & 3, u & 31, false, t_);
                if (MK_Q_STAG > 0 && (vcu & 3) == k) conv_claim(P, lds, l >= 1 ? l : 1, MK_Q_STAG, t_); }
            if (!last) for (int u = vcu; u < 128; u += 256) { const int bk = u >> 2; att::attn_A_unit(lds, QKV, O, sink, bk >> 2, bk & 3, u & 3, true, tid); }
            if (!last && vcu >= 128) conv_claim(P, lds, l >= 1 ? l : 1, MK_Q_ATT, tid);
        } PHASE_END
        PHASE_BEGIN(8, pb + LP_ATT, kind == 1) {
            const bf16_t* QKV = WSP(const bf16_t, WS_QKV); bf16_t* O = WSP(bf16_t, WS_O); LAS float* tab = (LAS float*)(misc + M_RPB);
            for (int u = vcu, k = 0; u < 1024; u += 256, ++k) { int t_ = wid0 * 64 + lane_id(); asm volatile("" : "+v"(t_)); const int bh = u >> 3; att::attn_B_unit(lds, tab, QKV, O, P->in[14], bh >> 4, bh & 15, u & 7, false, t_);
                if (MK_Q_STAG > 0 && (vcu & 3) == k) conv_claim(P, lds, l, MK_Q_STAG, t_); }
            for (int u = vcu; u < 128; u += 256) att::attn_B_unit(lds, tab, QKV, O, P->in[14], u >> 4, u & 15, 0, true, tid);
            if (vcu >= 128) conv_claim(P, lds, l, MK_Q_ATT, tid);
        } PHASE_END
        PHASE_BEGIN(9, pb + LP_ATT, kind == 2) {
            const bf16_t* QKV = WSP(const bf16_t, WS_QKV); bf16_t* O = WSP(bf16_t, WS_O); const bf16_t* KR = WSP(const bf16_t, WS_KR);
            for (int u = vcu, k = 0; u < 1024; u += 256, ++k) { int t_ = wid0 * 64 + lane_id(); asm volatile("" : "+v"(t_)); const int bh = u >> 3; att::attn_C_unit(lds, QKV, KR, O, bh >> 4, bh & 15, u & 7, false, t_);
                if (MK_Q_STAG > 0 && (vcu & 3) == k) conv_claim(P, lds, l, MK_Q_STAG, t_); }
            for (int u = vcu; u < 128; u += 256) att::attn_C_unit(lds, QKV, KR, O, u >> 4, u & 15, 0, true, tid);
            if (vcu >= 128) conv_claim(P, lds, l, MK_Q_ATT, tid);
        } PHASE_END
        PHASE_BEGIN(10, pb + LP_OUT, true) {
            const bf16_t* W = kind == 0 ? WSP(const bf16_t, WS_WA_OUT) + (size_t)slot * D * D : (kind == 1 ? WSP(const bf16_t, WS_WB_OUT) : WSP(const bf16_t, WS_WC_OUT));
            pg8::Gemm g{WSP(const bf16_t, WS_O), W, D, 0, nullptr};
            pg8::DenseOrder S{nMrows, 4, vcu, 0, 0, 0};
            pg8::EpiResid E{(const LAS float*)(misc + M_EPF), WSP(bf16_t, WS_XS), WSP(const float, WS_MOD) + (size_t)l * 9 * 6144 + 2048, (rep_ + 1 < 1 + ((MK_REP_MASK >> 10) & 1)) ? WSP(bf16_t, WS_ACT) : WSP(bf16_t, WS_XS)};
            pg8::gemm_phase<pg8::EpiResid, pg8::DenseOrder, false>(lds, g, S, E, tid);
            if (!last && S.short_one()) conv_claim(P, lds, l + 1, MK_Q_OUT, tid);
        } PHASE_END
        PHASE_BEGIN(11, pb + LP_RT, true) { if (l >= 1) conv_claim(P, lds, l, 1 << 30, tid); phase_router(P, lds, l, last ? NL : NT, vcu, tid, rep_); } PHASE_END
        PHASE_BEGIN(12, pb + LP_GU, true) {
            moe_tables(misc, WSP(unsigned, WS_CTL) + CW_CNT + (l * 2 + ((MK_REP_MASK >> 11) & 1)) * 512, tid);
            pg8::Gemm g{WSP(const void, WS_H), WSP(const unsigned char, WS_WGU) + (size_t)l * NEXP * 2 * D * D, D, (size_t)2 * D * D, WSP(const int, WS_ELIST)};
            const int Ugu = __builtin_amdgcn_readfirstlane(((const LAS int*)(misc + M_CUMT))[32]) * 8, Rgu = (Ugu + 255) >> 8, Gmin = (Ugu + Rgu - 1) / (Rgu > 0 ? Rgu : 1);
            const int cpx = (!last && MK_CVW_GU > 0) ? ((256 - Gmin) >> 3) : 0;
            const bool cvw = (vcu & 31) >= 32 - cpx;
            const int Gc = 256 - 8 * cpx, ic = cvw ? -1 : vcu - cpx * (vcu >> 5);
            pg8::MoeOrder S{(const LAS int*)(misc + M_ECNT), (const LAS int*)(misc + M_LBASE), (const LAS int*)(misc + M_CUMT), 8, ic, Gc, (LAS int*)(misc + M_UL)}; S.build(tid);
            pg8::EpiSwiglu8 E{WSP(unsigned char, WS_ACT), WSP(float, WS_SBLK), P->in[24] + (size_t)l * NEXP * D, P->in[26] + (size_t)l * NEXP * D, WSP(const float, WS_SAL), WSP(const float, WS_SBW) + (size_t)l * NEXP * 2048, (const LAS float*)(misc + M_EPF)};
            pg8::gemm_phase<pg8::EpiSwiglu8, pg8::MoeOrder, true, true>(lds, g, S, E, tid);
            if (!last && (cvw || S.short_one())) conv_claim(P, lds, l + 1, cvw ? (Rgu * MK_CVW_GU) >> 1 : MK_Q_GU, tid);
        } PHASE_END
        PHASE_BEGIN(13, pb + LP_DN, true) {
            if (MK_PER_PHASE) moe_tables(misc, WSP(unsigned, WS_CTL) + CW_CNT + (l * 2 + ((MK_REP_MASK >> 11) & 1)) * 512, tid);
            if (MK_TIME_PHASE == 1000 + l) ts0 = __builtin_amdgcn_s_memrealtime();
            phase_requant(P, (const LAS int*)(misc + M_CUMT), gw, lane);
            xcd_barrier(bar);
            if (MK_TIME_PHASE == 1000 + l) tsd = __builtin_amdgcn_s_memrealtime() - ts0;
            const int Udn = __builtin_amdgcn_readfirstlane(((const LAS int*)(misc + M_CUMT))[32]) * 4, Rdn = (Udn + 255) >> 8, Gmin = (Udn + Rdn - 1) / (Rdn > 0 ? Rdn : 1);
            const int cpx = (!last && MK_CVW_DN > 0) ? ((256 - Gmin) >> 3) : 0;
            const bool cvw = (vcu & 31) >= 32 - cpx;
            const int Gc = 256 - 8 * cpx, ic = cvw ? -1 : vcu - cpx * (vcu >> 5);
            pg8::Gemm g{WSP(const void, WS_ACT8), WSP(const unsigned char, WS_WD) + (size_t)l * NEXP * D * D, D, (size_t)D * D, nullptr};
            pg8::MoeOrder S{(const LAS int*)(misc + M_ECNT), (const LAS int*)(misc + M_LBASE), (const LAS int*)(misc + M_CUMT), 4, ic, Gc, (LAS int*)(misc + M_UL)}; S.build(tid);
            pg8::EpiDown8 E{WSP(unsigned char, WS_YS), WSP(float, WS_YSB), P->in[28] + (size_t)l * NEXP * D, WSP(const float, WS_SAQ), WSP(const float, WS_SBD) + (size_t)l * NEXP * D, (const LAS float*)(misc + M_EPF)};
            pg8::gemm_phase<pg8::EpiDown8, pg8::MoeOrder, false, true>(lds, g, S, E, tid);
            if (!last && (cvw || S.short_one())) conv_claim(P, lds, l + 1, cvw ? (Rdn * MK_CVW_DN) >> 1 : MK_Q_DN, tid);
        } PHASE_END
        PHASE_BEGIN(14, pb + LP_CB, true) phase_combine(P, lds, l, last ? NL : NT, gw, tid, (rep_ + 1 < 1 + ((MK_REP_MASK >> 14) & 1))); PHASE_END
    }
    PHASE_BEGIN(15, PH_FINAL, MK_STOP_AFTER < PH_FINAL - 1) phase_final_norm(P, gw, lane); PHASE_END
    if (MK_TIME_PHASE >= 0) {
        xcd_barrier(bar); STAMP_HERE();
        ArgsK ak_ = ak; PK P = &ak_->P; unsigned* tw = WSP(unsigned, WS_CTL) + 300;
        if (blockIdx.x == 0 && wid0 == 0 && lane_id() == 0) __hip_atomic_store(tw, (unsigned)tsd, __ATOMIC_RELAXED, __HIP_MEMORY_SCOPE_AGENT);
        xcd_barrier(bar);
        const float us = (float)__hip_atomic_load(tw, __ATOMIC_RELAXED, __HIP_MEMORY_SCOPE_AGENT) * 0.01f; const float sv = log2f(fmaxf(us, 1.0f));
        const int gt = blockIdx.x * 512 + wid0 * 64 + lane_id();
        for (int i = gt; i < NL * D / 4; i += 131072) ((f32x4*)P->out)[i] = (f32x4){sv, sv, sv, sv};
    }
#undef PHASE_BEGIN
#undef PHASE_END
}

extern "C" void kernel_launch(void* const* d_in, const int* in_sizes, int n_in, void* d_out, int out_size, void* d_ws, size_t ws_size, hipStream_t stream) {
    static int grid = 0;
    if (grid == 0) {
        if (n_in != 29 || out_size != NL * D || ws_size < WS_END) { fprintf(stderr, "kernel_launch: expected 29 inputs, out %d, ws >= %zu; got n_in %d out %d ws %zu\n", NL * D, (size_t)WS_END, n_in, out_size, ws_size); grid = -1; return; }
        int dev = 0, cus = 0, per_cu = 0;
        if (hipGetDevice(&dev) != hipSuccess || hipDeviceGetAttribute(&cus, hipDeviceAttributeMultiprocessorCount, dev) != hipSuccess) { grid = -1; return; }
        if (hipFuncSetAttribute((const void*)mk_fwd, hipFuncAttributeMaxDynamicSharedMemorySize, LDS_BYTES) != hipSuccess) { fprintf(stderr, "kernel_launch: hipFuncSetAttribute failed\n"); grid = -1; return; }
        if (hipOccupancyMaxActiveBlocksPerMultiprocessor(&per_cu, (const void*)mk_fwd, 512, LDS_BYTES) != hipSuccess || per_cu < 1) fprintf(stderr, "kernel_launch: occupancy query says %d\n", per_cu);
        (void)hipGetLastError();
        grid = 256;
        if (cus < 256) { fprintf(stderr, "kernel_launch: needs 256 CUs, device has %d\n", cus); grid = -1; return; }
    }
    if (grid < 0) return;
    if (hipMemsetAsync((char*)d_ws + WS_CTL, 0, CTL_BYTES, stream) != hipSuccess) return;
    Args a{};
    for (int i = 0; i < 29; ++i) a.P.in[i] = (const float*)d_in[i];
    a.P.out = (float*)d_out; a.P.ws = (unsigned char*)d_ws; a.pad = 0;
#if MK_PER_PHASE
    for (int p = 0; p < NPH; ++p) { a.p_lo = p; a.p_hi = p + 1; a.bar_idx = 0; hipLaunchKernelGGL(mk_fwd, dim3(grid), dim3(512), LDS_BYTES, stream, a); }
#else
    a.p_lo = 0; a.p_hi = NPH; a.bar_idx = 0;
    hipLaunchKernelGGL(mk_fwd, dim3(grid), dim3(512), LDS_BYTES, stream, a);
#endif
    const hipError_t le = hipPeekAtLastError();
    if (le != hipSuccess) fprintf(stderr, "kernel_launch: launch failed: %s\n", hipGetErrorName(le));
}
```
